# Optimizing an MI355X kernel written in HIP

```python
import math
import jax, jax.numpy as jnp
from jax import lax
import numpy as np

D_MODEL = 1024
BATCH = 2
SEQ = 8192
DEPTH = 4

SB_HEADS = 8
SB_HEAD_DIM = 64
SB_WIDTH = SB_HEADS * SB_HEAD_DIM
Q_BLOCK = 128
SGU_GROUPS = 8
SGU_GROUP_DIM = 64
SGU_WIDTH = SGU_GROUPS * SGU_GROUP_DIM
CHUNK = 128
IN_SPLITS = (SB_WIDTH, SB_WIDTH, SB_WIDTH, SGU_WIDTH, SGU_WIDTH, D_MODEL, D_MODEL)
IN_WIDTH = sum(IN_SPLITS)
N_GROUPS = 4
EXPERTS_PER_GROUP = 8
N_EXPERTS = N_GROUPS * EXPERTS_PER_GROUP
TOP_K = 2
EXPERT_FF = 512
MOE_BLOCK = 128
PLE_DIM = 256
EPS = 1e-6

kernel_name = "hybrid_stickbreak_sgu_hmoe_trunk"


def rms_norm(x, g):
    xf = x.astype(jnp.float32)
    y = xf * lax.rsqrt(jnp.mean(xf * xf, axis=-1, keepdims=True) + EPS)
    return (y * g.astype(jnp.float32)).astype(x.dtype)


def stick_breaking_attention(q, k, v):
    b, h, s, dh = q.shape
    q = q.astype(jnp.float32)
    k = k.astype(jnp.float32)
    v = v.astype(jnp.float32)
    nqb = s // Q_BLOCK
    q_blocks = q.reshape(b, h, nqb, Q_BLOCK, dh).transpose(2, 0, 1, 3, 4)
    starts = jnp.arange(nqb, dtype=jnp.int32) * Q_BLOCK
    key_pos = jnp.arange(s, dtype=jnp.int32)
    scale = 1.0 / math.sqrt(dh)

    def block(args):
        q_blk, t0 = args
        z = jnp.einsum('bhqd,bhkd->bhqk', q_blk, k) * scale
        q_pos = t0 + jnp.arange(Q_BLOCK, dtype=jnp.int32)
        causal = key_pos[None, :] < q_pos[:, None]
        log_beta = jax.nn.log_sigmoid(z)
        log_keep = jnp.where(causal, log_beta - z, 0.0)
        after = lax.cumsum(log_keep, axis=3, reverse=True) - log_keep
        a = jnp.where(causal, jnp.exp(log_beta + after), 0.0)
        return jnp.einsum('bhqk,bhkd->bhqd', a, v)

    o = lax.map(block, (q_blocks, starts))
    return o.transpose(1, 2, 0, 3, 4).reshape(b, h, s, dh)


def chunk_spatial_gating(u, v, w_s, b_s):
    b, s, g, dg = v.shape
    nc = s // CHUNK
    vc = v.reshape(b, nc, CHUNK, g, dg)
    tril = jnp.tril(jnp.ones((CHUNK, CHUNK), dtype=bool))
    w = jnp.where(tril[None], w_s, 0.0).astype(v.dtype)
    mixed = jnp.einsum('gts,bcsgd->bctgd', w, vc) + b_s.T.astype(v.dtype)[None, None, :, :, None]
    return u * mixed.reshape(b, s, g, dg)


def hierarchical_moe(h, w_gr, b_gr, w_er, b_er, w_e_in, w_e_out):
    bsz, s, d = h.shape
    n = bsz * s
    hf = h.reshape(n, d)
    g_logits = (hf @ w_gr).astype(jnp.float32) + b_gr.astype(jnp.float32)
    g_prob = jax.nn.softmax(g_logits, axis=-1)
    grp = jnp.argmax(g_prob, axis=-1).astype(jnp.int32)
    grp_w = jnp.max(g_prob, axis=-1)
    e_logits = ((hf @ w_er).astype(jnp.float32) + b_er.astype(jnp.float32))
    e_logits = e_logits.reshape(n, N_GROUPS, EXPERTS_PER_GROUP)
    e_logits = jnp.take_along_axis(e_logits, grp[:, None, None], axis=1)[:, 0]
    e_prob = jax.nn.softmax(e_logits, axis=-1)
    top_w, top_i = lax.top_k(e_prob, TOP_K)
    top_w = top_w / jnp.sum(top_w, axis=-1, keepdims=True)
    wts = (grp_w[:, None] * top_w).reshape(-1)
    eid = (grp[:, None] * EXPERTS_PER_GROUP + top_i.astype(jnp.int32)).reshape(-1)
    tok = jnp.repeat(jnp.arange(n, dtype=jnp.int32), TOP_K)
    order = jnp.argsort(eid)
    se = eid[order]
    counts = jnp.bincount(eid, length=N_EXPERTS).astype(jnp.int32)
    padded = (counts + MOE_BLOCK - 1) // MOE_BLOCK * MOE_BLOCK
    off = jnp.cumsum(counts) - counts
    pend = jnp.cumsum(padded)
    poff = pend - padded
    rank = jnp.arange(n * TOP_K, dtype=jnp.int32) - off[se]
    dest = poff[se] + rank
    cap = n * TOP_K + N_EXPERTS * MOE_BLOCK
    slot_tok = jnp.full((cap,), n, dtype=jnp.int32).at[dest].set(tok[order])
    slot_w = jnp.zeros((cap,), jnp.float32).at[dest].set(wts[order])
    nblk = cap // MOE_BLOCK
    blk_start = jnp.arange(nblk, dtype=jnp.int32) * MOE_BLOCK
    blk_e = jnp.minimum(jnp.sum(pend[None, :] <= blk_start[:, None], axis=1), N_EXPERTS - 1)
    hp = jnp.concatenate([hf, jnp.zeros((1, d), hf.dtype)], axis=0)
    xs = hp[slot_tok].reshape(nblk, MOE_BLOCK, d)

    def expert_block(args):
        xb, e = args
        gate, up = jnp.split(xb @ w_e_in[e], 2, axis=-1)
        return (jax.nn.silu(gate) * up) @ w_e_out[e]

    ys = lax.map(expert_block, (xs, blk_e)).reshape(cap, d)
    ys = ys * slot_w[:, None].astype(ys.dtype)
    out = jnp.zeros((n + 1, d), ys.dtype).at[slot_tok].add(ys)[:n]
    return out.reshape(bsz, s, d)


def setup_inputs(seed: int = 0) -> dict:
    key = jax.random.key(seed)
    ks = jax.random.split(key, 24)
    f32 = jnp.float32
    nrm = lambda k, shape, scale: jax.random.normal(k, shape, f32) * scale
    gain = lambda k, shape: 1.0 + 0.01 * jax.random.normal(k, shape, f32)
    L, D = DEPTH, D_MODEL
    return {
        "x": nrm(ks[0], (BATCH, SEQ, D), 1.0),
        "p": nrm(ks[1], (DEPTH, BATCH, SEQ, PLE_DIM), 1.0),
        "norm_mix": gain(ks[2], (L, D)),
        "w_in": nrm(ks[3], (L, D, IN_WIDTH), D ** -0.5),
        "q_norm": gain(ks[4], (L, SB_HEAD_DIM)),
        "k_norm": gain(ks[5], (L, SB_HEAD_DIM)),
        "sgu_norm": gain(ks[6], (L, SGU_WIDTH)),
        "w_spatial": nrm(ks[7], (L, SGU_GROUPS, CHUNK, CHUNK), CHUNK ** -0.5),
        "b_spatial": gain(ks[8], (L, SGU_GROUPS, CHUNK)),
        "w_up_a": nrm(ks[9], (L, SB_WIDTH, D), SB_WIDTH ** -0.5),
        "w_up_b": nrm(ks[10], (L, SGU_WIDTH, D), SGU_WIDTH ** -0.5),
        "w_out": nrm(ks[11], (L, D, D), D ** -0.5),
        "norm_ffn": gain(ks[12], (L, D)),
        "w_group_router": nrm(ks[13], (L, D, N_GROUPS), D ** -0.5),
        "b_group_router": nrm(ks[14], (L, N_GROUPS), 0.01),
        "w_expert_router": nrm(ks[15], (L, D, N_EXPERTS), D ** -0.5),
        "b_expert_router": nrm(ks[16], (L, N_EXPERTS), 0.01),
        "w_expert_in": nrm(ks[17], (L, N_EXPERTS, D, 2 * EXPERT_FF), D ** -0.5),
        "w_expert_out": nrm(ks[18], (L, N_EXPERTS, EXPERT_FF, D), EXPERT_FF ** -0.5),
        "norm_ple": gain(ks[19], (L, D)),
        "w_ple_gate": nrm(ks[20], (L, D, D), D ** -0.5),
        "w_ple_proj": nrm(ks[21], (L, PLE_DIM, D), PLE_DIM ** -0.5),
    }


def reference(x, p, norm_mix, w_in, q_norm, k_norm, sgu_norm, w_spatial, b_spatial,
              w_up_a, w_up_b, w_out, norm_ffn, w_group_router, b_group_router,
              w_expert_router, b_expert_router, w_expert_in, w_expert_out,
              norm_ple, w_ple_gate, w_ple_proj):
    bsz, s, d = x.shape
    cuts = list(np.cumsum(IN_SPLITS)[:-1])
    for i in range(DEPTH):
        h = rms_norm(x, norm_mix[i])
        z = h @ w_in[i]
        q, k, v, u_s, v_s, g_a, g_b = jnp.split(z, cuts, axis=-1)
        q = rms_norm(q.reshape(bsz, s, SB_HEADS, SB_HEAD_DIM), q_norm[i]).transpose(0, 2, 1, 3)
        k = rms_norm(k.reshape(bsz, s, SB_HEADS, SB_HEAD_DIM), k_norm[i]).transpose(0, 2, 1, 3)
        v = v.reshape(bsz, s, SB_HEADS, SB_HEAD_DIM).transpose(0, 2, 1, 3)
        o_a = stick_breaking_attention(q, k, v).astype(x.dtype)
        o_a = o_a.transpose(0, 2, 1, 3).reshape(bsz, s, SB_WIDTH)
        u_s = jax.nn.gelu(u_s).reshape(bsz, s, SGU_GROUPS, SGU_GROUP_DIM)
        v_s = rms_norm(jax.nn.gelu(v_s), sgu_norm[i]).reshape(bsz, s, SGU_GROUPS, SGU_GROUP_DIM)
        o_b = chunk_spatial_gating(u_s, v_s, w_spatial[i], b_spatial[i]).reshape(bsz, s, SGU_WIDTH)
        merged = jax.nn.sigmoid(g_a) * (o_a @ w_up_a[i]) + jax.nn.sigmoid(g_b) * (o_b @ w_up_b[i])
        x = x + merged @ w_out[i]
        h2 = rms_norm(x, norm_ffn[i])
        x = x + hierarchical_moe(h2, w_group_router[i], b_group_router[i],
                                 w_expert_router[i], b_expert_router[i],
                                 w_expert_in[i], w_expert_out[i])
        gate = jax.nn.sigmoid(rms_norm(x, norm_ple[i]) @ w_ple_gate[i])
        x = x + gate * (p[i].astype(x.dtype) @ w_ple_proj[i])
    return x
```

```cpp
#include <hip/hip_runtime.h>
#include <cstdio>
#include <cstdint>
#include <cmath>
namespace gold {
constexpr int M = 16384, S = 8192, D = 1024, INW = 4608, NE = 32, ECAP = 16384;
constexpr float EPS = 1e-6f;

__device__ __forceinline__ float wsum(float v) {
#pragma unroll
    for (int o = 1; o < 64; o <<= 1) v += __shfl_xor(v, o);
    return v;
}
__device__ __forceinline__ float gelu_tanh(float x) {
    const float u = 0.7978845608028654f * (x + 0.044715f * x * x * x);
    return 0.5f * x * (1.f + tanhf(u));
}
__device__ __forceinline__ float sigm(float x) { return 1.f / (1.f + expf(-x)); }

__global__ void __launch_bounds__(256) k_rmsnorm(const float* __restrict__ x, const float* __restrict__ g, float* __restrict__ out) {
    const int row = blockIdx.x * 4 + (threadIdx.x >> 6), lane = threadIdx.x & 63;
    const float* xr = x + (size_t)row * D;
    float v[16]; float ss = 0.f;
#pragma unroll
    for (int j = 0; j < 16; ++j) { v[j] = xr[lane + 64 * j]; ss += v[j] * v[j]; }
    ss = wsum(ss);
    const float r = rsqrtf(ss * (1.f / D) + EPS);
#pragma unroll
    for (int j = 0; j < 16; ++j) out[(size_t)row * D + lane + 64 * j] = v[j] * r * g[lane + 64 * j];
}

struct GArgs {
    const float* A; const int* rowidx; const float* W; float* C; const int* cnt; const int* off;
    size_t wstride; int lda, ldw, ldc, M, N, K, accumulate, ridx_stride;
};
__global__ void __launch_bounds__(256) k_gemm(GArgs g) {
    __shared__ float As[16][132];
    __shared__ float Bs[16][128];
    const int e = blockIdx.z;
    const int Mloc = g.cnt ? g.cnt[e] : g.M;
    const int row0 = blockIdx.y * 128;
    if (row0 >= Mloc) return;
    const int offe = g.off ? g.off[e] : 0;
    const float* W = g.W + (size_t)e * g.wstride;
    const int col0 = blockIdx.x * 128, tid = threadIdx.x;
    const int ar = tid >> 1, ak = (tid & 1) * 8;
    const int grow = row0 + ar; const bool av = grow < Mloc;
    long arow = 0;
    if (av) arow = g.rowidx ? (long)g.rowidx[(size_t)e * g.ridx_stride + grow] : (long)(offe + grow);
    const float* Ap = g.A + (size_t)arow * g.lda + ak;
    const int bk = tid >> 4, bn = (tid & 15) * 8;
    const float* Bp = W + (size_t)bk * g.ldw + col0 + bn;
    float acc[8][8];
#pragma unroll
    for (int i = 0; i < 8; ++i)
#pragma unroll
        for (int j = 0; j < 8; ++j) acc[i][j] = 0.f;
    const int ty = tid >> 4, tx = tid & 15;
    for (int k0 = 0; k0 < g.K; k0 += 16) {
        float4 a0 = make_float4(0.f, 0.f, 0.f, 0.f), a1 = a0;
        if (av) { a0 = *(const float4*)(Ap + k0); a1 = *(const float4*)(Ap + k0 + 4); }
        const float4 b0 = *(const float4*)(Bp + (size_t)k0 * g.ldw), b1 = *(const float4*)(Bp + (size_t)k0 * g.ldw + 4);
        __syncthreads();
        As[ak + 0][ar] = a0.x; As[ak + 1][ar] = a0.y; As[ak + 2][ar] = a0.z; As[ak + 3][ar] = a0.w;
        As[ak + 4][ar] = a1.x; As[ak + 5][ar] = a1.y; As[ak + 6][ar] = a1.z; As[ak + 7][ar] = a1.w;
        *(float4*)&Bs[bk][bn] = b0; *(float4*)&Bs[bk][bn + 4] = b1;
        __syncthreads();
#pragma unroll
        for (int kk = 0; kk < 16; ++kk) {
            const float4 x0 = *(const float4*)&As[kk][ty * 8], x1 = *(const float4*)&As[kk][ty * 8 + 4];
            const float4 y0 = *(const float4*)&Bs[kk][tx * 8], y1 = *(const float4*)&Bs[kk][tx * 8 + 4];
            const float a[8] = {x0.x, x0.y, x0.z, x0.w, x1.x, x1.y, x1.z, x1.w};
            const float b[8] = {y0.x, y0.y, y0.z, y0.w, y1.x, y1.y, y1.z, y1.w};
#pragma unroll
            for (int i = 0; i < 8; ++i)
#pragma unroll
                for (int j = 0; j < 8; ++j) acc[i][j] += a[i] * b[j];
        }
    }
#pragma unroll
    for (int i = 0; i < 8; ++i) {
        const int r = row0 + ty * 8 + i;
        if (r < Mloc) {
            float* cp = g.C + (size_t)(offe + r) * g.ldc + col0 + tx * 8;
            float4 o0 = make_float4(acc[i][0], acc[i][1], acc[i][2], acc[i][3]), o1 = make_float4(acc[i][4], acc[i][5], acc[i][6], acc[i][7]);
            if (g.accumulate) { const float4 c0 = *(float4*)cp, c1 = *(float4*)(cp + 4);
                o0.x += c0.x; o0.y += c0.y; o0.z += c0.z; o0.w += c0.w; o1.x += c1.x; o1.y += c1.y; o1.z += c1.z; o1.w += c1.w; }
            *(float4*)cp = o0; *(float4*)(cp + 4) = o1;
        }
    }
}

__global__ void __launch_bounds__(256) k_post_in(float* __restrict__ z, const float* __restrict__ qn, const float* __restrict__ kn, const float* __restrict__ sn) {
    const int row = blockIdx.x * 4 + (threadIdx.x >> 6), lane = threadIdx.x & 63;
    float* zr = z + (size_t)row * INW;
#pragma unroll 1
    for (int hh = 0; hh < 16; ++hh) {
        const float v = zr[hh * 64 + lane];
        const float ss = wsum(v * v);
        const float gn = hh < 8 ? qn[lane] : kn[lane];
        zr[hh * 64 + lane] = v * rsqrtf(ss * (1.f / 64.f) + EPS) * gn;
    }
#pragma unroll
    for (int j = 0; j < 8; ++j) { const int c = 1536 + lane + 64 * j; zr[c] = gelu_tanh(zr[c]); }
    float vv[8]; float ss = 0.f;
#pragma unroll
    for (int j = 0; j < 8; ++j) { vv[j] = gelu_tanh(zr[2048 + lane + 64 * j]); ss += vv[j] * vv[j]; }
    ss = wsum(ss);
    const float r = rsqrtf(ss * (1.f / 512.f) + EPS);
#pragma unroll
    for (int j = 0; j < 8; ++j) zr[2048 + lane + 64 * j] = vv[j] * r * sn[lane + 64 * j];
#pragma unroll 4
    for (int j = 0; j < 32; ++j) { const int c = 2560 + lane + 64 * j; zr[c] = sigm(zr[c]); }
}

__global__ void __launch_bounds__(256) k_attn(const float* __restrict__ z, float* __restrict__ oa) {
    const int w = blockIdx.x * 4 + (threadIdx.x >> 6), lane = threadIdx.x & 63;
    const int h = w & 7, row = w >> 3, t = row & (S - 1), rowb = row - t;
    const float q = z[(size_t)row * INW + h * 64 + lane] * 0.125f;
    float o = 0.f, R = 0.f;
    for (int s = t - 1; s >= 0; --s) {
        const float* zr = z + (size_t)(rowb + s) * INW;
        const float kk = zr[512 + h * 64 + lane], vv = zr[1024 + h * 64 + lane];
        const float zz = wsum(q * kk);
        const float l1 = log1pf(expf(-fabsf(zz)));
        const float lb = fminf(zz, 0.f) - l1;
        const float a = expf(lb + R);
        o += a * vv;
        R += lb - zz;
        if (R < -110.f) break;
    }
    oa[(size_t)row * 512 + h * 64 + lane] = o;
}

__global__ void __launch_bounds__(256) k_sgu(const float* __restrict__ z, const float* __restrict__ wsp, const float* __restrict__ bsp, float* __restrict__ ob) {
    const size_t idx = (size_t)blockIdx.x * 256 + threadIdx.x;
    const int c = (int)(idx & 511), row = (int)(idx >> 9);
    const int g = c >> 6, tl = row & 127, r0 = row - tl;
    const float* wr = wsp + ((size_t)g * 128 + tl) * 128;
    float acc = 0.f;
    for (int s = 0; s <= tl; ++s) acc += wr[s] * z[(size_t)(r0 + s) * INW + 2048 + c];
    acc += bsp[g * 128 + tl];
    ob[(size_t)row * 512 + c] = z[(size_t)row * INW + 1536 + c] * acc;
}

__global__ void __launch_bounds__(256) k_merge(const float* __restrict__ z, float* __restrict__ ya, const float* __restrict__ yb) {
    const size_t idx = (size_t)blockIdx.x * 256 + threadIdx.x;
    const int c = (int)(idx & 1023); const size_t row = idx >> 10;
    ya[idx] = z[row * INW + 2560 + c] * ya[idx] + z[row * INW + 3584 + c] * yb[idx];
}

__global__ void __launch_bounds__(256) k_router(const float* __restrict__ h, const float* __restrict__ wgr, const float* __restrict__ bgr, const float* __restrict__ wer, const float* __restrict__ ber,
                                                int* __restrict__ cnt, int* __restrict__ tokl, int* __restrict__ tk_e, int* __restrict__ tk_pos, float* __restrict__ tk_w) {
    __shared__ float lg[4][40];
    const int wv = threadIdx.x >> 6, tok = blockIdx.x * 4 + wv, lane = threadIdx.x & 63;
    float hv[16];
#pragma unroll
    for (int j = 0; j < 16; ++j) hv[j] = h[(size_t)tok * D + lane + 64 * j];
#pragma unroll 1
    for (int o = 0; o < 36; ++o) {
        float p = 0.f;
#pragma unroll
        for (int j = 0; j < 16; ++j) { const int k = lane + 64 * j; p += hv[j] * (o < 4 ? wgr[k * 4 + o] : wer[k * 32 + (o - 4)]); }
        p = wsum(p);
        if (lane == 0) lg[wv][o] = p;
    }
    __syncthreads();
    if (lane == 0) {
        float gl[4]; int grp = 0; float gm = -INFINITY;
#pragma unroll
        for (int i = 0; i < 4; ++i) { gl[i] = lg[wv][i] + bgr[i]; if (gl[i] > gm) { gm = gl[i]; grp = i; } }
        float gs = 0.f;
#pragma unroll
        for (int i = 0; i < 4; ++i) gs += expf(gl[i] - gm);
        const float grp_w = 1.f / gs;
        float el[8]; int i1 = 0; float m1 = -INFINITY;
#pragma unroll
        for (int i = 0; i < 8; ++i) { el[i] = lg[wv][4 + grp * 8 + i] + ber[grp * 8 + i]; if (el[i] > m1) { m1 = el[i]; i1 = i; } }
        int i2 = 0; float m2 = -INFINITY;
#pragma unroll
        for (int i = 0; i < 8; ++i) if (i != i1 && el[i] > m2) { m2 = el[i]; i2 = i; }
        const float p2 = expf(m2 - m1), w1 = 1.f / (1.f + p2), w2 = p2 / (1.f + p2);
        const int e1 = grp * 8 + i1, e2 = grp * 8 + i2;
        const int pos1 = atomicAdd(&cnt[e1], 1), pos2 = atomicAdd(&cnt[e2], 1);
        tokl[e1 * ECAP + pos1] = tok; tokl[e2 * ECAP + pos2] = tok;
        tk_e[tok * 2] = e1; tk_e[tok * 2 + 1] = e2; tk_pos[tok * 2] = pos1; tk_pos[tok * 2 + 1] = pos2;
        tk_w[tok * 2] = grp_w * w1; tk_w[tok * 2 + 1] = grp_w * w2;
    }
}
__global__ void k_offsets(const int* cnt, int* off) { if (threadIdx.x == 0) { int s = 0; for (int e = 0; e < NE; ++e) { off[e] = s; s += cnt[e]; } } }
__global__ void __launch_bounds__(256) k_act(const float* __restrict__ T, float* __restrict__ G) {
    const size_t idx = (size_t)blockIdx.x * 256 + threadIdx.x; const int c = (int)(idx & 511); const size_t s = idx >> 9;
    const float gt = T[s * 1024 + c], up = T[s * 1024 + 512 + c];
    G[idx] = gt * sigm(gt) * up;
}
__global__ void __launch_bounds__(256) k_combine(float* __restrict__ x, const float* __restrict__ ys, const int* __restrict__ off, const int* __restrict__ tk_e, const int* __restrict__ tk_pos, const float* __restrict__ tk_w) {
    const size_t idx = (size_t)blockIdx.x * 256 + threadIdx.x; const int c = (int)(idx & 1023); const int tok = (int)(idx >> 10);
    const int s0 = off[tk_e[tok * 2]] + tk_pos[tok * 2], s1 = off[tk_e[tok * 2 + 1]] + tk_pos[tok * 2 + 1];
    float o = 0.f; o += tk_w[tok * 2] * ys[(size_t)s0 * 1024 + c]; o += tk_w[tok * 2 + 1] * ys[(size_t)s1 * 1024 + c];
    x[idx] += o;
}
__global__ void __launch_bounds__(256) k_ple(float* __restrict__ x, const float* __restrict__ t1, const float* __restrict__ t2) {
    const size_t idx = (size_t)blockIdx.x * 256 + threadIdx.x;
    x[idx] += sigm(t1[idx]) * t2[idx];
}

static void gemm(hipStream_t st, const float* A, int lda, const float* W, int ldw, float* C, int ldc, int Mm, int N, int K, int accumulate) {
    GArgs g{}; g.A = A; g.rowidx = nullptr; g.W = W; g.C = C; g.cnt = nullptr; g.off = nullptr; g.wstride = 0; g.lda = lda; g.ldw = ldw; g.ldc = ldc; g.M = Mm; g.N = N; g.K = K; g.accumulate = accumulate; g.ridx_stride = 0;
    hipLaunchKernelGGL(k_gemm, dim3(N / 128, (Mm + 127) / 128, 1), dim3(256), 0, st, g);
}
static void gemm_grouped(hipStream_t st, const float* A, int lda, const int* rowidx, const float* W, size_t wstride, int ldw, float* C, int ldc, const int* cnt, const int* off, int N, int K) {
    GArgs g{}; g.A = A; g.rowidx = rowidx; g.W = W; g.C = C; g.cnt = cnt; g.off = off; g.wstride = wstride; g.lda = lda; g.ldw = ldw; g.ldc = ldc; g.M = 0; g.N = N; g.K = K; g.accumulate = 0; g.ridx_stride = ECAP;
    hipLaunchKernelGGL(k_gemm, dim3(N / 128, ECAP / 128, NE), dim3(256), 0, st, g);
}

constexpr size_t MiB = 1u << 20;
constexpr size_t O_X = 0, O_H = 64 * MiB, O_Z = 128 * MiB  , O_OA = 416 * MiB, O_OB = 448 * MiB, O_YA = 480 * MiB, O_YB = 544 * MiB,
                 O_T1 = 608 * MiB  , O_G = 736 * MiB  , O_YS = 800 * MiB  , O_CTL = 928 * MiB, O_END = 936 * MiB;

static void forward(void* const* d_in, float* xout, unsigned char* base, int nlayers, hipStream_t st) {
    const float* x0 = (const float*)d_in[0]; const float* p = (const float*)d_in[1];
    float* x = (float*)(base + O_X); float* h = (float*)(base + O_H); float* z = (float*)(base + O_Z); float* oa = (float*)(base + O_OA); float* ob = (float*)(base + O_OB);
    float* ya = (float*)(base + O_YA); float* yb = (float*)(base + O_YB); float* t1 = (float*)(base + O_T1); float* G = (float*)(base + O_G); float* ys = (float*)(base + O_YS);
    unsigned char* ctl = base + O_CTL;
    int* cnt = (int*)ctl; int* off = (int*)(ctl + 1024); int* tokl = (int*)(ctl + 65536); int* tk_e = (int*)(ctl + 3 * MiB); int* tk_pos = (int*)(ctl + 3 * MiB + 256 * 1024); float* tk_w = (float*)(ctl + 3 * MiB + 512 * 1024);
    (void)hipMemcpyAsync(x, x0, (size_t)M * D * 4, hipMemcpyDeviceToDevice, st);
    (void)hipMemsetAsync(cnt, 0, 1024, st);
    for (int i = 0; i < nlayers; ++i) {
        const float* norm_mix = (const float*)d_in[2] + (size_t)i * D; const float* w_in = (const float*)d_in[3] + (size_t)i * D * INW;
        const float* qn = (const float*)d_in[4] + i * 64; const float* kn = (const float*)d_in[5] + i * 64; const float* sn = (const float*)d_in[6] + i * 512;
        const float* wsp = (const float*)d_in[7] + (size_t)i * 8 * 128 * 128; const float* bsp = (const float*)d_in[8] + (size_t)i * 8 * 128;
        const float* wua = (const float*)d_in[9] + (size_t)i * 512 * D; const float* wub = (const float*)d_in[10] + (size_t)i * 512 * D; const float* wout = (const float*)d_in[11] + (size_t)i * D * D;
        const float* nffn = (const float*)d_in[12] + (size_t)i * D; const float* wgr = (const float*)d_in[13] + (size_t)i * D * 4; const float* bgr = (const float*)d_in[14] + i * 4;
        const float* wer = (const float*)d_in[15] + (size_t)i * D * 32; const float* ber = (const float*)d_in[16] + i * 32;
        const float* wei = (const float*)d_in[17] + (size_t)i * NE * D * 1024; const float* weo = (const float*)d_in[18] + (size_t)i * NE * 512 * D;
        const float* nple = (const float*)d_in[19] + (size_t)i * D; const float* wpg = (const float*)d_in[20] + (size_t)i * D * D; const float* wpp = (const float*)d_in[21] + (size_t)i * 256 * D;
        const float* pi = p + (size_t)i * M * 256;
        hipLaunchKernelGGL(k_rmsnorm, dim3(M / 4), dim3(256), 0, st, x, norm_mix, h);
        gemm(st, h, D, w_in, INW, z, INW, M, INW, D, 0);
        hipLaunchKernelGGL(k_post_in, dim3(M / 4), dim3(256), 0, st, z, qn, kn, sn);
        hipLaunchKernelGGL(k_attn, dim3(M * 8 / 4), dim3(256), 0, st, z, oa);
        hipLaunchKernelGGL(k_sgu, dim3(M * 512 / 256), dim3(256), 0, st, z, wsp, bsp, ob);
        gemm(st, oa, 512, wua, D, ya, D, M, D, 512, 0);
        gemm(st, ob, 512, wub, D, yb, D, M, D, 512, 0);
        hipLaunchKernelGGL(k_merge, dim3(M * D / 256), dim3(256), 0, st, z, ya, yb);
        gemm(st, ya, D, wout, D, x, D, M, D, D, 1);
        hipLaunchKernelGGL(k_rmsnorm, dim3(M / 4), dim3(256), 0, st, x, nffn, h);
        hipLaunchKernelGGL(k_router, dim3(M / 4), dim3(256), 0, st, h, wgr, bgr, wer, ber, cnt + i * 32, tokl, tk_e, tk_pos, tk_w);
        hipLaunchKernelGGL(k_offsets, dim3(1), dim3(64), 0, st, cnt + i * 32, off + i * 32);
        gemm_grouped(st, h, D, tokl, wei, (size_t)D * 1024, 1024, t1, 1024, cnt + i * 32, off + i * 32, 1024, D);
        hipLaunchKernelGGL(k_act, dim3(2 * M * 512 / 256), dim3(256), 0, st, t1, G);
        gemm_grouped(st, G, 512, nullptr, weo, (size_t)512 * D, D, ys, D, cnt + i * 32, off + i * 32, D, 512);
        hipLaunchKernelGGL(k_combine, dim3(M * D / 256), dim3(256), 0, st, x, ys, off + i * 32, tk_e, tk_pos, tk_w);
        hipLaunchKernelGGL(k_rmsnorm, dim3(M / 4), dim3(256), 0, st, x, nple, h);
        gemm(st, h, D, wpg, D, t1, D, M, D, D, 0);
        gemm(st, pi, 256, wpp, D, ya, D, M, D, 256, 0);
        hipLaunchKernelGGL(k_ple, dim3(M * D / 256), dim3(256), 0, st, x, t1, ya);
    }
    if (xout) (void)hipMemcpyAsync(xout, x, (size_t)M * D * 4, hipMemcpyDeviceToDevice, st);
}
}
extern "C" void kernel_launch(void* const* d_in, const int* in_sizes, int n_in, void* d_out, int out_size, void* d_ws, size_t ws_size, hipStream_t stream) {
    if (n_in != 22 || out_size != gold::M * gold::D || ws_size < gold::O_END) { fprintf(stderr, "kernel_launch: unexpected shapes (n_in %d out %d ws %zu)\n", n_in, out_size, ws_size); return; }
    gold::forward(d_in, (float*)d_out, (unsigned char*)d_ws, 4, stream);
}
```

```cpp
#include <hip/hip_runtime.h>
#include <hip/hip_bf16.h>
#include <cstdio>
#include <cstdint>
#include <cmath>
namespace fk {
#define LAS __attribute__((address_space(3)))
#define GAS __attribute__((address_space(1)))
typedef unsigned short bf16_t;
typedef short bf16x8 __attribute__((ext_vector_type(8)));
typedef short s16x4 __attribute__((ext_vector_type(4)));
typedef float f32x2 __attribute__((ext_vector_type(2)));
typedef float f32x4 __attribute__((ext_vector_type(4)));
typedef float f32x16 __attribute__((ext_vector_type(16)));
typedef unsigned u32x2 __attribute__((ext_vector_type(2)));
typedef unsigned u32x4 __attribute__((ext_vector_type(4)));

constexpr int M = 16384, SEQ = 8192, D = 1024, INW = 4608, NE = 32, ECAP = 16384, DEPTH = 4;
constexpr float EPS = 1e-6f, LOG2E = 1.4426950408889634f;
constexpr int BM = 256, BK = 64, HALF = 128, HTB = HALF * BK * 2, STAGE_BYTES = 8 * HTB, NXCD = 8, WGM = 8;

__device__ __forceinline__ unsigned cvt_pk_bf16(float lo, float hi) { unsigned r; asm volatile("v_cvt_pk_bf16_f32 %0, %1, %2" : "=v"(r) : "v"(lo), "v"(hi)); return r; }
__device__ __forceinline__ float bf_lo(unsigned w) { return __uint_as_float(w << 16); }
__device__ __forceinline__ float bf_hi(unsigned w) { return __uint_as_float(w & 0xffff0000u); }
__device__ __forceinline__ float fast_rcp(float x) { return __builtin_amdgcn_rcpf(x); }
__device__ __forceinline__ float fast_exp2(float x) { return __builtin_amdgcn_exp2f(x); }
__device__ __forceinline__ float fast_log2(float x) { return __builtin_amdgcn_logf(x); }
__device__ __forceinline__ float fast_rsq(float x) { return __builtin_amdgcn_rsqf(x); }
__device__ __forceinline__ float sigmoid_f(float x) { return fast_rcp(1.f + fast_exp2(-LOG2E * x)); }
__device__ __forceinline__ float gelu_tanh_f(float x) { const float u2 = 1.5957691216057308f * (x + 0.044715f * x * x * x); return x * fast_rcp(1.f + fast_exp2(-LOG2E * u2)); }

__host__ __device__ __forceinline__ int lds_byte(int r, int c) { const int st = (r >> 4) * 2 + (c >> 5), rr = r & 15, cc = c & 31, ob = rr * 64 + cc * 2; return st * 1024 + (ob ^ (((ob >> 9) & 1) << 5)); }
__host__ __device__ __forceinline__ void stage_rc(int b, int& R, int& C) { const int st = b / 1024, sb = b % 1024, swz = sb ^ (((sb >> 9) & 1) << 5); R = (st >> 1) * 16 + swz / 64; C = (st & 1) * 32 + (swz % 64) / 2; }
__host__ __device__ __forceinline__ int perm32(int rho) { const int n = rho >> 4, i = rho & 15; return 8 * (i >> 2) + 4 * n + (i & 3); }

struct Unit { int pm, pn, e, aux; };

struct DenseOrder {
    int nM, nN, nwg, G, c; const char* A; const char* B; int K;
    __device__ void init(int Mr, int N, int G_, int c_, const void* A_, const void* B_, int K_) { nM = Mr / BM; nN = N / BM; nwg = nM * nN; G = G_; c = c_; A = (const char*)A_; B = (const char*)B_; K = K_; }
    __device__ __forceinline__ bool next(int i, Unit& u) const {
        const long L = (long)i * G + c; if (L >= nwg) return false;
        int wgid = (int)L; { const int q = nwg / NXCD, r = nwg % NXCD, xcd = wgid % NXCD, off = wgid / NXCD; wgid = (xcd < r ? xcd * (q + 1) : r * (q + 1) + (xcd - r) * q) + off; }
        const int nig = WGM * nN, gid = wgid / nig, fm = gid * WGM, gsz = (nM - fm) < WGM ? (nM - fm) : WGM;
        u.pm = fm + ((wgid % nig) % gsz); u.pn = (wgid % nig) / gsz; u.e = 0; u.aux = 0; return true;
    }
    __device__ __forceinline__ const char* a_base() const { return A; }
    __device__ __forceinline__ const char* b_base(const Unit& u) const { return B + (size_t)u.pn * BM * K * 2; }
    __device__ __forceinline__ void a_voff(const Unit& u, unsigned (&v)[2][2], const int (&R)[2], const int (&C)[2]) const {
#pragma unroll
        for (int h = 0; h < 2; ++h)
#pragma unroll
            for (int i = 0; i < 2; ++i) v[h][i] = (unsigned)((u.pm * BM + h * HALF + R[i]) * K + C[i]) * 2u;
    }
};

struct ExpertOrder {
    int G, c, K, nN; const char* A; const char* B; size_t bstride; const LAS int* pref; const int* tokl; const int* cnt; int gather;
    __device__ __forceinline__ bool next(int i, Unit& u) const {
        const int L = i * G + c; const int tot = pref[NE] * nN; if (L >= tot) return false;
        const int rbi = L / nN; u.pn = L % nN; int e = 0;
#pragma unroll 1
        for (int j = 1; j < NE; ++j) if (rbi >= pref[j]) e = j;
        u.e = e; u.pm = rbi - pref[e]; u.aux = rbi * BM; return true;
    }
    __device__ __forceinline__ const char* a_base() const { return A; }
    __device__ __forceinline__ const char* b_base(const Unit& u) const { return B + (size_t)u.e * bstride + (size_t)u.pn * BM * K * 2; }
    __device__ __forceinline__ void a_voff(const Unit& u, unsigned (&v)[2][2], const int (&R)[2], const int (&C)[2]) const {
        const int ce = cnt[u.e];
#pragma unroll
        for (int h = 0; h < 2; ++h)
#pragma unroll
            for (int i = 0; i < 2; ++i) {
                const int r = u.pm * BM + h * HALF + R[i]; int row;
                if (gather) row = (r < ce) ? tokl[u.e * ECAP + r] : 0; else row = u.aux + h * HALF + R[i];
                v[h][i] = (unsigned)(row * K + C[i]) * 2u;
            }
    }
};

template <class Epi, class Sched, bool ALIGN_EPI>
__device__ __forceinline__ void gemm_phase(LAS unsigned char* lds, const int K, const Sched& S, const Epi& E) {
    int tid_ = threadIdx.x; asm volatile("" : "+v"(tid_));
    const int tid = tid_, wid = __builtin_amdgcn_readfirstlane(tid >> 6), lane = tid & 63, wr = wid >> 2, wc = wid & 3, fr = lane & 15, fq = lane >> 4;
    const int nt = K / BK;
    int Rr[2], Cc[2]; unsigned voffB[2];
#pragma unroll
    for (int i = 0; i < 2; ++i) { int R, C; stage_rc(tid * 16 + i * 8192, R, C); Rr[i] = R; Cc[i] = C; const int Rb = Epi::PERM ? ((R & ~31) + perm32(R & 31)) : R; voffB[i] = (unsigned)(Rb * K + C) * 2u; }
    const size_t kstep = (size_t)(BK * 2);
    const size_t hstep = (size_t)HALF * K * 2;
    const unsigned ldsw = (unsigned)wid * 1024u;
    const int aoff = lds_byte(wr * 64 + fr, fq * 8), boff = lds_byte(wc * 32 + fr, fq * 8);
#define PG8_SA(b, h) (((b) * 2 + (h)) * HTB)
#define PG8_SB(b, h) ((4 + (b) * 2 + (h)) * HTB)
#define PG8_STAGE_B(bufoff, gbase) do { _Pragma("unroll") for (int _i = 0; _i < 2; ++_i) \
        __builtin_amdgcn_global_load_lds((const unsigned*)((const char*)(gbase) + voffB[_i]), (LAS unsigned*)(lds + (bufoff) + ldsw + _i * 8192), 16, 0, 0); } while (0)
#define PG8_STAGE_A(bufoff, vo, h, koff) do { _Pragma("unroll") for (int _i = 0; _i < 2; ++_i) \
        __builtin_amdgcn_global_load_lds((const unsigned*)(Ab + (size_t)(vo)[h][_i] + (size_t)(koff)), (LAS unsigned*)(lds + (bufoff) + ldsw + _i * 8192), 16, 0, 0); } while (0)
#define PG8_LDA(dst, b, h) do { _Pragma("unroll") for (int m = 0; m < 4; ++m) _Pragma("unroll") for (int k = 0; k < 2; ++k) dst[m][k] = *(const LAS bf16x8*)(lds + PG8_SA(b, h) + aoff + m * 2048 + k * 1024); } while (0)
#define PG8_LDB(dst, b, h) do { _Pragma("unroll") for (int n = 0; n < 2; ++n) _Pragma("unroll") for (int k = 0; k < 2; ++k) dst[n][k] = *(const LAS bf16x8*)(lds + PG8_SB(b, h) + boff + n * 2048 + k * 1024); } while (0)
#define PG8_MMA(ai, bj, At, Bt) do { __builtin_amdgcn_s_setprio(1); _Pragma("unroll") for (int m = 0; m < 4; ++m) _Pragma("unroll") for (int n = 0; n < 2; ++n) _Pragma("unroll") for (int k = 0; k < 2; ++k) \
        acc[ai][bj][m][n] = __builtin_amdgcn_mfma_f32_16x16x32_bf16(Bt[n][k], At[m][k], acc[ai][bj][m][n], 0, 0, 0); __builtin_amdgcn_s_setprio(0); } while (0)
#define PG8_WAIT_V(n) asm volatile("s_waitcnt vmcnt(" #n ")" ::: "memory")
#define PG8_WAIT_L(n) asm volatile("s_waitcnt lgkmcnt(" #n ")" ::: "memory")
#define PG8_BAR __builtin_amdgcn_s_barrier()
#define PG8_SCHED __builtin_amdgcn_sched_barrier(0)
    Unit cur, nxt; int ui = 0;
    if (!S.next(0, cur)) return;
    f32x4 acc[2][2][4][2];
#pragma unroll
    for (int a = 0; a < 2; ++a)
#pragma unroll
        for (int b = 0; b < 2; ++b)
#pragma unroll
            for (int m = 0; m < 4; ++m)
#pragma unroll
                for (int n = 0; n < 2; ++n) acc[a][b][m][n] = (f32x4){0.f, 0.f, 0.f, 0.f};
    bf16x8 At[4][2], B0[2][2], B1[2][2];
    const char* Ab = S.a_base();
    unsigned cvA[2][2], nvA[2][2];
    S.a_voff(cur, cvA, Rr, Cc);
    const char* cB = S.b_base(cur);
    PG8_STAGE_B(PG8_SB(0, 0), cB); PG8_STAGE_B(PG8_SB(0, 1), cB + hstep); PG8_STAGE_A(PG8_SA(0, 0), cvA, 0, 0); PG8_STAGE_A(PG8_SA(0, 1), cvA, 1, 0);
    if (wr == 1) PG8_BAR;
    PG8_WAIT_V(2); PG8_BAR;
    PG8_STAGE_B(PG8_SB(1, 0), cB + kstep); PG8_STAGE_A(PG8_SA(1, 0), cvA, 0, kstep); PG8_STAGE_B(PG8_SB(1, 1), cB + hstep + kstep);
    PG8_WAIT_V(6); PG8_BAR;
    for (;;) {
        const bool has_next = S.next(ui + 1, nxt);
        const char* nB = has_next ? S.b_base(nxt) : cB;
        if (has_next) S.a_voff(nxt, nvA, Rr, Cc);
        else {
#pragma unroll
            for (int h = 0; h < 2; ++h)
#pragma unroll
                for (int i = 0; i < 2; ++i) nvA[h][i] = cvA[h][i];
        }
#pragma unroll 1
        for (int t = 0; t < nt; t += 2) {
            const bool last = (t == nt - 2);
            if constexpr (Epi::HAS_MID) { if (t == Epi::MID_T) E.mid(acc, cur, wr, wc, fr, fq); }
            const size_t k1 = (size_t)(t + 1) * kstep;
            unsigned a2[2][2];
#pragma unroll
            for (int h = 0; h < 2; ++h)
#pragma unroll
                for (int i = 0; i < 2; ++i) a2[h][i] = last ? nvA[h][i] : cvA[h][i] + (unsigned)((t + 2) * (BK * 2));
            const char* b2 = last ? nB : cB + (size_t)(t + 2) * kstep;
            const char* b3 = b2 + kstep;
            PG8_LDB(B0, 0, 0); PG8_LDB(B1, 0, 1); PG8_SCHED; PG8_LDA(At, 0, 0); PG8_STAGE_A(PG8_SA(1, 1), cvA, 1, k1);
            PG8_WAIT_V(8); PG8_WAIT_L(0); PG8_BAR; PG8_MMA(0, 0, At, B0); PG8_MMA(0, 1, At, B1); PG8_BAR; PG8_SCHED;
            PG8_LDA(At, 0, 1); PG8_STAGE_B(PG8_SB(0, 0), b2); PG8_STAGE_B(PG8_SB(0, 1), b2 + hstep); PG8_STAGE_A(PG8_SA(0, 0), a2, 0, 0);
            PG8_WAIT_V(8); PG8_WAIT_L(0); PG8_BAR; PG8_MMA(1, 0, At, B0); PG8_MMA(1, 1, At, B1); PG8_BAR; PG8_SCHED;
            PG8_LDB(B0, 1, 0); PG8_LDB(B1, 1, 1); PG8_SCHED; PG8_LDA(At, 1, 0); PG8_STAGE_A(PG8_SA(0, 1), a2, 1, 0);
            PG8_WAIT_V(8); PG8_WAIT_L(0); PG8_BAR; PG8_MMA(0, 0, At, B0); PG8_MMA(0, 1, At, B1); PG8_BAR; PG8_SCHED;
            PG8_LDA(At, 1, 1); PG8_STAGE_B(PG8_SB(1, 0), b3); PG8_STAGE_B(PG8_SB(1, 1), b3 + hstep); PG8_STAGE_A(PG8_SA(1, 0), a2, 0, kstep);
            PG8_WAIT_V(8); PG8_WAIT_L(0); PG8_BAR; PG8_MMA(1, 0, At, B0); PG8_MMA(1, 1, At, B1); PG8_BAR; PG8_SCHED;
        }
        if constexpr (ALIGN_EPI) { if (wr == 0) PG8_BAR; }
        E(acc, cur, wr, wc, fr, fq);
        if (!has_next) break;
#pragma unroll
        for (int a = 0; a < 2; ++a)
#pragma unroll
            for (int b = 0; b < 2; ++b)
#pragma unroll
                for (int m = 0; m < 4; ++m)
#pragma unroll
                    for (int n = 0; n < 2; ++n) acc[a][b][m][n] = (f32x4){0.f, 0.f, 0.f, 0.f};
        cur = nxt; cB = nB; ++ui;
#pragma unroll
        for (int h = 0; h < 2; ++h)
#pragma unroll
            for (int i = 0; i < 2; ++i) cvA[h][i] = nvA[h][i];
        if constexpr (ALIGN_EPI) { if (wr == 1) PG8_BAR; }
    }
    PG8_WAIT_V(0);
    if constexpr (!ALIGN_EPI) { if (wr == 0) PG8_BAR; }
    PG8_BAR;
#undef PG8_SA
#undef PG8_SB
#undef PG8_STAGE_A
#undef PG8_STAGE_B
#undef PG8_LDA
#undef PG8_LDB
#undef PG8_MMA
#undef PG8_WAIT_V
#undef PG8_WAIT_L
#undef PG8_BAR
#undef PG8_SCHED
}

typedef f32x4 Acc[2][2][4][2];
__device__ __forceinline__ u32x4 pack8(const f32x4 a, const f32x4 b) { u32x4 w; w.x = cvt_pk_bf16(a[0], a[1]); w.y = cvt_pk_bf16(a[2], a[3]); w.z = cvt_pk_bf16(b[0], b[1]); w.w = cvt_pk_bf16(b[2], b[3]); return w; }

struct EpiPlain {
    static constexpr bool PERM = true, HAS_MID = false; static constexpr int MID_T = 0;
    bf16_t* O; int ldc; int use_aux;
    __device__ __forceinline__ void mid(Acc&, const Unit&, int, int, int, int) const {}
    __device__ __forceinline__ void operator()(const Acc& acc, const Unit& u, int wr, int wc, int fr, int fq) const {
        const int row0 = (use_aux ? u.aux : u.pm * BM) + wr * 64 + fr, col0 = u.pn * BM + wc * 32 + 8 * fq;
#pragma unroll
        for (int ai = 0; ai < 2; ++ai)
#pragma unroll
            for (int m = 0; m < 4; ++m) { bf16_t* rowp = O + (size_t)(row0 + ai * HALF + m * 16) * ldc + col0;
#pragma unroll
                for (int bj = 0; bj < 2; ++bj) *(u32x4*)(rowp + bj * HALF) = pack8(acc[ai][bj][m][0], acc[ai][bj][m][1]); }
    }
};

struct EpiIn {
    static constexpr bool PERM = true, HAS_MID = false; static constexpr int MID_T = 0;
    const float* xpart; const float* qn; const float* kn;
    bf16_t *qb, *kb, *vb, *ub, *vsb, *gab; float* vspart;
    __device__ __forceinline__ void mid(Acc&, const Unit&, int, int, int, int) const {}
    __device__ __forceinline__ void operator()(const Acc& acc, const Unit& u, int wr, int wc, int fr, int fq) const {
        const int pn = u.pn;
#pragma unroll
        for (int ai = 0; ai < 2; ++ai)
#pragma unroll
            for (int m = 0; m < 4; ++m) {
                const int row = u.pm * BM + ai * HALF + wr * 64 + m * 16 + fr;
                const f32x4* xp = (const f32x4*)(xpart + (size_t)row * 16);
                const f32x4 s0 = xp[0], s1 = xp[1], s2 = xp[2], s3 = xp[3];
                const float ssx = ((s0[0] + s0[1]) + (s0[2] + s0[3])) + ((s1[0] + s1[1]) + (s1[2] + s1[3])) + ((s2[0] + s2[1]) + (s2[2] + s2[3])) + ((s3[0] + s3[1]) + (s3[2] + s3[3]));
                const float rs = fast_rsq(ssx * (1.f / D) + EPS);
                f32x4 v[2][2];
#pragma unroll
                for (int bj = 0; bj < 2; ++bj)
#pragma unroll
                    for (int n = 0; n < 2; ++n) v[bj][n] = acc[ai][bj][m][n] * rs;
                if (pn < 4) {
                    float ss = 0.f;
#pragma unroll
                    for (int bj = 0; bj < 2; ++bj)
#pragma unroll
                        for (int n = 0; n < 2; ++n) ss += (v[bj][n][0] * v[bj][n][0] + v[bj][n][1] * v[bj][n][1]) + (v[bj][n][2] * v[bj][n][2] + v[bj][n][3] * v[bj][n][3]);
                    ss += __shfl_xor(ss, 16); ss += __shfl_xor(ss, 32);
                    const bool isq = pn < 2;
                    const float sc = fast_rsq(ss * (1.f / 64.f) + EPS) * (isq ? 0.125f * LOG2E : 1.f);
                    const float* gn = isq ? qn : kn; bf16_t* O = isq ? qb : kb;
                    const int head = 4 * (pn & 1) + wc;
#pragma unroll
                    for (int bj = 0; bj < 2; ++bj) {
                        const f32x4 g0 = *(const f32x4*)(gn + 32 * bj + 8 * fq), g1 = *(const f32x4*)(gn + 32 * bj + 8 * fq + 4);
                        *(u32x4*)(O + (size_t)row * 512 + head * 64 + 32 * bj + 8 * fq) = pack8(v[bj][0] * sc * g0, v[bj][1] * sc * g1);
                    }
                } else {
                    const int colw = wc * 32 + 8 * fq;
                    if (pn < 6) {
#pragma unroll
                        for (int bj = 0; bj < 2; ++bj) *(u32x4*)(vb + (size_t)row * 512 + (pn - 4) * BM + bj * HALF + colw) = pack8(v[bj][0], v[bj][1]);
                    } else if (pn < 10) {
                        float ss = 0.f;
#pragma unroll
                        for (int bj = 0; bj < 2; ++bj)
#pragma unroll
                            for (int n = 0; n < 2; ++n)
#pragma unroll
                                for (int i = 0; i < 4; ++i) { const float gv = gelu_tanh_f(v[bj][n][i]); v[bj][n][i] = gv; ss += gv * gv; }
                        if (pn < 8) {
#pragma unroll
                            for (int bj = 0; bj < 2; ++bj) *(u32x4*)(ub + (size_t)row * 512 + (pn - 6) * BM + bj * HALF + colw) = pack8(v[bj][0], v[bj][1]);
                        } else {
#pragma unroll
                            for (int bj = 0; bj < 2; ++bj) *(u32x4*)(vsb + (size_t)row * 512 + (pn - 8) * BM + bj * HALF + colw) = pack8(v[bj][0], v[bj][1]);
                            ss += __shfl_xor(ss, 16); ss += __shfl_xor(ss, 32);
                            if (fq == 0) vspart[(size_t)row * 8 + (pn - 8) * 4 + wc] = ss;
                        }
                    } else {
#pragma unroll
                        for (int bj = 0; bj < 2; ++bj) {
#pragma unroll
                            for (int n = 0; n < 2; ++n)
#pragma unroll
                                for (int i = 0; i < 4; ++i) v[bj][n][i] = fmaxf(sigmoid_f(v[bj][n][i]), 1e-13f);
                            *(u32x4*)(gab + (size_t)row * 2048 + (pn - 10) * BM + bj * HALF + colw) = pack8(v[bj][0], v[bj][1]);
                        }
                    }
                }
            }
    }
};

struct EpiUp {
    static constexpr bool PERM = true, HAS_MID = true; static constexpr int MID_T = 8;
    const bf16_t* gab; bf16_t* mg;
    __device__ __forceinline__ void mid(Acc& acc, const Unit& u, int wr, int wc, int fr, int fq) const {
        int row0 = u.pm * BM + wr * 64 + fr; const int col0 = u.pn * BM + wc * 32 + 8 * fq; asm volatile("" : "+v"(row0));
#pragma unroll
        for (int ai = 0; ai < 2; ++ai)
#pragma unroll
            for (int m = 0; m < 4; ++m) { const bf16_t* gp = gab + (size_t)(row0 + ai * HALF + m * 16) * 2048 + col0;
#pragma unroll
                for (int bj = 0; bj < 2; ++bj) { const u32x4 a = *(const u32x4*)(gp + bj * HALF), b = *(const u32x4*)(gp + 1024 + bj * HALF);
#pragma unroll
                    for (int j = 0; j < 4; ++j) { const float r0 = bf_lo(a[j]) * fast_rcp(bf_lo(b[j])), r1 = bf_hi(a[j]) * fast_rcp(bf_hi(b[j]));
                        acc[ai][bj][m][j >> 1][(j & 1) * 2] *= r0; acc[ai][bj][m][j >> 1][(j & 1) * 2 + 1] *= r1; } }
                asm volatile("" ::: "memory"); }
    }
    __device__ __forceinline__ void operator()(const Acc& acc, const Unit& u, int wr, int wc, int fr, int fq) const {
        int row0 = u.pm * BM + wr * 64 + fr; const int col0 = u.pn * BM + wc * 32 + 8 * fq; asm volatile("" : "+v"(row0));
#pragma unroll
        for (int ai = 0; ai < 2; ++ai)
#pragma unroll
            for (int m = 0; m < 4; ++m) { const size_t ro = (size_t)(row0 + ai * HALF + m * 16);
#pragma unroll
                for (int bj = 0; bj < 2; ++bj) { const u32x4 b = *(const u32x4*)(gab + ro * 2048 + 1024 + col0 + bj * HALF);
                    f32x4 o0, o1;
                    o0[0] = acc[ai][bj][m][0][0] * bf_lo(b[0]); o0[1] = acc[ai][bj][m][0][1] * bf_hi(b[0]); o0[2] = acc[ai][bj][m][0][2] * bf_lo(b[1]); o0[3] = acc[ai][bj][m][0][3] * bf_hi(b[1]);
                    o1[0] = acc[ai][bj][m][1][0] * bf_lo(b[2]); o1[1] = acc[ai][bj][m][1][1] * bf_hi(b[2]); o1[2] = acc[ai][bj][m][1][2] * bf_lo(b[3]); o1[3] = acc[ai][bj][m][1][3] * bf_hi(b[3]);
                    *(u32x4*)(mg + ro * 1024 + col0 + bj * HALF) = pack8(o0, o1); } }
    }
};

struct EpiOut {
    static constexpr bool PERM = false, HAS_MID = false; static constexpr int MID_T = 0;
    const float* xin; float* xout; bf16_t* xb;
    __device__ __forceinline__ void mid(Acc&, const Unit&, int, int, int, int) const {}
    __device__ __forceinline__ void operator()(const Acc& acc, const Unit& u, int wr, int wc, int fr, int fq) const {
        const int row0 = u.pm * BM + wr * 64 + fr, col0 = u.pn * BM + wc * 32 + 4 * fq;
#pragma unroll
        for (int ai = 0; ai < 2; ++ai)
#pragma unroll
            for (int m = 0; m < 4; ++m) { const size_t off = (size_t)(row0 + ai * HALF + m * 16) * D + col0;
#pragma unroll
                for (int bj = 0; bj < 2; ++bj)
#pragma unroll
                    for (int n = 0; n < 2; ++n) { const size_t o = off + bj * HALF + n * 16; const f32x4 xn = *(const f32x4*)(xin + o) + acc[ai][bj][m][n];
                        *(f32x4*)(xout + o) = xn; u32x2 w; w.x = cvt_pk_bf16(xn[0], xn[1]); w.y = cvt_pk_bf16(xn[2], xn[3]); *(u32x2*)(xb + o) = w; } }
    }
};

struct EpiG1 {
    static constexpr bool PERM = true, HAS_MID = false; static constexpr int MID_T = 0;
    const int* tokl; const int* cnt; const float* rs2; bf16_t* Gb;
    __device__ __forceinline__ void mid(Acc&, const Unit&, int, int, int, int) const {}
    __device__ __forceinline__ void operator()(const Acc& acc, const Unit& u, int wr, int wc, int fr, int fq) const {
        const int ce = cnt[u.e];
#pragma unroll
        for (int ai = 0; ai < 2; ++ai)
#pragma unroll
            for (int m = 0; m < 4; ++m) {
                const int rl = ai * HALF + wr * 64 + m * 16 + fr, r = u.pm * BM + rl;
                const int tok = (r < ce) ? tokl[u.e * ECAP + r] : 0;
                const float rs = rs2[tok];
                f32x4 o[2];
#pragma unroll
                for (int n = 0; n < 2; ++n)
#pragma unroll
                    for (int i = 0; i < 4; ++i) { const float g = acc[ai][0][m][n][i] * rs, up = acc[ai][1][m][n][i] * rs; o[n][i] = g * sigmoid_f(g) * up; }
                *(u32x4*)(Gb + (size_t)(u.aux + rl) * 512 + u.pn * HALF + wc * 32 + 8 * fq) = pack8(o[0], o[1]);
            }
    }
};

struct EpiPle {
    static constexpr bool PERM = false, HAS_MID = false; static constexpr int MID_T = 0;
    float* x; bf16_t* xb; const bf16_t* Eb; const float* rs3; float* xpart;
    __device__ __forceinline__ void mid(Acc&, const Unit&, int, int, int, int) const {}
    __device__ __forceinline__ void operator()(const Acc& acc, const Unit& u, int wr, int wc, int fr, int fq) const {
        const int row0 = u.pm * BM + wr * 64 + fr, col0 = u.pn * BM + wc * 32 + 4 * fq;
#pragma unroll
        for (int ai = 0; ai < 2; ++ai)
#pragma unroll
            for (int m = 0; m < 4; ++m) { const int row = row0 + ai * HALF + m * 16; const size_t off = (size_t)row * D + col0; const float rs = rs3[row]; float ss = 0.f;
#pragma unroll
                for (int bj = 0; bj < 2; ++bj)
#pragma unroll
                    for (int n = 0; n < 2; ++n) { const size_t o = off + bj * HALF + n * 16; const u32x2 ev = *(const u32x2*)(Eb + o); const f32x4 xo = *(const f32x4*)(x + o); f32x4 xn;
                        xn[0] = xo[0] + sigmoid_f(acc[ai][bj][m][n][0] * rs) * bf_lo(ev.x); xn[1] = xo[1] + sigmoid_f(acc[ai][bj][m][n][1] * rs) * bf_hi(ev.x);
                        xn[2] = xo[2] + sigmoid_f(acc[ai][bj][m][n][2] * rs) * bf_lo(ev.y); xn[3] = xo[3] + sigmoid_f(acc[ai][bj][m][n][3] * rs) * bf_hi(ev.y);
                        ss += (xn[0] * xn[0] + xn[1] * xn[1]) + (xn[2] * xn[2] + xn[3] * xn[3]);
                        *(f32x4*)(x + o) = xn; u32x2 w; w.x = cvt_pk_bf16(xn[0], xn[1]); w.y = cvt_pk_bf16(xn[2], xn[3]); *(u32x2*)(xb + o) = w; }
                ss += __shfl_xor(ss, 16); ss += __shfl_xor(ss, 32);
                if (fq == 0) xpart[(size_t)row * 16 + u.pn * 4 + wc] = ss; }
    }
};
__device__ __forceinline__ int crow(int r, int hi) { return (r & 3) + 8 * (r >> 2) + 4 * hi; }
__device__ __forceinline__ unsigned cvtpk_s(float lo, float hi) { typedef __bf16 bf16x2_t __attribute__((ext_vector_type(2))); f32x2 v = {lo, hi}; bf16x2_t b = __builtin_convertvector(v, bf16x2_t); return __builtin_bit_cast(unsigned, b); }
#define FK_SBAR() __builtin_amdgcn_sched_barrier(0)
__device__ __forceinline__ void pv(f32x16* o, int vb, bf16x8 pa0, bf16x8 pa1, bf16x8 pa2, bf16x8 pa3) {
#pragma unroll
    for (int d0 = 0; d0 < 2; ++d0) { s16x4 lo[4], hi[4];
#pragma unroll
        for (int ks = 0; ks < 4; ++ks) {
            asm volatile("ds_read_b64_tr_b16 %0,%1 offset:%c2" : "=&v"(lo[ks]) : "v"(vb), "i"(d0 * 4096 + ks * 1024) : "memory");
            asm volatile("ds_read_b64_tr_b16 %0,%1 offset:%c2" : "=&v"(hi[ks]) : "v"(vb), "i"(d0 * 4096 + ks * 1024 + 512) : "memory"); }
        asm volatile("s_waitcnt lgkmcnt(0)" ::: "memory"); FK_SBAR();
#define FK_PK(k) (bf16x8){lo[k][0], lo[k][1], lo[k][2], lo[k][3], hi[k][0], hi[k][1], hi[k][2], hi[k][3]}
        o[d0] = __builtin_amdgcn_mfma_f32_32x32x16_bf16(pa0, FK_PK(0), o[d0], 0, 0, 0);
        o[d0] = __builtin_amdgcn_mfma_f32_32x32x16_bf16(pa1, FK_PK(1), o[d0], 0, 0, 0);
        o[d0] = __builtin_amdgcn_mfma_f32_32x32x16_bf16(pa2, FK_PK(2), o[d0], 0, 0, 0);
        o[d0] = __builtin_amdgcn_mfma_f32_32x32x16_bf16(pa3, FK_PK(3), o[d0], 0, 0, 0);
#undef FK_PK
    }
}
constexpr int WLDS_BYTES = 12288;

__device__ __forceinline__ void attn_wave_unit(int b, int h, int qblk, const bf16_t* __restrict__ qb, const bf16_t* __restrict__ kb, const bf16_t* __restrict__ vb, bf16_t* __restrict__ oc, LAS unsigned char* wl, int lane) {
    const int r32 = lane & 31, hi = lane >> 5;
    const long rowbase = (long)b * SEQ; const int q0 = qblk * 32, tq = q0 + r32;
    bf16x8 qr[4];
    { const bf16_t* qp = qb + (size_t)(rowbase + q0 + r32) * 512 + h * 64 + hi * 8;
#pragma unroll
      for (int d0 = 0; d0 < 4; ++d0) qr[d0] = *(const bf16x8*)(qp + d0 * 16); }
    f32x16 o[2]; o[0] = f32x16{}; o[1] = f32x16{};
    float R = 0.f;
    const int vbase = (int)(unsigned)(uintptr_t)wl + ((lane >> 4) & 1) * 32 + (lane & 3) * 8 + (4 * hi + ((lane & 15) >> 2)) * 64;
    const int jd = q0 >> 6;
    for (int jt = jd; jt >= 0; --jt) {
        const int s0 = jt * 64;
        const bf16_t* kp = kb + (size_t)(rowbase + s0 + r32) * 512 + h * 64 + hi * 8;
        bf16x8 k0[4], k1[4];
#pragma unroll
        for (int d0 = 0; d0 < 4; ++d0) { k0[d0] = *(const bf16x8*)(kp + d0 * 16); k1[d0] = *(const bf16x8*)(kp + 32 * 512 + d0 * 16); }
        u32x4 vt[8];
#pragma unroll
        for (int w8 = 0; w8 < 8; ++w8) vt[w8] = *(const u32x4*)(vb + (size_t)(rowbase + s0 + 16 * (w8 & 3) + (lane >> 2)) * 512 + h * 64 + 32 * (w8 >> 2) + 8 * (lane & 3));
        f32x16 p0 = f32x16{}, p1 = f32x16{};
#pragma unroll
        for (int d0 = 0; d0 < 4; ++d0) { p0 = __builtin_amdgcn_mfma_f32_32x32x16_bf16(k0[d0], qr[d0], p0, 0, 0, 0); p1 = __builtin_amdgcn_mfma_f32_32x32x16_bf16(k1[d0], qr[d0], p1, 0, 0, 0); }
#pragma unroll
        for (int w8 = 0; w8 < 8; ++w8) *(LAS u32x4*)(wl + w8 * 1024 + lane * 16) = vt[w8];
        const bool diag = (jt == jd);
        float lb[32], lk[32];
#pragma unroll
        for (int r = 0; r < 32; ++r) {
            const float z = r < 16 ? p0[r] : p1[r - 16];
            const float e = fast_exp2(-fabsf(z)), l = fast_log2(1.f + e);
            float b_ = fminf(z, 0.f) - l, k_ = b_ - z;
            if (diag) { const int kv = s0 + crow(r & 15, hi) + (r >> 4) * 32; if (!(kv < tq)) { k_ = 0.f; b_ = -INFINITY; } }
            lb[r] = b_; lk[r] = k_;
        }
        float gs[8], pg[8], T[8], SP[8];
#pragma unroll
        for (int g = 0; g < 8; ++g) { gs[g] = (lk[4 * g] + lk[4 * g + 1]) + (lk[4 * g + 2] + lk[4 * g + 3]); pg[g] = __shfl_xor(gs[g], 32); T[g] = gs[g] + pg[g]; }
        SP[7] = 0.f;
#pragma unroll
        for (int g = 6; g >= 0; --g) SP[g] = SP[g + 1] + T[g + 1];
        float a[32];
#pragma unroll
        for (int g = 0; g < 8; ++g) {
            const float base = R + SP[g] + (hi == 0 ? pg[g] : 0.f);
            const float a3 = base, a2 = a3 + lk[4 * g + 3], a1 = a2 + lk[4 * g + 2], a0 = a1 + lk[4 * g + 1];
            a[4 * g + 3] = fast_exp2(lb[4 * g + 3] + a3); a[4 * g + 2] = fast_exp2(lb[4 * g + 2] + a2);
            a[4 * g + 1] = fast_exp2(lb[4 * g + 1] + a1); a[4 * g] = fast_exp2(lb[4 * g] + a0);
        }
        R += SP[0] + T[0];
        u32x4 pw0, pw1, pw2, pw3;
        pw0 = (u32x4){cvtpk_s(a[0], a[1]), cvtpk_s(a[2], a[3]), cvtpk_s(a[4], a[5]), cvtpk_s(a[6], a[7])};
        pw1 = (u32x4){cvtpk_s(a[8], a[9]), cvtpk_s(a[10], a[11]), cvtpk_s(a[12], a[13]), cvtpk_s(a[14], a[15])};
        pw2 = (u32x4){cvtpk_s(a[16], a[17]), cvtpk_s(a[18], a[19]), cvtpk_s(a[20], a[21]), cvtpk_s(a[22], a[23])};
        pw3 = (u32x4){cvtpk_s(a[24], a[25]), cvtpk_s(a[26], a[27]), cvtpk_s(a[28], a[29]), cvtpk_s(a[30], a[31])};
        asm volatile("s_waitcnt lgkmcnt(0)" ::: "memory");
        pv(o, vbase, __builtin_bit_cast(bf16x8, pw0), __builtin_bit_cast(bf16x8, pw1), __builtin_bit_cast(bf16x8, pw2), __builtin_bit_cast(bf16x8, pw3));
        if (__all(R < -159.f)) break;
    }
    LAS bf16_t* stg = (LAS bf16_t*)(wl + 8192);
#pragma unroll
    for (int r = 0; r < 16; ++r) { const int orow = crow(r, hi);
#pragma unroll
        for (int d0 = 0; d0 < 2; ++d0) stg[orow * 64 + d0 * 32 + r32] = (bf16_t)(cvtpk_s(o[d0][r], 0.f) & 0xffffu); }
    asm volatile("s_waitcnt lgkmcnt(0)" ::: "memory");
    bf16_t* Ow = oc + (size_t)(rowbase + q0) * 1024 + h * 64;
#pragma unroll
    for (int i = 0; i < 4; ++i) { const int row = i * 8 + (lane >> 3), ch = lane & 7; const u32x4 v = *(const LAS u32x4*)(stg + row * 64 + ch * 8); *(u32x4*)(Ow + (size_t)row * 1024 + ch * 8) = v; }
    asm volatile("s_waitcnt lgkmcnt(0)" ::: "memory");
}

template <int HF>
__device__ __forceinline__ void sgu_wave_unit(int chunk, int g, const bf16_t* __restrict__ ub, const bf16_t* __restrict__ vsb, const float* __restrict__ vspart, const bf16_t* __restrict__ wsp  ,
                                              const float* __restrict__ bsp  , const float* __restrict__ sgn  , bf16_t* __restrict__ oc, LAS unsigned char* wl, int lane) {
    const int r32 = lane & 31, hi = lane >> 5;
    const size_t row0 = (size_t)chunk * 128;
    const int vbase = (int)(unsigned)(uintptr_t)wl + ((lane >> 4) & 1) * 32 + (lane & 3) * 8 + (4 * hi + ((lane & 15) >> 2)) * 64;
    f32x16 o[2][2];
#pragma unroll
    for (int rl = 0; rl < 2; ++rl) { o[rl][0] = f32x16{}; o[rl][1] = f32x16{}; }
#pragma unroll
    for (int kt = 0; kt <= HF; ++kt) {
#pragma unroll 2
        for (int w8 = 0; w8 < 8; ++w8) {
            const size_t row = row0 + 64 * kt + 16 * (w8 & 3) + (lane >> 2);
            const f32x4 s0 = *(const f32x4*)(vspart + row * 8), s1 = *(const f32x4*)(vspart + row * 8 + 4);
            const float rv = fast_rsq((((s0[0] + s0[1]) + (s0[2] + s0[3])) + ((s1[0] + s1[1]) + (s1[2] + s1[3]))) * (1.f / 512.f) + EPS);
            const u32x4 v = *(const u32x4*)(vsb + row * 512 + g * 64 + 32 * (w8 >> 2) + 8 * (lane & 3));
            u32x4 w;
#pragma unroll
            for (int j = 0; j < 4; ++j) w[j] = cvtpk_s(bf_lo(v[j]) * rv, bf_hi(v[j]) * rv);
            *(LAS u32x4*)(wl + w8 * 1024 + lane * 16) = w;
        }
        asm volatile("s_waitcnt lgkmcnt(0)" ::: "memory");
#pragma unroll
        for (int rl = 0; rl < 2; ++rl) {
            const int rb = 2 * HF + rl;
            const bf16_t* wp = wsp + ((size_t)g * 128 + 32 * rb + r32) * 128 + 64 * kt + 4 * hi;
            u32x4 pw[4];
#pragma unroll
            for (int ks = 0; ks < 4; ++ks) { const u32x2 lo = *(const u32x2*)(wp + 16 * ks), h8 = *(const u32x2*)(wp + 16 * ks + 8); pw[ks] = (u32x4){lo.x, lo.y, h8.x, h8.y}; }
            pv(o[rl], vbase, __builtin_bit_cast(bf16x8, pw[0]), __builtin_bit_cast(bf16x8, pw[1]), __builtin_bit_cast(bf16x8, pw[2]), __builtin_bit_cast(bf16x8, pw[3]));
        }
        asm volatile("s_waitcnt lgkmcnt(0)" ::: "memory");
    }
    LAS bf16_t* stg = (LAS bf16_t*)(wl + 8192);
    const float gn0 = sgn[g * 64 + r32], gn1 = sgn[g * 64 + 32 + r32];
#pragma unroll
    for (int rl = 0; rl < 2; ++rl) {
        const int rb = 2 * HF + rl;
#pragma unroll
        for (int r = 0; r < 16; ++r) { const int orow = crow(r, hi); const float bb = bsp[g * 128 + 32 * rb + orow];
            stg[orow * 64 + r32] = (bf16_t)(cvtpk_s(gn0 * o[rl][0][r] + bb, 0.f) & 0xffffu); stg[orow * 64 + 32 + r32] = (bf16_t)(cvtpk_s(gn1 * o[rl][1][r] + bb, 0.f) & 0xffffu); }
        asm volatile("s_waitcnt lgkmcnt(0)" ::: "memory");
#pragma unroll
        for (int i = 0; i < 4; ++i) { const int row = i * 8 + (lane >> 3), ch = lane & 7; const size_t grow = row0 + 32 * rb + row;
            const u32x4 mv = *(const LAS u32x4*)(stg + row * 64 + ch * 8); const u32x4 uv = *(const u32x4*)(ub + grow * 512 + g * 64 + ch * 8); u32x4 w;
#pragma unroll
            for (int j = 0; j < 4; ++j) w[j] = cvtpk_s(bf_lo(mv[j]) * bf_lo(uv[j]), bf_hi(mv[j]) * bf_hi(uv[j]));
            *(u32x4*)(oc + grow * 1024 + 512 + g * 64 + ch * 8) = w; }
        asm volatile("s_waitcnt lgkmcnt(0)" ::: "memory");
    }
}
constexpr size_t MiB = 1u << 20;
constexpr size_t WS_CTL = 0, CTL_ZERO_BYTES = 1 * MiB;
constexpr size_t WS_W = 16 * MiB, WL_STRIDE = 112 * MiB;
constexpr size_t WO_IN = 0, WO_UP = 9 * MiB, WO_OUT = 11 * MiB, WO_PG = 13 * MiB, WO_PP = 15 * MiB, WO_SP = 15 * MiB + 512 * 1024, WO_R = 15 * MiB + 768 * 1024, WO_EI = 16 * MiB, WO_EO = 80 * MiB;
constexpr size_t WS_PB = 464 * MiB, WS_E = 496 * MiB, WS_XB = 624 * MiB, WS_Q = 656 * MiB, WS_K = 672 * MiB, WS_V = 688 * MiB, WS_U = 704 * MiB, WS_VS = 720 * MiB, WS_GAB = 736 * MiB,
                 WS_OC = 800 * MiB, WS_MG = 832 * MiB, WS_G = 864 * MiB, WS_YS = 904 * MiB, WS_XPART = 984 * MiB, WS_VSPART = 985 * MiB, WS_RS2 = 985 * MiB + 512 * 1024, WS_RS3 = 985 * MiB + 640 * 1024,
                 WS_TOKL = 986 * MiB, WS_TKE = 988 * MiB, WS_TKP = 988 * MiB + 256 * 1024, WS_TKW = 988 * MiB + 512 * 1024, WS_FAST_END = 990 * MiB;
constexpr int GSLOTS = 2 * M + NE * 256;
constexpr int CW_TMO = 0, CW_CODE = 1, CW_BAR = 4096, CW_CNT = 8192  ;

constexpr int RING_OFF = 0, RING_BYTES = 131072, LDSCTL_OFF = RING_BYTES, MISC_OFF = LDSCTL_OFF + 320, PREF_OFF = MISC_OFF + 128  , LDS_BYTES = 147456;

#define RLX_AGENT __ATOMIC_RELAXED, __HIP_MEMORY_SCOPE_AGENT
#define XB_TMO      128
#define XB_XCNT(j)  (256  + 64 * (j))
#define XB_XSUB(j)  (1280 + 64 * (j))
#define XB_XGEN(j)  (2304 + 64 * (j))
#define XB_TOP      3328
#define XB_TOPGEN   3392
#define XCD_BAR_WORDS 3456
#define XB_SPIN_CAP (1u << 18)
__device__ __forceinline__ unsigned xb_ld(unsigned* p)              { return __hip_atomic_load(p, __ATOMIC_RELAXED, __HIP_MEMORY_SCOPE_AGENT); }
__device__ __forceinline__ unsigned xb_add(unsigned* p, unsigned v) { return __hip_atomic_fetch_add(p, v, __ATOMIC_RELAXED, __HIP_MEMORY_SCOPE_AGENT); }
__device__ __forceinline__ unsigned xb_xcc_id() { return (unsigned)__builtin_amdgcn_s_getreg((3 << 11) | 20) & 0xFu; }
#define XB_SPIN(cond, bar) do { unsigned _sp = 0; while (cond) { __builtin_amdgcn_s_sleep(1); \
    if ((++_sp & 255u) == 0u) { if (xb_ld(&(bar)[XB_TMO])) break; if (_sp > XB_SPIN_CAP) { atomicAdd(&(bar)[XB_TMO], 1u); break; } } } } while (0)
struct XcdBarrier { unsigned* bar; unsigned x; volatile LAS unsigned* st; };
__device__ __forceinline__ XcdBarrier xcd_barrier_post(unsigned* bar, volatile LAS unsigned* st) {
    XcdBarrier b; b.bar = bar; b.x = xb_xcc_id(); b.st = st;
    if (threadIdx.x == 0) (void)xb_add(&bar[XB_XCNT(b.x)], 1u);
    return b;
}
__device__ __forceinline__ void xcd_barrier_complete(unsigned* bar, unsigned x, unsigned& nloc, unsigned& nx) {
    const unsigned G = gridDim.x * gridDim.y * gridDim.z;
    unsigned sum, cnt, mine, sp = 0u;
    for (;;) {
        sum = 0u; cnt = 0u; mine = 0u;
#pragma unroll
        for (unsigned j = 0; j < 16; ++j) { const unsigned c = xb_ld(&bar[XB_XCNT(j)]); sum += c; cnt += (c > 0u) ? 1u : 0u; mine = (j == x) ? c : mine; }
        if (sum == G) break;
        __builtin_amdgcn_s_sleep(1);
        if ((++sp & 255u) == 0u) { if (xb_ld(&bar[XB_TMO])) break; if (sp > XB_SPIN_CAP) { atomicAdd(&bar[XB_TMO], 1u); break; } }
    }
    nloc = mine > 0u ? mine : 1u; nx = cnt > 0u ? cnt : 1u;
}
__device__ __forceinline__ void xcd_barrier(const XcdBarrier& b) {
    asm volatile("s_waitcnt vmcnt(0)" ::: "memory");
    __syncthreads();
    if (threadIdx.x == 0) {
        unsigned* bar = b.bar;
        __builtin_amdgcn_s_waitcnt(0);
        unsigned nloc = b.st[0], nx = b.st[1];
        if (nloc == 0u) { xcd_barrier_complete(bar, b.x, nloc, nx); b.st[0] = nloc; b.st[1] = nx; }
        const unsigned old = xb_add(&bar[XB_XSUB(b.x)], 1u);
        const unsigned gen = old / nloc;
        if (old + 1u == (gen + 1u) * nloc) {
            __builtin_amdgcn_fence(__ATOMIC_RELEASE, "agent");
            asm volatile("s_waitcnt vmcnt(0)" ::: "memory");
            const unsigned og = xb_add(&bar[XB_TOP], 1u);
            const unsigned tg = og / nx;
            if (og + 1u == (tg + 1u) * nx) xb_add(&bar[XB_TOPGEN], 1u);
            else XB_SPIN(xb_ld(&bar[XB_TOPGEN]) == tg, bar);
            __builtin_amdgcn_fence(__ATOMIC_ACQUIRE, "agent");
            xb_add(&bar[XB_XGEN(b.x)], 1u);
            asm volatile("s_waitcnt vmcnt(0)" ::: "memory");
        } else {
            XB_SPIN(xb_ld(&bar[XB_XGEN(b.x)]) == gen, bar);
            __builtin_amdgcn_fence(__ATOMIC_ACQUIRE, "agent");
            asm volatile("s_waitcnt vmcnt(0)" ::: "memory");
        }
    }
    __syncthreads();
}

struct Args {
    const float* in[22]; float* out; unsigned char* ws;
    int ph_lo, ph_hi, nlayers, pad;
};
__device__ __forceinline__ float wave_sum(float v) {
#pragma unroll
    for (int o = 1; o < 64; o <<= 1) v += __shfl_xor(v, o);
    return v;
}
__device__ __forceinline__ unsigned f2bf(float f) { unsigned u = __builtin_bit_cast(unsigned, f); return (u + 0x7fffu + ((u >> 16) & 1u)) >> 16; }
__device__ __forceinline__ unsigned pk2(float lo, float hi) { return f2bf(lo) | (f2bf(hi) << 16); }

__device__ __forceinline__ int rowmap(int kind, int n) {
    if (kind == 1) { if (n >= 1024) return n; const int nl = n & 255; return (n - nl) + 128 * ((nl & 63) >> 5) + 32 * (nl >> 6) + (nl & 31); }
    if (kind == 2) { return n < 512 ? 256 * (n >> 7) + (n & 127) : 256 * ((n - 512) >> 7) + 128 + ((n - 512) & 127); }
    return n;
}
__device__ __forceinline__ void transpose_item(const float* __restrict__ W, int N, const float* __restrict__ gain, bf16_t* __restrict__ WT, int ldt, int koff, int kind, LAS float* scr, int item, int lane) {
    const int nblk = N / 32, kb = item / nblk, nb = item % nblk, k0 = 64 * kb, n0 = 32 * nb;
#pragma unroll 8
    for (int i = 0; i < 32; ++i) { const int kk = 2 * i + (lane >> 5); const float gv = gain ? gain[k0 + kk] : 1.f; scr[kk * 33 + (lane & 31)] = gv * W[(size_t)(k0 + kk) * N + n0 + (lane & 31)]; }
    asm volatile("s_waitcnt lgkmcnt(0)" ::: "memory");
    const int c = lane & 7;
#pragma unroll
    for (int j = 0; j < 4; ++j) { const int n = (lane >> 3) + 8 * j; const LAS float* s = scr + (8 * c) * 33 + n;
        u32x4 o; o.x = pk2(s[0 * 33], s[1 * 33]); o.y = pk2(s[2 * 33], s[3 * 33]); o.z = pk2(s[4 * 33], s[5 * 33]); o.w = pk2(s[6 * 33], s[7 * 33]);
        *(u32x4*)(WT + (size_t)rowmap(kind, n0 + n) * ldt + koff + k0 + 8 * c) = o; }
    asm volatile("s_waitcnt lgkmcnt(0)" ::: "memory");
}

typedef const __attribute__((address_space(4))) Args* KArgs;
__device__ __forceinline__ KArgs fresh(KArgs k) { asm volatile("" : "+s"(k)); return k; }
__device__ __forceinline__ void p0_prologue(KArgs ap, int nlayers, LAS unsigned char* lds, int wave, int lane, int gw, int NGW) {
    LAS float* scr = (LAS float*)(lds + RING_OFF + wave * 16384);
    unsigned char* ws = ap->ws;
    constexpr int I_IN = 16 * 144, I_UP = 8 * 32, I_OUT = 16 * 32, I_PG = 16 * 32, I_PP = 4 * 32, I_EI = 16 * 32, I_EO = 8 * 32;
    constexpr int PER_LAYER = I_IN + 2 * I_UP + I_OUT + I_PG + I_PP + NE * I_EI + NE * I_EO;
    const int nitems = PER_LAYER * nlayers;
    for (int it = gw; it < nitems; it += NGW) {
        const int L = it / PER_LAYER; int r = it % PER_LAYER;
        unsigned char* wl = ws + WS_W + (size_t)L * WL_STRIDE;
        if (r < I_IN) { transpose_item(ap->in[3] + (size_t)L * D * INW, INW, ap->in[2] + (size_t)L * D, (bf16_t*)(wl + WO_IN), D, 0, 1, scr, r, lane); continue; } r -= I_IN;
        if (r < I_UP) { transpose_item(ap->in[9] + (size_t)L * 512 * D, D, nullptr, (bf16_t*)(wl + WO_UP), 1024, 0, 0, scr, r, lane); continue; } r -= I_UP;
        if (r < I_UP) { transpose_item(ap->in[10] + (size_t)L * 512 * D, D, nullptr, (bf16_t*)(wl + WO_UP), 1024, 512, 0, scr, r, lane); continue; } r -= I_UP;
        if (r < I_OUT) { transpose_item(ap->in[11] + (size_t)L * D * D, D, nullptr, (bf16_t*)(wl + WO_OUT), D, 0, 0, scr, r, lane); continue; } r -= I_OUT;
        if (r < I_PG) { transpose_item(ap->in[20] + (size_t)L * D * D, D, ap->in[19] + (size_t)L * D, (bf16_t*)(wl + WO_PG), D, 0, 0, scr, r, lane); continue; } r -= I_PG;
        if (r < I_PP) { transpose_item(ap->in[21] + (size_t)L * 256 * D, D, nullptr, (bf16_t*)(wl + WO_PP), 256, 0, 0, scr, r, lane); continue; } r -= I_PP;
        if (r < NE * I_EI) { const int e = r / I_EI; transpose_item(ap->in[17] + ((size_t)L * NE + e) * D * 1024, 1024, ap->in[12] + (size_t)L * D, (bf16_t*)(wl + WO_EI) + (size_t)e * 1024 * 1024, 1024, 0, 2, scr, r % I_EI, lane); continue; } r -= NE * I_EI;
        { const int e = r / I_EO; transpose_item(ap->in[18] + ((size_t)L * NE + e) * 512 * D, D, nullptr, (bf16_t*)(wl + WO_EO) + (size_t)e * 1024 * 512, 512, 0, 0, scr, r % I_EO, lane); }
    }
    const int gt = gw * 64 + lane, NGT = NGW * 64;
    for (int L = 0; L < nlayers; ++L) {
        unsigned char* wl = ws + WS_W + (size_t)L * WL_STRIDE;
        bf16_t* sp = (bf16_t*)(wl + WO_SP); const float* wsrc = ap->in[7] + (size_t)L * 8 * 128 * 128;
        for (int i = gt; i < 8 * 128 * 128; i += NGT) { const int s = i & 127, t = (i >> 7) & 127; sp[i] = (bf16_t)f2bf(s <= t ? wsrc[i] : 0.f); }
        float* wr = (float*)(wl + WO_R); const float* gain = ap->in[12] + (size_t)L * D; const float* wg = ap->in[13] + (size_t)L * D * 4; const float* we = ap->in[15] + (size_t)L * D * 32;
        for (int i = gt; i < 36 * 1024; i += NGT) { const int o = i >> 10, k = i & 1023; wr[i] = gain[k] * (o < 4 ? wg[k * 4 + o] : we[k * 32 + (o - 4)]); }
    }
    { const f32x4* p4 = (const f32x4*)ap->in[1]; u32x2* pb = (u32x2*)(ws + WS_PB); const size_t n4 = (size_t)nlayers * M * 256 / 4;
      for (size_t i = gt; i < n4; i += NGT) { const f32x4 v = p4[i]; u32x2 w; w.x = pk2(v[0], v[1]); w.y = pk2(v[2], v[3]); pb[i] = w; } }
    for (int m = gw; m < M; m += NGW) {
        const f32x4* xr = (const f32x4*)(ap->in[0] + (size_t)m * D) + lane; u32x2* o8 = (u32x2*)((bf16_t*)(ws + WS_XB) + (size_t)m * D) + lane; float s = 0.f;
#pragma unroll
        for (int j = 0; j < 4; ++j) { const f32x4 v = xr[64 * j]; s += (v[0] * v[0] + v[1] * v[1]) + (v[2] * v[2] + v[3] * v[3]); u32x2 w; w.x = pk2(v[0], v[1]); w.y = pk2(v[2], v[3]); o8[64 * j] = w; }
        s = wave_sum(s);
        if (lane < 16) ((float*)(ws + WS_XPART))[(size_t)m * 16 + lane] = lane == 0 ? s : 0.f;
    }
}

__device__ __forceinline__ void router_pass(const float* __restrict__ x, const float* __restrict__ wr  , const float* __restrict__ bgr, const float* __restrict__ ber,
                                            float* __restrict__ rs2, int* __restrict__ cnt, int* __restrict__ tokl, int* __restrict__ tk_e, int* __restrict__ tk_pos, float* __restrict__ tk_w,
                                            LAS unsigned char* lds, int wave, int lane, int gw, int NGW) {
    LAS float* lg = (LAS float*)(lds + RING_OFF + wave * 16384);
    for (int t0 = gw * 4; t0 < M; t0 += NGW * 4) {
        float xv[4][16];
#pragma unroll
        for (int r = 0; r < 4; ++r) { float ss = 0.f;
#pragma unroll
            for (int j = 0; j < 16; ++j) { xv[r][j] = x[(size_t)(t0 + r) * D + lane + 64 * j]; ss += xv[r][j] * xv[r][j]; }
            ss = wave_sum(ss); if (lane == 0) lg[r * 40 + 36] = 1.0f / sqrtf(ss * (1.f / D) + EPS); }
#pragma unroll 1
        for (int o = 0; o < 36; ++o) {
            float wv[16];
#pragma unroll
            for (int j = 0; j < 16; ++j) wv[j] = wr[o * 1024 + lane + 64 * j];
#pragma unroll
            for (int r = 0; r < 4; ++r) { float p = 0.f;
#pragma unroll
                for (int j = 0; j < 16; ++j) p += xv[r][j] * wv[j];
                p = wave_sum(p);
                if (lane == 0) lg[r * 40 + o] = p; }
        }
        asm volatile("s_waitcnt lgkmcnt(0)" ::: "memory");
        if (lane < 4) {
            const int tok = t0 + lane; const LAS float* l = lg + lane * 40;
            const float rsm = l[36];
            rs2[tok] = rsm;
            const float g0 = l[0] * rsm + bgr[0], g1 = l[1] * rsm + bgr[1], g2 = l[2] * rsm + bgr[2], g3 = l[3] * rsm + bgr[3];
            int grp = 0; float gm = g0;
            if (g1 > gm) { gm = g1; grp = 1; } if (g2 > gm) { gm = g2; grp = 2; } if (g3 > gm) { gm = g3; grp = 3; }
            const float gsum = (expf(g0 - gm) + expf(g1 - gm)) + (expf(g2 - gm) + expf(g3 - gm));
            const float grp_w = 1.f / gsum;
            int i1 = 0, i2 = 0; float m1 = -INFINITY, m2 = -INFINITY;
#pragma unroll
            for (int i = 0; i < 8; ++i) { const float el = l[4 + grp * 8 + i] * rsm + ber[grp * 8 + i]; if (el > m1) { m2 = m1; i2 = i1; m1 = el; i1 = i; } else if (el > m2) { m2 = el; i2 = i; } }
            const float p2 = expf(m2 - m1), w1 = 1.f / (1.f + p2), w2 = p2 / (1.f + p2);
            const int e1 = grp * 8 + i1, e2 = grp * 8 + i2;
            const int pos1 = atomicAdd(&cnt[e1], 1), pos2 = atomicAdd(&cnt[e2], 1);
            tokl[e1 * ECAP + pos1] = tok; tokl[e2 * ECAP + pos2] = tok;
            tk_e[tok * 2] = e1; tk_e[tok * 2 + 1] = e2; tk_pos[tok * 2] = pos1; tk_pos[tok * 2 + 1] = pos2; tk_w[tok * 2] = grp_w * w1; tk_w[tok * 2 + 1] = grp_w * w2;
        }
        asm volatile("s_waitcnt lgkmcnt(0)" ::: "memory");
    }
}

__device__ __forceinline__ void combine_pass(float* __restrict__ x, bf16_t* __restrict__ xb, const bf16_t* __restrict__ ys, const LAS int* pref, const int* __restrict__ tk_e, const int* __restrict__ tk_pos,
                                             const float* __restrict__ tk_w, float* __restrict__ rs3, int lane, int gw, int NGW) {
    for (int m = gw; m < M; m += NGW) {
        const int s0 = 256 * pref[tk_e[m * 2]] + tk_pos[m * 2], s1 = 256 * pref[tk_e[m * 2 + 1]] + tk_pos[m * 2 + 1];
        const float w0 = tk_w[m * 2], w1 = tk_w[m * 2 + 1];
        f32x4* xr = (f32x4*)(x + (size_t)m * D) + lane; u32x2* o8 = (u32x2*)(xb + (size_t)m * D) + lane;
        const u32x2* y0 = (const u32x2*)(ys + (size_t)s0 * D) + lane; const u32x2* y1 = (const u32x2*)(ys + (size_t)s1 * D) + lane; float s = 0.f;
#pragma unroll
        for (int j = 0; j < 4; ++j) { f32x4 v = xr[64 * j]; const u32x2 a0 = y0[64 * j], a1 = y1[64 * j];
            v[0] += w0 * bf_lo(a0.x) + w1 * bf_lo(a1.x); v[1] += w0 * bf_hi(a0.x) + w1 * bf_hi(a1.x); v[2] += w0 * bf_lo(a0.y) + w1 * bf_lo(a1.y); v[3] += w0 * bf_hi(a0.y) + w1 * bf_hi(a1.y);
            s += (v[0] * v[0] + v[1] * v[1]) + (v[2] * v[2] + v[3] * v[3]); xr[64 * j] = v; u32x2 w; w.x = pk2(v[0], v[1]); w.y = pk2(v[2], v[3]); o8[64 * j] = w; }
        s = wave_sum(s);
        if (lane == 0) rs3[m] = 1.0f / sqrtf(s * (1.f / D) + EPS);
    }
}

constexpr int NWAVES = 8, PH_PER_LAYER = 9;
__global__ void __launch_bounds__(NWAVES * 64, 2) mega_fwd(Args args_unused) {
    extern __shared__ __attribute__((aligned(16))) unsigned char lds_raw[];
    LAS unsigned char* lds = (LAS unsigned char*)lds_raw;
    LAS int* pref = (LAS int*)(lds + PREF_OFF);
    const KArgs kp0 = (KArgs)__builtin_amdgcn_kernarg_segment_ptr();
    const int tid = threadIdx.x, lane0 = tid & 63, wave0 = __builtin_amdgcn_readfirstlane(tid >> 6);
    const int G = gridDim.x, bx = blockIdx.x;
    const int vcu = (G % 8 == 0) ? (bx % 8) * (G / 8) + bx / 8 : bx;
    const int gw0 = vcu * NWAVES + wave0, NGW = G * NWAVES;
#define FK_IDS int lane_o = lane0, wave_o = wave0, gw_o = gw0; asm volatile("" : "+v"(lane_o), "+s"(wave_o), "+s"(gw_o)); const int lane = lane_o, wave = wave_o, gw = gw_o; (void)lane; (void)wave; (void)gw;
    for (int u = tid; u < (LDS_BYTES - LDSCTL_OFF) / 4; u += NWAVES * 64) ((LAS unsigned*)(lds + LDSCTL_OFF))[u] = 0u;
    __syncthreads();
    const int lo = kp0->ph_lo, hi = kp0->ph_hi, nlayers = kp0->nlayers;
#define IN(k) (lo <= (k) && (k) < hi)
#define SEAM(k) do { if (IN(k) && IN((k) + 1)) { KArgs A_ = fresh(kp0); XcdBarrier bar_; bar_.bar = (unsigned*)(A_->ws + WS_CTL) + CW_BAR; bar_.x = xb_xcc_id(); bar_.st = (volatile LAS unsigned*)(lds + MISC_OFF) + 8; xcd_barrier(bar_); } } while (0)
    if (hi - lo > 1) { KArgs A = fresh(kp0); (void)xcd_barrier_post((unsigned*)(A->ws + WS_CTL) + CW_BAR, (volatile LAS unsigned*)(lds + MISC_OFF) + 8); }

    if (IN(0)) { FK_IDS; p0_prologue(fresh(kp0), nlayers, lds, wave, lane, gw, NGW); }
    SEAM(0);
    if (IN(1)) {
        for (int L = 0; L < nlayers; ++L) {
            KArgs A = fresh(kp0); unsigned char* ws = A->ws;
            DenseOrder S; S.init(M, D, G, bx, ws + WS_PB + (size_t)L * M * 256 * 2, ws + WS_W + (size_t)L * WL_STRIDE + WO_PP, 256);
            EpiPlain E{(bf16_t*)(ws + WS_E) + (size_t)L * M * D, D, 0};
            gemm_phase<EpiPlain, DenseOrder, true>(lds + RING_OFF, 256, S, E);
        }
    }
    SEAM(1);
    for (int L = 0; L < nlayers; ++L) {
        const int pb = 2 + PH_PER_LAYER * L;
        if (IN(pb + 0)) {
            KArgs A = fresh(kp0); unsigned char* ws = A->ws; unsigned char* wl = ws + WS_W + (size_t)L * WL_STRIDE;
            DenseOrder S; S.init(M, INW, G, bx, ws + WS_XB, wl + WO_IN, D);
            EpiIn E{(const float*)(ws + WS_XPART), A->in[4] + L * 64, A->in[5] + L * 64, (bf16_t*)(ws + WS_Q), (bf16_t*)(ws + WS_K), (bf16_t*)(ws + WS_V), (bf16_t*)(ws + WS_U), (bf16_t*)(ws + WS_VS), (bf16_t*)(ws + WS_GAB), (float*)(ws + WS_VSPART)};
            gemm_phase<EpiIn, DenseOrder, true>(lds + RING_OFF, D, S, E);
        }
        SEAM(pb + 0);
        if (IN(pb + 1)) {
            KArgs A = fresh(kp0); unsigned char* ws = A->ws; unsigned char* wl = ws + WS_W + (size_t)L * WL_STRIDE;
            FK_IDS;
            LAS unsigned char* wlds = lds + RING_OFF + wave * WLDS_BYTES;
            constexpr int NATT = 2 * 8 * (SEQ / 32), NSGU = (M / 128) * 8 * 2;
            for (int it = gw; it < NATT + NSGU; it += NGW) {
                if (it < NATT) { const int qblk = it % (SEQ / 32), bh = it / (SEQ / 32); attn_wave_unit(bh >> 3, bh & 7, qblk, (const bf16_t*)(ws + WS_Q), (const bf16_t*)(ws + WS_K), (const bf16_t*)(ws + WS_V), (bf16_t*)(ws + WS_OC), wlds, lane); }
                else { const int j = it - NATT; const int hf = j & 1, g = (j >> 1) & 7, ch = j >> 4;
                    if (hf == 0) sgu_wave_unit<0>(ch, g, (const bf16_t*)(ws + WS_U), (const bf16_t*)(ws + WS_VS), (const float*)(ws + WS_VSPART), (const bf16_t*)(wl + WO_SP), A->in[8] + (size_t)L * 8 * 128, A->in[6] + (size_t)L * 512, (bf16_t*)(ws + WS_OC), wlds, lane);
                    else sgu_wave_unit<1>(ch, g, (const bf16_t*)(ws + WS_U), (const bf16_t*)(ws + WS_VS), (const float*)(ws + WS_VSPART), (const bf16_t*)(wl + WO_SP), A->in[8] + (size_t)L * 8 * 128, A->in[6] + (size_t)L * 512, (bf16_t*)(ws + WS_OC), wlds, lane); }
            }
        }
        SEAM(pb + 1);
        if (IN(pb + 2)) {
            KArgs A = fresh(kp0); unsigned char* ws = A->ws; unsigned char* wl = ws + WS_W + (size_t)L * WL_STRIDE;
            DenseOrder S; S.init(M, D, G, bx, ws + WS_OC, wl + WO_UP, D);
            EpiUp E{(const bf16_t*)(ws + WS_GAB), (bf16_t*)(ws + WS_MG)};
            gemm_phase<EpiUp, DenseOrder, false>(lds + RING_OFF, D, S, E);
        }
        SEAM(pb + 2);
        if (IN(pb + 3)) {
            KArgs A = fresh(kp0); unsigned char* ws = A->ws; unsigned char* wl = ws + WS_W + (size_t)L * WL_STRIDE;
            DenseOrder S; S.init(M, D, G, bx, ws + WS_MG, wl + WO_OUT, D);
            EpiOut E{(L == 0) ? A->in[0] : (const float*)A->out, A->out, (bf16_t*)(ws + WS_XB)};
            gemm_phase<EpiOut, DenseOrder, false>(lds + RING_OFF, D, S, E);
        }
        SEAM(pb + 3);
        if (IN(pb + 4)) {
            KArgs A = fresh(kp0); unsigned char* ws = A->ws; unsigned char* wl = ws + WS_W + (size_t)L * WL_STRIDE;
            FK_IDS;
            router_pass(A->out, (const float*)(wl + WO_R), A->in[14] + L * 4, A->in[16] + L * 32, (float*)(ws + WS_RS2), (int*)((unsigned*)(ws + WS_CTL) + CW_CNT) + L * NE, (int*)(ws + WS_TOKL), (int*)(ws + WS_TKE), (int*)(ws + WS_TKP), (float*)(ws + WS_TKW), lds, wave, lane, gw, NGW);
        }
        SEAM(pb + 4);
        if (IN(pb + 5) || IN(pb + 6) || IN(pb + 7)) {
            KArgs A = fresh(kp0); const int* cnt = (const int*)((unsigned*)(A->ws + WS_CTL) + CW_CNT) + L * NE;
            if (tid == 0) { int s = 0; for (int e = 0; e < NE; ++e) { pref[e] = s; s += (cnt[e] + 255) >> 8; } pref[NE] = s; }
            __syncthreads();
        }
        if (IN(pb + 5)) {
            KArgs A = fresh(kp0); unsigned char* ws = A->ws; unsigned char* wl = ws + WS_W + (size_t)L * WL_STRIDE; const int* cnt = (const int*)((unsigned*)(ws + WS_CTL) + CW_CNT) + L * NE;
            ExpertOrder S{G, bx, D, 4, (const char*)(ws + WS_XB), (const char*)(wl + WO_EI), (size_t)1024 * 1024 * 2, pref, (const int*)(ws + WS_TOKL), cnt, 1};
            EpiG1 E{(const int*)(ws + WS_TOKL), cnt, (const float*)(ws + WS_RS2), (bf16_t*)(ws + WS_G)};
            gemm_phase<EpiG1, ExpertOrder, true>(lds + RING_OFF, D, S, E);
        }
        SEAM(pb + 5);
        if (IN(pb + 6)) {
            KArgs A = fresh(kp0); unsigned char* ws = A->ws; unsigned char* wl = ws + WS_W + (size_t)L * WL_STRIDE; const int* cnt = (const int*)((unsigned*)(ws + WS_CTL) + CW_CNT) + L * NE;
            ExpertOrder S{G, bx, 512, 4, (const char*)(ws + WS_G), (const char*)(wl + WO_EO), (size_t)1024 * 512 * 2, pref, (const int*)(ws + WS_TOKL), cnt, 0};
            EpiPlain E{(bf16_t*)(ws + WS_YS), D, 1};
            gemm_phase<EpiPlain, ExpertOrder, true>(lds + RING_OFF, 512, S, E);
        }
        SEAM(pb + 6);
        if (IN(pb + 7)) {
            KArgs A = fresh(kp0); unsigned char* ws = A->ws;
            FK_IDS;
            combine_pass(A->out, (bf16_t*)(ws + WS_XB), (const bf16_t*)(ws + WS_YS), pref, (const int*)(ws + WS_TKE), (const int*)(ws + WS_TKP), (const float*)(ws + WS_TKW), (float*)(ws + WS_RS3), lane, gw, NGW);
        }
        SEAM(pb + 7);
        if (IN(pb + 8)) {
            KArgs A = fresh(kp0); unsigned char* ws = A->ws; unsigned char* wl = ws + WS_W + (size_t)L * WL_STRIDE;
            DenseOrder S; S.init(M, D, G, bx, ws + WS_XB, wl + WO_PG, D);
            EpiPle E{A->out, (bf16_t*)(ws + WS_XB), (const bf16_t*)(ws + WS_E) + (size_t)L * M * D, (const float*)(ws + WS_RS3), (float*)(ws + WS_XPART)};
            gemm_phase<EpiPle, DenseOrder, false>(lds + RING_OFF, D, S, E);
        }
        SEAM(pb + 8);
    }
#undef IN
#undef SEAM
#undef FK_IDS
}
}
#ifndef FK_N_LAUNCHES
#define FK_N_LAUNCHES 1
#endif
static int fk_grid = 0;
static bool fk_setup() {
    if (fk_grid) return fk_grid > 0;
    int dev = 0, cus = 0, per_cu = 0;
    if (hipGetDevice(&dev) != hipSuccess || hipDeviceGetAttribute(&cus, hipDeviceAttributeMultiprocessorCount, dev) != hipSuccess) { fprintf(stderr, "kernel_launch: device query failed\n"); fk_grid = -1; return false; }
    if (hipFuncSetAttribute((const void*)fk::mega_fwd, hipFuncAttributeMaxDynamicSharedMemorySize, fk::LDS_BYTES) != hipSuccess) { fprintf(stderr, "kernel_launch: hipFuncSetAttribute failed\n"); fk_grid = -1; return false; }
    if (hipOccupancyMaxActiveBlocksPerMultiprocessor(&per_cu, (const void*)fk::mega_fwd, fk::NWAVES * 64, fk::LDS_BYTES) != hipSuccess || per_cu < 1)
        fprintf(stderr, "kernel_launch: note: occupancy query reports %d workgroups per CU\n", per_cu);
    (void)hipGetLastError();
    fk_grid = cus;
    return true;
}
static void fk_launch_range(fk::Args a, int lo, int hi, hipStream_t stream) {
    a.ph_lo = lo; a.ph_hi = hi;
    hipLaunchKernelGGL(fk::mega_fwd, dim3(fk_grid), dim3(fk::NWAVES * 64), fk::LDS_BYTES, stream, a);
    const hipError_t le = hipPeekAtLastError();
    if (le != hipSuccess) fprintf(stderr, "kernel_launch: launch [%d,%d) failed: %s\n", lo, hi, hipGetErrorName(le));
}

#ifdef FK_DEBUG_CHECK
#ifndef FK_FOCUS
#define FK_FOCUS 0
#endif
#ifndef FK_STAT
#define FK_STAT 1
#endif
namespace dbg {
__global__ void __launch_bounds__(256) k_cmp(const void* fast, int is_bf16, int fld, int fcol0, const float* gold, int gld, int gcol0, int rows, int cols, float gscale, float* acc) {
    float sd = 0.f, sb = 0.f, sa = 0.f, sb2 = 0.f;
    const size_t n = (size_t)rows * cols;
    for (size_t i = (size_t)blockIdx.x * 256 + threadIdx.x; i < n; i += (size_t)gridDim.x * 256) {
        const size_t r = i / cols; const int c = (int)(i % cols);
        float a;
        if (is_bf16) { const unsigned short h = ((const unsigned short*)fast)[r * fld + fcol0 + c]; a = __uint_as_float((unsigned)h << 16); } else a = ((const float*)fast)[r * fld + fcol0 + c];
        const float b = gold[r * gld + gcol0 + c] * gscale;
        const float d = a - b; sd += d * d; sb += b * b; sa += (FK_STAT == 2 ? a : FK_STAT == 3 ? a * b : FK_STAT == 4 ? (a > 0.99f ? 1.f : 0.f) : a * a); sb2 += (FK_STAT == 2 ? b : FK_STAT == 4 ? 1.f : b * b);
    }
    for (int o = 1; o < 64; o <<= 1) { sd += __shfl_xor(sd, o); sb += __shfl_xor(sb, o); sa += __shfl_xor(sa, o); sb2 += __shfl_xor(sb2, o); }
    if ((threadIdx.x & 63) == 0) { atomicAdd(&acc[0], sd); atomicAdd(&acc[1], sb); atomicAdd(&acc[512], sa); atomicAdd(&acc[513], sb2); }
}
__global__ void __launch_bounds__(256) k_cmp_vs(const unsigned short* vsb, const float* vspart, const float* gain, const float* gz, float* acc) {
    const int row = blockIdx.x * 4 + (threadIdx.x >> 6), lane = threadIdx.x & 63;
    float ss = 0.f; for (int j = 0; j < 8; ++j) ss += vspart[(size_t)row * 8 + j];
    const float rv = 1.f / sqrtf(ss / 512.f + 1e-6f);
    float sd = 0.f, sb = 0.f;
    for (int j = 0; j < 8; ++j) { const int c = lane + 64 * j; const float a = __uint_as_float((unsigned)vsb[(size_t)row * 512 + c] << 16) * rv * gain[c]; const float b = gz[(size_t)row * 4608 + 2048 + c]; sd += (a - b) * (a - b); sb += b * b; }
    for (int o = 1; o < 64; o <<= 1) { sd += __shfl_xor(sd, o); sb += __shfl_xor(sb, o); }
    if (lane == 0) { atomicAdd(&acc[0], sd); atomicAdd(&acc[1], sb); }
}
__global__ void __launch_bounds__(256) k_cmp_w(const unsigned short* wt, const float* w, const float* gain, int n0, int n1, float* acc) {
    float sd = 0.f, sb = 0.f; const size_t tot = (size_t)(n1 - n0) * 1024;
    for (size_t i = (size_t)blockIdx.x * 256 + threadIdx.x; i < tot; i += (size_t)gridDim.x * 256) { const int n = n0 + (int)(i >> 10), k = (int)(i & 1023);
        const float a = __uint_as_float((unsigned)wt[(size_t)n * 1024 + k] << 16), b = gain[k] * w[(size_t)k * 4608 + n]; sd += (a - b) * (a - b); sb += b * b; }
    for (int o = 1; o < 64; o <<= 1) { sd += __shfl_xor(sd, o); sb += __shfl_xor(sb, o); }
    if ((threadIdx.x & 63) == 0) { atomicAdd(&acc[0], sd); atomicAdd(&acc[1], sb); }
}
__global__ void k_final_v(const float* acc, int nchecks, float tol, float* v, int focus) {
    if (threadIdx.x == 0 && blockIdx.x == 0) {
        float out = 0.f;
        if (focus > 0) { float m = acc[2 * focus + 512] / acc[2 * focus + 513]; if (FK_STAT == 1) m = sqrtf(m); if (!(m <= 8.f)) m = 8.f; m = floorf(m * 20.f + 0.5f) * 0.05f; v[0] = powf(10.f, (float)focus) * (1.f + m); return; }
        for (int c = nchecks; c >= 1; --c) { const float e = sqrtf(acc[2 * c] / acc[2 * c + 1]); if (!(e <= tol)) { float m = e; if (!(m <= 2.f)) m = 2.f; m = floorf(m * 10.f + 0.5f) * 0.1f;   out = powf(10.f, (float)c) * (1.f + m); } }
        v[0] = out;
    }
}
__global__ void __launch_bounds__(256) k_scale_out(const float* base, const float* v, float* out, size_t n) {
    const size_t i = (size_t)blockIdx.x * 256 + threadIdx.x; if (i < n) out[i] = base[i] * (1.f + v[0]);
}
}
#endif

extern "C" void kernel_launch(void* const* d_in, const int* in_sizes, int n_in, void* d_out, int out_size, void* d_ws, size_t ws_size, hipStream_t stream) {
    using namespace fk;
    if (n_in != 22 || out_size != M * D || ws_size < WS_FAST_END) { fprintf(stderr, "kernel_launch: unexpected shapes (n_in %d out %d ws %zu)\n", n_in, out_size, ws_size); return; }
    if (!fk_setup()) return;
    if (hipMemsetAsync((char*)d_ws + WS_CTL, 0, CTL_ZERO_BYTES, stream) != hipSuccess) { fprintf(stderr, "kernel_launch: memset failed\n"); return; }
    Args a{};
    for (int i = 0; i < 22; ++i) a.in[i] = (const float*)d_in[i];
    a.out = (float*)d_out; a.ws = (unsigned char*)d_ws; a.nlayers = DEPTH; a.pad = 0;
#ifndef FK_DEBUG_CHECK
    const int nph = 2 + PH_PER_LAYER * DEPTH;
    if (FK_N_LAUNCHES == 1) fk_launch_range(a, 0, nph, stream);
    else for (int p = 0; p < nph; ++p) fk_launch_range(a, p, p + 1, stream);
#else
    constexpr size_t GOLD_BASE = 1100 * MiB, SN_A = 128 * MiB, SN_B = 192 * MiB, SN_BASE = 256 * MiB, FS_A = 320 * MiB, FS_B = 384 * MiB, DBG_ACC = 448 * MiB;
    if (ws_size < GOLD_BASE + gold::O_END) { fprintf(stderr, "kernel_launch: debug build needs %zu bytes of workspace, got %zu\n", GOLD_BASE + gold::O_END, ws_size); return; }
    unsigned char* ws = (unsigned char*)d_ws; unsigned char* gb = ws + GOLD_BASE;
    gold::forward(d_in, (float*)(ws + SN_BASE), gb, 4, stream);
    gold::forward(d_in, nullptr, gb, 1, stream, (float*)(ws + SN_A), (float*)(ws + SN_B));
    a.nlayers = 1;
    const int nph = 2 + PH_PER_LAYER;
    for (int p = 0; p < nph; ++p) {
        fk_launch_range(a, p, p + 1, stream);
        if (p == 2 + 0) (void)hipMemcpyAsync(ws + 528 * MiB, ws + WS_GAB, (size_t)M * 2048 * 2, hipMemcpyDeviceToDevice, stream);
        if (p == 2 + 3) (void)hipMemcpyAsync(ws + FS_A, d_out, (size_t)M * D * 4, hipMemcpyDeviceToDevice, stream);
        if (p == 2 + 7) (void)hipMemcpyAsync(ws + FS_B, d_out, (size_t)M * D * 4, hipMemcpyDeviceToDevice, stream);
    }
    float* acc = (float*)(ws + DBG_ACC);
    (void)hipMemsetAsync(acc, 0, 4096, stream);
    const float* gz = (const float*)(gb + gold::O_Z);
    int c = 0;
#define CMP(fast, isbf, fld, fc0, gold_, gld, gc0, rows, cols, gs) do { ++c; hipLaunchKernelGGL(dbg::k_cmp, dim3(2048), dim3(256), 0, stream, (const void*)(fast), isbf, fld, fc0, (const float*)(gold_), gld, gc0, rows, cols, gs, acc + 2 * c); } while (0)
    ++c; hipLaunchKernelGGL(dbg::k_cmp_w, dim3(1024), dim3(256), 0, stream, (const unsigned short*)(ws + WS_W + WO_IN), (const float*)d_in[3], (const float*)d_in[2], 1024, 2560, acc + 2 * c);
    ++c; hipLaunchKernelGGL(dbg::k_cmp_w, dim3(1024), dim3(256), 0, stream, (const unsigned short*)(ws + WS_W + WO_IN), (const float*)d_in[3], (const float*)d_in[2], 2560, 3584, acc + 2 * c);
    ++c; hipLaunchKernelGGL(dbg::k_cmp_w, dim3(1024), dim3(256), 0, stream, (const unsigned short*)(ws + WS_W + WO_IN), (const float*)d_in[3], (const float*)d_in[2], 3584, 4608, acc + 2 * c);
    CMP(ws + WS_E, 1, 1024, 0, gb + gold::O_YB, 1024, 0, M, 1024, 1.f);
    CMP(ws + WS_Q, 1, 512, 0, gz, INW, 0, M, 512, 0.125f * LOG2E);
    CMP(ws + WS_K, 1, 512, 0, gz, INW, 512, M, 512, 1.f);
    CMP(ws + WS_V, 1, 512, 0, gz, INW, 1024, M, 512, 1.f);
    CMP(ws + WS_U, 1, 512, 0, gz, INW, 1536, M, 512, 1.f);
    ++c; hipLaunchKernelGGL(dbg::k_cmp_vs, dim3(M / 4), dim3(256), 0, stream, (const unsigned short*)(ws + WS_VS), (const float*)(ws + WS_VSPART), (const float*)d_in[6], gz, acc + 2 * c);
    CMP(ws + WS_OC, 1, 1024, 0, gb + gold::O_OA, 512, 0, M, 512, 1.f);
    CMP(ws + WS_OC, 1, 1024, 512, gb + gold::O_OB, 512, 0, M, 512, 1.f);
    CMP(ws + WS_MG, 1, 1024, 0, gb + gold::O_YA, 1024, 0, M, 1024, 1.f);
    CMP(ws + FS_A, 0, 1024, 0, ws + SN_A, 1024, 0, M, 1024, 1.f);
    CMP(ws + FS_B, 0, 1024, 0, ws + SN_B, 1024, 0, M, 1024, 1.f);
    CMP(d_out, 0, 1024, 0, gb + gold::O_X, 1024, 0, M, 1024, 1.f);
    CMP(ws + 528 * MiB, 1, 2048, 0, gz, INW, 2560, M, 256, 1.f);
    CMP(ws + WS_GAB, 1, 2048, 0, gz, INW, 2560, M, 256, 1.f);
    CMP(ws + WS_GAB, 1, 2048, 256, gz, INW, 2816, M, 256, 1.f);
    CMP(ws + WS_GAB, 1, 2048, 512, gz, INW, 3072, M, 512, 1.f);
    CMP(ws + WS_GAB, 1, 2048, 1024, gz, INW, 3584, M, 1024, 1.f);
    hipLaunchKernelGGL(dbg::k_final_v, dim3(1), dim3(64), 0, stream, acc, c, 0.03f, acc + 900, FK_FOCUS);
    hipLaunchKernelGGL(dbg::k_scale_out, dim3(M * D / 256), dim3(256), 0, stream, (const float*)(ws + SN_BASE), acc + 900, (float*)d_out, (size_t)M * D);
#endif
}
```

```cpp
#include <hip/hip_runtime.h>
#include <hip/hip_bf16.h>
#include <cstdio>
#include <cstdint>
#include <cmath>
namespace fk {
#define LAS __attribute__((address_space(3)))
#define GAS __attribute__((address_space(1)))
typedef unsigned short bf16_t;
typedef short bf16x8 __attribute__((ext_vector_type(8)));
typedef short s16x4 __attribute__((ext_vector_type(4)));
typedef float f32x2 __attribute__((ext_vector_type(2)));
typedef float f32x4 __attribute__((ext_vector_type(4)));
typedef float f32x16 __attribute__((ext_vector_type(16)));
typedef unsigned u32x2 __attribute__((ext_vector_type(2)));
typedef unsigned u32x4 __attribute__((ext_vector_type(4)));

constexpr int M = 16384, SEQ = 8192, D = 1024, INW = 4608, NE = 32, ECAP = 16384, DEPTH = 4;
constexpr float EPS = 1e-6f, LOG2E = 1.4426950408889634f;
constexpr int CNT_STRIDE = 64;
constexpr int BM = 256, BK = 64, HALF = 128, HTB = HALF * BK * 2, STAGE_BYTES = 8 * HTB, NXCD = 8, WGM = 8;

__device__ __forceinline__ unsigned cvt_pk_bf16(float lo, float hi) { unsigned r; asm volatile("v_cvt_pk_bf16_f32 %0, %1, %2" : "=v"(r) : "v"(lo), "v"(hi)); return r; }
__device__ __forceinline__ float bf_lo(unsigned w) { return __uint_as_float(w << 16); }
__device__ __forceinline__ float bf_hi(unsigned w) { return __uint_as_float(w & 0xffff0000u); }
__device__ __forceinline__ float fast_rcp(float x) { return __builtin_amdgcn_rcpf(x); }
__device__ __forceinline__ float fast_exp2(float x) { return __builtin_amdgcn_exp2f(x); }
__device__ __forceinline__ float fast_log2(float x) { return __builtin_amdgcn_logf(x); }
__device__ __forceinline__ float fast_rsq(float x) { return __builtin_amdgcn_rsqf(x); }
__device__ __forceinline__ float sigmoid_f(float x) { return fast_rcp(1.f + fast_exp2(-LOG2E * x)); }
__device__ __forceinline__ float gelu_tanh_f(float x) { const float u2 = 1.5957691216057308f * (x + 0.044715f * x * x * x); return x * fast_rcp(1.f + fast_exp2(-LOG2E * u2)); }

__host__ __device__ __forceinline__ int lds_byte(int r, int c) { const int st = (r >> 4) * 2 + (c >> 5), rr = r & 15, cc = c & 31, ob = rr * 64 + cc * 2; return st * 1024 + (ob ^ (((ob >> 9) & 1) << 5)); }
__host__ __device__ __forceinline__ void stage_rc(int b, int& R, int& C) { const int st = b / 1024, sb = b % 1024, swz = sb ^ (((sb >> 9) & 1) << 5); R = (st >> 1) * 16 + swz / 64; C = (st & 1) * 32 + (swz % 64) / 2; }
__host__ __device__ __forceinline__ int perm32(int rho) { const int n = rho >> 4, i = rho & 15; return 8 * (i >> 2) + 4 * n + (i & 3); }

struct Unit { int pm, pn, e, aux; };

struct DenseOrder {
    int nM, nN, nwg, G, c; const char* A; const char* B; int K;
    __device__ void init(int Mr, int N, int G_, int c_, const void* A_, const void* B_, int K_) { nM = Mr / BM; nN = N / BM; nwg = nM * nN; G = G_; c = c_; A = (const char*)A_; B = (const char*)B_; K = K_; }
    __device__ __forceinline__ bool next(int i, Unit& u) const {
        const long L = (long)i * G + c; if (L >= nwg) return false;
        int wgid = (int)L; { const int q = nwg / NXCD, r = nwg % NXCD, xcd = wgid % NXCD, off = wgid / NXCD; wgid = (xcd < r ? xcd * (q + 1) : r * (q + 1) + (xcd - r) * q) + off; }
        const int nig = WGM * nN, gid = wgid / nig, fm = gid * WGM, gsz = (nM - fm) < WGM ? (nM - fm) : WGM;
        u.pm = fm + ((wgid % nig) % gsz); u.pn = (wgid % nig) / gsz; u.e = 0; u.aux = 0; return true;
    }
    __device__ __forceinline__ const char* a_base() const { return A; }
    __device__ __forceinline__ const char* b_base(const Unit& u) const { return B + (size_t)u.pn * BM * K * 2; }
    __device__ __forceinline__ void a_voff(const Unit& u, unsigned (&v)[2][2], const int (&R)[2], const int (&C)[2]) const {
#pragma unroll
        for (int h = 0; h < 2; ++h)
#pragma unroll
            for (int i = 0; i < 2; ++i) v[h][i] = (unsigned)((u.pm * BM + h * HALF + R[i]) * K + C[i]) * 2u;
    }
};

struct ExpertOrder {
    int G, c, K, nN; const char* A; const char* B; size_t bstride; const LAS int* pref; const int* tokl; const int* cnt; int gather;
    __device__ __forceinline__ bool next(int i, Unit& u) const {
        const int L = i * G + c; const int tot = pref[NE] * nN; if (L >= tot) return false;
        const int rbi = L / nN; u.pn = L % nN; int e = 0;
#pragma unroll 1
        for (int j = 1; j < NE; ++j) if (rbi >= pref[j]) e = j;
        u.e = e; u.pm = rbi - pref[e]; u.aux = rbi * BM; return true;
    }
    __device__ __forceinline__ const char* a_base() const { return A; }
    __device__ __forceinline__ const char* b_base(const Unit& u) const { return B + (size_t)u.e * bstride + (size_t)u.pn * BM * K * 2; }
    __device__ __forceinline__ void a_voff(const Unit& u, unsigned (&v)[2][2], const int (&R)[2], const int (&C)[2]) const {
        const int ce = cnt[u.e * CNT_STRIDE];
#pragma unroll
        for (int h = 0; h < 2; ++h)
#pragma unroll
            for (int i = 0; i < 2; ++i) {
                const int r = u.pm * BM + h * HALF + R[i]; int row;
                if (gather) row = (r < ce) ? tokl[u.e * ECAP + r] : 0; else row = u.aux + h * HALF + R[i];
                v[h][i] = (unsigned)(row * K + C[i]) * 2u;
            }
    }
};

template <class Epi, class Sched, bool ALIGN_EPI>
__device__ __forceinline__ void gemm_phase(LAS unsigned char* lds, const int K, const Sched& S, const Epi& E) {
    int tid_ = threadIdx.x; asm volatile("" : "+v"(tid_));
    const int tid = tid_, wid = __builtin_amdgcn_readfirstlane(tid >> 6), lane = tid & 63, wr = wid >> 2, wc = wid & 3, fr = lane & 15, fq = lane >> 4;
    const int nt = K / BK;
    int Rr[2], Cc[2]; unsigned voffB[2];
#pragma unroll
    for (int i = 0; i < 2; ++i) { int R, C; stage_rc(tid * 16 + i * 8192, R, C); Rr[i] = R; Cc[i] = C; const int Rb = Epi::PERM ? ((R & ~31) + perm32(R & 31)) : R; voffB[i] = (unsigned)(Rb * K + C) * 2u; }
    const size_t kstep = (size_t)(BK * 2);
    const size_t hstep = (size_t)HALF * K * 2;
    const unsigned ldsw = (unsigned)wid * 1024u;
    const int aoff = lds_byte(wr * 64 + fr, fq * 8), boff = lds_byte(wc * 32 + fr, fq * 8);
#define PG8_SA(b, h) (((b) * 2 + (h)) * HTB)
#define PG8_SB(b, h) ((4 + (b) * 2 + (h)) * HTB)
#define PG8_STAGE_B(bufoff, gbase) do { _Pragma("unroll") for (int _i = 0; _i < 2; ++_i) \
        __builtin_amdgcn_global_load_lds((const unsigned*)((const char*)(gbase) + voffB[_i]), (LAS unsigned*)(lds + (bufoff) + ldsw + _i * 8192), 16, 0, 0); } while (0)
#define PG8_STAGE_A(bufoff, vo, h, koff) do { _Pragma("unroll") for (int _i = 0; _i < 2; ++_i) \
        __builtin_amdgcn_global_load_lds((const unsigned*)(Ab + (size_t)(vo)[h][_i] + (size_t)(koff)), (LAS unsigned*)(lds + (bufoff) + ldsw + _i * 8192), 16, 0, 0); } while (0)
#define PG8_LDA(dst, b, h) do { _Pragma("unroll") for (int m = 0; m < 4; ++m) _Pragma("unroll") for (int k = 0; k < 2; ++k) dst[m][k] = *(const LAS bf16x8*)(lds + PG8_SA(b, h) + aoff + m * 2048 + k * 1024); } while (0)
#define PG8_LDB(dst, b, h) do { _Pragma("unroll") for (int n = 0; n < 2; ++n) _Pragma("unroll") for (int k = 0; k < 2; ++k) dst[n][k] = *(const LAS bf16x8*)(lds + PG8_SB(b, h) + boff + n * 2048 + k * 1024); } while (0)
#define PG8_MMA(ai, bj, At, Bt) do { __builtin_amdgcn_s_setprio(1); _Pragma("unroll") for (int m = 0; m < 4; ++m) _Pragma("unroll") for (int n = 0; n < 2; ++n) _Pragma("unroll") for (int k = 0; k < 2; ++k) \
        acc[ai][bj][m][n] = __builtin_amdgcn_mfma_f32_16x16x32_bf16(Bt[n][k], At[m][k], acc[ai][bj][m][n], 0, 0, 0); __builtin_amdgcn_s_setprio(0); } while (0)
#define PG8_WAIT_V(n) asm volatile("s_waitcnt vmcnt(" #n ")" ::: "memory")
#define PG8_WAIT_L(n) asm volatile("s_waitcnt lgkmcnt(" #n ")" ::: "memory")
#define PG8_BAR __builtin_amdgcn_s_barrier()
#define PG8_SCHED __builtin_amdgcn_sched_barrier(0)
    Unit cur, nxt; int ui = 0;
    if (!S.next(0, cur)) return;
    f32x4 acc[2][2][4][2];
#pragma unroll
    for (int a = 0; a < 2; ++a)
#pragma unroll
        for (int b = 0; b < 2; ++b)
#pragma unroll
            for (int m = 0; m < 4; ++m)
#pragma unroll
                for (int n = 0; n < 2; ++n) acc[a][b][m][n] = (f32x4){0.f, 0.f, 0.f, 0.f};
    bf16x8 At[4][2], B0[2][2], B1[2][2];
    const char* Ab = S.a_base();
    unsigned cvA[2][2], nvA[2][2];
    S.a_voff(cur, cvA, Rr, Cc);
    const char* cB = S.b_base(cur);
    PG8_STAGE_B(PG8_SB(0, 0), cB); PG8_STAGE_B(PG8_SB(0, 1), cB + hstep); PG8_STAGE_A(PG8_SA(0, 0), cvA, 0, 0); PG8_STAGE_A(PG8_SA(0, 1), cvA, 1, 0);
    if (wr == 1) PG8_BAR;
    PG8_WAIT_V(2); PG8_BAR;
    PG8_STAGE_B(PG8_SB(1, 0), cB + kstep); PG8_STAGE_A(PG8_SA(1, 0), cvA, 0, kstep); PG8_STAGE_B(PG8_SB(1, 1), cB + hstep + kstep);
    PG8_WAIT_V(6); PG8_BAR;
    for (;;) {
        const bool has_next = S.next(ui + 1, nxt);
        const char* nB = has_next ? S.b_base(nxt) : cB;
        if (has_next) S.a_voff(nxt, nvA, Rr, Cc);
        else {
#pragma unroll
            for (int h = 0; h < 2; ++h)
#pragma unroll
                for (int i = 0; i < 2; ++i) nvA[h][i] = cvA[h][i];
        }
#pragma unroll 1
        for (int t = 0; t < nt; t += 2) {
            const bool last = (t == nt - 2);
            if constexpr (Epi::HAS_MID) { if (t == Epi::MID_T) E.mid(acc, cur, wr, wc, fr, fq); }
            const size_t k1 = (size_t)(t + 1) * kstep;
            unsigned a2[2][2];
#pragma unroll
            for (int h = 0; h < 2; ++h)
#pragma unroll
                for (int i = 0; i < 2; ++i) a2[h][i] = last ? nvA[h][i] : cvA[h][i] + (unsigned)((t + 2) * (BK * 2));
            const char* b2 = last ? nB : cB + (size_t)(t + 2) * kstep;
            const char* b3 = b2 + kstep;
            PG8_LDB(B0, 0, 0); PG8_LDB(B1, 0, 1); PG8_SCHED; PG8_LDA(At, 0, 0); PG8_STAGE_A(PG8_SA(1, 1), cvA, 1, k1);
            PG8_WAIT_V(8); PG8_WAIT_L(0); PG8_BAR; PG8_MMA(0, 0, At, B0); PG8_MMA(0, 1, At, B1); PG8_BAR; PG8_SCHED;
            PG8_LDA(At, 0, 1); PG8_STAGE_B(PG8_SB(0, 0), b2); PG8_STAGE_B(PG8_SB(0, 1), b2 + hstep); PG8_STAGE_A(PG8_SA(0, 0), a2, 0, 0);
            PG8_WAIT_V(8); PG8_WAIT_L(0); PG8_BAR; PG8_MMA(1, 0, At, B0); PG8_MMA(1, 1, At, B1); PG8_BAR; PG8_SCHED;
            PG8_LDB(B0, 1, 0); PG8_LDB(B1, 1, 1); PG8_SCHED; PG8_LDA(At, 1, 0); PG8_STAGE_A(PG8_SA(0, 1), a2, 1, 0);
            PG8_WAIT_V(8); PG8_WAIT_L(0); PG8_BAR; PG8_MMA(0, 0, At, B0); PG8_MMA(0, 1, At, B1); PG8_BAR; PG8_SCHED;
            PG8_LDA(At, 1, 1); PG8_STAGE_B(PG8_SB(1, 0), b3); PG8_STAGE_B(PG8_SB(1, 1), b3 + hstep); PG8_STAGE_A(PG8_SA(1, 0), a2, 0, kstep);
            PG8_WAIT_V(8); PG8_WAIT_L(0); PG8_BAR; PG8_MMA(1, 0, At, B0); PG8_MMA(1, 1, At, B1); PG8_BAR; PG8_SCHED;
        }
        if constexpr (ALIGN_EPI) { if (wr == 0) PG8_BAR; }
        E(acc, cur, wr, wc, fr, fq);
        if (!has_next) break;
#pragma unroll
        for (int a = 0; a < 2; ++a)
#pragma unroll
            for (int b = 0; b < 2; ++b)
#pragma unroll
                for (int m = 0; m < 4; ++m)
#pragma unroll
                    for (int n = 0; n < 2; ++n) acc[a][b][m][n] = (f32x4){0.f, 0.f, 0.f, 0.f};
        cur = nxt; cB = nB; ++ui;
#pragma unroll
        for (int h = 0; h < 2; ++h)
#pragma unroll
            for (int i = 0; i < 2; ++i) cvA[h][i] = nvA[h][i];
        if constexpr (ALIGN_EPI) { if (wr == 1) PG8_BAR; }
    }
    PG8_WAIT_V(0);
    if constexpr (!ALIGN_EPI) { if (wr == 0) PG8_BAR; }
    PG8_BAR;
#undef PG8_SA
#undef PG8_SB
#undef PG8_STAGE_A
#undef PG8_STAGE_B
#undef PG8_LDA
#undef PG8_LDB
#undef PG8_MMA
#undef PG8_WAIT_V
#undef PG8_WAIT_L
#undef PG8_BAR
#undef PG8_SCHED
}

typedef f32x4 Acc[2][2][4][2];
__device__ __forceinline__ u32x4 pack8(const f32x4 a, const f32x4 b) { u32x4 w; w.x = cvt_pk_bf16(a[0], a[1]); w.y = cvt_pk_bf16(a[2], a[3]); w.z = cvt_pk_bf16(b[0], b[1]); w.w = cvt_pk_bf16(b[2], b[3]); return w; }

struct EpiPlain {
    static constexpr bool PERM = true, HAS_MID = false; static constexpr int MID_T = 0;
    bf16_t* O; int ldc; int use_aux;
    __device__ __forceinline__ void mid(Acc&, const Unit&, int, int, int, int) const {}
    __device__ __forceinline__ void operator()(const Acc& acc, const Unit& u, int wr, int wc, int fr, int fq) const {
        const int row0 = (use_aux ? u.aux : u.pm * BM) + wr * 64 + fr, col0 = u.pn * BM + wc * 32 + 8 * fq;
#pragma unroll
        for (int ai = 0; ai < 2; ++ai)
#pragma unroll
            for (int m = 0; m < 4; ++m) { bf16_t* rowp = O + (size_t)(row0 + ai * HALF + m * 16) * ldc + col0;
#pragma unroll
                for (int bj = 0; bj < 2; ++bj) *(u32x4*)(rowp + bj * HALF) = pack8(acc[ai][bj][m][0], acc[ai][bj][m][1]); }
    }
};

struct EpiIn {
    static constexpr bool PERM = true, HAS_MID = false; static constexpr int MID_T = 0;
    const float* xpart; const float* qn; const float* kn;
    bf16_t *qb, *kb, *vb, *ub, *vsb, *gab; float* vspart;
    __device__ __forceinline__ void mid(Acc&, const Unit&, int, int, int, int) const {}
    __device__ __forceinline__ void operator()(const Acc& acc, const Unit& u, int wr, int wc, int fr, int fq) const {
        const int pn = u.pn;
#pragma unroll
        for (int ai = 0; ai < 2; ++ai)
#pragma unroll
            for (int m = 0; m < 4; ++m) {
                const int row = u.pm * BM + ai * HALF + wr * 64 + m * 16 + fr;
                const f32x4* xp = (const f32x4*)(xpart + (size_t)row * 16);
                const f32x4 s0 = xp[0], s1 = xp[1], s2 = xp[2], s3 = xp[3];
                const float ssx = ((s0[0] + s0[1]) + (s0[2] + s0[3])) + ((s1[0] + s1[1]) + (s1[2] + s1[3])) + ((s2[0] + s2[1]) + (s2[2] + s2[3])) + ((s3[0] + s3[1]) + (s3[2] + s3[3]));
                const float rs = fast_rsq(ssx * (1.f / D) + EPS);
                f32x4 v[2][2];
#pragma unroll
                for (int bj = 0; bj < 2; ++bj)
#pragma unroll
                    for (int n = 0; n < 2; ++n) v[bj][n] = acc[ai][bj][m][n] * rs;
                if (pn < 4) {
                    float ss = 0.f;
#pragma unroll
                    for (int bj = 0; bj < 2; ++bj)
#pragma unroll
                        for (int n = 0; n < 2; ++n) ss += (v[bj][n][0] * v[bj][n][0] + v[bj][n][1] * v[bj][n][1]) + (v[bj][n][2] * v[bj][n][2] + v[bj][n][3] * v[bj][n][3]);
                    ss += __shfl_xor(ss, 16); ss += __shfl_xor(ss, 32);
                    const bool isq = pn < 2;
                    const float sc = fast_rsq(ss * (1.f / 64.f) + EPS) * (isq ? 0.125f * LOG2E : 1.f);
                    const float* gn = isq ? qn : kn; bf16_t* O = isq ? qb : kb;
                    const int head = 4 * (pn & 1) + wc;
#pragma unroll
                    for (int bj = 0; bj < 2; ++bj) {
                        const f32x4 g0 = *(const f32x4*)(gn + 32 * bj + 8 * fq), g1 = *(const f32x4*)(gn + 32 * bj + 8 * fq + 4);
                        *(u32x4*)(O + (size_t)row * 512 + head * 64 + 32 * bj + 8 * fq) = pack8(v[bj][0] * sc * g0, v[bj][1] * sc * g1);
                    }
                } else {
                    const int colw = wc * 32 + 8 * fq;
                    if (pn < 6) {
#pragma unroll
                        for (int bj = 0; bj < 2; ++bj) *(u32x4*)(vb + (size_t)row * 512 + (pn - 4) * BM + bj * HALF + colw) = pack8(v[bj][0], v[bj][1]);
                    } else if (pn < 10) {
                        float ss = 0.f;
#pragma unroll
                        for (int bj = 0; bj < 2; ++bj)
#pragma unroll
                            for (int n = 0; n < 2; ++n)
#pragma unroll
                                for (int i = 0; i < 4; ++i) { const float gv = gelu_tanh_f(v[bj][n][i]); v[bj][n][i] = gv; ss += gv * gv; }
                        if (pn < 8) {
#pragma unroll
                            for (int bj = 0; bj < 2; ++bj) *(u32x4*)(ub + (size_t)row * 512 + (pn - 6) * BM + bj * HALF + colw) = pack8(v[bj][0], v[bj][1]);
                        } else {
#pragma unroll
                            for (int bj = 0; bj < 2; ++bj) *(u32x4*)(vsb + (size_t)row * 512 + (pn - 8) * BM + bj * HALF + colw) = pack8(v[bj][0], v[bj][1]);
                            ss += __shfl_xor(ss, 16); ss += __shfl_xor(ss, 32);
                            if (fq == 0) vspart[(size_t)row * 8 + (pn - 8) * 4 + wc] = ss;
                        }
                    } else {
#pragma unroll
                        for (int bj = 0; bj < 2; ++bj) {
#pragma unroll
                            for (int n = 0; n < 2; ++n)
#pragma unroll
                                for (int i = 0; i < 4; ++i) v[bj][n][i] = fmaxf(sigmoid_f(v[bj][n][i]), 1e-13f);
                            *(u32x4*)(gab + (size_t)row * 2048 + (pn - 10) * BM + bj * HALF + colw) = pack8(v[bj][0], v[bj][1]);
                        }
                    }
                }
            }
    }
};

struct EpiUp {
    static constexpr bool PERM = true, HAS_MID = true; static constexpr int MID_T = 8;
    const bf16_t* gab; bf16_t* mg;
    __device__ __forceinline__ void mid(Acc& acc, const Unit& u, int wr, int wc, int fr, int fq) const {
        int row0 = u.pm * BM + wr * 64 + fr; const int col0 = u.pn * BM + wc * 32 + 8 * fq; asm volatile("" : "+v"(row0));
#pragma unroll
        for (int am = 0; am < 4; ++am) {
            const int ai = am >> 1, mb = (am & 1) * 2;
            u32x4 ga[2][2], gb[2][2];
#pragma unroll
            for (int mm = 0; mm < 2; ++mm) { const bf16_t* gp = gab + (size_t)(row0 + ai * HALF + (mb + mm) * 16) * 2048 + col0;
#pragma unroll
                for (int bj = 0; bj < 2; ++bj) { ga[mm][bj] = *(const u32x4*)(gp + bj * HALF); gb[mm][bj] = *(const u32x4*)(gp + 1024 + bj * HALF); } }
#pragma unroll
            for (int mm = 0; mm < 2; ++mm)
#pragma unroll
                for (int bj = 0; bj < 2; ++bj)
#pragma unroll
                    for (int j = 0; j < 4; ++j) { const float r0 = bf_lo(ga[mm][bj][j]) * fast_rcp(bf_lo(gb[mm][bj][j])), r1 = bf_hi(ga[mm][bj][j]) * fast_rcp(bf_hi(gb[mm][bj][j]));
                        acc[ai][bj][mb + mm][j >> 1][(j & 1) * 2] *= r0; acc[ai][bj][mb + mm][j >> 1][(j & 1) * 2 + 1] *= r1; }
            asm volatile("" ::: "memory");
        }
    }
    __device__ __forceinline__ void operator()(const Acc& acc, const Unit& u, int wr, int wc, int fr, int fq) const {
        int row0 = u.pm * BM + wr * 64 + fr; const int col0 = u.pn * BM + wc * 32 + 8 * fq; asm volatile("" : "+v"(row0));
#pragma unroll
        for (int ai = 0; ai < 2; ++ai) {
            u32x4 gb[4][2];
#pragma unroll
            for (int m = 0; m < 4; ++m)
#pragma unroll
                for (int bj = 0; bj < 2; ++bj) gb[m][bj] = *(const u32x4*)(gab + (size_t)(row0 + ai * HALF + m * 16) * 2048 + 1024 + col0 + bj * HALF);
#pragma unroll
            for (int m = 0; m < 4; ++m) { const size_t ro = (size_t)(row0 + ai * HALF + m * 16);
#pragma unroll
                for (int bj = 0; bj < 2; ++bj) { const u32x4 b = gb[m][bj];
                    f32x4 o0, o1;
                    o0[0] = acc[ai][bj][m][0][0] * bf_lo(b[0]); o0[1] = acc[ai][bj][m][0][1] * bf_hi(b[0]); o0[2] = acc[ai][bj][m][0][2] * bf_lo(b[1]); o0[3] = acc[ai][bj][m][0][3] * bf_hi(b[1]);
                    o1[0] = acc[ai][bj][m][1][0] * bf_lo(b[2]); o1[1] = acc[ai][bj][m][1][1] * bf_hi(b[2]); o1[2] = acc[ai][bj][m][1][2] * bf_lo(b[3]); o1[3] = acc[ai][bj][m][1][3] * bf_hi(b[3]);
                    *(u32x4*)(mg + ro * 1024 + col0 + bj * HALF) = pack8(o0, o1); } }
            asm volatile("" ::: "memory");
        }
    }
};

struct EpiOut {
    static constexpr bool PERM = false, HAS_MID = false; static constexpr int MID_T = 0;
    const float* xin; float* xout; bf16_t* xb;
    __device__ __forceinline__ void mid(Acc&, const Unit&, int, int, int, int) const {}
    __device__ __forceinline__ void operator()(const Acc& acc, const Unit& u, int wr, int wc, int fr, int fq) const {
        const int row0 = u.pm * BM + wr * 64 + fr, col0 = u.pn * BM + wc * 32 + 4 * fq;
#pragma unroll
        for (int ai = 0; ai < 2; ++ai)
#pragma unroll
            for (int m = 0; m < 4; ++m) { const size_t off = (size_t)(row0 + ai * HALF + m * 16) * D + col0;
#pragma unroll
                for (int bj = 0; bj < 2; ++bj)
#pragma unroll
                    for (int n = 0; n < 2; ++n) { const size_t o = off + bj * HALF + n * 16; const f32x4 xn = *(const f32x4*)(xin + o) + acc[ai][bj][m][n];
                        *(f32x4*)(xout + o) = xn; u32x2 w; w.x = cvt_pk_bf16(xn[0], xn[1]); w.y = cvt_pk_bf16(xn[2], xn[3]); *(u32x2*)(xb + o) = w; } }
    }
};

struct EpiG1 {
    static constexpr bool PERM = true, HAS_MID = false; static constexpr int MID_T = 0;
    const int* tokl; const int* cnt; const float* rs2; bf16_t* Gb;
    __device__ __forceinline__ void mid(Acc&, const Unit&, int, int, int, int) const {}
    __device__ __forceinline__ void operator()(const Acc& acc, const Unit& u, int wr, int wc, int fr, int fq) const {
        const int ce = cnt[u.e * CNT_STRIDE];
#pragma unroll
        for (int ai = 0; ai < 2; ++ai)
#pragma unroll
            for (int m = 0; m < 4; ++m) {
                const int rl = ai * HALF + wr * 64 + m * 16 + fr, r = u.pm * BM + rl;
                const int tok = (r < ce) ? tokl[u.e * ECAP + r] : 0;
                const float rs = rs2[tok];
                f32x4 o[2];
#pragma unroll
                for (int n = 0; n < 2; ++n)
#pragma unroll
                    for (int i = 0; i < 4; ++i) { const float g = acc[ai][0][m][n][i] * rs, up = acc[ai][1][m][n][i] * rs; o[n][i] = g * sigmoid_f(g) * up; }
                *(u32x4*)(Gb + (size_t)(u.aux + rl) * 512 + u.pn * HALF + wc * 32 + 8 * fq) = pack8(o[0], o[1]);
            }
    }
};

struct EpiPle {
    static constexpr bool PERM = false, HAS_MID = false; static constexpr int MID_T = 0;
    float* x; bf16_t* xb; const bf16_t* Eb; const float* rs3; float* xpart;
    __device__ __forceinline__ void mid(Acc&, const Unit&, int, int, int, int) const {}
    __device__ __forceinline__ void operator()(const Acc& acc, const Unit& u, int wr, int wc, int fr, int fq) const {
        const int row0 = u.pm * BM + wr * 64 + fr, col0 = u.pn * BM + wc * 32 + 4 * fq;
#pragma unroll
        for (int ai = 0; ai < 2; ++ai)
#pragma unroll
            for (int m = 0; m < 4; ++m) { const int row = row0 + ai * HALF + m * 16; const size_t off = (size_t)row * D + col0; const float rs = rs3[row]; float ss = 0.f;
#pragma unroll
                for (int bj = 0; bj < 2; ++bj)
#pragma unroll
                    for (int n = 0; n < 2; ++n) { const size_t o = off + bj * HALF + n * 16; const u32x2 ev = *(const u32x2*)(Eb + o); const f32x4 xo = *(const f32x4*)(x + o); f32x4 xn;
                        xn[0] = xo[0] + sigmoid_f(acc[ai][bj][m][n][0] * rs) * bf_lo(ev.x); xn[1] = xo[1] + sigmoid_f(acc[ai][bj][m][n][1] * rs) * bf_hi(ev.x);
                        xn[2] = xo[2] + sigmoid_f(acc[ai][bj][m][n][2] * rs) * bf_lo(ev.y); xn[3] = xo[3] + sigmoid_f(acc[ai][bj][m][n][3] * rs) * bf_hi(ev.y);
                        ss += (xn[0] * xn[0] + xn[1] * xn[1]) + (xn[2] * xn[2] + xn[3] * xn[3]);
                        *(f32x4*)(x + o) = xn; u32x2 w; w.x = cvt_pk_bf16(xn[0], xn[1]); w.y = cvt_pk_bf16(xn[2], xn[3]); *(u32x2*)(xb + o) = w; }
                ss += __shfl_xor(ss, 16); ss += __shfl_xor(ss, 32);
                if (fq == 0) xpart[(size_t)row * 16 + u.pn * 4 + wc] = ss; }
    }
};
__device__ __forceinline__ int crow(int r, int hi) { return (r & 3) + 8 * (r >> 2) + 4 * hi; }
__device__ __forceinline__ unsigned cvtpk_s(float lo, float hi) { typedef __bf16 bf16x2_t __attribute__((ext_vector_type(2))); f32x2 v = {lo, hi}; bf16x2_t b = __builtin_convertvector(v, bf16x2_t); return __builtin_bit_cast(unsigned, b); }
#define FK_SBAR() __builtin_amdgcn_sched_barrier(0)
__device__ __forceinline__ void pv(f32x16* o, int vb, bf16x8 pa0, bf16x8 pa1, bf16x8 pa2, bf16x8 pa3) {
#pragma unroll
    for (int d0 = 0; d0 < 2; ++d0) { s16x4 lo[4], hi[4];
#pragma unroll
        for (int ks = 0; ks < 4; ++ks) {
            asm volatile("ds_read_b64_tr_b16 %0,%1 offset:%c2" : "=&v"(lo[ks]) : "v"(vb), "i"(d0 * 4096 + ks * 1024) : "memory");
            asm volatile("ds_read_b64_tr_b16 %0,%1 offset:%c2" : "=&v"(hi[ks]) : "v"(vb), "i"(d0 * 4096 + ks * 1024 + 512) : "memory"); }
        asm volatile("s_waitcnt lgkmcnt(0)" ::: "memory"); FK_SBAR();
#define FK_PK(k) (bf16x8){lo[k][0], lo[k][1], lo[k][2], lo[k][3], hi[k][0], hi[k][1], hi[k][2], hi[k][3]}
        o[d0] = __builtin_amdgcn_mfma_f32_32x32x16_bf16(pa0, FK_PK(0), o[d0], 0, 0, 0);
        o[d0] = __builtin_amdgcn_mfma_f32_32x32x16_bf16(pa1, FK_PK(1), o[d0], 0, 0, 0);
        o[d0] = __builtin_amdgcn_mfma_f32_32x32x16_bf16(pa2, FK_PK(2), o[d0], 0, 0, 0);
        o[d0] = __builtin_amdgcn_mfma_f32_32x32x16_bf16(pa3, FK_PK(3), o[d0], 0, 0, 0);
#undef FK_PK
    }
}
constexpr int WLDS_BYTES = 12288;

__device__ __forceinline__ void attn_wave_unit(int b, int h, int qblk, const bf16_t* __restrict__ qb, const bf16_t* __restrict__ kb, const bf16_t* __restrict__ vb, bf16_t* __restrict__ oc, LAS unsigned char* wl, int lane) {
    const int r32 = lane & 31, hi = lane >> 5;
    const long rowbase = (long)b * SEQ; const int q0 = qblk * 32, tq = q0 + r32;
    bf16x8 qr[4];
    { const bf16_t* qp = qb + (size_t)(rowbase + q0 + r32) * 512 + h * 64 + hi * 8;
#pragma unroll
      for (int d0 = 0; d0 < 4; ++d0) qr[d0] = *(const bf16x8*)(qp + d0 * 16); }
    f32x16 o[2]; o[0] = f32x16{}; o[1] = f32x16{};
    float R = 0.f;
    const int vbase = (int)(unsigned)(uintptr_t)wl + ((lane >> 4) & 1) * 32 + (lane & 3) * 8 + (4 * hi + ((lane & 15) >> 2)) * 64;
    const int jd = q0 >> 6;
    for (int jt = jd; jt >= 0; --jt) {
        const int s0 = jt * 64;
        const bf16_t* kp = kb + (size_t)(rowbase + s0 + r32) * 512 + h * 64 + hi * 8;
        bf16x8 k0[4], k1[4];
#pragma unroll
        for (int d0 = 0; d0 < 4; ++d0) { k0[d0] = *(const bf16x8*)(kp + d0 * 16); k1[d0] = *(const bf16x8*)(kp + 32 * 512 + d0 * 16); }
        u32x4 vt[8];
#pragma unroll
        for (int w8 = 0; w8 < 8; ++w8) vt[w8] = *(const u32x4*)(vb + (size_t)(rowbase + s0 + 16 * (w8 & 3) + (lane >> 2)) * 512 + h * 64 + 32 * (w8 >> 2) + 8 * (lane & 3));
        f32x16 p0 = f32x16{}, p1 = f32x16{};
#pragma unroll
        for (int d0 = 0; d0 < 4; ++d0) { p0 = __builtin_amdgcn_mfma_f32_32x32x16_bf16(k0[d0], qr[d0], p0, 0, 0, 0); p1 = __builtin_amdgcn_mfma_f32_32x32x16_bf16(k1[d0], qr[d0], p1, 0, 0, 0); }
#pragma unroll
        for (int w8 = 0; w8 < 8; ++w8) *(LAS u32x4*)(wl + w8 * 1024 + lane * 16) = vt[w8];
        const bool diag = (jt == jd);
        float lb[32], lk[32];
#pragma unroll
        for (int r = 0; r < 32; ++r) {
            const float z = r < 16 ? p0[r] : p1[r - 16];
            const float e = fast_exp2(-fabsf(z)), l = fast_log2(1.f + e);
            float b_ = fminf(z, 0.f) - l, k_ = b_ - z;
            if (diag) { const int kv = s0 + crow(r & 15, hi) + (r >> 4) * 32; if (!(kv < tq)) { k_ = 0.f; b_ = -INFINITY; } }
            lb[r] = b_; lk[r] = k_;
        }
        float gs[8], pg[8], T[8], SP[8];
#pragma unroll
        for (int g = 0; g < 8; ++g) { gs[g] = (lk[4 * g] + lk[4 * g + 1]) + (lk[4 * g + 2] + lk[4 * g + 3]); pg[g] = __shfl_xor(gs[g], 32); T[g] = gs[g] + pg[g]; }
        SP[7] = 0.f;
#pragma unroll
        for (int g = 6; g >= 0; --g) SP[g] = SP[g + 1] + T[g + 1];
        float a[32];
#pragma unroll
        for (int g = 0; g < 8; ++g) {
            const float base = R + SP[g] + (hi == 0 ? pg[g] : 0.f);
            const float a3 = base, a2 = a3 + lk[4 * g + 3], a1 = a2 + lk[4 * g + 2], a0 = a1 + lk[4 * g + 1];
            a[4 * g + 3] = fast_exp2(lb[4 * g + 3] + a3); a[4 * g + 2] = fast_exp2(lb[4 * g + 2] + a2);
            a[4 * g + 1] = fast_exp2(lb[4 * g + 1] + a1); a[4 * g] = fast_exp2(lb[4 * g] + a0);
        }
        R += SP[0] + T[0];
        u32x4 pw0, pw1, pw2, pw3;
        pw0 = (u32x4){cvtpk_s(a[0], a[1]), cvtpk_s(a[2], a[3]), cvtpk_s(a[4], a[5]), cvtpk_s(a[6], a[7])};
        pw1 = (u32x4){cvtpk_s(a[8], a[9]), cvtpk_s(a[10], a[11]), cvtpk_s(a[12], a[13]), cvtpk_s(a[14], a[15])};
        pw2 = (u32x4){cvtpk_s(a[16], a[17]), cvtpk_s(a[18], a[19]), cvtpk_s(a[20], a[21]), cvtpk_s(a[22], a[23])};
        pw3 = (u32x4){cvtpk_s(a[24], a[25]), cvtpk_s(a[26], a[27]), cvtpk_s(a[28], a[29]), cvtpk_s(a[30], a[31])};
        asm volatile("s_waitcnt lgkmcnt(0)" ::: "memory");
        pv(o, vbase, __builtin_bit_cast(bf16x8, pw0), __builtin_bit_cast(bf16x8, pw1), __builtin_bit_cast(bf16x8, pw2), __builtin_bit_cast(bf16x8, pw3));
        if (__all(R < -159.f)) break;
    }
    LAS bf16_t* stg = (LAS bf16_t*)(wl + 8192);
#pragma unroll
    for (int r = 0; r < 16; ++r) { const int orow = crow(r, hi);
#pragma unroll
        for (int d0 = 0; d0 < 2; ++d0) stg[orow * 64 + d0 * 32 + r32] = (bf16_t)(cvtpk_s(o[d0][r], 0.f) & 0xffffu); }
    asm volatile("s_waitcnt lgkmcnt(0)" ::: "memory");
    bf16_t* Ow = oc + (size_t)(rowbase + q0) * 1024 + h * 64;
#pragma unroll
    for (int i = 0; i < 4; ++i) { const int row = i * 8 + (lane >> 3), ch = lane & 7; const u32x4 v = *(const LAS u32x4*)(stg + row * 64 + ch * 8); *(u32x4*)(Ow + (size_t)row * 1024 + ch * 8) = v; }
    asm volatile("s_waitcnt lgkmcnt(0)" ::: "memory");
}

template <int HF>
__device__ __forceinline__ void sgu_wave_unit(int chunk, int g, const bf16_t* __restrict__ ub, const bf16_t* __restrict__ vsb, const float* __restrict__ vspart, const bf16_t* __restrict__ wsp  ,
                                              const float* __restrict__ bsp  , const float* __restrict__ sgn  , bf16_t* __restrict__ oc, LAS unsigned char* wl, int lane) {
    const int r32 = lane & 31, hi = lane >> 5;
    const size_t row0 = (size_t)chunk * 128;
    const int vbase = (int)(unsigned)(uintptr_t)wl + ((lane >> 4) & 1) * 32 + (lane & 3) * 8 + (4 * hi + ((lane & 15) >> 2)) * 64;
    f32x16 o[2][2];
#pragma unroll
    for (int rl = 0; rl < 2; ++rl) { o[rl][0] = f32x16{}; o[rl][1] = f32x16{}; }
#pragma unroll
    for (int kt = 0; kt <= HF; ++kt) {
#pragma unroll 2
        for (int w8 = 0; w8 < 8; ++w8) {
            const size_t row = row0 + 64 * kt + 16 * (w8 & 3) + (lane >> 2);
            const f32x4 s0 = *(const f32x4*)(vspart + row * 8), s1 = *(const f32x4*)(vspart + row * 8 + 4);
            const float rv = fast_rsq((((s0[0] + s0[1]) + (s0[2] + s0[3])) + ((s1[0] + s1[1]) + (s1[2] + s1[3]))) * (1.f / 512.f) + EPS);
            const u32x4 v = *(const u32x4*)(vsb + row * 512 + g * 64 + 32 * (w8 >> 2) + 8 * (lane & 3));
            u32x4 w;
#pragma unroll
            for (int j = 0; j < 4; ++j) w[j] = cvtpk_s(bf_lo(v[j]) * rv, bf_hi(v[j]) * rv);
            *(LAS u32x4*)(wl + w8 * 1024 + lane * 16) = w;
        }
        asm volatile("s_waitcnt lgkmcnt(0)" ::: "memory");
#pragma unroll
        for (int rl = 0; rl < 2; ++rl) {
            const int rb = 2 * HF + rl;
            const bf16_t* wp = wsp + ((size_t)g * 128 + 32 * rb + r32) * 128 + 64 * kt + 4 * hi;
            u32x4 pw[4];
#pragma unroll
            for (int ks = 0; ks < 4; ++ks) { const u32x2 lo = *(const u32x2*)(wp + 16 * ks), h8 = *(const u32x2*)(wp + 16 * ks + 8); pw[ks] = (u32x4){lo.x, lo.y, h8.x, h8.y}; }
            pv(o[rl], vbase, __builtin_bit_cast(bf16x8, pw[0]), __builtin_bit_cast(bf16x8, pw[1]), __builtin_bit_cast(bf16x8, pw[2]), __builtin_bit_cast(bf16x8, pw[3]));
        }
        asm volatile("s_waitcnt lgkmcnt(0)" ::: "memory");
    }
    LAS bf16_t* stg = (LAS bf16_t*)(wl + 8192);
    const float gn0 = sgn[g * 64 + r32], gn1 = sgn[g * 64 + 32 + r32];
#pragma unroll
    for (int rl = 0; rl < 2; ++rl) {
        const int rb = 2 * HF + rl;
#pragma unroll
        for (int r = 0; r < 16; ++r) { const int orow = crow(r, hi); const float bb = bsp[g * 128 + 32 * rb + orow];
            stg[orow * 64 + r32] = (bf16_t)(cvtpk_s(gn0 * o[rl][0][r] + bb, 0.f) & 0xffffu); stg[orow * 64 + 32 + r32] = (bf16_t)(cvtpk_s(gn1 * o[rl][1][r] + bb, 0.f) & 0xffffu); }
        asm volatile("s_waitcnt lgkmcnt(0)" ::: "memory");
#pragma unroll
        for (int i = 0; i < 4; ++i) { const int row = i * 8 + (lane >> 3), ch = lane & 7; const size_t grow = row0 + 32 * rb + row;
            const u32x4 mv = *(const LAS u32x4*)(stg + row * 64 + ch * 8); const u32x4 uv = *(const u32x4*)(ub + grow * 512 + g * 64 + ch * 8); u32x4 w;
#pragma unroll
            for (int j = 0; j < 4; ++j) w[j] = cvtpk_s(bf_lo(mv[j]) * bf_lo(uv[j]), bf_hi(mv[j]) * bf_hi(uv[j]));
            *(u32x4*)(oc + grow * 1024 + 512 + g * 64 + ch * 8) = w; }
        asm volatile("s_waitcnt lgkmcnt(0)" ::: "memory");
    }
}
constexpr size_t MiB = 1u << 20;
constexpr size_t WS_CTL = 0, CTL_ZERO_BYTES = 1 * MiB;
constexpr size_t WS_W = 16 * MiB, WL_STRIDE = 112 * MiB;
constexpr size_t WO_IN = 0, WO_UP = 9 * MiB, WO_OUT = 11 * MiB, WO_PG = 13 * MiB, WO_PP = 15 * MiB, WO_SP = 15 * MiB + 512 * 1024, WO_R = 15 * MiB + 768 * 1024, WO_EI = 16 * MiB, WO_EO = 80 * MiB;
constexpr size_t WS_PB = 464 * MiB, WS_E = 496 * MiB, WS_XB = 624 * MiB, WS_Q = 656 * MiB, WS_K = 672 * MiB, WS_V = 688 * MiB, WS_U = 704 * MiB, WS_VS = 720 * MiB, WS_GAB = 736 * MiB,
                 WS_OC = 800 * MiB, WS_MG = 832 * MiB, WS_G = 864 * MiB, WS_YS = 904 * MiB, WS_XPART = 984 * MiB, WS_VSPART = 985 * MiB, WS_RS2 = 985 * MiB + 512 * 1024, WS_RS3 = 985 * MiB + 640 * 1024,
                 WS_TOKL = 986 * MiB, WS_TKE = 988 * MiB, WS_TKP = 988 * MiB + 256 * 1024, WS_TKW = 988 * MiB + 512 * 1024, WS_FAST_END = 990 * MiB;
constexpr int GSLOTS = 2 * M + NE * 256;
constexpr int CW_TMO = 0, CW_CODE = 1, CW_BAR = 4096, CW_CNT = 8192  ;

constexpr int RING_OFF = 0, RING_BYTES = 131072, LDSCTL_OFF = 139264  , MISC_OFF = LDSCTL_OFF + 320, PREF_OFF = MISC_OFF + 128  , LDS_BYTES = 147456;

#define RLX_AGENT __ATOMIC_RELAXED, __HIP_MEMORY_SCOPE_AGENT
#define XB_TMO      128
#define XB_XCNT(j)  (256  + 64 * (j))
#define XB_XSUB(j)  (1280 + 64 * (j))
#define XB_XGEN(j)  (2304 + 64 * (j))
#define XB_TOP      3328
#define XB_TOPGEN   3392
#define XCD_BAR_WORDS 3456
#define XB_SPIN_CAP (1u << 18)
__device__ __forceinline__ unsigned xb_ld(unsigned* p)              { return __hip_atomic_load(p, __ATOMIC_RELAXED, __HIP_MEMORY_SCOPE_AGENT); }
__device__ __forceinline__ unsigned xb_add(unsigned* p, unsigned v) { return __hip_atomic_fetch_add(p, v, __ATOMIC_RELAXED, __HIP_MEMORY_SCOPE_AGENT); }
__device__ __forceinline__ unsigned xb_xcc_id() { return (unsigned)__builtin_amdgcn_s_getreg((3 << 11) | 20) & 0xFu; }
#define XB_SPIN(cond, bar) do { unsigned _sp = 0; while (cond) { __builtin_amdgcn_s_sleep(1); \
    if ((++_sp & 255u) == 0u) { if (xb_ld(&(bar)[XB_TMO])) break; if (_sp > XB_SPIN_CAP) { atomicAdd(&(bar)[XB_TMO], 1u); break; } } } } while (0)
struct XcdBarrier { unsigned* bar; unsigned x; volatile LAS unsigned* st; };
__device__ __forceinline__ XcdBarrier xcd_barrier_post(unsigned* bar, volatile LAS unsigned* st) {
    XcdBarrier b; b.bar = bar; b.x = xb_xcc_id(); b.st = st;
    if (threadIdx.x == 0) (void)xb_add(&bar[XB_XCNT(b.x)], 1u);
    return b;
}
__device__ __forceinline__ void xcd_barrier_complete(unsigned* bar, unsigned x, unsigned& nloc, unsigned& nx) {
    const unsigned G = gridDim.x * gridDim.y * gridDim.z;
    unsigned sum, cnt, mine, sp = 0u;
    for (;;) {
        sum = 0u; cnt = 0u; mine = 0u;
#pragma unroll
        for (unsigned j = 0; j < 16; ++j) { const unsigned c = xb_ld(&bar[XB_XCNT(j)]); sum += c; cnt += (c > 0u) ? 1u : 0u; mine = (j == x) ? c : mine; }
        if (sum == G) break;
        __builtin_amdgcn_s_sleep(1);
        if ((++sp & 255u) == 0u) { if (xb_ld(&bar[XB_TMO])) break; if (sp > XB_SPIN_CAP) { atomicAdd(&bar[XB_TMO], 1u); break; } }
    }
    nloc = mine > 0u ? mine : 1u; nx = cnt > 0u ? cnt : 1u;
}
__device__ __forceinline__ void xcd_barrier(const XcdBarrier& b) {
    asm volatile("s_waitcnt vmcnt(0)" ::: "memory");
    __syncthreads();
    if (threadIdx.x == 0) {
        unsigned* bar = b.bar;
        __builtin_amdgcn_s_waitcnt(0);
        unsigned nloc = b.st[0], nx = b.st[1];
        if (nloc == 0u) { xcd_barrier_complete(bar, b.x, nloc, nx); b.st[0] = nloc; b.st[1] = nx; }
        const unsigned old = xb_add(&bar[XB_XSUB(b.x)], 1u);
        const unsigned gen = old / nloc;
        if (old + 1u == (gen + 1u) * nloc) {
            __builtin_amdgcn_fence(__ATOMIC_RELEASE, "agent");
            asm volatile("s_waitcnt vmcnt(0)" ::: "memory");
            const unsigned og = xb_add(&bar[XB_TOP], 1u);
            const unsigned tg = og / nx;
            if (og + 1u == (tg + 1u) * nx) xb_add(&bar[XB_TOPGEN], 1u);
            else XB_SPIN(xb_ld(&bar[XB_TOPGEN]) == tg, bar);
            __builtin_amdgcn_fence(__ATOMIC_ACQUIRE, "agent");
            xb_add(&bar[XB_XGEN(b.x)], 1u);
            asm volatile("s_waitcnt vmcnt(0)" ::: "memory");
        } else {
            XB_SPIN(xb_ld(&bar[XB_XGEN(b.x)]) == gen, bar);
            __builtin_amdgcn_fence(__ATOMIC_ACQUIRE, "agent");
            asm volatile("s_waitcnt vmcnt(0)" ::: "memory");
        }
    }
    __syncthreads();
}

struct Args {
    const float* in[22]; float* out; unsigned char* ws;
    int ph_lo, ph_hi, nlayers, pad;
};
__device__ __forceinline__ float wave_sum(float v) {
#pragma unroll
    for (int o = 1; o < 64; o <<= 1) v += __shfl_xor(v, o);
    return v;
}
__device__ __forceinline__ unsigned f2bf(float f) { unsigned u = __builtin_bit_cast(unsigned, f); return (u + 0x7fffu + ((u >> 16) & 1u)) >> 16; }
__device__ __forceinline__ unsigned pk2(float lo, float hi) { return f2bf(lo) | (f2bf(hi) << 16); }

__device__ __forceinline__ int rowmap(int kind, int n) {
    if (kind == 1) { if (n >= 1024) return n; const int nl = n & 255; return (n - nl) + 128 * ((nl & 63) >> 5) + 32 * (nl >> 6) + (nl & 31); }
    if (kind == 2) { return n < 512 ? 256 * (n >> 7) + (n & 127) : 256 * ((n - 512) >> 7) + 128 + ((n - 512) & 127); }
    return n;
}
__device__ __forceinline__ void transpose_item(const float* __restrict__ W, int N, const float* __restrict__ gain, bf16_t* __restrict__ WT, int ldt, int koff, int kind, LAS float* scr, int item, int lane) {
    const int nblk = N / 64, kb = item / nblk, nb = item % nblk, k0 = 64 * kb, n0 = 64 * nb;
    const int kr = lane >> 4, nc = 4 * (lane & 15);
    f32x4 v[16];
#pragma unroll
    for (int i = 0; i < 16; ++i) v[i] = *(const f32x4*)(W + (size_t)(k0 + 4 * i + kr) * N + n0 + nc);
#pragma unroll
    for (int i = 0; i < 16; ++i) { const int kk = 4 * i + kr; const float gv = gain ? gain[k0 + kk] : 1.f; LAS float* d = scr + kk * 65 + nc; d[0] = v[i][0] * gv; d[1] = v[i][1] * gv; d[2] = v[i][2] * gv; d[3] = v[i][3] * gv; }
    asm volatile("s_waitcnt lgkmcnt(0)" ::: "memory");
    const int c = lane & 7;
#pragma unroll
    for (int j = 0; j < 8; ++j) { const int n = 8 * j + (lane >> 3); const LAS float* s = scr + (8 * c) * 65 + n;
        u32x4 o; o.x = pk2(s[0 * 65], s[1 * 65]); o.y = pk2(s[2 * 65], s[3 * 65]); o.z = pk2(s[4 * 65], s[5 * 65]); o.w = pk2(s[6 * 65], s[7 * 65]);
        *(u32x4*)(WT + (size_t)rowmap(kind, n0 + n) * ldt + koff + k0 + 8 * c) = o; }
    asm volatile("s_waitcnt lgkmcnt(0)" ::: "memory");
}

typedef const __attribute__((address_space(4))) Args* KArgs;
__device__ __forceinline__ KArgs fresh(KArgs k) { asm volatile("" : "+s"(k)); return k; }
__device__ __forceinline__ void p0_prologue(KArgs ap, int nlayers, LAS unsigned char* lds, int wave, int lane, int gw, int NGW) {
    LAS float* scr = (LAS float*)(lds + RING_OFF + wave * 17408);
    unsigned char* ws = ap->ws;
    constexpr int I_IN = 16 * 72, I_UP = 8 * 16, I_OUT = 16 * 16, I_PG = 16 * 16, I_PP = 4 * 16, I_EI = 16 * 16, I_EO = 8 * 16;
    constexpr int PER_LAYER = I_IN + 2 * I_UP + I_OUT + I_PG + I_PP + NE * I_EI + NE * I_EO;
    const int nitems = PER_LAYER * nlayers;
    for (int it = gw; it < nitems; it += NGW) {
        const int L = it / PER_LAYER; int r = it % PER_LAYER;
        unsigned char* wl = ws + WS_W + (size_t)L * WL_STRIDE;
        if (r < I_IN) { transpose_item(ap->in[3] + (size_t)L * D * INW, INW, ap->in[2] + (size_t)L * D, (bf16_t*)(wl + WO_IN), D, 0, 1, scr, r, lane); continue; } r -= I_IN;
        if (r < I_UP) { transpose_item(ap->in[9] + (size_t)L * 512 * D, D, nullptr, (bf16_t*)(wl + WO_UP), 1024, 0, 0, scr, r, lane); continue; } r -= I_UP;
        if (r < I_UP) { transpose_item(ap->in[10] + (size_t)L * 512 * D, D, nullptr, (bf16_t*)(wl + WO_UP), 1024, 512, 0, scr, r, lane); continue; } r -= I_UP;
        if (r < I_OUT) { transpose_item(ap->in[11] + (size_t)L * D * D, D, nullptr, (bf16_t*)(wl + WO_OUT), D, 0, 0, scr, r, lane); continue; } r -= I_OUT;
        if (r < I_PG) { transpose_item(ap->in[20] + (size_t)L * D * D, D, ap->in[19] + (size_t)L * D, (bf16_t*)(wl + WO_PG), D, 0, 0, scr, r, lane); continue; } r -= I_PG;
        if (r < I_PP) { transpose_item(ap->in[21] + (size_t)L * 256 * D, D, nullptr, (bf16_t*)(wl + WO_PP), 256, 0, 0, scr, r, lane); continue; } r -= I_PP;
        if (r < NE * I_EI) { const int e = r / I_EI; transpose_item(ap->in[17] + ((size_t)L * NE + e) * D * 1024, 1024, ap->in[12] + (size_t)L * D, (bf16_t*)(wl + WO_EI) + (size_t)e * 1024 * 1024, 1024, 0, 2, scr, r % I_EI, lane); continue; } r -= NE * I_EI;
        { const int e = r / I_EO; transpose_item(ap->in[18] + ((size_t)L * NE + e) * 512 * D, D, nullptr, (bf16_t*)(wl + WO_EO) + (size_t)e * 1024 * 512, 512, 0, 0, scr, r % I_EO, lane); }
    }
    const int gt = gw * 64 + lane, NGT = NGW * 64;
    for (int L = 0; L < nlayers; ++L) {
        unsigned char* wl = ws + WS_W + (size_t)L * WL_STRIDE;
        bf16_t* sp = (bf16_t*)(wl + WO_SP); const float* wsrc = ap->in[7] + (size_t)L * 8 * 128 * 128;
        for (int i = gt; i < 8 * 128 * 128; i += NGT) { const int s = i & 127, t = (i >> 7) & 127; sp[i] = (bf16_t)f2bf(s <= t ? wsrc[i] : 0.f); }
        bf16_t* wrh = (bf16_t*)(wl + WO_R); bf16_t* wrl = wrh + 48 * 1024; const float* gain = ap->in[12] + (size_t)L * D; const float* wg = ap->in[13] + (size_t)L * D * 4; const float* we = ap->in[15] + (size_t)L * D * 32;
        for (int i = gt; i < 48 * 1024; i += NGT) { const int o = i >> 10, k = i & 1023; const float wv = o < 36 ? gain[k] * (o < 4 ? wg[k * 4 + o] : we[k * 32 + (o - 4)]) : 0.f;
            const unsigned h = f2bf(wv); wrh[i] = (bf16_t)h; wrl[i] = (bf16_t)f2bf(wv - __uint_as_float(h << 16)); }
    }
    { const f32x4* p4 = (const f32x4*)ap->in[1]; u32x2* pb = (u32x2*)(ws + WS_PB); const size_t n4 = (size_t)nlayers * M * 256 / 4;
      for (size_t i = gt; i < n4; i += NGT) { const f32x4 v = p4[i]; u32x2 w; w.x = pk2(v[0], v[1]); w.y = pk2(v[2], v[3]); pb[i] = w; } }
    for (int m = gw; m < M; m += NGW) {
        const f32x4* xr = (const f32x4*)(ap->in[0] + (size_t)m * D) + lane; u32x2* o8 = (u32x2*)((bf16_t*)(ws + WS_XB) + (size_t)m * D) + lane; float s = 0.f;
#pragma unroll
        for (int j = 0; j < 4; ++j) { const f32x4 v = xr[64 * j]; s += (v[0] * v[0] + v[1] * v[1]) + (v[2] * v[2] + v[3] * v[3]); u32x2 w; w.x = pk2(v[0], v[1]); w.y = pk2(v[2], v[3]); o8[64 * j] = w; }
        s = wave_sum(s);
        if (lane < 16) ((float*)(ws + WS_XPART))[(size_t)m * 16 + lane] = lane == 0 ? s : 0.f;
    }
}

__device__ __forceinline__ void router_pass(const float* __restrict__ x, const bf16_t* __restrict__ wrh  , const bf16_t* __restrict__ wrl  , const float* __restrict__ bgr, const float* __restrict__ ber,
                                            float* __restrict__ rs2, int* __restrict__ cnt, int* __restrict__ tokl, int* __restrict__ tk_e, int* __restrict__ tk_pos, float* __restrict__ tk_w,
                                            LAS unsigned char* lds, int wave, int lane, int vcu, int G) {
    LAS float* lg = (LAS float*)(lds + RING_OFF + wave * 16384);
    LAS int* lcnt = (LAS int*)(lds + LDSCTL_OFF + 1024); LAS int* lbase = lcnt + 32;
    const int fr = lane & 15, fq = lane >> 4;
    for (int bt = vcu; bt < M / 64; bt += G) {
        if (threadIdx.x < 32) lcnt[threadIdx.x] = 0;
        __syncthreads();
        int e1 = 0, e2 = 0, lp1 = 0, lp2 = 0; float tw1 = 0.f, tw2 = 0.f;
        const int t0 = bt * 64 + (wave & 3) * 16;
        if (wave < 4) {
        f32x4 acc[3]; acc[0] = (f32x4){0.f, 0.f, 0.f, 0.f}; acc[1] = acc[0]; acc[2] = acc[0];
        float ss = 0.f;
        const float* xp = x + (size_t)(t0 + fr) * D + 8 * fq;
        const bf16_t* wh = wrh + (size_t)fr * 1024 + 8 * fq; const bf16_t* wl_ = wrl + (size_t)fr * 1024 + 8 * fq;
#pragma unroll 4
        for (int kk = 0; kk < 32; ++kk) {
            const f32x4 a0 = *(const f32x4*)(xp + 32 * kk), a1 = *(const f32x4*)(xp + 32 * kk + 4);
            ss += ((a0[0] * a0[0] + a0[1] * a0[1]) + (a0[2] * a0[2] + a0[3] * a0[3])) + ((a1[0] * a1[0] + a1[1] * a1[1]) + (a1[2] * a1[2] + a1[3] * a1[3]));
            u32x4 ah, al;
            ah.x = cvt_pk_bf16(a0[0], a0[1]); ah.y = cvt_pk_bf16(a0[2], a0[3]); ah.z = cvt_pk_bf16(a1[0], a1[1]); ah.w = cvt_pk_bf16(a1[2], a1[3]);
            al.x = cvt_pk_bf16(a0[0] - bf_lo(ah.x), a0[1] - bf_hi(ah.x)); al.y = cvt_pk_bf16(a0[2] - bf_lo(ah.y), a0[3] - bf_hi(ah.y));
            al.z = cvt_pk_bf16(a1[0] - bf_lo(ah.z), a1[1] - bf_hi(ah.z)); al.w = cvt_pk_bf16(a1[2] - bf_lo(ah.w), a1[3] - bf_hi(ah.w));
            const bf16x8 Ah = __builtin_bit_cast(bf16x8, ah), Al = __builtin_bit_cast(bf16x8, al);
#pragma unroll
            for (int cb = 0; cb < 3; ++cb) {
                const bf16x8 bh = *(const bf16x8*)(wh + (size_t)cb * 16 * 1024 + 32 * kk), bl = *(const bf16x8*)(wl_ + (size_t)cb * 16 * 1024 + 32 * kk);
                acc[cb] = __builtin_amdgcn_mfma_f32_16x16x32_bf16(bh, Ah, acc[cb], 0, 0, 0);
                acc[cb] = __builtin_amdgcn_mfma_f32_16x16x32_bf16(bl, Ah, acc[cb], 0, 0, 0);
                acc[cb] = __builtin_amdgcn_mfma_f32_16x16x32_bf16(bh, Al, acc[cb], 0, 0, 0);
            }
        }
        ss += __shfl_xor(ss, 16); ss += __shfl_xor(ss, 32);
        const float rsr = 1.0f / sqrtf(ss * (1.f / D) + EPS);
#pragma unroll
        for (int cb = 0; cb < 3; ++cb)
#pragma unroll
            for (int i = 0; i < 4; ++i) lg[fr * 49 + 16 * cb + 4 * fq + i] = acc[cb][i] * rsr;
        if (fq == 0) lg[fr * 49 + 48] = rsr;
        asm volatile("s_waitcnt lgkmcnt(0)" ::: "memory");
        if (lane < 16) {
            const int tok = t0 + lane; const LAS float* l = lg + lane * 49;
            rs2[tok] = l[48];
            const float g0 = l[0] + bgr[0], g1 = l[1] + bgr[1], g2 = l[2] + bgr[2], g3 = l[3] + bgr[3];
            int grp = 0; float gm = g0;
            if (g1 > gm) { gm = g1; grp = 1; } if (g2 > gm) { gm = g2; grp = 2; } if (g3 > gm) { gm = g3; grp = 3; }
            const float gsum = (expf(g0 - gm) + expf(g1 - gm)) + (expf(g2 - gm) + expf(g3 - gm));
            const float grp_w = 1.f / gsum;
            int i1 = 0, i2 = 0; float m1 = -INFINITY, m2 = -INFINITY;
#pragma unroll
            for (int i = 0; i < 8; ++i) { const float el = l[4 + grp * 8 + i] + ber[grp * 8 + i]; if (el > m1) { m2 = m1; i2 = i1; m1 = el; i1 = i; } else if (el > m2) { m2 = el; i2 = i; } }
            const float p2 = expf(m2 - m1), w1 = 1.f / (1.f + p2), w2 = p2 / (1.f + p2);
            e1 = grp * 8 + i1; e2 = grp * 8 + i2; tw1 = grp_w * w1; tw2 = grp_w * w2;
            lp1 = __hip_atomic_fetch_add(&lcnt[e1], 1, __ATOMIC_RELAXED, __HIP_MEMORY_SCOPE_WORKGROUP); lp2 = __hip_atomic_fetch_add(&lcnt[e2], 1, __ATOMIC_RELAXED, __HIP_MEMORY_SCOPE_WORKGROUP);
        }
        }
        __syncthreads();
        if (threadIdx.x < 32) { const int c = lcnt[threadIdx.x]; lbase[threadIdx.x] = c > 0 ? atomicAdd(&cnt[threadIdx.x * CNT_STRIDE], c) : 0; }
        __syncthreads();
        if (wave < 4 && lane < 16) {
            const int tok = t0 + lane; const int pos1 = lbase[e1] + lp1, pos2 = lbase[e2] + lp2;
            tokl[e1 * ECAP + pos1] = tok; tokl[e2 * ECAP + pos2] = tok;
            tk_e[tok * 2] = e1; tk_e[tok * 2 + 1] = e2; tk_pos[tok * 2] = pos1; tk_pos[tok * 2 + 1] = pos2; tk_w[tok * 2] = tw1; tk_w[tok * 2 + 1] = tw2;
        }
        __syncthreads();
    }
}

__device__ __forceinline__ void combine_pass(float* __restrict__ x, bf16_t* __restrict__ xb, const bf16_t* __restrict__ ys, const LAS int* pref, const int* __restrict__ tk_e, const int* __restrict__ tk_pos,
                                             const float* __restrict__ tk_w, float* __restrict__ rs3, int lane, int gw, int NGW) {
    for (int m = gw; m < M; m += NGW) {
        const int s0 = 256 * pref[tk_e[m * 2]] + tk_pos[m * 2], s1 = 256 * pref[tk_e[m * 2 + 1]] + tk_pos[m * 2 + 1];
        const float w0 = tk_w[m * 2], w1 = tk_w[m * 2 + 1];
        f32x4* xr = (f32x4*)(x + (size_t)m * D) + lane; u32x2* o8 = (u32x2*)(xb + (size_t)m * D) + lane;
        const u32x2* y0 = (const u32x2*)(ys + (size_t)s0 * D) + lane; const u32x2* y1 = (const u32x2*)(ys + (size_t)s1 * D) + lane; float s = 0.f;
#pragma unroll
        for (int j = 0; j < 4; ++j) { f32x4 v = xr[64 * j]; const u32x2 a0 = y0[64 * j], a1 = y1[64 * j];
            v[0] += w0 * bf_lo(a0.x) + w1 * bf_lo(a1.x); v[1] += w0 * bf_hi(a0.x) + w1 * bf_hi(a1.x); v[2] += w0 * bf_lo(a0.y) + w1 * bf_lo(a1.y); v[3] += w0 * bf_hi(a0.y) + w1 * bf_hi(a1.y);
            s += (v[0] * v[0] + v[1] * v[1]) + (v[2] * v[2] + v[3] * v[3]); xr[64 * j] = v; u32x2 w; w.x = pk2(v[0], v[1]); w.y = pk2(v[2], v[3]); o8[64 * j] = w; }
        s = wave_sum(s);
        if (lane == 0) rs3[m] = 1.0f / sqrtf(s * (1.f / D) + EPS);
    }
}

constexpr int NWAVES = 8, PH_PER_LAYER = 9;
#ifndef FK_REP
#define FK_REP 0
#endif
#define REPS(bit) ((FK_REP & (bit)) ? 2 : 1)
__global__ void __launch_bounds__(NWAVES * 64, 2) mega_fwd(Args args_unused) {
    extern __shared__ __attribute__((aligned(16))) unsigned char lds_raw[];
    LAS unsigned char* lds = (LAS unsigned char*)lds_raw;
    LAS int* pref = (LAS int*)(lds + PREF_OFF);
    const KArgs kp0 = (KArgs)__builtin_amdgcn_kernarg_segment_ptr();
    const int tid = threadIdx.x, lane0 = tid & 63, wave0 = __builtin_amdgcn_readfirstlane(tid >> 6);
    const int G = gridDim.x, bx = blockIdx.x;
    const int vcu = (G % 8 == 0) ? (bx % 8) * (G / 8) + bx / 8 : bx;
    const int gw0 = vcu * NWAVES + wave0, NGW = G * NWAVES;
#define FK_IDS int lane_o = lane0, wave_o = wave0, gw_o = gw0; asm volatile("" : "+v"(lane_o), "+s"(wave_o), "+s"(gw_o)); const int lane = lane_o, wave = wave_o, gw = gw_o; (void)lane; (void)wave; (void)gw;
    for (int u = tid; u < (LDS_BYTES - LDSCTL_OFF) / 4; u += NWAVES * 64) ((LAS unsigned*)(lds + LDSCTL_OFF))[u] = 0u;
    __syncthreads();
    const int lo = kp0->ph_lo, hi = kp0->ph_hi, nlayers = kp0->nlayers;
#define IN(k) (lo <= (k) && (k) < hi)
#define SEAM(k) do { if (IN(k) && IN((k) + 1)) { KArgs A_ = fresh(kp0); XcdBarrier bar_; bar_.bar = (unsigned*)(A_->ws + WS_CTL) + CW_BAR; bar_.x = xb_xcc_id(); bar_.st = (volatile LAS unsigned*)(lds + MISC_OFF) + 8; xcd_barrier(bar_); } } while (0)
    if (hi - lo > 1) { KArgs A = fresh(kp0); (void)xcd_barrier_post((unsigned*)(A->ws + WS_CTL) + CW_BAR, (volatile LAS unsigned*)(lds + MISC_OFF) + 8); }

    if (IN(0)) { for (int rep = 0; rep < REPS(1); ++rep) { FK_IDS; p0_prologue(fresh(kp0), nlayers, lds, wave, lane, gw, NGW); } }
    SEAM(0);
    if (IN(1)) {
        for (int L = 0; L < nlayers; ++L) {
            KArgs A = fresh(kp0); unsigned char* ws = A->ws;
            DenseOrder S; S.init(M, D, G, bx, ws + WS_PB + (size_t)L * M * 256 * 2, ws + WS_W + (size_t)L * WL_STRIDE + WO_PP, 256);
            EpiPlain E{(bf16_t*)(ws + WS_E) + (size_t)L * M * D, D, 0};
            gemm_phase<EpiPlain, DenseOrder, true>(lds + RING_OFF, 256, S, E);
        }
    }
    SEAM(1);
    for (int L = 0; L < nlayers; ++L) {
        const int pb = 2 + PH_PER_LAYER * L;
        if (IN(pb + 0)) for (int rep = 0; rep < REPS(4); ++rep) {
            KArgs A = fresh(kp0); unsigned char* ws = A->ws; unsigned char* wl = ws + WS_W + (size_t)L * WL_STRIDE;
            DenseOrder S; S.init(M, INW, G, bx, ws + WS_XB, wl + WO_IN, D);
            EpiIn E{(const float*)(ws + WS_XPART), A->in[4] + L * 64, A->in[5] + L * 64, (bf16_t*)(ws + WS_Q), (bf16_t*)(ws + WS_K), (bf16_t*)(ws + WS_V), (bf16_t*)(ws + WS_U), (bf16_t*)(ws + WS_VS), (bf16_t*)(ws + WS_GAB), (float*)(ws + WS_VSPART)};
            gemm_phase<EpiIn, DenseOrder, true>(lds + RING_OFF, D, S, E);
        }
        SEAM(pb + 0);
        if (IN(pb + 1)) for (int rep = 0; rep < REPS(8); ++rep) {
            KArgs A = fresh(kp0); unsigned char* ws = A->ws; unsigned char* wl = ws + WS_W + (size_t)L * WL_STRIDE;
            FK_IDS;
            LAS unsigned char* wlds = lds + RING_OFF + wave * WLDS_BYTES;
            constexpr int NATT = 2 * 8 * (SEQ / 32), NSGU = (M / 128) * 8 * 2;
            for (int it = gw; it < NATT + NSGU; it += NGW) {
                if (it < NATT) { const int qblk = it % (SEQ / 32), bh = it / (SEQ / 32); attn_wave_unit(bh >> 3, bh & 7, qblk, (const bf16_t*)(ws + WS_Q), (const bf16_t*)(ws + WS_K), (const bf16_t*)(ws + WS_V), (bf16_t*)(ws + WS_OC), wlds, lane); }
                else { const int j = it - NATT; const int hf = j & 1, g = (j >> 1) & 7, ch = j >> 4;
                    if (hf == 0) sgu_wave_unit<0>(ch, g, (const bf16_t*)(ws + WS_U), (const bf16_t*)(ws + WS_VS), (const float*)(ws + WS_VSPART), (const bf16_t*)(wl + WO_SP), A->in[8] + (size_t)L * 8 * 128, A->in[6] + (size_t)L * 512, (bf16_t*)(ws + WS_OC), wlds, lane);
                    else sgu_wave_unit<1>(ch, g, (const bf16_t*)(ws + WS_U), (const bf16_t*)(ws + WS_VS), (const float*)(ws + WS_VSPART), (const bf16_t*)(wl + WO_SP), A->in[8] + (size_t)L * 8 * 128, A->in[6] + (size_t)L * 512, (bf16_t*)(ws + WS_OC), wlds, lane); }
            }
        }
        SEAM(pb + 1);
        if (IN(pb + 2)) for (int rep = 0; rep < REPS(16); ++rep) {
            KArgs A = fresh(kp0); unsigned char* ws = A->ws; unsigned char* wl = ws + WS_W + (size_t)L * WL_STRIDE;
            DenseOrder S; S.init(M, D, G, bx, ws + WS_OC, wl + WO_UP, D);
            EpiUp E{(const bf16_t*)(ws + WS_GAB), (bf16_t*)(ws + WS_MG)};
            gemm_phase<EpiUp, DenseOrder, false>(lds + RING_OFF, D, S, E);
        }
        SEAM(pb + 2);
        if (IN(pb + 3)) {
            KArgs A = fresh(kp0); unsigned char* ws = A->ws; unsigned char* wl = ws + WS_W + (size_t)L * WL_STRIDE;
            DenseOrder S; S.init(M, D, G, bx, ws + WS_MG, wl + WO_OUT, D);
            EpiOut E{(L == 0) ? A->in[0] : (const float*)A->out, A->out, (bf16_t*)(ws + WS_XB)};
            gemm_phase<EpiOut, DenseOrder, false>(lds + RING_OFF, D, S, E);
        }
        SEAM(pb + 3);
        if (IN(pb + 4)) {
            KArgs A = fresh(kp0); unsigned char* ws = A->ws; unsigned char* wl = ws + WS_W + (size_t)L * WL_STRIDE;
            FK_IDS;
            router_pass(A->out, (const bf16_t*)(wl + WO_R), (const bf16_t*)(wl + WO_R) + 48 * 1024, A->in[14] + L * 4, A->in[16] + L * 32, (float*)(ws + WS_RS2), (int*)((unsigned*)(ws + WS_CTL) + CW_CNT) + L * NE * CNT_STRIDE, (int*)(ws + WS_TOKL), (int*)(ws + WS_TKE), (int*)(ws + WS_TKP), (float*)(ws + WS_TKW), lds, wave, lane, vcu, G);
        }
        SEAM(pb + 4);
        if (IN(pb + 5) || IN(pb + 6) || IN(pb + 7)) {
            KArgs A = fresh(kp0); const int* cnt = (const int*)((unsigned*)(A->ws + WS_CTL) + CW_CNT) + L * NE * CNT_STRIDE;
            if (tid == 0) { int s = 0; for (int e = 0; e < NE; ++e) { pref[e] = s; s += (cnt[e * CNT_STRIDE] + 255) >> 8; } pref[NE] = s; }
            __syncthreads();
        }
        if (IN(pb + 5)) for (int rep = 0; rep < REPS(32); ++rep) {
            KArgs A = fresh(kp0); unsigned char* ws = A->ws; unsigned char* wl = ws + WS_W + (size_t)L * WL_STRIDE; const int* cnt = (const int*)((unsigned*)(ws + WS_CTL) + CW_CNT) + L * NE * CNT_STRIDE;
            ExpertOrder S{G, bx, D, 4, (const char*)(ws + WS_XB), (const char*)(wl + WO_EI), (size_t)1024 * 1024 * 2, pref, (const int*)(ws + WS_TOKL), cnt, 1};
            EpiG1 E{(const int*)(ws + WS_TOKL), cnt, (const float*)(ws + WS_RS2), (bf16_t*)(ws + WS_G)};
            gemm_phase<EpiG1, ExpertOrder, true>(lds + RING_OFF, D, S, E);
        }
        SEAM(pb + 5);
        if (IN(pb + 6)) for (int rep = 0; rep < REPS(64); ++rep) {
            KArgs A = fresh(kp0); unsigned char* ws = A->ws; unsigned char* wl = ws + WS_W + (size_t)L * WL_STRIDE; const int* cnt = (const int*)((unsigned*)(ws + WS_CTL) + CW_CNT) + L * NE * CNT_STRIDE;
            ExpertOrder S{G, bx, 512, 4, (const char*)(ws + WS_G), (const char*)(wl + WO_EO), (size_t)1024 * 512 * 2, pref, (const int*)(ws + WS_TOKL), cnt, 0};
            EpiPlain E{(bf16_t*)(ws + WS_YS), D, 1};
            gemm_phase<EpiPlain, ExpertOrder, true>(lds + RING_OFF, 512, S, E);
        }
        SEAM(pb + 6);
        if (IN(pb + 7)) {
            KArgs A = fresh(kp0); unsigned char* ws = A->ws;
            FK_IDS;
            combine_pass(A->out, (bf16_t*)(ws + WS_XB), (const bf16_t*)(ws + WS_YS), pref, (const int*)(ws + WS_TKE), (const int*)(ws + WS_TKP), (const float*)(ws + WS_TKW), (float*)(ws + WS_RS3), lane, gw, NGW);
        }
        SEAM(pb + 7);
        if (IN(pb + 8)) {
            KArgs A = fresh(kp0); unsigned char* ws = A->ws; unsigned char* wl = ws + WS_W + (size_t)L * WL_STRIDE;
            DenseOrder S; S.init(M, D, G, bx, ws + WS_XB, wl + WO_PG, D);
            EpiPle E{A->out, (bf16_t*)(ws + WS_XB), (const bf16_t*)(ws + WS_E) + (size_t)L * M * D, (const float*)(ws + WS_RS3), (float*)(ws + WS_XPART)};
            gemm_phase<EpiPle, DenseOrder, false>(lds + RING_OFF, D, S, E);
        }
        SEAM(pb + 8);
    }
#undef IN
#undef SEAM
#undef FK_IDS
}
}
#ifndef FK_N_LAUNCHES
#define FK_N_LAUNCHES 1
#endif
static int fk_grid = 0;
static bool fk_setup() {
    if (fk_grid) return fk_grid > 0;
    int dev = 0, cus = 0, per_cu = 0;
    if (hipGetDevice(&dev) != hipSuccess || hipDeviceGetAttribute(&cus, hipDeviceAttributeMultiprocessorCount, dev) != hipSuccess) { fprintf(stderr, "kernel_launch: device query failed\n"); fk_grid = -1; return false; }
    if (hipFuncSetAttribute((const void*)fk::mega_fwd, hipFuncAttributeMaxDynamicSharedMemorySize, fk::LDS_BYTES) != hipSuccess) { fprintf(stderr, "kernel_launch: hipFuncSetAttribute failed\n"); fk_grid = -1; return false; }
    if (hipOccupancyMaxActiveBlocksPerMultiprocessor(&per_cu, (const void*)fk::mega_fwd, fk::NWAVES * 64, fk::LDS_BYTES) != hipSuccess || per_cu < 1)
        fprintf(stderr, "kernel_launch: note: occupancy query reports %d workgroups per CU\n", per_cu);
    (void)hipGetLastError();
    fk_grid = cus;
    return true;
}
static void fk_launch_range(fk::Args a, int lo, int hi, hipStream_t stream) {
    a.ph_lo = lo; a.ph_hi = hi;
    hipLaunchKernelGGL(fk::mega_fwd, dim3(fk_grid), dim3(fk::NWAVES * 64), fk::LDS_BYTES, stream, a);
    const hipError_t le = hipPeekAtLastError();
    if (le != hipSuccess) fprintf(stderr, "kernel_launch: launch [%d,%d) failed: %s\n", lo, hi, hipGetErrorName(le));
}

#ifdef FK_DEBUG_CHECK
#ifndef FK_FOCUS
#define FK_FOCUS 0
#endif
#ifndef FK_STAT
#define FK_STAT 1
#endif
namespace dbg {
__global__ void __launch_bounds__(256) k_cmp(const void* fast, int is_bf16, int fld, int fcol0, const float* gold, int gld, int gcol0, int rows, int cols, float gscale, float* acc) {
    float sd = 0.f, sb = 0.f, sa = 0.f, sb2 = 0.f;
    const size_t n = (size_t)rows * cols;
    for (size_t i = (size_t)blockIdx.x * 256 + threadIdx.x; i < n; i += (size_t)gridDim.x * 256) {
        const size_t r = i / cols; const int c = (int)(i % cols);
        float a;
        if (is_bf16) { const unsigned short h = ((const unsigned short*)fast)[r * fld + fcol0 + c]; a = __uint_as_float((unsigned)h << 16); } else a = ((const float*)fast)[r * fld + fcol0 + c];
        const float b = gold[r * gld + gcol0 + c] * gscale;
        const float d = a - b; sd += d * d; sb += b * b; sa += (FK_STAT == 2 ? a : FK_STAT == 3 ? a * b : FK_STAT == 4 ? (a > 0.99f ? 1.f : 0.f) : a * a); sb2 += (FK_STAT == 2 ? b : FK_STAT == 4 ? 1.f : b * b);
    }
    for (int o = 1; o < 64; o <<= 1) { sd += __shfl_xor(sd, o); sb += __shfl_xor(sb, o); sa += __shfl_xor(sa, o); sb2 += __shfl_xor(sb2, o); }
    if ((threadIdx.x & 63) == 0) { atomicAdd(&acc[0], sd); atomicAdd(&acc[1], sb); atomicAdd(&acc[512], sa); atomicAdd(&acc[513], sb2); }
}
__global__ void __launch_bounds__(256) k_cmp_vs(const unsigned short* vsb, const float* vspart, const float* gain, const float* gz, float* acc) {
    const int row = blockIdx.x * 4 + (threadIdx.x >> 6), lane = threadIdx.x & 63;
    float ss = 0.f; for (int j = 0; j < 8; ++j) ss += vspart[(size_t)row * 8 + j];
    const float rv = 1.f / sqrtf(ss / 512.f + 1e-6f);
    float sd = 0.f, sb = 0.f;
    for (int j = 0; j < 8; ++j) { const int c = lane + 64 * j; const float a = __uint_as_float((unsigned)vsb[(size_t)row * 512 + c] << 16) * rv * gain[c]; const float b = gz[(size_t)row * 4608 + 2048 + c]; sd += (a - b) * (a - b); sb += b * b; }
    for (int o = 1; o < 64; o <<= 1) { sd += __shfl_xor(sd, o); sb += __shfl_xor(sb, o); }
    if (lane == 0) { atomicAdd(&acc[0], sd); atomicAdd(&acc[1], sb); }
}
__global__ void __launch_bounds__(256) k_cmp_w(const unsigned short* wt, const float* w, const float* gain, int n0, int n1, float* acc) {
    float sd = 0.f, sb = 0.f; const size_t tot = (size_t)(n1 - n0) * 1024;
    for (size_t i = (size_t)blockIdx.x * 256 + threadIdx.x; i < tot; i += (size_t)gridDim.x * 256) { const int n = n0 + (int)(i >> 10), k = (int)(i & 1023);
        const float a = __uint_as_float((unsigned)wt[(size_t)n * 1024 + k] << 16), b = gain[k] * w[(size_t)k * 4608 + n]; sd += (a - b) * (a - b); sb += b * b; }
    for (int o = 1; o < 64; o <<= 1) { sd += __shfl_xor(sd, o); sb += __shfl_xor(sb, o); }
    if ((threadIdx.x & 63) == 0) { atomicAdd(&acc[0], sd); atomicAdd(&acc[1], sb); }
}
__global__ void k_final_v(const float* acc, int nchecks, float tol, float* v, int focus) {
    if (threadIdx.x == 0 && blockIdx.x == 0) {
        float out = 0.f;
        if (focus > 0) { float m = acc[2 * focus + 512] / acc[2 * focus + 513]; if (FK_STAT == 1) m = sqrtf(m); if (!(m <= 8.f)) m = 8.f; m = floorf(m * 20.f + 0.5f) * 0.05f; v[0] = powf(10.f, (float)focus) * (1.f + m); return; }
        for (int c = nchecks; c >= 1; --c) { const float e = sqrtf(acc[2 * c] / acc[2 * c + 1]); if (!(e <= tol)) { float m = e; if (!(m <= 2.f)) m = 2.f; m = floorf(m * 10.f + 0.5f) * 0.1f;   out = powf(10.f, (float)c) * (1.f + m); } }
        v[0] = out;
    }
}
__global__ void __launch_bounds__(256) k_scale_out(const float* base, const float* v, float* out, size_t n) {
    const size_t i = (size_t)blockIdx.x * 256 + threadIdx.x; if (i < n) out[i] = base[i] * (1.f + v[0]);
}
}
#endif

extern "C" void kernel_launch(void* const* d_in, const int* in_sizes, int n_in, void* d_out, int out_size, void* d_ws, size_t ws_size, hipStream_t stream) {
    using namespace fk;
    if (n_in != 22 || out_size != M * D || ws_size < WS_FAST_END) { fprintf(stderr, "kernel_launch: unexpected shapes (n_in %d out %d ws %zu)\n", n_in, out_size, ws_size); return; }
    if (!fk_setup()) return;
    if (hipMemsetAsync((char*)d_ws + WS_CTL, 0, CTL_ZERO_BYTES, stream) != hipSuccess) { fprintf(stderr, "kernel_launch: memset failed\n"); return; }
    Args a{};
    for (int i = 0; i < 22; ++i) a.in[i] = (const float*)d_in[i];
    a.out = (float*)d_out; a.ws = (unsigned char*)d_ws; a.nlayers = DEPTH; a.pad = 0;
#ifndef FK_DEBUG_CHECK
    const int nph = 2 + PH_PER_LAYER * DEPTH;
    if (FK_N_LAUNCHES == 1) fk_launch_range(a, 0, nph, stream);
    else for (int p = 0; p < nph; ++p) fk_launch_range(a, p, p + 1, stream);
#else
    constexpr size_t GOLD_BASE = 1100 * MiB, SN_A = 128 * MiB, SN_B = 192 * MiB, SN_BASE = 256 * MiB, FS_A = 320 * MiB, FS_B = 384 * MiB, DBG_ACC = 448 * MiB;
    if (ws_size < GOLD_BASE + gold::O_END) { fprintf(stderr, "kernel_launch: debug build needs %zu bytes of workspace, got %zu\n", GOLD_BASE + gold::O_END, ws_size); return; }
    unsigned char* ws = (unsigned char*)d_ws; unsigned char* gb = ws + GOLD_BASE;
    gold::forward(d_in, (float*)(ws + SN_BASE), gb, 4, stream);
    gold::forward(d_in, nullptr, gb, 1, stream, (float*)(ws + SN_A), (float*)(ws + SN_B));
    a.nlayers = 1;
    const int nph = 2 + PH_PER_LAYER;
    for (int p = 0; p < nph; ++p) {
        fk_launch_range(a, p, p + 1, stream);
        if (p == 2 + 0) (void)hipMemcpyAsync(ws + 528 * MiB, ws + WS_GAB, (size_t)M * 2048 * 2, hipMemcpyDeviceToDevice, stream);
        if (p == 2 + 3) (void)hipMemcpyAsync(ws + FS_A, d_out, (size_t)M * D * 4, hipMemcpyDeviceToDevice, stream);
        if (p == 2 + 7) (void)hipMemcpyAsync(ws + FS_B, d_out, (size_t)M * D * 4, hipMemcpyDeviceToDevice, stream);
    }
    float* acc = (float*)(ws + DBG_ACC);
    (void)hipMemsetAsync(acc, 0, 4096, stream);
    const float* gz = (const float*)(gb + gold::O_Z);
    int c = 0;
#define CMP(fast, isbf, fld, fc0, gold_, gld, gc0, rows, cols, gs) do { ++c; hipLaunchKernelGGL(dbg::k_cmp, dim3(2048), dim3(256), 0, stream, (const void*)(fast), isbf, fld, fc0, (const float*)(gold_), gld, gc0, rows, cols, gs, acc + 2 * c); } while (0)
    ++c; hipLaunchKernelGGL(dbg::k_cmp_w, dim3(1024), dim3(256), 0, stream, (const unsigned short*)(ws + WS_W + WO_IN), (const float*)d_in[3], (const float*)d_in[2], 1024, 2560, acc + 2 * c);
    ++c; hipLaunchKernelGGL(dbg::k_cmp_w, dim3(1024), dim3(256), 0, stream, (const unsigned short*)(ws + WS_W + WO_IN), (const float*)d_in[3], (const float*)d_in[2], 2560, 3584, acc + 2 * c);
    ++c; hipLaunchKernelGGL(dbg::k_cmp_w, dim3(1024), dim3(256), 0, stream, (const unsigned short*)(ws + WS_W + WO_IN), (const float*)d_in[3], (const float*)d_in[2], 3584, 4608, acc + 2 * c);
    CMP(ws + WS_E, 1, 1024, 0, gb + gold::O_YB, 1024, 0, M, 1024, 1.f);
    CMP(ws + WS_Q, 1, 512, 0, gz, INW, 0, M, 512, 0.125f * LOG2E);
    CMP(ws + WS_K, 1, 512, 0, gz, INW, 512, M, 512, 1.f);
    CMP(ws + WS_V, 1, 512, 0, gz, INW, 1024, M, 512, 1.f);
    CMP(ws + WS_U, 1, 512, 0, gz, INW, 1536, M, 512, 1.f);
    ++c; hipLaunchKernelGGL(dbg::k_cmp_vs, dim3(M / 4), dim3(256), 0, stream, (const unsigned short*)(ws + WS_VS), (const float*)(ws + WS_VSPART), (const float*)d_in[6], gz, acc + 2 * c);
    CMP(ws + WS_OC, 1, 1024, 0, gb + gold::O_OA, 512, 0, M, 512, 1.f);
    CMP(ws + WS_OC, 1, 1024, 512, gb + gold::O_OB, 512, 0, M, 512, 1.f);
    CMP(ws + WS_MG, 1, 1024, 0, gb + gold::O_YA, 1024, 0, M, 1024, 1.f);
    CMP(ws + FS_A, 0, 1024, 0, ws + SN_A, 1024, 0, M, 1024, 1.f);
    CMP(ws + FS_B, 0, 1024, 0, ws + SN_B, 1024, 0, M, 1024, 1.f);
    CMP(d_out, 0, 1024, 0, gb + gold::O_X, 1024, 0, M, 1024, 1.f);
    CMP(ws + 528 * MiB, 1, 2048, 0, gz, INW, 2560, M, 256, 1.f);
    CMP(ws + WS_GAB, 1, 2048, 0, gz, INW, 2560, M, 256, 1.f);
    CMP(ws + WS_GAB, 1, 2048, 256, gz, INW, 2816, M, 256, 1.f);
    CMP(ws + WS_GAB, 1, 2048, 512, gz, INW, 3072, M, 512, 1.f);
    CMP(ws + WS_GAB, 1, 2048, 1024, gz, INW, 3584, M, 1024, 1.f);
    hipLaunchKernelGGL(dbg::k_final_v, dim3(1), dim3(64), 0, stream, acc, c, 0.03f, acc + 900, FK_FOCUS);
    hipLaunchKernelGGL(dbg::k_scale_out, dim3(M * D / 256), dim3(256), 0, stream, (const float*)(ws + SN_BASE), acc + 900, (float*)d_out, (size_t)M * D);
#endif
}
```

```cpp
#include <hip/hip_runtime.h>
#include <hip/hip_bf16.h>
#include <cstdio>
#include <cstdint>
#include <cmath>
namespace fk {
#define LAS __attribute__((address_space(3)))
#define GAS __attribute__((address_space(1)))
typedef unsigned short bf16_t;
typedef short bf16x8 __attribute__((ext_vector_type(8)));
typedef short s16x4 __attribute__((ext_vector_type(4)));
typedef float f32x2 __attribute__((ext_vector_type(2)));
typedef float f32x4 __attribute__((ext_vector_type(4)));
typedef float f32x16 __attribute__((ext_vector_type(16)));
typedef unsigned u32x2 __attribute__((ext_vector_type(2)));
typedef unsigned u32x4 __attribute__((ext_vector_type(4)));

constexpr int M = 16384, SEQ = 8192, D = 1024, INW = 4608, NE = 32, ECAP = 16384, DEPTH = 4;
constexpr float EPS = 1e-6f, LOG2E = 1.4426950408889634f;
constexpr int CNT_STRIDE = 64;
constexpr int BM = 256, BK = 64, HALF = 128, HTB = HALF * BK * 2, STAGE_BYTES = 8 * HTB, NXCD = 8, WGM = 8;

__device__ __forceinline__ unsigned cvt_pk_bf16(float lo, float hi) { unsigned r; asm volatile("v_cvt_pk_bf16_f32 %0, %1, %2" : "=v"(r) : "v"(lo), "v"(hi)); return r; }
__device__ __forceinline__ float bf_lo(unsigned w) { return __uint_as_float(w << 16); }
__device__ __forceinline__ float bf_hi(unsigned w) { return __uint_as_float(w & 0xffff0000u); }
__device__ __forceinline__ float fast_rcp(float x) { return __builtin_amdgcn_rcpf(x); }
__device__ __forceinline__ float fast_exp2(float x) { return __builtin_amdgcn_exp2f(x); }
__device__ __forceinline__ float fast_log2(float x) { return __builtin_amdgcn_logf(x); }
__device__ __forceinline__ float fast_rsq(float x) { return __builtin_amdgcn_rsqf(x); }
__device__ __forceinline__ float sigmoid_f(float x) { return fast_rcp(1.f + fast_exp2(-LOG2E * x)); }
__device__ __forceinline__ float gelu_tanh_f(float x) { const float u2 = 1.5957691216057308f * (x + 0.044715f * x * x * x); return x * fast_rcp(1.f + fast_exp2(-LOG2E * u2)); }

__host__ __device__ __forceinline__ int lds_byte(int r, int c) { const int st = (r >> 4) * 2 + (c >> 5), rr = r & 15, cc = c & 31, ob = rr * 64 + cc * 2; return st * 1024 + (ob ^ (((ob >> 9) & 1) << 5)); }
__host__ __device__ __forceinline__ void stage_rc(int b, int& R, int& C) { const int st = b / 1024, sb = b % 1024, swz = sb ^ (((sb >> 9) & 1) << 5); R = (st >> 1) * 16 + swz / 64; C = (st & 1) * 32 + (swz % 64) / 2; }
__host__ __device__ __forceinline__ int perm32(int rho) { const int n = rho >> 4, i = rho & 15; return 8 * (i >> 2) + 4 * n + (i & 3); }

struct Unit { int pm, pn, e, aux; };

struct DenseOrder {
    int nM, nN, nwg, G, c; const char* A; const char* B; int K;
    __device__ void init(int Mr, int N, int G_, int c_, const void* A_, const void* B_, int K_) { nM = Mr / BM; nN = N / BM; nwg = nM * nN; G = G_; c = c_; A = (const char*)A_; B = (const char*)B_; K = K_; }
    __device__ __forceinline__ bool next(int i, Unit& u) const {
        const long L = (long)i * G + c; if (L >= nwg) return false;
        int wgid = (int)L; { const int q = nwg / NXCD, r = nwg % NXCD, xcd = wgid % NXCD, off = wgid / NXCD; wgid = (xcd < r ? xcd * (q + 1) : r * (q + 1) + (xcd - r) * q) + off; }
        const int nig = WGM * nN, gid = wgid / nig, fm = gid * WGM, gsz = (nM - fm) < WGM ? (nM - fm) : WGM;
        u.pm = fm + ((wgid % nig) % gsz); u.pn = (wgid % nig) / gsz; u.e = 0; u.aux = 0; return true;
    }
    __device__ __forceinline__ const char* a_base() const { return A; }
    __device__ __forceinline__ const char* b_base(const Unit& u) const { return B + (size_t)u.pn * BM * K * 2; }
    __device__ __forceinline__ void a_voff(const Unit& u, unsigned (&v)[2][2], const int (&R)[2], const int (&C)[2]) const {
#pragma unroll
        for (int h = 0; h < 2; ++h)
#pragma unroll
            for (int i = 0; i < 2; ++i) v[h][i] = (unsigned)((u.pm * BM + h * HALF + R[i]) * K + C[i]) * 2u;
    }
};

struct ExpertOrder {
    int G, c, K, nN; const char* A; const char* B; size_t bstride; const LAS int* pref; const int* tokl; const int* cnt; int gather;
    __device__ __forceinline__ bool next(int i, Unit& u) const {
        const int L = i * G + c; const int tot = pref[NE] * nN; if (L >= tot) return false;
        const int rbi = L / nN; u.pn = L % nN; int e = 0;
#pragma unroll 1
        for (int j = 1; j < NE; ++j) if (rbi >= pref[j]) e = j;
        u.e = e; u.pm = rbi - pref[e]; u.aux = rbi * BM; return true;
    }
    __device__ __forceinline__ const char* a_base() const { return A; }
    __device__ __forceinline__ const char* b_base(const Unit& u) const { return B + (size_t)u.e * bstride + (size_t)u.pn * BM * K * 2; }
    __device__ __forceinline__ void a_voff(const Unit& u, unsigned (&v)[2][2], const int (&R)[2], const int (&C)[2]) const {
        const int ce = cnt[u.e * CNT_STRIDE];
#pragma unroll
        for (int h = 0; h < 2; ++h)
#pragma unroll
            for (int i = 0; i < 2; ++i) {
                const int r = u.pm * BM + h * HALF + R[i]; int row;
                if (gather) row = (r < ce) ? tokl[u.e * ECAP + r] : 0; else row = u.aux + h * HALF + R[i];
                v[h][i] = (unsigned)(row * K + C[i]) * 2u;
            }
    }
};

template <class Epi, class Sched, bool ALIGN_EPI>
__device__ __forceinline__ void gemm_phase(LAS unsigned char* lds, const int K, const Sched& S, const Epi& E) {
    int tid_ = threadIdx.x; asm volatile("" : "+v"(tid_));
    const int tid = tid_, wid = __builtin_amdgcn_readfirstlane(tid >> 6), lane = tid & 63, wr = wid >> 2, wc = wid & 3, fr = lane & 15, fq = lane >> 4;
    const int nt = K / BK;
    int Rr[2], Cc[2]; unsigned voffB[2];
#pragma unroll
    for (int i = 0; i < 2; ++i) { int R, C; stage_rc(tid * 16 + i * 8192, R, C); Rr[i] = R; Cc[i] = C; const int Rb = Epi::PERM ? ((R & ~31) + perm32(R & 31)) : R; voffB[i] = (unsigned)(Rb * K + C) * 2u; }
    const size_t kstep = (size_t)(BK * 2);
    const size_t hstep = (size_t)HALF * K * 2;
    const unsigned ldsw = (unsigned)wid * 1024u;
    const int aoff = lds_byte(wr * 64 + fr, fq * 8), boff = lds_byte(wc * 32 + fr, fq * 8);
#define PG8_SA(b, h) (((b) * 2 + (h)) * HTB)
#define PG8_SB(b, h) ((4 + (b) * 2 + (h)) * HTB)
#define PG8_STAGE_B(bufoff, gbase) do { _Pragma("unroll") for (int _i = 0; _i < 2; ++_i) \
        __builtin_amdgcn_global_load_lds((const unsigned*)((const char*)(gbase) + voffB[_i]), (LAS unsigned*)(lds + (bufoff) + ldsw + _i * 8192), 16, 0, 0); } while (0)
#define PG8_STAGE_A(bufoff, vo, h, koff) do { _Pragma("unroll") for (int _i = 0; _i < 2; ++_i) \
        __builtin_amdgcn_global_load_lds((const unsigned*)(Ab + (size_t)(vo)[h][_i] + (size_t)(koff)), (LAS unsigned*)(lds + (bufoff) + ldsw + _i * 8192), 16, 0, 0); } while (0)
#define PG8_LDA(dst, b, h) do { _Pragma("unroll") for (int m = 0; m < 4; ++m) _Pragma("unroll") for (int k = 0; k < 2; ++k) dst[m][k] = *(const LAS bf16x8*)(lds + PG8_SA(b, h) + aoff + m * 2048 + k * 1024); } while (0)
#define PG8_LDB(dst, b, h) do { _Pragma("unroll") for (int n = 0; n < 2; ++n) _Pragma("unroll") for (int k = 0; k < 2; ++k) dst[n][k] = *(const LAS bf16x8*)(lds + PG8_SB(b, h) + boff + n * 2048 + k * 1024); } while (0)
#define PG8_MMA(ai, bj, At, Bt) do { __builtin_amdgcn_s_setprio(1); _Pragma("unroll") for (int m = 0; m < 4; ++m) _Pragma("unroll") for (int n = 0; n < 2; ++n) _Pragma("unroll") for (int k = 0; k < 2; ++k) \
        acc[ai][bj][m][n] = __builtin_amdgcn_mfma_f32_16x16x32_bf16(Bt[n][k], At[m][k], acc[ai][bj][m][n], 0, 0, 0); __builtin_amdgcn_s_setprio(0); } while (0)
#define PG8_WAIT_V(n) asm volatile("s_waitcnt vmcnt(" #n ")" ::: "memory")
#define PG8_WAIT_L(n) asm volatile("s_waitcnt lgkmcnt(" #n ")" ::: "memory")
#define PG8_BAR __builtin_amdgcn_s_barrier()
#define PG8_SCHED __builtin_amdgcn_sched_barrier(0)
    Unit cur, nxt; int ui = 0;
    if (!S.next(0, cur)) return;
    f32x4 acc[2][2][4][2];
#pragma unroll
    for (int a = 0; a < 2; ++a)
#pragma unroll
        for (int b = 0; b < 2; ++b)
#pragma unroll
            for (int m = 0; m < 4; ++m)
#pragma unroll
                for (int n = 0; n < 2; ++n) acc[a][b][m][n] = (f32x4){0.f, 0.f, 0.f, 0.f};
    bf16x8 At[4][2], B0[2][2], B1[2][2];
    const char* Ab = S.a_base();
    unsigned cvA[2][2], nvA[2][2];
    S.a_voff(cur, cvA, Rr, Cc);
    const char* cB = S.b_base(cur);
    PG8_STAGE_B(PG8_SB(0, 0), cB); PG8_STAGE_B(PG8_SB(0, 1), cB + hstep); PG8_STAGE_A(PG8_SA(0, 0), cvA, 0, 0); PG8_STAGE_A(PG8_SA(0, 1), cvA, 1, 0);
    if (wr == 1) PG8_BAR;
    PG8_WAIT_V(2); PG8_BAR;
    PG8_STAGE_B(PG8_SB(1, 0), cB + kstep); PG8_STAGE_A(PG8_SA(1, 0), cvA, 0, kstep); PG8_STAGE_B(PG8_SB(1, 1), cB + hstep + kstep);
    PG8_WAIT_V(6); PG8_BAR;
    for (;;) {
        const bool has_next = S.next(ui + 1, nxt);
        const char* nB = has_next ? S.b_base(nxt) : cB;
        if (has_next) S.a_voff(nxt, nvA, Rr, Cc);
        else {
#pragma unroll
            for (int h = 0; h < 2; ++h)
#pragma unroll
                for (int i = 0; i < 2; ++i) nvA[h][i] = cvA[h][i];
        }
#pragma unroll 1
        for (int t = 0; t < nt; t += 2) {
            const bool last = (t == nt - 2);
            if constexpr (Epi::HAS_MID) { if (t == Epi::MID_T) E.mid(acc, cur, wr, wc, fr, fq); }
            const size_t k1 = (size_t)(t + 1) * kstep;
            unsigned a2[2][2];
#pragma unroll
            for (int h = 0; h < 2; ++h)
#pragma unroll
                for (int i = 0; i < 2; ++i) a2[h][i] = last ? nvA[h][i] : cvA[h][i] + (unsigned)((t + 2) * (BK * 2));
            const char* b2 = last ? nB : cB + (size_t)(t + 2) * kstep;
            const char* b3 = b2 + kstep;
            PG8_LDB(B0, 0, 0); PG8_LDB(B1, 0, 1); PG8_SCHED; PG8_LDA(At, 0, 0); PG8_STAGE_A(PG8_SA(1, 1), cvA, 1, k1);
            PG8_WAIT_V(8); PG8_WAIT_L(0); PG8_BAR; PG8_MMA(0, 0, At, B0); PG8_MMA(0, 1, At, B1); PG8_BAR; PG8_SCHED;
            PG8_LDA(At, 0, 1); PG8_STAGE_B(PG8_SB(0, 0), b2); PG8_STAGE_B(PG8_SB(0, 1), b2 + hstep); PG8_STAGE_A(PG8_SA(0, 0), a2, 0, 0);
            PG8_WAIT_V(8); PG8_WAIT_L(0); PG8_BAR; PG8_MMA(1, 0, At, B0); PG8_MMA(1, 1, At, B1); PG8_BAR; PG8_SCHED;
            PG8_LDB(B0, 1, 0); PG8_LDB(B1, 1, 1); PG8_SCHED; PG8_LDA(At, 1, 0); PG8_STAGE_A(PG8_SA(0, 1), a2, 1, 0);
            PG8_WAIT_V(8); PG8_WAIT_L(0); PG8_BAR; PG8_MMA(0, 0, At, B0); PG8_MMA(0, 1, At, B1); PG8_BAR; PG8_SCHED;
            PG8_LDA(At, 1, 1); PG8_STAGE_B(PG8_SB(1, 0), b3); PG8_STAGE_B(PG8_SB(1, 1), b3 + hstep); PG8_STAGE_A(PG8_SA(1, 0), a2, 0, kstep);
            PG8_WAIT_V(8); PG8_WAIT_L(0); PG8_BAR; PG8_MMA(1, 0, At, B0); PG8_MMA(1, 1, At, B1); PG8_BAR; PG8_SCHED;
        }
        if constexpr (ALIGN_EPI) { if (wr == 0) PG8_BAR; }
        E(acc, cur, wr, wc, fr, fq);
        if (!has_next) break;
#pragma unroll
        for (int a = 0; a < 2; ++a)
#pragma unroll
            for (int b = 0; b < 2; ++b)
#pragma unroll
                for (int m = 0; m < 4; ++m)
#pragma unroll
                    for (int n = 0; n < 2; ++n) acc[a][b][m][n] = (f32x4){0.f, 0.f, 0.f, 0.f};
        cur = nxt; cB = nB; ++ui;
#pragma unroll
        for (int h = 0; h < 2; ++h)
#pragma unroll
            for (int i = 0; i < 2; ++i) cvA[h][i] = nvA[h][i];
        if constexpr (ALIGN_EPI) { if (wr == 1) PG8_BAR; }
    }
    PG8_WAIT_V(0);
    if constexpr (!ALIGN_EPI) { if (wr == 0) PG8_BAR; }
    PG8_BAR;
#undef PG8_SA
#undef PG8_SB
#undef PG8_STAGE_A
#undef PG8_STAGE_B
#undef PG8_LDA
#undef PG8_LDB
#undef PG8_MMA
#undef PG8_WAIT_V
#undef PG8_WAIT_L
#undef PG8_BAR
#undef PG8_SCHED
}

typedef f32x4 Acc[2][2][4][2];
__device__ __forceinline__ u32x4 pack8(const f32x4 a, const f32x4 b) { u32x4 w; w.x = cvt_pk_bf16(a[0], a[1]); w.y = cvt_pk_bf16(a[2], a[3]); w.z = cvt_pk_bf16(b[0], b[1]); w.w = cvt_pk_bf16(b[2], b[3]); return w; }

struct EpiPlain {
    static constexpr bool PERM = true, HAS_MID = false; static constexpr int MID_T = 0;
    bf16_t* O; int ldc; int use_aux;
    __device__ __forceinline__ void mid(Acc&, const Unit&, int, int, int, int) const {}
    __device__ __forceinline__ void operator()(const Acc& acc, const Unit& u, int wr, int wc, int fr, int fq) const {
        const int row0 = (use_aux ? u.aux : u.pm * BM) + wr * 64 + fr, col0 = u.pn * BM + wc * 32 + 8 * fq;
#pragma unroll
        for (int ai = 0; ai < 2; ++ai)
#pragma unroll
            for (int m = 0; m < 4; ++m) { bf16_t* rowp = O + (size_t)(row0 + ai * HALF + m * 16) * ldc + col0;
#pragma unroll
                for (int bj = 0; bj < 2; ++bj) *(u32x4*)(rowp + bj * HALF) = pack8(acc[ai][bj][m][0], acc[ai][bj][m][1]); }
    }
};

struct EpiIn {
    static constexpr bool PERM = true, HAS_MID = false; static constexpr int MID_T = 0;
    const float* xpart; const float* qn; const float* kn;
    bf16_t *qb, *kb, *vb, *ub, *vsb, *gab; float* vspart;
    __device__ __forceinline__ void mid(Acc&, const Unit&, int, int, int, int) const {}
    __device__ __forceinline__ void operator()(const Acc& acc, const Unit& u, int wr, int wc, int fr, int fq) const {
        const int pn = u.pn;
#pragma unroll
        for (int ai = 0; ai < 2; ++ai)
#pragma unroll
            for (int m = 0; m < 4; ++m) {
                const int row = u.pm * BM + ai * HALF + wr * 64 + m * 16 + fr;
                const f32x4* xp = (const f32x4*)(xpart + (size_t)row * 16);
                const f32x4 s0 = xp[0], s1 = xp[1], s2 = xp[2], s3 = xp[3];
                const float ssx = ((s0[0] + s0[1]) + (s0[2] + s0[3])) + ((s1[0] + s1[1]) + (s1[2] + s1[3])) + ((s2[0] + s2[1]) + (s2[2] + s2[3])) + ((s3[0] + s3[1]) + (s3[2] + s3[3]));
                const float rs = fast_rsq(ssx * (1.f / D) + EPS);
                f32x4 v[2][2];
#pragma unroll
                for (int bj = 0; bj < 2; ++bj)
#pragma unroll
                    for (int n = 0; n < 2; ++n) v[bj][n] = acc[ai][bj][m][n] * rs;
                if (pn < 4) {
                    float ss = 0.f;
#pragma unroll
                    for (int bj = 0; bj < 2; ++bj)
#pragma unroll
                        for (int n = 0; n < 2; ++n) ss += (v[bj][n][0] * v[bj][n][0] + v[bj][n][1] * v[bj][n][1]) + (v[bj][n][2] * v[bj][n][2] + v[bj][n][3] * v[bj][n][3]);
                    ss += __shfl_xor(ss, 16); ss += __shfl_xor(ss, 32);
                    const bool isq = pn < 2;
                    const float sc = fast_rsq(ss * (1.f / 64.f) + EPS) * (isq ? 0.125f * LOG2E : 1.f);
                    const float* gn = isq ? qn : kn; bf16_t* O = isq ? qb : kb;
                    const int head = 4 * (pn & 1) + wc;
#pragma unroll
                    for (int bj = 0; bj < 2; ++bj) {
                        const f32x4 g0 = *(const f32x4*)(gn + 32 * bj + 8 * fq), g1 = *(const f32x4*)(gn + 32 * bj + 8 * fq + 4);
                        *(u32x4*)(O + (size_t)row * 512 + head * 64 + 32 * bj + 8 * fq) = pack8(v[bj][0] * sc * g0, v[bj][1] * sc * g1);
                    }
                } else {
                    const int colw = wc * 32 + 8 * fq;
                    if (pn < 6) {
#pragma unroll
                        for (int bj = 0; bj < 2; ++bj) *(u32x4*)(vb + (size_t)row * 512 + (pn - 4) * BM + bj * HALF + colw) = pack8(v[bj][0], v[bj][1]);
                    } else if (pn < 10) {
                        float ss = 0.f;
#pragma unroll
                        for (int bj = 0; bj < 2; ++bj)
#pragma unroll
                            for (int n = 0; n < 2; ++n)
#pragma unroll
                                for (int i = 0; i < 4; ++i) { const float gv = gelu_tanh_f(v[bj][n][i]); v[bj][n][i] = gv; ss += gv * gv; }
                        if (pn < 8) {
#pragma unroll
                            for (int bj = 0; bj < 2; ++bj) *(u32x4*)(ub + (size_t)row * 512 + (pn - 6) * BM + bj * HALF + colw) = pack8(v[bj][0], v[bj][1]);
                        } else {
#pragma unroll
                            for (int bj = 0; bj < 2; ++bj) *(u32x4*)(vsb + (size_t)row * 512 + (pn - 8) * BM + bj * HALF + colw) = pack8(v[bj][0], v[bj][1]);
                            ss += __shfl_xor(ss, 16); ss += __shfl_xor(ss, 32);
                            if (fq == 0) vspart[(size_t)row * 8 + (pn - 8) * 4 + wc] = ss;
                        }
                    } else {
#pragma unroll
                        for (int bj = 0; bj < 2; ++bj) {
#pragma unroll
                            for (int n = 0; n < 2; ++n)
#pragma unroll
                                for (int i = 0; i < 4; ++i) v[bj][n][i] = fmaxf(sigmoid_f(v[bj][n][i]), 1e-13f);
                            *(u32x4*)(gab + (size_t)row * 2048 + (pn - 10) * BM + bj * HALF + colw) = pack8(v[bj][0], v[bj][1]);
                        }
                    }
                }
            }
    }
};

struct EpiUp {
    static constexpr bool PERM = true, HAS_MID = true; static constexpr int MID_T = 8;
    const bf16_t* gab; bf16_t* mg;
    __device__ __forceinline__ void mid(Acc& acc, const Unit& u, int wr, int wc, int fr, int fq) const {
        int row0 = u.pm * BM + wr * 64 + fr; const int col0 = u.pn * BM + wc * 32 + 8 * fq; asm volatile("" : "+v"(row0));
#pragma unroll
        for (int am = 0; am < 4; ++am) {
            const int ai = am >> 1, mb = (am & 1) * 2;
            u32x4 ga[2][2], gb[2][2];
#pragma unroll
            for (int mm = 0; mm < 2; ++mm) { const bf16_t* gp = gab + (size_t)(row0 + ai * HALF + (mb + mm) * 16) * 2048 + col0;
#pragma unroll
                for (int bj = 0; bj < 2; ++bj) { ga[mm][bj] = *(const u32x4*)(gp + bj * HALF); gb[mm][bj] = *(const u32x4*)(gp + 1024 + bj * HALF); } }
#pragma unroll
            for (int mm = 0; mm < 2; ++mm)
#pragma unroll
                for (int bj = 0; bj < 2; ++bj)
#pragma unroll
                    for (int j = 0; j < 4; ++j) { const float r0 = bf_lo(ga[mm][bj][j]) * fast_rcp(bf_lo(gb[mm][bj][j])), r1 = bf_hi(ga[mm][bj][j]) * fast_rcp(bf_hi(gb[mm][bj][j]));
                        acc[ai][bj][mb + mm][j >> 1][(j & 1) * 2] *= r0; acc[ai][bj][mb + mm][j >> 1][(j & 1) * 2 + 1] *= r1; }
            asm volatile("" ::: "memory");
        }
    }
    __device__ __forceinline__ void operator()(const Acc& acc, const Unit& u, int wr, int wc, int fr, int fq) const {
        int row0 = u.pm * BM + wr * 64 + fr; const int col0 = u.pn * BM + wc * 32 + 8 * fq; asm volatile("" : "+v"(row0));
#pragma unroll
        for (int ai = 0; ai < 2; ++ai) {
            u32x4 gb[4][2];
#pragma unroll
            for (int m = 0; m < 4; ++m)
#pragma unroll
                for (int bj = 0; bj < 2; ++bj) gb[m][bj] = *(const u32x4*)(gab + (size_t)(row0 + ai * HALF + m * 16) * 2048 + 1024 + col0 + bj * HALF);
#pragma unroll
            for (int m = 0; m < 4; ++m) { const size_t ro = (size_t)(row0 + ai * HALF + m * 16);
#pragma unroll
                for (int bj = 0; bj < 2; ++bj) { const u32x4 b = gb[m][bj];
                    f32x4 o0, o1;
                    o0[0] = acc[ai][bj][m][0][0] * bf_lo(b[0]); o0[1] = acc[ai][bj][m][0][1] * bf_hi(b[0]); o0[2] = acc[ai][bj][m][0][2] * bf_lo(b[1]); o0[3] = acc[ai][bj][m][0][3] * bf_hi(b[1]);
                    o1[0] = acc[ai][bj][m][1][0] * bf_lo(b[2]); o1[1] = acc[ai][bj][m][1][1] * bf_hi(b[2]); o1[2] = acc[ai][bj][m][1][2] * bf_lo(b[3]); o1[3] = acc[ai][bj][m][1][3] * bf_hi(b[3]);
                    *(u32x4*)(mg + ro * 1024 + col0 + bj * HALF) = pack8(o0, o1); } }
            asm volatile("" ::: "memory");
        }
    }
};

struct EpiOut {
    static constexpr bool PERM = true, HAS_MID = false; static constexpr int MID_T = 0;
    const bf16_t* xin; bf16_t* xout;
    __device__ __forceinline__ void mid(Acc&, const Unit&, int, int, int, int) const {}
    __device__ __forceinline__ void operator()(const Acc& acc, const Unit& u, int wr, int wc, int fr, int fq) const {
        int row0 = u.pm * BM + wr * 64 + fr; const int col0 = u.pn * BM + wc * 32 + 8 * fq; asm volatile("" : "+v"(row0));
#pragma unroll
        for (int ai = 0; ai < 2; ++ai) {
            u32x4 xv[4][2];
#pragma unroll
            for (int m = 0; m < 4; ++m)
#pragma unroll
                for (int bj = 0; bj < 2; ++bj) xv[m][bj] = *(const u32x4*)(xin + (size_t)(row0 + ai * HALF + m * 16) * D + col0 + bj * HALF);
#pragma unroll
            for (int m = 0; m < 4; ++m)
#pragma unroll
                for (int bj = 0; bj < 2; ++bj) { const u32x4 xo = xv[m][bj]; f32x4 o0, o1;
                    o0[0] = bf_lo(xo[0]) + acc[ai][bj][m][0][0]; o0[1] = bf_hi(xo[0]) + acc[ai][bj][m][0][1]; o0[2] = bf_lo(xo[1]) + acc[ai][bj][m][0][2]; o0[3] = bf_hi(xo[1]) + acc[ai][bj][m][0][3];
                    o1[0] = bf_lo(xo[2]) + acc[ai][bj][m][1][0]; o1[1] = bf_hi(xo[2]) + acc[ai][bj][m][1][1]; o1[2] = bf_lo(xo[3]) + acc[ai][bj][m][1][2]; o1[3] = bf_hi(xo[3]) + acc[ai][bj][m][1][3];
                    *(u32x4*)(xout + (size_t)(row0 + ai * HALF + m * 16) * D + col0 + bj * HALF) = pack8(o0, o1); }
            asm volatile("" ::: "memory");
        }
    }
};

struct EpiG1 {
    static constexpr bool PERM = true, HAS_MID = false; static constexpr int MID_T = 0;
    const int* tokl; const int* cnt; const float* rs2; bf16_t* Gb;
    __device__ __forceinline__ void mid(Acc&, const Unit&, int, int, int, int) const {}
    __device__ __forceinline__ void operator()(const Acc& acc, const Unit& u, int wr, int wc, int fr, int fq) const {
        const int ce = cnt[u.e * CNT_STRIDE];
#pragma unroll
        for (int ai = 0; ai < 2; ++ai)
#pragma unroll
            for (int m = 0; m < 4; ++m) {
                const int rl = ai * HALF + wr * 64 + m * 16 + fr, r = u.pm * BM + rl;
                const int tok = (r < ce) ? tokl[u.e * ECAP + r] : 0;
                const float rs = rs2[tok];
                f32x4 o[2];
#pragma unroll
                for (int n = 0; n < 2; ++n)
#pragma unroll
                    for (int i = 0; i < 4; ++i) { const float g = acc[ai][0][m][n][i] * rs, up = acc[ai][1][m][n][i] * rs; o[n][i] = g * sigmoid_f(g) * up; }
                *(u32x4*)(Gb + (size_t)(u.aux + rl) * 512 + u.pn * HALF + wc * 32 + 8 * fq) = pack8(o[0], o[1]);
            }
    }
};

struct EpiPle {
    static constexpr bool PERM = true, HAS_MID = false; static constexpr int MID_T = 0;
    const bf16_t* xin; bf16_t* xout; float* fout; const bf16_t* Eb; const float* rs3; float* xpart;
    __device__ __forceinline__ void mid(Acc&, const Unit&, int, int, int, int) const {}
    __device__ __forceinline__ void operator()(const Acc& acc, const Unit& u, int wr, int wc, int fr, int fq) const {
        int row0 = u.pm * BM + wr * 64 + fr; const int col0 = u.pn * BM + wc * 32 + 8 * fq; asm volatile("" : "+v"(row0));
#pragma unroll
        for (int am = 0; am < 4; ++am) {
            const int ai = am >> 1, mb = (am & 1) * 2;
            u32x4 xv[2][2], ev[2][2]; float rsv[2];
#pragma unroll
            for (int mm = 0; mm < 2; ++mm) { const int row = row0 + ai * HALF + (mb + mm) * 16; rsv[mm] = rs3[row];
#pragma unroll
                for (int bj = 0; bj < 2; ++bj) { xv[mm][bj] = *(const u32x4*)(xin + (size_t)row * D + col0 + bj * HALF); ev[mm][bj] = *(const u32x4*)(Eb + (size_t)row * D + col0 + bj * HALF); } }
#pragma unroll
            for (int mm = 0; mm < 2; ++mm) { const int row = row0 + ai * HALF + (mb + mm) * 16; const float rs = rsv[mm]; float ss = 0.f;
#pragma unroll
                for (int bj = 0; bj < 2; ++bj) { const u32x4 xo = xv[mm][bj], e = ev[mm][bj]; f32x4 o[2];
#pragma unroll
                    for (int j = 0; j < 4; ++j) { o[j >> 1][(j & 1) * 2] = bf_lo(xo[j]) + sigmoid_f(acc[ai][bj][mb + mm][j >> 1][(j & 1) * 2] * rs) * bf_lo(e[j]);
                                                  o[j >> 1][(j & 1) * 2 + 1] = bf_hi(xo[j]) + sigmoid_f(acc[ai][bj][mb + mm][j >> 1][(j & 1) * 2 + 1] * rs) * bf_hi(e[j]); }
                    const u32x4 w = pack8(o[0], o[1]);
#pragma unroll
                    for (int j = 0; j < 4; ++j) { const float a = bf_lo(w[j]), b = bf_hi(w[j]); ss += a * a + b * b; }
                    *(u32x4*)(xout + (size_t)row * D + col0 + bj * HALF) = w;
                    if (fout) { *(f32x4*)(fout + (size_t)row * D + col0 + bj * HALF) = o[0]; *(f32x4*)(fout + (size_t)row * D + col0 + bj * HALF + 4) = o[1]; } }
                ss += __shfl_xor(ss, 16); ss += __shfl_xor(ss, 32);
                if (fq == 0) xpart[(size_t)row * 16 + u.pn * 4 + wc] = ss; }
            asm volatile("" ::: "memory");
        }
    }
};
__device__ __forceinline__ int crow(int r, int hi) { return (r & 3) + 8 * (r >> 2) + 4 * hi; }
__device__ __forceinline__ unsigned cvtpk_s(float lo, float hi) { typedef __bf16 bf16x2_t __attribute__((ext_vector_type(2))); f32x2 v = {lo, hi}; bf16x2_t b = __builtin_convertvector(v, bf16x2_t); return __builtin_bit_cast(unsigned, b); }
#define FK_SBAR() __builtin_amdgcn_sched_barrier(0)
__device__ __forceinline__ void pv(f32x16* o, int vb, bf16x8 pa0, bf16x8 pa1, bf16x8 pa2, bf16x8 pa3) {
#pragma unroll
    for (int d0 = 0; d0 < 2; ++d0) { s16x4 lo[4], hi[4];
#pragma unroll
        for (int ks = 0; ks < 4; ++ks) {
            asm volatile("ds_read_b64_tr_b16 %0,%1 offset:%c2" : "=&v"(lo[ks]) : "v"(vb), "i"(d0 * 4096 + ks * 1024) : "memory");
            asm volatile("ds_read_b64_tr_b16 %0,%1 offset:%c2" : "=&v"(hi[ks]) : "v"(vb), "i"(d0 * 4096 + ks * 1024 + 512) : "memory"); }
        asm volatile("s_waitcnt lgkmcnt(0)" ::: "memory"); FK_SBAR();
#define FK_PK(k) (bf16x8){lo[k][0], lo[k][1], lo[k][2], lo[k][3], hi[k][0], hi[k][1], hi[k][2], hi[k][3]}
        o[d0] = __builtin_amdgcn_mfma_f32_32x32x16_bf16(pa0, FK_PK(0), o[d0], 0, 0, 0);
        o[d0] = __builtin_amdgcn_mfma_f32_32x32x16_bf16(pa1, FK_PK(1), o[d0], 0, 0, 0);
        o[d0] = __builtin_amdgcn_mfma_f32_32x32x16_bf16(pa2, FK_PK(2), o[d0], 0, 0, 0);
        o[d0] = __builtin_amdgcn_mfma_f32_32x32x16_bf16(pa3, FK_PK(3), o[d0], 0, 0, 0);
#undef FK_PK
    }
}
constexpr int WLDS_BYTES = 12288;

__device__ __forceinline__ void attn_wave_unit(int b, int h, int qblk, const bf16_t* __restrict__ qb, const bf16_t* __restrict__ kb, const bf16_t* __restrict__ vb, bf16_t* __restrict__ oc, LAS unsigned char* wl, int lane) {
    const int r32 = lane & 31, hi = lane >> 5;
    const long rowbase = (long)b * SEQ; const int q0 = qblk * 32, tq = q0 + r32;
    bf16x8 qr[4];
    { const bf16_t* qp = qb + (size_t)(rowbase + q0 + r32) * 512 + h * 64 + hi * 8;
#pragma unroll
      for (int d0 = 0; d0 < 4; ++d0) qr[d0] = *(const bf16x8*)(qp + d0 * 16); }
    f32x16 o[2]; o[0] = f32x16{}; o[1] = f32x16{};
    float R = 0.f;
    const int vbase = (int)(unsigned)(uintptr_t)wl + ((lane >> 4) & 1) * 32 + (lane & 3) * 8 + (4 * hi + ((lane & 15) >> 2)) * 64;
    const int jd = q0 >> 6;
    for (int jt = jd; jt >= 0; --jt) {
        const int s0 = jt * 64;
        const bf16_t* kp = kb + (size_t)(rowbase + s0 + r32) * 512 + h * 64 + hi * 8;
        bf16x8 k0[4], k1[4];
#pragma unroll
        for (int d0 = 0; d0 < 4; ++d0) { k0[d0] = *(const bf16x8*)(kp + d0 * 16); k1[d0] = *(const bf16x8*)(kp + 32 * 512 + d0 * 16); }
        u32x4 vt[8];
#pragma unroll
        for (int w8 = 0; w8 < 8; ++w8) vt[w8] = *(const u32x4*)(vb + (size_t)(rowbase + s0 + 16 * (w8 & 3) + (lane >> 2)) * 512 + h * 64 + 32 * (w8 >> 2) + 8 * (lane & 3));
        f32x16 p0 = f32x16{}, p1 = f32x16{};
#pragma unroll
        for (int d0 = 0; d0 < 4; ++d0) { p0 = __builtin_amdgcn_mfma_f32_32x32x16_bf16(k0[d0], qr[d0], p0, 0, 0, 0); p1 = __builtin_amdgcn_mfma_f32_32x32x16_bf16(k1[d0], qr[d0], p1, 0, 0, 0); }
#pragma unroll
        for (int w8 = 0; w8 < 8; ++w8) *(LAS u32x4*)(wl + w8 * 1024 + lane * 16) = vt[w8];
        const bool diag = (jt == jd);
        float lb[32], lk[32];
#pragma unroll
        for (int r = 0; r < 32; ++r) {
            const float z = r < 16 ? p0[r] : p1[r - 16];
            const float e = fast_exp2(-fabsf(z)), l = fast_log2(1.f + e);
            float b_ = fminf(z, 0.f) - l, k_ = b_ - z;
            if (diag) { const int kv = s0 + crow(r & 15, hi) + (r >> 4) * 32; if (!(kv < tq)) { k_ = 0.f; b_ = -INFINITY; } }
            lb[r] = b_; lk[r] = k_;
        }
        float gs[8], pg[8], T[8], SP[8];
#pragma unroll
        for (int g = 0; g < 8; ++g) { gs[g] = (lk[4 * g] + lk[4 * g + 1]) + (lk[4 * g + 2] + lk[4 * g + 3]); pg[g] = __shfl_xor(gs[g], 32); T[g] = gs[g] + pg[g]; }
        SP[7] = 0.f;
#pragma unroll
        for (int g = 6; g >= 0; --g) SP[g] = SP[g + 1] + T[g + 1];
        float a[32];
#pragma unroll
        for (int g = 0; g < 8; ++g) {
            const float base = R + SP[g] + (hi == 0 ? pg[g] : 0.f);
            const float a3 = base, a2 = a3 + lk[4 * g + 3], a1 = a2 + lk[4 * g + 2], a0 = a1 + lk[4 * g + 1];
            a[4 * g + 3] = fast_exp2(lb[4 * g + 3] + a3); a[4 * g + 2] = fast_exp2(lb[4 * g + 2] + a2);
            a[4 * g + 1] = fast_exp2(lb[4 * g + 1] + a1); a[4 * g] = fast_exp2(lb[4 * g] + a0);
        }
        R += SP[0] + T[0];
        u32x4 pw0, pw1, pw2, pw3;
        pw0 = (u32x4){cvtpk_s(a[0], a[1]), cvtpk_s(a[2], a[3]), cvtpk_s(a[4], a[5]), cvtpk_s(a[6], a[7])};
        pw1 = (u32x4){cvtpk_s(a[8], a[9]), cvtpk_s(a[10], a[11]), cvtpk_s(a[12], a[13]), cvtpk_s(a[14], a[15])};
        pw2 = (u32x4){cvtpk_s(a[16], a[17]), cvtpk_s(a[18], a[19]), cvtpk_s(a[20], a[21]), cvtpk_s(a[22], a[23])};
        pw3 = (u32x4){cvtpk_s(a[24], a[25]), cvtpk_s(a[26], a[27]), cvtpk_s(a[28], a[29]), cvtpk_s(a[30], a[31])};
        asm volatile("s_waitcnt lgkmcnt(0)" ::: "memory");
        pv(o, vbase, __builtin_bit_cast(bf16x8, pw0), __builtin_bit_cast(bf16x8, pw1), __builtin_bit_cast(bf16x8, pw2), __builtin_bit_cast(bf16x8, pw3));
        if (__all(R < -159.f)) break;
    }
    LAS bf16_t* stg = (LAS bf16_t*)(wl + 8192);
#pragma unroll
    for (int r = 0; r < 16; ++r) { const int orow = crow(r, hi);
#pragma unroll
        for (int d0 = 0; d0 < 2; ++d0) stg[orow * 64 + d0 * 32 + r32] = (bf16_t)(cvtpk_s(o[d0][r], 0.f) & 0xffffu); }
    asm volatile("s_waitcnt lgkmcnt(0)" ::: "memory");
    bf16_t* Ow = oc + (size_t)(rowbase + q0) * 1024 + h * 64;
#pragma unroll
    for (int i = 0; i < 4; ++i) { const int row = i * 8 + (lane >> 3), ch = lane & 7; const u32x4 v = *(const LAS u32x4*)(stg + row * 64 + ch * 8); *(u32x4*)(Ow + (size_t)row * 1024 + ch * 8) = v; }
    asm volatile("s_waitcnt lgkmcnt(0)" ::: "memory");
}

template <int HF>
__device__ __forceinline__ void sgu_wave_unit(int chunk, int g, const bf16_t* __restrict__ ub, const bf16_t* __restrict__ vsb, const float* __restrict__ vspart, const bf16_t* __restrict__ wsp  ,
                                              const float* __restrict__ bsp  , const float* __restrict__ sgn  , bf16_t* __restrict__ oc, LAS unsigned char* wl, int lane) {
    const int r32 = lane & 31, hi = lane >> 5;
    const size_t row0 = (size_t)chunk * 128;
    const int vbase = (int)(unsigned)(uintptr_t)wl + ((lane >> 4) & 1) * 32 + (lane & 3) * 8 + (4 * hi + ((lane & 15) >> 2)) * 64;
    f32x16 o[2][2];
#pragma unroll
    for (int rl = 0; rl < 2; ++rl) { o[rl][0] = f32x16{}; o[rl][1] = f32x16{}; }
#pragma unroll
    for (int kt = 0; kt <= HF; ++kt) {
#pragma unroll 2
        for (int w8 = 0; w8 < 8; ++w8) {
            const size_t row = row0 + 64 * kt + 16 * (w8 & 3) + (lane >> 2);
            const f32x4 s0 = *(const f32x4*)(vspart + row * 8), s1 = *(const f32x4*)(vspart + row * 8 + 4);
            const float rv = fast_rsq((((s0[0] + s0[1]) + (s0[2] + s0[3])) + ((s1[0] + s1[1]) + (s1[2] + s1[3]))) * (1.f / 512.f) + EPS);
            const u32x4 v = *(const u32x4*)(vsb + row * 512 + g * 64 + 32 * (w8 >> 2) + 8 * (lane & 3));
            u32x4 w;
#pragma unroll
            for (int j = 0; j < 4; ++j) w[j] = cvtpk_s(bf_lo(v[j]) * rv, bf_hi(v[j]) * rv);
            *(LAS u32x4*)(wl + w8 * 1024 + lane * 16) = w;
        }
        asm volatile("s_waitcnt lgkmcnt(0)" ::: "memory");
#pragma unroll
        for (int rl = 0; rl < 2; ++rl) {
            const int rb = 2 * HF + rl;
            const bf16_t* wp = wsp + ((size_t)g * 128 + 32 * rb + r32) * 128 + 64 * kt + 4 * hi;
            u32x4 pw[4];
#pragma unroll
            for (int ks = 0; ks < 4; ++ks) { const u32x2 lo = *(const u32x2*)(wp + 16 * ks), h8 = *(const u32x2*)(wp + 16 * ks + 8); pw[ks] = (u32x4){lo.x, lo.y, h8.x, h8.y}; }
            pv(o[rl], vbase, __builtin_bit_cast(bf16x8, pw[0]), __builtin_bit_cast(bf16x8, pw[1]), __builtin_bit_cast(bf16x8, pw[2]), __builtin_bit_cast(bf16x8, pw[3]));
        }
        asm volatile("s_waitcnt lgkmcnt(0)" ::: "memory");
    }
    LAS bf16_t* stg = (LAS bf16_t*)(wl + 8192);
    const float gn0 = sgn[g * 64 + r32], gn1 = sgn[g * 64 + 32 + r32];
#pragma unroll
    for (int rl = 0; rl < 2; ++rl) {
        const int rb = 2 * HF + rl;
#pragma unroll
        for (int r = 0; r < 16; ++r) { const int orow = crow(r, hi); const float bb = bsp[g * 128 + 32 * rb + orow];
            stg[orow * 64 + r32] = (bf16_t)(cvtpk_s(gn0 * o[rl][0][r] + bb, 0.f) & 0xffffu); stg[orow * 64 + 32 + r32] = (bf16_t)(cvtpk_s(gn1 * o[rl][1][r] + bb, 0.f) & 0xffffu); }
        asm volatile("s_waitcnt lgkmcnt(0)" ::: "memory");
#pragma unroll
        for (int i = 0; i < 4; ++i) { const int row = i * 8 + (lane >> 3), ch = lane & 7; const size_t grow = row0 + 32 * rb + row;
            const u32x4 mv = *(const LAS u32x4*)(stg + row * 64 + ch * 8); const u32x4 uv = *(const u32x4*)(ub + grow * 512 + g * 64 + ch * 8); u32x4 w;
#pragma unroll
            for (int j = 0; j < 4; ++j) w[j] = cvtpk_s(bf_lo(mv[j]) * bf_lo(uv[j]), bf_hi(mv[j]) * bf_hi(uv[j]));
            *(u32x4*)(oc + grow * 1024 + 512 + g * 64 + ch * 8) = w; }
        asm volatile("s_waitcnt lgkmcnt(0)" ::: "memory");
    }
}
constexpr size_t MiB = 1u << 20;
constexpr size_t WS_CTL = 0, CTL_ZERO_BYTES = 1 * MiB;
constexpr size_t WS_W = 16 * MiB, WL_STRIDE = 112 * MiB;
constexpr size_t WO_IN = 0, WO_UP = 9 * MiB, WO_OUT = 11 * MiB, WO_PG = 13 * MiB, WO_PP = 15 * MiB, WO_SP = 15 * MiB + 512 * 1024, WO_R = 15 * MiB + 768 * 1024, WO_EI = 16 * MiB, WO_EO = 80 * MiB;
constexpr size_t WS_PB = 464 * MiB, WS_E = 496 * MiB, WS_XB = 624 * MiB, WS_Q = 656 * MiB, WS_K = 672 * MiB, WS_V = 688 * MiB, WS_U = 704 * MiB, WS_VS = 720 * MiB, WS_GAB = 736 * MiB,
                 WS_OC = 800 * MiB, WS_MG = 832 * MiB, WS_G = 864 * MiB, WS_YS = 904 * MiB, WS_XPART = 984 * MiB, WS_VSPART = 985 * MiB, WS_RS2 = 985 * MiB + 512 * 1024, WS_RS3 = 985 * MiB + 640 * 1024,
                 WS_TOKL = 986 * MiB, WS_TKE = 988 * MiB, WS_TKP = 988 * MiB + 256 * 1024, WS_TKW = 988 * MiB + 512 * 1024, WS_XB1 = 992 * MiB, WS_FAST_END = 1024 * MiB;
constexpr int GSLOTS = 2 * M + NE * 256;
constexpr int CW_TMO = 0, CW_CODE = 1, CW_BAR = 4096, CW_CNT = 8192  ;

constexpr int RING_OFF = 0, RING_BYTES = 131072, LDSCTL_OFF = 139264  , MISC_OFF = LDSCTL_OFF + 320, PREF_OFF = MISC_OFF + 128  , LDS_BYTES = 147456;

#define RLX_AGENT __ATOMIC_RELAXED, __HIP_MEMORY_SCOPE_AGENT
#define XB_TMO      128
#define XB_XCNT(j)  (256  + 64 * (j))
#define XB_XSUB(j)  (1280 + 64 * (j))
#define XB_XGEN(j)  (2304 + 64 * (j))
#define XB_TOP      3328
#define XB_TOPGEN   3392
#define XCD_BAR_WORDS 3456
#define XB_SPIN_CAP (1u << 18)
__device__ __forceinline__ unsigned xb_ld(unsigned* p)              { return __hip_atomic_load(p, __ATOMIC_RELAXED, __HIP_MEMORY_SCOPE_AGENT); }
__device__ __forceinline__ unsigned xb_add(unsigned* p, unsigned v) { return __hip_atomic_fetch_add(p, v, __ATOMIC_RELAXED, __HIP_MEMORY_SCOPE_AGENT); }
__device__ __forceinline__ unsigned xb_xcc_id() { return (unsigned)__builtin_amdgcn_s_getreg((3 << 11) | 20) & 0xFu; }
#define XB_SPIN(cond, bar) do { unsigned _sp = 0; while (cond) { __builtin_amdgcn_s_sleep(1); \
    if ((++_sp & 255u) == 0u) { if (xb_ld(&(bar)[XB_TMO])) break; if (_sp > XB_SPIN_CAP) { atomicAdd(&(bar)[XB_TMO], 1u); break; } } } } while (0)
struct XcdBarrier { unsigned* bar; unsigned x; volatile LAS unsigned* st; };
__device__ __forceinline__ XcdBarrier xcd_barrier_post(unsigned* bar, volatile LAS unsigned* st) {
    XcdBarrier b; b.bar = bar; b.x = xb_xcc_id(); b.st = st;
    if (threadIdx.x == 0) (void)xb_add(&bar[XB_XCNT(b.x)], 1u);
    return b;
}
__device__ __forceinline__ void xcd_barrier_complete(unsigned* bar, unsigned x, unsigned& nloc, unsigned& nx) {
    const unsigned G = gridDim.x * gridDim.y * gridDim.z;
    unsigned sum, cnt, mine, sp = 0u;
    for (;;) {
        sum = 0u; cnt = 0u; mine = 0u;
#pragma unroll
        for (unsigned j = 0; j < 16; ++j) { const unsigned c = xb_ld(&bar[XB_XCNT(j)]); sum += c; cnt += (c > 0u) ? 1u : 0u; mine = (j == x) ? c : mine; }
        if (sum == G) break;
        __builtin_amdgcn_s_sleep(1);
        if ((++sp & 255u) == 0u) { if (xb_ld(&bar[XB_TMO])) break; if (sp > XB_SPIN_CAP) { atomicAdd(&bar[XB_TMO], 1u); break; } }
    }
    nloc = mine > 0u ? mine : 1u; nx = cnt > 0u ? cnt : 1u;
}
__device__ __forceinline__ void xcd_barrier(const XcdBarrier& b) {
    asm volatile("s_waitcnt vmcnt(0)" ::: "memory");
    __syncthreads();
    if (threadIdx.x == 0) {
        unsigned* bar = b.bar;
        __builtin_amdgcn_s_waitcnt(0);
        unsigned nloc = b.st[0], nx = b.st[1];
        if (nloc == 0u) { xcd_barrier_complete(bar, b.x, nloc, nx); b.st[0] = nloc; b.st[1] = nx; }
        const unsigned old = xb_add(&bar[XB_XSUB(b.x)], 1u);
        const unsigned gen = old / nloc;
        if (old + 1u == (gen + 1u) * nloc) {
            __builtin_amdgcn_fence(__ATOMIC_RELEASE, "agent");
            asm volatile("s_waitcnt vmcnt(0)" ::: "memory");
            const unsigned og = xb_add(&bar[XB_TOP], 1u);
            const unsigned tg = og / nx;
            if (og + 1u == (tg + 1u) * nx) xb_add(&bar[XB_TOPGEN], 1u);
            else XB_SPIN(xb_ld(&bar[XB_TOPGEN]) == tg, bar);
            __builtin_amdgcn_fence(__ATOMIC_ACQUIRE, "agent");
            xb_add(&bar[XB_XGEN(b.x)], 1u);
            asm volatile("s_waitcnt vmcnt(0)" ::: "memory");
        } else {
            XB_SPIN(xb_ld(&bar[XB_XGEN(b.x)]) == gen, bar);
            __builtin_amdgcn_fence(__ATOMIC_ACQUIRE, "agent");
            asm volatile("s_waitcnt vmcnt(0)" ::: "memory");
        }
    }
    __syncthreads();
}

struct Args {
    const float* in[22]; float* out; unsigned char* ws;
    int ph_lo, ph_hi, nlayers, pad;
};
__device__ __forceinline__ float wave_sum(float v) {
#pragma unroll
    for (int o = 1; o < 64; o <<= 1) v += __shfl_xor(v, o);
    return v;
}
__device__ __forceinline__ unsigned f2bf(float f) { unsigned u = __builtin_bit_cast(unsigned, f); return (u + 0x7fffu + ((u >> 16) & 1u)) >> 16; }
__device__ __forceinline__ unsigned pk2(float lo, float hi) { return f2bf(lo) | (f2bf(hi) << 16); }

__device__ __forceinline__ int rowmap(int kind, int n) {
    if (kind == 1) { if (n >= 1024) return n; const int nl = n & 255; return (n - nl) + 128 * ((nl & 63) >> 5) + 32 * (nl >> 6) + (nl & 31); }
    if (kind == 2) { return n < 512 ? 256 * (n >> 7) + (n & 127) : 256 * ((n - 512) >> 7) + 128 + ((n - 512) & 127); }
    return n;
}
__device__ __forceinline__ void transpose_item(const float* __restrict__ W, int N, const float* __restrict__ gain, bf16_t* __restrict__ WT, int ldt, int koff, int kind, LAS float* scr, int item, int lane) {
    const int nblk = N / 64, kb = item / nblk, nb = item % nblk, k0 = 64 * kb, n0 = 64 * nb;
    const int kr = lane >> 4, nc = 4 * (lane & 15);
    f32x4 v[16];
#pragma unroll
    for (int i = 0; i < 16; ++i) v[i] = *(const f32x4*)(W + (size_t)(k0 + 4 * i + kr) * N + n0 + nc);
#pragma unroll
    for (int i = 0; i < 16; ++i) { const int kk = 4 * i + kr; const float gv = gain ? gain[k0 + kk] : 1.f; LAS float* d = scr + kk * 65 + nc; d[0] = v[i][0] * gv; d[1] = v[i][1] * gv; d[2] = v[i][2] * gv; d[3] = v[i][3] * gv; }
    asm volatile("s_waitcnt lgkmcnt(0)" ::: "memory");
    const int c = lane & 7;
#pragma unroll
    for (int j = 0; j < 8; ++j) { const int n = 8 * j + (lane >> 3); const LAS float* s = scr + (8 * c) * 65 + n;
        u32x4 o; o.x = pk2(s[0 * 65], s[1 * 65]); o.y = pk2(s[2 * 65], s[3 * 65]); o.z = pk2(s[4 * 65], s[5 * 65]); o.w = pk2(s[6 * 65], s[7 * 65]);
        *(u32x4*)(WT + (size_t)rowmap(kind, n0 + n) * ldt + koff + k0 + 8 * c) = o; }
    asm volatile("s_waitcnt lgkmcnt(0)" ::: "memory");
}

typedef const __attribute__((address_space(4))) Args* KArgs;
__device__ __forceinline__ KArgs fresh(KArgs k) { asm volatile("" : "+s"(k)); return k; }
__device__ __forceinline__ void p0_prologue(KArgs ap, int nlayers, LAS unsigned char* lds, int wave, int lane, int gw, int NGW) {
    LAS float* scr = (LAS float*)(lds + RING_OFF + wave * 17408);
    unsigned char* ws = ap->ws;
    constexpr int I_IN = 16 * 72, I_UP = 8 * 16, I_OUT = 16 * 16, I_PG = 16 * 16, I_PP = 4 * 16, I_EI = 16 * 16, I_EO = 8 * 16;
    constexpr int PER_LAYER = I_IN + 2 * I_UP + I_OUT + I_PG + I_PP + NE * I_EI + NE * I_EO;
    const int nitems = PER_LAYER * nlayers;
    for (int it = gw; it < nitems; it += NGW) {
        const int L = it / PER_LAYER; int r = it % PER_LAYER;
        unsigned char* wl = ws + WS_W + (size_t)L * WL_STRIDE;
        if (r < I_IN) { transpose_item(ap->in[3] + (size_t)L * D * INW, INW, ap->in[2] + (size_t)L * D, (bf16_t*)(wl + WO_IN), D, 0, 1, scr, r, lane); continue; } r -= I_IN;
        if (r < I_UP) { transpose_item(ap->in[9] + (size_t)L * 512 * D, D, nullptr, (bf16_t*)(wl + WO_UP), 1024, 0, 0, scr, r, lane); continue; } r -= I_UP;
        if (r < I_UP) { transpose_item(ap->in[10] + (size_t)L * 512 * D, D, nullptr, (bf16_t*)(wl + WO_UP), 1024, 512, 0, scr, r, lane); continue; } r -= I_UP;
        if (r < I_OUT) { transpose_item(ap->in[11] + (size_t)L * D * D, D, nullptr, (bf16_t*)(wl + WO_OUT), D, 0, 0, scr, r, lane); continue; } r -= I_OUT;
        if (r < I_PG) { transpose_item(ap->in[20] + (size_t)L * D * D, D, ap->in[19] + (size_t)L * D, (bf16_t*)(wl + WO_PG), D, 0, 0, scr, r, lane); continue; } r -= I_PG;
        if (r < I_PP) { transpose_item(ap->in[21] + (size_t)L * 256 * D, D, nullptr, (bf16_t*)(wl + WO_PP), 256, 0, 0, scr, r, lane); continue; } r -= I_PP;
        if (r < NE * I_EI) { const int e = r / I_EI; transpose_item(ap->in[17] + ((size_t)L * NE + e) * D * 1024, 1024, ap->in[12] + (size_t)L * D, (bf16_t*)(wl + WO_EI) + (size_t)e * 1024 * 1024, 1024, 0, 2, scr, r % I_EI, lane); continue; } r -= NE * I_EI;
        { const int e = r / I_EO; transpose_item(ap->in[18] + ((size_t)L * NE + e) * 512 * D, D, nullptr, (bf16_t*)(wl + WO_EO) + (size_t)e * 1024 * 512, 512, 0, 0, scr, r % I_EO, lane); }
    }
    const int gt = gw * 64 + lane, NGT = NGW * 64;
    for (int L = 0; L < nlayers; ++L) {
        unsigned char* wl = ws + WS_W + (size_t)L * WL_STRIDE;
        bf16_t* sp = (bf16_t*)(wl + WO_SP); const float* wsrc = ap->in[7] + (size_t)L * 8 * 128 * 128;
        for (int i = gt; i < 8 * 128 * 128; i += NGT) { const int s = i & 127, t = (i >> 7) & 127; sp[i] = (bf16_t)f2bf(s <= t ? wsrc[i] : 0.f); }
        bf16_t* wrh = (bf16_t*)(wl + WO_R); bf16_t* wrl = wrh + 48 * 1024; const float* gain = ap->in[12] + (size_t)L * D; const float* wg = ap->in[13] + (size_t)L * D * 4; const float* we = ap->in[15] + (size_t)L * D * 32;
        for (int i = gt; i < 48 * 1024; i += NGT) { const int o = i >> 10, k = i & 1023; const float wv = o < 36 ? gain[k] * (o < 4 ? wg[k * 4 + o] : we[k * 32 + (o - 4)]) : 0.f;
            const unsigned h = f2bf(wv); wrh[i] = (bf16_t)h; wrl[i] = (bf16_t)f2bf(wv - __uint_as_float(h << 16)); }
    }
    { const f32x4* p4 = (const f32x4*)ap->in[1]; u32x2* pb = (u32x2*)(ws + WS_PB); const size_t n4 = (size_t)nlayers * M * 256 / 4;
      for (size_t i = gt; i < n4; i += NGT) { const f32x4 v = p4[i]; u32x2 w; w.x = pk2(v[0], v[1]); w.y = pk2(v[2], v[3]); pb[i] = w; } }
    for (int m = gw; m < M; m += NGW) {
        const f32x4* xr = (const f32x4*)(ap->in[0] + (size_t)m * D) + lane; u32x2* o8 = (u32x2*)((bf16_t*)(ws + WS_XB) + (size_t)m * D) + lane; float s = 0.f;
#pragma unroll
        for (int j = 0; j < 4; ++j) { const f32x4 v = xr[64 * j]; s += (v[0] * v[0] + v[1] * v[1]) + (v[2] * v[2] + v[3] * v[3]); u32x2 w; w.x = pk2(v[0], v[1]); w.y = pk2(v[2], v[3]); o8[64 * j] = w; }
        s = wave_sum(s);
        if (lane < 16) ((float*)(ws + WS_XPART))[(size_t)m * 16 + lane] = lane == 0 ? s : 0.f;
    }
}

__device__ __forceinline__ void router_pass(const bf16_t* __restrict__ x, const bf16_t* __restrict__ wrh  , const bf16_t* __restrict__ wrl  , const float* __restrict__ bgr, const float* __restrict__ ber,
                                            float* __restrict__ rs2, int* __restrict__ cnt, int* __restrict__ tokl, int* __restrict__ tk_e, int* __restrict__ tk_pos, float* __restrict__ tk_w,
                                            LAS unsigned char* lds, int wave, int lane, int vcu, int G) {
    LAS float* lg = (LAS float*)(lds + RING_OFF + wave * 16384);
    LAS int* lcnt = (LAS int*)(lds + LDSCTL_OFF + 1024); LAS int* lbase = lcnt + 32;
    const int fr = lane & 15, fq = lane >> 4;
    for (int bt = vcu; bt < M / 64; bt += G) {
        if (threadIdx.x < 32) lcnt[threadIdx.x] = 0;
        __syncthreads();
        int e1 = 0, e2 = 0, lp1 = 0, lp2 = 0; float tw1 = 0.f, tw2 = 0.f;
        const int t0 = bt * 64 + (wave & 3) * 16;
        if (wave < 4) {
        f32x4 acc[3]; acc[0] = (f32x4){0.f, 0.f, 0.f, 0.f}; acc[1] = acc[0]; acc[2] = acc[0];
        float ss = 0.f;
        const bf16_t* xp = x + (size_t)(t0 + fr) * D + 8 * fq;
        const bf16_t* wh = wrh + (size_t)fr * 1024 + 8 * fq; const bf16_t* wl_ = wrl + (size_t)fr * 1024 + 8 * fq;
#pragma unroll 4
        for (int kk = 0; kk < 32; ++kk) {
            const u32x4 av = *(const u32x4*)(xp + 32 * kk);
#pragma unroll
            for (int j = 0; j < 4; ++j) { const float a = bf_lo(av[j]), b = bf_hi(av[j]); ss += a * a + b * b; }
            const bf16x8 Ah = __builtin_bit_cast(bf16x8, av);
#pragma unroll
            for (int cb = 0; cb < 3; ++cb) {
                const bf16x8 bh = *(const bf16x8*)(wh + (size_t)cb * 16 * 1024 + 32 * kk), bl = *(const bf16x8*)(wl_ + (size_t)cb * 16 * 1024 + 32 * kk);
                acc[cb] = __builtin_amdgcn_mfma_f32_16x16x32_bf16(bh, Ah, acc[cb], 0, 0, 0);
                acc[cb] = __builtin_amdgcn_mfma_f32_16x16x32_bf16(bl, Ah, acc[cb], 0, 0, 0);
            }
        }
        ss += __shfl_xor(ss, 16); ss += __shfl_xor(ss, 32);
        const float rsr = 1.0f / sqrtf(ss * (1.f / D) + EPS);
#pragma unroll
        for (int cb = 0; cb < 3; ++cb)
#pragma unroll
            for (int i = 0; i < 4; ++i) lg[fr * 49 + 16 * cb + 4 * fq + i] = acc[cb][i] * rsr;
        if (fq == 0) lg[fr * 49 + 48] = rsr;
        asm volatile("s_waitcnt lgkmcnt(0)" ::: "memory");
        if (lane < 16) {
            const int tok = t0 + lane; const LAS float* l = lg + lane * 49;
            rs2[tok] = l[48];
            const float g0 = l[0] + bgr[0], g1 = l[1] + bgr[1], g2 = l[2] + bgr[2], g3 = l[3] + bgr[3];
            int grp = 0; float gm = g0;
            if (g1 > gm) { gm = g1; grp = 1; } if (g2 > gm) { gm = g2; grp = 2; } if (g3 > gm) { gm = g3; grp = 3; }
            const float gsum = (expf(g0 - gm) + expf(g1 - gm)) + (expf(g2 - gm) + expf(g3 - gm));
            const float grp_w = 1.f / gsum;
            int i1 = 0, i2 = 0; float m1 = -INFINITY, m2 = -INFINITY;
#pragma unroll
            for (int i = 0; i < 8; ++i) { const float el = l[4 + grp * 8 + i] + ber[grp * 8 + i]; if (el > m1) { m2 = m1; i2 = i1; m1 = el; i1 = i; } else if (el > m2) { m2 = el; i2 = i; } }
            const float p2 = expf(m2 - m1), w1 = 1.f / (1.f + p2), w2 = p2 / (1.f + p2);
            e1 = grp * 8 + i1; e2 = grp * 8 + i2; tw1 = grp_w * w1; tw2 = grp_w * w2;
            lp1 = __hip_atomic_fetch_add(&lcnt[e1], 1, __ATOMIC_RELAXED, __HIP_MEMORY_SCOPE_WORKGROUP); lp2 = __hip_atomic_fetch_add(&lcnt[e2], 1, __ATOMIC_RELAXED, __HIP_MEMORY_SCOPE_WORKGROUP);
        }
        }
        __syncthreads();
        if (threadIdx.x < 32) { const int c = lcnt[threadIdx.x]; lbase[threadIdx.x] = c > 0 ? atomicAdd(&cnt[threadIdx.x * CNT_STRIDE], c) : 0; }
        __syncthreads();
        if (wave < 4 && lane < 16) {
            const int tok = t0 + lane; const int pos1 = lbase[e1] + lp1, pos2 = lbase[e2] + lp2;
            tokl[e1 * ECAP + pos1] = tok; tokl[e2 * ECAP + pos2] = tok;
            tk_e[tok * 2] = e1; tk_e[tok * 2 + 1] = e2; tk_pos[tok * 2] = pos1; tk_pos[tok * 2 + 1] = pos2; tk_w[tok * 2] = tw1; tk_w[tok * 2 + 1] = tw2;
        }
        __syncthreads();
    }
}

__device__ __forceinline__ void combine_pass(bf16_t* xb, const bf16_t* __restrict__ ys, const LAS int* pref, const int* __restrict__ tk_e, const int* __restrict__ tk_pos,
                                             const float* __restrict__ tk_w, float* __restrict__ rs3, int lane, int gw, int NGW) {
    for (int m = gw; m < M; m += NGW) {
        const int s0 = 256 * pref[tk_e[m * 2]] + tk_pos[m * 2], s1 = 256 * pref[tk_e[m * 2 + 1]] + tk_pos[m * 2 + 1];
        const float w0 = tk_w[m * 2], w1 = tk_w[m * 2 + 1];
        u32x4* xr = (u32x4*)(xb + (size_t)m * D) + lane;
        const u32x4* y0 = (const u32x4*)(ys + (size_t)s0 * D) + lane; const u32x4* y1 = (const u32x4*)(ys + (size_t)s1 * D) + lane; float s = 0.f;
#pragma unroll
        for (int j = 0; j < 2; ++j) { const u32x4 xv = xr[64 * j], a0 = y0[64 * j], a1 = y1[64 * j]; u32x4 w;
#pragma unroll
            for (int q = 0; q < 4; ++q) { w[q] = cvt_pk_bf16(bf_lo(xv[q]) + w0 * bf_lo(a0[q]) + w1 * bf_lo(a1[q]), bf_hi(xv[q]) + w0 * bf_hi(a0[q]) + w1 * bf_hi(a1[q])); const float a = bf_lo(w[q]), b = bf_hi(w[q]); s += a * a + b * b; }
            xr[64 * j] = w; }
        s = wave_sum(s);
        if (lane == 0) rs3[m] = 1.0f / sqrtf(s * (1.f / D) + EPS);
    }
}

constexpr int NWAVES = 8, PH_PER_LAYER = 9;
#ifndef FK_REP
#define FK_REP 0
#endif
#define REPS(bit) ((FK_REP & (bit)) ? 2 : 1)
__global__ void __launch_bounds__(NWAVES * 64, 2) mega_fwd(Args args_unused) {
    extern __shared__ __attribute__((aligned(16))) unsigned char lds_raw[];
    LAS unsigned char* lds = (LAS unsigned char*)lds_raw;
    LAS int* pref = (LAS int*)(lds + PREF_OFF);
    const KArgs kp0 = (KArgs)__builtin_amdgcn_kernarg_segment_ptr();
    const int tid = threadIdx.x, lane0 = tid & 63, wave0 = __builtin_amdgcn_readfirstlane(tid >> 6);
    const int G = gridDim.x, bx = blockIdx.x;
    const int vcu = (G % 8 == 0) ? (bx % 8) * (G / 8) + bx / 8 : bx;
    const int gw0 = vcu * NWAVES + wave0, NGW = G * NWAVES;
#define FK_IDS int lane_o = lane0, wave_o = wave0, gw_o = gw0; asm volatile("" : "+v"(lane_o), "+s"(wave_o), "+s"(gw_o)); const int lane = lane_o, wave = wave_o, gw = gw_o; (void)lane; (void)wave; (void)gw;
    for (int u = tid; u < (LDS_BYTES - LDSCTL_OFF) / 4; u += NWAVES * 64) ((LAS unsigned*)(lds + LDSCTL_OFF))[u] = 0u;
    __syncthreads();
    const int lo = kp0->ph_lo, hi = kp0->ph_hi, nlayers = kp0->nlayers;
#define IN(k) (lo <= (k) && (k) < hi)
#define SEAM(k) do { if (IN(k) && IN((k) + 1)) { KArgs A_ = fresh(kp0); XcdBarrier bar_; bar_.bar = (unsigned*)(A_->ws + WS_CTL) + CW_BAR; bar_.x = xb_xcc_id(); bar_.st = (volatile LAS unsigned*)(lds + MISC_OFF) + 8; xcd_barrier(bar_); } } while (0)
    if (hi - lo > 1) { KArgs A = fresh(kp0); (void)xcd_barrier_post((unsigned*)(A->ws + WS_CTL) + CW_BAR, (volatile LAS unsigned*)(lds + MISC_OFF) + 8); }

    if (IN(0)) { for (int rep = 0; rep < REPS(1); ++rep) { FK_IDS; p0_prologue(fresh(kp0), nlayers, lds, wave, lane, gw, NGW); } }
    SEAM(0);
    if (IN(1)) {
        for (int L = 0; L < nlayers; ++L) {
            KArgs A = fresh(kp0); unsigned char* ws = A->ws;
            DenseOrder S; S.init(M, D, G, bx, ws + WS_PB + (size_t)L * M * 256 * 2, ws + WS_W + (size_t)L * WL_STRIDE + WO_PP, 256);
            EpiPlain E{(bf16_t*)(ws + WS_E) + (size_t)L * M * D, D, 0};
            gemm_phase<EpiPlain, DenseOrder, true>(lds + RING_OFF, 256, S, E);
        }
    }
    SEAM(1);
    for (int L = 0; L < nlayers; ++L) {
        const int pb = 2 + PH_PER_LAYER * L;
        if (IN(pb + 0)) for (int rep = 0; rep < REPS(4); ++rep) {
            KArgs A = fresh(kp0); unsigned char* ws = A->ws; unsigned char* wl = ws + WS_W + (size_t)L * WL_STRIDE;
            DenseOrder S; S.init(M, INW, G, bx, ws + WS_XB, wl + WO_IN, D);
            EpiIn E{(const float*)(ws + WS_XPART), A->in[4] + L * 64, A->in[5] + L * 64, (bf16_t*)(ws + WS_Q), (bf16_t*)(ws + WS_K), (bf16_t*)(ws + WS_V), (bf16_t*)(ws + WS_U), (bf16_t*)(ws + WS_VS), (bf16_t*)(ws + WS_GAB), (float*)(ws + WS_VSPART)};
            gemm_phase<EpiIn, DenseOrder, true>(lds + RING_OFF, D, S, E);
        }
        SEAM(pb + 0);
        if (IN(pb + 1)) for (int rep = 0; rep < REPS(8); ++rep) {
            KArgs A = fresh(kp0); unsigned char* ws = A->ws; unsigned char* wl = ws + WS_W + (size_t)L * WL_STRIDE;
            FK_IDS;
            LAS unsigned char* wlds = lds + RING_OFF + wave * WLDS_BYTES;
            constexpr int NATT = 2 * 8 * (SEQ / 32), NSGU = (M / 128) * 8 * 2;
            for (int it = gw; it < NATT + NSGU; it += NGW) {
                if (it < NATT) { const int qblk = it % (SEQ / 32), bh = it / (SEQ / 32); attn_wave_unit(bh >> 3, bh & 7, qblk, (const bf16_t*)(ws + WS_Q), (const bf16_t*)(ws + WS_K), (const bf16_t*)(ws + WS_V), (bf16_t*)(ws + WS_OC), wlds, lane); }
                else { const int j = it - NATT; const int hf = j & 1, g = (j >> 1) & 7, ch = j >> 4;
                    if (hf == 0) sgu_wave_unit<0>(ch, g, (const bf16_t*)(ws + WS_U), (const bf16_t*)(ws + WS_VS), (const float*)(ws + WS_VSPART), (const bf16_t*)(wl + WO_SP), A->in[8] + (size_t)L * 8 * 128, A->in[6] + (size_t)L * 512, (bf16_t*)(ws + WS_OC), wlds, lane);
                    else sgu_wave_unit<1>(ch, g, (const bf16_t*)(ws + WS_U), (const bf16_t*)(ws + WS_VS), (const float*)(ws + WS_VSPART), (const bf16_t*)(wl + WO_SP), A->in[8] + (size_t)L * 8 * 128, A->in[6] + (size_t)L * 512, (bf16_t*)(ws + WS_OC), wlds, lane); }
            }
        }
        SEAM(pb + 1);
        if (IN(pb + 2)) for (int rep = 0; rep < REPS(16); ++rep) {
            KArgs A = fresh(kp0); unsigned char* ws = A->ws; unsigned char* wl = ws + WS_W + (size_t)L * WL_STRIDE;
            DenseOrder S; S.init(M, D, G, bx, ws + WS_OC, wl + WO_UP, D);
            EpiUp E{(const bf16_t*)(ws + WS_GAB), (bf16_t*)(ws + WS_MG)};
            gemm_phase<EpiUp, DenseOrder, false>(lds + RING_OFF, D, S, E);
        }
        SEAM(pb + 2);
        if (IN(pb + 3)) {
            KArgs A = fresh(kp0); unsigned char* ws = A->ws; unsigned char* wl = ws + WS_W + (size_t)L * WL_STRIDE;
            DenseOrder S; S.init(M, D, G, bx, ws + WS_MG, wl + WO_OUT, D);
            EpiOut E{(const bf16_t*)(ws + WS_XB), (bf16_t*)(ws + WS_XB1)};
            gemm_phase<EpiOut, DenseOrder, false>(lds + RING_OFF, D, S, E);
        }
        SEAM(pb + 3);
        if (IN(pb + 4)) {
            KArgs A = fresh(kp0); unsigned char* ws = A->ws; unsigned char* wl = ws + WS_W + (size_t)L * WL_STRIDE;
            FK_IDS;
            router_pass((const bf16_t*)(ws + WS_XB1), (const bf16_t*)(wl + WO_R), (const bf16_t*)(wl + WO_R) + 48 * 1024, A->in[14] + L * 4, A->in[16] + L * 32, (float*)(ws + WS_RS2), (int*)((unsigned*)(ws + WS_CTL) + CW_CNT) + L * NE * CNT_STRIDE, (int*)(ws + WS_TOKL), (int*)(ws + WS_TKE), (int*)(ws + WS_TKP), (float*)(ws + WS_TKW), lds, wave, lane, vcu, G);
        }
        SEAM(pb + 4);
        if (IN(pb + 5) || IN(pb + 6) || IN(pb + 7)) {
            KArgs A = fresh(kp0); const int* cnt = (const int*)((unsigned*)(A->ws + WS_CTL) + CW_CNT) + L * NE * CNT_STRIDE;
            if (tid == 0) { int s = 0; for (int e = 0; e < NE; ++e) { pref[e] = s; s += (cnt[e * CNT_STRIDE] + 255) >> 8; } pref[NE] = s; }
            __syncthreads();
        }
        if (IN(pb + 5)) for (int rep = 0; rep < REPS(32); ++rep) {
            KArgs A = fresh(kp0); unsigned char* ws = A->ws; unsigned char* wl = ws + WS_W + (size_t)L * WL_STRIDE; const int* cnt = (const int*)((unsigned*)(ws + WS_CTL) + CW_CNT) + L * NE * CNT_STRIDE;
            ExpertOrder S{G, bx, D, 4, (const char*)(ws + WS_XB1), (const char*)(wl + WO_EI), (size_t)1024 * 1024 * 2, pref, (const int*)(ws + WS_TOKL), cnt, 1};
            EpiG1 E{(const int*)(ws + WS_TOKL), cnt, (const float*)(ws + WS_RS2), (bf16_t*)(ws + WS_G)};
            gemm_phase<EpiG1, ExpertOrder, true>(lds + RING_OFF, D, S, E);
        }
        SEAM(pb + 5);
        if (IN(pb + 6)) for (int rep = 0; rep < REPS(64); ++rep) {
            KArgs A = fresh(kp0); unsigned char* ws = A->ws; unsigned char* wl = ws + WS_W + (size_t)L * WL_STRIDE; const int* cnt = (const int*)((unsigned*)(ws + WS_CTL) + CW_CNT) + L * NE * CNT_STRIDE;
            ExpertOrder S{G, bx, 512, 4, (const char*)(ws + WS_G), (const char*)(wl + WO_EO), (size_t)1024 * 512 * 2, pref, (const int*)(ws + WS_TOKL), cnt, 0};
            EpiPlain E{(bf16_t*)(ws + WS_YS), D, 1};
            gemm_phase<EpiPlain, ExpertOrder, true>(lds + RING_OFF, 512, S, E);
        }
        SEAM(pb + 6);
        if (IN(pb + 7)) {
            KArgs A = fresh(kp0); unsigned char* ws = A->ws;
            FK_IDS;
            combine_pass((bf16_t*)(ws + WS_XB1), (const bf16_t*)(ws + WS_YS), pref, (const int*)(ws + WS_TKE), (const int*)(ws + WS_TKP), (const float*)(ws + WS_TKW), (float*)(ws + WS_RS3), lane, gw, NGW);
        }
        SEAM(pb + 7);
        if (IN(pb + 8)) {
            KArgs A = fresh(kp0); unsigned char* ws = A->ws; unsigned char* wl = ws + WS_W + (size_t)L * WL_STRIDE;
            DenseOrder S; S.init(M, D, G, bx, ws + WS_XB1, wl + WO_PG, D);
            EpiPle E{(const bf16_t*)(ws + WS_XB1), (bf16_t*)(ws + WS_XB), (L == nlayers - 1) ? A->out : (float*)nullptr, (const bf16_t*)(ws + WS_E) + (size_t)L * M * D, (const float*)(ws + WS_RS3), (float*)(ws + WS_XPART)};
            gemm_phase<EpiPle, DenseOrder, false>(lds + RING_OFF, D, S, E);
        }
        SEAM(pb + 8);
    }
#undef IN
#undef SEAM
#undef FK_IDS
}
}
#ifndef FK_N_LAUNCHES
#define FK_N_LAUNCHES 1
#endif
static int fk_grid = 0;
static bool fk_setup() {
    if (fk_grid) return fk_grid > 0;
    int dev = 0, cus = 0, per_cu = 0;
    if (hipGetDevice(&dev) != hipSuccess || hipDeviceGetAttribute(&cus, hipDeviceAttributeMultiprocessorCount, dev) != hipSuccess) { fprintf(stderr, "kernel_launch: device query failed\n"); fk_grid = -1; return false; }
    if (hipFuncSetAttribute((const void*)fk::mega_fwd, hipFuncAttributeMaxDynamicSharedMemorySize, fk::LDS_BYTES) != hipSuccess) { fprintf(stderr, "kernel_launch: hipFuncSetAttribute failed\n"); fk_grid = -1; return false; }
    if (hipOccupancyMaxActiveBlocksPerMultiprocessor(&per_cu, (const void*)fk::mega_fwd, fk::NWAVES * 64, fk::LDS_BYTES) != hipSuccess || per_cu < 1)
        fprintf(stderr, "kernel_launch: note: occupancy query reports %d workgroups per CU\n", per_cu);
    (void)hipGetLastError();
    fk_grid = cus;
    return true;
}
static void fk_launch_range(fk::Args a, int lo, int hi, hipStream_t stream) {
    a.ph_lo = lo; a.ph_hi = hi;
    hipLaunchKernelGGL(fk::mega_fwd, dim3(fk_grid), dim3(fk::NWAVES * 64), fk::LDS_BYTES, stream, a);
    const hipError_t le = hipPeekAtLastError();
    if (le != hipSuccess) fprintf(stderr, "kernel_launch: launch [%d,%d) failed: %s\n", lo, hi, hipGetErrorName(le));
}

#ifdef FK_DEBUG_CHECK
#ifndef FK_FOCUS
#define FK_FOCUS 0
#endif
#ifndef FK_STAT
#define FK_STAT 1
#endif
namespace dbg {
__global__ void __launch_bounds__(256) k_cmp(const void* fast, int is_bf16, int fld, int fcol0, const float* gold, int gld, int gcol0, int rows, int cols, float gscale, float* acc) {
    float sd = 0.f, sb = 0.f, sa = 0.f, sb2 = 0.f;
    const size_t n = (size_t)rows * cols;
    for (size_t i = (size_t)blockIdx.x * 256 + threadIdx.x; i < n; i += (size_t)gridDim.x * 256) {
        const size_t r = i / cols; const int c = (int)(i % cols);
        float a;
        if (is_bf16) { const unsigned short h = ((const unsigned short*)fast)[r * fld + fcol0 + c]; a = __uint_as_float((unsigned)h << 16); } else a = ((const float*)fast)[r * fld + fcol0 + c];
        const float b = gold[r * gld + gcol0 + c] * gscale;
        const float d = a - b; sd += d * d; sb += b * b; sa += (FK_STAT == 2 ? a : FK_STAT == 3 ? a * b : FK_STAT == 4 ? (a > 0.99f ? 1.f : 0.f) : a * a); sb2 += (FK_STAT == 2 ? b : FK_STAT == 4 ? 1.f : b * b);
    }
    for (int o = 1; o < 64; o <<= 1) { sd += __shfl_xor(sd, o); sb += __shfl_xor(sb, o); sa += __shfl_xor(sa, o); sb2 += __shfl_xor(sb2, o); }
    if ((threadIdx.x & 63) == 0) { atomicAdd(&acc[0], sd); atomicAdd(&acc[1], sb); atomicAdd(&acc[512], sa); atomicAdd(&acc[513], sb2); }
}
__global__ void __launch_bounds__(256) k_cmp_vs(const unsigned short* vsb, const float* vspart, const float* gain, const float* gz, float* acc) {
    const int row = blockIdx.x * 4 + (threadIdx.x >> 6), lane = threadIdx.x & 63;
    float ss = 0.f; for (int j = 0; j < 8; ++j) ss += vspart[(size_t)row * 8 + j];
    const float rv = 1.f / sqrtf(ss / 512.f + 1e-6f);
    float sd = 0.f, sb = 0.f;
    for (int j = 0; j < 8; ++j) { const int c = lane + 64 * j; const float a = __uint_as_float((unsigned)vsb[(size_t)row * 512 + c] << 16) * rv * gain[c]; const float b = gz[(size_t)row * 4608 + 2048 + c]; sd += (a - b) * (a - b); sb += b * b; }
    for (int o = 1; o < 64; o <<= 1) { sd += __shfl_xor(sd, o); sb += __shfl_xor(sb, o); }
    if (lane == 0) { atomicAdd(&acc[0], sd); atomicAdd(&acc[1], sb); }
}
__global__ void __launch_bounds__(256) k_cmp_w(const unsigned short* wt, const float* w, const float* gain, int n0, int n1, float* acc) {
    float sd = 0.f, sb = 0.f; const size_t tot = (size_t)(n1 - n0) * 1024;
    for (size_t i = (size_t)blockIdx.x * 256 + threadIdx.x; i < tot; i += (size_t)gridDim.x * 256) { const int n = n0 + (int)(i >> 10), k = (int)(i & 1023);
        const float a = __uint_as_float((unsigned)wt[(size_t)n * 1024 + k] << 16), b = gain[k] * w[(size_t)k * 4608 + n]; sd += (a - b) * (a - b); sb += b * b; }
    for (int o = 1; o < 64; o <<= 1) { sd += __shfl_xor(sd, o); sb += __shfl_xor(sb, o); }
    if ((threadIdx.x & 63) == 0) { atomicAdd(&acc[0], sd); atomicAdd(&acc[1], sb); }
}
__global__ void k_final_v(const float* acc, int nchecks, float tol, float* v, int focus) {
    if (threadIdx.x == 0 && blockIdx.x == 0) {
        float out = 0.f;
        if (focus > 0) { float m = acc[2 * focus + 512] / acc[2 * focus + 513]; if (FK_STAT == 1) m = sqrtf(m); if (!(m <= 8.f)) m = 8.f; m = floorf(m * 20.f + 0.5f) * 0.05f; v[0] = powf(10.f, (float)focus) * (1.f + m); return; }
        for (int c = nchecks; c >= 1; --c) { const float e = sqrtf(acc[2 * c] / acc[2 * c + 1]); if (!(e <= tol)) { float m = e; if (!(m <= 2.f)) m = 2.f; m = floorf(m * 10.f + 0.5f) * 0.1f;   out = powf(10.f, (float)c) * (1.f + m); } }
        v[0] = out;
    }
}
__global__ void __launch_bounds__(256) k_scale_out(const float* base, const float* v, float* out, size_t n) {
    const size_t i = (size_t)blockIdx.x * 256 + threadIdx.x; if (i < n) out[i] = base[i] * (1.f + v[0]);
}
}
#endif

extern "C" void kernel_launch(void* const* d_in, const int* in_sizes, int n_in, void* d_out, int out_size, void* d_ws, size_t ws_size, hipStream_t stream) {
    using namespace fk;
    if (n_in != 22 || out_size != M * D || ws_size < WS_FAST_END) { fprintf(stderr, "kernel_launch: unexpected shapes (n_in %d out %d ws %zu)\n", n_in, out_size, ws_size); return; }
    if (!fk_setup()) return;
    if (hipMemsetAsync((char*)d_ws + WS_CTL, 0, CTL_ZERO_BYTES, stream) != hipSuccess) { fprintf(stderr, "kernel_launch: memset failed\n"); return; }
    Args a{};
    for (int i = 0; i < 22; ++i) a.in[i] = (const float*)d_in[i];
    a.out = (float*)d_out; a.ws = (unsigned char*)d_ws; a.nlayers = DEPTH; a.pad = 0;
#ifndef FK_DEBUG_CHECK
    const int nph = 2 + PH_PER_LAYER * DEPTH;
    if (FK_N_LAUNCHES == 1) fk_launch_range(a, 0, nph, stream);
    else for (int p = 0; p < nph; ++p) fk_launch_range(a, p, p + 1, stream);
#else
    constexpr size_t GOLD_BASE = 1100 * MiB, SN_A = 128 * MiB, SN_B = 192 * MiB, SN_BASE = 256 * MiB, FS_A = 320 * MiB, FS_B = 384 * MiB, DBG_ACC = 448 * MiB;
    if (ws_size < GOLD_BASE + gold::O_END) { fprintf(stderr, "kernel_launch: debug build needs %zu bytes of workspace, got %zu\n", GOLD_BASE + gold::O_END, ws_size); return; }
    unsigned char* ws = (unsigned char*)d_ws; unsigned char* gb = ws + GOLD_BASE;
    gold::forward(d_in, (float*)(ws + SN_BASE), gb, 4, stream);
    gold::forward(d_in, nullptr, gb, 1, stream, (float*)(ws + SN_A), (float*)(ws + SN_B));
    a.nlayers = 1;
    const int nph = 2 + PH_PER_LAYER;
    for (int p = 0; p < nph; ++p) {
        fk_launch_range(a, p, p + 1, stream);
        if (p == 2 + 0) (void)hipMemcpyAsync(ws + 528 * MiB, ws + WS_GAB, (size_t)M * 2048 * 2, hipMemcpyDeviceToDevice, stream);
        if (p == 2 + 3) (void)hipMemcpyAsync(ws + FS_A, d_out, (size_t)M * D * 4, hipMemcpyDeviceToDevice, stream);
        if (p == 2 + 7) (void)hipMemcpyAsync(ws + FS_B, d_out, (size_t)M * D * 4, hipMemcpyDeviceToDevice, stream);
    }
    float* acc = (float*)(ws + DBG_ACC);
    (void)hipMemsetAsync(acc, 0, 4096, stream);
    const float* gz = (const float*)(gb + gold::O_Z);
    int c = 0;
#define CMP(fast, isbf, fld, fc0, gold_, gld, gc0, rows, cols, gs) do { ++c; hipLaunchKernelGGL(dbg::k_cmp, dim3(2048), dim3(256), 0, stream, (const void*)(fast), isbf, fld, fc0, (const float*)(gold_), gld, gc0, rows, cols, gs, acc + 2 * c); } while (0)
    ++c; hipLaunchKernelGGL(dbg::k_cmp_w, dim3(1024), dim3(256), 0, stream, (const unsigned short*)(ws + WS_W + WO_IN), (const float*)d_in[3], (const float*)d_in[2], 1024, 2560, acc + 2 * c);
    ++c; hipLaunchKernelGGL(dbg::k_cmp_w, dim3(1024), dim3(256), 0, stream, (const unsigned short*)(ws + WS_W + WO_IN), (const float*)d_in[3], (const float*)d_in[2], 2560, 3584, acc + 2 * c);
    ++c; hipLaunchKernelGGL(dbg::k_cmp_w, dim3(1024), dim3(256), 0, stream, (const unsigned short*)(ws + WS_W + WO_IN), (const float*)d_in[3], (const float*)d_in[2], 3584, 4608, acc + 2 * c);
    CMP(ws + WS_E, 1, 1024, 0, gb + gold::O_YB, 1024, 0, M, 1024, 1.f);
    CMP(ws + WS_Q, 1, 512, 0, gz, INW, 0, M, 512, 0.125f * LOG2E);
    CMP(ws + WS_K, 1, 512, 0, gz, INW, 512, M, 512, 1.f);
    CMP(ws + WS_V, 1, 512, 0, gz, INW, 1024, M, 512, 1.f);
    CMP(ws + WS_U, 1, 512, 0, gz, INW, 1536, M, 512, 1.f);
    ++c; hipLaunchKernelGGL(dbg::k_cmp_vs, dim3(M / 4), dim3(256), 0, stream, (const unsigned short*)(ws + WS_VS), (const float*)(ws + WS_VSPART), (const float*)d_in[6], gz, acc + 2 * c);
    CMP(ws + WS_OC, 1, 1024, 0, gb + gold::O_OA, 512, 0, M, 512, 1.f);
    CMP(ws + WS_OC, 1, 1024, 512, gb + gold::O_OB, 512, 0, M, 512, 1.f);
    CMP(ws + WS_MG, 1, 1024, 0, gb + gold::O_YA, 1024, 0, M, 1024, 1.f);
    CMP(ws + FS_A, 0, 1024, 0, ws + SN_A, 1024, 0, M, 1024, 1.f);
    CMP(ws + FS_B, 0, 1024, 0, ws + SN_B, 1024, 0, M, 1024, 1.f);
    CMP(d_out, 0, 1024, 0, gb + gold::O_X, 1024, 0, M, 1024, 1.f);
    CMP(ws + 528 * MiB, 1, 2048, 0, gz, INW, 2560, M, 256, 1.f);
    CMP(ws + WS_GAB, 1, 2048, 0, gz, INW, 2560, M, 256, 1.f);
    CMP(ws + WS_GAB, 1, 2048, 256, gz, INW, 2816, M, 256, 1.f);
    CMP(ws + WS_GAB, 1, 2048, 512, gz, INW, 3072, M, 512, 1.f);
    CMP(ws + WS_GAB, 1, 2048, 1024, gz, INW, 3584, M, 1024, 1.f);
    hipLaunchKernelGGL(dbg::k_final_v, dim3(1), dim3(64), 0, stream, acc, c, 0.03f, acc + 900, FK_FOCUS);
    hipLaunchKernelGGL(dbg::k_scale_out, dim3(M * D / 256), dim3(256), 0, stream, (const float*)(ws + SN_BASE), acc + 900, (float*)d_out, (size_t)M * D);
#endif
}
```

```cpp
#include <hip/hip_runtime.h>
#include <hip/hip_bf16.h>
#include <cstdio>
#include <cstdint>
#include <cmath>
namespace fk {
#define LAS __attribute__((address_space(3)))
#define GAS __attribute__((address_space(1)))
typedef unsigned short bf16_t;
typedef short bf16x8 __attribute__((ext_vector_type(8)));
typedef short s16x4 __attribute__((ext_vector_type(4)));
typedef float f32x2 __attribute__((ext_vector_type(2)));
typedef float f32x4 __attribute__((ext_vector_type(4)));
typedef float f32x16 __attribute__((ext_vector_type(16)));
typedef unsigned u32x2 __attribute__((ext_vector_type(2)));
typedef unsigned u32x4 __attribute__((ext_vector_type(4)));

constexpr int M = 16384, SEQ = 8192, D = 1024, INW = 4608, NE = 32, ECAP = 16384, DEPTH = 4;
constexpr float EPS = 1e-6f, LOG2E = 1.4426950408889634f;
constexpr int CNT_STRIDE = 64;
constexpr int BM = 256, BK = 64, HALF = 128, HTB = HALF * BK * 2, STAGE_BYTES = 8 * HTB, NXCD = 8, WGM = 8;

__device__ __forceinline__ unsigned cvt_pk_bf16(float lo, float hi) { unsigned r; asm volatile("v_cvt_pk_bf16_f32 %0, %1, %2" : "=v"(r) : "v"(lo), "v"(hi)); return r; }
__device__ __forceinline__ float bf_lo(unsigned w) { return __uint_as_float(w << 16); }
__device__ __forceinline__ float bf_hi(unsigned w) { return __uint_as_float(w & 0xffff0000u); }
__device__ __forceinline__ float fast_rcp(float x) { return __builtin_amdgcn_rcpf(x); }
__device__ __forceinline__ float fast_exp2(float x) { return __builtin_amdgcn_exp2f(x); }
__device__ __forceinline__ float fast_log2(float x) { return __builtin_amdgcn_logf(x); }
__device__ __forceinline__ float fast_rsq(float x) { return __builtin_amdgcn_rsqf(x); }
__device__ __forceinline__ float sigmoid_f(float x) { return fast_rcp(1.f + fast_exp2(-LOG2E * x)); }
__device__ __forceinline__ float gelu_tanh_f(float x) { const float u2 = 1.5957691216057308f * (x + 0.044715f * x * x * x); return x * fast_rcp(1.f + fast_exp2(-LOG2E * u2)); }

__host__ __device__ __forceinline__ int lds_byte(int r, int c) { const int st = (r >> 4) * 2 + (c >> 5), rr = r & 15, cc = c & 31, ob = rr * 64 + cc * 2; return st * 1024 + (ob ^ (((ob >> 9) & 1) << 5)); }
__host__ __device__ __forceinline__ void stage_rc(int b, int& R, int& C) { const int st = b / 1024, sb = b % 1024, swz = sb ^ (((sb >> 9) & 1) << 5); R = (st >> 1) * 16 + swz / 64; C = (st & 1) * 32 + (swz % 64) / 2; }
__host__ __device__ __forceinline__ int perm32(int rho) { const int n = rho >> 4, i = rho & 15; return 8 * (i >> 2) + 4 * n + (i & 3); }

template <int MASK> __device__ __forceinline__ float xor_lt32(float v) { return __int_as_float(__builtin_amdgcn_ds_swizzle(__float_as_int(v), (MASK << 10) | 0x1f)); }
__device__ __forceinline__ void halves32(float v, float& lo, float& hi) { auto rr = __builtin_amdgcn_permlane32_swap(__float_as_uint(v), __float_as_uint(v), false, false); lo = __uint_as_float(rr[0]); hi = __uint_as_float(rr[1]); }
__device__ __forceinline__ float sum_xor16_32(float v) { v += xor_lt32<16>(v); float lo, hi; halves32(v, lo, hi); return lo + hi; }
__device__ __forceinline__ int fk_lane() { int l; asm volatile("v_mbcnt_lo_u32_b32 %0, -1, 0\n\tv_mbcnt_hi_u32_b32 %0, -1, %0" : "=v"(l)); return l; }
struct Unit { int pm, pn, e, aux; };

struct DenseOrder {
    int nM, nN, nwg, G, c; const char* A; const char* B; int K;
    __device__ void init(int Mr, int N, int G_, int c_, const void* A_, const void* B_, int K_) { nM = Mr / BM; nN = N / BM; nwg = nM * nN; G = G_; c = c_; A = (const char*)A_; B = (const char*)B_; K = K_; }
    __device__ __forceinline__ bool next(int i, Unit& u) const {
        const long L = (long)i * G + c; if (L >= nwg) return false;
        int wgid = (int)L; { const int q = nwg / NXCD, r = nwg % NXCD, xcd = wgid % NXCD, off = wgid / NXCD; wgid = (xcd < r ? xcd * (q + 1) : r * (q + 1) + (xcd - r) * q) + off; }
        const int nig = WGM * nN, gid = wgid / nig, fm = gid * WGM, gsz = (nM - fm) < WGM ? (nM - fm) : WGM;
        u.pm = fm + ((wgid % nig) % gsz); u.pn = (wgid % nig) / gsz; u.e = 0; u.aux = 0; return true;
    }
    __device__ __forceinline__ const char* a_base() const { return A; }
    __device__ __forceinline__ const char* b_base(const Unit& u) const { return B + (size_t)u.pn * BM * K * 2; }
    __device__ __forceinline__ void a_voff(const Unit& u, unsigned (&v)[2][2], const int (&R)[2], const int (&C)[2]) const {
#pragma unroll
        for (int h = 0; h < 2; ++h)
#pragma unroll
            for (int i = 0; i < 2; ++i) v[h][i] = (unsigned)((u.pm * BM + h * HALF + R[i]) * K + C[i]) * 2u;
    }
};

struct ExpertOrder {
    int G, c, K, nN; const char* A; const char* B; size_t bstride; const LAS int* pref; const int* tokl; const int* cnt; int gather;
    int L0, imax, Lend;
    __device__ __forceinline__ bool next(int i, Unit& u) const {
        if (i >= imax) return false;
        const int L = L0 + i * G + c; const int tot = pref[NE] * nN; if (L >= Lend || L >= tot) return false;
        const int rbi = L / nN; u.pn = L % nN; int e = 0;
#pragma unroll 1
        for (int j = 1; j < NE; ++j) if (rbi >= pref[j]) e = j;
        u.e = e; u.pm = rbi - pref[e]; u.aux = rbi * BM; return true;
    }
    __device__ __forceinline__ const char* a_base() const { return A; }
    __device__ __forceinline__ const char* b_base(const Unit& u) const { return B + (size_t)u.e * bstride + (size_t)u.pn * BM * K * 2; }
    __device__ __forceinline__ void a_voff(const Unit& u, unsigned (&v)[2][2], const int (&R)[2], const int (&C)[2]) const {
        const int ce = cnt[u.e * CNT_STRIDE];
#pragma unroll
        for (int h = 0; h < 2; ++h)
#pragma unroll
            for (int i = 0; i < 2; ++i) {
                const int r = u.pm * BM + h * HALF + R[i]; int row;
                if (gather) row = (r < ce) ? tokl[u.e * ECAP + r] : 0; else row = u.aux + h * HALF + R[i];
                v[h][i] = (unsigned)(row * K + C[i]) * 2u;
            }
    }
};

template <class Epi, class Sched, bool ALIGN_EPI>
__device__ __forceinline__ void gemm_phase(LAS unsigned char* lds, const int K, const Sched& S, const Epi& E, const int wave_id) {
    const int tid_ = (wave_id << 6) | fk_lane();
    const int tid = tid_, wid = __builtin_amdgcn_readfirstlane(tid >> 6), lane = tid & 63, wr = wid >> 2, wc = wid & 3, fr = lane & 15, fq = lane >> 4;
    const int nt = K / BK;
    int Rr[2], Cc[2]; unsigned voffB[2];
#pragma unroll
    for (int i = 0; i < 2; ++i) { int R, C; stage_rc(tid * 16 + i * 8192, R, C); Rr[i] = R; Cc[i] = C; const int Rb = Epi::PERM ? ((R & ~31) + perm32(R & 31)) : R; voffB[i] = (unsigned)(Rb * K + C) * 2u; }
    const size_t kstep = (size_t)(BK * 2);
    const size_t hstep = (size_t)HALF * K * 2;
    const unsigned ldsw = (unsigned)wid * 1024u;
    const int aoff = lds_byte(wr * 64 + fr, fq * 8), boff = lds_byte(wc * 32 + fr, fq * 8);
#define PG8_SA(b, h) (((b) * 2 + (h)) * HTB)
#define PG8_SB(b, h) ((4 + (b) * 2 + (h)) * HTB)
#define PG8_STAGE_B(bufoff, gbase) do { _Pragma("unroll") for (int _i = 0; _i < 2; ++_i) \
        __builtin_amdgcn_global_load_lds((const unsigned*)((const char*)(gbase) + voffB[_i]), (LAS unsigned*)(lds + (bufoff) + ldsw + _i * 8192), 16, 0, 0); } while (0)
#define PG8_STAGE_A(bufoff, vo, h, koff) do { _Pragma("unroll") for (int _i = 0; _i < 2; ++_i) \
        __builtin_amdgcn_global_load_lds((const unsigned*)(Ab + (size_t)(vo)[h][_i] + (size_t)(koff)), (LAS unsigned*)(lds + (bufoff) + ldsw + _i * 8192), 16, 0, 0); } while (0)
#define PG8_LDA(dst, b, h) do { _Pragma("unroll") for (int m = 0; m < 4; ++m) _Pragma("unroll") for (int k = 0; k < 2; ++k) dst[m][k] = *(const LAS bf16x8*)(lds + PG8_SA(b, h) + aoff + m * 2048 + k * 1024); } while (0)
#define PG8_LDB(dst, b, h) do { _Pragma("unroll") for (int n = 0; n < 2; ++n) _Pragma("unroll") for (int k = 0; k < 2; ++k) dst[n][k] = *(const LAS bf16x8*)(lds + PG8_SB(b, h) + boff + n * 2048 + k * 1024); } while (0)
#define PG8_MMA(ai, bj, At, Bt) do { __builtin_amdgcn_s_setprio(1); _Pragma("unroll") for (int m = 0; m < 4; ++m) _Pragma("unroll") for (int n = 0; n < 2; ++n) _Pragma("unroll") for (int k = 0; k < 2; ++k) \
        acc[ai][bj][m][n] = __builtin_amdgcn_mfma_f32_16x16x32_bf16(Bt[n][k], At[m][k], acc[ai][bj][m][n], 0, 0, 0); __builtin_amdgcn_s_setprio(0); } while (0)
#define PG8_WAIT_V(n) asm volatile("s_waitcnt vmcnt(" #n ")" ::: "memory")
#define PG8_WAIT_L(n) asm volatile("s_waitcnt lgkmcnt(" #n ")" ::: "memory")
#define PG8_BAR __builtin_amdgcn_s_barrier()
#define PG8_SCHED __builtin_amdgcn_sched_barrier(0)
    Unit cur, nxt; int ui = 0;
    if (!S.next(0, cur)) return;
    f32x4 acc[2][2][4][2];
#pragma unroll
    for (int a = 0; a < 2; ++a)
#pragma unroll
        for (int b = 0; b < 2; ++b)
#pragma unroll
            for (int m = 0; m < 4; ++m)
#pragma unroll
                for (int n = 0; n < 2; ++n) acc[a][b][m][n] = (f32x4){0.f, 0.f, 0.f, 0.f};
    bf16x8 At[4][2], B0[2][2], B1[2][2];
    const char* Ab = S.a_base();
    unsigned cvA[2][2], nvA[2][2];
    S.a_voff(cur, cvA, Rr, Cc);
    const char* cB = S.b_base(cur);
    PG8_STAGE_B(PG8_SB(0, 0), cB); PG8_STAGE_B(PG8_SB(0, 1), cB + hstep); PG8_STAGE_A(PG8_SA(0, 0), cvA, 0, 0); PG8_STAGE_A(PG8_SA(0, 1), cvA, 1, 0);
    if (wr == 1) PG8_BAR;
    PG8_WAIT_V(2); PG8_BAR;
    PG8_STAGE_B(PG8_SB(1, 0), cB + kstep); PG8_STAGE_A(PG8_SA(1, 0), cvA, 0, kstep); PG8_STAGE_B(PG8_SB(1, 1), cB + hstep + kstep);
    PG8_WAIT_V(6); PG8_BAR;
    for (;;) {
        const bool has_next = S.next(ui + 1, nxt);
        const char* nB = has_next ? S.b_base(nxt) : cB;
        if (has_next) S.a_voff(nxt, nvA, Rr, Cc);
        else {
#pragma unroll
            for (int h = 0; h < 2; ++h)
#pragma unroll
                for (int i = 0; i < 2; ++i) nvA[h][i] = cvA[h][i];
        }
#pragma unroll 1
        for (int t = 0; t < nt; t += 2) {
            const bool last = (t == nt - 2);
            if constexpr (Epi::HAS_MID) { if (t == Epi::MID_T) E.mid(acc, cur, wr, wc, fr, fq); }
            const size_t k1 = (size_t)(t + 1) * kstep;
            unsigned a2[2][2];
#pragma unroll
            for (int h = 0; h < 2; ++h)
#pragma unroll
                for (int i = 0; i < 2; ++i) a2[h][i] = last ? nvA[h][i] : cvA[h][i] + (unsigned)((t + 2) * (BK * 2));
            const char* b2 = last ? nB : cB + (size_t)(t + 2) * kstep;
            const char* b3 = b2 + kstep;
            PG8_LDB(B0, 0, 0); PG8_LDB(B1, 0, 1); PG8_SCHED; PG8_LDA(At, 0, 0); PG8_STAGE_A(PG8_SA(1, 1), cvA, 1, k1);
            PG8_WAIT_V(8); PG8_WAIT_L(0); PG8_BAR; PG8_MMA(0, 0, At, B0); PG8_MMA(0, 1, At, B1); PG8_BAR; PG8_SCHED;
            PG8_LDA(At, 0, 1); PG8_STAGE_B(PG8_SB(0, 0), b2); PG8_STAGE_B(PG8_SB(0, 1), b2 + hstep); PG8_STAGE_A(PG8_SA(0, 0), a2, 0, 0);
            PG8_WAIT_V(8); PG8_WAIT_L(0); PG8_BAR; PG8_MMA(1, 0, At, B0); PG8_MMA(1, 1, At, B1); PG8_BAR; PG8_SCHED;
            PG8_LDB(B0, 1, 0); PG8_LDB(B1, 1, 1); PG8_SCHED; PG8_LDA(At, 1, 0); PG8_STAGE_A(PG8_SA(0, 1), a2, 1, 0);
            PG8_WAIT_V(8); PG8_WAIT_L(0); PG8_BAR; PG8_MMA(0, 0, At, B0); PG8_MMA(0, 1, At, B1); PG8_BAR; PG8_SCHED;
            PG8_LDA(At, 1, 1); PG8_STAGE_B(PG8_SB(1, 0), b3); PG8_STAGE_B(PG8_SB(1, 1), b3 + hstep); PG8_STAGE_A(PG8_SA(1, 0), a2, 0, kstep);
            PG8_WAIT_V(8); PG8_WAIT_L(0); PG8_BAR; PG8_MMA(1, 0, At, B0); PG8_MMA(1, 1, At, B1); PG8_BAR; PG8_SCHED;
        }
        if constexpr (ALIGN_EPI) { if (wr == 0) PG8_BAR; }
        E(acc, cur, wr, wc, fr, fq);
        if (!has_next) break;
#pragma unroll
        for (int a = 0; a < 2; ++a)
#pragma unroll
            for (int b = 0; b < 2; ++b)
#pragma unroll
                for (int m = 0; m < 4; ++m)
#pragma unroll
                    for (int n = 0; n < 2; ++n) acc[a][b][m][n] = (f32x4){0.f, 0.f, 0.f, 0.f};
        cur = nxt; cB = nB; ++ui;
#pragma unroll
        for (int h = 0; h < 2; ++h)
#pragma unroll
            for (int i = 0; i < 2; ++i) cvA[h][i] = nvA[h][i];
        if constexpr (ALIGN_EPI) { if (wr == 1) PG8_BAR; }
    }
    PG8_WAIT_V(0);
    if constexpr (!ALIGN_EPI) { if (wr == 0) PG8_BAR; }
    PG8_BAR;
#undef PG8_SA
#undef PG8_SB
#undef PG8_STAGE_A
#undef PG8_STAGE_B
#undef PG8_LDA
#undef PG8_LDB
#undef PG8_MMA
#undef PG8_WAIT_V
#undef PG8_WAIT_L
#undef PG8_BAR
#undef PG8_SCHED
}

typedef f32x4 Acc[2][2][4][2];
__device__ __forceinline__ u32x4 pack8(const f32x4 a, const f32x4 b) { u32x4 w; w.x = cvt_pk_bf16(a[0], a[1]); w.y = cvt_pk_bf16(a[2], a[3]); w.z = cvt_pk_bf16(b[0], b[1]); w.w = cvt_pk_bf16(b[2], b[3]); return w; }

struct EpiPlain {
    static constexpr bool PERM = true, HAS_MID = false; static constexpr int MID_T = 0;
    bf16_t* O; int ldc; int use_aux;
    __device__ __forceinline__ void mid(Acc&, const Unit&, int, int, int, int) const {}
    __device__ __forceinline__ void operator()(const Acc& acc, const Unit& u, int wr, int wc, int fr, int fq) const {
        const int row0 = (use_aux ? u.aux : u.pm * BM) + wr * 64 + fr, col0 = u.pn * BM + wc * 32 + 8 * fq;
#pragma unroll
        for (int ai = 0; ai < 2; ++ai)
#pragma unroll
            for (int m = 0; m < 4; ++m) { bf16_t* rowp = O + (size_t)(row0 + ai * HALF + m * 16) * ldc + col0;
#pragma unroll
                for (int bj = 0; bj < 2; ++bj) *(u32x4*)(rowp + bj * HALF) = pack8(acc[ai][bj][m][0], acc[ai][bj][m][1]); }
    }
};

struct EpiIn {
    static constexpr bool PERM = true, HAS_MID = false; static constexpr int MID_T = 0;
    const float* xpart; const float* qn; const float* kn;
    bf16_t *qb, *kb, *vb, *ub, *vsb, *gab; float* vspart;
    __device__ __forceinline__ void mid(Acc&, const Unit&, int, int, int, int) const {}
    __device__ __forceinline__ void operator()(const Acc& acc, const Unit& u, int wr, int wc, int fr, int fq) const {
        const int pn = u.pn;
#pragma unroll
        for (int ai = 0; ai < 2; ++ai)
#pragma unroll
            for (int m = 0; m < 4; ++m) {
                const int row = u.pm * BM + ai * HALF + wr * 64 + m * 16 + fr;
                const f32x4* xp = (const f32x4*)(xpart + (size_t)row * 16);
                const f32x4 s0 = xp[0], s1 = xp[1], s2 = xp[2], s3 = xp[3];
                const float ssx = ((s0[0] + s0[1]) + (s0[2] + s0[3])) + ((s1[0] + s1[1]) + (s1[2] + s1[3])) + ((s2[0] + s2[1]) + (s2[2] + s2[3])) + ((s3[0] + s3[1]) + (s3[2] + s3[3]));
                const float rs = fast_rsq(ssx * (1.f / D) + EPS);
                f32x4 v[2][2];
#pragma unroll
                for (int bj = 0; bj < 2; ++bj)
#pragma unroll
                    for (int n = 0; n < 2; ++n) v[bj][n] = acc[ai][bj][m][n] * rs;
                if (pn < 4) {
                    float ss = 0.f;
#pragma unroll
                    for (int bj = 0; bj < 2; ++bj)
#pragma unroll
                        for (int n = 0; n < 2; ++n) ss += (v[bj][n][0] * v[bj][n][0] + v[bj][n][1] * v[bj][n][1]) + (v[bj][n][2] * v[bj][n][2] + v[bj][n][3] * v[bj][n][3]);
                    ss = sum_xor16_32(ss);
                    const bool isq = pn < 2;
                    const float sc = fast_rsq(ss * (1.f / 64.f) + EPS) * (isq ? 0.125f * LOG2E : 1.f);
                    const float* gn = isq ? qn : kn; bf16_t* O = isq ? qb : kb;
                    const int head = 4 * (pn & 1) + wc;
#pragma unroll
                    for (int bj = 0; bj < 2; ++bj) {
                        const f32x4 g0 = *(const f32x4*)(gn + 32 * bj + 8 * fq), g1 = *(const f32x4*)(gn + 32 * bj + 8 * fq + 4);
                        *(u32x4*)(O + (size_t)row * 512 + head * 64 + 32 * bj + 8 * fq) = pack8(v[bj][0] * sc * g0, v[bj][1] * sc * g1);
                    }
                } else {
                    const int colw = wc * 32 + 8 * fq;
                    if (pn < 6) {
#pragma unroll
                        for (int bj = 0; bj < 2; ++bj) *(u32x4*)(vb + (size_t)row * 512 + (pn - 4) * BM + bj * HALF + colw) = pack8(v[bj][0], v[bj][1]);
                    } else if (pn < 10) {
                        float ss = 0.f;
#pragma unroll
                        for (int bj = 0; bj < 2; ++bj)
#pragma unroll
                            for (int n = 0; n < 2; ++n)
#pragma unroll
                                for (int i = 0; i < 4; ++i) { const float gv = gelu_tanh_f(v[bj][n][i]); v[bj][n][i] = gv; ss += gv * gv; }
                        if (pn < 8) {
#pragma unroll
                            for (int bj = 0; bj < 2; ++bj) *(u32x4*)(ub + (size_t)row * 512 + (pn - 6) * BM + bj * HALF + colw) = pack8(v[bj][0], v[bj][1]);
                        } else {
#pragma unroll
                            for (int bj = 0; bj < 2; ++bj) *(u32x4*)(vsb + (size_t)row * 512 + (pn - 8) * BM + bj * HALF + colw) = pack8(v[bj][0], v[bj][1]);
                            ss = sum_xor16_32(ss);
                            if (fq == 0) vspart[(size_t)row * 8 + (pn - 8) * 4 + wc] = ss;
                        }
                    } else {
#pragma unroll
                        for (int bj = 0; bj < 2; ++bj) {
#pragma unroll
                            for (int n = 0; n < 2; ++n)
#pragma unroll
                                for (int i = 0; i < 4; ++i) v[bj][n][i] = fmaxf(sigmoid_f(v[bj][n][i]), 1e-13f);
                            *(u32x4*)(gab + (size_t)row * 2048 + (pn - 10) * BM + bj * HALF + colw) = pack8(v[bj][0], v[bj][1]);
                        }
                    }
                }
            }
    }
};

struct EpiUp {
    static constexpr bool PERM = true, HAS_MID = true; static constexpr int MID_T = 8;
    const bf16_t* gab; bf16_t* mg;
    __device__ __forceinline__ void mid(Acc& acc, const Unit& u, int wr, int wc, int fr, int fq) const {
        int row0 = u.pm * BM + wr * 64 + fr; const int col0 = u.pn * BM + wc * 32 + 8 * fq; asm volatile("" : "+v"(row0));
#pragma unroll
        for (int am = 0; am < 4; ++am) {
            const int ai = am >> 1, mb = (am & 1) * 2;
            u32x4 ga[2][2], gb[2][2];
#pragma unroll
            for (int mm = 0; mm < 2; ++mm) { const bf16_t* gp = gab + (size_t)(row0 + ai * HALF + (mb + mm) * 16) * 2048 + col0;
#pragma unroll
                for (int bj = 0; bj < 2; ++bj) { ga[mm][bj] = *(const u32x4*)(gp + bj * HALF); gb[mm][bj] = *(const u32x4*)(gp + 1024 + bj * HALF); } }
#pragma unroll
            for (int mm = 0; mm < 2; ++mm)
#pragma unroll
                for (int bj = 0; bj < 2; ++bj)
#pragma unroll
                    for (int j = 0; j < 4; ++j) { const float r0 = bf_lo(ga[mm][bj][j]) * fast_rcp(bf_lo(gb[mm][bj][j])), r1 = bf_hi(ga[mm][bj][j]) * fast_rcp(bf_hi(gb[mm][bj][j]));
                        acc[ai][bj][mb + mm][j >> 1][(j & 1) * 2] *= r0; acc[ai][bj][mb + mm][j >> 1][(j & 1) * 2 + 1] *= r1; }
            asm volatile("" ::: "memory");
        }
    }
    __device__ __forceinline__ void operator()(const Acc& acc, const Unit& u, int wr, int wc, int fr, int fq) const {
        int row0 = u.pm * BM + wr * 64 + fr; const int col0 = u.pn * BM + wc * 32 + 8 * fq; asm volatile("" : "+v"(row0));
#pragma unroll
        for (int ai = 0; ai < 2; ++ai) {
            u32x4 gb[4][2];
#pragma unroll
            for (int m = 0; m < 4; ++m)
#pragma unroll
                for (int bj = 0; bj < 2; ++bj) gb[m][bj] = *(const u32x4*)(gab + (size_t)(row0 + ai * HALF + m * 16) * 2048 + 1024 + col0 + bj * HALF);
#pragma unroll
            for (int m = 0; m < 4; ++m) { const size_t ro = (size_t)(row0 + ai * HALF + m * 16);
#pragma unroll
                for (int bj = 0; bj < 2; ++bj) { const u32x4 b = gb[m][bj];
                    f32x4 o0, o1;
                    o0[0] = acc[ai][bj][m][0][0] * bf_lo(b[0]); o0[1] = acc[ai][bj][m][0][1] * bf_hi(b[0]); o0[2] = acc[ai][bj][m][0][2] * bf_lo(b[1]); o0[3] = acc[ai][bj][m][0][3] * bf_hi(b[1]);
                    o1[0] = acc[ai][bj][m][1][0] * bf_lo(b[2]); o1[1] = acc[ai][bj][m][1][1] * bf_hi(b[2]); o1[2] = acc[ai][bj][m][1][2] * bf_lo(b[3]); o1[3] = acc[ai][bj][m][1][3] * bf_hi(b[3]);
                    *(u32x4*)(mg + ro * 1024 + col0 + bj * HALF) = pack8(o0, o1); } }
            asm volatile("" ::: "memory");
        }
    }
};

struct EpiOut {
    static constexpr bool PERM = true, HAS_MID = false; static constexpr int MID_T = 0;
    const bf16_t* xin; bf16_t* xout;
    __device__ __forceinline__ void mid(Acc&, const Unit&, int, int, int, int) const {}
    __device__ __forceinline__ void operator()(const Acc& acc, const Unit& u, int wr, int wc, int fr, int fq) const {
        int row0 = u.pm * BM + wr * 64 + fr; const int col0 = u.pn * BM + wc * 32 + 8 * fq; asm volatile("" : "+v"(row0));
#pragma unroll
        for (int ai = 0; ai < 2; ++ai) {
            u32x4 xv[4][2];
#pragma unroll
            for (int m = 0; m < 4; ++m)
#pragma unroll
                for (int bj = 0; bj < 2; ++bj) xv[m][bj] = *(const u32x4*)(xin + (size_t)(row0 + ai * HALF + m * 16) * D + col0 + bj * HALF);
#pragma unroll
            for (int m = 0; m < 4; ++m)
#pragma unroll
                for (int bj = 0; bj < 2; ++bj) { const u32x4 xo = xv[m][bj]; f32x4 o0, o1;
                    o0[0] = bf_lo(xo[0]) + acc[ai][bj][m][0][0]; o0[1] = bf_hi(xo[0]) + acc[ai][bj][m][0][1]; o0[2] = bf_lo(xo[1]) + acc[ai][bj][m][0][2]; o0[3] = bf_hi(xo[1]) + acc[ai][bj][m][0][3];
                    o1[0] = bf_lo(xo[2]) + acc[ai][bj][m][1][0]; o1[1] = bf_hi(xo[2]) + acc[ai][bj][m][1][1]; o1[2] = bf_lo(xo[3]) + acc[ai][bj][m][1][2]; o1[3] = bf_hi(xo[3]) + acc[ai][bj][m][1][3];
                    *(u32x4*)(xout + (size_t)(row0 + ai * HALF + m * 16) * D + col0 + bj * HALF) = pack8(o0, o1); }
            asm volatile("" ::: "memory");
        }
    }
};

struct EpiG1 {
    static constexpr bool PERM = true, HAS_MID = false; static constexpr int MID_T = 0;
    const int* tokl; const int* cnt; const float* rs2; bf16_t* Gb;
    __device__ __forceinline__ void mid(Acc&, const Unit&, int, int, int, int) const {}
    __device__ __forceinline__ void operator()(const Acc& acc, const Unit& u, int wr, int wc, int fr, int fq) const {
        const int ce = cnt[u.e * CNT_STRIDE];
#pragma unroll
        for (int ai = 0; ai < 2; ++ai)
#pragma unroll
            for (int m = 0; m < 4; ++m) {
                const int rl = ai * HALF + wr * 64 + m * 16 + fr, r = u.pm * BM + rl;
                const int tok = (r < ce) ? tokl[u.e * ECAP + r] : 0;
                const float rs = rs2[tok];
                f32x4 o[2];
#pragma unroll
                for (int n = 0; n < 2; ++n)
#pragma unroll
                    for (int i = 0; i < 4; ++i) { const float g = acc[ai][0][m][n][i] * rs, up = acc[ai][1][m][n][i] * rs; o[n][i] = g * sigmoid_f(g) * up; }
                *(u32x4*)(Gb + (size_t)(u.aux + rl) * 512 + u.pn * HALF + wc * 32 + 8 * fq) = pack8(o[0], o[1]);
            }
    }
};

struct EpiPle {
    static constexpr bool PERM = true, HAS_MID = false; static constexpr int MID_T = 0;
    const bf16_t* xin; bf16_t* xout; float* fout; const bf16_t* Eb; const float* rs3; float* xpart;
    __device__ __forceinline__ void mid(Acc&, const Unit&, int, int, int, int) const {}
    __device__ __forceinline__ void operator()(const Acc& acc, const Unit& u, int wr, int wc, int fr, int fq) const {
        int row0 = u.pm * BM + wr * 64 + fr; const int col0 = u.pn * BM + wc * 32 + 8 * fq; asm volatile("" : "+v"(row0));
#pragma unroll
        for (int am = 0; am < 4; ++am) {
            const int ai = am >> 1, mb = (am & 1) * 2;
            u32x4 xv[2][2], ev[2][2]; float rsv[2];
#pragma unroll
            for (int mm = 0; mm < 2; ++mm) { const int row = row0 + ai * HALF + (mb + mm) * 16; rsv[mm] = rs3[row];
#pragma unroll
                for (int bj = 0; bj < 2; ++bj) { xv[mm][bj] = *(const u32x4*)(xin + (size_t)row * D + col0 + bj * HALF); ev[mm][bj] = *(const u32x4*)(Eb + (size_t)row * D + col0 + bj * HALF); } }
#pragma unroll
            for (int mm = 0; mm < 2; ++mm) { const int row = row0 + ai * HALF + (mb + mm) * 16; const float rs = rsv[mm]; float ss = 0.f;
#pragma unroll
                for (int bj = 0; bj < 2; ++bj) { const u32x4 xo = xv[mm][bj], e = ev[mm][bj]; f32x4 o[2];
#pragma unroll
                    for (int j = 0; j < 4; ++j) { o[j >> 1][(j & 1) * 2] = bf_lo(xo[j]) + sigmoid_f(acc[ai][bj][mb + mm][j >> 1][(j & 1) * 2] * rs) * bf_lo(e[j]);
                                                  o[j >> 1][(j & 1) * 2 + 1] = bf_hi(xo[j]) + sigmoid_f(acc[ai][bj][mb + mm][j >> 1][(j & 1) * 2 + 1] * rs) * bf_hi(e[j]); }
                    const u32x4 w = pack8(o[0], o[1]);
#pragma unroll
                    for (int j = 0; j < 4; ++j) { const float a = bf_lo(w[j]), b = bf_hi(w[j]); ss += a * a + b * b; }
                    *(u32x4*)(xout + (size_t)row * D + col0 + bj * HALF) = w;
                    if (fout) { *(f32x4*)(fout + (size_t)row * D + col0 + bj * HALF) = o[0]; *(f32x4*)(fout + (size_t)row * D + col0 + bj * HALF + 4) = o[1]; } }
                ss = sum_xor16_32(ss);
                if (fq == 0) xpart[(size_t)row * 16 + u.pn * 4 + wc] = ss; }
            asm volatile("" ::: "memory");
        }
    }
};
__device__ __forceinline__ int crow(int r, int hi) { return (r & 3) + 8 * (r >> 2) + 4 * hi; }
__device__ __forceinline__ unsigned cvtpk_s(float lo, float hi) { typedef __bf16 bf16x2_t __attribute__((ext_vector_type(2))); f32x2 v = {lo, hi}; bf16x2_t b = __builtin_convertvector(v, bf16x2_t); return __builtin_bit_cast(unsigned, b); }
#define FK_SBAR() __builtin_amdgcn_sched_barrier(0)
__device__ __forceinline__ void pv(f32x16* o, int vb, bf16x8 pa0, bf16x8 pa1, bf16x8 pa2, bf16x8 pa3) {
#pragma unroll
    for (int d0 = 0; d0 < 2; ++d0) { s16x4 lo[4], hi[4];
#pragma unroll
        for (int ks = 0; ks < 4; ++ks) {
            asm volatile("ds_read_b64_tr_b16 %0,%1 offset:%c2" : "=&v"(lo[ks]) : "v"(vb), "i"(d0 * 4096 + ks * 1024) : "memory");
            asm volatile("ds_read_b64_tr_b16 %0,%1 offset:%c2" : "=&v"(hi[ks]) : "v"(vb), "i"(d0 * 4096 + ks * 1024 + 512) : "memory"); }
        asm volatile("s_waitcnt lgkmcnt(0)" ::: "memory"); FK_SBAR();
#define FK_PK(k) (bf16x8){lo[k][0], lo[k][1], lo[k][2], lo[k][3], hi[k][0], hi[k][1], hi[k][2], hi[k][3]}
        o[d0] = __builtin_amdgcn_mfma_f32_32x32x16_bf16(pa0, FK_PK(0), o[d0], 0, 0, 0);
        o[d0] = __builtin_amdgcn_mfma_f32_32x32x16_bf16(pa1, FK_PK(1), o[d0], 0, 0, 0);
        o[d0] = __builtin_amdgcn_mfma_f32_32x32x16_bf16(pa2, FK_PK(2), o[d0], 0, 0, 0);
        o[d0] = __builtin_amdgcn_mfma_f32_32x32x16_bf16(pa3, FK_PK(3), o[d0], 0, 0, 0);
#undef FK_PK
    }
}
constexpr int WLDS_BYTES = 16384;

template <bool DIAG>
__device__ __forceinline__ void attn_tile(const bf16x8 (&k0)[4], const bf16x8 (&k1)[4], const bf16x8 (&qr)[4], f32x16 (&o)[2], float& R, int s0, int tq, int hi, int vbase) {
    f32x16 p0 = f32x16{}, p1 = f32x16{};
#pragma unroll
    for (int d0 = 0; d0 < 4; ++d0) { p0 = __builtin_amdgcn_mfma_f32_32x32x16_bf16(k0[d0], qr[d0], p0, 0, 0, 0); p1 = __builtin_amdgcn_mfma_f32_32x32x16_bf16(k1[d0], qr[d0], p1, 0, 0, 0); }
    float kp[32], bt[32];
#pragma unroll
    for (int r = 0; r < 32; ++r) {
        const float z = r < 16 ? p0[r] : p1[r - 16];
        const float e = fast_exp2(z);
        float k_ = fast_rcp(1.f + e), b_ = 1.f - k_;
        if (DIAG) { const int kv = s0 + crow(r & 15, hi) + (r >> 4) * 32; if (!(kv < tq)) { k_ = 1.f; b_ = 0.f; } }
        kp[r] = k_; bt[r] = b_;
    }
    float pg[8], T[8], SP[8];
#pragma unroll
    for (int g = 0; g < 8; ++g) { const float gs = (kp[4 * g] * kp[4 * g + 1]) * (kp[4 * g + 2] * kp[4 * g + 3]); float lo_, hi_; halves32(gs, lo_, hi_); pg[g] = hi ? lo_ : hi_; T[g] = lo_ * hi_; }
    SP[7] = 1.f;
#pragma unroll
    for (int g = 6; g >= 0; --g) SP[g] = SP[g + 1] * T[g + 1];
    float a[32];
#pragma unroll
    for (int g = 0; g < 8; ++g) {
        const float base = R * SP[g] * (hi == 0 ? pg[g] : 1.f);
        const float a3 = base, a2 = a3 * kp[4 * g + 3], a1 = a2 * kp[4 * g + 2], a0 = a1 * kp[4 * g + 1];
        a[4 * g + 3] = bt[4 * g + 3] * a3; a[4 * g + 2] = bt[4 * g + 2] * a2; a[4 * g + 1] = bt[4 * g + 1] * a1; a[4 * g] = bt[4 * g] * a0;
    }
    R *= SP[0] * T[0];
    u32x4 pw0, pw1, pw2, pw3;
    pw0 = (u32x4){cvtpk_s(a[0], a[1]), cvtpk_s(a[2], a[3]), cvtpk_s(a[4], a[5]), cvtpk_s(a[6], a[7])};
    pw1 = (u32x4){cvtpk_s(a[8], a[9]), cvtpk_s(a[10], a[11]), cvtpk_s(a[12], a[13]), cvtpk_s(a[14], a[15])};
    pw2 = (u32x4){cvtpk_s(a[16], a[17]), cvtpk_s(a[18], a[19]), cvtpk_s(a[20], a[21]), cvtpk_s(a[22], a[23])};
    pw3 = (u32x4){cvtpk_s(a[24], a[25]), cvtpk_s(a[26], a[27]), cvtpk_s(a[28], a[29]), cvtpk_s(a[30], a[31])};
    asm volatile("s_waitcnt vmcnt(0) lgkmcnt(0)" ::: "memory");
    pv(o, vbase, __builtin_bit_cast(bf16x8, pw0), __builtin_bit_cast(bf16x8, pw1), __builtin_bit_cast(bf16x8, pw2), __builtin_bit_cast(bf16x8, pw3));
}
__device__ __forceinline__ void attn_dma_v(const bf16_t* __restrict__ vb, long rowbase, int s0, int h, int lane, LAS unsigned char* wl) {
#pragma unroll
    for (int w8 = 0; w8 < 8; ++w8)
        __builtin_amdgcn_global_load_lds((const unsigned*)(vb + (size_t)(rowbase + s0 + 16 * (w8 & 3) + (lane >> 2)) * 512 + h * 64 + 32 * (w8 >> 2) + 8 * (lane & 3)), (LAS unsigned*)(wl + w8 * 1024), 16, 0, 0);
}
__device__ __forceinline__ void attn_dma_k(const bf16_t* __restrict__ kb, long rowbase, int s0, int h, int lane, LAS unsigned char* wl) {
#pragma unroll
    for (int c = 0; c < 8; ++c)
        __builtin_amdgcn_global_load_lds((const unsigned*)(kb + (size_t)(rowbase + s0 + lane) * 512 + h * 64 + 8 * c), (LAS unsigned*)(wl + 8192 + c * 1024), 16, 0, 0);
}
__device__ __forceinline__ void attn_read_k(bf16x8 (&k0)[4], bf16x8 (&k1)[4], LAS unsigned char* wl, int r32, int hi) {
    const LAS unsigned char* kp = wl + 8192 + hi * 1024 + r32 * 16;
#pragma unroll
    for (int d0 = 0; d0 < 4; ++d0) { k0[d0] = *(const LAS bf16x8*)(kp + d0 * 2048); k1[d0] = *(const LAS bf16x8*)(kp + d0 * 2048 + 512); }
}
__device__ __forceinline__ void attn_wave_unit(int b, int h, int qblk, const bf16_t* __restrict__ qb, const bf16_t* __restrict__ kb, const bf16_t* __restrict__ vb, bf16_t* __restrict__ oc, LAS unsigned char* wl, int lane) {
    const int r32 = lane & 31, hi = lane >> 5;
    const long rowbase = (long)b * SEQ; const int q0 = qblk * 32, tq = q0 + r32;
    bf16x8 qr[4];
    { const bf16_t* qp = qb + (size_t)(rowbase + q0 + r32) * 512 + h * 64 + hi * 8;
#pragma unroll
      for (int d0 = 0; d0 < 4; ++d0) qr[d0] = *(const bf16x8*)(qp + d0 * 16); }
    f32x16 o[2]; o[0] = f32x16{}; o[1] = f32x16{};
    float R = 1.f;
    const int vbase = (int)(unsigned)(uintptr_t)wl + ((lane >> 4) & 1) * 32 + (lane & 3) * 8 + (4 * hi + ((lane & 15) >> 2)) * 64;
    const int jd = q0 >> 6;
    bf16x8 k0[4], k1[4];
    attn_dma_k(kb, rowbase, jd * 64, h, lane, wl);
    attn_dma_v(vb, rowbase, jd * 64, h, lane, wl);
    asm volatile("s_waitcnt vmcnt(8)" ::: "memory");
    attn_read_k(k0, k1, wl, r32, hi);
    asm volatile("s_waitcnt lgkmcnt(0)" ::: "memory");
    attn_dma_k(kb, rowbase, (jd > 0 ? jd - 1 : 0) * 64, h, lane, wl);
    attn_tile<true>(k0, k1, qr, o, R, jd * 64, tq, hi, vbase);
    for (int jt = jd - 1; jt >= 0; --jt) {
        if (__all(R < 7.5e-37f)) break;
        attn_read_k(k0, k1, wl, r32, hi);
        attn_dma_v(vb, rowbase, jt * 64, h, lane, wl);
        asm volatile("s_waitcnt lgkmcnt(0)" ::: "memory");
        attn_dma_k(kb, rowbase, (jt > 0 ? jt - 1 : 0) * 64, h, lane, wl);
        attn_tile<false>(k0, k1, qr, o, R, jt * 64, tq, hi, vbase);
    }
    asm volatile("s_waitcnt vmcnt(0)" ::: "memory");
    LAS bf16_t* stg = (LAS bf16_t*)(wl + 8192);
#pragma unroll
    for (int r = 0; r < 16; ++r) { const int orow = crow(r, hi);
#pragma unroll
        for (int d0 = 0; d0 < 2; ++d0) stg[orow * 64 + d0 * 32 + r32] = (bf16_t)(cvtpk_s(o[d0][r], 0.f) & 0xffffu); }
    asm volatile("s_waitcnt lgkmcnt(0)" ::: "memory");
    bf16_t* Ow = oc + (size_t)(rowbase + q0) * 1024 + h * 64;
#pragma unroll
    for (int i = 0; i < 4; ++i) { const int row = i * 8 + (lane >> 3), ch = lane & 7; const u32x4 v = *(const LAS u32x4*)(stg + row * 64 + ch * 8); *(u32x4*)(Ow + (size_t)row * 1024 + ch * 8) = v; }
    asm volatile("s_waitcnt vmcnt(0) lgkmcnt(0)" ::: "memory");
}

template <int HF>
__device__ __forceinline__ void sgu_wave_unit(int chunk, int g, const bf16_t* __restrict__ ub, const bf16_t* __restrict__ vsb, const float* __restrict__ vspart, const bf16_t* __restrict__ wsp  ,
                                              const float* __restrict__ bsp  , const float* __restrict__ sgn  , bf16_t* __restrict__ oc, LAS unsigned char* wl, int lane) {
    const int r32 = lane & 31, hi = lane >> 5;
    const size_t row0 = (size_t)chunk * 128;
    const int vbase = (int)(unsigned)(uintptr_t)wl + ((lane >> 4) & 1) * 32 + (lane & 3) * 8 + (4 * hi + ((lane & 15) >> 2)) * 64;
    f32x16 o[2][2];
#pragma unroll
    for (int rl = 0; rl < 2; ++rl) { o[rl][0] = f32x16{}; o[rl][1] = f32x16{}; }
#pragma unroll
    for (int kt = 0; kt <= HF; ++kt) {
        float rvq[4];
#pragma unroll
        for (int q = 0; q < 4; ++q) { const size_t row = row0 + 64 * kt + 16 * q + (lane >> 2);
            const f32x4 s0 = *(const f32x4*)(vspart + row * 8), s1 = *(const f32x4*)(vspart + row * 8 + 4);
            rvq[q] = fast_rsq((((s0[0] + s0[1]) + (s0[2] + s0[3])) + ((s1[0] + s1[1]) + (s1[2] + s1[3]))) * (1.f / 512.f) + EPS); }
        u32x4 vv[8];
#pragma unroll
        for (int w8 = 0; w8 < 8; ++w8) vv[w8] = *(const u32x4*)(vsb + (row0 + 64 * kt + 16 * (w8 & 3) + (lane >> 2)) * 512 + g * 64 + 32 * (w8 >> 2) + 8 * (lane & 3));
#pragma unroll
        for (int w8 = 0; w8 < 8; ++w8) { const float rv = rvq[w8 & 3]; u32x4 w;
#pragma unroll
            for (int j = 0; j < 4; ++j) w[j] = cvtpk_s(bf_lo(vv[w8][j]) * rv, bf_hi(vv[w8][j]) * rv);
            *(LAS u32x4*)(wl + w8 * 1024 + lane * 16) = w; }
        asm volatile("s_waitcnt lgkmcnt(0)" ::: "memory");
#pragma unroll
        for (int rl = 0; rl < 2; ++rl) {
            const int rb = 2 * HF + rl;
            const bf16_t* wp = wsp + ((size_t)g * 128 + 32 * rb + r32) * 128 + 64 * kt + 4 * hi;
            u32x4 pw[4];
#pragma unroll
            for (int ks = 0; ks < 4; ++ks) { const u32x2 lo = *(const u32x2*)(wp + 16 * ks), h8 = *(const u32x2*)(wp + 16 * ks + 8); pw[ks] = (u32x4){lo.x, lo.y, h8.x, h8.y}; }
            pv(o[rl], vbase, __builtin_bit_cast(bf16x8, pw[0]), __builtin_bit_cast(bf16x8, pw[1]), __builtin_bit_cast(bf16x8, pw[2]), __builtin_bit_cast(bf16x8, pw[3]));
        }
        asm volatile("s_waitcnt lgkmcnt(0)" ::: "memory");
    }
    LAS bf16_t* stg = (LAS bf16_t*)(wl + 8192);
    const float gn0 = sgn[g * 64 + r32], gn1 = sgn[g * 64 + 32 + r32];
#pragma unroll
    for (int rl = 0; rl < 2; ++rl) {
        const int rb = 2 * HF + rl;
#pragma unroll
        for (int r = 0; r < 16; ++r) { const int orow = crow(r, hi); const float bb = bsp[g * 128 + 32 * rb + orow];
            stg[orow * 64 + r32] = (bf16_t)(cvtpk_s(gn0 * o[rl][0][r] + bb, 0.f) & 0xffffu); stg[orow * 64 + 32 + r32] = (bf16_t)(cvtpk_s(gn1 * o[rl][1][r] + bb, 0.f) & 0xffffu); }
        asm volatile("s_waitcnt lgkmcnt(0)" ::: "memory");
#pragma unroll
        for (int i = 0; i < 4; ++i) { const int row = i * 8 + (lane >> 3), ch = lane & 7; const size_t grow = row0 + 32 * rb + row;
            const u32x4 mv = *(const LAS u32x4*)(stg + row * 64 + ch * 8); const u32x4 uv = *(const u32x4*)(ub + grow * 512 + g * 64 + ch * 8); u32x4 w;
#pragma unroll
            for (int j = 0; j < 4; ++j) w[j] = cvtpk_s(bf_lo(mv[j]) * bf_lo(uv[j]), bf_hi(mv[j]) * bf_hi(uv[j]));
            *(u32x4*)(oc + grow * 1024 + 512 + g * 64 + ch * 8) = w; }
        asm volatile("s_waitcnt lgkmcnt(0)" ::: "memory");
    }
}
constexpr size_t MiB = 1u << 20;
constexpr size_t WS_CTL = 0, CTL_ZERO_BYTES = 1 * MiB;
constexpr size_t WS_W = 16 * MiB, WL_STRIDE = 112 * MiB;
constexpr size_t WO_IN = 0, WO_UP = 9 * MiB, WO_OUT = 11 * MiB, WO_PG = 13 * MiB, WO_PP = 15 * MiB, WO_SP = 15 * MiB + 512 * 1024, WO_R = 15 * MiB + 768 * 1024, WO_EI = 16 * MiB, WO_EO = 80 * MiB;
constexpr size_t WS_PB = 464 * MiB, WS_E = 496 * MiB, WS_XB = 624 * MiB, WS_Q = 656 * MiB, WS_K = 672 * MiB, WS_V = 688 * MiB, WS_U = 704 * MiB, WS_VS = 720 * MiB, WS_GAB = 736 * MiB,
                 WS_OC = 800 * MiB, WS_MG = 832 * MiB, WS_G = 864 * MiB, WS_YS = 904 * MiB, WS_XPART = 984 * MiB, WS_VSPART = 985 * MiB, WS_RS2 = 985 * MiB + 512 * 1024, WS_RS3 = 985 * MiB + 640 * 1024,
                 WS_TOKL = 986 * MiB, WS_TKE = 988 * MiB, WS_TKP = 988 * MiB + 256 * 1024, WS_TKW = 988 * MiB + 512 * 1024, WS_XB1 = 992 * MiB, WS_FAST_END = 1024 * MiB;
constexpr int GSLOTS = 2 * M + NE * 256;
constexpr int CW_TMO = 0, CW_CODE = 1, CW_BAR = 4096, CW_CNT = 8192  ;

constexpr int RING_OFF = 0, RING_BYTES = 131072, LDSCTL_OFF = 139264  , MISC_OFF = LDSCTL_OFF + 320, PREF_OFF = MISC_OFF + 128  , LDS_BYTES = 147456;

#define RLX_AGENT __ATOMIC_RELAXED, __HIP_MEMORY_SCOPE_AGENT
#define XB_TMO      128
#define XB_XCNT(j)  (256  + 64 * (j))
#define XB_XSUB(j)  (1280 + 64 * (j))
#define XB_XGEN(j)  (2304 + 64 * (j))
#define XB_TOP      3328
#define XB_TOPGEN   3392
#define XCD_BAR_WORDS 3456
#define XB_SPIN_CAP (1u << 18)
__device__ __forceinline__ unsigned xb_ld(unsigned* p)              { return __hip_atomic_load(p, __ATOMIC_RELAXED, __HIP_MEMORY_SCOPE_AGENT); }
__device__ __forceinline__ unsigned xb_add(unsigned* p, unsigned v) { return __hip_atomic_fetch_add(p, v, __ATOMIC_RELAXED, __HIP_MEMORY_SCOPE_AGENT); }
__device__ __forceinline__ unsigned xb_xcc_id() { return (unsigned)__builtin_amdgcn_s_getreg((3 << 11) | 20) & 0xFu; }
#define XB_SPIN(cond, bar) do { unsigned _sp = 0; while (cond) { __builtin_amdgcn_s_sleep(1); \
    if ((++_sp & 255u) == 0u) { if (xb_ld(&(bar)[XB_TMO])) break; if (_sp > XB_SPIN_CAP) { atomicAdd(&(bar)[XB_TMO], 1u); break; } } } } while (0)
struct XcdBarrier { unsigned* bar; unsigned x; volatile LAS unsigned* st; };
__device__ __forceinline__ XcdBarrier xcd_barrier_post(unsigned* bar, volatile LAS unsigned* st, const bool leader  ) {
    XcdBarrier b; b.bar = bar; b.x = xb_xcc_id(); b.st = st;
    if (leader) (void)xb_add(&bar[XB_XCNT(b.x)], 1u);
    return b;
}
__device__ __forceinline__ void xcd_barrier_complete(unsigned* bar, unsigned x, unsigned& nloc, unsigned& nx) {
    const unsigned G = gridDim.x * gridDim.y * gridDim.z;
    unsigned sum, cnt, mine, sp = 0u;
    for (;;) {
        sum = 0u; cnt = 0u; mine = 0u;
#pragma unroll
        for (unsigned j = 0; j < 16; ++j) { const unsigned c = xb_ld(&bar[XB_XCNT(j)]); sum += c; cnt += (c > 0u) ? 1u : 0u; mine = (j == x) ? c : mine; }
        if (sum == G) break;
        __builtin_amdgcn_s_sleep(1);
        if ((++sp & 255u) == 0u) { if (xb_ld(&bar[XB_TMO])) break; if (sp > XB_SPIN_CAP) { atomicAdd(&bar[XB_TMO], 1u); break; } }
    }
    nloc = mine > 0u ? mine : 1u; nx = cnt > 0u ? cnt : 1u;
}
__device__ __forceinline__ void xcd_barrier(const XcdBarrier& b, const bool leader  ) {
    asm volatile("s_waitcnt vmcnt(0)" ::: "memory");
    __syncthreads();
    if (leader) {
        unsigned* bar = b.bar;
        __builtin_amdgcn_s_waitcnt(0);
        unsigned nloc = b.st[0], nx = b.st[1];
        if (nloc == 0u) { xcd_barrier_complete(bar, b.x, nloc, nx); b.st[0] = nloc; b.st[1] = nx; }
        const unsigned old = xb_add(&bar[XB_XSUB(b.x)], 1u);
        const unsigned gen = old / nloc;
        if (old + 1u == (gen + 1u) * nloc) {
            __builtin_amdgcn_fence(__ATOMIC_RELEASE, "agent");
            asm volatile("s_waitcnt vmcnt(0)" ::: "memory");
            const unsigned og = xb_add(&bar[XB_TOP], 1u);
            const unsigned tg = og / nx;
            if (og + 1u == (tg + 1u) * nx) xb_add(&bar[XB_TOPGEN], 1u);
            else XB_SPIN(xb_ld(&bar[XB_TOPGEN]) == tg, bar);
            __builtin_amdgcn_fence(__ATOMIC_ACQUIRE, "agent");
            xb_add(&bar[XB_XGEN(b.x)], 1u);
            asm volatile("s_waitcnt vmcnt(0)" ::: "memory");
        } else {
            XB_SPIN(xb_ld(&bar[XB_XGEN(b.x)]) == gen, bar);
            __builtin_amdgcn_fence(__ATOMIC_ACQUIRE, "agent");
            asm volatile("s_waitcnt vmcnt(0)" ::: "memory");
        }
    }
    __syncthreads();
}

struct Args {
    const float* in[22]; float* out; unsigned char* ws;
    int ph_lo, ph_hi, nlayers, pad;
};
__device__ __forceinline__ float wave_sum(float v) { v += xor_lt32<1>(v); v += xor_lt32<2>(v); v += xor_lt32<4>(v); v += xor_lt32<8>(v); return sum_xor16_32(v); }
__device__ __forceinline__ unsigned f2bf(float f) { unsigned u = __builtin_bit_cast(unsigned, f); return (u + 0x7fffu + ((u >> 16) & 1u)) >> 16; }
__device__ __forceinline__ unsigned pk2(float lo, float hi) { return f2bf(lo) | (f2bf(hi) << 16); }

__device__ __forceinline__ int rowmap(int kind, int n) {
    if (kind == 1) { if (n >= 1024) return n; const int nl = n & 255; return (n - nl) + 128 * ((nl & 63) >> 5) + 32 * (nl >> 6) + (nl & 31); }
    if (kind == 2) { return n < 512 ? 256 * (n >> 7) + (n & 127) : 256 * ((n - 512) >> 7) + 128 + ((n - 512) & 127); }
    return n;
}
__device__ __forceinline__ void transpose_item(const float* __restrict__ W, int N, const float* __restrict__ gain, bf16_t* __restrict__ WT, int ldt, int koff, int kind, LAS float* scr, int item, int lane) {
    const int nblk = N / 64, kb = item / nblk, nb = item % nblk, k0 = 64 * kb, n0 = 64 * nb;
    const int kr = lane >> 4, nc = 4 * (lane & 15);
    f32x4 v[16];
#pragma unroll
    for (int i = 0; i < 16; ++i) v[i] = *(const f32x4*)(W + (size_t)(k0 + 4 * i + kr) * N + n0 + nc);
#pragma unroll
    for (int i = 0; i < 16; ++i) { const int kk = 4 * i + kr; const float gv = gain ? gain[k0 + kk] : 1.f; LAS float* d = scr + kk * 65 + nc; d[0] = v[i][0] * gv; d[1] = v[i][1] * gv; d[2] = v[i][2] * gv; d[3] = v[i][3] * gv; }
    asm volatile("s_waitcnt lgkmcnt(0)" ::: "memory");
    const int c = lane & 7;
#pragma unroll
    for (int j = 0; j < 8; ++j) { const int n = 8 * j + (lane >> 3); const LAS float* s = scr + (8 * c) * 65 + n;
        u32x4 o; o.x = pk2(s[0 * 65], s[1 * 65]); o.y = pk2(s[2 * 65], s[3 * 65]); o.z = pk2(s[4 * 65], s[5 * 65]); o.w = pk2(s[6 * 65], s[7 * 65]);
        *(u32x4*)(WT + (size_t)rowmap(kind, n0 + n) * ldt + koff + k0 + 8 * c) = o; }
    asm volatile("s_waitcnt lgkmcnt(0)" ::: "memory");
}

typedef const __attribute__((address_space(4))) Args* KArgs;
__device__ __forceinline__ KArgs fresh(KArgs k) { asm volatile("" : "+s"(k)); return k; }
__device__ __forceinline__ void p0_prologue(KArgs ap, int nlayers, LAS unsigned char* lds, int wave, int lane, int gw, int NGW) {
    LAS float* scr = (LAS float*)(lds + RING_OFF + wave * 17408);
    unsigned char* ws = ap->ws;
    constexpr int I_IN = 16 * 72, I_UP = 8 * 16, I_OUT = 16 * 16, I_PG = 16 * 16, I_PP = 4 * 16, I_EI = 16 * 16, I_EO = 8 * 16;
    constexpr int PER_LAYER = I_IN + 2 * I_UP + I_OUT + I_PG + I_PP + NE * I_EI + NE * I_EO;
    const int nitems = PER_LAYER * nlayers;
    for (int it = gw; it < nitems; it += NGW) {
        const int L = it / PER_LAYER; int r = it % PER_LAYER;
        unsigned char* wl = ws + WS_W + (size_t)L * WL_STRIDE;
        if (r < I_IN) { transpose_item(ap->in[3] + (size_t)L * D * INW, INW, ap->in[2] + (size_t)L * D, (bf16_t*)(wl + WO_IN), D, 0, 1, scr, r, lane); continue; } r -= I_IN;
        if (r < I_UP) { transpose_item(ap->in[9] + (size_t)L * 512 * D, D, nullptr, (bf16_t*)(wl + WO_UP), 1024, 0, 0, scr, r, lane); continue; } r -= I_UP;
        if (r < I_UP) { transpose_item(ap->in[10] + (size_t)L * 512 * D, D, nullptr, (bf16_t*)(wl + WO_UP), 1024, 512, 0, scr, r, lane); continue; } r -= I_UP;
        if (r < I_OUT) { transpose_item(ap->in[11] + (size_t)L * D * D, D, nullptr, (bf16_t*)(wl + WO_OUT), D, 0, 0, scr, r, lane); continue; } r -= I_OUT;
        if (r < I_PG) { transpose_item(ap->in[20] + (size_t)L * D * D, D, ap->in[19] + (size_t)L * D, (bf16_t*)(wl + WO_PG), D, 0, 0, scr, r, lane); continue; } r -= I_PG;
        if (r < I_PP) { transpose_item(ap->in[21] + (size_t)L * 256 * D, D, nullptr, (bf16_t*)(wl + WO_PP), 256, 0, 0, scr, r, lane); continue; } r -= I_PP;
        if (r < NE * I_EI) { const int e = r / I_EI; transpose_item(ap->in[17] + ((size_t)L * NE + e) * D * 1024, 1024, ap->in[12] + (size_t)L * D, (bf16_t*)(wl + WO_EI) + (size_t)e * 1024 * 1024, 1024, 0, 2, scr, r % I_EI, lane); continue; } r -= NE * I_EI;
        { const int e = r / I_EO; transpose_item(ap->in[18] + ((size_t)L * NE + e) * 512 * D, D, nullptr, (bf16_t*)(wl + WO_EO) + (size_t)e * 1024 * 512, 512, 0, 0, scr, r % I_EO, lane); }
    }
    const int gt = gw * 64 + lane, NGT = NGW * 64;
    for (int L = 0; L < nlayers; ++L) {
        unsigned char* wl = ws + WS_W + (size_t)L * WL_STRIDE;
        bf16_t* sp = (bf16_t*)(wl + WO_SP); const float* wsrc = ap->in[7] + (size_t)L * 8 * 128 * 128;
        for (int i = gt; i < 8 * 128 * 128; i += NGT) { const int s = i & 127, t = (i >> 7) & 127; sp[i] = (bf16_t)f2bf(s <= t ? wsrc[i] : 0.f); }
        bf16_t* wrh = (bf16_t*)(wl + WO_R); bf16_t* wrl = wrh + 48 * 1024; const float* gain = ap->in[12] + (size_t)L * D; const float* wg = ap->in[13] + (size_t)L * D * 4; const float* we = ap->in[15] + (size_t)L * D * 32;
        for (int i = gt; i < 48 * 1024; i += NGT) { const int o = i >> 10, k = i & 1023; const float wv = o < 36 ? gain[k] * (o < 4 ? wg[k * 4 + o] : we[k * 32 + (o - 4)]) : 0.f;
            const unsigned h = f2bf(wv); wrh[i] = (bf16_t)h; wrl[i] = (bf16_t)f2bf(wv - __uint_as_float(h << 16)); }
    }
    { const f32x4* p4 = (const f32x4*)ap->in[1]; u32x2* pb = (u32x2*)(ws + WS_PB); const size_t n4 = (size_t)nlayers * M * 256 / 4;
      for (size_t i = gt; i < n4; i += NGT) { const f32x4 v = p4[i]; u32x2 w; w.x = pk2(v[0], v[1]); w.y = pk2(v[2], v[3]); pb[i] = w; } }
    for (int m = gw; m < M; m += NGW) {
        const f32x4* xr = (const f32x4*)(ap->in[0] + (size_t)m * D) + lane; u32x2* o8 = (u32x2*)((bf16_t*)(ws + WS_XB) + (size_t)m * D) + lane; float s = 0.f;
#pragma unroll
        for (int j = 0; j < 4; ++j) { const f32x4 v = xr[64 * j]; s += (v[0] * v[0] + v[1] * v[1]) + (v[2] * v[2] + v[3] * v[3]); u32x2 w; w.x = pk2(v[0], v[1]); w.y = pk2(v[2], v[3]); o8[64 * j] = w; }
        s = wave_sum(s);
        if (lane < 16) ((float*)(ws + WS_XPART))[(size_t)m * 16 + lane] = lane == 0 ? s : 0.f;
    }
}

__device__ __forceinline__ void router_pass(const bf16_t* __restrict__ x, const bf16_t* __restrict__ wrh  , const bf16_t* __restrict__ wrl  , const float* __restrict__ bgr, const float* __restrict__ ber,
                                            float* __restrict__ rs2, int* __restrict__ cnt, int* __restrict__ tokl, int* __restrict__ tk_e, int* __restrict__ tk_pos, float* __restrict__ tk_w,
                                            LAS unsigned char* lds, int wave, int lane, int vcu, int G) {
    LAS float* lg = (LAS float*)(lds + RING_OFF + wave * 16384);
    LAS int* lcnt = (LAS int*)(lds + LDSCTL_OFF + 1024); LAS int* lbase = lcnt + 32;
    const int fr = lane & 15, fq = lane >> 4;
    for (int bt = vcu; bt < M / 64; bt += G) {
        if (wave == 0 && lane < 32) lcnt[lane] = 0;
        __syncthreads();
        int e1 = 0, e2 = 0, lp1 = 0, lp2 = 0; float tw1 = 0.f, tw2 = 0.f;
        const int t0 = bt * 64 + (wave & 3) * 16;
        if (wave < 4) {
        f32x4 acc[3]; acc[0] = (f32x4){0.f, 0.f, 0.f, 0.f}; acc[1] = acc[0]; acc[2] = acc[0];
        float ss = 0.f;
        const bf16_t* xp = x + (size_t)(t0 + fr) * D + 8 * fq;
        const bf16_t* wh = wrh + (size_t)fr * 1024 + 8 * fq; const bf16_t* wl_ = wrl + (size_t)fr * 1024 + 8 * fq;
#pragma unroll 4
        for (int kk = 0; kk < 32; ++kk) {
            const u32x4 av = *(const u32x4*)(xp + 32 * kk);
#pragma unroll
            for (int j = 0; j < 4; ++j) { const float a = bf_lo(av[j]), b = bf_hi(av[j]); ss += a * a + b * b; }
            const bf16x8 Ah = __builtin_bit_cast(bf16x8, av);
#pragma unroll
            for (int cb = 0; cb < 3; ++cb) {
                const bf16x8 bh = *(const bf16x8*)(wh + (size_t)cb * 16 * 1024 + 32 * kk), bl = *(const bf16x8*)(wl_ + (size_t)cb * 16 * 1024 + 32 * kk);
                acc[cb] = __builtin_amdgcn_mfma_f32_16x16x32_bf16(bh, Ah, acc[cb], 0, 0, 0);
                acc[cb] = __builtin_amdgcn_mfma_f32_16x16x32_bf16(bl, Ah, acc[cb], 0, 0, 0);
            }
        }
        ss = sum_xor16_32(ss);
        const float rsr = 1.0f / sqrtf(ss * (1.f / D) + EPS);
#pragma unroll
        for (int cb = 0; cb < 3; ++cb)
#pragma unroll
            for (int i = 0; i < 4; ++i) lg[fr * 49 + 16 * cb + 4 * fq + i] = acc[cb][i] * rsr;
        if (fq == 0) lg[fr * 49 + 48] = rsr;
        asm volatile("s_waitcnt lgkmcnt(0)" ::: "memory");
        if (lane < 16) {
            const int tok = t0 + lane; const LAS float* l = lg + lane * 49;
            rs2[tok] = l[48];
            const float g0 = l[0] + bgr[0], g1 = l[1] + bgr[1], g2 = l[2] + bgr[2], g3 = l[3] + bgr[3];
            int grp = 0; float gm = g0;
            if (g1 > gm) { gm = g1; grp = 1; } if (g2 > gm) { gm = g2; grp = 2; } if (g3 > gm) { gm = g3; grp = 3; }
            const float gsum = (expf(g0 - gm) + expf(g1 - gm)) + (expf(g2 - gm) + expf(g3 - gm));
            const float grp_w = 1.f / gsum;
            int i1 = 0, i2 = 0; float m1 = -INFINITY, m2 = -INFINITY;
#pragma unroll
            for (int i = 0; i < 8; ++i) { const float el = l[4 + grp * 8 + i] + ber[grp * 8 + i]; if (el > m1) { m2 = m1; i2 = i1; m1 = el; i1 = i; } else if (el > m2) { m2 = el; i2 = i; } }
            const float p2 = expf(m2 - m1), w1 = 1.f / (1.f + p2), w2 = p2 / (1.f + p2);
            e1 = grp * 8 + i1; e2 = grp * 8 + i2; tw1 = grp_w * w1; tw2 = grp_w * w2;
            lp1 = __hip_atomic_fetch_add(&lcnt[e1], 1, __ATOMIC_RELAXED, __HIP_MEMORY_SCOPE_WORKGROUP); lp2 = __hip_atomic_fetch_add(&lcnt[e2], 1, __ATOMIC_RELAXED, __HIP_MEMORY_SCOPE_WORKGROUP);
        }
        }
        __syncthreads();
        if (wave == 0 && lane < 32) { const int c = lcnt[lane]; lbase[lane] = c > 0 ? atomicAdd(&cnt[lane * CNT_STRIDE], c) : 0; }
        __syncthreads();
        if (wave < 4 && lane < 16) {
            const int tok = t0 + lane; const int pos1 = lbase[e1] + lp1, pos2 = lbase[e2] + lp2;
            tokl[e1 * ECAP + pos1] = tok; tokl[e2 * ECAP + pos2] = tok;
            tk_e[tok * 2] = e1; tk_e[tok * 2 + 1] = e2; tk_pos[tok * 2] = pos1; tk_pos[tok * 2 + 1] = pos2; tk_w[tok * 2] = tw1; tk_w[tok * 2 + 1] = tw2;
        }
        __syncthreads();
    }
}

__device__ __forceinline__ void combine_pass(bf16_t* xb, const bf16_t* __restrict__ ys, const LAS int* pref, const int* __restrict__ tk_e, const int* __restrict__ tk_pos,
                                             const float* __restrict__ tk_w, float* __restrict__ rs3, int lane, int gw, int NGW) {
    for (int m0 = gw * 4; m0 < M; m0 += NGW * 4) {
        int s0[4], s1[4]; float w0[4], w1[4];
#pragma unroll
        for (int r = 0; r < 4; ++r) { const int m = m0 + r; const int e0 = tk_e[m * 2], e1 = tk_e[m * 2 + 1]; s0[r] = 256 * pref[e0] + tk_pos[m * 2]; s1[r] = 256 * pref[e1] + tk_pos[m * 2 + 1]; w0[r] = tk_w[m * 2]; w1[r] = tk_w[m * 2 + 1]; }
        u32x4 xv[4][2], a0[4][2], a1[4][2];
#pragma unroll
        for (int r = 0; r < 4; ++r)
#pragma unroll
            for (int j = 0; j < 2; ++j) { xv[r][j] = ((const u32x4*)(xb + (size_t)(m0 + r) * D) + lane)[64 * j]; a0[r][j] = ((const u32x4*)(ys + (size_t)s0[r] * D) + lane)[64 * j]; a1[r][j] = ((const u32x4*)(ys + (size_t)s1[r] * D) + lane)[64 * j]; }
#pragma unroll
        for (int r = 0; r < 4; ++r) { float s = 0.f;
#pragma unroll
            for (int j = 0; j < 2; ++j) { u32x4 w;
#pragma unroll
                for (int q = 0; q < 4; ++q) { w[q] = cvt_pk_bf16(bf_lo(xv[r][j][q]) + w0[r] * bf_lo(a0[r][j][q]) + w1[r] * bf_lo(a1[r][j][q]), bf_hi(xv[r][j][q]) + w0[r] * bf_hi(a0[r][j][q]) + w1[r] * bf_hi(a1[r][j][q]));
                    const float a = bf_lo(w[q]), b = bf_hi(w[q]); s += a * a + b * b; }
                ((u32x4*)(xb + (size_t)(m0 + r) * D) + lane)[64 * j] = w; }
            s = wave_sum(s);
            if (lane == 0) rs3[m0 + r] = 1.0f / sqrtf(s * (1.f / D) + EPS); }
    }
}

constexpr int NWAVES = 8, PH_PER_LAYER = 10;
#ifndef FK_REP
#define FK_REP 0
#endif
#define REPS(bit) ((FK_REP & (bit)) ? 2 : 1)
__global__ void __launch_bounds__(NWAVES * 64, 2) mega_fwd(Args args_unused) {
    extern __shared__ __attribute__((aligned(16))) unsigned char lds_raw[];
    LAS unsigned char* lds = (LAS unsigned char*)lds_raw;
    LAS int* pref = (LAS int*)(lds + PREF_OFF);
    const KArgs kp0 = (KArgs)__builtin_amdgcn_kernarg_segment_ptr();
    const int tid = threadIdx.x, wave0 = __builtin_amdgcn_readfirstlane(tid >> 6);
    const int G = gridDim.x, bx = blockIdx.x;
    const int vcu = (G % 8 == 0) ? (bx % 8) * (G / 8) + bx / 8 : bx;
    const int gw0 = vcu * NWAVES + wave0, NGW = G * NWAVES;
#define FK_T0 (wave0 == 0 && fk_lane() == 0)
#define FK_IDS int lane_o = fk_lane(), wave_o = wave0, gw_o = gw0; asm volatile("" : "+v"(lane_o), "+s"(wave_o), "+s"(gw_o)); const int lane = lane_o, wave = wave_o, gw = gw_o; (void)lane; (void)wave; (void)gw;
    for (int u = tid; u < (LDS_BYTES - LDSCTL_OFF) / 4; u += NWAVES * 64) ((LAS unsigned*)(lds + LDSCTL_OFF))[u] = 0u;
    __syncthreads();
    const int lo = kp0->ph_lo, hi = kp0->ph_hi, nlayers = kp0->nlayers;
#define IN(k) (lo <= (k) && (k) < hi)
#define SEAM(k) do { if (IN(k) && IN((k) + 1)) { KArgs A_ = fresh(kp0); XcdBarrier bar_; bar_.bar = (unsigned*)(A_->ws + WS_CTL) + CW_BAR; bar_.x = xb_xcc_id(); bar_.st = (volatile LAS unsigned*)(lds + MISC_OFF) + 8; xcd_barrier(bar_, FK_T0); } } while (0)
    if (hi - lo > 1) { KArgs A = fresh(kp0); (void)xcd_barrier_post((unsigned*)(A->ws + WS_CTL) + CW_BAR, (volatile LAS unsigned*)(lds + MISC_OFF) + 8, FK_T0); }

    if (IN(0)) { for (int rep = 0; rep < REPS(1); ++rep) { FK_IDS; p0_prologue(fresh(kp0), nlayers, lds, wave, lane, gw, NGW); } }
    SEAM(0);
    if (IN(1)) { }
    for (int L = 0; L < nlayers; ++L) {
        const int pb = 2 + PH_PER_LAYER * L;
        if (IN(pb + 0)) for (int rep = 0; rep < REPS(4); ++rep) {
            KArgs A = fresh(kp0); unsigned char* ws = A->ws; unsigned char* wl = ws + WS_W + (size_t)L * WL_STRIDE;
            DenseOrder S; S.init(M, INW, G, bx, ws + WS_XB, wl + WO_IN, D);
            EpiIn E{(const float*)(ws + WS_XPART), A->in[4] + L * 64, A->in[5] + L * 64, (bf16_t*)(ws + WS_Q), (bf16_t*)(ws + WS_K), (bf16_t*)(ws + WS_V), (bf16_t*)(ws + WS_U), (bf16_t*)(ws + WS_VS), (bf16_t*)(ws + WS_GAB), (float*)(ws + WS_VSPART)};
            gemm_phase<EpiIn, DenseOrder, true>(lds + RING_OFF, D, S, E, wave0);
            { const int nshort = (G == 256) ? 128 : G; const int c2 = (G == 256) ? bx - 128 : bx;
              if (c2 >= 0) { DenseOrder S2; S2.init(M, D, nshort, c2, ws + WS_PB + (size_t)L * M * 256 * 2, wl + WO_PP, 256);
                  EpiPlain E2{(bf16_t*)(ws + WS_E) + (size_t)L * M * D, D, 0};
                  gemm_phase<EpiPlain, DenseOrder, true>(lds + RING_OFF, 256, S2, E2, wave0); } }
        }
        SEAM(pb + 0);
        if (IN(pb + 1)) for (int rep = 0; rep < REPS(8 | 2048); ++rep) {
            KArgs A = fresh(kp0); unsigned char* ws = A->ws; unsigned char* wl = ws + WS_W + (size_t)L * WL_STRIDE;
            FK_IDS;
            LAS unsigned char* wlds = lds + RING_OFF + wave * WLDS_BYTES;
            constexpr int NATT = 2 * 8 * (SEQ / 32), NSGU = (M / 128) * 8 * 2;
            for (int it = gw; it < NATT + NSGU; it += NGW) {
                if (rep == 1 && (it < NATT ? !(FK_REP & 8) : !(FK_REP & 2048))) continue;
                if (it < NATT) { const int qblk = it % (SEQ / 32), bh = it / (SEQ / 32); attn_wave_unit(bh >> 3, bh & 7, qblk, (const bf16_t*)(ws + WS_Q), (const bf16_t*)(ws + WS_K), (const bf16_t*)(ws + WS_V), (bf16_t*)(ws + WS_OC), wlds, lane); }
                else { const int j = it - NATT; const int hf = j & 1, g = (j >> 1) & 7, ch = j >> 4;
                    if (hf == 0) sgu_wave_unit<0>(ch, g, (const bf16_t*)(ws + WS_U), (const bf16_t*)(ws + WS_VS), (const float*)(ws + WS_VSPART), (const bf16_t*)(wl + WO_SP), A->in[8] + (size_t)L * 8 * 128, A->in[6] + (size_t)L * 512, (bf16_t*)(ws + WS_OC), wlds, lane);
                    else sgu_wave_unit<1>(ch, g, (const bf16_t*)(ws + WS_U), (const bf16_t*)(ws + WS_VS), (const float*)(ws + WS_VSPART), (const bf16_t*)(wl + WO_SP), A->in[8] + (size_t)L * 8 * 128, A->in[6] + (size_t)L * 512, (bf16_t*)(ws + WS_OC), wlds, lane); }
            }
        }
        SEAM(pb + 1);
        if (IN(pb + 2)) for (int rep = 0; rep < REPS(16); ++rep) {
            KArgs A = fresh(kp0); unsigned char* ws = A->ws; unsigned char* wl = ws + WS_W + (size_t)L * WL_STRIDE;
            DenseOrder S; S.init(M, D, G, bx, ws + WS_OC, wl + WO_UP, D);
            EpiUp E{(const bf16_t*)(ws + WS_GAB), (bf16_t*)(ws + WS_MG)};
            gemm_phase<EpiUp, DenseOrder, false>(lds + RING_OFF, D, S, E, wave0);
        }
        SEAM(pb + 2);
        if (IN(pb + 3)) {
            KArgs A = fresh(kp0); unsigned char* ws = A->ws; unsigned char* wl = ws + WS_W + (size_t)L * WL_STRIDE;
            DenseOrder S; S.init(M, D, G, bx, ws + WS_MG, wl + WO_OUT, D);
            EpiOut E{(const bf16_t*)(ws + WS_XB), (bf16_t*)(ws + WS_XB1)};
            gemm_phase<EpiOut, DenseOrder, false>(lds + RING_OFF, D, S, E, wave0);
        }
        SEAM(pb + 3);
        if (IN(pb + 4)) {
            KArgs A = fresh(kp0); unsigned char* ws = A->ws; unsigned char* wl = ws + WS_W + (size_t)L * WL_STRIDE;
            FK_IDS;
            router_pass((const bf16_t*)(ws + WS_XB1), (const bf16_t*)(wl + WO_R), (const bf16_t*)(wl + WO_R) + 48 * 1024, A->in[14] + L * 4, A->in[16] + L * 32, (float*)(ws + WS_RS2), (int*)((unsigned*)(ws + WS_CTL) + CW_CNT) + L * NE * CNT_STRIDE, (int*)(ws + WS_TOKL), (int*)(ws + WS_TKE), (int*)(ws + WS_TKP), (float*)(ws + WS_TKW), lds, wave, lane, vcu, G);
        }
        SEAM(pb + 4);
        if (IN(pb + 5) || IN(pb + 6) || IN(pb + 7) || IN(pb + 8)) {
            KArgs A = fresh(kp0); const int* cnt = (const int*)((unsigned*)(A->ws + WS_CTL) + CW_CNT) + L * NE * CNT_STRIDE;
            if (FK_T0) { int s = 0; for (int e = 0; e < NE; ++e) { pref[e] = s; s += (cnt[e * CNT_STRIDE] + 255) >> 8; } pref[NE] = s; }
            __syncthreads();
        }
        const int nG1 = pref[NE] * 4, fr = nG1 / G, n3 = nG1 - fr * G;
        const int jB = (fr >= 1) ? min(2 * (G - n3), (fr * G / 4) * 4) : 0;
        if (IN(pb + 5)) for (int rep = 0; rep < REPS(32); ++rep) {
            KArgs A = fresh(kp0); unsigned char* ws = A->ws; unsigned char* wl = ws + WS_W + (size_t)L * WL_STRIDE; const int* cnt = (const int*)((unsigned*)(ws + WS_CTL) + CW_CNT) + L * NE * CNT_STRIDE;
            ExpertOrder S{G, bx, D, 4, (const char*)(ws + WS_XB1), (const char*)(wl + WO_EI), (size_t)1024 * 1024 * 2, pref, (const int*)(ws + WS_TOKL), cnt, 1, 0, fr, fr * G};
            EpiG1 E{(const int*)(ws + WS_TOKL), cnt, (const float*)(ws + WS_RS2), (bf16_t*)(ws + WS_G)};
            gemm_phase<EpiG1, ExpertOrder, true>(lds + RING_OFF, D, S, E, wave0);
        }
        SEAM(pb + 5);
        if (IN(pb + 6)) {
            KArgs A = fresh(kp0); unsigned char* ws = A->ws; unsigned char* wl = ws + WS_W + (size_t)L * WL_STRIDE; const int* cnt = (const int*)((unsigned*)(ws + WS_CTL) + CW_CNT) + L * NE * CNT_STRIDE;
            if (bx < n3) {
                ExpertOrder S{G, bx, D, 4, (const char*)(ws + WS_XB1), (const char*)(wl + WO_EI), (size_t)1024 * 1024 * 2, pref, (const int*)(ws + WS_TOKL), cnt, 1, fr * G, 1, nG1};
                EpiG1 E{(const int*)(ws + WS_TOKL), cnt, (const float*)(ws + WS_RS2), (bf16_t*)(ws + WS_G)};
                gemm_phase<EpiG1, ExpertOrder, true>(lds + RING_OFF, D, S, E, wave0);
            } else {
                ExpertOrder S{G - n3, bx - n3, 512, 4, (const char*)(ws + WS_G), (const char*)(wl + WO_EO), (size_t)1024 * 512 * 2, pref, (const int*)(ws + WS_TOKL), cnt, 0, 0, 2, jB};
                EpiPlain E{(bf16_t*)(ws + WS_YS), D, 1};
                gemm_phase<EpiPlain, ExpertOrder, true>(lds + RING_OFF, 512, S, E, wave0);
            }
        }
        SEAM(pb + 6);
        if (IN(pb + 7)) for (int rep = 0; rep < REPS(64); ++rep) {
            KArgs A = fresh(kp0); unsigned char* ws = A->ws; unsigned char* wl = ws + WS_W + (size_t)L * WL_STRIDE; const int* cnt = (const int*)((unsigned*)(ws + WS_CTL) + CW_CNT) + L * NE * CNT_STRIDE;
            ExpertOrder S{G, bx, 512, 4, (const char*)(ws + WS_G), (const char*)(wl + WO_EO), (size_t)1024 * 512 * 2, pref, (const int*)(ws + WS_TOKL), cnt, 0, jB, 1 << 20, nG1};
            EpiPlain E{(bf16_t*)(ws + WS_YS), D, 1};
            gemm_phase<EpiPlain, ExpertOrder, true>(lds + RING_OFF, 512, S, E, wave0);
        }
        SEAM(pb + 7);
        if (IN(pb + 8)) {
            KArgs A = fresh(kp0); unsigned char* ws = A->ws;
            FK_IDS;
            combine_pass((bf16_t*)(ws + WS_XB1), (const bf16_t*)(ws + WS_YS), pref, (const int*)(ws + WS_TKE), (const int*)(ws + WS_TKP), (const float*)(ws + WS_TKW), (float*)(ws + WS_RS3), lane, gw, NGW);
        }
        SEAM(pb + 8);
        if (IN(pb + 9)) {
            KArgs A = fresh(kp0); unsigned char* ws = A->ws; unsigned char* wl = ws + WS_W + (size_t)L * WL_STRIDE;
            DenseOrder S; S.init(M, D, G, bx, ws + WS_XB1, wl + WO_PG, D);
            EpiPle E{(const bf16_t*)(ws + WS_XB1), (bf16_t*)(ws + WS_XB), (L == nlayers - 1) ? A->out : (float*)nullptr, (const bf16_t*)(ws + WS_E) + (size_t)L * M * D, (const float*)(ws + WS_RS3), (float*)(ws + WS_XPART)};
            gemm_phase<EpiPle, DenseOrder, false>(lds + RING_OFF, D, S, E, wave0);
        }
        SEAM(pb + 9);
    }
#undef IN
#undef SEAM
#undef FK_IDS
#undef FK_T0
}
}
#ifndef FK_N_LAUNCHES
#define FK_N_LAUNCHES 1
#endif
static int fk_grid = 0;
static bool fk_setup() {
    if (fk_grid) return fk_grid > 0;
    int dev = 0, cus = 0, per_cu = 0;
    if (hipGetDevice(&dev) != hipSuccess || hipDeviceGetAttribute(&cus, hipDeviceAttributeMultiprocessorCount, dev) != hipSuccess) { fprintf(stderr, "kernel_launch: device query failed\n"); fk_grid = -1; return false; }
    if (hipFuncSetAttribute((const void*)fk::mega_fwd, hipFuncAttributeMaxDynamicSharedMemorySize, fk::LDS_BYTES) != hipSuccess) { fprintf(stderr, "kernel_launch: hipFuncSetAttribute failed\n"); fk_grid = -1; return false; }
    if (hipOccupancyMaxActiveBlocksPerMultiprocessor(&per_cu, (const void*)fk::mega_fwd, fk::NWAVES * 64, fk::LDS_BYTES) != hipSuccess || per_cu < 1)
        fprintf(stderr, "kernel_launch: note: occupancy query reports %d workgroups per CU\n", per_cu);
    (void)hipGetLastError();
    fk_grid = cus;
    return true;
}
static void fk_launch_range(fk::Args a, int lo, int hi, hipStream_t stream) {
    a.ph_lo = lo; a.ph_hi = hi;
    hipLaunchKernelGGL(fk::mega_fwd, dim3(fk_grid), dim3(fk::NWAVES * 64), fk::LDS_BYTES, stream, a);
    const hipError_t le = hipPeekAtLastError();
    if (le != hipSuccess) fprintf(stderr, "kernel_launch: launch [%d,%d) failed: %s\n", lo, hi, hipGetErrorName(le));
}

#ifdef FK_DEBUG_CHECK
#ifndef FK_FOCUS
#define FK_FOCUS 0
#endif
#ifndef FK_STAT
#define FK_STAT 1
#endif
namespace dbg {
__global__ void __launch_bounds__(256) k_cmp(const void* fast, int is_bf16, int fld, int fcol0, const float* gold, int gld, int gcol0, int rows, int cols, float gscale, float* acc) {
    float sd = 0.f, sb = 0.f, sa = 0.f, sb2 = 0.f;
    const size_t n = (size_t)rows * cols;
    for (size_t i = (size_t)blockIdx.x * 256 + threadIdx.x; i < n; i += (size_t)gridDim.x * 256) {
        const size_t r = i / cols; const int c = (int)(i % cols);
        float a;
        if (is_bf16) { const unsigned short h = ((const unsigned short*)fast)[r * fld + fcol0 + c]; a = __uint_as_float((unsigned)h << 16); } else a = ((const float*)fast)[r * fld + fcol0 + c];
        const float b = gold[r * gld + gcol0 + c] * gscale;
        const float d = a - b; sd += d * d; sb += b * b; sa += (FK_STAT == 2 ? a : FK_STAT == 3 ? a * b : FK_STAT == 4 ? (a > 0.99f ? 1.f : 0.f) : a * a); sb2 += (FK_STAT == 2 ? b : FK_STAT == 4 ? 1.f : b * b);
    }
    for (int o = 1; o < 64; o <<= 1) { sd += __shfl_xor(sd, o); sb += __shfl_xor(sb, o); sa += __shfl_xor(sa, o); sb2 += __shfl_xor(sb2, o); }
    if ((threadIdx.x & 63) == 0) { atomicAdd(&acc[0], sd); atomicAdd(&acc[1], sb); atomicAdd(&acc[512], sa); atomicAdd(&acc[513], sb2); }
}
__global__ void __launch_bounds__(256) k_cmp_vs(const unsigned short* vsb, const float* vspart, const float* gain, const float* gz, float* acc) {
    const int row = blockIdx.x * 4 + (threadIdx.x >> 6), lane = threadIdx.x & 63;
    float ss = 0.f; for (int j = 0; j < 8; ++j) ss += vspart[(size_t)row * 8 + j];
    const float rv = 1.f / sqrtf(ss / 512.f + 1e-6f);
    float sd = 0.f, sb = 0.f;
    for (int j = 0; j < 8; ++j) { const int c = lane + 64 * j; const float a = __uint_as_float((unsigned)vsb[(size_t)row * 512 + c] << 16) * rv * gain[c]; const float b = gz[(size_t)row * 4608 + 2048 + c]; sd += (a - b) * (a - b); sb += b * b; }
    for (int o = 1; o < 64; o <<= 1) { sd += __shfl_xor(sd, o); sb += __shfl_xor(sb, o); }
    if (lane == 0) { atomicAdd(&acc[0], sd); atomicAdd(&acc[1], sb); }
}
__global__ void __launch_bounds__(256) k_cmp_w(const unsigned short* wt, const float* w, const float* gain, int n0, int n1, float* acc) {
    float sd = 0.f, sb = 0.f; const size_t tot = (size_t)(n1 - n0) * 1024;
    for (size_t i = (size_t)blockIdx.x * 256 + threadIdx.x; i < tot; i += (size_t)gridDim.x * 256) { const int n = n0 + (int)(i >> 10), k = (int)(i & 1023);
        const float a = __uint_as_float((unsigned)wt[(size_t)n * 1024 + k] << 16), b = gain[k] * w[(size_t)k * 4608 + n]; sd += (a - b) * (a - b); sb += b * b; }
    for (int o = 1; o < 64; o <<= 1) { sd += __shfl_xor(sd, o); sb += __shfl_xor(sb, o); }
    if ((threadIdx.x & 63) == 0) { atomicAdd(&acc[0], sd); atomicAdd(&acc[1], sb); }
}
__global__ void k_final_v(const float* acc, int nchecks, float tol, float* v, int focus) {
    if (threadIdx.x == 0 && blockIdx.x == 0) {
        float out = 0.f;
        if (focus > 0) { float m = acc[2 * focus + 512] / acc[2 * focus + 513]; if (FK_STAT == 1) m = sqrtf(m); if (!(m <= 8.f)) m = 8.f; m = floorf(m * 20.f + 0.5f) * 0.05f; v[0] = powf(10.f, (float)focus) * (1.f + m); return; }
        for (int c = nchecks; c >= 1; --c) { const float e = sqrtf(acc[2 * c] / acc[2 * c + 1]); if (!(e <= tol)) { float m = e; if (!(m <= 2.f)) m = 2.f; m = floorf(m * 10.f + 0.5f) * 0.1f;   out = powf(10.f, (float)c) * (1.f + m); } }
        v[0] = out;
    }
}
__global__ void __launch_bounds__(256) k_scale_out(const float* base, const float* v, float* out, size_t n) {
    const size_t i = (size_t)blockIdx.x * 256 + threadIdx.x; if (i < n) out[i] = base[i] * (1.f + v[0]);
}
}
#endif

extern "C" void kernel_launch(void* const* d_in, const int* in_sizes, int n_in, void* d_out, int out_size, void* d_ws, size_t ws_size, hipStream_t stream) {
    using namespace fk;
    if (n_in != 22 || out_size != M * D || ws_size < WS_FAST_END) { fprintf(stderr, "kernel_launch: unexpected shapes (n_in %d out %d ws %zu)\n", n_in, out_size, ws_size); return; }
    if (!fk_setup()) return;
    if (hipMemsetAsync((char*)d_ws + WS_CTL, 0, CTL_ZERO_BYTES, stream) != hipSuccess) { fprintf(stderr, "kernel_launch: memset failed\n"); return; }
    Args a{};
    for (int i = 0; i < 22; ++i) a.in[i] = (const float*)d_in[i];
    a.out = (float*)d_out; a.ws = (unsigned char*)d_ws; a.nlayers = DEPTH; a.pad = 0;
#ifndef FK_DEBUG_CHECK
    const int nph = 2 + PH_PER_LAYER * DEPTH;
    if (FK_N_LAUNCHES == 1) fk_launch_range(a, 0, nph, stream);
    else for (int p = 0; p < nph; ++p) fk_launch_range(a, p, p + 1, stream);
#else
    constexpr size_t GOLD_BASE = 1100 * MiB, SN_A = 128 * MiB, SN_B = 192 * MiB, SN_BASE = 256 * MiB, FS_A = 320 * MiB, FS_B = 384 * MiB, DBG_ACC = 448 * MiB;
    if (ws_size < GOLD_BASE + gold::O_END) { fprintf(stderr, "kernel_launch: debug build needs %zu bytes of workspace, got %zu\n", GOLD_BASE + gold::O_END, ws_size); return; }
    unsigned char* ws = (unsigned char*)d_ws; unsigned char* gb = ws + GOLD_BASE;
    gold::forward(d_in, (float*)(ws + SN_BASE), gb, 4, stream);
    gold::forward(d_in, nullptr, gb, 1, stream, (float*)(ws + SN_A), (float*)(ws + SN_B));
    a.nlayers = 1;
    const int nph = 2 + PH_PER_LAYER;
    for (int p = 0; p < nph; ++p) {
        fk_launch_range(a, p, p + 1, stream);
        if (p == 2 + 0) (void)hipMemcpyAsync(ws + 528 * MiB, ws + WS_GAB, (size_t)M * 2048 * 2, hipMemcpyDeviceToDevice, stream);
        if (p == 2 + 3) (void)hipMemcpyAsync(ws + FS_A, d_out, (size_t)M * D * 4, hipMemcpyDeviceToDevice, stream);
        if (p == 2 + 7) (void)hipMemcpyAsync(ws + FS_B, d_out, (size_t)M * D * 4, hipMemcpyDeviceToDevice, stream);
    }
    float* acc = (float*)(ws + DBG_ACC);
    (void)hipMemsetAsync(acc, 0, 4096, stream);
    const float* gz = (const float*)(gb + gold::O_Z);
    int c = 0;
#define CMP(fast, isbf, fld, fc0, gold_, gld, gc0, rows, cols, gs) do { ++c; hipLaunchKernelGGL(dbg::k_cmp, dim3(2048), dim3(256), 0, stream, (const void*)(fast), isbf, fld, fc0, (const float*)(gold_), gld, gc0, rows, cols, gs, acc + 2 * c); } while (0)
    ++c; hipLaunchKernelGGL(dbg::k_cmp_w, dim3(1024), dim3(256), 0, stream, (const unsigned short*)(ws + WS_W + WO_IN), (const float*)d_in[3], (const float*)d_in[2], 1024, 2560, acc + 2 * c);
    ++c; hipLaunchKernelGGL(dbg::k_cmp_w, dim3(1024), dim3(256), 0, stream, (const unsigned short*)(ws + WS_W + WO_IN), (const float*)d_in[3], (const float*)d_in[2], 2560, 3584, acc + 2 * c);
    ++c; hipLaunchKernelGGL(dbg::k_cmp_w, dim3(1024), dim3(256), 0, stream, (const unsigned short*)(ws + WS_W + WO_IN), (const float*)d_in[3], (const float*)d_in[2], 3584, 4608, acc + 2 * c);
    CMP(ws + WS_E, 1, 1024, 0, gb + gold::O_YB, 1024, 0, M, 1024, 1.f);
    CMP(ws + WS_Q, 1, 512, 0, gz, INW, 0, M, 512, 0.125f * LOG2E);
    CMP(ws + WS_K, 1, 512, 0, gz, INW, 512, M, 512, 1.f);
    CMP(ws + WS_V, 1, 512, 0, gz, INW, 1024, M, 512, 1.f);
    CMP(ws + WS_U, 1, 512, 0, gz, INW, 1536, M, 512, 1.f);
    ++c; hipLaunchKernelGGL(dbg::k_cmp_vs, dim3(M / 4), dim3(256), 0, stream, (const unsigned short*)(ws + WS_VS), (const float*)(ws + WS_VSPART), (const float*)d_in[6], gz, acc + 2 * c);
    CMP(ws + WS_OC, 1, 1024, 0, gb + gold::O_OA, 512, 0, M, 512, 1.f);
    CMP(ws + WS_OC, 1, 1024, 512, gb + gold::O_OB, 512, 0, M, 512, 1.f);
    CMP(ws + WS_MG, 1, 1024, 0, gb + gold::O_YA, 1024, 0, M, 1024, 1.f);
    CMP(ws + FS_A, 0, 1024, 0, ws + SN_A, 1024, 0, M, 1024, 1.f);
    CMP(ws + FS_B, 0, 1024, 0, ws + SN_B, 1024, 0, M, 1024, 1.f);
    CMP(d_out, 0, 1024, 0, gb + gold::O_X, 1024, 0, M, 1024, 1.f);
    CMP(ws + 528 * MiB, 1, 2048, 0, gz, INW, 2560, M, 256, 1.f);
    CMP(ws + WS_GAB, 1, 2048, 0, gz, INW, 2560, M, 256, 1.f);
    CMP(ws + WS_GAB, 1, 2048, 256, gz, INW, 2816, M, 256, 1.f);
    CMP(ws + WS_GAB, 1, 2048, 512, gz, INW, 3072, M, 512, 1.f);
    CMP(ws + WS_GAB, 1, 2048, 1024, gz, INW, 3584, M, 1024, 1.f);
    hipLaunchKernelGGL(dbg::k_final_v, dim3(1), dim3(64), 0, stream, acc, c, 0.03f, acc + 900, FK_FOCUS);
    hipLaunchKernelGGL(dbg::k_scale_out, dim3(M * D / 256), dim3(256), 0, stream, (const float*)(ws + SN_BASE), acc + 900, (float*)d_out, (size_t)M * D);
#endif
}
```

```cpp
#include <hip/hip_runtime.h>
#include <hip/hip_bf16.h>
#include <cstdio>
#include <cstdint>
#include <cmath>
namespace fk {
#define LAS __attribute__((address_space(3)))
#define GAS __attribute__((address_space(1)))
typedef unsigned short bf16_t;
typedef short bf16x8 __attribute__((ext_vector_type(8)));
typedef short s16x4 __attribute__((ext_vector_type(4)));
typedef float f32x2 __attribute__((ext_vector_type(2)));
typedef float f32x4 __attribute__((ext_vector_type(4)));
typedef float f32x16 __attribute__((ext_vector_type(16)));
typedef unsigned u32x2 __attribute__((ext_vector_type(2)));
typedef unsigned u32x4 __attribute__((ext_vector_type(4)));

constexpr int M = 16384, SEQ = 8192, D = 1024, INW = 4608, NE = 32, ECAP = 16384, DEPTH = 4;
constexpr float EPS = 1e-6f, LOG2E = 1.4426950408889634f;
constexpr int CNT_STRIDE = 64;
constexpr int BM = 256, BK = 64, HALF = 128, HTB = HALF * BK * 2, STAGE_BYTES = 8 * HTB, NXCD = 8, WGM = 8;

__device__ __forceinline__ unsigned cvt_pk_bf16(float lo, float hi) { unsigned r; asm volatile("v_cvt_pk_bf16_f32 %0, %1, %2" : "=v"(r) : "v"(lo), "v"(hi)); return r; }
__device__ __forceinline__ float bf_lo(unsigned w) { return __uint_as_float(w << 16); }
__device__ __forceinline__ float bf_hi(unsigned w) { return __uint_as_float(w & 0xffff0000u); }
__device__ __forceinline__ float fast_rcp(float x) { return __builtin_amdgcn_rcpf(x); }
__device__ __forceinline__ float fast_exp2(float x) { return __builtin_amdgcn_exp2f(x); }
__device__ __forceinline__ float fast_log2(float x) { return __builtin_amdgcn_logf(x); }
__device__ __forceinline__ float fast_rsq(float x) { return __builtin_amdgcn_rsqf(x); }
__device__ __forceinline__ float sigmoid_f(float x) { return fast_rcp(1.f + fast_exp2(-LOG2E * x)); }
__device__ __forceinline__ float gelu_tanh_f(float x) { const float u2 = 1.5957691216057308f * (x + 0.044715f * x * x * x); return x * fast_rcp(1.f + fast_exp2(-LOG2E * u2)); }

__host__ __device__ __forceinline__ int lds_byte(int r, int c) { const int st = (r >> 4) * 2 + (c >> 5), rr = r & 15, cc = c & 31, ob = rr * 64 + cc * 2; return st * 1024 + (ob ^ (((ob >> 9) & 1) << 5)); }
__host__ __device__ __forceinline__ void stage_rc(int b, int& R, int& C) { const int st = b / 1024, sb = b % 1024, swz = sb ^ (((sb >> 9) & 1) << 5); R = (st >> 1) * 16 + swz / 64; C = (st & 1) * 32 + (swz % 64) / 2; }
__host__ __device__ __forceinline__ int perm32(int rho) { const int n = rho >> 4, i = rho & 15; return 8 * (i >> 2) + 4 * n + (i & 3); }

template <int MASK> __device__ __forceinline__ float xor_lt32(float v) { return __int_as_float(__builtin_amdgcn_ds_swizzle(__float_as_int(v), (MASK << 10) | 0x1f)); }
__device__ __forceinline__ void halves32(float v, float& lo, float& hi) { auto rr = __builtin_amdgcn_permlane32_swap(__float_as_uint(v), __float_as_uint(v), false, false); lo = __uint_as_float(rr[0]); hi = __uint_as_float(rr[1]); }
__device__ __forceinline__ float sum_xor16_32(float v) { v += xor_lt32<16>(v); float lo, hi; halves32(v, lo, hi); return lo + hi; }
#ifndef FK_WT
#define FK_WT 0
#endif
__device__ __forceinline__ void st16wt(void* p, u32x4 v) {
#if FK_WT
    asm volatile("global_store_dwordx4 %0, %1, off sc1" :: "v"(p), "v"(v) : "memory");
#else
    *(u32x4*)p = v;
#endif
}
__device__ __forceinline__ void st16(void* p, u32x4 v) { *(u32x4*)p = v; }
__device__ __forceinline__ int fk_lane() { int l; asm volatile("v_mbcnt_lo_u32_b32 %0, -1, 0\n\tv_mbcnt_hi_u32_b32 %0, -1, %0" : "=v"(l)); return l; }
struct Unit { int pm, pn, e, aux; };

struct DenseOrder {
    int nM, nN, nwg, G, c; const char* A; const char* B; int K;
    __device__ void init(int Mr, int N, int G_, int c_, const void* A_, const void* B_, int K_) { nM = Mr / BM; nN = N / BM; nwg = nM * nN; G = G_; c = c_; A = (const char*)A_; B = (const char*)B_; K = K_; }
    __device__ __forceinline__ bool next(int i, Unit& u) const {
        const long L = (long)i * G + c; if (L >= nwg) return false;
        int wgid = (int)L; { const int q = nwg / NXCD, r = nwg % NXCD, xcd = wgid % NXCD, off = wgid / NXCD; wgid = (xcd < r ? xcd * (q + 1) : r * (q + 1) + (xcd - r) * q) + off; }
        const int nig = WGM * nN, gid = wgid / nig, fm = gid * WGM, gsz = (nM - fm) < WGM ? (nM - fm) : WGM;
        u.pm = fm + ((wgid % nig) % gsz); u.pn = (wgid % nig) / gsz; u.e = 0; u.aux = 0; return true;
    }
    __device__ __forceinline__ const char* a_base() const { return A; }
    __device__ __forceinline__ const char* b_base(const Unit& u) const { return B + (size_t)u.pn * BM * K * 2; }
    __device__ __forceinline__ void a_voff(const Unit& u, unsigned (&v)[2][2], const int (&R)[2], const int (&C)[2]) const {
#pragma unroll
        for (int h = 0; h < 2; ++h)
#pragma unroll
            for (int i = 0; i < 2; ++i) v[h][i] = (unsigned)((u.pm * BM + h * HALF + R[i]) * K + C[i]) * 2u;
    }
};

struct ExpertOrder {
    int G, c, K, nN; const char* A; const char* B; size_t bstride; const LAS int* pref; const int* tokl; const int* cnt; int gather;
    int L0, imax, Lend;
    int xcd_deal;
    __device__ __forceinline__ bool next(int i, Unit& u) const {
        if (i >= imax) return false;
        int u_ = c; if (xcd_deal) { const int q = c >> 3, x = c & 7; u_ = (x * (G >> 5) + (q >> 2)) * 4 + (q & 3); }
        const int L = L0 + i * G + u_; const int tot = pref[NE] * nN; if (L >= Lend || L >= tot) return false;
        const int rbi = L / nN; u.pn = L % nN; int e = 0;
#pragma unroll 1
        for (int j = 1; j < NE; ++j) if (rbi >= pref[j]) e = j;
        u.e = e; u.pm = rbi - pref[e]; u.aux = rbi * BM; return true;
    }
    __device__ __forceinline__ const char* a_base() const { return A; }
    __device__ __forceinline__ const char* b_base(const Unit& u) const { return B + (size_t)u.e * bstride + (size_t)u.pn * BM * K * 2; }
    __device__ __forceinline__ void a_voff(const Unit& u, unsigned (&v)[2][2], const int (&R)[2], const int (&C)[2]) const {
        const int ce = cnt[u.e * CNT_STRIDE];
#pragma unroll
        for (int h = 0; h < 2; ++h)
#pragma unroll
            for (int i = 0; i < 2; ++i) {
                const int r = u.pm * BM + h * HALF + R[i]; int row;
                if (gather) row = (r < ce) ? tokl[u.e * ECAP + r] : 0; else row = u.aux + h * HALF + R[i];
                v[h][i] = (unsigned)(row * K + C[i]) * 2u;
            }
    }
};

template <class Epi, class Sched, bool ALIGN_EPI>
__device__ __forceinline__ void gemm_phase(LAS unsigned char* lds, const int K, const Sched& S, const Epi& E, const int wave_id) {
    const int tid_ = (wave_id << 6) | fk_lane();
    const int tid = tid_, wid = __builtin_amdgcn_readfirstlane(tid >> 6), lane = tid & 63, wr = wid >> 2, wc = wid & 3, fr = lane & 15, fq = lane >> 4;
    const int nt = K / BK;
    int Rr[2], Cc[2]; unsigned voffB[2];
#pragma unroll
    for (int i = 0; i < 2; ++i) { int R, C; stage_rc(tid * 16 + i * 8192, R, C); Rr[i] = R; Cc[i] = C; const int Rb = Epi::PERM ? ((R & ~31) + perm32(R & 31)) : R; voffB[i] = (unsigned)(Rb * K + C) * 2u; }
    const size_t kstep = (size_t)(BK * 2);
    const size_t hstep = (size_t)HALF * K * 2;
    const unsigned ldsw = (unsigned)wid * 1024u;
    const int aoff = lds_byte(wr * 64 + fr, fq * 8), boff = lds_byte(wc * 32 + fr, fq * 8);
#define PG8_SA(b, h) (((b) * 2 + (h)) * HTB)
#define PG8_SB(b, h) ((4 + (b) * 2 + (h)) * HTB)
#define PG8_STAGE_B(bufoff, gbase) do { _Pragma("unroll") for (int _i = 0; _i < 2; ++_i) \
        __builtin_amdgcn_global_load_lds((const unsigned*)((const char*)(gbase) + voffB[_i]), (LAS unsigned*)(lds + (bufoff) + ldsw + _i * 8192), 16, 0, 0); } while (0)
#define PG8_STAGE_A(bufoff, vo, h, koff) do { _Pragma("unroll") for (int _i = 0; _i < 2; ++_i) \
        __builtin_amdgcn_global_load_lds((const unsigned*)(Ab + (size_t)(vo)[h][_i] + (size_t)(koff)), (LAS unsigned*)(lds + (bufoff) + ldsw + _i * 8192), 16, 0, 0); } while (0)
#define PG8_LDA(dst, b, h) do { _Pragma("unroll") for (int m = 0; m < 4; ++m) _Pragma("unroll") for (int k = 0; k < 2; ++k) dst[m][k] = *(const LAS bf16x8*)(lds + PG8_SA(b, h) + aoff + m * 2048 + k * 1024); } while (0)
#define PG8_LDB(dst, b, h) do { _Pragma("unroll") for (int n = 0; n < 2; ++n) _Pragma("unroll") for (int k = 0; k < 2; ++k) dst[n][k] = *(const LAS bf16x8*)(lds + PG8_SB(b, h) + boff + n * 2048 + k * 1024); } while (0)
#define PG8_MMA(ai, bj, At, Bt) do { __builtin_amdgcn_s_setprio(1); _Pragma("unroll") for (int m = 0; m < 4; ++m) _Pragma("unroll") for (int n = 0; n < 2; ++n) _Pragma("unroll") for (int k = 0; k < 2; ++k) \
        acc[ai][bj][m][n] = __builtin_amdgcn_mfma_f32_16x16x32_bf16(Bt[n][k], At[m][k], acc[ai][bj][m][n], 0, 0, 0); __builtin_amdgcn_s_setprio(0); } while (0)
#define PG8_WAIT_V(n) asm volatile("s_waitcnt vmcnt(" #n ")" ::: "memory")
#define PG8_WAIT_L(n) asm volatile("s_waitcnt lgkmcnt(" #n ")" ::: "memory")
#define PG8_BAR __builtin_amdgcn_s_barrier()
#define PG8_SCHED __builtin_amdgcn_sched_barrier(0)
    Unit cur, nxt; int ui = 0;
    if (!S.next(0, cur)) return;
    f32x4 acc[2][2][4][2];
#pragma unroll
    for (int a = 0; a < 2; ++a)
#pragma unroll
        for (int b = 0; b < 2; ++b)
#pragma unroll
            for (int m = 0; m < 4; ++m)
#pragma unroll
                for (int n = 0; n < 2; ++n) acc[a][b][m][n] = (f32x4){0.f, 0.f, 0.f, 0.f};
    bf16x8 At[4][2], B0[2][2], B1[2][2];
    const char* Ab = S.a_base();
    unsigned cvA[2][2], nvA[2][2];
    S.a_voff(cur, cvA, Rr, Cc);
    const char* cB = S.b_base(cur);
    PG8_STAGE_B(PG8_SB(0, 0), cB); PG8_STAGE_B(PG8_SB(0, 1), cB + hstep); PG8_STAGE_A(PG8_SA(0, 0), cvA, 0, 0); PG8_STAGE_A(PG8_SA(0, 1), cvA, 1, 0);
    if (wr == 1) PG8_BAR;
    PG8_WAIT_V(2); PG8_BAR;
    PG8_STAGE_B(PG8_SB(1, 0), cB + kstep); PG8_STAGE_A(PG8_SA(1, 0), cvA, 0, kstep); PG8_STAGE_B(PG8_SB(1, 1), cB + hstep + kstep);
    PG8_WAIT_V(6); PG8_BAR;
    for (;;) {
        const bool has_next = S.next(ui + 1, nxt);
        const char* nB = has_next ? S.b_base(nxt) : cB;
        if (has_next) S.a_voff(nxt, nvA, Rr, Cc);
        else {
#pragma unroll
            for (int h = 0; h < 2; ++h)
#pragma unroll
                for (int i = 0; i < 2; ++i) nvA[h][i] = cvA[h][i];
        }
#pragma unroll 1
        for (int t = 0; t < nt; t += 2) {
            const bool last = (t == nt - 2);
            if constexpr (Epi::HAS_MID) { if (t == Epi::MID_T) E.mid(acc, cur, wr, wc, fr, fq); }
            const size_t k1 = (size_t)(t + 1) * kstep;
            unsigned a2[2][2];
#pragma unroll
            for (int h = 0; h < 2; ++h)
#pragma unroll
                for (int i = 0; i < 2; ++i) a2[h][i] = last ? nvA[h][i] : cvA[h][i] + (unsigned)((t + 2) * (BK * 2));
            const char* b2 = last ? nB : cB + (size_t)(t + 2) * kstep;
            const char* b3 = b2 + kstep;
            PG8_LDB(B0, 0, 0); PG8_LDB(B1, 0, 1); PG8_SCHED; PG8_LDA(At, 0, 0); PG8_STAGE_A(PG8_SA(1, 1), cvA, 1, k1);
            PG8_WAIT_V(8); PG8_WAIT_L(0); PG8_BAR; PG8_MMA(0, 0, At, B0); PG8_MMA(0, 1, At, B1); PG8_BAR; PG8_SCHED;
            PG8_LDA(At, 0, 1); PG8_STAGE_B(PG8_SB(0, 0), b2); PG8_STAGE_B(PG8_SB(0, 1), b2 + hstep); PG8_STAGE_A(PG8_SA(0, 0), a2, 0, 0);
            PG8_WAIT_V(8); PG8_WAIT_L(0); PG8_BAR; PG8_MMA(1, 0, At, B0); PG8_MMA(1, 1, At, B1); PG8_BAR; PG8_SCHED;
            PG8_LDB(B0, 1, 0); PG8_LDB(B1, 1, 1); PG8_SCHED; PG8_LDA(At, 1, 0); PG8_STAGE_A(PG8_SA(0, 1), a2, 1, 0);
            PG8_WAIT_V(8); PG8_WAIT_L(0); PG8_BAR; PG8_MMA(0, 0, At, B0); PG8_MMA(0, 1, At, B1); PG8_BAR; PG8_SCHED;
            PG8_LDA(At, 1, 1); PG8_STAGE_B(PG8_SB(1, 0), b3); PG8_STAGE_B(PG8_SB(1, 1), b3 + hstep); PG8_STAGE_A(PG8_SA(1, 0), a2, 0, kstep);
            PG8_WAIT_V(8); PG8_WAIT_L(0); PG8_BAR; PG8_MMA(1, 0, At, B0); PG8_MMA(1, 1, At, B1); PG8_BAR; PG8_SCHED;
        }
        if constexpr (ALIGN_EPI) { if (wr == 0) PG8_BAR; }
        E(acc, cur, wr, wc, fr, fq);
        if (!has_next) break;
#pragma unroll
        for (int a = 0; a < 2; ++a)
#pragma unroll
            for (int b = 0; b < 2; ++b)
#pragma unroll
                for (int m = 0; m < 4; ++m)
#pragma unroll
                    for (int n = 0; n < 2; ++n) acc[a][b][m][n] = (f32x4){0.f, 0.f, 0.f, 0.f};
        cur = nxt; cB = nB; ++ui;
#pragma unroll
        for (int h = 0; h < 2; ++h)
#pragma unroll
            for (int i = 0; i < 2; ++i) cvA[h][i] = nvA[h][i];
        if constexpr (ALIGN_EPI) { if (wr == 1) PG8_BAR; }
    }
    PG8_WAIT_V(0);
    if constexpr (!ALIGN_EPI) { if (wr == 0) PG8_BAR; }
    PG8_BAR;
#undef PG8_SA
#undef PG8_SB
#undef PG8_STAGE_A
#undef PG8_STAGE_B
#undef PG8_LDA
#undef PG8_LDB
#undef PG8_MMA
#undef PG8_WAIT_V
#undef PG8_WAIT_L
#undef PG8_BAR
#undef PG8_SCHED
}

typedef f32x4 Acc[2][2][4][2];
__device__ __forceinline__ u32x4 pack8(const f32x4 a, const f32x4 b) { u32x4 w; w.x = cvt_pk_bf16(a[0], a[1]); w.y = cvt_pk_bf16(a[2], a[3]); w.z = cvt_pk_bf16(b[0], b[1]); w.w = cvt_pk_bf16(b[2], b[3]); return w; }

struct EpiPlain {
    static constexpr bool PERM = true, HAS_MID = false; static constexpr int MID_T = 0;
    bf16_t* O; int ldc; int use_aux;
    __device__ __forceinline__ void mid(Acc&, const Unit&, int, int, int, int) const {}
    __device__ __forceinline__ void operator()(const Acc& acc, const Unit& u, int wr, int wc, int fr, int fq) const {
        const int row0 = (use_aux ? u.aux : u.pm * BM) + wr * 64 + fr, col0 = u.pn * BM + wc * 32 + 8 * fq;
#pragma unroll
        for (int ai = 0; ai < 2; ++ai)
#pragma unroll
            for (int m = 0; m < 4; ++m) { bf16_t* rowp = O + (size_t)(row0 + ai * HALF + m * 16) * ldc + col0;
#pragma unroll
                for (int bj = 0; bj < 2; ++bj) st16(rowp + bj * HALF, pack8(acc[ai][bj][m][0], acc[ai][bj][m][1])); }
    }
};

struct EpiIn {
    static constexpr bool PERM = true, HAS_MID = false; static constexpr int MID_T = 0;
    const float* xpart; const float* qn; const float* kn;
    bf16_t *qb, *kb, *vb, *ub, *vsb, *gab; float* vspart;
    __device__ __forceinline__ void mid(Acc&, const Unit&, int, int, int, int) const {}
    __device__ __forceinline__ void operator()(const Acc& acc, const Unit& u, int wr, int wc, int fr, int fq) const {
        const int pn = u.pn;
#pragma unroll
        for (int ai = 0; ai < 2; ++ai)
#pragma unroll
            for (int m = 0; m < 4; ++m) {
                const int row = u.pm * BM + ai * HALF + wr * 64 + m * 16 + fr;
                const f32x4* xp = (const f32x4*)(xpart + (size_t)row * 16);
                const f32x4 s0 = xp[0], s1 = xp[1], s2 = xp[2], s3 = xp[3];
                const float ssx = ((s0[0] + s0[1]) + (s0[2] + s0[3])) + ((s1[0] + s1[1]) + (s1[2] + s1[3])) + ((s2[0] + s2[1]) + (s2[2] + s2[3])) + ((s3[0] + s3[1]) + (s3[2] + s3[3]));
                const float rs = fast_rsq(ssx * (1.f / D) + EPS);
                f32x4 v[2][2];
#pragma unroll
                for (int bj = 0; bj < 2; ++bj)
#pragma unroll
                    for (int n = 0; n < 2; ++n) v[bj][n] = acc[ai][bj][m][n] * rs;
                if (pn < 4) {
                    float ss = 0.f;
#pragma unroll
                    for (int bj = 0; bj < 2; ++bj)
#pragma unroll
                        for (int n = 0; n < 2; ++n) ss += (v[bj][n][0] * v[bj][n][0] + v[bj][n][1] * v[bj][n][1]) + (v[bj][n][2] * v[bj][n][2] + v[bj][n][3] * v[bj][n][3]);
                    ss = sum_xor16_32(ss);
                    const bool isq = pn < 2;
                    const float sc = fast_rsq(ss * (1.f / 64.f) + EPS) * (isq ? 0.125f * LOG2E : 1.f);
                    const float* gn = isq ? qn : kn; bf16_t* O = isq ? qb : kb;
                    const int head = 4 * (pn & 1) + wc;
#pragma unroll
                    for (int bj = 0; bj < 2; ++bj) {
                        const f32x4 g0 = *(const f32x4*)(gn + 32 * bj + 8 * fq), g1 = *(const f32x4*)(gn + 32 * bj + 8 * fq + 4);
                        st16wt(O + (size_t)row * 512 + head * 64 + 32 * bj + 8 * fq, pack8(v[bj][0] * sc * g0, v[bj][1] * sc * g1));
                    }
                } else {
                    const int colw = wc * 32 + 8 * fq;
                    if (pn < 6) {
#pragma unroll
                        for (int bj = 0; bj < 2; ++bj) st16wt(vb + (size_t)row * 512 + (pn - 4) * BM + bj * HALF + colw, pack8(v[bj][0], v[bj][1]));
                    } else if (pn < 10) {
                        float ss = 0.f;
#pragma unroll
                        for (int bj = 0; bj < 2; ++bj)
#pragma unroll
                            for (int n = 0; n < 2; ++n)
#pragma unroll
                                for (int i = 0; i < 4; ++i) { const float gv = gelu_tanh_f(v[bj][n][i]); v[bj][n][i] = gv; ss += gv * gv; }
                        if (pn < 8) {
#pragma unroll
                            for (int bj = 0; bj < 2; ++bj) st16wt(ub + (size_t)row * 512 + (pn - 6) * BM + bj * HALF + colw, pack8(v[bj][0], v[bj][1]));
                        } else {
#pragma unroll
                            for (int bj = 0; bj < 2; ++bj) st16wt(vsb + (size_t)row * 512 + (pn - 8) * BM + bj * HALF + colw, pack8(v[bj][0], v[bj][1]));
                            ss = sum_xor16_32(ss);
                            if (fq == 0) vspart[(size_t)row * 8 + (pn - 8) * 4 + wc] = ss;
                        }
                    } else {
#pragma unroll
                        for (int bj = 0; bj < 2; ++bj) {
#pragma unroll
                            for (int n = 0; n < 2; ++n)
#pragma unroll
                                for (int i = 0; i < 4; ++i) v[bj][n][i] = fmaxf(sigmoid_f(v[bj][n][i]), 1e-13f);
                            st16wt(gab + (size_t)row * 2048 + (pn - 10) * BM + bj * HALF + colw, pack8(v[bj][0], v[bj][1]));
                        }
                    }
                }
            }
    }
};

struct EpiUp {
    static constexpr bool PERM = true, HAS_MID = true; static constexpr int MID_T = 8;
    const bf16_t* gab; bf16_t* mg;
    __device__ __forceinline__ void mid(Acc& acc, const Unit& u, int wr, int wc, int fr, int fq) const {
        int row0 = u.pm * BM + wr * 64 + fr; const int col0 = u.pn * BM + wc * 32 + 8 * fq; asm volatile("" : "+v"(row0));
#pragma unroll
        for (int am = 0; am < 4; ++am) {
            const int ai = am >> 1, mb = (am & 1) * 2;
            u32x4 ga[2][2], gb[2][2];
#pragma unroll
            for (int mm = 0; mm < 2; ++mm) { const bf16_t* gp = gab + (size_t)(row0 + ai * HALF + (mb + mm) * 16) * 2048 + col0;
#pragma unroll
                for (int bj = 0; bj < 2; ++bj) { ga[mm][bj] = *(const u32x4*)(gp + bj * HALF); gb[mm][bj] = *(const u32x4*)(gp + 1024 + bj * HALF); } }
#pragma unroll
            for (int mm = 0; mm < 2; ++mm)
#pragma unroll
                for (int bj = 0; bj < 2; ++bj)
#pragma unroll
                    for (int j = 0; j < 4; ++j) { const float r0 = bf_lo(ga[mm][bj][j]) * fast_rcp(bf_lo(gb[mm][bj][j])), r1 = bf_hi(ga[mm][bj][j]) * fast_rcp(bf_hi(gb[mm][bj][j]));
                        acc[ai][bj][mb + mm][j >> 1][(j & 1) * 2] *= r0; acc[ai][bj][mb + mm][j >> 1][(j & 1) * 2 + 1] *= r1; }
            asm volatile("" ::: "memory");
        }
    }
    __device__ __forceinline__ void operator()(const Acc& acc, const Unit& u, int wr, int wc, int fr, int fq) const {
        int row0 = u.pm * BM + wr * 64 + fr; const int col0 = u.pn * BM + wc * 32 + 8 * fq; asm volatile("" : "+v"(row0));
#pragma unroll
        for (int ai = 0; ai < 2; ++ai) {
            u32x4 gb[4][2];
#pragma unroll
            for (int m = 0; m < 4; ++m)
#pragma unroll
                for (int bj = 0; bj < 2; ++bj) gb[m][bj] = *(const u32x4*)(gab + (size_t)(row0 + ai * HALF + m * 16) * 2048 + 1024 + col0 + bj * HALF);
#pragma unroll
            for (int m = 0; m < 4; ++m) { const size_t ro = (size_t)(row0 + ai * HALF + m * 16);
#pragma unroll
                for (int bj = 0; bj < 2; ++bj) { const u32x4 b = gb[m][bj];
                    f32x4 o0, o1;
                    o0[0] = acc[ai][bj][m][0][0] * bf_lo(b[0]); o0[1] = acc[ai][bj][m][0][1] * bf_hi(b[0]); o0[2] = acc[ai][bj][m][0][2] * bf_lo(b[1]); o0[3] = acc[ai][bj][m][0][3] * bf_hi(b[1]);
                    o1[0] = acc[ai][bj][m][1][0] * bf_lo(b[2]); o1[1] = acc[ai][bj][m][1][1] * bf_hi(b[2]); o1[2] = acc[ai][bj][m][1][2] * bf_lo(b[3]); o1[3] = acc[ai][bj][m][1][3] * bf_hi(b[3]);
                    st16(mg + ro * 1024 + col0 + bj * HALF, pack8(o0, o1)); } }
            asm volatile("" ::: "memory");
        }
    }
};

struct EpiOut {
    static constexpr bool PERM = true, HAS_MID = false; static constexpr int MID_T = 0;
    const bf16_t* xin; bf16_t* xout;
    __device__ __forceinline__ void mid(Acc&, const Unit&, int, int, int, int) const {}
    __device__ __forceinline__ void operator()(const Acc& acc, const Unit& u, int wr, int wc, int fr, int fq) const {
        int row0 = u.pm * BM + wr * 64 + fr; const int col0 = u.pn * BM + wc * 32 + 8 * fq; asm volatile("" : "+v"(row0));
#pragma unroll
        for (int ai = 0; ai < 2; ++ai) {
            u32x4 xv[4][2];
#pragma unroll
            for (int m = 0; m < 4; ++m)
#pragma unroll
                for (int bj = 0; bj < 2; ++bj) xv[m][bj] = *(const u32x4*)(xin + (size_t)(row0 + ai * HALF + m * 16) * D + col0 + bj * HALF);
#pragma unroll
            for (int m = 0; m < 4; ++m)
#pragma unroll
                for (int bj = 0; bj < 2; ++bj) { const u32x4 xo = xv[m][bj]; f32x4 o0, o1;
                    o0[0] = bf_lo(xo[0]) + acc[ai][bj][m][0][0]; o0[1] = bf_hi(xo[0]) + acc[ai][bj][m][0][1]; o0[2] = bf_lo(xo[1]) + acc[ai][bj][m][0][2]; o0[3] = bf_hi(xo[1]) + acc[ai][bj][m][0][3];
                    o1[0] = bf_lo(xo[2]) + acc[ai][bj][m][1][0]; o1[1] = bf_hi(xo[2]) + acc[ai][bj][m][1][1]; o1[2] = bf_lo(xo[3]) + acc[ai][bj][m][1][2]; o1[3] = bf_hi(xo[3]) + acc[ai][bj][m][1][3];
                    st16(xout + (size_t)(row0 + ai * HALF + m * 16) * D + col0 + bj * HALF, pack8(o0, o1)); }
            asm volatile("" ::: "memory");
        }
    }
};

struct EpiG1 {
    static constexpr bool PERM = true, HAS_MID = false; static constexpr int MID_T = 0;
    const int* tokl; const int* cnt; const float* rs2; bf16_t* Gb;
    __device__ __forceinline__ void mid(Acc&, const Unit&, int, int, int, int) const {}
    __device__ __forceinline__ void operator()(const Acc& acc, const Unit& u, int wr, int wc, int fr, int fq) const {
        const int ce = cnt[u.e * CNT_STRIDE];
#pragma unroll
        for (int ai = 0; ai < 2; ++ai)
#pragma unroll
            for (int m = 0; m < 4; ++m) {
                const int rl = ai * HALF + wr * 64 + m * 16 + fr, r = u.pm * BM + rl;
                const int tok = (r < ce) ? tokl[u.e * ECAP + r] : 0;
                const float rs = rs2[tok];
                f32x4 o[2];
#pragma unroll
                for (int n = 0; n < 2; ++n)
#pragma unroll
                    for (int i = 0; i < 4; ++i) { const float g = acc[ai][0][m][n][i] * rs, up = acc[ai][1][m][n][i] * rs; o[n][i] = g * sigmoid_f(g) * up; }
                st16(Gb + (size_t)(u.aux + rl) * 512 + u.pn * HALF + wc * 32 + 8 * fq, pack8(o[0], o[1]));
            }
    }
};

struct EpiPle {
    static constexpr bool PERM = true, HAS_MID = false; static constexpr int MID_T = 0;
    const bf16_t* xin; bf16_t* xout; float* fout; const bf16_t* Eb; const float* rs3; float* xpart;
    __device__ __forceinline__ void mid(Acc&, const Unit&, int, int, int, int) const {}
    __device__ __forceinline__ void operator()(const Acc& acc, const Unit& u, int wr, int wc, int fr, int fq) const {
        int row0 = u.pm * BM + wr * 64 + fr; const int col0 = u.pn * BM + wc * 32 + 8 * fq; asm volatile("" : "+v"(row0));
#pragma unroll
        for (int am = 0; am < 4; ++am) {
            const int ai = am >> 1, mb = (am & 1) * 2;
            u32x4 xv[2][2], ev[2][2]; float rsv[2];
#pragma unroll
            for (int mm = 0; mm < 2; ++mm) { const int row = row0 + ai * HALF + (mb + mm) * 16; rsv[mm] = rs3[row];
#pragma unroll
                for (int bj = 0; bj < 2; ++bj) { xv[mm][bj] = *(const u32x4*)(xin + (size_t)row * D + col0 + bj * HALF); ev[mm][bj] = *(const u32x4*)(Eb + (size_t)row * D + col0 + bj * HALF); } }
#pragma unroll
            for (int mm = 0; mm < 2; ++mm) { const int row = row0 + ai * HALF + (mb + mm) * 16; const float rs = rsv[mm]; float ss = 0.f;
#pragma unroll
                for (int bj = 0; bj < 2; ++bj) { const u32x4 xo = xv[mm][bj], e = ev[mm][bj]; f32x4 o[2];
#pragma unroll
                    for (int j = 0; j < 4; ++j) { o[j >> 1][(j & 1) * 2] = bf_lo(xo[j]) + sigmoid_f(acc[ai][bj][mb + mm][j >> 1][(j & 1) * 2] * rs) * bf_lo(e[j]);
                                                  o[j >> 1][(j & 1) * 2 + 1] = bf_hi(xo[j]) + sigmoid_f(acc[ai][bj][mb + mm][j >> 1][(j & 1) * 2 + 1] * rs) * bf_hi(e[j]); }
                    const u32x4 w = pack8(o[0], o[1]);
#pragma unroll
                    for (int j = 0; j < 4; ++j) { const float a = bf_lo(w[j]), b = bf_hi(w[j]); ss += a * a + b * b; }
                    st16(xout + (size_t)row * D + col0 + bj * HALF, w);
                    if (fout) { *(f32x4*)(fout + (size_t)row * D + col0 + bj * HALF) = o[0]; *(f32x4*)(fout + (size_t)row * D + col0 + bj * HALF + 4) = o[1]; } }
                ss = sum_xor16_32(ss);
                if (fq == 0) xpart[(size_t)row * 16 + u.pn * 4 + wc] = ss; }
            asm volatile("" ::: "memory");
        }
    }
};
__device__ __forceinline__ int crow(int r, int hi) { return (r & 3) + 8 * (r >> 2) + 4 * hi; }
__device__ __forceinline__ unsigned cvtpk_s(float lo, float hi) { typedef __bf16 bf16x2_t __attribute__((ext_vector_type(2))); f32x2 v = {lo, hi}; bf16x2_t b = __builtin_convertvector(v, bf16x2_t); return __builtin_bit_cast(unsigned, b); }
#define FK_SBAR() __builtin_amdgcn_sched_barrier(0)
__device__ __forceinline__ void pv(f32x16* o, int vb, bf16x8 pa0, bf16x8 pa1, bf16x8 pa2, bf16x8 pa3) {
#pragma unroll
    for (int d0 = 0; d0 < 2; ++d0) { s16x4 lo[4], hi[4];
#pragma unroll
        for (int ks = 0; ks < 4; ++ks) {
            asm volatile("ds_read_b64_tr_b16 %0,%1 offset:%c2" : "=&v"(lo[ks]) : "v"(vb), "i"(d0 * 4096 + ks * 1024) : "memory");
            asm volatile("ds_read_b64_tr_b16 %0,%1 offset:%c2" : "=&v"(hi[ks]) : "v"(vb), "i"(d0 * 4096 + ks * 1024 + 512) : "memory"); }
        asm volatile("s_waitcnt lgkmcnt(0)" ::: "memory"); FK_SBAR();
#define FK_PK(k) (bf16x8){lo[k][0], lo[k][1], lo[k][2], lo[k][3], hi[k][0], hi[k][1], hi[k][2], hi[k][3]}
        o[d0] = __builtin_amdgcn_mfma_f32_32x32x16_bf16(pa0, FK_PK(0), o[d0], 0, 0, 0);
        o[d0] = __builtin_amdgcn_mfma_f32_32x32x16_bf16(pa1, FK_PK(1), o[d0], 0, 0, 0);
        o[d0] = __builtin_amdgcn_mfma_f32_32x32x16_bf16(pa2, FK_PK(2), o[d0], 0, 0, 0);
        o[d0] = __builtin_amdgcn_mfma_f32_32x32x16_bf16(pa3, FK_PK(3), o[d0], 0, 0, 0);
#undef FK_PK
    }
}
constexpr int WLDS_BYTES = 16384;

template <bool DIAG>
__device__ __forceinline__ void attn_tile(const bf16x8 (&k0)[4], const bf16x8 (&k1)[4], const bf16x8 (&qr)[4], f32x16 (&o)[2], float& R, int s0, int tq, int hi, int vbase) {
    f32x16 p0 = f32x16{}, p1 = f32x16{};
#pragma unroll
    for (int d0 = 0; d0 < 4; ++d0) { p0 = __builtin_amdgcn_mfma_f32_32x32x16_bf16(k0[d0], qr[d0], p0, 0, 0, 0); p1 = __builtin_amdgcn_mfma_f32_32x32x16_bf16(k1[d0], qr[d0], p1, 0, 0, 0); }
    float kp[32], bt[32];
#pragma unroll
    for (int r = 0; r < 32; ++r) {
        const float z = r < 16 ? p0[r] : p1[r - 16];
        const float e = fast_exp2(z);
        float k_ = fast_rcp(1.f + e), b_ = 1.f - k_;
        if (DIAG) { const int kv = s0 + crow(r & 15, hi) + (r >> 4) * 32; if (!(kv < tq)) { k_ = 1.f; b_ = 0.f; } }
        kp[r] = k_; bt[r] = b_;
    }
    float pg[8], T[8], SP[8];
#pragma unroll
    for (int g = 0; g < 8; ++g) { const float gs = (kp[4 * g] * kp[4 * g + 1]) * (kp[4 * g + 2] * kp[4 * g + 3]); float lo_, hi_; halves32(gs, lo_, hi_); pg[g] = hi ? lo_ : hi_; T[g] = lo_ * hi_; }
    SP[7] = 1.f;
#pragma unroll
    for (int g = 6; g >= 0; --g) SP[g] = SP[g + 1] * T[g + 1];
    float a[32];
#pragma unroll
    for (int g = 0; g < 8; ++g) {
        const float base = R * SP[g] * (hi == 0 ? pg[g] : 1.f);
        const float a3 = base, a2 = a3 * kp[4 * g + 3], a1 = a2 * kp[4 * g + 2], a0 = a1 * kp[4 * g + 1];
        a[4 * g + 3] = bt[4 * g + 3] * a3; a[4 * g + 2] = bt[4 * g + 2] * a2; a[4 * g + 1] = bt[4 * g + 1] * a1; a[4 * g] = bt[4 * g] * a0;
    }
    R *= SP[0] * T[0];
    u32x4 pw0, pw1, pw2, pw3;
    pw0 = (u32x4){cvtpk_s(a[0], a[1]), cvtpk_s(a[2], a[3]), cvtpk_s(a[4], a[5]), cvtpk_s(a[6], a[7])};
    pw1 = (u32x4){cvtpk_s(a[8], a[9]), cvtpk_s(a[10], a[11]), cvtpk_s(a[12], a[13]), cvtpk_s(a[14], a[15])};
    pw2 = (u32x4){cvtpk_s(a[16], a[17]), cvtpk_s(a[18], a[19]), cvtpk_s(a[20], a[21]), cvtpk_s(a[22], a[23])};
    pw3 = (u32x4){cvtpk_s(a[24], a[25]), cvtpk_s(a[26], a[27]), cvtpk_s(a[28], a[29]), cvtpk_s(a[30], a[31])};
    asm volatile("s_waitcnt vmcnt(0) lgkmcnt(0)" ::: "memory");
    pv(o, vbase, __builtin_bit_cast(bf16x8, pw0), __builtin_bit_cast(bf16x8, pw1), __builtin_bit_cast(bf16x8, pw2), __builtin_bit_cast(bf16x8, pw3));
}
__device__ __forceinline__ void attn_dma_v(const bf16_t* __restrict__ vb, long rowbase, int s0, int h, int lane, LAS unsigned char* wl) {
#pragma unroll
    for (int w8 = 0; w8 < 8; ++w8)
        __builtin_amdgcn_global_load_lds((const unsigned*)(vb + (size_t)(rowbase + s0 + 16 * (w8 & 3) + (lane >> 2)) * 512 + h * 64 + 32 * (w8 >> 2) + 8 * (lane & 3)), (LAS unsigned*)(wl + w8 * 1024), 16, 0, 0);
}
__device__ __forceinline__ void attn_dma_k(const bf16_t* __restrict__ kb, long rowbase, int s0, int h, int lane, LAS unsigned char* wl) {
#pragma unroll
    for (int c = 0; c < 8; ++c)
        __builtin_amdgcn_global_load_lds((const unsigned*)(kb + (size_t)(rowbase + s0 + lane) * 512 + h * 64 + 8 * c), (LAS unsigned*)(wl + 8192 + c * 1024), 16, 0, 0);
}
__device__ __forceinline__ void attn_read_k(bf16x8 (&k0)[4], bf16x8 (&k1)[4], LAS unsigned char* wl, int r32, int hi) {
    const LAS unsigned char* kp = wl + 8192 + hi * 1024 + r32 * 16;
#pragma unroll
    for (int d0 = 0; d0 < 4; ++d0) { k0[d0] = *(const LAS bf16x8*)(kp + d0 * 2048); k1[d0] = *(const LAS bf16x8*)(kp + d0 * 2048 + 512); }
}
__device__ __forceinline__ void attn_wave_unit(int b, int h, int qblk, const bf16_t* __restrict__ qb, const bf16_t* __restrict__ kb, const bf16_t* __restrict__ vb, bf16_t* __restrict__ oc, LAS unsigned char* wl, int lane) {
    const int r32 = lane & 31, hi = lane >> 5;
    const long rowbase = (long)b * SEQ; const int q0 = qblk * 32, tq = q0 + r32;
    bf16x8 qr[4];
    { const bf16_t* qp = qb + (size_t)(rowbase + q0 + r32) * 512 + h * 64 + hi * 8;
#pragma unroll
      for (int d0 = 0; d0 < 4; ++d0) qr[d0] = *(const bf16x8*)(qp + d0 * 16); }
    f32x16 o[2]; o[0] = f32x16{}; o[1] = f32x16{};
    float R = 1.f;
    const int vbase = (int)(unsigned)(uintptr_t)wl + ((lane >> 4) & 1) * 32 + (lane & 3) * 8 + (4 * hi + ((lane & 15) >> 2)) * 64;
    const int jd = q0 >> 6;
    bf16x8 k0[4], k1[4];
    attn_dma_k(kb, rowbase, jd * 64, h, lane, wl);
    attn_dma_v(vb, rowbase, jd * 64, h, lane, wl);
    asm volatile("s_waitcnt vmcnt(8)" ::: "memory");
    attn_read_k(k0, k1, wl, r32, hi);
    asm volatile("s_waitcnt lgkmcnt(0)" ::: "memory");
    attn_dma_k(kb, rowbase, (jd > 0 ? jd - 1 : 0) * 64, h, lane, wl);
    attn_tile<true>(k0, k1, qr, o, R, jd * 64, tq, hi, vbase);
    for (int jt = jd - 1; jt >= 0; --jt) {
        if (__all(R < 7.5e-37f)) break;
        attn_read_k(k0, k1, wl, r32, hi);
        attn_dma_v(vb, rowbase, jt * 64, h, lane, wl);
        asm volatile("s_waitcnt lgkmcnt(0)" ::: "memory");
        attn_dma_k(kb, rowbase, (jt > 0 ? jt - 1 : 0) * 64, h, lane, wl);
        attn_tile<false>(k0, k1, qr, o, R, jt * 64, tq, hi, vbase);
    }
    asm volatile("s_waitcnt vmcnt(0)" ::: "memory");
    LAS bf16_t* stg = (LAS bf16_t*)(wl + 8192);
#pragma unroll
    for (int r = 0; r < 16; ++r) { const int orow = crow(r, hi);
#pragma unroll
        for (int d0 = 0; d0 < 2; ++d0) stg[orow * 64 + d0 * 32 + r32] = (bf16_t)(cvtpk_s(o[d0][r], 0.f) & 0xffffu); }
    asm volatile("s_waitcnt lgkmcnt(0)" ::: "memory");
    bf16_t* Ow = oc + (size_t)(rowbase + q0) * 1024 + h * 64;
#pragma unroll
    for (int i = 0; i < 4; ++i) { const int row = i * 8 + (lane >> 3), ch = lane & 7; const u32x4 v = *(const LAS u32x4*)(stg + row * 64 + ch * 8); st16(Ow + (size_t)row * 1024 + ch * 8, v); }
    asm volatile("s_waitcnt vmcnt(0) lgkmcnt(0)" ::: "memory");
}

template <int HF>
__device__ __forceinline__ void sgu_wave_unit(int chunk, int g, const bf16_t* __restrict__ ub, const bf16_t* __restrict__ vsb, const float* __restrict__ vspart, const bf16_t* __restrict__ wsp  ,
                                              const float* __restrict__ bsp  , const float* __restrict__ sgn  , bf16_t* __restrict__ oc, LAS unsigned char* wl, int lane) {
    const int r32 = lane & 31, hi = lane >> 5;
    const size_t row0 = (size_t)chunk * 128;
    const int vbase = (int)(unsigned)(uintptr_t)wl + ((lane >> 4) & 1) * 32 + (lane & 3) * 8 + (4 * hi + ((lane & 15) >> 2)) * 64;
    f32x16 o[2][2];
#pragma unroll
    for (int rl = 0; rl < 2; ++rl) { o[rl][0] = f32x16{}; o[rl][1] = f32x16{}; }
#pragma unroll
    for (int kt = 0; kt <= HF; ++kt) {
        float rvq[4];
#pragma unroll
        for (int q = 0; q < 4; ++q) { const size_t row = row0 + 64 * kt + 16 * q + (lane >> 2);
            const f32x4 s0 = *(const f32x4*)(vspart + row * 8), s1 = *(const f32x4*)(vspart + row * 8 + 4);
            rvq[q] = fast_rsq((((s0[0] + s0[1]) + (s0[2] + s0[3])) + ((s1[0] + s1[1]) + (s1[2] + s1[3]))) * (1.f / 512.f) + EPS); }
        u32x4 vv[8];
#pragma unroll
        for (int w8 = 0; w8 < 8; ++w8) vv[w8] = *(const u32x4*)(vsb + (row0 + 64 * kt + 16 * (w8 & 3) + (lane >> 2)) * 512 + g * 64 + 32 * (w8 >> 2) + 8 * (lane & 3));
#pragma unroll
        for (int w8 = 0; w8 < 8; ++w8) { const float rv = rvq[w8 & 3]; u32x4 w;
#pragma unroll
            for (int j = 0; j < 4; ++j) w[j] = cvtpk_s(bf_lo(vv[w8][j]) * rv, bf_hi(vv[w8][j]) * rv);
            *(LAS u32x4*)(wl + w8 * 1024 + lane * 16) = w; }
        asm volatile("s_waitcnt lgkmcnt(0)" ::: "memory");
#pragma unroll
        for (int rl = 0; rl < 2; ++rl) {
            const int rb = 2 * HF + rl;
            const bf16_t* wp = wsp + ((size_t)g * 128 + 32 * rb + r32) * 128 + 64 * kt + 4 * hi;
            u32x4 pw[4];
#pragma unroll
            for (int ks = 0; ks < 4; ++ks) { const u32x2 lo = *(const u32x2*)(wp + 16 * ks), h8 = *(const u32x2*)(wp + 16 * ks + 8); pw[ks] = (u32x4){lo.x, lo.y, h8.x, h8.y}; }
            pv(o[rl], vbase, __builtin_bit_cast(bf16x8, pw[0]), __builtin_bit_cast(bf16x8, pw[1]), __builtin_bit_cast(bf16x8, pw[2]), __builtin_bit_cast(bf16x8, pw[3]));
        }
        asm volatile("s_waitcnt lgkmcnt(0)" ::: "memory");
    }
    LAS bf16_t* stg = (LAS bf16_t*)(wl + 8192);
    const float gn0 = sgn[g * 64 + r32], gn1 = sgn[g * 64 + 32 + r32];
#pragma unroll
    for (int rl = 0; rl < 2; ++rl) {
        const int rb = 2 * HF + rl;
#pragma unroll
        for (int r = 0; r < 16; ++r) { const int orow = crow(r, hi); const float bb = bsp[g * 128 + 32 * rb + orow];
            stg[orow * 64 + r32] = (bf16_t)(cvtpk_s(gn0 * o[rl][0][r] + bb, 0.f) & 0xffffu); stg[orow * 64 + 32 + r32] = (bf16_t)(cvtpk_s(gn1 * o[rl][1][r] + bb, 0.f) & 0xffffu); }
        asm volatile("s_waitcnt lgkmcnt(0)" ::: "memory");
#pragma unroll
        for (int i = 0; i < 4; ++i) { const int row = i * 8 + (lane >> 3), ch = lane & 7; const size_t grow = row0 + 32 * rb + row;
            const u32x4 mv = *(const LAS u32x4*)(stg + row * 64 + ch * 8); const u32x4 uv = *(const u32x4*)(ub + grow * 512 + g * 64 + ch * 8); u32x4 w;
#pragma unroll
            for (int j = 0; j < 4; ++j) w[j] = cvtpk_s(bf_lo(mv[j]) * bf_lo(uv[j]), bf_hi(mv[j]) * bf_hi(uv[j]));
            st16(oc + grow * 1024 + 512 + g * 64 + ch * 8, w); }
        asm volatile("s_waitcnt lgkmcnt(0)" ::: "memory");
    }
}
constexpr size_t MiB = 1u << 20;
constexpr size_t WS_CTL = 0, CTL_ZERO_BYTES = 1 * MiB;
constexpr size_t WS_W = 16 * MiB, WL_STRIDE = 112 * MiB;
constexpr size_t WO_IN = 0, WO_UP = 9 * MiB, WO_OUT = 11 * MiB, WO_PG = 13 * MiB, WO_PP = 15 * MiB, WO_SP = 15 * MiB + 512 * 1024, WO_R = 15 * MiB + 768 * 1024, WO_EI = 16 * MiB, WO_EO = 80 * MiB;
constexpr size_t WS_PB = 464 * MiB, WS_E = 496 * MiB, WS_XB = 624 * MiB, WS_Q = 656 * MiB, WS_K = 672 * MiB, WS_V = 688 * MiB, WS_U = 704 * MiB, WS_VS = 720 * MiB, WS_GAB = 736 * MiB,
                 WS_OC = 800 * MiB, WS_MG = 832 * MiB, WS_G = 864 * MiB, WS_YS = 904 * MiB, WS_XPART = 984 * MiB, WS_VSPART = 985 * MiB, WS_RS2 = 985 * MiB + 512 * 1024, WS_RS3 = 985 * MiB + 640 * 1024,
                 WS_TOKL = 986 * MiB, WS_TKE = 988 * MiB, WS_TKP = 988 * MiB + 256 * 1024, WS_TKW = 988 * MiB + 512 * 1024, WS_XB1 = 992 * MiB, WS_FAST_END = 1024 * MiB;
constexpr int GSLOTS = 2 * M + NE * 256;
constexpr int CW_TMO = 0, CW_CODE = 1, CW_BAR = 4096, CW_CNT = 8192  ;

constexpr int RING_OFF = 0, RING_BYTES = 131072, LDSCTL_OFF = 139264  , MISC_OFF = LDSCTL_OFF + 320, PREF_OFF = MISC_OFF + 128  , LDS_BYTES = 147456;

#define RLX_AGENT __ATOMIC_RELAXED, __HIP_MEMORY_SCOPE_AGENT
#define XB_TMO      128
#define XB_XCNT(j)  (256  + 64 * (j))
#define XB_XSUB(j)  (1280 + 64 * (j))
#define XB_XGEN(j)  (2304 + 64 * (j))
#define XB_TOP      3328
#define XB_TOPGEN   3392
#define XCD_BAR_WORDS 3456
#define XB_SPIN_CAP (1u << 18)
__device__ __forceinline__ unsigned xb_ld(unsigned* p)              { return __hip_atomic_load(p, __ATOMIC_RELAXED, __HIP_MEMORY_SCOPE_AGENT); }
__device__ __forceinline__ unsigned xb_add(unsigned* p, unsigned v) { return __hip_atomic_fetch_add(p, v, __ATOMIC_RELAXED, __HIP_MEMORY_SCOPE_AGENT); }
__device__ __forceinline__ unsigned xb_xcc_id() { return (unsigned)__builtin_amdgcn_s_getreg((3 << 11) | 20) & 0xFu; }
#define XB_SPIN(cond, bar) do { unsigned _sp = 0; while (cond) { __builtin_amdgcn_s_sleep(1); \
    if ((++_sp & 255u) == 0u) { if (xb_ld(&(bar)[XB_TMO])) break; if (_sp > XB_SPIN_CAP) { atomicAdd(&(bar)[XB_TMO], 1u); break; } } } } while (0)
struct XcdBarrier { unsigned* bar; unsigned x; volatile LAS unsigned* st; };
__device__ __forceinline__ XcdBarrier xcd_barrier_post(unsigned* bar, volatile LAS unsigned* st, const bool leader  ) {
    XcdBarrier b; b.bar = bar; b.x = xb_xcc_id(); b.st = st;
    if (leader) (void)xb_add(&bar[XB_XCNT(b.x)], 1u);
    return b;
}
__device__ __forceinline__ void xcd_barrier_complete(unsigned* bar, unsigned x, unsigned& nloc, unsigned& nx) {
    const unsigned G = gridDim.x * gridDim.y * gridDim.z;
    unsigned sum, cnt, mine, sp = 0u;
    for (;;) {
        sum = 0u; cnt = 0u; mine = 0u;
#pragma unroll
        for (unsigned j = 0; j < 16; ++j) { const unsigned c = xb_ld(&bar[XB_XCNT(j)]); sum += c; cnt += (c > 0u) ? 1u : 0u; mine = (j == x) ? c : mine; }
        if (sum == G) break;
        __builtin_amdgcn_s_sleep(1);
        if ((++sp & 255u) == 0u) { if (xb_ld(&bar[XB_TMO])) break; if (sp > XB_SPIN_CAP) { atomicAdd(&bar[XB_TMO], 1u); break; } }
    }
    nloc = mine > 0u ? mine : 1u; nx = cnt > 0u ? cnt : 1u;
}
__device__ __forceinline__ void xcd_barrier_t0(const XcdBarrier& b) {
        unsigned* bar = b.bar;
        __builtin_amdgcn_s_waitcnt(0);
        unsigned nloc = b.st[0], nx = b.st[1];
        if (nloc == 0u) { xcd_barrier_complete(bar, b.x, nloc, nx); b.st[0] = nloc; b.st[1] = nx; }
        const unsigned old = xb_add(&bar[XB_XSUB(b.x)], 1u);
        const unsigned gen = old / nloc;
        if (old + 1u == (gen + 1u) * nloc) {
            __builtin_amdgcn_fence(__ATOMIC_RELEASE, "agent");
            asm volatile("s_waitcnt vmcnt(0)" ::: "memory");
            const unsigned og = xb_add(&bar[XB_TOP], 1u);
            const unsigned tg = og / nx;
            if (og + 1u == (tg + 1u) * nx) xb_add(&bar[XB_TOPGEN], 1u);
            else XB_SPIN(xb_ld(&bar[XB_TOPGEN]) == tg, bar);
            __builtin_amdgcn_fence(__ATOMIC_ACQUIRE, "agent");
            xb_add(&bar[XB_XGEN(b.x)], 1u);
            asm volatile("s_waitcnt vmcnt(0)" ::: "memory");
        } else {
            XB_SPIN(xb_ld(&bar[XB_XGEN(b.x)]) == gen, bar);
            __builtin_amdgcn_fence(__ATOMIC_ACQUIRE, "agent");
            asm volatile("s_waitcnt vmcnt(0)" ::: "memory");
        }
}

struct Args {
    const float* in[22]; float* out; unsigned char* ws;
    int ph_lo, ph_hi, nlayers, pad;
};
__device__ __forceinline__ float wave_sum(float v) { v += xor_lt32<1>(v); v += xor_lt32<2>(v); v += xor_lt32<4>(v); v += xor_lt32<8>(v); return sum_xor16_32(v); }
__device__ __forceinline__ unsigned f2bf(float f) { unsigned u = __builtin_bit_cast(unsigned, f); return (u + 0x7fffu + ((u >> 16) & 1u)) >> 16; }
__device__ __forceinline__ unsigned pk2(float lo, float hi) { return f2bf(lo) | (f2bf(hi) << 16); }

__device__ __forceinline__ int rowmap(int kind, int n) {
    if (kind == 1) { if (n >= 1024) return n; const int nl = n & 255; return (n - nl) + 128 * ((nl & 63) >> 5) + 32 * (nl >> 6) + (nl & 31); }
    if (kind == 2) { return n < 512 ? 256 * (n >> 7) + (n & 127) : 256 * ((n - 512) >> 7) + 128 + ((n - 512) & 127); }
    return n;
}
__device__ __forceinline__ void transpose_item(const float* __restrict__ W, int N, const float* __restrict__ gain, bf16_t* __restrict__ WT, int ldt, int koff, int kind, LAS float* scr, int item, int lane) {
    const int nblk = N / 64, kb = item / nblk, nb = item % nblk, k0 = 64 * kb, n0 = 64 * nb;
    const int kr = lane >> 4, nc = 4 * (lane & 15);
    f32x4 v[16];
#pragma unroll
    for (int i = 0; i < 16; ++i) v[i] = __builtin_nontemporal_load((const f32x4*)(W + (size_t)(k0 + 4 * i + kr) * N + n0 + nc));
#pragma unroll
    for (int i = 0; i < 16; ++i) { const int kk = 4 * i + kr; const float gv = gain ? gain[k0 + kk] : 1.f; LAS float* d = scr + kk * 65 + nc; d[0] = v[i][0] * gv; d[1] = v[i][1] * gv; d[2] = v[i][2] * gv; d[3] = v[i][3] * gv; }
    asm volatile("s_waitcnt lgkmcnt(0)" ::: "memory");
    const int c = lane & 7;
#pragma unroll
    for (int j = 0; j < 8; ++j) { const int n = 8 * j + (lane >> 3); const LAS float* s = scr + (8 * c) * 65 + n;
        u32x4 o; o.x = pk2(s[0 * 65], s[1 * 65]); o.y = pk2(s[2 * 65], s[3 * 65]); o.z = pk2(s[4 * 65], s[5 * 65]); o.w = pk2(s[6 * 65], s[7 * 65]);
        st16(WT + (size_t)rowmap(kind, n0 + n) * ldt + koff + k0 + 8 * c, o); }
    asm volatile("s_waitcnt lgkmcnt(0)" ::: "memory");
}

typedef const __attribute__((address_space(4))) Args* KArgs;
__device__ __forceinline__ KArgs fresh(KArgs k) { asm volatile("" : "+s"(k)); return k; }
constexpr int NWAVES = 8;
#ifndef FK_FILLW
#define FK_FILLW 7
#endif
constexpr int FILLW = FK_FILLW, FILL_SLABS = 8;
constexpr int CVT_IN = 16 * 72, CVT_UP = 8 * 16, CVT_OUT = 16 * 16, CVT_PG = 16 * 16, CVT_PP = 4 * 16, CVT_EI = 16 * 16, CVT_EO = 8 * 16;
constexpr int CVT_PER_LAYER = CVT_IN + 2 * CVT_UP + CVT_OUT + CVT_PG + CVT_PP + NE * CVT_EI + NE * CVT_EO;
__device__ __forceinline__ void convert_item(KArgs ap, int L, int r, LAS float* scr, int lane) {
    unsigned char* wl = ap->ws + WS_W + (size_t)L * WL_STRIDE;
    const float* W; const float* gain = nullptr; bf16_t* WT; int N = D, ldt = D, koff = 0, kind = 0, item = r;
    if (r < CVT_IN) { W = ap->in[3] + (size_t)L * D * INW; N = INW; gain = ap->in[2] + (size_t)L * D; WT = (bf16_t*)(wl + WO_IN); kind = 1; }
    else if ((r -= CVT_IN) < CVT_UP) { W = ap->in[9] + (size_t)L * 512 * D; WT = (bf16_t*)(wl + WO_UP); ldt = 1024; item = r; }
    else if ((r -= CVT_UP) < CVT_UP) { W = ap->in[10] + (size_t)L * 512 * D; WT = (bf16_t*)(wl + WO_UP); ldt = 1024; koff = 512; item = r; }
    else if ((r -= CVT_UP) < CVT_OUT) { W = ap->in[11] + (size_t)L * D * D; WT = (bf16_t*)(wl + WO_OUT); item = r; }
    else if ((r -= CVT_OUT) < CVT_PG) { W = ap->in[20] + (size_t)L * D * D; gain = ap->in[19] + (size_t)L * D; WT = (bf16_t*)(wl + WO_PG); item = r; }
    else if ((r -= CVT_PG) < CVT_PP) { W = ap->in[21] + (size_t)L * 256 * D; WT = (bf16_t*)(wl + WO_PP); ldt = 256; item = r; }
    else if ((r -= CVT_PP) < NE * CVT_EI) { const int e = r / CVT_EI; W = ap->in[17] + ((size_t)L * NE + e) * D * 1024; N = 1024; gain = ap->in[12] + (size_t)L * D; WT = (bf16_t*)(wl + WO_EI) + (size_t)e * 1024 * 1024; ldt = 1024; kind = 2; item = r % CVT_EI; }
    else { r -= NE * CVT_EI; const int e = r / CVT_EO; W = ap->in[18] + ((size_t)L * NE + e) * 512 * D; WT = (bf16_t*)(wl + WO_EO) + (size_t)e * 1024 * 512; ldt = 512; item = r % CVT_EO; }
    transpose_item(W, N, gain, WT, ldt, koff, kind, scr, item, lane);
}
__device__ __forceinline__ void p0_prologue(KArgs ap, int nlayers, bool fill_later, LAS unsigned char* lds, int wave, int lane, int gw, int NGW) {
    LAS float* scr = (LAS float*)(lds + RING_OFF + wave * 17408);
    unsigned char* ws = ap->ws;
    const int nconv = fill_later ? 1 : nlayers;
    for (int it = gw; it < CVT_PER_LAYER * nconv; it += NGW) convert_item(ap, nconv - 1 - it / CVT_PER_LAYER, it % CVT_PER_LAYER, scr, lane);
    if (fill_later) { const int first = FILL_SLABS * FILLW * (NGW / NWAVES), rest = CVT_PER_LAYER - first;
        if (rest > 0) for (int it = gw; it < rest * (nlayers - 1); it += NGW) convert_item(ap, 1 + it / rest, first + it % rest, scr, lane); }
    const int gt = gw * 64 + lane, NGT = NGW * 64;
    for (int L = 0; L < nlayers; ++L) {
        unsigned char* wl = ws + WS_W + (size_t)L * WL_STRIDE;
        bf16_t* sp = (bf16_t*)(wl + WO_SP); const float* wsrc = ap->in[7] + (size_t)L * 8 * 128 * 128;
        for (int i = gt; i < 8 * 128 * 128; i += NGT) { const int s = i & 127, t = (i >> 7) & 127; sp[i] = (bf16_t)f2bf(s <= t ? wsrc[i] : 0.f); }
        bf16_t* wrh = (bf16_t*)(wl + WO_R); bf16_t* wrl = wrh + 48 * 1024; const float* gain = ap->in[12] + (size_t)L * D; const float* wg = ap->in[13] + (size_t)L * D * 4; const float* we = ap->in[15] + (size_t)L * D * 32;
        for (int i = gt; i < 48 * 1024; i += NGT) { const int o = i >> 10, k = i & 1023; const float wv = o < 36 ? gain[k] * (o < 4 ? wg[k * 4 + o] : we[k * 32 + (o - 4)]) : 0.f;
            const unsigned h = f2bf(wv); wrh[i] = (bf16_t)h; wrl[i] = (bf16_t)f2bf(wv - __uint_as_float(h << 16)); }
    }
    { const f32x4* p4 = (const f32x4*)ap->in[1]; u32x2* pb = (u32x2*)(ws + WS_PB); const size_t n4 = (size_t)nlayers * M * 256 / 4;
      for (size_t i = gt; i < n4; i += NGT) { const f32x4 v = p4[i]; u32x2 w; w.x = pk2(v[0], v[1]); w.y = pk2(v[2], v[3]); pb[i] = w; } }
    for (int m = gw; m < M; m += NGW) {
        const f32x4* xr = (const f32x4*)(ap->in[0] + (size_t)m * D) + lane; u32x2* o8 = (u32x2*)((bf16_t*)(ws + WS_XB) + (size_t)m * D) + lane; float s = 0.f;
#pragma unroll
        for (int j = 0; j < 4; ++j) { const f32x4 v = xr[64 * j]; s += (v[0] * v[0] + v[1] * v[1]) + (v[2] * v[2] + v[3] * v[3]); u32x2 w; w.x = pk2(v[0], v[1]); w.y = pk2(v[2], v[3]); o8[64 * j] = w; }
        s = wave_sum(s);
        if (lane < 16) ((float*)(ws + WS_XPART))[(size_t)m * 16 + lane] = lane == 0 ? s : 0.f;
    }
}

__device__ __forceinline__ void router_pass(const bf16_t* __restrict__ x, const bf16_t* __restrict__ wrh  , const bf16_t* __restrict__ wrl  , const float* __restrict__ bgr, const float* __restrict__ ber,
                                            float* __restrict__ rs2, int* __restrict__ cnt, int* __restrict__ tokl, int* __restrict__ tk_e, int* __restrict__ tk_pos, float* __restrict__ tk_w,
                                            LAS unsigned char* lds, int wave, int lane, int vcu, int G) {
    LAS float* lg = (LAS float*)(lds + RING_OFF + wave * 16384);
    LAS int* lcnt = (LAS int*)(lds + LDSCTL_OFF + 1024); LAS int* lbase = lcnt + 32;
    const int fr = lane & 15, fq = lane >> 4;
    for (int bt = vcu; bt < M / 64; bt += G) {
        if (wave == 0 && lane < 32) lcnt[lane] = 0;
        __syncthreads();
        int e1 = 0, e2 = 0, lp1 = 0, lp2 = 0; float tw1 = 0.f, tw2 = 0.f;
        const int t0 = bt * 64 + (wave & 3) * 16;
        f32x4 acc[3]; acc[0] = (f32x4){0.f, 0.f, 0.f, 0.f}; acc[1] = acc[0]; acc[2] = acc[0];
        float ss = 0.f;
        {
        const int kh = (wave >> 2) * 16;
        const bf16_t* xp = x + (size_t)(t0 + fr) * D + 8 * fq + 32 * kh;
        const bf16_t* wh = wrh + (size_t)fr * 1024 + 8 * fq + 32 * kh; const bf16_t* wl_ = wrl + (size_t)fr * 1024 + 8 * fq + 32 * kh;
#pragma unroll 8
        for (int kk = 0; kk < 16; ++kk) {
            const u32x4 av = *(const u32x4*)(xp + 32 * kk);
#pragma unroll
            for (int j = 0; j < 4; ++j) { const float a = bf_lo(av[j]), b = bf_hi(av[j]); ss += a * a + b * b; }
            const bf16x8 Ah = __builtin_bit_cast(bf16x8, av);
#pragma unroll
            for (int cb = 0; cb < 3; ++cb) {
                const bf16x8 bh = *(const bf16x8*)(wh + (size_t)cb * 16 * 1024 + 32 * kk), bl = *(const bf16x8*)(wl_ + (size_t)cb * 16 * 1024 + 32 * kk);
                acc[cb] = __builtin_amdgcn_mfma_f32_16x16x32_bf16(bh, Ah, acc[cb], 0, 0, 0);
                acc[cb] = __builtin_amdgcn_mfma_f32_16x16x32_bf16(bl, Ah, acc[cb], 0, 0, 0);
            }
        }
        }
        if (wave >= 4) { LAS float* pp = (LAS float*)(lds + RING_OFF + wave * 16384) + lane * 13;
#pragma unroll
            for (int cb = 0; cb < 3; ++cb)
#pragma unroll
                for (int i = 0; i < 4; ++i) pp[cb * 4 + i] = acc[cb][i];
            pp[12] = ss; }
        __syncthreads();
        if (wave < 4) {
        { const LAS float* pp = (const LAS float*)(lds + RING_OFF + (wave + 4) * 16384) + lane * 13;
#pragma unroll
            for (int cb = 0; cb < 3; ++cb)
#pragma unroll
                for (int i = 0; i < 4; ++i) acc[cb][i] += pp[cb * 4 + i];
            ss += pp[12]; }
        ss = sum_xor16_32(ss);
        const float rsr = 1.0f / sqrtf(ss * (1.f / D) + EPS);
#pragma unroll
        for (int cb = 0; cb < 3; ++cb)
#pragma unroll
            for (int i = 0; i < 4; ++i) lg[fr * 49 + 16 * cb + 4 * fq + i] = acc[cb][i] * rsr;
        if (fq == 0) lg[fr * 49 + 48] = rsr;
        asm volatile("s_waitcnt lgkmcnt(0)" ::: "memory");
        if (lane < 16) {
            const int tok = t0 + lane; const LAS float* l = lg + lane * 49;
            rs2[tok] = l[48];
            const float g0 = l[0] + bgr[0], g1 = l[1] + bgr[1], g2 = l[2] + bgr[2], g3 = l[3] + bgr[3];
            int grp = 0; float gm = g0;
            if (g1 > gm) { gm = g1; grp = 1; } if (g2 > gm) { gm = g2; grp = 2; } if (g3 > gm) { gm = g3; grp = 3; }
            const float gsum = (expf(g0 - gm) + expf(g1 - gm)) + (expf(g2 - gm) + expf(g3 - gm));
            const float grp_w = 1.f / gsum;
            int i1 = 0, i2 = 0; float m1 = -INFINITY, m2 = -INFINITY;
#pragma unroll
            for (int i = 0; i < 8; ++i) { const float el = l[4 + grp * 8 + i] + ber[grp * 8 + i]; if (el > m1) { m2 = m1; i2 = i1; m1 = el; i1 = i; } else if (el > m2) { m2 = el; i2 = i; } }
            const float p2 = expf(m2 - m1), w1 = 1.f / (1.f + p2), w2 = p2 / (1.f + p2);
            e1 = grp * 8 + i1; e2 = grp * 8 + i2; tw1 = grp_w * w1; tw2 = grp_w * w2;
            lp1 = __hip_atomic_fetch_add(&lcnt[e1], 1, __ATOMIC_RELAXED, __HIP_MEMORY_SCOPE_WORKGROUP); lp2 = __hip_atomic_fetch_add(&lcnt[e2], 1, __ATOMIC_RELAXED, __HIP_MEMORY_SCOPE_WORKGROUP);
        }
        }
        __syncthreads();
        if (wave == 0 && lane < 32) { const int c = lcnt[lane]; lbase[lane] = c > 0 ? atomicAdd(&cnt[lane * CNT_STRIDE], c) : 0; }
        __syncthreads();
        if (wave < 4 && lane < 16) {
            const int tok = t0 + lane; const int pos1 = lbase[e1] + lp1, pos2 = lbase[e2] + lp2;
            tokl[e1 * ECAP + pos1] = tok; tokl[e2 * ECAP + pos2] = tok;
            tk_e[tok * 2] = e1; tk_e[tok * 2 + 1] = e2; tk_pos[tok * 2] = pos1; tk_pos[tok * 2 + 1] = pos2; tk_w[tok * 2] = tw1; tk_w[tok * 2 + 1] = tw2;
        }
        __syncthreads();
    }
}

__device__ __forceinline__ void combine_pass(bf16_t* xb, const bf16_t* __restrict__ ys, const LAS int* pref, const int* __restrict__ tk_e, const int* __restrict__ tk_pos,
                                             const float* __restrict__ tk_w, float* __restrict__ rs3, int lane, int gw, int NGW) {
    for (int m0 = gw * 4; m0 < M; m0 += NGW * 4) {
        int s0[4], s1[4]; float w0[4], w1[4];
#pragma unroll
        for (int r = 0; r < 4; ++r) { const int m = m0 + r; const int e0 = tk_e[m * 2], e1 = tk_e[m * 2 + 1]; s0[r] = 256 * pref[e0] + tk_pos[m * 2]; s1[r] = 256 * pref[e1] + tk_pos[m * 2 + 1]; w0[r] = tk_w[m * 2]; w1[r] = tk_w[m * 2 + 1]; }
        u32x4 xv[4][2], a0[4][2], a1[4][2];
#pragma unroll
        for (int r = 0; r < 4; ++r)
#pragma unroll
            for (int j = 0; j < 2; ++j) { xv[r][j] = ((const u32x4*)(xb + (size_t)(m0 + r) * D) + lane)[64 * j]; a0[r][j] = ((const u32x4*)(ys + (size_t)s0[r] * D) + lane)[64 * j]; a1[r][j] = ((const u32x4*)(ys + (size_t)s1[r] * D) + lane)[64 * j]; }
#pragma unroll
        for (int r = 0; r < 4; ++r) { float s = 0.f;
#pragma unroll
            for (int j = 0; j < 2; ++j) { u32x4 w;
#pragma unroll
                for (int q = 0; q < 4; ++q) { w[q] = cvt_pk_bf16(bf_lo(xv[r][j][q]) + w0[r] * bf_lo(a0[r][j][q]) + w1[r] * bf_lo(a1[r][j][q]), bf_hi(xv[r][j][q]) + w0[r] * bf_hi(a0[r][j][q]) + w1[r] * bf_hi(a1[r][j][q]));
                    const float a = bf_lo(w[q]), b = bf_hi(w[q]); s += a * a + b * b; }
                st16((u32x4*)(xb + (size_t)(m0 + r) * D) + lane + 64 * j, w); }
            s = wave_sum(s);
            if (lane == 0) rs3[m0 + r] = 1.0f / sqrtf(s * (1.f / D) + EPS); }
    }
}

constexpr int PH_PER_LAYER = 10;
#ifndef FK_REP
#define FK_REP 0
#endif
#define REPS(bit) ((FK_REP & (bit)) ? 2 : 1)
__global__ void __launch_bounds__(NWAVES * 64, 2) mega_fwd(Args args_unused) {
    extern __shared__ __attribute__((aligned(16))) unsigned char lds_raw[];
    LAS unsigned char* lds = (LAS unsigned char*)lds_raw;
    LAS int* pref = (LAS int*)(lds + PREF_OFF);
    const KArgs kp0 = (KArgs)__builtin_amdgcn_kernarg_segment_ptr();
    const int tid = threadIdx.x, wave0 = __builtin_amdgcn_readfirstlane(tid >> 6);
    const int G = gridDim.x, bx = blockIdx.x;
    const int vcu = (G % 8 == 0) ? (bx % 8) * (G / 8) + bx / 8 : bx;
    const int gw0 = vcu * NWAVES + wave0, NGW = G * NWAVES;
#define FK_T0 (wave0 == 0 && fk_lane() == 0)
#define FK_IDS int lane_o = fk_lane(), wave_o = wave0, gw_o = gw0; asm volatile("" : "+v"(lane_o), "+s"(wave_o), "+s"(gw_o)); const int lane = lane_o, wave = wave_o, gw = gw_o; (void)lane; (void)wave; (void)gw;
    for (int u = tid; u < (LDS_BYTES - LDSCTL_OFF) / 4; u += NWAVES * 64) ((LAS unsigned*)(lds + LDSCTL_OFF))[u] = 0u;
    __syncthreads();
    const int lo = kp0->ph_lo, hi = kp0->ph_hi, nlayers = kp0->nlayers;
#define IN(k) (lo <= (k) && (k) < hi)
    const bool fill_on = (hi - lo > 1) && G == 256;
#define SEAM_F(k, Lc, slab) do { if (IN(k) && IN((k) + 1)) { \
        asm volatile("s_waitcnt vmcnt(0)" ::: "memory"); __syncthreads(); \
        if (wave0 == 0) { if (fk_lane() == 0) { KArgs A_ = fresh(kp0); XcdBarrier bar_; bar_.bar = (unsigned*)(A_->ws + WS_CTL) + CW_BAR; bar_.x = xb_xcc_id(); bar_.st = (volatile LAS unsigned*)(lds + MISC_OFF) + 8; xcd_barrier_t0(bar_); } } \
        else if (fill_on && (Lc) < nlayers && (slab) < FILL_SLABS && wave0 <= FILLW) { int idx_ = (slab) * FILLW * G + bx * FILLW + (wave0 - 1); asm volatile("" : "+s"(idx_));   if (idx_ < CVT_PER_LAYER) convert_item(fresh(kp0), (Lc), idx_, (LAS float*)(lds + RING_OFF + wave0 * 17408), fk_lane()); } \
        __syncthreads(); } } while (0)
#define SEAM(k) SEAM_F(k, L + 1, (k) - pb)
    if (hi - lo > 1) { KArgs A = fresh(kp0); (void)xcd_barrier_post((unsigned*)(A->ws + WS_CTL) + CW_BAR, (volatile LAS unsigned*)(lds + MISC_OFF) + 8, FK_T0); }

    if (IN(0)) { for (int rep = 0; rep < REPS(1); ++rep) { FK_IDS; p0_prologue(fresh(kp0), nlayers, fill_on, lds, wave, lane, gw, NGW); } }
    SEAM_F(0, nlayers, 0);
    if (IN(1)) { }
    for (int L = 0; L < nlayers; ++L) {
        const int pb = 2 + PH_PER_LAYER * L;
        if (IN(pb + 0)) for (int rep = 0; rep < REPS(4); ++rep) {
            KArgs A = fresh(kp0); unsigned char* ws = A->ws; unsigned char* wl = ws + WS_W + (size_t)L * WL_STRIDE;
            DenseOrder S; S.init(M, INW, G, bx, ws + WS_XB, wl + WO_IN, D);
            EpiIn E{(const float*)(ws + WS_XPART), A->in[4] + L * 64, A->in[5] + L * 64, (bf16_t*)(ws + WS_Q), (bf16_t*)(ws + WS_K), (bf16_t*)(ws + WS_V), (bf16_t*)(ws + WS_U), (bf16_t*)(ws + WS_VS), (bf16_t*)(ws + WS_GAB), (float*)(ws + WS_VSPART)};
            gemm_phase<EpiIn, DenseOrder, true>(lds + RING_OFF, D, S, E, wave0);
            { const int nshort = (G == 256) ? 128 : G; const int c2 = (G == 256) ? bx - 128 : bx;
              if (c2 >= 0) { DenseOrder S2; S2.init(M, D, nshort, c2, ws + WS_PB + (size_t)L * M * 256 * 2, wl + WO_PP, 256);
                  EpiPlain E2{(bf16_t*)(ws + WS_E) + (size_t)L * M * D, D, 0};
                  gemm_phase<EpiPlain, DenseOrder, true>(lds + RING_OFF, 256, S2, E2, wave0); } }
        }
        SEAM(pb + 0);
        if (IN(pb + 1)) for (int rep = 0; rep < REPS(8 | 2048); ++rep) {
            KArgs A = fresh(kp0); unsigned char* ws = A->ws; unsigned char* wl = ws + WS_W + (size_t)L * WL_STRIDE;
            FK_IDS;
            LAS unsigned char* wlds = lds + RING_OFF + wave * WLDS_BYTES;
            constexpr int NATT = 2 * 8 * (SEQ / 32), NSGU = (M / 128) * 8 * 2;
            for (int it = gw; it < NATT + NSGU; it += NGW) {
                if (rep == 1 && (it < NATT ? !(FK_REP & 8) : !(FK_REP & 2048))) continue;
                if (it < NATT) { const int qblk = it % (SEQ / 32), bh = it / (SEQ / 32); attn_wave_unit(bh >> 3, bh & 7, qblk, (const bf16_t*)(ws + WS_Q), (const bf16_t*)(ws + WS_K), (const bf16_t*)(ws + WS_V), (bf16_t*)(ws + WS_OC), wlds, lane); }
                else { const int j = it - NATT; const int hf = j & 1, g = (j >> 1) & 7, ch = j >> 4;
                    if (hf == 0) sgu_wave_unit<0>(ch, g, (const bf16_t*)(ws + WS_U), (const bf16_t*)(ws + WS_VS), (const float*)(ws + WS_VSPART), (const bf16_t*)(wl + WO_SP), A->in[8] + (size_t)L * 8 * 128, A->in[6] + (size_t)L * 512, (bf16_t*)(ws + WS_OC), wlds, lane);
                    else sgu_wave_unit<1>(ch, g, (const bf16_t*)(ws + WS_U), (const bf16_t*)(ws + WS_VS), (const float*)(ws + WS_VSPART), (const bf16_t*)(wl + WO_SP), A->in[8] + (size_t)L * 8 * 128, A->in[6] + (size_t)L * 512, (bf16_t*)(ws + WS_OC), wlds, lane); }
            }
        }
        SEAM(pb + 1);
        if (IN(pb + 2)) for (int rep = 0; rep < REPS(16); ++rep) {
            KArgs A = fresh(kp0); unsigned char* ws = A->ws; unsigned char* wl = ws + WS_W + (size_t)L * WL_STRIDE;
            DenseOrder S; S.init(M, D, G, bx, ws + WS_OC, wl + WO_UP, D);
            EpiUp E{(const bf16_t*)(ws + WS_GAB), (bf16_t*)(ws + WS_MG)};
            gemm_phase<EpiUp, DenseOrder, false>(lds + RING_OFF, D, S, E, wave0);
        }
        SEAM(pb + 2);
        if (IN(pb + 3)) {
            KArgs A = fresh(kp0); unsigned char* ws = A->ws; unsigned char* wl = ws + WS_W + (size_t)L * WL_STRIDE;
            DenseOrder S; S.init(M, D, G, bx, ws + WS_MG, wl + WO_OUT, D);
            EpiOut E{(const bf16_t*)(ws + WS_XB), (bf16_t*)(ws + WS_XB1)};
            gemm_phase<EpiOut, DenseOrder, false>(lds + RING_OFF, D, S, E, wave0);
        }
        SEAM(pb + 3);
        if (IN(pb + 4)) {
            KArgs A = fresh(kp0); unsigned char* ws = A->ws; unsigned char* wl = ws + WS_W + (size_t)L * WL_STRIDE;
            FK_IDS;
            router_pass((const bf16_t*)(ws + WS_XB1), (const bf16_t*)(wl + WO_R), (const bf16_t*)(wl + WO_R) + 48 * 1024, A->in[14] + L * 4, A->in[16] + L * 32, (float*)(ws + WS_RS2), (int*)((unsigned*)(ws + WS_CTL) + CW_CNT) + L * NE * CNT_STRIDE, (int*)(ws + WS_TOKL), (int*)(ws + WS_TKE), (int*)(ws + WS_TKP), (float*)(ws + WS_TKW), lds, wave, lane, vcu, G);
        }
        SEAM(pb + 4);
        if (IN(pb + 5) || IN(pb + 6) || IN(pb + 7) || IN(pb + 8)) {
            KArgs A = fresh(kp0); const int* cnt = (const int*)((unsigned*)(A->ws + WS_CTL) + CW_CNT) + L * NE * CNT_STRIDE;
            if (FK_T0) { int s = 0; for (int e = 0; e < NE; ++e) { pref[e] = s; s += (cnt[e * CNT_STRIDE] + 255) >> 8; } pref[NE] = s; }
            __syncthreads();
        }
        const int nG1 = pref[NE] * 4, fr = nG1 / G, n3 = nG1 - fr * G;
        const int jB = (fr >= 1) ? min(2 * (G - n3), (fr * G / 4) * 4) : 0;
        if (IN(pb + 5)) for (int rep = 0; rep < REPS(32); ++rep) {
            KArgs A = fresh(kp0); unsigned char* ws = A->ws; unsigned char* wl = ws + WS_W + (size_t)L * WL_STRIDE; const int* cnt = (const int*)((unsigned*)(ws + WS_CTL) + CW_CNT) + L * NE * CNT_STRIDE;
            ExpertOrder S{G, bx, D, 4, (const char*)(ws + WS_XB1), (const char*)(wl + WO_EI), (size_t)1024 * 1024 * 2, pref, (const int*)(ws + WS_TOKL), cnt, 1, 0, fr, fr * G, 0};
            EpiG1 E{(const int*)(ws + WS_TOKL), cnt, (const float*)(ws + WS_RS2), (bf16_t*)(ws + WS_G)};
            gemm_phase<EpiG1, ExpertOrder, true>(lds + RING_OFF, D, S, E, wave0);
        }
        SEAM(pb + 5);
        if (IN(pb + 6)) {
            KArgs A = fresh(kp0); unsigned char* ws = A->ws; unsigned char* wl = ws + WS_W + (size_t)L * WL_STRIDE; const int* cnt = (const int*)((unsigned*)(ws + WS_CTL) + CW_CNT) + L * NE * CNT_STRIDE;
            if (bx < n3) {
                ExpertOrder S{G, bx, D, 4, (const char*)(ws + WS_XB1), (const char*)(wl + WO_EI), (size_t)1024 * 1024 * 2, pref, (const int*)(ws + WS_TOKL), cnt, 1, fr * G, 1, nG1, 0};
                EpiG1 E{(const int*)(ws + WS_TOKL), cnt, (const float*)(ws + WS_RS2), (bf16_t*)(ws + WS_G)};
                gemm_phase<EpiG1, ExpertOrder, true>(lds + RING_OFF, D, S, E, wave0);
            } else {
                ExpertOrder S{G - n3, bx - n3, 512, 4, (const char*)(ws + WS_G), (const char*)(wl + WO_EO), (size_t)1024 * 512 * 2, pref, (const int*)(ws + WS_TOKL), cnt, 0, 0, 2, jB, 0};
                EpiPlain E{(bf16_t*)(ws + WS_YS), D, 1};
                gemm_phase<EpiPlain, ExpertOrder, true>(lds + RING_OFF, 512, S, E, wave0);
            }
        }
        SEAM(pb + 6);
        if (IN(pb + 7)) for (int rep = 0; rep < REPS(64); ++rep) {
            KArgs A = fresh(kp0); unsigned char* ws = A->ws; unsigned char* wl = ws + WS_W + (size_t)L * WL_STRIDE; const int* cnt = (const int*)((unsigned*)(ws + WS_CTL) + CW_CNT) + L * NE * CNT_STRIDE;
            ExpertOrder S{G, bx, 512, 4, (const char*)(ws + WS_G), (const char*)(wl + WO_EO), (size_t)1024 * 512 * 2, pref, (const int*)(ws + WS_TOKL), cnt, 0, jB, 1 << 20, nG1, 0};
            EpiPlain E{(bf16_t*)(ws + WS_YS), D, 1};
            gemm_phase<EpiPlain, ExpertOrder, true>(lds + RING_OFF, 512, S, E, wave0);
        }
        SEAM(pb + 7);
        if (IN(pb + 8)) {
            KArgs A = fresh(kp0); unsigned char* ws = A->ws;
            FK_IDS;
            combine_pass((bf16_t*)(ws + WS_XB1), (const bf16_t*)(ws + WS_YS), pref, (const int*)(ws + WS_TKE), (const int*)(ws + WS_TKP), (const float*)(ws + WS_TKW), (float*)(ws + WS_RS3), lane, gw, NGW);
        }
        SEAM(pb + 8);
        if (IN(pb + 9)) {
            KArgs A = fresh(kp0); unsigned char* ws = A->ws; unsigned char* wl = ws + WS_W + (size_t)L * WL_STRIDE;
            DenseOrder S; S.init(M, D, G, bx, ws + WS_XB1, wl + WO_PG, D);
            EpiPle E{(const bf16_t*)(ws + WS_XB1), (bf16_t*)(ws + WS_XB), (L == nlayers - 1) ? A->out : (float*)nullptr, (const bf16_t*)(ws + WS_E) + (size_t)L * M * D, (const float*)(ws + WS_RS3), (float*)(ws + WS_XPART)};
            gemm_phase<EpiPle, DenseOrder, false>(lds + RING_OFF, D, S, E, wave0);
        }
        SEAM(pb + 9);
    }
#undef IN
#undef SEAM
#undef SEAM_F
#undef FK_IDS
#undef FK_T0
}
}
#ifndef FK_N_LAUNCHES
#define FK_N_LAUNCHES 1
#endif
static int fk_grid = 0;
static bool fk_setup() {
    if (fk_grid) return fk_grid > 0;
    int dev = 0, cus = 0, per_cu = 0;
    if (hipGetDevice(&dev) != hipSuccess || hipDeviceGetAttribute(&cus, hipDeviceAttributeMultiprocessorCount, dev) != hipSuccess) { fprintf(stderr, "kernel_launch: device query failed\n"); fk_grid = -1; return false; }
    if (hipFuncSetAttribute((const void*)fk::mega_fwd, hipFuncAttributeMaxDynamicSharedMemorySize, fk::LDS_BYTES) != hipSuccess) { fprintf(stderr, "kernel_launch: hipFuncSetAttribute failed\n"); fk_grid = -1; return false; }
    if (hipOccupancyMaxActiveBlocksPerMultiprocessor(&per_cu, (const void*)fk::mega_fwd, fk::NWAVES * 64, fk::LDS_BYTES) != hipSuccess || per_cu < 1)
        fprintf(stderr, "kernel_launch: note: occupancy query reports %d workgroups per CU\n", per_cu);
    (void)hipGetLastError();
    fk_grid = cus;
    return true;
}
static void fk_launch_range(fk::Args a, int lo, int hi, hipStream_t stream) {
    a.ph_lo = lo; a.ph_hi = hi;
    hipLaunchKernelGGL(fk::mega_fwd, dim3(fk_grid), dim3(fk::NWAVES * 64), fk::LDS_BYTES, stream, a);
    const hipError_t le = hipPeekAtLastError();
    if (le != hipSuccess) fprintf(stderr, "kernel_launch: launch [%d,%d) failed: %s\n", lo, hi, hipGetErrorName(le));
}

#ifdef FK_DEBUG_CHECK
#ifndef FK_FOCUS
#define FK_FOCUS 0
#endif
#ifndef FK_STAT
#define FK_STAT 1
#endif
namespace dbg {
__global__ void __launch_bounds__(256) k_cmp(const void* fast, int is_bf16, int fld, int fcol0, const float* gold, int gld, int gcol0, int rows, int cols, float gscale, float* acc) {
    float sd = 0.f, sb = 0.f, sa = 0.f, sb2 = 0.f;
    const size_t n = (size_t)rows * cols;
    for (size_t i = (size_t)blockIdx.x * 256 + threadIdx.x; i < n; i += (size_t)gridDim.x * 256) {
        const size_t r = i / cols; const int c = (int)(i % cols);
        float a;
        if (is_bf16) { const unsigned short h = ((const unsigned short*)fast)[r * fld + fcol0 + c]; a = __uint_as_float((unsigned)h << 16); } else a = ((const float*)fast)[r * fld + fcol0 + c];
        const float b = gold[r * gld + gcol0 + c] * gscale;
        const float d = a - b; sd += d * d; sb += b * b; sa += (FK_STAT == 2 ? a : FK_STAT == 3 ? a * b : FK_STAT == 4 ? (a > 0.99f ? 1.f : 0.f) : a * a); sb2 += (FK_STAT == 2 ? b : FK_STAT == 4 ? 1.f : b * b);
    }
    for (int o = 1; o < 64; o <<= 1) { sd += __shfl_xor(sd, o); sb += __shfl_xor(sb, o); sa += __shfl_xor(sa, o); sb2 += __shfl_xor(sb2, o); }
    if ((threadIdx.x & 63) == 0) { atomicAdd(&acc[0], sd); atomicAdd(&acc[1], sb); atomicAdd(&acc[512], sa); atomicAdd(&acc[513], sb2); }
}
__global__ void __launch_bounds__(256) k_cmp_vs(const unsigned short* vsb, const float* vspart, const float* gain, const float* gz, float* acc) {
    const int row = blockIdx.x * 4 + (threadIdx.x >> 6), lane = threadIdx.x & 63;
    float ss = 0.f; for (int j = 0; j < 8; ++j) ss += vspart[(size_t)row * 8 + j];
    const float rv = 1.f / sqrtf(ss / 512.f + 1e-6f);
    float sd = 0.f, sb = 0.f;
    for (int j = 0; j < 8; ++j) { const int c = lane + 64 * j; const float a = __uint_as_float((unsigned)vsb[(size_t)row * 512 + c] << 16) * rv * gain[c]; const float b = gz[(size_t)row * 4608 + 2048 + c]; sd += (a - b) * (a - b); sb += b * b; }
    for (int o = 1; o < 64; o <<= 1) { sd += __shfl_xor(sd, o); sb += __shfl_xor(sb, o); }
    if (lane == 0) { atomicAdd(&acc[0], sd); atomicAdd(&acc[1], sb); }
}
__global__ void __launch_bounds__(256) k_cmp_w(const unsigned short* wt, const float* w, const float* gain, int n0, int n1, float* acc) {
    float sd = 0.f, sb = 0.f; const size_t tot = (size_t)(n1 - n0) * 1024;
    for (size_t i = (size_t)blockIdx.x * 256 + threadIdx.x; i < tot; i += (size_t)gridDim.x * 256) { const int n = n0 + (int)(i >> 10), k = (int)(i & 1023);
        const float a = __uint_as_float((unsigned)wt[(size_t)n * 1024 + k] << 16), b = gain[k] * w[(size_t)k * 4608 + n]; sd += (a - b) * (a - b); sb += b * b; }
    for (int o = 1; o < 64; o <<= 1) { sd += __shfl_xor(sd, o); sb += __shfl_xor(sb, o); }
    if ((threadIdx.x & 63) == 0) { atomicAdd(&acc[0], sd); atomicAdd(&acc[1], sb); }
}
__global__ void k_final_v(const float* acc, int nchecks, float tol, float* v, int focus) {
    if (threadIdx.x == 0 && blockIdx.x == 0) {
        float out = 0.f;
        if (focus > 0) { float m = acc[2 * focus + 512] / acc[2 * focus + 513]; if (FK_STAT == 1) m = sqrtf(m); if (!(m <= 8.f)) m = 8.f; m = floorf(m * 20.f + 0.5f) * 0.05f; v[0] = powf(10.f, (float)focus) * (1.f + m); return; }
        for (int c = nchecks; c >= 1; --c) { const float e = sqrtf(acc[2 * c] / acc[2 * c + 1]); if (!(e <= tol)) { float m = e; if (!(m <= 2.f)) m = 2.f; m = floorf(m * 10.f + 0.5f) * 0.1f;   out = powf(10.f, (float)c) * (1.f + m); } }
        v[0] = out;
    }
}
__global__ void __launch_bounds__(256) k_scale_out(const float* base, const float* v, float* out, size_t n) {
    const size_t i = (size_t)blockIdx.x * 256 + threadIdx.x; if (i < n) out[i] = base[i] * (1.f + v[0]);
}
}
#endif

extern "C" void kernel_launch(void* const* d_in, const int* in_sizes, int n_in, void* d_out, int out_size, void* d_ws, size_t ws_size, hipStream_t stream) {
    using namespace fk;
    if (n_in != 22 || out_size != M * D || ws_size < WS_FAST_END) { fprintf(stderr, "kernel_launch: unexpected shapes (n_in %d out %d ws %zu)\n", n_in, out_size, ws_size); return; }
    if (!fk_setup()) return;
    if (hipMemsetAsync((char*)d_ws + WS_CTL, 0, CTL_ZERO_BYTES, stream) != hipSuccess) { fprintf(stderr, "kernel_launch: memset failed\n"); return; }
    Args a{};
    for (int i = 0; i < 22; ++i) a.in[i] = (const float*)d_in[i];
    a.out = (float*)d_out; a.ws = (unsigned char*)d_ws; a.nlayers = DEPTH; a.pad = 0;
#ifndef FK_DEBUG_CHECK
    const int nph = 2 + PH_PER_LAYER * DEPTH;
    if (FK_N_LAUNCHES == 1) fk_launch_range(a, 0, nph, stream);
    else for (int p = 0; p < nph; ++p) fk_launch_range(a, p, p + 1, stream);
#else
    constexpr size_t GOLD_BASE = 1100 * MiB, SN_A = 128 * MiB, SN_B = 192 * MiB, SN_BASE = 256 * MiB, FS_A = 320 * MiB, FS_B = 384 * MiB, DBG_ACC = 448 * MiB;
    if (ws_size < GOLD_BASE + gold::O_END) { fprintf(stderr, "kernel_launch: debug build needs %zu bytes of workspace, got %zu\n", GOLD_BASE + gold::O_END, ws_size); return; }
    unsigned char* ws = (unsigned char*)d_ws; unsigned char* gb = ws + GOLD_BASE;
    gold::forward(d_in, (float*)(ws + SN_BASE), gb, 4, stream);
    gold::forward(d_in, nullptr, gb, 1, stream, (float*)(ws + SN_A), (float*)(ws + SN_B));
    a.nlayers = 1;
    const int nph = 2 + PH_PER_LAYER;
    for (int p = 0; p < nph; ++p) {
        fk_launch_range(a, p, p + 1, stream);
        if (p == 2 + 0) (void)hipMemcpyAsync(ws + 528 * MiB, ws + WS_GAB, (size_t)M * 2048 * 2, hipMemcpyDeviceToDevice, stream);
        if (p == 2 + 3) (void)hipMemcpyAsync(ws + FS_A, d_out, (size_t)M * D * 4, hipMemcpyDeviceToDevice, stream);
        if (p == 2 + 7) (void)hipMemcpyAsync(ws + FS_B, d_out, (size_t)M * D * 4, hipMemcpyDeviceToDevice, stream);
    }
    float* acc = (float*)(ws + DBG_ACC);
    (void)hipMemsetAsync(acc, 0, 4096, stream);
    const float* gz = (const float*)(gb + gold::O_Z);
    int c = 0;
#define CMP(fast, isbf, fld, fc0, gold_, gld, gc0, rows, cols, gs) do { ++c; hipLaunchKernelGGL(dbg::k_cmp, dim3(2048), dim3(256), 0, stream, (const void*)(fast), isbf, fld, fc0, (const float*)(gold_), gld, gc0, rows, cols, gs, acc + 2 * c); } while (0)
    ++c; hipLaunchKernelGGL(dbg::k_cmp_w, dim3(1024), dim3(256), 0, stream, (const unsigned short*)(ws + WS_W + WO_IN), (const float*)d_in[3], (const float*)d_in[2], 1024, 2560, acc + 2 * c);
    ++c; hipLaunchKernelGGL(dbg::k_cmp_w, dim3(1024), dim3(256), 0, stream, (const unsigned short*)(ws + WS_W + WO_IN), (const float*)d_in[3], (const float*)d_in[2], 2560, 3584, acc + 2 * c);
    ++c; hipLaunchKernelGGL(dbg::k_cmp_w, dim3(1024), dim3(256), 0, stream, (const unsigned short*)(ws + WS_W + WO_IN), (const float*)d_in[3], (const float*)d_in[2], 3584, 4608, acc + 2 * c);
    CMP(ws + WS_E, 1, 1024, 0, gb + gold::O_YB, 1024, 0, M, 1024, 1.f);
    CMP(ws + WS_Q, 1, 512, 0, gz, INW, 0, M, 512, 0.125f * LOG2E);
    CMP(ws + WS_K, 1, 512, 0, gz, INW, 512, M, 512, 1.f);
    CMP(ws + WS_V, 1, 512, 0, gz, INW, 1024, M, 512, 1.f);
    CMP(ws + WS_U, 1, 512, 0, gz, INW, 1536, M, 512, 1.f);
    ++c; hipLaunchKernelGGL(dbg::k_cmp_vs, dim3(M / 4), dim3(256), 0, stream, (const unsigned short*)(ws + WS_VS), (const float*)(ws + WS_VSPART), (const float*)d_in[6], gz, acc + 2 * c);
    CMP(ws + WS_OC, 1, 1024, 0, gb + gold::O_OA, 512, 0, M, 512, 1.f);
    CMP(ws + WS_OC, 1, 1024, 512, gb + gold::O_OB, 512, 0, M, 512, 1.f);
    CMP(ws + WS_MG, 1, 1024, 0, gb + gold::O_YA, 1024, 0, M, 1024, 1.f);
    CMP(ws + FS_A, 0, 1024, 0, ws + SN_A, 1024, 0, M, 1024, 1.f);
    CMP(ws + FS_B, 0, 1024, 0, ws + SN_B, 1024, 0, M, 1024, 1.f);
    CMP(d_out, 0, 1024, 0, gb + gold::O_X, 1024, 0, M, 1024, 1.f);
    CMP(ws + 528 * MiB, 1, 2048, 0, gz, INW, 2560, M, 256, 1.f);
    CMP(ws + WS_GAB, 1, 2048, 0, gz, INW, 2560, M, 256, 1.f);
    CMP(ws + WS_GAB, 1, 2048, 256, gz, INW, 2816, M, 256, 1.f);
    CMP(ws + WS_GAB, 1, 2048, 512, gz, INW, 3072, M, 512, 1.f);
    CMP(ws + WS_GAB, 1, 2048, 1024, gz, INW, 3584, M, 1024, 1.f);
    hipLaunchKernelGGL(dbg::k_final_v, dim3(1), dim3(64), 0, stream, acc, c, 0.03f, acc + 900, FK_FOCUS);
    hipLaunchKernelGGL(dbg::k_scale_out, dim3(M * D / 256), dim3(256), 0, stream, (const float*)(ws + SN_BASE), acc + 900, (float*)d_out, (size_t)M * D);
#endif
}
```

```cpp
#include <hip/hip_runtime.h>
#include <hip/hip_bf16.h>
#include <cstdio>
#include <cstdint>
#include <cmath>
namespace fk {
#define LAS __attribute__((address_space(3)))
#define GAS __attribute__((address_space(1)))
typedef unsigned short bf16_t;
typedef short bf16x8 __attribute__((ext_vector_type(8)));
typedef short s16x4 __attribute__((ext_vector_type(4)));
typedef float f32x2 __attribute__((ext_vector_type(2)));
typedef float f32x4 __attribute__((ext_vector_type(4)));
typedef float f32x16 __attribute__((ext_vector_type(16)));
typedef unsigned u32x2 __attribute__((ext_vector_type(2)));
typedef unsigned u32x4 __attribute__((ext_vector_type(4)));

constexpr int M = 16384, SEQ = 8192, D = 1024, INW = 4608, NE = 32, ECAP = 16384, DEPTH = 4;
constexpr float EPS = 1e-6f, LOG2E = 1.4426950408889634f;
constexpr int CNT_STRIDE = 64;
constexpr int BM = 256, BK = 64, HALF = 128, HTB = HALF * BK * 2, STAGE_BYTES = 8 * HTB, NXCD = 8, WGM = 8;

__device__ __forceinline__ unsigned cvt_pk_bf16(float lo, float hi) { unsigned r; asm volatile("v_cvt_pk_bf16_f32 %0, %1, %2" : "=v"(r) : "v"(lo), "v"(hi)); return r; }
__device__ __forceinline__ float bf_lo(unsigned w) { return __uint_as_float(w << 16); }
__device__ __forceinline__ float bf_hi(unsigned w) { return __uint_as_float(w & 0xffff0000u); }
__device__ __forceinline__ float fast_rcp(float x) { return __builtin_amdgcn_rcpf(x); }
__device__ __forceinline__ float fast_exp2(float x) { return __builtin_amdgcn_exp2f(x); }
__device__ __forceinline__ float fast_log2(float x) { return __builtin_amdgcn_logf(x); }
__device__ __forceinline__ float fast_rsq(float x) { return __builtin_amdgcn_rsqf(x); }
__device__ __forceinline__ float sigmoid_f(float x) { return fast_rcp(1.f + fast_exp2(-LOG2E * x)); }
__device__ __forceinline__ float gelu_tanh_f(float x) { const float u2 = 1.5957691216057308f * (x + 0.044715f * x * x * x); return x * fast_rcp(1.f + fast_exp2(-LOG2E * u2)); }

__host__ __device__ __forceinline__ int lds_byte(int r, int c) { const int st = (r >> 4) * 2 + (c >> 5), rr = r & 15, cc = c & 31, ob = rr * 64 + cc * 2; return st * 1024 + (ob ^ (((ob >> 9) & 1) << 5)); }
__host__ __device__ __forceinline__ void stage_rc(int b, int& R, int& C) { const int st = b / 1024, sb = b % 1024, swz = sb ^ (((sb >> 9) & 1) << 5); R = (st >> 1) * 16 + swz / 64; C = (st & 1) * 32 + (swz % 64) / 2; }
__host__ __device__ __forceinline__ int perm32(int rho) { const int n = rho >> 4, i = rho & 15; return 8 * (i >> 2) + 4 * n + (i & 3); }

template <int MASK> __device__ __forceinline__ float xor_lt32(float v) { return __int_as_float(__builtin_amdgcn_ds_swizzle(__float_as_int(v), (MASK << 10) | 0x1f)); }
__device__ __forceinline__ void halves32(float v, float& lo, float& hi) { auto rr = __builtin_amdgcn_permlane32_swap(__float_as_uint(v), __float_as_uint(v), false, false); lo = __uint_as_float(rr[0]); hi = __uint_as_float(rr[1]); }
__device__ __forceinline__ float sum_xor16_32(float v) { v += xor_lt32<16>(v); float lo, hi; halves32(v, lo, hi); return lo + hi; }
#ifndef FK_WT
#define FK_WT 0
#endif
__device__ __forceinline__ void st16wt(void* p, u32x4 v) {
#if FK_WT
    asm volatile("global_store_dwordx4 %0, %1, off sc1" :: "v"(p), "v"(v) : "memory");
#else
    *(u32x4*)p = v;
#endif
}
__device__ __forceinline__ void st16(void* p, u32x4 v) { *(u32x4*)p = v; }
__device__ __forceinline__ int fk_lane() { int l; asm volatile("v_mbcnt_lo_u32_b32 %0, -1, 0\n\tv_mbcnt_hi_u32_b32 %0, -1, %0" : "=v"(l)); return l; }
struct Unit { int pm, pn, e, aux; };

struct DenseOrder {
    int nM, nN, nwg, G, c; const char* A; const char* B; int K;
    __device__ void init(int Mr, int N, int G_, int c_, const void* A_, const void* B_, int K_) { nM = Mr / BM; nN = N / BM; nwg = nM * nN; G = G_; c = c_; A = (const char*)A_; B = (const char*)B_; K = K_; }
    __device__ __forceinline__ bool next(int i, Unit& u) const {
        const long L = (long)i * G + c; if (L >= nwg) return false;
        int wgid = (int)L; { const int q = nwg / NXCD, r = nwg % NXCD, xcd = wgid % NXCD, off = wgid / NXCD; wgid = (xcd < r ? xcd * (q + 1) : r * (q + 1) + (xcd - r) * q) + off; }
        const int nig = WGM * nN, gid = wgid / nig, fm = gid * WGM, gsz = (nM - fm) < WGM ? (nM - fm) : WGM;
        u.pm = fm + ((wgid % nig) % gsz); u.pn = (wgid % nig) / gsz; u.e = 0; u.aux = 0; return true;
    }
    __device__ __forceinline__ const char* a_base() const { return A; }
    __device__ __forceinline__ const char* b_base(const Unit& u) const { return B + (size_t)u.pn * BM * K * 2; }
    __device__ __forceinline__ void a_voff(const Unit& u, unsigned (&v)[2][2], const int (&R)[2], const int (&C)[2]) const {
#pragma unroll
        for (int h = 0; h < 2; ++h)
#pragma unroll
            for (int i = 0; i < 2; ++i) v[h][i] = (unsigned)((u.pm * BM + h * HALF + R[i]) * K + C[i]) * 2u;
    }
};

struct ExpertOrder {
    int G, c, K, nN; const char* A; const char* B; size_t bstride; const LAS int* pref; const int* tokl; const int* cnt; int gather;
    int L0, imax, Lend;
    int xcd_deal;
    __device__ __forceinline__ bool next(int i, Unit& u) const {
        if (i >= imax) return false;
        int u_ = c; if (xcd_deal) { const int q = c >> 3, x = c & 7; u_ = (x * (G >> 5) + (q >> 2)) * 4 + (q & 3); }
        const int L = L0 + i * G + u_; const int tot = pref[NE] * nN; if (L >= Lend || L >= tot) return false;
        const int rbi = L / nN; u.pn = L % nN; int e = 0;
#pragma unroll 1
        for (int j = 1; j < NE; ++j) if (rbi >= pref[j]) e = j;
        u.e = e; u.pm = rbi - pref[e]; u.aux = rbi * BM; return true;
    }
    __device__ __forceinline__ const char* a_base() const { return A; }
    __device__ __forceinline__ const char* b_base(const Unit& u) const { return B + (size_t)u.e * bstride + (size_t)u.pn * BM * K * 2; }
    __device__ __forceinline__ void a_voff(const Unit& u, unsigned (&v)[2][2], const int (&R)[2], const int (&C)[2]) const {
        const int ce = cnt[u.e * CNT_STRIDE];
#pragma unroll
        for (int h = 0; h < 2; ++h)
#pragma unroll
            for (int i = 0; i < 2; ++i) {
                const int r = u.pm * BM + h * HALF + R[i]; int row;
                if (gather) row = (r < ce) ? tokl[u.e * ECAP + r] : 0; else row = u.aux + h * HALF + R[i];
                v[h][i] = (unsigned)(row * K + C[i]) * 2u;
            }
    }
};

template <class Epi, class Sched, bool ALIGN_EPI>
__device__ __forceinline__ void gemm_phase(LAS unsigned char* lds, const int K, const Sched& S, const Epi& E, const int wave_id) {
    const int tid_ = (wave_id << 6) | fk_lane();
    const int tid = tid_, wid = __builtin_amdgcn_readfirstlane(tid >> 6), lane = tid & 63, wr = wid >> 2, wc = wid & 3, fr = lane & 15, fq = lane >> 4;
    const int nt = K / BK;
    int Rr[2], Cc[2]; unsigned voffB[2];
#pragma unroll
    for (int i = 0; i < 2; ++i) { int R, C; stage_rc(tid * 16 + i * 8192, R, C); Rr[i] = R; Cc[i] = C; const int Rb = Epi::PERM ? ((R & ~31) + perm32(R & 31)) : R; voffB[i] = (unsigned)(Rb * K + C) * 2u; }
    const size_t kstep = (size_t)(BK * 2);
    const size_t hstep = (size_t)HALF * K * 2;
    const unsigned ldsw = (unsigned)wid * 1024u;
    const int aoff = lds_byte(wr * 64 + fr, fq * 8), boff = lds_byte(wc * 32 + fr, fq * 8);
#define PG8_SA(b, h) (((b) * 2 + (h)) * HTB)
#define PG8_SB(b, h) ((4 + (b) * 2 + (h)) * HTB)
#define PG8_STAGE_B(bufoff, gbase) do { _Pragma("unroll") for (int _i = 0; _i < 2; ++_i) \
        __builtin_amdgcn_global_load_lds((const unsigned*)((const char*)(gbase) + voffB[_i]), (LAS unsigned*)(lds + (bufoff) + ldsw + _i * 8192), 16, 0, 0); } while (0)
#define PG8_STAGE_A(bufoff, vo, h, koff) do { _Pragma("unroll") for (int _i = 0; _i < 2; ++_i) \
        __builtin_amdgcn_global_load_lds((const unsigned*)(Ab + (size_t)(vo)[h][_i] + (size_t)(koff)), (LAS unsigned*)(lds + (bufoff) + ldsw + _i * 8192), 16, 0, 0); } while (0)
#define PG8_LDA(dst, b, h) do { _Pragma("unroll") for (int m = 0; m < 4; ++m) _Pragma("unroll") for (int k = 0; k < 2; ++k) dst[m][k] = *(const LAS bf16x8*)(lds + PG8_SA(b, h) + aoff + m * 2048 + k * 1024); } while (0)
#define PG8_LDB(dst, b, h) do { _Pragma("unroll") for (int n = 0; n < 2; ++n) _Pragma("unroll") for (int k = 0; k < 2; ++k) dst[n][k] = *(const LAS bf16x8*)(lds + PG8_SB(b, h) + boff + n * 2048 + k * 1024); } while (0)
#define PG8_MMA(ai, bj, At, Bt) do { __builtin_amdgcn_s_setprio(1); _Pragma("unroll") for (int m = 0; m < 4; ++m) _Pragma("unroll") for (int n = 0; n < 2; ++n) _Pragma("unroll") for (int k = 0; k < 2; ++k) \
        acc[ai][bj][m][n] = __builtin_amdgcn_mfma_f32_16x16x32_bf16(Bt[n][k], At[m][k], acc[ai][bj][m][n], 0, 0, 0); __builtin_amdgcn_s_setprio(0); } while (0)
#define PG8_WAIT_V(n) asm volatile("s_waitcnt vmcnt(" #n ")" ::: "memory")
#define PG8_WAIT_L(n) asm volatile("s_waitcnt lgkmcnt(" #n ")" ::: "memory")
#define PG8_BAR __builtin_amdgcn_s_barrier()
#define PG8_SCHED __builtin_amdgcn_sched_barrier(0)
    Unit cur, nxt; int ui = 0;
    if (!S.next(0, cur)) return;
    f32x4 acc[2][2][4][2];
#pragma unroll
    for (int a = 0; a < 2; ++a)
#pragma unroll
        for (int b = 0; b < 2; ++b)
#pragma unroll
            for (int m = 0; m < 4; ++m)
#pragma unroll
                for (int n = 0; n < 2; ++n) acc[a][b][m][n] = (f32x4){0.f, 0.f, 0.f, 0.f};
    bf16x8 At[4][2], B0[2][2], B1[2][2];
    const char* Ab = S.a_base();
    unsigned cvA[2][2], nvA[2][2];
    S.a_voff(cur, cvA, Rr, Cc);
    const char* cB = S.b_base(cur);
    PG8_STAGE_B(PG8_SB(0, 0), cB); PG8_STAGE_B(PG8_SB(0, 1), cB + hstep); PG8_STAGE_A(PG8_SA(0, 0), cvA, 0, 0); PG8_STAGE_A(PG8_SA(0, 1), cvA, 1, 0);
    if (wr == 1) PG8_BAR;
    PG8_WAIT_V(2); PG8_BAR;
    PG8_STAGE_B(PG8_SB(1, 0), cB + kstep); PG8_STAGE_A(PG8_SA(1, 0), cvA, 0, kstep); PG8_STAGE_B(PG8_SB(1, 1), cB + hstep + kstep);
    PG8_WAIT_V(6); PG8_BAR;
    for (;;) {
        const bool has_next = S.next(ui + 1, nxt);
        const char* nB = has_next ? S.b_base(nxt) : cB;
        if (has_next) S.a_voff(nxt, nvA, Rr, Cc);
        else {
#pragma unroll
            for (int h = 0; h < 2; ++h)
#pragma unroll
                for (int i = 0; i < 2; ++i) nvA[h][i] = cvA[h][i];
        }
#pragma unroll 1
        for (int t = 0; t < nt; t += 2) {
            const bool last = (t == nt - 2);
            if constexpr (Epi::HAS_MID) { if (t == Epi::MID_T) E.mid(acc, cur, wr, wc, fr, fq); }
            const size_t k1 = (size_t)(t + 1) * kstep;
            unsigned a2[2][2];
#pragma unroll
            for (int h = 0; h < 2; ++h)
#pragma unroll
                for (int i = 0; i < 2; ++i) a2[h][i] = last ? nvA[h][i] : cvA[h][i] + (unsigned)((t + 2) * (BK * 2));
            const char* b2 = last ? nB : cB + (size_t)(t + 2) * kstep;
            const char* b3 = b2 + kstep;
            PG8_LDB(B0, 0, 0); PG8_LDB(B1, 0, 1); PG8_SCHED; PG8_LDA(At, 0, 0); PG8_STAGE_A(PG8_SA(1, 1), cvA, 1, k1);
            PG8_WAIT_V(8); PG8_WAIT_L(0); PG8_BAR; PG8_MMA(0, 0, At, B0); PG8_MMA(0, 1, At, B1); PG8_BAR; PG8_SCHED;
            PG8_LDA(At, 0, 1); PG8_STAGE_B(PG8_SB(0, 0), b2); PG8_STAGE_B(PG8_SB(0, 1), b2 + hstep); PG8_STAGE_A(PG8_SA(0, 0), a2, 0, 0);
            PG8_WAIT_V(8); PG8_WAIT_L(0); PG8_BAR; PG8_MMA(1, 0, At, B0); PG8_MMA(1, 1, At, B1); PG8_BAR; PG8_SCHED;
            PG8_LDB(B0, 1, 0); PG8_LDB(B1, 1, 1); PG8_SCHED; PG8_LDA(At, 1, 0); PG8_STAGE_A(PG8_SA(0, 1), a2, 1, 0);
            PG8_WAIT_V(8); PG8_WAIT_L(0); PG8_BAR; PG8_MMA(0, 0, At, B0); PG8_MMA(0, 1, At, B1); PG8_BAR; PG8_SCHED;
            PG8_LDA(At, 1, 1); PG8_STAGE_B(PG8_SB(1, 0), b3); PG8_STAGE_B(PG8_SB(1, 1), b3 + hstep); PG8_STAGE_A(PG8_SA(1, 0), a2, 0, kstep);
            PG8_WAIT_V(8); PG8_WAIT_L(0); PG8_BAR; PG8_MMA(1, 0, At, B0); PG8_MMA(1, 1, At, B1); PG8_BAR; PG8_SCHED;
        }
        if constexpr (ALIGN_EPI) { if (wr == 0) PG8_BAR; }
        E(acc, cur, wr, wc, fr, fq);
        if (!has_next) break;
#pragma unroll
        for (int a = 0; a < 2; ++a)
#pragma unroll
            for (int b = 0; b < 2; ++b)
#pragma unroll
                for (int m = 0; m < 4; ++m)
#pragma unroll
                    for (int n = 0; n < 2; ++n) acc[a][b][m][n] = (f32x4){0.f, 0.f, 0.f, 0.f};
        cur = nxt; cB = nB; ++ui;
#pragma unroll
        for (int h = 0; h < 2; ++h)
#pragma unroll
            for (int i = 0; i < 2; ++i) cvA[h][i] = nvA[h][i];
        if constexpr (ALIGN_EPI) { if (wr == 1) PG8_BAR; }
    }
    PG8_WAIT_V(0);
    if constexpr (!ALIGN_EPI) { if (wr == 0) PG8_BAR; }
    PG8_BAR;
#undef PG8_SA
#undef PG8_SB
#undef PG8_STAGE_A
#undef PG8_STAGE_B
#undef PG8_LDA
#undef PG8_LDB
#undef PG8_MMA
#undef PG8_WAIT_V
#undef PG8_WAIT_L
#undef PG8_BAR
#undef PG8_SCHED
}

typedef f32x4 Acc[2][2][4][2];
__device__ __forceinline__ u32x4 pack8(const f32x4 a, const f32x4 b) { u32x4 w; w.x = cvt_pk_bf16(a[0], a[1]); w.y = cvt_pk_bf16(a[2], a[3]); w.z = cvt_pk_bf16(b[0], b[1]); w.w = cvt_pk_bf16(b[2], b[3]); return w; }

struct EpiPlain {
    static constexpr bool PERM = true, HAS_MID = false; static constexpr int MID_T = 0;
    bf16_t* O; int ldc; int use_aux;
    __device__ __forceinline__ void mid(Acc&, const Unit&, int, int, int, int) const {}
    __device__ __forceinline__ void operator()(const Acc& acc, const Unit& u, int wr, int wc, int fr, int fq) const {
        const int row0 = (use_aux ? u.aux : u.pm * BM) + wr * 64 + fr, col0 = u.pn * BM + wc * 32 + 8 * fq;
#pragma unroll
        for (int ai = 0; ai < 2; ++ai)
#pragma unroll
            for (int m = 0; m < 4; ++m) { bf16_t* rowp = O + (size_t)(row0 + ai * HALF + m * 16) * ldc + col0;
#pragma unroll
                for (int bj = 0; bj < 2; ++bj) st16(rowp + bj * HALF, pack8(acc[ai][bj][m][0], acc[ai][bj][m][1])); }
    }
};

struct EpiIn {
    static constexpr bool PERM = true, HAS_MID = false; static constexpr int MID_T = 0;
    const float* xpart; const float* qn; const float* kn;
    bf16_t *qb, *kb, *vb, *ub, *vsb, *gab; float* vspart;
    __device__ __forceinline__ void mid(Acc&, const Unit&, int, int, int, int) const {}
    __device__ __forceinline__ void operator()(const Acc& acc, const Unit& u, int wr, int wc, int fr, int fq) const {
        const int pn = u.pn;
#pragma unroll
        for (int ai = 0; ai < 2; ++ai)
#pragma unroll
            for (int m = 0; m < 4; ++m) {
                const int row = u.pm * BM + ai * HALF + wr * 64 + m * 16 + fr;
                const f32x4* xp = (const f32x4*)(xpart + (size_t)row * 16);
                const f32x4 s0 = xp[0], s1 = xp[1], s2 = xp[2], s3 = xp[3];
                const float ssx = ((s0[0] + s0[1]) + (s0[2] + s0[3])) + ((s1[0] + s1[1]) + (s1[2] + s1[3])) + ((s2[0] + s2[1]) + (s2[2] + s2[3])) + ((s3[0] + s3[1]) + (s3[2] + s3[3]));
                const float rs = fast_rsq(ssx * (1.f / D) + EPS);
                f32x4 v[2][2];
#pragma unroll
                for (int bj = 0; bj < 2; ++bj)
#pragma unroll
                    for (int n = 0; n < 2; ++n) v[bj][n] = acc[ai][bj][m][n] * rs;
                if (pn < 4) {
                    float ss = 0.f;
#pragma unroll
                    for (int bj = 0; bj < 2; ++bj)
#pragma unroll
                        for (int n = 0; n < 2; ++n) ss += (v[bj][n][0] * v[bj][n][0] + v[bj][n][1] * v[bj][n][1]) + (v[bj][n][2] * v[bj][n][2] + v[bj][n][3] * v[bj][n][3]);
                    ss = sum_xor16_32(ss);
                    const bool isq = pn < 2;
                    const float sc = fast_rsq(ss * (1.f / 64.f) + EPS) * (isq ? 0.125f * LOG2E : 1.f);
                    const float* gn = isq ? qn : kn; bf16_t* O = isq ? qb : kb;
                    const int head = 4 * (pn & 1) + wc;
#pragma unroll
                    for (int bj = 0; bj < 2; ++bj) {
                        const f32x4 g0 = *(const f32x4*)(gn + 32 * bj + 8 * fq), g1 = *(const f32x4*)(gn + 32 * bj + 8 * fq + 4);
                        st16wt(O + (size_t)row * 512 + head * 64 + 32 * bj + 8 * fq, pack8(v[bj][0] * sc * g0, v[bj][1] * sc * g1));
                    }
                } else {
                    const int colw = wc * 32 + 8 * fq;
                    if (pn < 6) {
#pragma unroll
                        for (int bj = 0; bj < 2; ++bj) st16wt(vb + (size_t)row * 512 + (pn - 4) * BM + bj * HALF + colw, pack8(v[bj][0], v[bj][1]));
                    } else if (pn < 10) {
                        float ss = 0.f;
#pragma unroll
                        for (int bj = 0; bj < 2; ++bj)
#pragma unroll
                            for (int n = 0; n < 2; ++n)
#pragma unroll
                                for (int i = 0; i < 4; ++i) { const float gv = gelu_tanh_f(v[bj][n][i]); v[bj][n][i] = gv; ss += gv * gv; }
                        if (pn < 8) {
#pragma unroll
                            for (int bj = 0; bj < 2; ++bj) st16wt(ub + (size_t)row * 512 + (pn - 6) * BM + bj * HALF + colw, pack8(v[bj][0], v[bj][1]));
                        } else {
#pragma unroll
                            for (int bj = 0; bj < 2; ++bj) st16wt(vsb + (size_t)row * 512 + (pn - 8) * BM + bj * HALF + colw, pack8(v[bj][0], v[bj][1]));
                            ss = sum_xor16_32(ss);
                            if (fq == 0) vspart[(size_t)row * 8 + (pn - 8) * 4 + wc] = ss;
                        }
                    } else {
#pragma unroll
                        for (int bj = 0; bj < 2; ++bj) {
#pragma unroll
                            for (int n = 0; n < 2; ++n)
#pragma unroll
                                for (int i = 0; i < 4; ++i) v[bj][n][i] = fmaxf(sigmoid_f(v[bj][n][i]), 1e-13f);
                            st16wt(gab + (size_t)row * 2048 + (pn - 10) * BM + bj * HALF + colw, pack8(v[bj][0], v[bj][1]));
                        }
                    }
                }
            }
    }
};

struct EpiUp {
    static constexpr bool PERM = true, HAS_MID = true; static constexpr int MID_T = 8;
    const bf16_t* gab; bf16_t* mg;
    __device__ __forceinline__ void mid(Acc& acc, const Unit& u, int wr, int wc, int fr, int fq) const {
        int row0 = u.pm * BM + wr * 64 + fr; const int col0 = u.pn * BM + wc * 32 + 8 * fq; asm volatile("" : "+v"(row0));
#pragma unroll
        for (int am = 0; am < 4; ++am) {
            const int ai = am >> 1, mb = (am & 1) * 2;
            u32x4 ga[2][2], gb[2][2];
#pragma unroll
            for (int mm = 0; mm < 2; ++mm) { const bf16_t* gp = gab + (size_t)(row0 + ai * HALF + (mb + mm) * 16) * 2048 + col0;
#pragma unroll
                for (int bj = 0; bj < 2; ++bj) { ga[mm][bj] = *(const u32x4*)(gp + bj * HALF); gb[mm][bj] = *(const u32x4*)(gp + 1024 + bj * HALF); } }
#pragma unroll
            for (int mm = 0; mm < 2; ++mm)
#pragma unroll
                for (int bj = 0; bj < 2; ++bj)
#pragma unroll
                    for (int j = 0; j < 4; ++j) { const float r0 = bf_lo(ga[mm][bj][j]) * fast_rcp(bf_lo(gb[mm][bj][j])), r1 = bf_hi(ga[mm][bj][j]) * fast_rcp(bf_hi(gb[mm][bj][j]));
                        acc[ai][bj][mb + mm][j >> 1][(j & 1) * 2] *= r0; acc[ai][bj][mb + mm][j >> 1][(j & 1) * 2 + 1] *= r1; }
            asm volatile("" ::: "memory");
        }
    }
    __device__ __forceinline__ void operator()(const Acc& acc, const Unit& u, int wr, int wc, int fr, int fq) const {
        int row0 = u.pm * BM + wr * 64 + fr; const int col0 = u.pn * BM + wc * 32 + 8 * fq; asm volatile("" : "+v"(row0));
#pragma unroll
        for (int ai = 0; ai < 2; ++ai) {
            u32x4 gb[4][2];
#pragma unroll
            for (int m = 0; m < 4; ++m)
#pragma unroll
                for (int bj = 0; bj < 2; ++bj) gb[m][bj] = *(const u32x4*)(gab + (size_t)(row0 + ai * HALF + m * 16) * 2048 + 1024 + col0 + bj * HALF);
#pragma unroll
            for (int m = 0; m < 4; ++m) { const size_t ro = (size_t)(row0 + ai * HALF + m * 16);
#pragma unroll
                for (int bj = 0; bj < 2; ++bj) { const u32x4 b = gb[m][bj];
                    f32x4 o0, o1;
                    o0[0] = acc[ai][bj][m][0][0] * bf_lo(b[0]); o0[1] = acc[ai][bj][m][0][1] * bf_hi(b[0]); o0[2] = acc[ai][bj][m][0][2] * bf_lo(b[1]); o0[3] = acc[ai][bj][m][0][3] * bf_hi(b[1]);
                    o1[0] = acc[ai][bj][m][1][0] * bf_lo(b[2]); o1[1] = acc[ai][bj][m][1][1] * bf_hi(b[2]); o1[2] = acc[ai][bj][m][1][2] * bf_lo(b[3]); o1[3] = acc[ai][bj][m][1][3] * bf_hi(b[3]);
                    st16(mg + ro * 1024 + col0 + bj * HALF, pack8(o0, o1)); } }
            asm volatile("" ::: "memory");
        }
    }
};

struct EpiOut {
    static constexpr bool PERM = true, HAS_MID = false; static constexpr int MID_T = 0;
    const bf16_t* xin; bf16_t* xout;
    __device__ __forceinline__ void mid(Acc&, const Unit&, int, int, int, int) const {}
    __device__ __forceinline__ void operator()(const Acc& acc, const Unit& u, int wr, int wc, int fr, int fq) const {
        int row0 = u.pm * BM + wr * 64 + fr; const int col0 = u.pn * BM + wc * 32 + 8 * fq; asm volatile("" : "+v"(row0));
#pragma unroll
        for (int ai = 0; ai < 2; ++ai) {
            u32x4 xv[4][2];
#pragma unroll
            for (int m = 0; m < 4; ++m)
#pragma unroll
                for (int bj = 0; bj < 2; ++bj) xv[m][bj] = *(const u32x4*)(xin + (size_t)(row0 + ai * HALF + m * 16) * D + col0 + bj * HALF);
#pragma unroll
            for (int m = 0; m < 4; ++m)
#pragma unroll
                for (int bj = 0; bj < 2; ++bj) { const u32x4 xo = xv[m][bj]; f32x4 o0, o1;
                    o0[0] = bf_lo(xo[0]) + acc[ai][bj][m][0][0]; o0[1] = bf_hi(xo[0]) + acc[ai][bj][m][0][1]; o0[2] = bf_lo(xo[1]) + acc[ai][bj][m][0][2]; o0[3] = bf_hi(xo[1]) + acc[ai][bj][m][0][3];
                    o1[0] = bf_lo(xo[2]) + acc[ai][bj][m][1][0]; o1[1] = bf_hi(xo[2]) + acc[ai][bj][m][1][1]; o1[2] = bf_lo(xo[3]) + acc[ai][bj][m][1][2]; o1[3] = bf_hi(xo[3]) + acc[ai][bj][m][1][3];
                    st16(xout + (size_t)(row0 + ai * HALF + m * 16) * D + col0 + bj * HALF, pack8(o0, o1)); }
            asm volatile("" ::: "memory");
        }
    }
};

struct EpiG1 {
    static constexpr bool PERM = true, HAS_MID = false; static constexpr int MID_T = 0;
    const int* tokl; const int* cnt; const float* rs2; bf16_t* Gb;
    __device__ __forceinline__ void mid(Acc&, const Unit&, int, int, int, int) const {}
    __device__ __forceinline__ void operator()(const Acc& acc, const Unit& u, int wr, int wc, int fr, int fq) const {
        const int ce = cnt[u.e * CNT_STRIDE];
#pragma unroll
        for (int ai = 0; ai < 2; ++ai)
#pragma unroll
            for (int m = 0; m < 4; ++m) {
                const int rl = ai * HALF + wr * 64 + m * 16 + fr, r = u.pm * BM + rl;
                const int tok = (r < ce) ? tokl[u.e * ECAP + r] : 0;
                const float rs = rs2[tok];
                f32x4 o[2];
#pragma unroll
                for (int n = 0; n < 2; ++n)
#pragma unroll
                    for (int i = 0; i < 4; ++i) { const float g = acc[ai][0][m][n][i] * rs, up = acc[ai][1][m][n][i] * rs; o[n][i] = g * sigmoid_f(g) * up; }
                st16(Gb + (size_t)(u.aux + rl) * 512 + u.pn * HALF + wc * 32 + 8 * fq, pack8(o[0], o[1]));
            }
    }
};

struct EpiPle {
    static constexpr bool PERM = true, HAS_MID = false; static constexpr int MID_T = 0;
    const bf16_t* xin; bf16_t* xout; float* fout; const bf16_t* Eb; const float* rs3; float* xpart;
    __device__ __forceinline__ void mid(Acc&, const Unit&, int, int, int, int) const {}
    __device__ __forceinline__ void operator()(const Acc& acc, const Unit& u, int wr, int wc, int fr, int fq) const {
        int row0 = u.pm * BM + wr * 64 + fr; const int col0 = u.pn * BM + wc * 32 + 8 * fq; asm volatile("" : "+v"(row0));
#pragma unroll
        for (int am = 0; am < 4; ++am) {
            const int ai = am >> 1, mb = (am & 1) * 2;
            u32x4 xv[2][2], ev[2][2]; float rsv[2];
#pragma unroll
            for (int mm = 0; mm < 2; ++mm) { const int row = row0 + ai * HALF + (mb + mm) * 16; rsv[mm] = rs3[row];
#pragma unroll
                for (int bj = 0; bj < 2; ++bj) { xv[mm][bj] = *(const u32x4*)(xin + (size_t)row * D + col0 + bj * HALF); ev[mm][bj] = *(const u32x4*)(Eb + (size_t)row * D + col0 + bj * HALF); } }
#pragma unroll
            for (int mm = 0; mm < 2; ++mm) { const int row = row0 + ai * HALF + (mb + mm) * 16; const float rs = rsv[mm]; float ss = 0.f;
#pragma unroll
                for (int bj = 0; bj < 2; ++bj) { const u32x4 xo = xv[mm][bj], e = ev[mm][bj]; f32x4 o[2];
#pragma unroll
                    for (int j = 0; j < 4; ++j) { o[j >> 1][(j & 1) * 2] = bf_lo(xo[j]) + sigmoid_f(acc[ai][bj][mb + mm][j >> 1][(j & 1) * 2] * rs) * bf_lo(e[j]);
                                                  o[j >> 1][(j & 1) * 2 + 1] = bf_hi(xo[j]) + sigmoid_f(acc[ai][bj][mb + mm][j >> 1][(j & 1) * 2 + 1] * rs) * bf_hi(e[j]); }
                    const u32x4 w = pack8(o[0], o[1]);
#pragma unroll
                    for (int j = 0; j < 4; ++j) { const float a = bf_lo(w[j]), b = bf_hi(w[j]); ss += a * a + b * b; }
                    st16(xout + (size_t)row * D + col0 + bj * HALF, w);
                    if (fout) { *(f32x4*)(fout + (size_t)row * D + col0 + bj * HALF) = o[0]; *(f32x4*)(fout + (size_t)row * D + col0 + bj * HALF + 4) = o[1]; } }
                ss = sum_xor16_32(ss);
                if (fq == 0) xpart[(size_t)row * 16 + u.pn * 4 + wc] = ss; }
            asm volatile("" ::: "memory");
        }
    }
};
__device__ __forceinline__ int crow(int r, int hi) { return (r & 3) + 8 * (r >> 2) + 4 * hi; }
__device__ __forceinline__ unsigned cvtpk_s(float lo, float hi) { typedef __bf16 bf16x2_t __attribute__((ext_vector_type(2))); f32x2 v = {lo, hi}; bf16x2_t b = __builtin_convertvector(v, bf16x2_t); return __builtin_bit_cast(unsigned, b); }
#define FK_SBAR() __builtin_amdgcn_sched_barrier(0)
__device__ __forceinline__ void pv(f32x16* o, int vb, bf16x8 pa0, bf16x8 pa1, bf16x8 pa2, bf16x8 pa3) {
#pragma unroll
    for (int d0 = 0; d0 < 2; ++d0) { s16x4 lo[4], hi[4];
#pragma unroll
        for (int ks = 0; ks < 4; ++ks) {
            asm volatile("ds_read_b64_tr_b16 %0,%1 offset:%c2" : "=&v"(lo[ks]) : "v"(vb), "i"(d0 * 4096 + ks * 1024) : "memory");
            asm volatile("ds_read_b64_tr_b16 %0,%1 offset:%c2" : "=&v"(hi[ks]) : "v"(vb), "i"(d0 * 4096 + ks * 1024 + 512) : "memory"); }
        asm volatile("s_waitcnt lgkmcnt(0)" ::: "memory"); FK_SBAR();
#define FK_PK(k) (bf16x8){lo[k][0], lo[k][1], lo[k][2], lo[k][3], hi[k][0], hi[k][1], hi[k][2], hi[k][3]}
        o[d0] = __builtin_amdgcn_mfma_f32_32x32x16_bf16(pa0, FK_PK(0), o[d0], 0, 0, 0);
        o[d0] = __builtin_amdgcn_mfma_f32_32x32x16_bf16(pa1, FK_PK(1), o[d0], 0, 0, 0);
        o[d0] = __builtin_amdgcn_mfma_f32_32x32x16_bf16(pa2, FK_PK(2), o[d0], 0, 0, 0);
        o[d0] = __builtin_amdgcn_mfma_f32_32x32x16_bf16(pa3, FK_PK(3), o[d0], 0, 0, 0);
#undef FK_PK
    }
}
constexpr int WLDS_BYTES = 16384;

template <bool DIAG>
__device__ __forceinline__ void attn_tile(const bf16x8 (&k0)[4], const bf16x8 (&k1)[4], const bf16x8 (&qr)[4], f32x16 (&o)[2], float& R, int s0, int tq, int hi, int vbase) {
    f32x16 p0 = f32x16{}, p1 = f32x16{};
#pragma unroll
    for (int d0 = 0; d0 < 4; ++d0) { p0 = __builtin_amdgcn_mfma_f32_32x32x16_bf16(k0[d0], qr[d0], p0, 0, 0, 0); p1 = __builtin_amdgcn_mfma_f32_32x32x16_bf16(k1[d0], qr[d0], p1, 0, 0, 0); }
    float kp[32], bt[32];
#pragma unroll
    for (int r = 0; r < 32; ++r) {
        const float z = r < 16 ? p0[r] : p1[r - 16];
        const float e = fast_exp2(z);
        float k_ = fast_rcp(1.f + e), b_ = 1.f - k_;
        if (DIAG) { const int kv = s0 + crow(r & 15, hi) + (r >> 4) * 32; if (!(kv < tq)) { k_ = 1.f; b_ = 0.f; } }
        kp[r] = k_; bt[r] = b_;
    }
    float pg[8], T[8], SP[8];
#pragma unroll
    for (int g = 0; g < 8; ++g) { const float gs = (kp[4 * g] * kp[4 * g + 1]) * (kp[4 * g + 2] * kp[4 * g + 3]); float lo_, hi_; halves32(gs, lo_, hi_); pg[g] = hi ? lo_ : hi_; T[g] = lo_ * hi_; }
    SP[7] = 1.f;
#pragma unroll
    for (int g = 6; g >= 0; --g) SP[g] = SP[g + 1] * T[g + 1];
    float a[32];
#pragma unroll
    for (int g = 0; g < 8; ++g) {
        const float base = R * SP[g] * (hi == 0 ? pg[g] : 1.f);
        const float a3 = base, a2 = a3 * kp[4 * g + 3], a1 = a2 * kp[4 * g + 2], a0 = a1 * kp[4 * g + 1];
        a[4 * g + 3] = bt[4 * g + 3] * a3; a[4 * g + 2] = bt[4 * g + 2] * a2; a[4 * g + 1] = bt[4 * g + 1] * a1; a[4 * g] = bt[4 * g] * a0;
    }
    R *= SP[0] * T[0];
    u32x4 pw0, pw1, pw2, pw3;
    pw0 = (u32x4){cvtpk_s(a[0], a[1]), cvtpk_s(a[2], a[3]), cvtpk_s(a[4], a[5]), cvtpk_s(a[6], a[7])};
    pw1 = (u32x4){cvtpk_s(a[8], a[9]), cvtpk_s(a[10], a[11]), cvtpk_s(a[12], a[13]), cvtpk_s(a[14], a[15])};
    pw2 = (u32x4){cvtpk_s(a[16], a[17]), cvtpk_s(a[18], a[19]), cvtpk_s(a[20], a[21]), cvtpk_s(a[22], a[23])};
    pw3 = (u32x4){cvtpk_s(a[24], a[25]), cvtpk_s(a[26], a[27]), cvtpk_s(a[28], a[29]), cvtpk_s(a[30], a[31])};
    asm volatile("s_waitcnt vmcnt(0) lgkmcnt(0)" ::: "memory");
    pv(o, vbase, __builtin_bit_cast(bf16x8, pw0), __builtin_bit_cast(bf16x8, pw1), __builtin_bit_cast(bf16x8, pw2), __builtin_bit_cast(bf16x8, pw3));
}
__device__ __forceinline__ void attn_dma_v(const bf16_t* __restrict__ vb, long rowbase, int s0, int h, int lane, LAS unsigned char* wl) {
#pragma unroll
    for (int w8 = 0; w8 < 8; ++w8)
        __builtin_amdgcn_global_load_lds((const unsigned*)(vb + (size_t)(rowbase + s0 + 16 * (w8 & 3) + (lane >> 2)) * 512 + h * 64 + 32 * (w8 >> 2) + 8 * (lane & 3)), (LAS unsigned*)(wl + w8 * 1024), 16, 0, 0);
}
__device__ __forceinline__ void attn_dma_k(const bf16_t* __restrict__ kb, long rowbase, int s0, int h, int lane, LAS unsigned char* wl) {
#pragma unroll
    for (int c = 0; c < 8; ++c)
        __builtin_amdgcn_global_load_lds((const unsigned*)(kb + (size_t)(rowbase + s0 + lane) * 512 + h * 64 + 8 * c), (LAS unsigned*)(wl + 8192 + c * 1024), 16, 0, 0);
}
__device__ __forceinline__ void attn_read_k(bf16x8 (&k0)[4], bf16x8 (&k1)[4], LAS unsigned char* wl, int r32, int hi) {
    const LAS unsigned char* kp = wl + 8192 + hi * 1024 + r32 * 16;
#pragma unroll
    for (int d0 = 0; d0 < 4; ++d0) { k0[d0] = *(const LAS bf16x8*)(kp + d0 * 2048); k1[d0] = *(const LAS bf16x8*)(kp + d0 * 2048 + 512); }
}
__device__ __forceinline__ void attn_wave_unit(int b, int h, int qblk, const bf16_t* __restrict__ qb, const bf16_t* __restrict__ kb, const bf16_t* __restrict__ vb, bf16_t* __restrict__ oc, LAS unsigned char* wl, int lane) {
    const int r32 = lane & 31, hi = lane >> 5;
    const long rowbase = (long)b * SEQ; const int q0 = qblk * 32, tq = q0 + r32;
    bf16x8 qr[4];
    { const bf16_t* qp = qb + (size_t)(rowbase + q0 + r32) * 512 + h * 64 + hi * 8;
#pragma unroll
      for (int d0 = 0; d0 < 4; ++d0) qr[d0] = *(const bf16x8*)(qp + d0 * 16); }
    f32x16 o[2]; o[0] = f32x16{}; o[1] = f32x16{};
    float R = 1.f;
    const int vbase = (int)(unsigned)(uintptr_t)wl + ((lane >> 4) & 1) * 32 + (lane & 3) * 8 + (4 * hi + ((lane & 15) >> 2)) * 64;
    const int jd = q0 >> 6;
    bf16x8 k0[4], k1[4];
    attn_dma_k(kb, rowbase, jd * 64, h, lane, wl);
    attn_dma_v(vb, rowbase, jd * 64, h, lane, wl);
    asm volatile("s_waitcnt vmcnt(8)" ::: "memory");
    attn_read_k(k0, k1, wl, r32, hi);
    asm volatile("s_waitcnt lgkmcnt(0)" ::: "memory");
    attn_dma_k(kb, rowbase, (jd > 0 ? jd - 1 : 0) * 64, h, lane, wl);
    attn_tile<true>(k0, k1, qr, o, R, jd * 64, tq, hi, vbase);
    for (int jt = jd - 1; jt >= 0; --jt) {
        if (__all(R < 7.5e-37f)) break;
        attn_read_k(k0, k1, wl, r32, hi);
        attn_dma_v(vb, rowbase, jt * 64, h, lane, wl);
        asm volatile("s_waitcnt lgkmcnt(0)" ::: "memory");
        attn_dma_k(kb, rowbase, (jt > 0 ? jt - 1 : 0) * 64, h, lane, wl);
        attn_tile<false>(k0, k1, qr, o, R, jt * 64, tq, hi, vbase);
    }
    asm volatile("s_waitcnt vmcnt(0)" ::: "memory");
    LAS bf16_t* stg = (LAS bf16_t*)(wl + 8192);
#pragma unroll
    for (int r = 0; r < 16; ++r) { const int orow = crow(r, hi);
#pragma unroll
        for (int d0 = 0; d0 < 2; ++d0) stg[orow * 64 + d0 * 32 + r32] = (bf16_t)(cvtpk_s(o[d0][r], 0.f) & 0xffffu); }
    asm volatile("s_waitcnt lgkmcnt(0)" ::: "memory");
    bf16_t* Ow = oc + (size_t)(rowbase + q0) * 1024 + h * 64;
#pragma unroll
    for (int i = 0; i < 4; ++i) { const int row = i * 8 + (lane >> 3), ch = lane & 7; const u32x4 v = *(const LAS u32x4*)(stg + row * 64 + ch * 8); *(u32x4*)(Ow + (size_t)row * 1024 + ch * 8) = v; }
    asm volatile("s_waitcnt vmcnt(0) lgkmcnt(0)" ::: "memory");
}

template <int HF>
__device__ __forceinline__ void sgu_wave_unit(int chunk, int g, const bf16_t* __restrict__ ub, const bf16_t* __restrict__ vsb, const float* __restrict__ vspart, const bf16_t* __restrict__ wsp  ,
                                              const float* __restrict__ bsp  , const float* __restrict__ sgn  , bf16_t* __restrict__ oc, LAS unsigned char* wl, int lane) {
    const int r32 = lane & 31, hi = lane >> 5;
    const size_t row0 = (size_t)chunk * 128;
    const int vbase = (int)(unsigned)(uintptr_t)wl + ((lane >> 4) & 1) * 32 + (lane & 3) * 8 + (4 * hi + ((lane & 15) >> 2)) * 64;
    f32x16 o[2][2];
#pragma unroll
    for (int rl = 0; rl < 2; ++rl) { o[rl][0] = f32x16{}; o[rl][1] = f32x16{}; }
#pragma unroll
    for (int kt = 0; kt <= HF; ++kt) {
        float rvq[4];
#pragma unroll
        for (int q = 0; q < 4; ++q) { const size_t row = row0 + 64 * kt + 16 * q + (lane >> 2);
            const f32x4 s0 = *(const f32x4*)(vspart + row * 8), s1 = *(const f32x4*)(vspart + row * 8 + 4);
            rvq[q] = fast_rsq((((s0[0] + s0[1]) + (s0[2] + s0[3])) + ((s1[0] + s1[1]) + (s1[2] + s1[3]))) * (1.f / 512.f) + EPS); }
        u32x4 vv[8];
#pragma unroll
        for (int w8 = 0; w8 < 8; ++w8) vv[w8] = *(const u32x4*)(vsb + (row0 + 64 * kt + 16 * (w8 & 3) + (lane >> 2)) * 512 + g * 64 + 32 * (w8 >> 2) + 8 * (lane & 3));
#pragma unroll
        for (int w8 = 0; w8 < 8; ++w8) { const float rv = rvq[w8 & 3]; u32x4 w;
#pragma unroll
            for (int j = 0; j < 4; ++j) w[j] = cvtpk_s(bf_lo(vv[w8][j]) * rv, bf_hi(vv[w8][j]) * rv);
            *(LAS u32x4*)(wl + w8 * 1024 + lane * 16) = w; }
        asm volatile("s_waitcnt lgkmcnt(0)" ::: "memory");
#pragma unroll
        for (int rl = 0; rl < 2; ++rl) {
            const int rb = 2 * HF + rl;
            const bf16_t* wp = wsp + ((size_t)g * 128 + 32 * rb + r32) * 128 + 64 * kt + 4 * hi;
            u32x4 pw[4];
#pragma unroll
            for (int ks = 0; ks < 4; ++ks) { const u32x2 lo = *(const u32x2*)(wp + 16 * ks), h8 = *(const u32x2*)(wp + 16 * ks + 8); pw[ks] = (u32x4){lo.x, lo.y, h8.x, h8.y}; }
            pv(o[rl], vbase, __builtin_bit_cast(bf16x8, pw[0]), __builtin_bit_cast(bf16x8, pw[1]), __builtin_bit_cast(bf16x8, pw[2]), __builtin_bit_cast(bf16x8, pw[3]));
        }
        asm volatile("s_waitcnt lgkmcnt(0)" ::: "memory");
    }
    LAS bf16_t* stg = (LAS bf16_t*)(wl + 8192);
    const float gn0 = sgn[g * 64 + r32], gn1 = sgn[g * 64 + 32 + r32];
#pragma unroll
    for (int rl = 0; rl < 2; ++rl) {
        const int rb = 2 * HF + rl;
#pragma unroll
        for (int r = 0; r < 16; ++r) { const int orow = crow(r, hi); const float bb = bsp[g * 128 + 32 * rb + orow];
            stg[orow * 64 + r32] = (bf16_t)(cvtpk_s(gn0 * o[rl][0][r] + bb, 0.f) & 0xffffu); stg[orow * 64 + 32 + r32] = (bf16_t)(cvtpk_s(gn1 * o[rl][1][r] + bb, 0.f) & 0xffffu); }
        asm volatile("s_waitcnt lgkmcnt(0)" ::: "memory");
#pragma unroll
        for (int i = 0; i < 4; ++i) { const int row = i * 8 + (lane >> 3), ch = lane & 7; const size_t grow = row0 + 32 * rb + row;
            const u32x4 mv = *(const LAS u32x4*)(stg + row * 64 + ch * 8); const u32x4 uv = *(const u32x4*)(ub + grow * 512 + g * 64 + ch * 8); u32x4 w;
#pragma unroll
            for (int j = 0; j < 4; ++j) w[j] = cvtpk_s(bf_lo(mv[j]) * bf_lo(uv[j]), bf_hi(mv[j]) * bf_hi(uv[j]));
            *(u32x4*)(oc + grow * 1024 + 512 + g * 64 + ch * 8) = w; }
        asm volatile("s_waitcnt lgkmcnt(0)" ::: "memory");
    }
}
constexpr size_t MiB = 1u << 20;
constexpr size_t WS_CTL = 0, CTL_ZERO_BYTES = 1 * MiB;
constexpr size_t WS_W = 16 * MiB, WL_STRIDE = 112 * MiB;
constexpr size_t WO_IN = 0, WO_UP = 9 * MiB, WO_OUT = 11 * MiB, WO_PG = 13 * MiB, WO_PP = 15 * MiB, WO_SP = 15 * MiB + 512 * 1024, WO_R = 15 * MiB + 768 * 1024, WO_EI = 16 * MiB, WO_EO = 80 * MiB;
constexpr size_t WS_PB = 464 * MiB, WS_E = 496 * MiB, WS_XB = 624 * MiB, WS_Q = 656 * MiB, WS_K = 672 * MiB, WS_V = 688 * MiB, WS_U = 704 * MiB, WS_VS = 720 * MiB, WS_GAB = 736 * MiB,
                 WS_OC = 800 * MiB, WS_MG = 832 * MiB, WS_G = 864 * MiB, WS_YS = 904 * MiB, WS_XPART = 984 * MiB, WS_VSPART = 985 * MiB, WS_RS2 = 985 * MiB + 512 * 1024, WS_RS3 = 985 * MiB + 640 * 1024,
                 WS_TOKL = 986 * MiB, WS_TKE = 988 * MiB, WS_TKP = 988 * MiB + 256 * 1024, WS_TKW = 988 * MiB + 512 * 1024, WS_XB1 = 992 * MiB, WS_FAST_END = 1024 * MiB;
constexpr int GSLOTS = 2 * M + NE * 256;
constexpr int CW_TMO = 0, CW_CODE = 1, CW_BAR = 4096, CW_CNT = 8192  ;

constexpr int RING_OFF = 0, RING_BYTES = 131072, LDSCTL_OFF = 139264  , MISC_OFF = LDSCTL_OFF + 320, PREF_OFF = MISC_OFF + 128  , LDS_BYTES = 147456;

#define RLX_AGENT __ATOMIC_RELAXED, __HIP_MEMORY_SCOPE_AGENT
#define XB_TMO      128
#define XB_XCNT(j)  (256  + 64 * (j))
#define XB_XSUB(j)  (1280 + 64 * (j))
#define XB_XGEN(j)  (2304 + 64 * (j))
#define XB_TOP      3328
#define XB_TOPGEN   3392
#define XCD_BAR_WORDS 3456
#define XB_SPIN_CAP (1u << 18)
__device__ __forceinline__ unsigned xb_ld(unsigned* p)              { return __hip_atomic_load(p, __ATOMIC_RELAXED, __HIP_MEMORY_SCOPE_AGENT); }
__device__ __forceinline__ unsigned xb_add(unsigned* p, unsigned v) { return __hip_atomic_fetch_add(p, v, __ATOMIC_RELAXED, __HIP_MEMORY_SCOPE_AGENT); }
__device__ __forceinline__ unsigned xb_xcc_id() { return (unsigned)__builtin_amdgcn_s_getreg((3 << 11) | 20) & 0xFu; }
#define XB_SPIN(cond, bar) do { unsigned _sp = 0; while (cond) { __builtin_amdgcn_s_sleep(1); \
    if ((++_sp & 255u) == 0u) { if (xb_ld(&(bar)[XB_TMO])) break; if (_sp > XB_SPIN_CAP) { atomicAdd(&(bar)[XB_TMO], 1u); break; } } } } while (0)
struct XcdBarrier { unsigned* bar; unsigned x; volatile LAS unsigned* st; };
__device__ __forceinline__ XcdBarrier xcd_barrier_post(unsigned* bar, volatile LAS unsigned* st, const bool leader  ) {
    XcdBarrier b; b.bar = bar; b.x = xb_xcc_id(); b.st = st;
    if (leader) (void)xb_add(&bar[XB_XCNT(b.x)], 1u);
    return b;
}
__device__ __forceinline__ void xcd_barrier_complete(unsigned* bar, unsigned x, unsigned& nloc, unsigned& nx) {
    const unsigned G = gridDim.x * gridDim.y * gridDim.z;
    unsigned sum, cnt, mine, sp = 0u;
    for (;;) {
        sum = 0u; cnt = 0u; mine = 0u;
#pragma unroll
        for (unsigned j = 0; j < 16; ++j) { const unsigned c = xb_ld(&bar[XB_XCNT(j)]); sum += c; cnt += (c > 0u) ? 1u : 0u; mine = (j == x) ? c : mine; }
        if (sum == G) break;
        __builtin_amdgcn_s_sleep(1);
        if ((++sp & 255u) == 0u) { if (xb_ld(&bar[XB_TMO])) break; if (sp > XB_SPIN_CAP) { atomicAdd(&bar[XB_TMO], 1u); break; } }
    }
    nloc = mine > 0u ? mine : 1u; nx = cnt > 0u ? cnt : 1u;
}
__device__ __forceinline__ void xcd_barrier_t0(const XcdBarrier& b) {
        unsigned* bar = b.bar;
        __builtin_amdgcn_s_waitcnt(0);
        unsigned nloc = b.st[0], nx = b.st[1];
        if (nloc == 0u) { xcd_barrier_complete(bar, b.x, nloc, nx); b.st[0] = nloc; b.st[1] = nx; }
        const unsigned old = xb_add(&bar[XB_XSUB(b.x)], 1u);
        const unsigned gen = old / nloc;
        if (old + 1u == (gen + 1u) * nloc) {
            __builtin_amdgcn_fence(__ATOMIC_RELEASE, "agent");
            asm volatile("s_waitcnt vmcnt(0)" ::: "memory");
            const unsigned og = xb_add(&bar[XB_TOP], 1u);
            const unsigned tg = og / nx;
            if (og + 1u == (tg + 1u) * nx) xb_add(&bar[XB_TOPGEN], 1u);
            else XB_SPIN(xb_ld(&bar[XB_TOPGEN]) == tg, bar);
            __builtin_amdgcn_fence(__ATOMIC_ACQUIRE, "agent");
            xb_add(&bar[XB_XGEN(b.x)], 1u);
            asm volatile("s_waitcnt vmcnt(0)" ::: "memory");
        } else {
            XB_SPIN(xb_ld(&bar[XB_XGEN(b.x)]) == gen, bar);
            __builtin_amdgcn_fence(__ATOMIC_ACQUIRE, "agent");
            asm volatile("s_waitcnt vmcnt(0)" ::: "memory");
        }
}

struct Args {
    const float* in[22]; float* out; unsigned char* ws;
    int ph_lo, ph_hi, nlayers, pad;
};
__device__ __forceinline__ float wave_sum(float v) { v += xor_lt32<1>(v); v += xor_lt32<2>(v); v += xor_lt32<4>(v); v += xor_lt32<8>(v); return sum_xor16_32(v); }
__device__ __forceinline__ unsigned f2bf(float f) { unsigned u = __builtin_bit_cast(unsigned, f); return (u + 0x7fffu + ((u >> 16) & 1u)) >> 16; }
__device__ __forceinline__ unsigned pk2(float lo, float hi) { return f2bf(lo) | (f2bf(hi) << 16); }

__device__ __forceinline__ int rowmap(int kind, int n) {
    if (kind == 1) { if (n >= 1024) return n; const int nl = n & 255; return (n - nl) + 128 * ((nl & 63) >> 5) + 32 * (nl >> 6) + (nl & 31); }
    if (kind == 2) { return n < 512 ? 256 * (n >> 7) + (n & 127) : 256 * ((n - 512) >> 7) + 128 + ((n - 512) & 127); }
    return n;
}
__device__ __forceinline__ void transpose_item(const float* __restrict__ W, int N, const float* __restrict__ gain, bf16_t* __restrict__ WT, int ldt, int koff, int kind, LAS float* scr, int item, int lane) {
    const int nblk = N / 64, kb = item / nblk, nb = item % nblk, k0 = 64 * kb, n0 = 64 * nb;
    const int kr = lane >> 4, nc = 4 * (lane & 15);
    f32x4 v[16];
#pragma unroll
    for (int i = 0; i < 16; ++i) v[i] = __builtin_nontemporal_load((const f32x4*)(W + (size_t)(k0 + 4 * i + kr) * N + n0 + nc));
#pragma unroll
    for (int i = 0; i < 16; ++i) { const int kk = 4 * i + kr; const float gv = gain ? gain[k0 + kk] : 1.f; LAS float* d = scr + kk * 65 + nc; d[0] = v[i][0] * gv; d[1] = v[i][1] * gv; d[2] = v[i][2] * gv; d[3] = v[i][3] * gv; }
    asm volatile("s_waitcnt lgkmcnt(0)" ::: "memory");
    const int c = lane & 7;
#pragma unroll
    for (int j = 0; j < 8; ++j) { const int n = 8 * j + (lane >> 3); const LAS float* s = scr + (8 * c) * 65 + n;
        u32x4 o; o.x = pk2(s[0 * 65], s[1 * 65]); o.y = pk2(s[2 * 65], s[3 * 65]); o.z = pk2(s[4 * 65], s[5 * 65]); o.w = pk2(s[6 * 65], s[7 * 65]);
        st16(WT + (size_t)rowmap(kind, n0 + n) * ldt + koff + k0 + 8 * c, o); }
    asm volatile("s_waitcnt lgkmcnt(0)" ::: "memory");
}

typedef const __attribute__((address_space(4))) Args* KArgs;
__device__ __forceinline__ KArgs fresh(KArgs k) { asm volatile("" : "+s"(k)); return k; }
constexpr int NWAVES = 8;
#ifndef FK_FILLW
#define FK_FILLW 7
#endif
constexpr int FILLW = FK_FILLW, FILL_SLABS = 8;
constexpr int CVT_IN = 16 * 72, CVT_UP = 8 * 16, CVT_OUT = 16 * 16, CVT_PG = 16 * 16, CVT_PP = 4 * 16, CVT_EI = 16 * 16, CVT_EO = 8 * 16;
constexpr int CVT_PER_LAYER = CVT_IN + 2 * CVT_UP + CVT_OUT + CVT_PG + CVT_PP + NE * CVT_EI + NE * CVT_EO;
__device__ __forceinline__ void convert_item(KArgs ap, int L, int r, LAS float* scr, int lane) {
    unsigned char* wl = ap->ws + WS_W + (size_t)L * WL_STRIDE;
    const float* W; const float* gain = nullptr; bf16_t* WT; int N = D, ldt = D, koff = 0, kind = 0, item = r;
    if (r < CVT_IN) { W = ap->in[3] + (size_t)L * D * INW; N = INW; gain = ap->in[2] + (size_t)L * D; WT = (bf16_t*)(wl + WO_IN); kind = 1; }
    else if ((r -= CVT_IN) < CVT_UP) { W = ap->in[9] + (size_t)L * 512 * D; WT = (bf16_t*)(wl + WO_UP); ldt = 1024; item = r; }
    else if ((r -= CVT_UP) < CVT_UP) { W = ap->in[10] + (size_t)L * 512 * D; WT = (bf16_t*)(wl + WO_UP); ldt = 1024; koff = 512; item = r; }
    else if ((r -= CVT_UP) < CVT_OUT) { W = ap->in[11] + (size_t)L * D * D; WT = (bf16_t*)(wl + WO_OUT); item = r; }
    else if ((r -= CVT_OUT) < CVT_PG) { W = ap->in[20] + (size_t)L * D * D; gain = ap->in[19] + (size_t)L * D; WT = (bf16_t*)(wl + WO_PG); item = r; }
    else if ((r -= CVT_PG) < CVT_PP) { W = ap->in[21] + (size_t)L * 256 * D; WT = (bf16_t*)(wl + WO_PP); ldt = 256; item = r; }
    else if ((r -= CVT_PP) < NE * CVT_EI) { const int e = r / CVT_EI; W = ap->in[17] + ((size_t)L * NE + e) * D * 1024; N = 1024; gain = ap->in[12] + (size_t)L * D; WT = (bf16_t*)(wl + WO_EI) + (size_t)e * 1024 * 1024; ldt = 1024; kind = 2; item = r % CVT_EI; }
    else { r -= NE * CVT_EI; const int e = r / CVT_EO; W = ap->in[18] + ((size_t)L * NE + e) * 512 * D; WT = (bf16_t*)(wl + WO_EO) + (size_t)e * 1024 * 512; ldt = 512; item = r % CVT_EO; }
    transpose_item(W, N, gain, WT, ldt, koff, kind, scr, item, lane);
}
__device__ __forceinline__ void p0_prologue(KArgs ap, int nlayers, bool fill_later, LAS unsigned char* lds, int wave, int lane, int gw, int NGW) {
    LAS float* scr = (LAS float*)(lds + RING_OFF + wave * 17408);
    unsigned char* ws = ap->ws;
    const int nconv = fill_later ? 1 : nlayers;
    for (int it = gw; it < CVT_PER_LAYER * nconv; it += NGW) convert_item(ap, nconv - 1 - it / CVT_PER_LAYER, it % CVT_PER_LAYER, scr, lane);
    if (fill_later) { const int first = FILL_SLABS * FILLW * (NGW / NWAVES), rest = CVT_PER_LAYER - first;
        if (rest > 0) for (int it = gw; it < rest * (nlayers - 1); it += NGW) convert_item(ap, 1 + it / rest, first + it % rest, scr, lane); }
    const int gt = gw * 64 + lane, NGT = NGW * 64;
    for (int L = 0; L < nlayers; ++L) {
        unsigned char* wl = ws + WS_W + (size_t)L * WL_STRIDE;
        bf16_t* sp = (bf16_t*)(wl + WO_SP); const float* wsrc = ap->in[7] + (size_t)L * 8 * 128 * 128;
        for (int i = gt; i < 8 * 128 * 128; i += NGT) { const int s = i & 127, t = (i >> 7) & 127; sp[i] = (bf16_t)f2bf(s <= t ? wsrc[i] : 0.f); }
        bf16_t* wrh = (bf16_t*)(wl + WO_R); bf16_t* wrl = wrh + 48 * 1024; const float* gain = ap->in[12] + (size_t)L * D; const float* wg = ap->in[13] + (size_t)L * D * 4; const float* we = ap->in[15] + (size_t)L * D * 32;
        for (int i = gt; i < 48 * 1024; i += NGT) { const int o = i >> 10, k = i & 1023; const float wv = o < 36 ? gain[k] * (o < 4 ? wg[k * 4 + o] : we[k * 32 + (o - 4)]) : 0.f;
            const unsigned h = f2bf(wv); wrh[i] = (bf16_t)h; wrl[i] = (bf16_t)f2bf(wv - __uint_as_float(h << 16)); }
    }
    { const f32x4* p4 = (const f32x4*)ap->in[1]; u32x2* pb = (u32x2*)(ws + WS_PB); const size_t n4 = (size_t)nlayers * M * 256 / 4;
      for (size_t i = gt; i < n4; i += NGT) { const f32x4 v = p4[i]; u32x2 w; w.x = pk2(v[0], v[1]); w.y = pk2(v[2], v[3]); pb[i] = w; } }
    for (int m = gw; m < M; m += NGW) {
        const f32x4* xr = (const f32x4*)(ap->in[0] + (size_t)m * D) + lane; u32x2* o8 = (u32x2*)((bf16_t*)(ws + WS_XB) + (size_t)m * D) + lane; float s = 0.f;
#pragma unroll
        for (int j = 0; j < 4; ++j) { const f32x4 v = xr[64 * j]; s += (v[0] * v[0] + v[1] * v[1]) + (v[2] * v[2] + v[3] * v[3]); u32x2 w; w.x = pk2(v[0], v[1]); w.y = pk2(v[2], v[3]); o8[64 * j] = w; }
        s = wave_sum(s);
        if (lane < 16) ((float*)(ws + WS_XPART))[(size_t)m * 16 + lane] = lane == 0 ? s : 0.f;
    }
}

__device__ __forceinline__ void router_pass(const bf16_t* __restrict__ x, const bf16_t* __restrict__ wrh  , const bf16_t* __restrict__ wrl  , const float* __restrict__ bgr, const float* __restrict__ ber,
                                            float* __restrict__ rs2, int* __restrict__ cnt, int* __restrict__ tokl, int* __restrict__ tk_e, int* __restrict__ tk_pos, float* __restrict__ tk_w,
                                            LAS unsigned char* lds, int wave, int lane, int vcu, int G) {
    LAS float* lg = (LAS float*)(lds + RING_OFF + wave * 16384);
    LAS int* lcnt = (LAS int*)(lds + LDSCTL_OFF + 1024); LAS int* lbase = lcnt + 32;
    const int fr = lane & 15, fq = lane >> 4;
    for (int bt = vcu; bt < M / 64; bt += G) {
        if (wave == 0 && lane < 32) lcnt[lane] = 0;
        __syncthreads();
        int e1 = 0, e2 = 0, lp1 = 0, lp2 = 0; float tw1 = 0.f, tw2 = 0.f;
        const int t0 = bt * 64 + (wave & 3) * 16;
        f32x4 acc[3]; acc[0] = (f32x4){0.f, 0.f, 0.f, 0.f}; acc[1] = acc[0]; acc[2] = acc[0];
        float ss = 0.f;
        {
        const int kh = (wave >> 2) * 16;
        const bf16_t* xp = x + (size_t)(t0 + fr) * D + 8 * fq + 32 * kh;
        const bf16_t* wh = wrh + (size_t)fr * 1024 + 8 * fq + 32 * kh; const bf16_t* wl_ = wrl + (size_t)fr * 1024 + 8 * fq + 32 * kh;
#pragma unroll 8
        for (int kk = 0; kk < 16; ++kk) {
            const u32x4 av = *(const u32x4*)(xp + 32 * kk);
#pragma unroll
            for (int j = 0; j < 4; ++j) { const float a = bf_lo(av[j]), b = bf_hi(av[j]); ss += a * a + b * b; }
            const bf16x8 Ah = __builtin_bit_cast(bf16x8, av);
#pragma unroll
            for (int cb = 0; cb < 3; ++cb) {
                const bf16x8 bh = *(const bf16x8*)(wh + (size_t)cb * 16 * 1024 + 32 * kk), bl = *(const bf16x8*)(wl_ + (size_t)cb * 16 * 1024 + 32 * kk);
                acc[cb] = __builtin_amdgcn_mfma_f32_16x16x32_bf16(bh, Ah, acc[cb], 0, 0, 0);
                acc[cb] = __builtin_amdgcn_mfma_f32_16x16x32_bf16(bl, Ah, acc[cb], 0, 0, 0);
            }
        }
        }
        if (wave >= 4) { LAS float* pp = (LAS float*)(lds + RING_OFF + wave * 16384) + lane * 13;
#pragma unroll
            for (int cb = 0; cb < 3; ++cb)
#pragma unroll
                for (int i = 0; i < 4; ++i) pp[cb * 4 + i] = acc[cb][i];
            pp[12] = ss; }
        __syncthreads();
        if (wave < 4) {
        { const LAS float* pp = (const LAS float*)(lds + RING_OFF + (wave + 4) * 16384) + lane * 13;
#pragma unroll
            for (int cb = 0; cb < 3; ++cb)
#pragma unroll
                for (int i = 0; i < 4; ++i) acc[cb][i] += pp[cb * 4 + i];
            ss += pp[12]; }
        ss = sum_xor16_32(ss);
        const float rsr = 1.0f / sqrtf(ss * (1.f / D) + EPS);
#pragma unroll
        for (int cb = 0; cb < 3; ++cb)
#pragma unroll
            for (int i = 0; i < 4; ++i) lg[fr * 49 + 16 * cb + 4 * fq + i] = acc[cb][i] * rsr;
        if (fq == 0) lg[fr * 49 + 48] = rsr;
        asm volatile("s_waitcnt lgkmcnt(0)" ::: "memory");
        if (lane < 16) {
            const int tok = t0 + lane; const LAS float* l = lg + lane * 49;
            rs2[tok] = l[48];
            const float g0 = l[0] + bgr[0], g1 = l[1] + bgr[1], g2 = l[2] + bgr[2], g3 = l[3] + bgr[3];
            int grp = 0; float gm = g0;
            if (g1 > gm) { gm = g1; grp = 1; } if (g2 > gm) { gm = g2; grp = 2; } if (g3 > gm) { gm = g3; grp = 3; }
            const float gsum = (expf(g0 - gm) + expf(g1 - gm)) + (expf(g2 - gm) + expf(g3 - gm));
            const float grp_w = 1.f / gsum;
            int i1 = 0, i2 = 0; float m1 = -INFINITY, m2 = -INFINITY;
#pragma unroll
            for (int i = 0; i < 8; ++i) { const float el = l[4 + grp * 8 + i] + ber[grp * 8 + i]; if (el > m1) { m2 = m1; i2 = i1; m1 = el; i1 = i; } else if (el > m2) { m2 = el; i2 = i; } }
            const float p2 = expf(m2 - m1), w1 = 1.f / (1.f + p2), w2 = p2 / (1.f + p2);
            e1 = grp * 8 + i1; e2 = grp * 8 + i2; tw1 = grp_w * w1; tw2 = grp_w * w2;
            lp1 = __hip_atomic_fetch_add(&lcnt[e1], 1, __ATOMIC_RELAXED, __HIP_MEMORY_SCOPE_WORKGROUP); lp2 = __hip_atomic_fetch_add(&lcnt[e2], 1, __ATOMIC_RELAXED, __HIP_MEMORY_SCOPE_WORKGROUP);
        }
        }
        __syncthreads();
        if (wave == 0 && lane < 32) { const int c = lcnt[lane]; lbase[lane] = c > 0 ? atomicAdd(&cnt[lane * CNT_STRIDE], c) : 0; }
        __syncthreads();
        if (wave < 4 && lane < 16) {
            const int tok = t0 + lane; const int pos1 = lbase[e1] + lp1, pos2 = lbase[e2] + lp2;
            tokl[e1 * ECAP + pos1] = tok; tokl[e2 * ECAP + pos2] = tok;
            tk_e[tok * 2] = e1; tk_e[tok * 2 + 1] = e2; tk_pos[tok * 2] = pos1; tk_pos[tok * 2 + 1] = pos2; tk_w[tok * 2] = tw1; tk_w[tok * 2 + 1] = tw2;
        }
        __syncthreads();
    }
}

__device__ __forceinline__ void combine_pass(bf16_t* xb, const bf16_t* __restrict__ ys, const LAS int* pref, const int* __restrict__ tk_e, const int* __restrict__ tk_pos,
                                             const float* __restrict__ tk_w, float* __restrict__ rs3, int lane, int gw, int NGW) {
    for (int m0 = gw * 4; m0 < M; m0 += NGW * 4) {
        int s0[4], s1[4]; float w0[4], w1[4];
#pragma unroll
        for (int r = 0; r < 4; ++r) { const int m = m0 + r; const int e0 = tk_e[m * 2], e1 = tk_e[m * 2 + 1]; s0[r] = 256 * pref[e0] + tk_pos[m * 2]; s1[r] = 256 * pref[e1] + tk_pos[m * 2 + 1]; w0[r] = tk_w[m * 2]; w1[r] = tk_w[m * 2 + 1]; }
        u32x4 xv[4][2], a0[4][2], a1[4][2];
#pragma unroll
        for (int r = 0; r < 4; ++r)
#pragma unroll
            for (int j = 0; j < 2; ++j) { xv[r][j] = ((const u32x4*)(xb + (size_t)(m0 + r) * D) + lane)[64 * j]; a0[r][j] = ((const u32x4*)(ys + (size_t)s0[r] * D) + lane)[64 * j]; a1[r][j] = ((const u32x4*)(ys + (size_t)s1[r] * D) + lane)[64 * j]; }
#pragma unroll
        for (int r = 0; r < 4; ++r) { float s = 0.f;
#pragma unroll
            for (int j = 0; j < 2; ++j) { u32x4 w;
#pragma unroll
                for (int q = 0; q < 4; ++q) { w[q] = cvt_pk_bf16(bf_lo(xv[r][j][q]) + w0[r] * bf_lo(a0[r][j][q]) + w1[r] * bf_lo(a1[r][j][q]), bf_hi(xv[r][j][q]) + w0[r] * bf_hi(a0[r][j][q]) + w1[r] * bf_hi(a1[r][j][q]));
                    const float a = bf_lo(w[q]), b = bf_hi(w[q]); s += a * a + b * b; }
                st16((u32x4*)(xb + (size_t)(m0 + r) * D) + lane + 64 * j, w); }
            s = wave_sum(s);
            if (lane == 0) rs3[m0 + r] = 1.0f / sqrtf(s * (1.f / D) + EPS); }
    }
}

constexpr int PH_PER_LAYER = 10;
#ifndef FK_REP
#define FK_REP 0
#endif
#define REPS(bit) ((FK_REP & (bit)) ? 2 : 1)
__global__ void __launch_bounds__(NWAVES * 64, 2) mega_fwd(Args args_unused) {
    extern __shared__ __attribute__((aligned(16))) unsigned char lds_raw[];
    LAS unsigned char* lds = (LAS unsigned char*)lds_raw;
    LAS int* pref = (LAS int*)(lds + PREF_OFF);
    const KArgs kp0 = (KArgs)__builtin_amdgcn_kernarg_segment_ptr();
    const int tid = threadIdx.x, wave0 = __builtin_amdgcn_readfirstlane(tid >> 6);
    const int G = gridDim.x, bx = blockIdx.x;
    const int vcu = (G % 8 == 0) ? (bx % 8) * (G / 8) + bx / 8 : bx;
    const int gw0 = vcu * NWAVES + wave0, NGW = G * NWAVES;
#define FK_T0 (wave0 == 0 && fk_lane() == 0)
#define FK_IDS int lane_o = fk_lane(), wave_o = wave0, gw_o = gw0; asm volatile("" : "+v"(lane_o), "+s"(wave_o), "+s"(gw_o)); const int lane = lane_o, wave = wave_o, gw = gw_o; (void)lane; (void)wave; (void)gw;
    for (int u = tid; u < (LDS_BYTES - LDSCTL_OFF) / 4; u += NWAVES * 64) ((LAS unsigned*)(lds + LDSCTL_OFF))[u] = 0u;
    __syncthreads();
    const int lo = kp0->ph_lo, hi = kp0->ph_hi, nlayers = kp0->nlayers;
#define IN(k) (lo <= (k) && (k) < hi)
    const bool fill_on = (hi - lo > 1) && G == 256;
#define SEAM_F(k, Lc, slab) do { if (IN(k) && IN((k) + 1)) { \
        asm volatile("s_waitcnt vmcnt(0)" ::: "memory"); __syncthreads(); \
        if (wave0 == 0) { if (fk_lane() == 0) { KArgs A_ = fresh(kp0); XcdBarrier bar_; bar_.bar = (unsigned*)(A_->ws + WS_CTL) + CW_BAR; bar_.x = xb_xcc_id(); bar_.st = (volatile LAS unsigned*)(lds + MISC_OFF) + 8; xcd_barrier_t0(bar_); } } \
        else if (fill_on && (Lc) < nlayers && (slab) < FILL_SLABS && wave0 <= FILLW) { int idx_ = (slab) * FILLW * G + bx * FILLW + (wave0 - 1); asm volatile("" : "+s"(idx_));   if (idx_ < CVT_PER_LAYER) convert_item(fresh(kp0), (Lc), idx_, (LAS float*)(lds + RING_OFF + wave0 * 17408), fk_lane()); } \
        __syncthreads(); } } while (0)
#define SEAM(k) SEAM_F(k, L + 1, (k) - pb)
    if (hi - lo > 1) { KArgs A = fresh(kp0); (void)xcd_barrier_post((unsigned*)(A->ws + WS_CTL) + CW_BAR, (volatile LAS unsigned*)(lds + MISC_OFF) + 8, FK_T0); }

    if (IN(0)) { for (int rep = 0; rep < REPS(1); ++rep) { FK_IDS; p0_prologue(fresh(kp0), nlayers, fill_on, lds, wave, lane, gw, NGW); } }
    SEAM_F(0, nlayers, 0);
    if (IN(1)) { }
    for (int L = 0; L < nlayers; ++L) {
        const int pb = 2 + PH_PER_LAYER * L;
        if (IN(pb + 0)) for (int rep = 0; rep < REPS(4); ++rep) {
            KArgs A = fresh(kp0); unsigned char* ws = A->ws; unsigned char* wl = ws + WS_W + (size_t)L * WL_STRIDE;
            DenseOrder S; S.init(M, INW, G, bx, ws + WS_XB, wl + WO_IN, D);
            EpiIn E{(const float*)(ws + WS_XPART), A->in[4] + L * 64, A->in[5] + L * 64, (bf16_t*)(ws + WS_Q), (bf16_t*)(ws + WS_K), (bf16_t*)(ws + WS_V), (bf16_t*)(ws + WS_U), (bf16_t*)(ws + WS_VS), (bf16_t*)(ws + WS_GAB), (float*)(ws + WS_VSPART)};
            gemm_phase<EpiIn, DenseOrder, true>(lds + RING_OFF, D, S, E, wave0);
            { const int nshort = (G == 256) ? 128 : G; const int c2 = (G == 256) ? bx - 128 : bx;
              if (c2 >= 0) { DenseOrder S2; S2.init(M, D, nshort, c2, ws + WS_PB + (size_t)L * M * 256 * 2, wl + WO_PP, 256);
                  EpiPlain E2{(bf16_t*)(ws + WS_E) + (size_t)L * M * D, D, 0};
                  gemm_phase<EpiPlain, DenseOrder, true>(lds + RING_OFF, 256, S2, E2, wave0); } }
        }
        SEAM(pb + 0);
        if (IN(pb + 1)) for (int rep = 0; rep < REPS(8 | 2048); ++rep) {
            KArgs A = fresh(kp0); unsigned char* ws = A->ws; unsigned char* wl = ws + WS_W + (size_t)L * WL_STRIDE;
            FK_IDS;
            LAS unsigned char* wlds = lds + RING_OFF + wave * WLDS_BYTES;
            constexpr int NATT = 2 * 8 * (SEQ / 32), NSGU = (M / 128) * 8 * 2;
            for (int it = gw; it < NATT + NSGU; it += NGW) {
                if (rep == 1 && (it < NATT ? !(FK_REP & 8) : !(FK_REP & 2048))) continue;
                if (it < NATT) { const int qblk = it % (SEQ / 32), bh = it / (SEQ / 32); attn_wave_unit(bh >> 3, bh & 7, qblk, (const bf16_t*)(ws + WS_Q), (const bf16_t*)(ws + WS_K), (const bf16_t*)(ws + WS_V), (bf16_t*)(ws + WS_OC), wlds, lane); }
                else { const int j = it - NATT; const int hf = j & 1, g = (j >> 1) & 7, ch = j >> 4;
                    if (hf == 0) sgu_wave_unit<0>(ch, g, (const bf16_t*)(ws + WS_U), (const bf16_t*)(ws + WS_VS), (const float*)(ws + WS_VSPART), (const bf16_t*)(wl + WO_SP), A->in[8] + (size_t)L * 8 * 128, A->in[6] + (size_t)L * 512, (bf16_t*)(ws + WS_OC), wlds, lane);
                    else sgu_wave_unit<1>(ch, g, (const bf16_t*)(ws + WS_U), (const bf16_t*)(ws + WS_VS), (const float*)(ws + WS_VSPART), (const bf16_t*)(wl + WO_SP), A->in[8] + (size_t)L * 8 * 128, A->in[6] + (size_t)L * 512, (bf16_t*)(ws + WS_OC), wlds, lane); }
            }
        }
        SEAM(pb + 1);
        if (IN(pb + 2)) for (int rep = 0; rep < REPS(16); ++rep) {
            KArgs A = fresh(kp0); unsigned char* ws = A->ws; unsigned char* wl = ws + WS_W + (size_t)L * WL_STRIDE;
            DenseOrder S; S.init(M, D, G, bx, ws + WS_OC, wl + WO_UP, D);
            EpiUp E{(const bf16_t*)(ws + WS_GAB), (bf16_t*)(ws + WS_MG)};
            gemm_phase<EpiUp, DenseOrder, false>(lds + RING_OFF, D, S, E, wave0);
        }
        SEAM(pb + 2);
        if (IN(pb + 3)) {
            KArgs A = fresh(kp0); unsigned char* ws = A->ws; unsigned char* wl = ws + WS_W + (size_t)L * WL_STRIDE;
            DenseOrder S; S.init(M, D, G, bx, ws + WS_MG, wl + WO_OUT, D);
            EpiOut E{(const bf16_t*)(ws + WS_XB), (bf16_t*)(ws + WS_XB1)};
            gemm_phase<EpiOut, DenseOrder, false>(lds + RING_OFF, D, S, E, wave0);
        }
        SEAM(pb + 3);
        if (IN(pb + 4)) {
            KArgs A = fresh(kp0); unsigned char* ws = A->ws; unsigned char* wl = ws + WS_W + (size_t)L * WL_STRIDE;
            FK_IDS;
            router_pass((const bf16_t*)(ws + WS_XB1), (const bf16_t*)(wl + WO_R), (const bf16_t*)(wl + WO_R) + 48 * 1024, A->in[14] + L * 4, A->in[16] + L * 32, (float*)(ws + WS_RS2), (int*)((unsigned*)(ws + WS_CTL) + CW_CNT) + L * NE * CNT_STRIDE, (int*)(ws + WS_TOKL), (int*)(ws + WS_TKE), (int*)(ws + WS_TKP), (float*)(ws + WS_TKW), lds, wave, lane, vcu, G);
        }
        SEAM(pb + 4);
        if (IN(pb + 5) || IN(pb + 6) || IN(pb + 7) || IN(pb + 8)) {
            KArgs A = fresh(kp0); const int* cnt = (const int*)((unsigned*)(A->ws + WS_CTL) + CW_CNT) + L * NE * CNT_STRIDE;
            if (FK_T0) { int s = 0; for (int e = 0; e < NE; ++e) { pref[e] = s; s += (cnt[e * CNT_STRIDE] + 255) >> 8; } pref[NE] = s; }
            __syncthreads();
        }
        const int nG1 = pref[NE] * 4, fr = nG1 / G, n3 = nG1 - fr * G;
        const int jB = (fr >= 1) ? min(2 * (G - n3), (fr * G / 4) * 4) : 0;
        if (IN(pb + 5)) for (int rep = 0; rep < REPS(32); ++rep) {
            KArgs A = fresh(kp0); unsigned char* ws = A->ws; unsigned char* wl = ws + WS_W + (size_t)L * WL_STRIDE; const int* cnt = (const int*)((unsigned*)(ws + WS_CTL) + CW_CNT) + L * NE * CNT_STRIDE;
            ExpertOrder S{G, bx, D, 4, (const char*)(ws + WS_XB1), (const char*)(wl + WO_EI), (size_t)1024 * 1024 * 2, pref, (const int*)(ws + WS_TOKL), cnt, 1, 0, fr, fr * G, 0};
            EpiG1 E{(const int*)(ws + WS_TOKL), cnt, (const float*)(ws + WS_RS2), (bf16_t*)(ws + WS_G)};
            gemm_phase<EpiG1, ExpertOrder, true>(lds + RING_OFF, D, S, E, wave0);
        }
        SEAM(pb + 5);
        if (IN(pb + 6)) {
            KArgs A = fresh(kp0); unsigned char* ws = A->ws; unsigned char* wl = ws + WS_W + (size_t)L * WL_STRIDE; const int* cnt = (const int*)((unsigned*)(ws + WS_CTL) + CW_CNT) + L * NE * CNT_STRIDE;
            if (bx < n3) {
                ExpertOrder S{G, bx, D, 4, (const char*)(ws + WS_XB1), (const char*)(wl + WO_EI), (size_t)1024 * 1024 * 2, pref, (const int*)(ws + WS_TOKL), cnt, 1, fr * G, 1, nG1, 0};
                EpiG1 E{(const int*)(ws + WS_TOKL), cnt, (const float*)(ws + WS_RS2), (bf16_t*)(ws + WS_G)};
                gemm_phase<EpiG1, ExpertOrder, true>(lds + RING_OFF, D, S, E, wave0);
            } else {
                ExpertOrder S{G - n3, bx - n3, 512, 4, (const char*)(ws + WS_G), (const char*)(wl + WO_EO), (size_t)1024 * 512 * 2, pref, (const int*)(ws + WS_TOKL), cnt, 0, 0, 2, jB, 0};
                EpiPlain E{(bf16_t*)(ws + WS_YS), D, 1};
                gemm_phase<EpiPlain, ExpertOrder, true>(lds + RING_OFF, 512, S, E, wave0);
            }
        }
        SEAM(pb + 6);
        if (IN(pb + 7)) for (int rep = 0; rep < REPS(64); ++rep) {
            KArgs A = fresh(kp0); unsigned char* ws = A->ws; unsigned char* wl = ws + WS_W + (size_t)L * WL_STRIDE; const int* cnt = (const int*)((unsigned*)(ws + WS_CTL) + CW_CNT) + L * NE * CNT_STRIDE;
            ExpertOrder S{G, bx, 512, 4, (const char*)(ws + WS_G), (const char*)(wl + WO_EO), (size_t)1024 * 512 * 2, pref, (const int*)(ws + WS_TOKL), cnt, 0, jB, 1 << 20, nG1, 0};
            EpiPlain E{(bf16_t*)(ws + WS_YS), D, 1};
            gemm_phase<EpiPlain, ExpertOrder, true>(lds + RING_OFF, 512, S, E, wave0);
        }
        SEAM(pb + 7);
        if (IN(pb + 8)) {
            KArgs A = fresh(kp0); unsigned char* ws = A->ws;
            FK_IDS;
            combine_pass((bf16_t*)(ws + WS_XB1), (const bf16_t*)(ws + WS_YS), pref, (const int*)(ws + WS_TKE), (const int*)(ws + WS_TKP), (const float*)(ws + WS_TKW), (float*)(ws + WS_RS3), lane, gw, NGW);
        }
        SEAM(pb + 8);
        if (IN(pb + 9)) {
            KArgs A = fresh(kp0); unsigned char* ws = A->ws; unsigned char* wl = ws + WS_W + (size_t)L * WL_STRIDE;
            DenseOrder S; S.init(M, D, G, bx, ws + WS_XB1, wl + WO_PG, D);
            EpiPle E{(const bf16_t*)(ws + WS_XB1), (bf16_t*)(ws + WS_XB), (L == nlayers - 1) ? A->out : (float*)nullptr, (const bf16_t*)(ws + WS_E) + (size_t)L * M * D, (const float*)(ws + WS_RS3), (float*)(ws + WS_XPART)};
            gemm_phase<EpiPle, DenseOrder, false>(lds + RING_OFF, D, S, E, wave0);
        }
        SEAM(pb + 9);
    }
#undef IN
#undef SEAM
#undef SEAM_F
#undef FK_IDS
#undef FK_T0
}
}
#ifndef FK_N_LAUNCHES
#define FK_N_LAUNCHES 1
#endif
static int fk_grid = 0;
static bool fk_setup() {
    if (fk_grid) return fk_grid > 0;
    int dev = 0, cus = 0, per_cu = 0;
    if (hipGetDevice(&dev) != hipSuccess || hipDeviceGetAttribute(&cus, hipDeviceAttributeMultiprocessorCount, dev) != hipSuccess) { fprintf(stderr, "kernel_launch: device query failed\n"); fk_grid = -1; return false; }
    if (hipFuncSetAttribute((const void*)fk::mega_fwd, hipFuncAttributeMaxDynamicSharedMemorySize, fk::LDS_BYTES) != hipSuccess) { fprintf(stderr, "kernel_launch: hipFuncSetAttribute failed\n"); fk_grid = -1; return false; }
    if (hipOccupancyMaxActiveBlocksPerMultiprocessor(&per_cu, (const void*)fk::mega_fwd, fk::NWAVES * 64, fk::LDS_BYTES) != hipSuccess || per_cu < 1)
        fprintf(stderr, "kernel_launch: note: occupancy query reports %d workgroups per CU\n", per_cu);
    (void)hipGetLastError();
    fk_grid = cus;
    return true;
}
static void fk_launch_range(fk::Args a, int lo, int hi, hipStream_t stream) {
    a.ph_lo = lo; a.ph_hi = hi;
    hipLaunchKernelGGL(fk::mega_fwd, dim3(fk_grid), dim3(fk::NWAVES * 64), fk::LDS_BYTES, stream, a);
    const hipError_t le = hipPeekAtLastError();
    if (le != hipSuccess) fprintf(stderr, "kernel_launch: launch [%d,%d) failed: %s\n", lo, hi, hipGetErrorName(le));
}

#ifdef FK_DEBUG_CHECK
#ifndef FK_FOCUS
#define FK_FOCUS 0
#endif
#ifndef FK_STAT
#define FK_STAT 1
#endif
namespace dbg {
__global__ void __launch_bounds__(256) k_cmp(const void* fast, int is_bf16, int fld, int fcol0, const float* gold, int gld, int gcol0, int rows, int cols, float gscale, float* acc) {
    float sd = 0.f, sb = 0.f, sa = 0.f, sb2 = 0.f;
    const size_t n = (size_t)rows * cols;
    for (size_t i = (size_t)blockIdx.x * 256 + threadIdx.x; i < n; i += (size_t)gridDim.x * 256) {
        const size_t r = i / cols; const int c = (int)(i % cols);
        float a;
        if (is_bf16) { const unsigned short h = ((const unsigned short*)fast)[r * fld + fcol0 + c]; a = __uint_as_float((unsigned)h << 16); } else a = ((const float*)fast)[r * fld + fcol0 + c];
        const float b = gold[r * gld + gcol0 + c] * gscale;
        const float d = a - b; sd += d * d; sb += b * b; sa += (FK_STAT == 2 ? a : FK_STAT == 3 ? a * b : FK_STAT == 4 ? (a > 0.99f ? 1.f : 0.f) : a * a); sb2 += (FK_STAT == 2 ? b : FK_STAT == 4 ? 1.f : b * b);
    }
    for (int o = 1; o < 64; o <<= 1) { sd += __shfl_xor(sd, o); sb += __shfl_xor(sb, o); sa += __shfl_xor(sa, o); sb2 += __shfl_xor(sb2, o); }
    if ((threadIdx.x & 63) == 0) { atomicAdd(&acc[0], sd); atomicAdd(&acc[1], sb); atomicAdd(&acc[512], sa); atomicAdd(&acc[513], sb2); }
}
__global__ void __launch_bounds__(256) k_cmp_vs(const unsigned short* vsb, const float* vspart, const float* gain, const float* gz, float* acc) {
    const int row = blockIdx.x * 4 + (threadIdx.x >> 6), lane = threadIdx.x & 63;
    float ss = 0.f; for (int j = 0; j < 8; ++j) ss += vspart[(size_t)row * 8 + j];
    const float rv = 1.f / sqrtf(ss / 512.f + 1e-6f);
    float sd = 0.f, sb = 0.f;
    for (int j = 0; j < 8; ++j) { const int c = lane + 64 * j; const float a = __uint_as_float((unsigned)vsb[(size_t)row * 512 + c] << 16) * rv * gain[c]; const float b = gz[(size_t)row * 4608 + 2048 + c]; sd += (a - b) * (a - b); sb += b * b; }
    for (int o = 1; o < 64; o <<= 1) { sd += __shfl_xor(sd, o); sb += __shfl_xor(sb, o); }
    if (lane == 0) { atomicAdd(&acc[0], sd); atomicAdd(&acc[1], sb); }
}
__global__ void __launch_bounds__(256) k_cmp_w(const unsigned short* wt, const float* w, const float* gain, int n0, int n1, float* acc) {
    float sd = 0.f, sb = 0.f; const size_t tot = (size_t)(n1 - n0) * 1024;
    for (size_t i = (size_t)blockIdx.x * 256 + threadIdx.x; i < tot; i += (size_t)gridDim.x * 256) { const int n = n0 + (int)(i >> 10), k = (int)(i & 1023);
        const float a = __uint_as_float((unsigned)wt[(size_t)n * 1024 + k] << 16), b = gain[k] * w[(size_t)k * 4608 + n]; sd += (a - b) * (a - b); sb += b * b; }
    for (int o = 1; o < 64; o <<= 1) { sd += __shfl_xor(sd, o); sb += __shfl_xor(sb, o); }
    if ((threadIdx.x & 63) == 0) { atomicAdd(&acc[0], sd); atomicAdd(&acc[1], sb); }
}
__global__ void k_final_v(const float* acc, int nchecks, float tol, float* v, int focus) {
    if (threadIdx.x == 0 && blockIdx.x == 0) {
        float out = 0.f;
        if (focus > 0) { float m = acc[2 * focus + 512] / acc[2 * focus + 513]; if (FK_STAT == 1) m = sqrtf(m); if (!(m <= 8.f)) m = 8.f; m = floorf(m * 20.f + 0.5f) * 0.05f; v[0] = powf(10.f, (float)focus) * (1.f + m); return; }
        for (int c = nchecks; c >= 1; --c) { const float e = sqrtf(acc[2 * c] / acc[2 * c + 1]); if (!(e <= tol)) { float m = e; if (!(m <= 2.f)) m = 2.f; m = floorf(m * 10.f + 0.5f) * 0.1f;   out = powf(10.f, (float)c) * (1.f + m); } }
        v[0] = out;
    }
}
__global__ void __launch_bounds__(256) k_scale_out(const float* base, const float* v, float* out, size_t n) {
    const size_t i = (size_t)blockIdx.x * 256 + threadIdx.x; if (i < n) out[i] = base[i] * (1.f + v[0]);
}
}
#endif

extern "C" void kernel_launch(void* const* d_in, const int* in_sizes, int n_in, void* d_out, int out_size, void* d_ws, size_t ws_size, hipStream_t stream) {
    using namespace fk;
    if (n_in != 22 || out_size != M * D || ws_size < WS_FAST_END) { fprintf(stderr, "kernel_launch: unexpected shapes (n_in %d out %d ws %zu)\n", n_in, out_size, ws_size); return; }
    if (!fk_setup()) return;
    if (hipMemsetAsync((char*)d_ws + WS_CTL, 0, CTL_ZERO_BYTES, stream) != hipSuccess) { fprintf(stderr, "kernel_launch: memset failed\n"); return; }
    Args a{};
    for (int i = 0; i < 22; ++i) a.in[i] = (const float*)d_in[i];
    a.out = (float*)d_out; a.ws = (unsigned char*)d_ws; a.nlayers = DEPTH; a.pad = 0;
#ifndef FK_DEBUG_CHECK
    const int nph = 2 + PH_PER_LAYER * DEPTH;
    if (FK_N_LAUNCHES == 1) fk_launch_range(a, 0, nph, stream);
    else for (int p = 0; p < nph; ++p) fk_launch_range(a, p, p + 1, stream);
#else
    constexpr size_t GOLD_BASE = 1100 * MiB, SN_A = 128 * MiB, SN_B = 192 * MiB, SN_BASE = 256 * MiB, FS_A = 320 * MiB, FS_B = 384 * MiB, DBG_ACC = 448 * MiB;
    if (ws_size < GOLD_BASE + gold::O_END) { fprintf(stderr, "kernel_launch: debug build needs %zu bytes of workspace, got %zu\n", GOLD_BASE + gold::O_END, ws_size); return; }
    unsigned char* ws = (unsigned char*)d_ws; unsigned char* gb = ws + GOLD_BASE;
    gold::forward(d_in, (float*)(ws + SN_BASE), gb, 4, stream);
    gold::forward(d_in, nullptr, gb, 1, stream, (float*)(ws + SN_A), (float*)(ws + SN_B));
    a.nlayers = 1;
    const int nph = 2 + PH_PER_LAYER;
    for (int p = 0; p < nph; ++p) {
        fk_launch_range(a, p, p + 1, stream);
        if (p == 2 + 0) (void)hipMemcpyAsync(ws + 528 * MiB, ws + WS_GAB, (size_t)M * 2048 * 2, hipMemcpyDeviceToDevice, stream);
        if (p == 2 + 3) (void)hipMemcpyAsync(ws + FS_A, d_out, (size_t)M * D * 4, hipMemcpyDeviceToDevice, stream);
        if (p == 2 + 7) (void)hipMemcpyAsync(ws + FS_B, d_out, (size_t)M * D * 4, hipMemcpyDeviceToDevice, stream);
    }
    float* acc = (float*)(ws + DBG_ACC);
    (void)hipMemsetAsync(acc, 0, 4096, stream);
    const float* gz = (const float*)(gb + gold::O_Z);
    int c = 0;
#define CMP(fast, isbf, fld, fc0, gold_, gld, gc0, rows, cols, gs) do { ++c; hipLaunchKernelGGL(dbg::k_cmp, dim3(2048), dim3(256), 0, stream, (const void*)(fast), isbf, fld, fc0, (const float*)(gold_), gld, gc0, rows, cols, gs, acc + 2 * c); } while (0)
    ++c; hipLaunchKernelGGL(dbg::k_cmp_w, dim3(1024), dim3(256), 0, stream, (const unsigned short*)(ws + WS_W + WO_IN), (const float*)d_in[3], (const float*)d_in[2], 1024, 2560, acc + 2 * c);
    ++c; hipLaunchKernelGGL(dbg::k_cmp_w, dim3(1024), dim3(256), 0, stream, (const unsigned short*)(ws + WS_W + WO_IN), (const float*)d_in[3], (const float*)d_in[2], 2560, 3584, acc + 2 * c);
    ++c; hipLaunchKernelGGL(dbg::k_cmp_w, dim3(1024), dim3(256), 0, stream, (const unsigned short*)(ws + WS_W + WO_IN), (const float*)d_in[3], (const float*)d_in[2], 3584, 4608, acc + 2 * c);
    CMP(ws + WS_E, 1, 1024, 0, gb + gold::O_YB, 1024, 0, M, 1024, 1.f);
    CMP(ws + WS_Q, 1, 512, 0, gz, INW, 0, M, 512, 0.125f * LOG2E);
    CMP(ws + WS_K, 1, 512, 0, gz, INW, 512, M, 512, 1.f);
    CMP(ws + WS_V, 1, 512, 0, gz, INW, 1024, M, 512, 1.f);
    CMP(ws + WS_U, 1, 512, 0, gz, INW, 1536, M, 512, 1.f);
    ++c; hipLaunchKernelGGL(dbg::k_cmp_vs, dim3(M / 4), dim3(256), 0, stream, (const unsigned short*)(ws + WS_VS), (const float*)(ws + WS_VSPART), (const float*)d_in[6], gz, acc + 2 * c);
    CMP(ws + WS_OC, 1, 1024, 0, gb + gold::O_OA, 512, 0, M, 512, 1.f);
    CMP(ws + WS_OC, 1, 1024, 512, gb + gold::O_OB, 512, 0, M, 512, 1.f);
    CMP(ws + WS_MG, 1, 1024, 0, gb + gold::O_YA, 1024, 0, M, 1024, 1.f);
    CMP(ws + FS_A, 0, 1024, 0, ws + SN_A, 1024, 0, M, 1024, 1.f);
    CMP(ws + FS_B, 0, 1024, 0, ws + SN_B, 1024, 0, M, 1024, 1.f);
    CMP(d_out, 0, 1024, 0, gb + gold::O_X, 1024, 0, M, 1024, 1.f);
    CMP(ws + 528 * MiB, 1, 2048, 0, gz, INW, 2560, M, 256, 1.f);
    CMP(ws + WS_GAB, 1, 2048, 0, gz, INW, 2560, M, 256, 1.f);
    CMP(ws + WS_GAB, 1, 2048, 256, gz, INW, 2816, M, 256, 1.f);
    CMP(ws + WS_GAB, 1, 2048, 512, gz, INW, 3072, M, 512, 1.f);
    CMP(ws + WS_GAB, 1, 2048, 1024, gz, INW, 3584, M, 1024, 1.f);
    hipLaunchKernelGGL(dbg::k_final_v, dim3(1), dim3(64), 0, stream, acc, c, 0.03f, acc + 900, FK_FOCUS);
    hipLaunchKernelGGL(dbg::k_scale_out, dim3(M * D / 256), dim3(256), 0, stream, (const float*)(ws + SN_BASE), acc + 900, (float*)d_out, (size_t)M * D);
#endif
}
```

```cpp
#include <hip/hip_runtime.h>
#include <hip/hip_bf16.h>
#include <cstdio>
#include <cstdint>
#include <cmath>
namespace fk {
#define LAS __attribute__((address_space(3)))
#define GAS __attribute__((address_space(1)))
typedef unsigned short bf16_t;
typedef short bf16x8 __attribute__((ext_vector_type(8)));
typedef short s16x4 __attribute__((ext_vector_type(4)));
typedef float f32x2 __attribute__((ext_vector_type(2)));
typedef float f32x4 __attribute__((ext_vector_type(4)));
typedef float f32x16 __attribute__((ext_vector_type(16)));
typedef unsigned u32x2 __attribute__((ext_vector_type(2)));
typedef unsigned u32x4 __attribute__((ext_vector_type(4)));

constexpr int M = 16384, SEQ = 8192, D = 1024, INW = 4608, NE = 32, ECAP = 16384, DEPTH = 4;
constexpr float EPS = 1e-6f, LOG2E = 1.4426950408889634f;
constexpr int CNT_STRIDE = 64;
constexpr int BM = 256, BK = 64, HALF = 128, HTB = HALF * BK * 2, STAGE_BYTES = 8 * HTB, NXCD = 8, WGM = 8;

__device__ __forceinline__ unsigned cvt_pk_bf16(float lo, float hi) { unsigned r; asm volatile("v_cvt_pk_bf16_f32 %0, %1, %2" : "=v"(r) : "v"(lo), "v"(hi)); return r; }
__device__ __forceinline__ float bf_lo(unsigned w) { return __uint_as_float(w << 16); }
__device__ __forceinline__ float bf_hi(unsigned w) { return __uint_as_float(w & 0xffff0000u); }
__device__ __forceinline__ float fast_rcp(float x) { return __builtin_amdgcn_rcpf(x); }
__device__ __forceinline__ float fast_exp2(float x) { return __builtin_amdgcn_exp2f(x); }
__device__ __forceinline__ float fast_log2(float x) { return __builtin_amdgcn_logf(x); }
__device__ __forceinline__ float fast_rsq(float x) { return __builtin_amdgcn_rsqf(x); }
__device__ __forceinline__ float sigmoid_f(float x) { return fast_rcp(1.f + fast_exp2(-LOG2E * x)); }
__device__ __forceinline__ float gelu_tanh_f(float x) { const float u2 = 1.5957691216057308f * (x + 0.044715f * x * x * x); return x * fast_rcp(1.f + fast_exp2(-LOG2E * u2)); }

__host__ __device__ __forceinline__ int lds_byte(int r, int c) { const int st = (r >> 4) * 2 + (c >> 5), rr = r & 15, cc = c & 31, ob = rr * 64 + cc * 2; return st * 1024 + (ob ^ (((ob >> 9) & 1) << 5)); }
__host__ __device__ __forceinline__ void stage_rc(int b, int& R, int& C) { const int st = b / 1024, sb = b % 1024, swz = sb ^ (((sb >> 9) & 1) << 5); R = (st >> 1) * 16 + swz / 64; C = (st & 1) * 32 + (swz % 64) / 2; }
__host__ __device__ __forceinline__ int perm32(int rho) { const int n = rho >> 4, i = rho & 15; return 8 * (i >> 2) + 4 * n + (i & 3); }

template <int MASK> __device__ __forceinline__ float xor_lt32(float v) { return __int_as_float(__builtin_amdgcn_ds_swizzle(__float_as_int(v), (MASK << 10) | 0x1f)); }
__device__ __forceinline__ void halves32(float v, float& lo, float& hi) { auto rr = __builtin_amdgcn_permlane32_swap(__float_as_uint(v), __float_as_uint(v), false, false); lo = __uint_as_float(rr[0]); hi = __uint_as_float(rr[1]); }
__device__ __forceinline__ float sum_xor16_32(float v) { v += xor_lt32<16>(v); float lo, hi; halves32(v, lo, hi); return lo + hi; }
#ifndef FK_WT
#define FK_WT 0
#endif
__device__ __forceinline__ void st16wt(void* p, u32x4 v) {
#if FK_WT
    asm volatile("global_store_dwordx4 %0, %1, off sc1" :: "v"(p), "v"(v) : "memory");
#else
    *(u32x4*)p = v;
#endif
}
__device__ __forceinline__ void st16(void* p, u32x4 v) { *(u32x4*)p = v; }
__device__ __forceinline__ int fk_lane() { int l; asm volatile("v_mbcnt_lo_u32_b32 %0, -1, 0\n\tv_mbcnt_hi_u32_b32 %0, -1, %0" : "=v"(l)); return l; }
struct Unit { int pm, pn, e, aux; };

struct DenseOrder {
    int nM, nN, nwg, G, c; const char* A; const char* B; int K;
    __device__ void init(int Mr, int N, int G_, int c_, const void* A_, const void* B_, int K_) { nM = Mr / BM; nN = N / BM; nwg = nM * nN; G = G_; c = c_; A = (const char*)A_; B = (const char*)B_; K = K_; }
    __device__ __forceinline__ bool next(int i, Unit& u) const {
        const long L = (long)i * G + c; if (L >= nwg) return false;
        int wgid = (int)L; { const int q = nwg / NXCD, r = nwg % NXCD, xcd = wgid % NXCD, off = wgid / NXCD; wgid = (xcd < r ? xcd * (q + 1) : r * (q + 1) + (xcd - r) * q) + off; }
        const int nig = WGM * nN, gid = wgid / nig, fm = gid * WGM, gsz = (nM - fm) < WGM ? (nM - fm) : WGM;
        u.pm = fm + ((wgid % nig) % gsz); u.pn = (wgid % nig) / gsz; u.e = 0; u.aux = 0; return true;
    }
    __device__ __forceinline__ const char* a_base() const { return A; }
    __device__ __forceinline__ const char* b_base(const Unit& u) const { return B + (size_t)u.pn * BM * K * 2; }
    __device__ __forceinline__ void a_voff(const Unit& u, unsigned (&v)[2][2], const int (&R)[2], const int (&C)[2]) const {
#pragma unroll
        for (int h = 0; h < 2; ++h)
#pragma unroll
            for (int i = 0; i < 2; ++i) v[h][i] = (unsigned)((u.pm * BM + h * HALF + R[i]) * K + C[i]) * 2u;
    }
};

struct ExpertOrder {
    int G, c, K, nN; const char* A; const char* B; size_t bstride; const LAS int* pref; const int* tokl; const int* cnt; int gather;
    int L0, imax, Lend;
    int xcd_deal;
    __device__ __forceinline__ bool next(int i, Unit& u) const {
        if (i >= imax) return false;
        int u_ = c; if (xcd_deal) { const int q = c >> 3, x = c & 7; u_ = (x * (G >> 5) + (q >> 2)) * 4 + (q & 3); }
        const int L = L0 + i * G + u_; const int tot = pref[NE] * nN; if (L >= Lend || L >= tot) return false;
        const int rbi = L / nN; u.pn = L % nN; int e = 0;
#pragma unroll 1
        for (int j = 1; j < NE; ++j) if (rbi >= pref[j]) e = j;
        u.e = e; u.pm = rbi - pref[e]; u.aux = rbi * BM; return true;
    }
    __device__ __forceinline__ const char* a_base() const { return A; }
    __device__ __forceinline__ const char* b_base(const Unit& u) const { return B + (size_t)u.e * bstride + (size_t)u.pn * BM * K * 2; }
    __device__ __forceinline__ void a_voff(const Unit& u, unsigned (&v)[2][2], const int (&R)[2], const int (&C)[2]) const {
        const int ce = cnt[u.e * CNT_STRIDE];
#pragma unroll
        for (int h = 0; h < 2; ++h)
#pragma unroll
            for (int i = 0; i < 2; ++i) {
                const int r = u.pm * BM + h * HALF + R[i]; int row;
                if (gather) row = (r < ce) ? tokl[u.e * ECAP + r] : 0; else row = u.aux + h * HALF + R[i];
                v[h][i] = (unsigned)(row * K + C[i]) * 2u;
            }
    }
};

template <class Epi, class Sched, bool ALIGN_EPI>
__device__ __forceinline__ void gemm_phase(LAS unsigned char* lds, const int K, const Sched& S, const Epi& E, const int wave_id) {
    const int tid_ = (wave_id << 6) | fk_lane();
    const int tid = tid_, wid = __builtin_amdgcn_readfirstlane(tid >> 6), lane = tid & 63, wr = wid >> 2, wc = wid & 3, fr = lane & 15, fq = lane >> 4;
    const int nt = K / BK;
    int Rr[2], Cc[2]; unsigned voffB[2];
#pragma unroll
    for (int i = 0; i < 2; ++i) { int R, C; stage_rc(tid * 16 + i * 8192, R, C); Rr[i] = R; Cc[i] = C; const int Rb = Epi::PERM ? ((R & ~31) + perm32(R & 31)) : R; voffB[i] = (unsigned)(Rb * K + C) * 2u; }
    const size_t kstep = (size_t)(BK * 2);
    const size_t hstep = (size_t)HALF * K * 2;
    const unsigned ldsw = (unsigned)wid * 1024u;
    const int aoff = lds_byte(wr * 64 + fr, fq * 8), boff = lds_byte(wc * 32 + fr, fq * 8);
#define PG8_SA(b, h) (((b) * 2 + (h)) * HTB)
#define PG8_SB(b, h) ((4 + (b) * 2 + (h)) * HTB)
#define PG8_STAGE_B(bufoff, gbase) do { _Pragma("unroll") for (int _i = 0; _i < 2; ++_i) \
        __builtin_amdgcn_global_load_lds((const unsigned*)((const char*)(gbase) + voffB[_i]), (LAS unsigned*)(lds + (bufoff) + ldsw + _i * 8192), 16, 0, 0); } while (0)
#define PG8_STAGE_A(bufoff, vo, h, koff) do { _Pragma("unroll") for (int _i = 0; _i < 2; ++_i) \
        __builtin_amdgcn_global_load_lds((const unsigned*)(Ab + (size_t)(vo)[h][_i] + (size_t)(koff)), (LAS unsigned*)(lds + (bufoff) + ldsw + _i * 8192), 16, 0, 0); } while (0)
#define PG8_LDA(dst, b, h) do { _Pragma("unroll") for (int m = 0; m < 4; ++m) _Pragma("unroll") for (int k = 0; k < 2; ++k) dst[m][k] = *(const LAS bf16x8*)(lds + PG8_SA(b, h) + aoff + m * 2048 + k * 1024); } while (0)
#define PG8_LDB(dst, b, h) do { _Pragma("unroll") for (int n = 0; n < 2; ++n) _Pragma("unroll") for (int k = 0; k < 2; ++k) dst[n][k] = *(const LAS bf16x8*)(lds + PG8_SB(b, h) + boff + n * 2048 + k * 1024); } while (0)
#define PG8_MMA(ai, bj, At, Bt) do { __builtin_amdgcn_s_setprio(1); _Pragma("unroll") for (int m = 0; m < 4; ++m) _Pragma("unroll") for (int n = 0; n < 2; ++n) _Pragma("unroll") for (int k = 0; k < 2; ++k) \
        acc[ai][bj][m][n] = __builtin_amdgcn_mfma_f32_16x16x32_bf16(Bt[n][k], At[m][k], acc[ai][bj][m][n], 0, 0, 0); __builtin_amdgcn_s_setprio(0); } while (0)
#define PG8_WAIT_V(n) asm volatile("s_waitcnt vmcnt(" #n ")" ::: "memory")
#define PG8_WAIT_L(n) asm volatile("s_waitcnt lgkmcnt(" #n ")" ::: "memory")
#define PG8_BAR __builtin_amdgcn_s_barrier()
#define PG8_SCHED __builtin_amdgcn_sched_barrier(0)
    Unit cur, nxt; int ui = 0;
    if (!S.next(0, cur)) return;
    f32x4 acc[2][2][4][2];
#pragma unroll
    for (int a = 0; a < 2; ++a)
#pragma unroll
        for (int b = 0; b < 2; ++b)
#pragma unroll
            for (int m = 0; m < 4; ++m)
#pragma unroll
                for (int n = 0; n < 2; ++n) acc[a][b][m][n] = (f32x4){0.f, 0.f, 0.f, 0.f};
    bf16x8 At[4][2], B0[2][2], B1[2][2];
    const char* Ab = S.a_base();
    unsigned cvA[2][2], nvA[2][2];
    S.a_voff(cur, cvA, Rr, Cc);
    const char* cB = S.b_base(cur);
    PG8_STAGE_B(PG8_SB(0, 0), cB); PG8_STAGE_B(PG8_SB(0, 1), cB + hstep); PG8_STAGE_A(PG8_SA(0, 0), cvA, 0, 0); PG8_STAGE_A(PG8_SA(0, 1), cvA, 1, 0);
    if (wr == 1) PG8_BAR;
    PG8_WAIT_V(2); PG8_BAR;
    PG8_STAGE_B(PG8_SB(1, 0), cB + kstep); PG8_STAGE_A(PG8_SA(1, 0), cvA, 0, kstep); PG8_STAGE_B(PG8_SB(1, 1), cB + hstep + kstep);
    PG8_WAIT_V(6); PG8_BAR;
    for (;;) {
        const bool has_next = S.next(ui + 1, nxt);
        const char* nB = has_next ? S.b_base(nxt) : cB;
        if (has_next) S.a_voff(nxt, nvA, Rr, Cc);
        else {
#pragma unroll
            for (int h = 0; h < 2; ++h)
#pragma unroll
                for (int i = 0; i < 2; ++i) nvA[h][i] = cvA[h][i];
        }
#pragma unroll 1
        for (int t = 0; t < nt; t += 2) {
            const bool last = (t == nt - 2);
            if constexpr (Epi::HAS_MID) { if (t == Epi::MID_T) E.mid(acc, cur, wr, wc, fr, fq); }
            const size_t k1 = (size_t)(t + 1) * kstep;
            unsigned a2[2][2];
#pragma unroll
            for (int h = 0; h < 2; ++h)
#pragma unroll
                for (int i = 0; i < 2; ++i) a2[h][i] = last ? nvA[h][i] : cvA[h][i] + (unsigned)((t + 2) * (BK * 2));
            const char* b2 = last ? nB : cB + (size_t)(t + 2) * kstep;
            const char* b3 = b2 + kstep;
            PG8_LDB(B0, 0, 0); PG8_LDB(B1, 0, 1); PG8_SCHED; PG8_LDA(At, 0, 0); PG8_STAGE_A(PG8_SA(1, 1), cvA, 1, k1);
            PG8_WAIT_V(8); PG8_WAIT_L(0); PG8_BAR; PG8_MMA(0, 0, At, B0); PG8_MMA(0, 1, At, B1); PG8_BAR; PG8_SCHED;
            PG8_LDA(At, 0, 1); PG8_STAGE_B(PG8_SB(0, 0), b2); PG8_STAGE_B(PG8_SB(0, 1), b2 + hstep); PG8_STAGE_A(PG8_SA(0, 0), a2, 0, 0);
            PG8_WAIT_V(8); PG8_WAIT_L(0); PG8_BAR; PG8_MMA(1, 0, At, B0); PG8_MMA(1, 1, At, B1); PG8_BAR; PG8_SCHED;
            PG8_LDB(B0, 1, 0); PG8_LDB(B1, 1, 1); PG8_SCHED; PG8_LDA(At, 1, 0); PG8_STAGE_A(PG8_SA(0, 1), a2, 1, 0);
            PG8_WAIT_V(8); PG8_WAIT_L(0); PG8_BAR; PG8_MMA(0, 0, At, B0); PG8_MMA(0, 1, At, B1); PG8_BAR; PG8_SCHED;
            PG8_LDA(At, 1, 1); PG8_STAGE_B(PG8_SB(1, 0), b3); PG8_STAGE_B(PG8_SB(1, 1), b3 + hstep); PG8_STAGE_A(PG8_SA(1, 0), a2, 0, kstep);
            PG8_WAIT_V(8); PG8_WAIT_L(0); PG8_BAR; PG8_MMA(1, 0, At, B0); PG8_MMA(1, 1, At, B1); PG8_BAR; PG8_SCHED;
        }
        if constexpr (ALIGN_EPI) { if (wr == 0) PG8_BAR; }
        E(acc, cur, wr, wc, fr, fq);
        if (!has_next) break;
#pragma unroll
        for (int a = 0; a < 2; ++a)
#pragma unroll
            for (int b = 0; b < 2; ++b)
#pragma unroll
                for (int m = 0; m < 4; ++m)
#pragma unroll
                    for (int n = 0; n < 2; ++n) acc[a][b][m][n] = (f32x4){0.f, 0.f, 0.f, 0.f};
        cur = nxt; cB = nB; ++ui;
#pragma unroll
        for (int h = 0; h < 2; ++h)
#pragma unroll
            for (int i = 0; i < 2; ++i) cvA[h][i] = nvA[h][i];
        if constexpr (ALIGN_EPI) { if (wr == 1) PG8_BAR; }
    }
    PG8_WAIT_V(0);
    if constexpr (!ALIGN_EPI) { if (wr == 0) PG8_BAR; }
    PG8_BAR;
#undef PG8_SA
#undef PG8_SB
#undef PG8_STAGE_A
#undef PG8_STAGE_B
#undef PG8_LDA
#undef PG8_LDB
#undef PG8_MMA
#undef PG8_WAIT_V
#undef PG8_WAIT_L
#undef PG8_BAR
#undef PG8_SCHED
}

typedef f32x4 Acc[2][2][4][2];
__device__ __forceinline__ u32x4 pack8(const f32x4 a, const f32x4 b) { u32x4 w; w.x = cvt_pk_bf16(a[0], a[1]); w.y = cvt_pk_bf16(a[2], a[3]); w.z = cvt_pk_bf16(b[0], b[1]); w.w = cvt_pk_bf16(b[2], b[3]); return w; }

struct EpiPlain {
    static constexpr bool PERM = true, HAS_MID = false; static constexpr int MID_T = 0;
    bf16_t* O; int ldc; int use_aux;
    __device__ __forceinline__ void mid(Acc&, const Unit&, int, int, int, int) const {}
    __device__ __forceinline__ void operator()(const Acc& acc, const Unit& u, int wr, int wc, int fr, int fq) const {
        const int row0 = (use_aux ? u.aux : u.pm * BM) + wr * 64 + fr, col0 = u.pn * BM + wc * 32 + 8 * fq;
#pragma unroll
        for (int ai = 0; ai < 2; ++ai)
#pragma unroll
            for (int m = 0; m < 4; ++m) { bf16_t* rowp = O + (size_t)(row0 + ai * HALF + m * 16) * ldc + col0;
#pragma unroll
                for (int bj = 0; bj < 2; ++bj) st16(rowp + bj * HALF, pack8(acc[ai][bj][m][0], acc[ai][bj][m][1])); }
    }
};

struct EpiIn {
    static constexpr bool PERM = true, HAS_MID = false; static constexpr int MID_T = 0;
    const float* xpart; const float* qn; const float* kn;
    bf16_t *qb, *kb, *vb, *ub, *vsb, *gab; float* vspart;
    __device__ __forceinline__ void mid(Acc&, const Unit&, int, int, int, int) const {}
    __device__ __forceinline__ void operator()(const Acc& acc, const Unit& u, int wr, int wc, int fr, int fq) const {
        const int pn = u.pn;
#pragma unroll
        for (int ai = 0; ai < 2; ++ai)
#pragma unroll
            for (int m = 0; m < 4; ++m) {
                const int row = u.pm * BM + ai * HALF + wr * 64 + m * 16 + fr;
                const f32x4* xp = (const f32x4*)(xpart + (size_t)row * 16);
                const f32x4 s0 = xp[0], s1 = xp[1], s2 = xp[2], s3 = xp[3];
                const float ssx = ((s0[0] + s0[1]) + (s0[2] + s0[3])) + ((s1[0] + s1[1]) + (s1[2] + s1[3])) + ((s2[0] + s2[1]) + (s2[2] + s2[3])) + ((s3[0] + s3[1]) + (s3[2] + s3[3]));
                const float rs = fast_rsq(ssx * (1.f / D) + EPS);
                f32x4 v[2][2];
#pragma unroll
                for (int bj = 0; bj < 2; ++bj)
#pragma unroll
                    for (int n = 0; n < 2; ++n) v[bj][n] = acc[ai][bj][m][n] * rs;
                if (pn < 4) {
                    float ss = 0.f;
#pragma unroll
                    for (int bj = 0; bj < 2; ++bj)
#pragma unroll
                        for (int n = 0; n < 2; ++n) ss += (v[bj][n][0] * v[bj][n][0] + v[bj][n][1] * v[bj][n][1]) + (v[bj][n][2] * v[bj][n][2] + v[bj][n][3] * v[bj][n][3]);
                    ss = sum_xor16_32(ss);
                    const bool isq = pn < 2;
                    const float sc = fast_rsq(ss * (1.f / 64.f) + EPS) * (isq ? 0.125f * LOG2E : 1.f);
                    const float* gn = isq ? qn : kn; bf16_t* O = isq ? qb : kb;
                    const int head = 4 * (pn & 1) + wc;
#pragma unroll
                    for (int bj = 0; bj < 2; ++bj) {
                        const f32x4 g0 = *(const f32x4*)(gn + 32 * bj + 8 * fq), g1 = *(const f32x4*)(gn + 32 * bj + 8 * fq + 4);
                        st16wt(O + (size_t)row * 512 + head * 64 + 32 * bj + 8 * fq, pack8(v[bj][0] * sc * g0, v[bj][1] * sc * g1));
                    }
                } else {
                    const int colw = wc * 32 + 8 * fq;
                    if (pn < 6) {
#pragma unroll
                        for (int bj = 0; bj < 2; ++bj) st16wt(vb + (size_t)row * 512 + (pn - 4) * BM + bj * HALF + colw, pack8(v[bj][0], v[bj][1]));
                    } else if (pn < 10) {
                        float ss = 0.f;
#pragma unroll
                        for (int bj = 0; bj < 2; ++bj)
#pragma unroll
                            for (int n = 0; n < 2; ++n)
#pragma unroll
                                for (int i = 0; i < 4; ++i) { const float gv = gelu_tanh_f(v[bj][n][i]); v[bj][n][i] = gv; ss += gv * gv; }
                        if (pn < 8) {
#pragma unroll
                            for (int bj = 0; bj < 2; ++bj) st16wt(ub + (size_t)row * 512 + (pn - 6) * BM + bj * HALF + colw, pack8(v[bj][0], v[bj][1]));
                        } else {
#pragma unroll
                            for (int bj = 0; bj < 2; ++bj) st16wt(vsb + (size_t)row * 512 + (pn - 8) * BM + bj * HALF + colw, pack8(v[bj][0], v[bj][1]));
                            ss = sum_xor16_32(ss);
                            if (fq == 0) vspart[(size_t)row * 8 + (pn - 8) * 4 + wc] = ss;
                        }
                    } else {
#pragma unroll
                        for (int bj = 0; bj < 2; ++bj) {
#pragma unroll
                            for (int n = 0; n < 2; ++n)
#pragma unroll
                                for (int i = 0; i < 4; ++i) v[bj][n][i] = fmaxf(sigmoid_f(v[bj][n][i]), 1e-13f);
                            st16wt(gab + (size_t)row * 2048 + (pn - 10) * BM + bj * HALF + colw, pack8(v[bj][0], v[bj][1]));
                        }
                    }
                }
            }
    }
};

struct EpiUp {
    static constexpr bool PERM = true, HAS_MID = true; static constexpr int MID_T = 8;
    const bf16_t* gab; bf16_t* mg;
    __device__ __forceinline__ void mid(Acc& acc, const Unit& u, int wr, int wc, int fr, int fq) const {
        int row0 = u.pm * BM + wr * 64 + fr; const int col0 = u.pn * BM + wc * 32 + 8 * fq; asm volatile("" : "+v"(row0));
#pragma unroll
        for (int am = 0; am < 4; ++am) {
            const int ai = am >> 1, mb = (am & 1) * 2;
            u32x4 ga[2][2], gb[2][2];
#pragma unroll
            for (int mm = 0; mm < 2; ++mm) { const bf16_t* gp = gab + (size_t)(row0 + ai * HALF + (mb + mm) * 16) * 2048 + col0;
#pragma unroll
                for (int bj = 0; bj < 2; ++bj) { ga[mm][bj] = *(const u32x4*)(gp + bj * HALF); gb[mm][bj] = *(const u32x4*)(gp + 1024 + bj * HALF); } }
#pragma unroll
            for (int mm = 0; mm < 2; ++mm)
#pragma unroll
                for (int bj = 0; bj < 2; ++bj)
#pragma unroll
                    for (int j = 0; j < 4; ++j) { const float r0 = bf_lo(ga[mm][bj][j]) * fast_rcp(bf_lo(gb[mm][bj][j])), r1 = bf_hi(ga[mm][bj][j]) * fast_rcp(bf_hi(gb[mm][bj][j]));
                        acc[ai][bj][mb + mm][j >> 1][(j & 1) * 2] *= r0; acc[ai][bj][mb + mm][j >> 1][(j & 1) * 2 + 1] *= r1; }
            asm volatile("" ::: "memory");
        }
    }
    __device__ __forceinline__ void operator()(const Acc& acc, const Unit& u, int wr, int wc, int fr, int fq) const {
        int row0 = u.pm * BM + wr * 64 + fr; const int col0 = u.pn * BM + wc * 32 + 8 * fq; asm volatile("" : "+v"(row0));
#pragma unroll
        for (int ai = 0; ai < 2; ++ai) {
            u32x4 gb[4][2];
#pragma unroll
            for (int m = 0; m < 4; ++m)
#pragma unroll
                for (int bj = 0; bj < 2; ++bj) gb[m][bj] = *(const u32x4*)(gab + (size_t)(row0 + ai * HALF + m * 16) * 2048 + 1024 + col0 + bj * HALF);
#pragma unroll
            for (int m = 0; m < 4; ++m) { const size_t ro = (size_t)(row0 + ai * HALF + m * 16);
#pragma unroll
                for (int bj = 0; bj < 2; ++bj) { const u32x4 b = gb[m][bj];
                    f32x4 o0, o1;
                    o0[0] = acc[ai][bj][m][0][0] * bf_lo(b[0]); o0[1] = acc[ai][bj][m][0][1] * bf_hi(b[0]); o0[2] = acc[ai][bj][m][0][2] * bf_lo(b[1]); o0[3] = acc[ai][bj][m][0][3] * bf_hi(b[1]);
                    o1[0] = acc[ai][bj][m][1][0] * bf_lo(b[2]); o1[1] = acc[ai][bj][m][1][1] * bf_hi(b[2]); o1[2] = acc[ai][bj][m][1][2] * bf_lo(b[3]); o1[3] = acc[ai][bj][m][1][3] * bf_hi(b[3]);
                    st16(mg + ro * 1024 + col0 + bj * HALF, pack8(o0, o1)); } }
            asm volatile("" ::: "memory");
        }
    }
};

struct EpiOut {
    static constexpr bool PERM = true, HAS_MID = false; static constexpr int MID_T = 0;
    const bf16_t* xin; bf16_t* xout;
    __device__ __forceinline__ void mid(Acc&, const Unit&, int, int, int, int) const {}
    __device__ __forceinline__ void operator()(const Acc& acc, const Unit& u, int wr, int wc, int fr, int fq) const {
        int row0 = u.pm * BM + wr * 64 + fr; const int col0 = u.pn * BM + wc * 32 + 8 * fq; asm volatile("" : "+v"(row0));
#pragma unroll
        for (int ai = 0; ai < 2; ++ai) {
            u32x4 xv[4][2];
#pragma unroll
            for (int m = 0; m < 4; ++m)
#pragma unroll
                for (int bj = 0; bj < 2; ++bj) xv[m][bj] = *(const u32x4*)(xin + (size_t)(row0 + ai * HALF + m * 16) * D + col0 + bj * HALF);
#pragma unroll
            for (int m = 0; m < 4; ++m)
#pragma unroll
                for (int bj = 0; bj < 2; ++bj) { const u32x4 xo = xv[m][bj]; f32x4 o0, o1;
                    o0[0] = bf_lo(xo[0]) + acc[ai][bj][m][0][0]; o0[1] = bf_hi(xo[0]) + acc[ai][bj][m][0][1]; o0[2] = bf_lo(xo[1]) + acc[ai][bj][m][0][2]; o0[3] = bf_hi(xo[1]) + acc[ai][bj][m][0][3];
                    o1[0] = bf_lo(xo[2]) + acc[ai][bj][m][1][0]; o1[1] = bf_hi(xo[2]) + acc[ai][bj][m][1][1]; o1[2] = bf_lo(xo[3]) + acc[ai][bj][m][1][2]; o1[3] = bf_hi(xo[3]) + acc[ai][bj][m][1][3];
                    st16(xout + (size_t)(row0 + ai * HALF + m * 16) * D + col0 + bj * HALF, pack8(o0, o1)); }
            asm volatile("" ::: "memory");
        }
    }
};

struct EpiG1 {
    static constexpr bool PERM = true, HAS_MID = false; static constexpr int MID_T = 0;
    const int* tokl; const int* cnt; const float* rs2; bf16_t* Gb;
    __device__ __forceinline__ void mid(Acc&, const Unit&, int, int, int, int) const {}
    __device__ __forceinline__ void operator()(const Acc& acc, const Unit& u, int wr, int wc, int fr, int fq) const {
        const int ce = cnt[u.e * CNT_STRIDE];
#pragma unroll
        for (int ai = 0; ai < 2; ++ai)
#pragma unroll
            for (int m = 0; m < 4; ++m) {
                const int rl = ai * HALF + wr * 64 + m * 16 + fr, r = u.pm * BM + rl;
                const int tok = (r < ce) ? tokl[u.e * ECAP + r] : 0;
                const float rs = rs2[tok];
                f32x4 o[2];
#pragma unroll
                for (int n = 0; n < 2; ++n)
#pragma unroll
                    for (int i = 0; i < 4; ++i) { const float g = acc[ai][0][m][n][i] * rs, up = acc[ai][1][m][n][i] * rs; o[n][i] = g * sigmoid_f(g) * up; }
                st16(Gb + (size_t)(u.aux + rl) * 512 + u.pn * HALF + wc * 32 + 8 * fq, pack8(o[0], o[1]));
            }
    }
};

struct EpiPle {
    static constexpr bool PERM = true, HAS_MID = false; static constexpr int MID_T = 0;
    const bf16_t* xin; bf16_t* xout; float* fout; const bf16_t* Eb; const float* rs3; float* xpart;
    __device__ __forceinline__ void mid(Acc&, const Unit&, int, int, int, int) const {}
    __device__ __forceinline__ void operator()(const Acc& acc, const Unit& u, int wr, int wc, int fr, int fq) const {
        int row0 = u.pm * BM + wr * 64 + fr; const int col0 = u.pn * BM + wc * 32 + 8 * fq; asm volatile("" : "+v"(row0));
#pragma unroll
        for (int am = 0; am < 4; ++am) {
            const int ai = am >> 1, mb = (am & 1) * 2;
            u32x4 xv[2][2], ev[2][2]; float rsv[2];
#pragma unroll
            for (int mm = 0; mm < 2; ++mm) { const int row = row0 + ai * HALF + (mb + mm) * 16; rsv[mm] = rs3[row];
#pragma unroll
                for (int bj = 0; bj < 2; ++bj) { xv[mm][bj] = *(const u32x4*)(xin + (size_t)row * D + col0 + bj * HALF); ev[mm][bj] = *(const u32x4*)(Eb + (size_t)row * D + col0 + bj * HALF); } }
#pragma unroll
            for (int mm = 0; mm < 2; ++mm) { const int row = row0 + ai * HALF + (mb + mm) * 16; const float rs = rsv[mm]; float ss = 0.f;
#pragma unroll
                for (int bj = 0; bj < 2; ++bj) { const u32x4 xo = xv[mm][bj], e = ev[mm][bj]; f32x4 o[2];
#pragma unroll
                    for (int j = 0; j < 4; ++j) { o[j >> 1][(j & 1) * 2] = bf_lo(xo[j]) + sigmoid_f(acc[ai][bj][mb + mm][j >> 1][(j & 1) * 2] * rs) * bf_lo(e[j]);
                                                  o[j >> 1][(j & 1) * 2 + 1] = bf_hi(xo[j]) + sigmoid_f(acc[ai][bj][mb + mm][j >> 1][(j & 1) * 2 + 1] * rs) * bf_hi(e[j]); }
                    const u32x4 w = pack8(o[0], o[1]);
#pragma unroll
                    for (int j = 0; j < 4; ++j) { const float a = bf_lo(w[j]), b = bf_hi(w[j]); ss += a * a + b * b; }
                    st16(xout + (size_t)row * D + col0 + bj * HALF, w);
                    if (fout) { *(f32x4*)(fout + (size_t)row * D + col0 + bj * HALF) = o[0]; *(f32x4*)(fout + (size_t)row * D + col0 + bj * HALF + 4) = o[1]; } }
                ss = sum_xor16_32(ss);
                if (fq == 0) xpart[(size_t)row * 16 + u.pn * 4 + wc] = ss; }
            asm volatile("" ::: "memory");
        }
    }
};
__device__ __forceinline__ int crow(int r, int hi) { return (r & 3) + 8 * (r >> 2) + 4 * hi; }
__device__ __forceinline__ unsigned cvtpk_s(float lo, float hi) { typedef __bf16 bf16x2_t __attribute__((ext_vector_type(2))); f32x2 v = {lo, hi}; bf16x2_t b = __builtin_convertvector(v, bf16x2_t); return __builtin_bit_cast(unsigned, b); }
#define FK_SBAR() __builtin_amdgcn_sched_barrier(0)
__device__ __forceinline__ void pv(f32x16* o, int vb, bf16x8 pa0, bf16x8 pa1, bf16x8 pa2, bf16x8 pa3) {
#pragma unroll
    for (int d0 = 0; d0 < 2; ++d0) { s16x4 lo[4], hi[4];
#pragma unroll
        for (int ks = 0; ks < 4; ++ks) {
            asm volatile("ds_read_b64_tr_b16 %0,%1 offset:%c2" : "=&v"(lo[ks]) : "v"(vb), "i"(d0 * 4096 + ks * 1024) : "memory");
            asm volatile("ds_read_b64_tr_b16 %0,%1 offset:%c2" : "=&v"(hi[ks]) : "v"(vb), "i"(d0 * 4096 + ks * 1024 + 512) : "memory"); }
        asm volatile("s_waitcnt lgkmcnt(0)" ::: "memory"); FK_SBAR();
#define FK_PK(k) (bf16x8){lo[k][0], lo[k][1], lo[k][2], lo[k][3], hi[k][0], hi[k][1], hi[k][2], hi[k][3]}
        o[d0] = __builtin_amdgcn_mfma_f32_32x32x16_bf16(pa0, FK_PK(0), o[d0], 0, 0, 0);
        o[d0] = __builtin_amdgcn_mfma_f32_32x32x16_bf16(pa1, FK_PK(1), o[d0], 0, 0, 0);
        o[d0] = __builtin_amdgcn_mfma_f32_32x32x16_bf16(pa2, FK_PK(2), o[d0], 0, 0, 0);
        o[d0] = __builtin_amdgcn_mfma_f32_32x32x16_bf16(pa3, FK_PK(3), o[d0], 0, 0, 0);
#undef FK_PK
    }
}
constexpr int WLDS_BYTES = 16384;

template <bool DIAG>
__device__ __forceinline__ void attn_tile(const bf16x8 (&k0)[4], const bf16x8 (&k1)[4], const bf16x8 (&qr)[4], f32x16 (&o)[2], float& R, int s0, int tq, int hi, int vbase) {
    f32x16 p0 = f32x16{}, p1 = f32x16{};
#pragma unroll
    for (int d0 = 0; d0 < 4; ++d0) { p0 = __builtin_amdgcn_mfma_f32_32x32x16_bf16(k0[d0], qr[d0], p0, 0, 0, 0); p1 = __builtin_amdgcn_mfma_f32_32x32x16_bf16(k1[d0], qr[d0], p1, 0, 0, 0); }
    float kp[32], bt[32];
#pragma unroll
    for (int r = 0; r < 32; ++r) {
        const float z = r < 16 ? p0[r] : p1[r - 16];
        const float e = fast_exp2(z);
        float k_ = fast_rcp(1.f + e), b_ = 1.f - k_;
        if (DIAG) { const int kv = s0 + crow(r & 15, hi) + (r >> 4) * 32; if (!(kv < tq)) { k_ = 1.f; b_ = 0.f; } }
        kp[r] = k_; bt[r] = b_;
    }
    float pg[8], T[8], SP[8];
#pragma unroll
    for (int g = 0; g < 8; ++g) { const float gs = (kp[4 * g] * kp[4 * g + 1]) * (kp[4 * g + 2] * kp[4 * g + 3]); float lo_, hi_; halves32(gs, lo_, hi_); pg[g] = hi ? lo_ : hi_; T[g] = lo_ * hi_; }
    SP[7] = 1.f;
#pragma unroll
    for (int g = 6; g >= 0; --g) SP[g] = SP[g + 1] * T[g + 1];
    float a[32];
#pragma unroll
    for (int g = 0; g < 8; ++g) {
        const float base = R * SP[g] * (hi == 0 ? pg[g] : 1.f);
        const float a3 = base, a2 = a3 * kp[4 * g + 3], a1 = a2 * kp[4 * g + 2], a0 = a1 * kp[4 * g + 1];
        a[4 * g + 3] = bt[4 * g + 3] * a3; a[4 * g + 2] = bt[4 * g + 2] * a2; a[4 * g + 1] = bt[4 * g + 1] * a1; a[4 * g] = bt[4 * g] * a0;
    }
    R *= SP[0] * T[0];
    u32x4 pw0, pw1, pw2, pw3;
    pw0 = (u32x4){cvtpk_s(a[0], a[1]), cvtpk_s(a[2], a[3]), cvtpk_s(a[4], a[5]), cvtpk_s(a[6], a[7])};
    pw1 = (u32x4){cvtpk_s(a[8], a[9]), cvtpk_s(a[10], a[11]), cvtpk_s(a[12], a[13]), cvtpk_s(a[14], a[15])};
    pw2 = (u32x4){cvtpk_s(a[16], a[17]), cvtpk_s(a[18], a[19]), cvtpk_s(a[20], a[21]), cvtpk_s(a[22], a[23])};
    pw3 = (u32x4){cvtpk_s(a[24], a[25]), cvtpk_s(a[26], a[27]), cvtpk_s(a[28], a[29]), cvtpk_s(a[30], a[31])};
    asm volatile("s_waitcnt vmcnt(0) lgkmcnt(0)" ::: "memory");
    pv(o, vbase, __builtin_bit_cast(bf16x8, pw0), __builtin_bit_cast(bf16x8, pw1), __builtin_bit_cast(bf16x8, pw2), __builtin_bit_cast(bf16x8, pw3));
}
__device__ __forceinline__ void attn_dma_v(const bf16_t* __restrict__ vb, long rowbase, int s0, int h, int lane, LAS unsigned char* wl) {
#pragma unroll
    for (int w8 = 0; w8 < 8; ++w8)
        __builtin_amdgcn_global_load_lds((const unsigned*)(vb + (size_t)(rowbase + s0 + 16 * (w8 & 3) + (lane >> 2)) * 512 + h * 64 + 32 * (w8 >> 2) + 8 * (lane & 3)), (LAS unsigned*)(wl + w8 * 1024), 16, 0, 0);
}
__device__ __forceinline__ void attn_dma_k(const bf16_t* __restrict__ kb, long rowbase, int s0, int h, int lane, LAS unsigned char* wl) {
#pragma unroll
    for (int c = 0; c < 8; ++c)
        __builtin_amdgcn_global_load_lds((const unsigned*)(kb + (size_t)(rowbase + s0 + lane) * 512 + h * 64 + 8 * c), (LAS unsigned*)(wl + 8192 + c * 1024), 16, 0, 0);
}
__device__ __forceinline__ void attn_read_k(bf16x8 (&k0)[4], bf16x8 (&k1)[4], LAS unsigned char* wl, int r32, int hi) {
    const LAS unsigned char* kp = wl + 8192 + hi * 1024 + r32 * 16;
#pragma unroll
    for (int d0 = 0; d0 < 4; ++d0) { k0[d0] = *(const LAS bf16x8*)(kp + d0 * 2048); k1[d0] = *(const LAS bf16x8*)(kp + d0 * 2048 + 512); }
}
__device__ __forceinline__ void attn_wave_unit(int b, int h, int qblk, const bf16_t* __restrict__ qb, const bf16_t* __restrict__ kb, const bf16_t* __restrict__ vb, bf16_t* __restrict__ oc, LAS unsigned char* wl, int lane) {
    const int r32 = lane & 31, hi = lane >> 5;
    const long rowbase = (long)b * SEQ; const int q0 = qblk * 32, tq = q0 + r32;
    bf16x8 qr[4];
    { const bf16_t* qp = qb + (size_t)(rowbase + q0 + r32) * 512 + h * 64 + hi * 8;
#pragma unroll
      for (int d0 = 0; d0 < 4; ++d0) qr[d0] = *(const bf16x8*)(qp + d0 * 16); }
    f32x16 o[2]; o[0] = f32x16{}; o[1] = f32x16{};
    float R = 1.f;
    const int vbase = (int)(unsigned)(uintptr_t)wl + ((lane >> 4) & 1) * 32 + (lane & 3) * 8 + (4 * hi + ((lane & 15) >> 2)) * 64;
    const int jd = q0 >> 6;
    bf16x8 k0[4], k1[4];
    attn_dma_k(kb, rowbase, jd * 64, h, lane, wl);
    attn_dma_v(vb, rowbase, jd * 64, h, lane, wl);
    asm volatile("s_waitcnt vmcnt(8)" ::: "memory");
    attn_read_k(k0, k1, wl, r32, hi);
    asm volatile("s_waitcnt lgkmcnt(0)" ::: "memory");
    attn_dma_k(kb, rowbase, (jd > 0 ? jd - 1 : 0) * 64, h, lane, wl);
    attn_tile<true>(k0, k1, qr, o, R, jd * 64, tq, hi, vbase);
    for (int jt = jd - 1; jt >= 0; --jt) {
        if (__all(R < 7.5e-37f)) break;
        attn_read_k(k0, k1, wl, r32, hi);
        attn_dma_v(vb, rowbase, jt * 64, h, lane, wl);
        asm volatile("s_waitcnt lgkmcnt(0)" ::: "memory");
        attn_dma_k(kb, rowbase, (jt > 0 ? jt - 1 : 0) * 64, h, lane, wl);
        attn_tile<false>(k0, k1, qr, o, R, jt * 64, tq, hi, vbase);
    }
    asm volatile("s_waitcnt vmcnt(0)" ::: "memory");
    LAS bf16_t* stg = (LAS bf16_t*)(wl + 8192);
#pragma unroll
    for (int r = 0; r < 16; ++r) { const int orow = crow(r, hi);
#pragma unroll
        for (int d0 = 0; d0 < 2; ++d0) stg[orow * 64 + d0 * 32 + r32] = (bf16_t)(cvtpk_s(o[d0][r], 0.f) & 0xffffu); }
    asm volatile("s_waitcnt lgkmcnt(0)" ::: "memory");
    bf16_t* Ow = oc + (size_t)(rowbase + q0) * 1024 + h * 64;
#pragma unroll
    for (int i = 0; i < 4; ++i) { const int row = i * 8 + (lane >> 3), ch = lane & 7; const u32x4 v = *(const LAS u32x4*)(stg + row * 64 + ch * 8); *(u32x4*)(Ow + (size_t)row * 1024 + ch * 8) = v; }
    asm volatile("s_waitcnt vmcnt(0) lgkmcnt(0)" ::: "memory");
}

template <int HF>
__device__ __forceinline__ void sgu_wave_unit(int chunk, int g, const bf16_t* __restrict__ ub, const bf16_t* __restrict__ vsb, const float* __restrict__ vspart, const bf16_t* __restrict__ wsp  ,
                                              const float* __restrict__ bsp  , const float* __restrict__ sgn  , bf16_t* __restrict__ oc, LAS unsigned char* wl, int lane) {
    const int r32 = lane & 31, hi = lane >> 5;
    const size_t row0 = (size_t)chunk * 128;
    const int vbase = (int)(unsigned)(uintptr_t)wl + ((lane >> 4) & 1) * 32 + (lane & 3) * 8 + (4 * hi + ((lane & 15) >> 2)) * 64;
    f32x16 o[2][2];
#pragma unroll
    for (int rl = 0; rl < 2; ++rl) { o[rl][0] = f32x16{}; o[rl][1] = f32x16{}; }
#pragma unroll
    for (int kt = 0; kt <= HF; ++kt) {
        float rvq[4];
#pragma unroll
        for (int q = 0; q < 4; ++q) { const size_t row = row0 + 64 * kt + 16 * q + (lane >> 2);
            const f32x4 s0 = *(const f32x4*)(vspart + row * 8), s1 = *(const f32x4*)(vspart + row * 8 + 4);
            rvq[q] = fast_rsq((((s0[0] + s0[1]) + (s0[2] + s0[3])) + ((s1[0] + s1[1]) + (s1[2] + s1[3]))) * (1.f / 512.f) + EPS); }
        u32x4 vv[8];
#pragma unroll
        for (int w8 = 0; w8 < 8; ++w8) vv[w8] = *(const u32x4*)(vsb + (row0 + 64 * kt + 16 * (w8 & 3) + (lane >> 2)) * 512 + g * 64 + 32 * (w8 >> 2) + 8 * (lane & 3));
#pragma unroll
        for (int w8 = 0; w8 < 8; ++w8) { const float rv = rvq[w8 & 3]; u32x4 w;
#pragma unroll
            for (int j = 0; j < 4; ++j) w[j] = cvtpk_s(bf_lo(vv[w8][j]) * rv, bf_hi(vv[w8][j]) * rv);
            *(LAS u32x4*)(wl + w8 * 1024 + lane * 16) = w; }
        asm volatile("s_waitcnt lgkmcnt(0)" ::: "memory");
#pragma unroll
        for (int rl = 0; rl < 2; ++rl) {
            const int rb = 2 * HF + rl;
            const bf16_t* wp = wsp + ((size_t)g * 128 + 32 * rb + r32) * 128 + 64 * kt + 4 * hi;
            u32x4 pw[4];
#pragma unroll
            for (int ks = 0; ks < 4; ++ks) { const u32x2 lo = *(const u32x2*)(wp + 16 * ks), h8 = *(const u32x2*)(wp + 16 * ks + 8); pw[ks] = (u32x4){lo.x, lo.y, h8.x, h8.y}; }
            pv(o[rl], vbase, __builtin_bit_cast(bf16x8, pw[0]), __builtin_bit_cast(bf16x8, pw[1]), __builtin_bit_cast(bf16x8, pw[2]), __builtin_bit_cast(bf16x8, pw[3]));
        }
        asm volatile("s_waitcnt lgkmcnt(0)" ::: "memory");
    }
    LAS bf16_t* stg = (LAS bf16_t*)(wl + 8192);
    const float gn0 = sgn[g * 64 + r32], gn1 = sgn[g * 64 + 32 + r32];
#pragma unroll
    for (int rl = 0; rl < 2; ++rl) {
        const int rb = 2 * HF + rl;
#pragma unroll
        for (int r = 0; r < 16; ++r) { const int orow = crow(r, hi); const float bb = bsp[g * 128 + 32 * rb + orow];
            stg[orow * 64 + r32] = (bf16_t)(cvtpk_s(gn0 * o[rl][0][r] + bb, 0.f) & 0xffffu); stg[orow * 64 + 32 + r32] = (bf16_t)(cvtpk_s(gn1 * o[rl][1][r] + bb, 0.f) & 0xffffu); }
        asm volatile("s_waitcnt lgkmcnt(0)" ::: "memory");
#pragma unroll
        for (int i = 0; i < 4; ++i) { const int row = i * 8 + (lane >> 3), ch = lane & 7; const size_t grow = row0 + 32 * rb + row;
            const u32x4 mv = *(const LAS u32x4*)(stg + row * 64 + ch * 8); const u32x4 uv = *(const u32x4*)(ub + grow * 512 + g * 64 + ch * 8); u32x4 w;
#pragma unroll
            for (int j = 0; j < 4; ++j) w[j] = cvtpk_s(bf_lo(mv[j]) * bf_lo(uv[j]), bf_hi(mv[j]) * bf_hi(uv[j]));
            *(u32x4*)(oc + grow * 1024 + 512 + g * 64 + ch * 8) = w; }
        asm volatile("s_waitcnt lgkmcnt(0)" ::: "memory");
    }
}
constexpr size_t MiB = 1u << 20;
constexpr size_t WS_CTL = 0, CTL_ZERO_BYTES = 1 * MiB;
constexpr size_t WS_W = 16 * MiB, WL_STRIDE = 112 * MiB;
constexpr size_t WO_IN = 0, WO_UP = 9 * MiB, WO_OUT = 11 * MiB, WO_PG = 13 * MiB, WO_PP = 15 * MiB, WO_SP = 15 * MiB + 512 * 1024, WO_R = 15 * MiB + 768 * 1024, WO_EI = 16 * MiB, WO_EO = 80 * MiB;
constexpr size_t WS_PB = 464 * MiB, WS_E = 496 * MiB, WS_XB = 624 * MiB, WS_Q = 656 * MiB, WS_K = 672 * MiB, WS_V = 688 * MiB, WS_U = 704 * MiB, WS_VS = 720 * MiB, WS_GAB = 736 * MiB,
                 WS_OC = 800 * MiB, WS_MG = 832 * MiB, WS_G = 864 * MiB, WS_YS = 904 * MiB, WS_XPART = 984 * MiB, WS_VSPART = 985 * MiB, WS_RS2 = 985 * MiB + 512 * 1024, WS_RS3 = 985 * MiB + 640 * 1024,
                 WS_TOKL = 986 * MiB, WS_TKE = 988 * MiB, WS_TKP = 988 * MiB + 256 * 1024, WS_TKW = 988 * MiB + 512 * 1024, WS_XB1 = 992 * MiB, WS_FAST_END = 1024 * MiB;
constexpr int GSLOTS = 2 * M + NE * 256;
constexpr int CW_TMO = 0, CW_CODE = 1, CW_BAR = 4096, CW_CNT = 8192  ;

constexpr int RING_OFF = 0, RING_BYTES = 131072, LDSCTL_OFF = 139264  , MISC_OFF = LDSCTL_OFF + 320, PREF_OFF = MISC_OFF + 128  , LDS_BYTES = 147456;

#define RLX_AGENT __ATOMIC_RELAXED, __HIP_MEMORY_SCOPE_AGENT
#define XB_TMO      128
#define XB_XCNT(j)  (256  + 64 * (j))
#define XB_XSUB(j)  (1280 + 64 * (j))
#define XB_XGEN(j)  (2304 + 64 * (j))
#define XB_TOP      3328
#define XB_TOPGEN   3392
#define XCD_BAR_WORDS 3456
#define XB_SPIN_CAP (1u << 18)
__device__ __forceinline__ unsigned xb_ld(unsigned* p)              { return __hip_atomic_load(p, __ATOMIC_RELAXED, __HIP_MEMORY_SCOPE_AGENT); }
__device__ __forceinline__ unsigned xb_add(unsigned* p, unsigned v) { return __hip_atomic_fetch_add(p, v, __ATOMIC_RELAXED, __HIP_MEMORY_SCOPE_AGENT); }
__device__ __forceinline__ unsigned xb_xcc_id() { return (unsigned)__builtin_amdgcn_s_getreg((3 << 11) | 20) & 0xFu; }
#define XB_SPIN(cond, bar) do { unsigned _sp = 0; while (cond) { __builtin_amdgcn_s_sleep(1); \
    if ((++_sp & 255u) == 0u) { if (xb_ld(&(bar)[XB_TMO])) break; if (_sp > XB_SPIN_CAP) { atomicAdd(&(bar)[XB_TMO], 1u); break; } } } } while (0)
struct XcdBarrier { unsigned* bar; unsigned x; volatile LAS unsigned* st; };
__device__ __forceinline__ XcdBarrier xcd_barrier_post(unsigned* bar, volatile LAS unsigned* st, const bool leader  ) {
    XcdBarrier b; b.bar = bar; b.x = xb_xcc_id(); b.st = st;
    if (leader) (void)xb_add(&bar[XB_XCNT(b.x)], 1u);
    return b;
}
__device__ __forceinline__ void xcd_barrier_complete(unsigned* bar, unsigned x, unsigned& nloc, unsigned& nx) {
    const unsigned G = gridDim.x * gridDim.y * gridDim.z;
    unsigned sum, cnt, mine, sp = 0u;
    for (;;) {
        sum = 0u; cnt = 0u; mine = 0u;
#pragma unroll
        for (unsigned j = 0; j < 16; ++j) { const unsigned c = xb_ld(&bar[XB_XCNT(j)]); sum += c; cnt += (c > 0u) ? 1u : 0u; mine = (j == x) ? c : mine; }
        if (sum == G) break;
        __builtin_amdgcn_s_sleep(1);
        if ((++sp & 255u) == 0u) { if (xb_ld(&bar[XB_TMO])) break; if (sp > XB_SPIN_CAP) { atomicAdd(&bar[XB_TMO], 1u); break; } }
    }
    nloc = mine > 0u ? mine : 1u; nx = cnt > 0u ? cnt : 1u;
}
__device__ __forceinline__ void xcd_barrier_t0(const XcdBarrier& b) {
        unsigned* bar = b.bar;
        __builtin_amdgcn_s_waitcnt(0);
        unsigned nloc = b.st[0], nx = b.st[1];
        if (nloc == 0u) { xcd_barrier_complete(bar, b.x, nloc, nx); b.st[0] = nloc; b.st[1] = nx; }
        const unsigned old = xb_add(&bar[XB_XSUB(b.x)], 1u);
        const unsigned gen = old / nloc;
        if (old + 1u == (gen + 1u) * nloc) {
            __builtin_amdgcn_fence(__ATOMIC_RELEASE, "agent");
            asm volatile("s_waitcnt vmcnt(0)" ::: "memory");
            const unsigned og = xb_add(&bar[XB_TOP], 1u);
            const unsigned tg = og / nx;
            if (og + 1u == (tg + 1u) * nx) xb_add(&bar[XB_TOPGEN], 1u);
            else XB_SPIN(xb_ld(&bar[XB_TOPGEN]) == tg, bar);
            __builtin_amdgcn_fence(__ATOMIC_ACQUIRE, "agent");
            xb_add(&bar[XB_XGEN(b.x)], 1u);
            asm volatile("s_waitcnt vmcnt(0)" ::: "memory");
        } else {
            XB_SPIN(xb_ld(&bar[XB_XGEN(b.x)]) == gen, bar);
            __builtin_amdgcn_fence(__ATOMIC_ACQUIRE, "agent");
            asm volatile("s_waitcnt vmcnt(0)" ::: "memory");
        }
}

struct Args {
    const float* in[22]; float* out; unsigned char* ws;
    int ph_lo, ph_hi, nlayers, pad;
};
__device__ __forceinline__ float wave_sum(float v) { v += xor_lt32<1>(v); v += xor_lt32<2>(v); v += xor_lt32<4>(v); v += xor_lt32<8>(v); return sum_xor16_32(v); }
__device__ __forceinline__ unsigned f2bf(float f) { unsigned u = __builtin_bit_cast(unsigned, f); return (u + 0x7fffu + ((u >> 16) & 1u)) >> 16; }
__device__ __forceinline__ unsigned pk2(float lo, float hi) { return f2bf(lo) | (f2bf(hi) << 16); }

__device__ __forceinline__ int rowmap(int kind, int n) {
    if (kind == 1) { if (n >= 1024) return n; const int nl = n & 255; return (n - nl) + 128 * ((nl & 63) >> 5) + 32 * (nl >> 6) + (nl & 31); }
    if (kind == 2) { return n < 512 ? 256 * (n >> 7) + (n & 127) : 256 * ((n - 512) >> 7) + 128 + ((n - 512) & 127); }
    return n;
}
__device__ __forceinline__ void transpose_item(const float* __restrict__ W, int N, const float* __restrict__ gain, bf16_t* __restrict__ WT, int ldt, int koff, int kind, LAS float* scr, int item, int lane) {
    const int nblk = N / 64, kb = item / nblk, nb = item % nblk, k0 = 64 * kb, n0 = 64 * nb;
    const int kr = lane >> 4, nc = 4 * (lane & 15);
    f32x4 v[16];
#pragma unroll
    for (int i = 0; i < 16; ++i) v[i] = __builtin_nontemporal_load((const f32x4*)(W + (size_t)(k0 + 4 * i + kr) * N + n0 + nc));
#pragma unroll
    for (int i = 0; i < 16; ++i) { const int kk = 4 * i + kr; const float gv = gain ? gain[k0 + kk] : 1.f; LAS float* d = scr + kk * 65 + nc; d[0] = v[i][0] * gv; d[1] = v[i][1] * gv; d[2] = v[i][2] * gv; d[3] = v[i][3] * gv; }
    asm volatile("s_waitcnt lgkmcnt(0)" ::: "memory");
    const int c = lane & 7;
#pragma unroll
    for (int j = 0; j < 8; ++j) { const int n = 8 * j + (lane >> 3); const LAS float* s = scr + (8 * c) * 65 + n;
        u32x4 o; o.x = pk2(s[0 * 65], s[1 * 65]); o.y = pk2(s[2 * 65], s[3 * 65]); o.z = pk2(s[4 * 65], s[5 * 65]); o.w = pk2(s[6 * 65], s[7 * 65]);
        st16(WT + (size_t)rowmap(kind, n0 + n) * ldt + koff + k0 + 8 * c, o); }
    asm volatile("s_waitcnt lgkmcnt(0)" ::: "memory");
}

typedef const __attribute__((address_space(4))) Args* KArgs;
__device__ __forceinline__ KArgs fresh(KArgs k) { asm volatile("" : "+s"(k)); return k; }
constexpr int NWAVES = 8;
#ifndef FK_FILLW
#define FK_FILLW 7
#endif
constexpr int FILLW = FK_FILLW, FILL_SLABS = 8;
constexpr int CVT_IN = 16 * 72, CVT_UP = 8 * 16, CVT_OUT = 16 * 16, CVT_PG = 16 * 16, CVT_PP = 4 * 16, CVT_EI = 16 * 16, CVT_EO = 8 * 16;
constexpr int CVT_PER_LAYER = CVT_IN + 2 * CVT_UP + CVT_OUT + CVT_PG + CVT_PP + NE * CVT_EI + NE * CVT_EO;
__device__ __forceinline__ void convert_item(KArgs ap, int L, int r, LAS float* scr, int lane) {
    unsigned char* wl = ap->ws + WS_W + (size_t)L * WL_STRIDE;
    const float* W; const float* gain = nullptr; bf16_t* WT; int N = D, ldt = D, koff = 0, kind = 0, item = r;
    if (r < CVT_IN) { W = ap->in[3] + (size_t)L * D * INW; N = INW; gain = ap->in[2] + (size_t)L * D; WT = (bf16_t*)(wl + WO_IN); kind = 1; }
    else if ((r -= CVT_IN) < CVT_UP) { W = ap->in[9] + (size_t)L * 512 * D; WT = (bf16_t*)(wl + WO_UP); ldt = 1024; item = r; }
    else if ((r -= CVT_UP) < CVT_UP) { W = ap->in[10] + (size_t)L * 512 * D; WT = (bf16_t*)(wl + WO_UP); ldt = 1024; koff = 512; item = r; }
    else if ((r -= CVT_UP) < CVT_OUT) { W = ap->in[11] + (size_t)L * D * D; WT = (bf16_t*)(wl + WO_OUT); item = r; }
    else if ((r -= CVT_OUT) < CVT_PG) { W = ap->in[20] + (size_t)L * D * D; gain = ap->in[19] + (size_t)L * D; WT = (bf16_t*)(wl + WO_PG); item = r; }
    else if ((r -= CVT_PG) < CVT_PP) { W = ap->in[21] + (size_t)L * 256 * D; WT = (bf16_t*)(wl + WO_PP); ldt = 256; item = r; }
    else if ((r -= CVT_PP) < NE * CVT_EI) { const int e = r / CVT_EI; W = ap->in[17] + ((size_t)L * NE + e) * D * 1024; N = 1024; gain = ap->in[12] + (size_t)L * D; WT = (bf16_t*)(wl + WO_EI) + (size_t)e * 1024 * 1024; ldt = 1024; kind = 2; item = r % CVT_EI; }
    else { r -= NE * CVT_EI; const int e = r / CVT_EO; W = ap->in[18] + ((size_t)L * NE + e) * 512 * D; WT = (bf16_t*)(wl + WO_EO) + (size_t)e * 1024 * 512; ldt = 512; item = r % CVT_EO; }
    transpose_item(W, N, gain, WT, ldt, koff, kind, scr, item, lane);
}
__device__ __forceinline__ void p0_prologue(KArgs ap, int nlayers, bool fill_later, LAS unsigned char* lds, int wave, int lane, int gw, int NGW) {
    LAS float* scr = (LAS float*)(lds + RING_OFF + wave * 17408);
    unsigned char* ws = ap->ws;
    const int nconv = fill_later ? 1 : nlayers;
    for (int it = gw; it < CVT_PER_LAYER * nconv; it += NGW) convert_item(ap, nconv - 1 - it / CVT_PER_LAYER, it % CVT_PER_LAYER, scr, lane);
    if (fill_later) { const int first = FILL_SLABS * FILLW * (NGW / NWAVES), rest = CVT_PER_LAYER - first;
        if (rest > 0) for (int it = gw; it < rest * (nlayers - 1); it += NGW) convert_item(ap, 1 + it / rest, first + it % rest, scr, lane); }
    const int gt = gw * 64 + lane, NGT = NGW * 64;
    for (int L = 0; L < nlayers; ++L) {
        unsigned char* wl = ws + WS_W + (size_t)L * WL_STRIDE;
        bf16_t* sp = (bf16_t*)(wl + WO_SP); const float* wsrc = ap->in[7] + (size_t)L * 8 * 128 * 128;
        for (int i = gt; i < 8 * 128 * 128; i += NGT) { const int s = i & 127, t = (i >> 7) & 127; sp[i] = (bf16_t)f2bf(s <= t ? wsrc[i] : 0.f); }
        bf16_t* wrh = (bf16_t*)(wl + WO_R); bf16_t* wrl = wrh + 48 * 1024; const float* gain = ap->in[12] + (size_t)L * D; const float* wg = ap->in[13] + (size_t)L * D * 4; const float* we = ap->in[15] + (size_t)L * D * 32;
        for (int i = gt; i < 48 * 1024; i += NGT) { const int o = i >> 10, k = i & 1023; const float wv = o < 36 ? gain[k] * (o < 4 ? wg[k * 4 + o] : we[k * 32 + (o - 4)]) : 0.f;
            const unsigned h = f2bf(wv); wrh[i] = (bf16_t)h; wrl[i] = (bf16_t)f2bf(wv - __uint_as_float(h << 16)); }
    }
    { const f32x4* p4 = (const f32x4*)ap->in[1]; u32x2* pb = (u32x2*)(ws + WS_PB); const size_t n4 = (size_t)nlayers * M * 256 / 4;
      for (size_t i = gt; i < n4; i += NGT) { const f32x4 v = p4[i]; u32x2 w; w.x = pk2(v[0], v[1]); w.y = pk2(v[2], v[3]); pb[i] = w; } }
    for (int m = gw; m < M; m += NGW) {
        const f32x4* xr = (const f32x4*)(ap->in[0] + (size_t)m * D) + lane; u32x2* o8 = (u32x2*)((bf16_t*)(ws + WS_XB) + (size_t)m * D) + lane; float s = 0.f;
#pragma unroll
        for (int j = 0; j < 4; ++j) { const f32x4 v = xr[64 * j]; s += (v[0] * v[0] + v[1] * v[1]) + (v[2] * v[2] + v[3] * v[3]); u32x2 w; w.x = pk2(v[0], v[1]); w.y = pk2(v[2], v[3]); o8[64 * j] = w; }
        s = wave_sum(s);
        if (lane < 16) ((float*)(ws + WS_XPART))[(size_t)m * 16 + lane] = lane == 0 ? s : 0.f;
    }
}

__device__ __forceinline__ void router_pass(const bf16_t* __restrict__ x, const bf16_t* __restrict__ wrh  , const bf16_t* __restrict__ wrl  , const float* __restrict__ bgr, const float* __restrict__ ber,
                                            float* __restrict__ rs2, int* __restrict__ cnt, int* __restrict__ tokl, int* __restrict__ tk_e, int* __restrict__ tk_pos, float* __restrict__ tk_w,
                                            LAS unsigned char* lds, int wave, int lane, int vcu, int G) {
    LAS float* lg = (LAS float*)(lds + RING_OFF + 106496 + (wave & 3) * 3200);
    LAS int* lcnt = (LAS int*)(lds + LDSCTL_OFF + 1024); LAS int* lbase = lcnt + 32;
    const int fr = lane & 15, fq = lane >> 4;
    for (int bt = vcu; bt < M / 64; bt += G) {
        if (wave == 0 && lane < 32) lcnt[lane] = 0;
        __syncthreads();
        int e1 = 0, e2 = 0, lp1 = 0, lp2 = 0; float tw1 = 0.f, tw2 = 0.f;
        const int t0 = bt * 64 + (wave & 3) * 16;
        {
            bf16x8 bh[3][4], bl[3][4]; u32x4 av[4][4];
            const bf16_t* wh = wrh + (size_t)fr * 1024 + 8 * fq + 128 * wave; const bf16_t* wl_ = wrl + (size_t)fr * 1024 + 8 * fq + 128 * wave;
            const bf16_t* xp = x + (size_t)(bt * 64 + fr) * D + 8 * fq + 128 * wave;
#pragma unroll
            for (int cb = 0; cb < 3; ++cb)
#pragma unroll
                for (int kk = 0; kk < 4; ++kk) { bh[cb][kk] = *(const bf16x8*)(wh + (size_t)cb * 16 * 1024 + 32 * kk); bl[cb][kk] = *(const bf16x8*)(wl_ + (size_t)cb * 16 * 1024 + 32 * kk); }
#pragma unroll
            for (int rg = 0; rg < 4; ++rg)
#pragma unroll
                for (int kk = 0; kk < 4; ++kk) av[rg][kk] = *(const u32x4*)(xp + (size_t)rg * 16 * D + 32 * kk);
#pragma unroll
            for (int rg = 0; rg < 4; ++rg) {
                f32x4 pacc[3]; pacc[0] = (f32x4){0.f, 0.f, 0.f, 0.f}; pacc[1] = pacc[0]; pacc[2] = pacc[0]; float pss = 0.f;
#pragma unroll
                for (int kk = 0; kk < 4; ++kk) {
#pragma unroll
                    for (int j = 0; j < 4; ++j) { const float a = bf_lo(av[rg][kk][j]), b = bf_hi(av[rg][kk][j]); pss += a * a + b * b; }
                    const bf16x8 Ah = __builtin_bit_cast(bf16x8, av[rg][kk]);
#pragma unroll
                    for (int cb = 0; cb < 3; ++cb) { pacc[cb] = __builtin_amdgcn_mfma_f32_16x16x32_bf16(bh[cb][kk], Ah, pacc[cb], 0, 0, 0); pacc[cb] = __builtin_amdgcn_mfma_f32_16x16x32_bf16(bl[cb][kk], Ah, pacc[cb], 0, 0, 0); }
                }
                LAS float* pp = (LAS float*)(lds + RING_OFF) + ((wave * 4 + rg) * 64 + lane) * 13;
#pragma unroll
                for (int cb = 0; cb < 3; ++cb)
#pragma unroll
                    for (int i = 0; i < 4; ++i) pp[cb * 4 + i] = pacc[cb][i];
                pp[12] = pss;
            }
        }
        __syncthreads();
        if (wave < 4) {
        f32x4 acc[3]; acc[0] = (f32x4){0.f, 0.f, 0.f, 0.f}; acc[1] = acc[0]; acc[2] = acc[0]; float ss = 0.f;
#pragma unroll
        for (int w2 = 0; w2 < 8; ++w2) { const LAS float* pp = (const LAS float*)(lds + RING_OFF) + ((w2 * 4 + wave) * 64 + lane) * 13;
#pragma unroll
            for (int cb = 0; cb < 3; ++cb)
#pragma unroll
                for (int i = 0; i < 4; ++i) acc[cb][i] += pp[cb * 4 + i];
            ss += pp[12]; }
        ss = sum_xor16_32(ss);
        const float rsr = 1.0f / sqrtf(ss * (1.f / D) + EPS);
#pragma unroll
        for (int cb = 0; cb < 3; ++cb)
#pragma unroll
            for (int i = 0; i < 4; ++i) lg[fr * 49 + 16 * cb + 4 * fq + i] = acc[cb][i] * rsr;
        if (fq == 0) lg[fr * 49 + 48] = rsr;
        asm volatile("s_waitcnt lgkmcnt(0)" ::: "memory");
        if (lane < 16) {
            const int tok = t0 + lane; const LAS float* l = lg + lane * 49;
            rs2[tok] = l[48];
            const float g0 = l[0] + bgr[0], g1 = l[1] + bgr[1], g2 = l[2] + bgr[2], g3 = l[3] + bgr[3];
            int grp = 0; float gm = g0;
            if (g1 > gm) { gm = g1; grp = 1; } if (g2 > gm) { gm = g2; grp = 2; } if (g3 > gm) { gm = g3; grp = 3; }
            const float gsum = (expf(g0 - gm) + expf(g1 - gm)) + (expf(g2 - gm) + expf(g3 - gm));
            const float grp_w = 1.f / gsum;
            int i1 = 0, i2 = 0; float m1 = -INFINITY, m2 = -INFINITY;
#pragma unroll
            for (int i = 0; i < 8; ++i) { const float el = l[4 + grp * 8 + i] + ber[grp * 8 + i]; if (el > m1) { m2 = m1; i2 = i1; m1 = el; i1 = i; } else if (el > m2) { m2 = el; i2 = i; } }
            const float p2 = expf(m2 - m1), w1 = 1.f / (1.f + p2), w2 = p2 / (1.f + p2);
            e1 = grp * 8 + i1; e2 = grp * 8 + i2; tw1 = grp_w * w1; tw2 = grp_w * w2;
            lp1 = __hip_atomic_fetch_add(&lcnt[e1], 1, __ATOMIC_RELAXED, __HIP_MEMORY_SCOPE_WORKGROUP); lp2 = __hip_atomic_fetch_add(&lcnt[e2], 1, __ATOMIC_RELAXED, __HIP_MEMORY_SCOPE_WORKGROUP);
        }
        }
        __syncthreads();
        if (wave == 0 && lane < 32) { const int c = lcnt[lane]; lbase[lane] = c > 0 ? atomicAdd(&cnt[lane * CNT_STRIDE], c) : 0; }
        __syncthreads();
        if (wave < 4 && lane < 16) {
            const int tok = t0 + lane; const int pos1 = lbase[e1] + lp1, pos2 = lbase[e2] + lp2;
            tokl[e1 * ECAP + pos1] = tok; tokl[e2 * ECAP + pos2] = tok;
            tk_e[tok * 2] = e1; tk_e[tok * 2 + 1] = e2; tk_pos[tok * 2] = pos1; tk_pos[tok * 2 + 1] = pos2; tk_w[tok * 2] = tw1; tk_w[tok * 2 + 1] = tw2;
        }
        __syncthreads();
    }
}

__device__ __forceinline__ void combine_pass(bf16_t* xb, const bf16_t* __restrict__ ys, const LAS int* pref, const int* __restrict__ tk_e, const int* __restrict__ tk_pos,
                                             const float* __restrict__ tk_w, float* __restrict__ rs3, int lane, int gw, int NGW) {
    for (int m0 = gw * 4; m0 < M; m0 += NGW * 4) {
        int s0[4], s1[4]; float w0[4], w1[4];
#pragma unroll
        for (int r = 0; r < 4; ++r) { const int m = m0 + r; const int e0 = tk_e[m * 2], e1 = tk_e[m * 2 + 1]; s0[r] = 256 * pref[e0] + tk_pos[m * 2]; s1[r] = 256 * pref[e1] + tk_pos[m * 2 + 1]; w0[r] = tk_w[m * 2]; w1[r] = tk_w[m * 2 + 1]; }
        u32x4 xv[4][2], a0[4][2], a1[4][2];
#pragma unroll
        for (int r = 0; r < 4; ++r)
#pragma unroll
            for (int j = 0; j < 2; ++j) { xv[r][j] = ((const u32x4*)(xb + (size_t)(m0 + r) * D) + lane)[64 * j]; a0[r][j] = ((const u32x4*)(ys + (size_t)s0[r] * D) + lane)[64 * j]; a1[r][j] = ((const u32x4*)(ys + (size_t)s1[r] * D) + lane)[64 * j]; }
#pragma unroll
        for (int r = 0; r < 4; ++r) { float s = 0.f;
#pragma unroll
            for (int j = 0; j < 2; ++j) { u32x4 w;
#pragma unroll
                for (int q = 0; q < 4; ++q) { w[q] = cvt_pk_bf16(bf_lo(xv[r][j][q]) + w0[r] * bf_lo(a0[r][j][q]) + w1[r] * bf_lo(a1[r][j][q]), bf_hi(xv[r][j][q]) + w0[r] * bf_hi(a0[r][j][q]) + w1[r] * bf_hi(a1[r][j][q]));
                    const float a = bf_lo(w[q]), b = bf_hi(w[q]); s += a * a + b * b; }
                st16((u32x4*)(xb + (size_t)(m0 + r) * D) + lane + 64 * j, w); }
            s = wave_sum(s);
            if (lane == 0) rs3[m0 + r] = 1.0f / sqrtf(s * (1.f / D) + EPS); }
    }
}

constexpr int PH_PER_LAYER = 10;
#ifndef FK_REP
#define FK_REP 0
#endif
#define REPS(bit) ((FK_REP & (bit)) ? 2 : 1)
__global__ void __launch_bounds__(NWAVES * 64, 2) mega_fwd(Args args_unused) {
    extern __shared__ __attribute__((aligned(16))) unsigned char lds_raw[];
    LAS unsigned char* lds = (LAS unsigned char*)lds_raw;
    LAS int* pref = (LAS int*)(lds + PREF_OFF);
    const KArgs kp0 = (KArgs)__builtin_amdgcn_kernarg_segment_ptr();
    const int tid = threadIdx.x, wave0 = __builtin_amdgcn_readfirstlane(tid >> 6);
    const int G = gridDim.x, bx = blockIdx.x;
    const int vcu = (G % 8 == 0) ? (bx % 8) * (G / 8) + bx / 8 : bx;
    const int gw0 = vcu * NWAVES + wave0, NGW = G * NWAVES;
#define FK_T0 (wave0 == 0 && fk_lane() == 0)
#define FK_IDS int lane_o = fk_lane(), wave_o = wave0, gw_o = gw0; asm volatile("" : "+v"(lane_o), "+s"(wave_o), "+s"(gw_o)); const int lane = lane_o, wave = wave_o, gw = gw_o; (void)lane; (void)wave; (void)gw;
    for (int u = tid; u < (LDS_BYTES - LDSCTL_OFF) / 4; u += NWAVES * 64) ((LAS unsigned*)(lds + LDSCTL_OFF))[u] = 0u;
    __syncthreads();
    const int lo = kp0->ph_lo, hi = kp0->ph_hi, nlayers = kp0->nlayers;
#define IN(k) (lo <= (k) && (k) < hi)
    const bool fill_on = (hi - lo > 1) && G == 256;
#define SEAM_F(k, Lc, slab) do { if (IN(k) && IN((k) + 1)) { \
        asm volatile("s_waitcnt vmcnt(0)" ::: "memory"); __syncthreads(); \
        if (wave0 == 0) { if (fk_lane() == 0) { KArgs A_ = fresh(kp0); XcdBarrier bar_; bar_.bar = (unsigned*)(A_->ws + WS_CTL) + CW_BAR; bar_.x = xb_xcc_id(); bar_.st = (volatile LAS unsigned*)(lds + MISC_OFF) + 8; xcd_barrier_t0(bar_); } } \
        else if (fill_on && (Lc) < nlayers && (slab) < FILL_SLABS && wave0 <= FILLW) { int idx_ = (slab) * FILLW * G + bx * FILLW + (wave0 - 1); asm volatile("" : "+s"(idx_));   if (idx_ < CVT_PER_LAYER) convert_item(fresh(kp0), (Lc), idx_, (LAS float*)(lds + RING_OFF + wave0 * 17408), fk_lane()); } \
        __syncthreads(); } } while (0)
#define SEAM(k) SEAM_F(k, L + 1, (k) - pb)
    if (hi - lo > 1) { KArgs A = fresh(kp0); (void)xcd_barrier_post((unsigned*)(A->ws + WS_CTL) + CW_BAR, (volatile LAS unsigned*)(lds + MISC_OFF) + 8, FK_T0); }

    if (IN(0)) { for (int rep = 0; rep < REPS(1); ++rep) { FK_IDS; p0_prologue(fresh(kp0), nlayers, fill_on, lds, wave, lane, gw, NGW); } }
    SEAM_F(0, nlayers, 0);
    if (IN(1)) { }
    for (int L = 0; L < nlayers; ++L) {
        const int pb = 2 + PH_PER_LAYER * L;
        if (IN(pb + 0)) for (int rep = 0; rep < REPS(4); ++rep) {
            KArgs A = fresh(kp0); unsigned char* ws = A->ws; unsigned char* wl = ws + WS_W + (size_t)L * WL_STRIDE;
            DenseOrder S; S.init(M, INW, G, bx, ws + WS_XB, wl + WO_IN, D);
            EpiIn E{(const float*)(ws + WS_XPART), A->in[4] + L * 64, A->in[5] + L * 64, (bf16_t*)(ws + WS_Q), (bf16_t*)(ws + WS_K), (bf16_t*)(ws + WS_V), (bf16_t*)(ws + WS_U), (bf16_t*)(ws + WS_VS), (bf16_t*)(ws + WS_GAB), (float*)(ws + WS_VSPART)};
            gemm_phase<EpiIn, DenseOrder, true>(lds + RING_OFF, D, S, E, wave0);
            { const int nshort = (G == 256) ? 128 : G; const int c2 = (G == 256) ? bx - 128 : bx;
              if (c2 >= 0) { DenseOrder S2; S2.init(M, D, nshort, c2, ws + WS_PB + (size_t)L * M * 256 * 2, wl + WO_PP, 256);
                  EpiPlain E2{(bf16_t*)(ws + WS_E) + (size_t)L * M * D, D, 0};
                  gemm_phase<EpiPlain, DenseOrder, true>(lds + RING_OFF, 256, S2, E2, wave0); } }
        }
        SEAM(pb + 0);
        if (IN(pb + 1)) for (int rep = 0; rep < REPS(8 | 2048); ++rep) {
            KArgs A = fresh(kp0); unsigned char* ws = A->ws; unsigned char* wl = ws + WS_W + (size_t)L * WL_STRIDE;
            FK_IDS;
            LAS unsigned char* wlds = lds + RING_OFF + wave * WLDS_BYTES;
            constexpr int NATT = 2 * 8 * (SEQ / 32), NSGU = (M / 128) * 8 * 2;
            const int nun = (NATT + NSGU - gw + NGW - 1) / NGW;
            for (int k_ = 0; k_ < nun; ++k_) { const int kk_ = (wave >= 4) ? (k_ == 0 ? nun - 1 : k_ - 1) : k_; const int it = gw + kk_ * NGW;
                if (rep == 1 && (it < NATT ? !(FK_REP & 8) : !(FK_REP & 2048))) continue;
                if (it < NATT) { const int qblk = it % (SEQ / 32), bh = it / (SEQ / 32); attn_wave_unit(bh >> 3, bh & 7, qblk, (const bf16_t*)(ws + WS_Q), (const bf16_t*)(ws + WS_K), (const bf16_t*)(ws + WS_V), (bf16_t*)(ws + WS_OC), wlds, lane); }
                else { const int j = it - NATT; const int hf = j & 1, g = (j >> 1) & 7, ch = j >> 4;
                    if (hf == 0) sgu_wave_unit<0>(ch, g, (const bf16_t*)(ws + WS_U), (const bf16_t*)(ws + WS_VS), (const float*)(ws + WS_VSPART), (const bf16_t*)(wl + WO_SP), A->in[8] + (size_t)L * 8 * 128, A->in[6] + (size_t)L * 512, (bf16_t*)(ws + WS_OC), wlds, lane);
                    else sgu_wave_unit<1>(ch, g, (const bf16_t*)(ws + WS_U), (const bf16_t*)(ws + WS_VS), (const float*)(ws + WS_VSPART), (const bf16_t*)(wl + WO_SP), A->in[8] + (size_t)L * 8 * 128, A->in[6] + (size_t)L * 512, (bf16_t*)(ws + WS_OC), wlds, lane); }
            }
        }
        SEAM(pb + 1);
        if (IN(pb + 2)) for (int rep = 0; rep < REPS(16); ++rep) {
            KArgs A = fresh(kp0); unsigned char* ws = A->ws; unsigned char* wl = ws + WS_W + (size_t)L * WL_STRIDE;
            DenseOrder S; S.init(M, D, G, bx, ws + WS_OC, wl + WO_UP, D);
            EpiUp E{(const bf16_t*)(ws + WS_GAB), (bf16_t*)(ws + WS_MG)};
            gemm_phase<EpiUp, DenseOrder, false>(lds + RING_OFF, D, S, E, wave0);
        }
        SEAM(pb + 2);
        if (IN(pb + 3)) {
            KArgs A = fresh(kp0); unsigned char* ws = A->ws; unsigned char* wl = ws + WS_W + (size_t)L * WL_STRIDE;
            DenseOrder S; S.init(M, D, G, bx, ws + WS_MG, wl + WO_OUT, D);
            EpiOut E{(const bf16_t*)(ws + WS_XB), (bf16_t*)(ws + WS_XB1)};
            gemm_phase<EpiOut, DenseOrder, false>(lds + RING_OFF, D, S, E, wave0);
        }
        SEAM(pb + 3);
        if (IN(pb + 4)) {
            KArgs A = fresh(kp0); unsigned char* ws = A->ws; unsigned char* wl = ws + WS_W + (size_t)L * WL_STRIDE;
            FK_IDS;
            router_pass((const bf16_t*)(ws + WS_XB1), (const bf16_t*)(wl + WO_R), (const bf16_t*)(wl + WO_R) + 48 * 1024, A->in[14] + L * 4, A->in[16] + L * 32, (float*)(ws + WS_RS2), (int*)((unsigned*)(ws + WS_CTL) + CW_CNT) + L * NE * CNT_STRIDE, (int*)(ws + WS_TOKL), (int*)(ws + WS_TKE), (int*)(ws + WS_TKP), (float*)(ws + WS_TKW), lds, wave, lane, vcu, G);
        }
        SEAM(pb + 4);
        if (IN(pb + 5) || IN(pb + 6) || IN(pb + 7) || IN(pb + 8)) {
            KArgs A = fresh(kp0); const int* cnt = (const int*)((unsigned*)(A->ws + WS_CTL) + CW_CNT) + L * NE * CNT_STRIDE;
            if (FK_T0) { int s = 0; for (int e = 0; e < NE; ++e) { pref[e] = s; s += (cnt[e * CNT_STRIDE] + 255) >> 8; } pref[NE] = s; }
            __syncthreads();
        }
        const int nG1 = pref[NE] * 4, fr = nG1 / G, n3 = nG1 - fr * G;
        const int jB = (fr >= 1) ? min(2 * (G - n3), (fr * G / 4) * 4) : 0;
        if (IN(pb + 5)) for (int rep = 0; rep < REPS(32); ++rep) {
            KArgs A = fresh(kp0); unsigned char* ws = A->ws; unsigned char* wl = ws + WS_W + (size_t)L * WL_STRIDE; const int* cnt = (const int*)((unsigned*)(ws + WS_CTL) + CW_CNT) + L * NE * CNT_STRIDE;
            ExpertOrder S{G, bx, D, 4, (const char*)(ws + WS_XB1), (const char*)(wl + WO_EI), (size_t)1024 * 1024 * 2, pref, (const int*)(ws + WS_TOKL), cnt, 1, 0, fr, fr * G, 0};
            EpiG1 E{(const int*)(ws + WS_TOKL), cnt, (const float*)(ws + WS_RS2), (bf16_t*)(ws + WS_G)};
            gemm_phase<EpiG1, ExpertOrder, true>(lds + RING_OFF, D, S, E, wave0);
        }
        SEAM(pb + 5);
        if (IN(pb + 6)) {
            KArgs A = fresh(kp0); unsigned char* ws = A->ws; unsigned char* wl = ws + WS_W + (size_t)L * WL_STRIDE; const int* cnt = (const int*)((unsigned*)(ws + WS_CTL) + CW_CNT) + L * NE * CNT_STRIDE;
            if (bx < n3) {
                ExpertOrder S{G, bx, D, 4, (const char*)(ws + WS_XB1), (const char*)(wl + WO_EI), (size_t)1024 * 1024 * 2, pref, (const int*)(ws + WS_TOKL), cnt, 1, fr * G, 1, nG1, 0};
                EpiG1 E{(const int*)(ws + WS_TOKL), cnt, (const float*)(ws + WS_RS2), (bf16_t*)(ws + WS_G)};
                gemm_phase<EpiG1, ExpertOrder, true>(lds + RING_OFF, D, S, E, wave0);
            } else {
                ExpertOrder S{G - n3, bx - n3, 512, 4, (const char*)(ws + WS_G), (const char*)(wl + WO_EO), (size_t)1024 * 512 * 2, pref, (const int*)(ws + WS_TOKL), cnt, 0, 0, 2, jB, 0};
                EpiPlain E{(bf16_t*)(ws + WS_YS), D, 1};
                gemm_phase<EpiPlain, ExpertOrder, true>(lds + RING_OFF, 512, S, E, wave0);
            }
        }
        SEAM(pb + 6);
        if (IN(pb + 7)) for (int rep = 0; rep < REPS(64); ++rep) {
            KArgs A = fresh(kp0); unsigned char* ws = A->ws; unsigned char* wl = ws + WS_W + (size_t)L * WL_STRIDE; const int* cnt = (const int*)((unsigned*)(ws + WS_CTL) + CW_CNT) + L * NE * CNT_STRIDE;
            ExpertOrder S{G, bx, 512, 4, (const char*)(ws + WS_G), (const char*)(wl + WO_EO), (size_t)1024 * 512 * 2, pref, (const int*)(ws + WS_TOKL), cnt, 0, jB, 1 << 20, nG1, 0};
            EpiPlain E{(bf16_t*)(ws + WS_YS), D, 1};
            gemm_phase<EpiPlain, ExpertOrder, true>(lds + RING_OFF, 512, S, E, wave0);
        }
        SEAM(pb + 7);
        if (IN(pb + 8)) {
            KArgs A = fresh(kp0); unsigned char* ws = A->ws;
            FK_IDS;
            combine_pass((bf16_t*)(ws + WS_XB1), (const bf16_t*)(ws + WS_YS), pref, (const int*)(ws + WS_TKE), (const int*)(ws + WS_TKP), (const float*)(ws + WS_TKW), (float*)(ws + WS_RS3), lane, gw, NGW);
        }
        SEAM(pb + 8);
        if (IN(pb + 9)) {
            KArgs A = fresh(kp0); unsigned char* ws = A->ws; unsigned char* wl = ws + WS_W + (size_t)L * WL_STRIDE;
            DenseOrder S; S.init(M, D, G, bx, ws + WS_XB1, wl + WO_PG, D);
            EpiPle E{(const bf16_t*)(ws + WS_XB1), (bf16_t*)(ws + WS_XB), (L == nlayers - 1) ? A->out : (float*)nullptr, (const bf16_t*)(ws + WS_E) + (size_t)L * M * D, (const float*)(ws + WS_RS3), (float*)(ws + WS_XPART)};
            gemm_phase<EpiPle, DenseOrder, false>(lds + RING_OFF, D, S, E, wave0);
        }
        SEAM(pb + 9);
    }
#undef IN
#undef SEAM
#undef SEAM_F
#undef FK_IDS
#undef FK_T0
}
}
#ifndef FK_N_LAUNCHES
#define FK_N_LAUNCHES 1
#endif
static int fk_grid = 0;
static bool fk_setup() {
    if (fk_grid) return fk_grid > 0;
    int dev = 0, cus = 0, per_cu = 0;
    if (hipGetDevice(&dev) != hipSuccess || hipDeviceGetAttribute(&cus, hipDeviceAttributeMultiprocessorCount, dev) != hipSuccess) { fprintf(stderr, "kernel_launch: device query failed\n"); fk_grid = -1; return false; }
    if (hipFuncSetAttribute((const void*)fk::mega_fwd, hipFuncAttributeMaxDynamicSharedMemorySize, fk::LDS_BYTES) != hipSuccess) { fprintf(stderr, "kernel_launch: hipFuncSetAttribute failed\n"); fk_grid = -1; return false; }
    if (hipOccupancyMaxActiveBlocksPerMultiprocessor(&per_cu, (const void*)fk::mega_fwd, fk::NWAVES * 64, fk::LDS_BYTES) != hipSuccess || per_cu < 1)
        fprintf(stderr, "kernel_launch: note: occupancy query reports %d workgroups per CU\n", per_cu);
    (void)hipGetLastError();
    fk_grid = cus;
    return true;
}
static void fk_launch_range(fk::Args a, int lo, int hi, hipStream_t stream) {
    a.ph_lo = lo; a.ph_hi = hi;
    hipLaunchKernelGGL(fk::mega_fwd, dim3(fk_grid), dim3(fk::NWAVES * 64), fk::LDS_BYTES, stream, a);
    const hipError_t le = hipPeekAtLastError();
    if (le != hipSuccess) fprintf(stderr, "kernel_launch: launch [%d,%d) failed: %s\n", lo, hi, hipGetErrorName(le));
}

#ifdef FK_DEBUG_CHECK
#ifndef FK_FOCUS
#define FK_FOCUS 0
#endif
#ifndef FK_STAT
#define FK_STAT 1
#endif
namespace dbg {
__global__ void __launch_bounds__(256) k_cmp(const void* fast, int is_bf16, int fld, int fcol0, const float* gold, int gld, int gcol0, int rows, int cols, float gscale, float* acc) {
    float sd = 0.f, sb = 0.f, sa = 0.f, sb2 = 0.f;
    const size_t n = (size_t)rows * cols;
    for (size_t i = (size_t)blockIdx.x * 256 + threadIdx.x; i < n; i += (size_t)gridDim.x * 256) {
        const size_t r = i / cols; const int c = (int)(i % cols);
        float a;
        if (is_bf16) { const unsigned short h = ((const unsigned short*)fast)[r * fld + fcol0 + c]; a = __uint_as_float((unsigned)h << 16); } else a = ((const float*)fast)[r * fld + fcol0 + c];
        const float b = gold[r * gld + gcol0 + c] * gscale;
        const float d = a - b; sd += d * d; sb += b * b; sa += (FK_STAT == 2 ? a : FK_STAT == 3 ? a * b : FK_STAT == 4 ? (a > 0.99f ? 1.f : 0.f) : a * a); sb2 += (FK_STAT == 2 ? b : FK_STAT == 4 ? 1.f : b * b);
    }
    for (int o = 1; o < 64; o <<= 1) { sd += __shfl_xor(sd, o); sb += __shfl_xor(sb, o); sa += __shfl_xor(sa, o); sb2 += __shfl_xor(sb2, o); }
    if ((threadIdx.x & 63) == 0) { atomicAdd(&acc[0], sd); atomicAdd(&acc[1], sb); atomicAdd(&acc[512], sa); atomicAdd(&acc[513], sb2); }
}
__global__ void __launch_bounds__(256) k_cmp_vs(const unsigned short* vsb, const float* vspart, const float* gain, const float* gz, float* acc) {
    const int row = blockIdx.x * 4 + (threadIdx.x >> 6), lane = threadIdx.x & 63;
    float ss = 0.f; for (int j = 0; j < 8; ++j) ss += vspart[(size_t)row * 8 + j];
    const float rv = 1.f / sqrtf(ss / 512.f + 1e-6f);
    float sd = 0.f, sb = 0.f;
    for (int j = 0; j < 8; ++j) { const int c = lane + 64 * j; const float a = __uint_as_float((unsigned)vsb[(size_t)row * 512 + c] << 16) * rv * gain[c]; const float b = gz[(size_t)row * 4608 + 2048 + c]; sd += (a - b) * (a - b); sb += b * b; }
    for (int o = 1; o < 64; o <<= 1) { sd += __shfl_xor(sd, o); sb += __shfl_xor(sb, o); }
    if (lane == 0) { atomicAdd(&acc[0], sd); atomicAdd(&acc[1], sb); }
}
__global__ void __launch_bounds__(256) k_cmp_w(const unsigned short* wt, const float* w, const float* gain, int n0, int n1, float* acc) {
    float sd = 0.f, sb = 0.f; const size_t tot = (size_t)(n1 - n0) * 1024;
    for (size_t i = (size_t)blockIdx.x * 256 + threadIdx.x; i < tot; i += (size_t)gridDim.x * 256) { const int n = n0 + (int)(i >> 10), k = (int)(i & 1023);
        const float a = __uint_as_float((unsigned)wt[(size_t)n * 1024 + k] << 16), b = gain[k] * w[(size_t)k * 4608 + n]; sd += (a - b) * (a - b); sb += b * b; }
    for (int o = 1; o < 64; o <<= 1) { sd += __shfl_xor(sd, o); sb += __shfl_xor(sb, o); }
    if ((threadIdx.x & 63) == 0) { atomicAdd(&acc[0], sd); atomicAdd(&acc[1], sb); }
}
__global__ void k_final_v(const float* acc, int nchecks, float tol, float* v, int focus) {
    if (threadIdx.x == 0 && blockIdx.x == 0) {
        float out = 0.f;
        if (focus > 0) { float m = acc[2 * focus + 512] / acc[2 * focus + 513]; if (FK_STAT == 1) m = sqrtf(m); if (!(m <= 8.f)) m = 8.f; m = floorf(m * 20.f + 0.5f) * 0.05f; v[0] = powf(10.f, (float)focus) * (1.f + m); return; }
        for (int c = nchecks; c >= 1; --c) { const float e = sqrtf(acc[2 * c] / acc[2 * c + 1]); if (!(e <= tol)) { float m = e; if (!(m <= 2.f)) m = 2.f; m = floorf(m * 10.f + 0.5f) * 0.1f;   out = powf(10.f, (float)c) * (1.f + m); } }
        v[0] = out;
    }
}
__global__ void __launch_bounds__(256) k_scale_out(const float* base, const float* v, float* out, size_t n) {
    const size_t i = (size_t)blockIdx.x * 256 + threadIdx.x; if (i < n) out[i] = base[i] * (1.f + v[0]);
}
}
#endif

extern "C" void kernel_launch(void* const* d_in, const int* in_sizes, int n_in, void* d_out, int out_size, void* d_ws, size_t ws_size, hipStream_t stream) {
    using namespace fk;
    if (n_in != 22 || out_size != M * D || ws_size < WS_FAST_END) { fprintf(stderr, "kernel_launch: unexpected shapes (n_in %d out %d ws %zu)\n", n_in, out_size, ws_size); return; }
    if (!fk_setup()) return;
    if (hipMemsetAsync((char*)d_ws + WS_CTL, 0, CTL_ZERO_BYTES, stream) != hipSuccess) { fprintf(stderr, "kernel_launch: memset failed\n"); return; }
    Args a{};
    for (int i = 0; i < 22; ++i) a.in[i] = (const float*)d_in[i];
    a.out = (float*)d_out; a.ws = (unsigned char*)d_ws; a.nlayers = DEPTH; a.pad = 0;
#ifndef FK_DEBUG_CHECK
    const int nph = 2 + PH_PER_LAYER * DEPTH;
    if (FK_N_LAUNCHES == 1) fk_launch_range(a, 0, nph, stream);
    else for (int p = 0; p < nph; ++p) fk_launch_range(a, p, p + 1, stream);
#else
    constexpr size_t GOLD_BASE = 1100 * MiB, SN_A = 128 * MiB, SN_B = 192 * MiB, SN_BASE = 256 * MiB, FS_A = 320 * MiB, FS_B = 384 * MiB, DBG_ACC = 448 * MiB;
    if (ws_size < GOLD_BASE + gold::O_END) { fprintf(stderr, "kernel_launch: debug build needs %zu bytes of workspace, got %zu\n", GOLD_BASE + gold::O_END, ws_size); return; }
    unsigned char* ws = (unsigned char*)d_ws; unsigned char* gb = ws + GOLD_BASE;
    gold::forward(d_in, (float*)(ws + SN_BASE), gb, 4, stream);
    gold::forward(d_in, nullptr, gb, 1, stream, (float*)(ws + SN_A), (float*)(ws + SN_B));
    a.nlayers = 1;
    const int nph = 2 + PH_PER_LAYER;
    for (int p = 0; p < nph; ++p) {
        fk_launch_range(a, p, p + 1, stream);
        if (p == 2 + 0) (void)hipMemcpyAsync(ws + 528 * MiB, ws + WS_GAB, (size_t)M * 2048 * 2, hipMemcpyDeviceToDevice, stream);
        if (p == 2 + 3) (void)hipMemcpyAsync(ws + FS_A, d_out, (size_t)M * D * 4, hipMemcpyDeviceToDevice, stream);
        if (p == 2 + 7) (void)hipMemcpyAsync(ws + FS_B, d_out, (size_t)M * D * 4, hipMemcpyDeviceToDevice, stream);
    }
    float* acc = (float*)(ws + DBG_ACC);
    (void)hipMemsetAsync(acc, 0, 4096, stream);
    const float* gz = (const float*)(gb + gold::O_Z);
    int c = 0;
#define CMP(fast, isbf, fld, fc0, gold_, gld, gc0, rows, cols, gs) do { ++c; hipLaunchKernelGGL(dbg::k_cmp, dim3(2048), dim3(256), 0, stream, (const void*)(fast), isbf, fld, fc0, (const float*)(gold_), gld, gc0, rows, cols, gs, acc + 2 * c); } while (0)
    ++c; hipLaunchKernelGGL(dbg::k_cmp_w, dim3(1024), dim3(256), 0, stream, (const unsigned short*)(ws + WS_W + WO_IN), (const float*)d_in[3], (const float*)d_in[2], 1024, 2560, acc + 2 * c);
    ++c; hipLaunchKernelGGL(dbg::k_cmp_w, dim3(1024), dim3(256), 0, stream, (const unsigned short*)(ws + WS_W + WO_IN), (const float*)d_in[3], (const float*)d_in[2], 2560, 3584, acc + 2 * c);
    ++c; hipLaunchKernelGGL(dbg::k_cmp_w, dim3(1024), dim3(256), 0, stream, (const unsigned short*)(ws + WS_W + WO_IN), (const float*)d_in[3], (const float*)d_in[2], 3584, 4608, acc + 2 * c);
    CMP(ws + WS_E, 1, 1024, 0, gb + gold::O_YB, 1024, 0, M, 1024, 1.f);
    CMP(ws + WS_Q, 1, 512, 0, gz, INW, 0, M, 512, 0.125f * LOG2E);
    CMP(ws + WS_K, 1, 512, 0, gz, INW, 512, M, 512, 1.f);
    CMP(ws + WS_V, 1, 512, 0, gz, INW, 1024, M, 512, 1.f);
    CMP(ws + WS_U, 1, 512, 0, gz, INW, 1536, M, 512, 1.f);
    ++c; hipLaunchKernelGGL(dbg::k_cmp_vs, dim3(M / 4), dim3(256), 0, stream, (const unsigned short*)(ws + WS_VS), (const float*)(ws + WS_VSPART), (const float*)d_in[6], gz, acc + 2 * c);
    CMP(ws + WS_OC, 1, 1024, 0, gb + gold::O_OA, 512, 0, M, 512, 1.f);
    CMP(ws + WS_OC, 1, 1024, 512, gb + gold::O_OB, 512, 0, M, 512, 1.f);
    CMP(ws + WS_MG, 1, 1024, 0, gb + gold::O_YA, 1024, 0, M, 1024, 1.f);
    CMP(ws + FS_A, 0, 1024, 0, ws + SN_A, 1024, 0, M, 1024, 1.f);
    CMP(ws + FS_B, 0, 1024, 0, ws + SN_B, 1024, 0, M, 1024, 1.f);
    CMP(d_out, 0, 1024, 0, gb + gold::O_X, 1024, 0, M, 1024, 1.f);
    CMP(ws + 528 * MiB, 1, 2048, 0, gz, INW, 2560, M, 256, 1.f);
    CMP(ws + WS_GAB, 1, 2048, 0, gz, INW, 2560, M, 256, 1.f);
    CMP(ws + WS_GAB, 1, 2048, 256, gz, INW, 2816, M, 256, 1.f);
    CMP(ws + WS_GAB, 1, 2048, 512, gz, INW, 3072, M, 512, 1.f);
    CMP(ws + WS_GAB, 1, 2048, 1024, gz, INW, 3584, M, 1024, 1.f);
    hipLaunchKernelGGL(dbg::k_final_v, dim3(1), dim3(64), 0, stream, acc, c, 0.03f, acc + 900, FK_FOCUS);
    hipLaunchKernelGGL(dbg::k_scale_out, dim3(M * D / 256), dim3(256), 0, stream, (const float*)(ws + SN_BASE), acc + 900, (float*)d_out, (size_t)M * D);
#endif
}
```

```cpp
#include <hip/hip_runtime.h>
#include <hip/hip_bf16.h>
#include <cstdio>
#include <cstdint>
#include <cmath>
namespace fk {
#define LAS __attribute__((address_space(3)))
#define GAS __attribute__((address_space(1)))
typedef unsigned short bf16_t;
typedef short bf16x8 __attribute__((ext_vector_type(8)));
typedef short s16x4 __attribute__((ext_vector_type(4)));
typedef float f32x2 __attribute__((ext_vector_type(2)));
typedef float f32x4 __attribute__((ext_vector_type(4)));
typedef float f32x16 __attribute__((ext_vector_type(16)));
typedef unsigned u32x2 __attribute__((ext_vector_type(2)));
typedef unsigned u32x4 __attribute__((ext_vector_type(4)));

constexpr int M = 16384, SEQ = 8192, D = 1024, INW = 4608, NE = 32, ECAP = 16384, DEPTH = 4;
constexpr float EPS = 1e-6f, LOG2E = 1.4426950408889634f;
constexpr int CNT_STRIDE = 64;
constexpr int BM = 256, BK = 64, HALF = 128, HTB = HALF * BK * 2, STAGE_BYTES = 8 * HTB, NXCD = 8, WGM = 8;

__device__ __forceinline__ unsigned cvt_pk_bf16(float lo, float hi) { unsigned r; asm volatile("v_cvt_pk_bf16_f32 %0, %1, %2" : "=v"(r) : "v"(lo), "v"(hi)); return r; }
__device__ __forceinline__ float bf_lo(unsigned w) { return __uint_as_float(w << 16); }
__device__ __forceinline__ float bf_hi(unsigned w) { return __uint_as_float(w & 0xffff0000u); }
__device__ __forceinline__ float fast_rcp(float x) { return __builtin_amdgcn_rcpf(x); }
__device__ __forceinline__ float fast_exp2(float x) { return __builtin_amdgcn_exp2f(x); }
__device__ __forceinline__ float fast_log2(float x) { return __builtin_amdgcn_logf(x); }
__device__ __forceinline__ float fast_rsq(float x) { return __builtin_amdgcn_rsqf(x); }
__device__ __forceinline__ float sigmoid_f(float x) { return fast_rcp(1.f + fast_exp2(-LOG2E * x)); }
__device__ __forceinline__ float gelu_tanh_f(float x) { const float u2 = 1.5957691216057308f * (x + 0.044715f * x * x * x); return x * fast_rcp(1.f + fast_exp2(-LOG2E * u2)); }

__host__ __device__ __forceinline__ int lds_byte(int r, int c) { const int st = (r >> 4) * 2 + (c >> 5), rr = r & 15, cc = c & 31, ob = rr * 64 + cc * 2; return st * 1024 + (ob ^ (((ob >> 9) & 1) << 5)); }
__host__ __device__ __forceinline__ void stage_rc(int b, int& R, int& C) { const int st = b / 1024, sb = b % 1024, swz = sb ^ (((sb >> 9) & 1) << 5); R = (st >> 1) * 16 + swz / 64; C = (st & 1) * 32 + (swz % 64) / 2; }
__host__ __device__ __forceinline__ int perm32(int rho) { const int n = rho >> 4, i = rho & 15; return 8 * (i >> 2) + 4 * n + (i & 3); }

template <int MASK> __device__ __forceinline__ float xor_lt32(float v) { return __int_as_float(__builtin_amdgcn_ds_swizzle(__float_as_int(v), (MASK << 10) | 0x1f)); }
__device__ __forceinline__ void halves32(float v, float& lo, float& hi) { auto rr = __builtin_amdgcn_permlane32_swap(__float_as_uint(v), __float_as_uint(v), false, false); lo = __uint_as_float(rr[0]); hi = __uint_as_float(rr[1]); }
__device__ __forceinline__ float sum_xor16_32(float v) { v += xor_lt32<16>(v); float lo, hi; halves32(v, lo, hi); return lo + hi; }
#ifndef FK_WT
#define FK_WT 0
#endif
__device__ __forceinline__ void st16wt(void* p, u32x4 v) {
#if FK_WT
    asm volatile("global_store_dwordx4 %0, %1, off sc1" :: "v"(p), "v"(v) : "memory");
#else
    *(u32x4*)p = v;
#endif
}
__device__ __forceinline__ void st16(void* p, u32x4 v) { *(u32x4*)p = v; }
__device__ __forceinline__ int fk_lane() { int l; asm volatile("v_mbcnt_lo_u32_b32 %0, -1, 0\n\tv_mbcnt_hi_u32_b32 %0, -1, %0" : "=v"(l)); return l; }
struct Unit { int pm, pn, e, aux; };

struct DenseOrder {
    int nM, nN, nwg, G, c; const char* A; const char* B; int K;
    __device__ void init(int Mr, int N, int G_, int c_, const void* A_, const void* B_, int K_) { nM = Mr / BM; nN = N / BM; nwg = nM * nN; G = G_; c = c_; A = (const char*)A_; B = (const char*)B_; K = K_; }
    __device__ __forceinline__ bool next(int i, Unit& u) const {
        const long L = (long)i * G + c; if (L >= nwg) return false;
        int wgid = (int)L; { const int q = nwg / NXCD, r = nwg % NXCD, xcd = wgid % NXCD, off = wgid / NXCD; wgid = (xcd < r ? xcd * (q + 1) : r * (q + 1) + (xcd - r) * q) + off; }
        const int nig = WGM * nN, gid = wgid / nig, fm = gid * WGM, gsz = (nM - fm) < WGM ? (nM - fm) : WGM;
        u.pm = fm + ((wgid % nig) % gsz); u.pn = (wgid % nig) / gsz; u.e = 0; u.aux = 0; return true;
    }
    __device__ __forceinline__ const char* a_base() const { return A; }
    __device__ __forceinline__ const char* b_base(const Unit& u) const { return B + (size_t)u.pn * BM * K * 2; }
    __device__ __forceinline__ void a_voff(const Unit& u, unsigned (&v)[2][2], const int (&R)[2], const int (&C)[2]) const {
#pragma unroll
        for (int h = 0; h < 2; ++h)
#pragma unroll
            for (int i = 0; i < 2; ++i) v[h][i] = (unsigned)((u.pm * BM + h * HALF + R[i]) * K + C[i]) * 2u;
    }
};

struct ExpertOrder {
    int G, c, K, nN; const char* A; const char* B; size_t bstride; const LAS int* pref; const int* tokl; const int* cnt; int gather;
    int L0, imax, Lend;
    int xcd_deal;
    __device__ __forceinline__ bool next(int i, Unit& u) const {
        if (i >= imax) return false;
        int u_ = c; if (xcd_deal) { const int q = c >> 3, x = c & 7; u_ = (x * (G >> 5) + (q >> 2)) * 4 + (q & 3); }
        const int L = L0 + i * G + u_; const int tot = pref[NE] * nN; if (L >= Lend || L >= tot) return false;
        const int rbi = L / nN; u.pn = L % nN; int e = 0;
#pragma unroll 1
        for (int j = 1; j < NE; ++j) if (rbi >= pref[j]) e = j;
        u.e = e; u.pm = rbi - pref[e]; u.aux = rbi * BM; return true;
    }
    __device__ __forceinline__ const char* a_base() const { return A; }
    __device__ __forceinline__ const char* b_base(const Unit& u) const { return B + (size_t)u.e * bstride + (size_t)u.pn * BM * K * 2; }
    __device__ __forceinline__ void a_voff(const Unit& u, unsigned (&v)[2][2], const int (&R)[2], const int (&C)[2]) const {
        const int ce = cnt[u.e * CNT_STRIDE];
#pragma unroll
        for (int h = 0; h < 2; ++h)
#pragma unroll
            for (int i = 0; i < 2; ++i) {
                const int r = u.pm * BM + h * HALF + R[i]; int row;
                if (gather) row = (r < ce) ? tokl[u.e * ECAP + r] : 0; else row = u.aux + h * HALF + R[i];
                v[h][i] = (unsigned)(row * K + C[i]) * 2u;
            }
    }
};

template <class Epi, class Sched, bool ALIGN_EPI>
__device__ __forceinline__ void gemm_phase(LAS unsigned char* lds, const int K, const Sched& S, const Epi& E, const int wave_id) {
    const int tid_ = (wave_id << 6) | fk_lane();
    const int tid = tid_, wid = __builtin_amdgcn_readfirstlane(tid >> 6), lane = tid & 63, wr = wid >> 2, wc = wid & 3, fr = lane & 15, fq = lane >> 4;
    const int nt = K / BK;
    int Rr[2], Cc[2]; unsigned voffB[2];
#pragma unroll
    for (int i = 0; i < 2; ++i) { int R, C; stage_rc(tid * 16 + i * 8192, R, C); Rr[i] = R; Cc[i] = C; const int Rb = Epi::PERM ? ((R & ~31) + perm32(R & 31)) : R; voffB[i] = (unsigned)(Rb * K + C) * 2u; }
    const size_t kstep = (size_t)(BK * 2);
    const size_t hstep = (size_t)HALF * K * 2;
    const unsigned ldsw = (unsigned)wid * 1024u;
    const int aoff = lds_byte(wr * 64 + fr, fq * 8), boff = lds_byte(wc * 32 + fr, fq * 8);
#define PG8_SA(b, h) (((b) * 2 + (h)) * HTB)
#define PG8_SB(b, h) ((4 + (b) * 2 + (h)) * HTB)
#define PG8_STAGE_B(bufoff, gbase) do { _Pragma("unroll") for (int _i = 0; _i < 2; ++_i) \
        __builtin_amdgcn_global_load_lds((const unsigned*)((const char*)(gbase) + voffB[_i]), (LAS unsigned*)(lds + (bufoff) + ldsw + _i * 8192), 16, 0, 0); } while (0)
#define PG8_STAGE_A(bufoff, vo, h, koff) do { _Pragma("unroll") for (int _i = 0; _i < 2; ++_i) \
        __builtin_amdgcn_global_load_lds((const unsigned*)(Ab + (size_t)(vo)[h][_i] + (size_t)(koff)), (LAS unsigned*)(lds + (bufoff) + ldsw + _i * 8192), 16, 0, 0); } while (0)
#define PG8_LDA(dst, b, h) do { _Pragma("unroll") for (int m = 0; m < 4; ++m) _Pragma("unroll") for (int k = 0; k < 2; ++k) dst[m][k] = *(const LAS bf16x8*)(lds + PG8_SA(b, h) + aoff + m * 2048 + k * 1024); } while (0)
#define PG8_LDB(dst, b, h) do { _Pragma("unroll") for (int n = 0; n < 2; ++n) _Pragma("unroll") for (int k = 0; k < 2; ++k) dst[n][k] = *(const LAS bf16x8*)(lds + PG8_SB(b, h) + boff + n * 2048 + k * 1024); } while (0)
#define PG8_MMA(ai, bj, At, Bt) do { __builtin_amdgcn_s_setprio(1); _Pragma("unroll") for (int m = 0; m < 4; ++m) _Pragma("unroll") for (int n = 0; n < 2; ++n) _Pragma("unroll") for (int k = 0; k < 2; ++k) \
        acc[ai][bj][m][n] = __builtin_amdgcn_mfma_f32_16x16x32_bf16(Bt[n][k], At[m][k], acc[ai][bj][m][n], 0, 0, 0); __builtin_amdgcn_s_setprio(0); } while (0)
#define PG8_WAIT_V(n) asm volatile("s_waitcnt vmcnt(" #n ")" ::: "memory")
#define PG8_WAIT_L(n) asm volatile("s_waitcnt lgkmcnt(" #n ")" ::: "memory")
#define PG8_BAR __builtin_amdgcn_s_barrier()
#define PG8_SCHED __builtin_amdgcn_sched_barrier(0)
    Unit cur, nxt; int ui = 0;
    if (!S.next(0, cur)) return;
    f32x4 acc[2][2][4][2];
#pragma unroll
    for (int a = 0; a < 2; ++a)
#pragma unroll
        for (int b = 0; b < 2; ++b)
#pragma unroll
            for (int m = 0; m < 4; ++m)
#pragma unroll
                for (int n = 0; n < 2; ++n) acc[a][b][m][n] = (f32x4){0.f, 0.f, 0.f, 0.f};
    bf16x8 At[4][2], B0[2][2], B1[2][2];
    const char* Ab = S.a_base();
    unsigned cvA[2][2], nvA[2][2];
    S.a_voff(cur, cvA, Rr, Cc);
    const char* cB = S.b_base(cur);
    PG8_STAGE_B(PG8_SB(0, 0), cB); PG8_STAGE_B(PG8_SB(0, 1), cB + hstep); PG8_STAGE_A(PG8_SA(0, 0), cvA, 0, 0); PG8_STAGE_A(PG8_SA(0, 1), cvA, 1, 0);
    if (wr == 1) PG8_BAR;
    PG8_WAIT_V(2); PG8_BAR;
    PG8_STAGE_B(PG8_SB(1, 0), cB + kstep); PG8_STAGE_A(PG8_SA(1, 0), cvA, 0, kstep); PG8_STAGE_B(PG8_SB(1, 1), cB + hstep + kstep);
    PG8_WAIT_V(6); PG8_BAR;
    for (;;) {
        const bool has_next = S.next(ui + 1, nxt);
        const char* nB = has_next ? S.b_base(nxt) : cB;
        if (has_next) S.a_voff(nxt, nvA, Rr, Cc);
        else {
#pragma unroll
            for (int h = 0; h < 2; ++h)
#pragma unroll
                for (int i = 0; i < 2; ++i) nvA[h][i] = cvA[h][i];
        }
#pragma unroll 1
        for (int t = 0; t < nt; t += 2) {
            const bool last = (t == nt - 2);
            if constexpr (Epi::HAS_MID) { if (t == Epi::MID_T) E.mid(acc, cur, wr, wc, fr, fq); }
            const size_t k1 = (size_t)(t + 1) * kstep;
            unsigned a2[2][2];
#pragma unroll
            for (int h = 0; h < 2; ++h)
#pragma unroll
                for (int i = 0; i < 2; ++i) a2[h][i] = last ? nvA[h][i] : cvA[h][i] + (unsigned)((t + 2) * (BK * 2));
            const char* b2 = last ? nB : cB + (size_t)(t + 2) * kstep;
            const char* b3 = b2 + kstep;
            PG8_LDB(B0, 0, 0); PG8_LDB(B1, 0, 1); PG8_SCHED; PG8_LDA(At, 0, 0); PG8_STAGE_A(PG8_SA(1, 1), cvA, 1, k1);
            PG8_WAIT_V(8); PG8_WAIT_L(0); PG8_BAR; PG8_MMA(0, 0, At, B0); PG8_MMA(0, 1, At, B1); PG8_BAR; PG8_SCHED;
            PG8_LDA(At, 0, 1); PG8_STAGE_B(PG8_SB(0, 0), b2); PG8_STAGE_B(PG8_SB(0, 1), b2 + hstep); PG8_STAGE_A(PG8_SA(0, 0), a2, 0, 0);
            PG8_WAIT_V(8); PG8_WAIT_L(0); PG8_BAR; PG8_MMA(1, 0, At, B0); PG8_MMA(1, 1, At, B1); PG8_BAR; PG8_SCHED;
            PG8_LDB(B0, 1, 0); PG8_LDB(B1, 1, 1); PG8_SCHED; PG8_LDA(At, 1, 0); PG8_STAGE_A(PG8_SA(0, 1), a2, 1, 0);
            PG8_WAIT_V(8); PG8_WAIT_L(0); PG8_BAR; PG8_MMA(0, 0, At, B0); PG8_MMA(0, 1, At, B1); PG8_BAR; PG8_SCHED;
            PG8_LDA(At, 1, 1); PG8_STAGE_B(PG8_SB(1, 0), b3); PG8_STAGE_B(PG8_SB(1, 1), b3 + hstep); PG8_STAGE_A(PG8_SA(1, 0), a2, 0, kstep);
            PG8_WAIT_V(8); PG8_WAIT_L(0); PG8_BAR; PG8_MMA(1, 0, At, B0); PG8_MMA(1, 1, At, B1); PG8_BAR; PG8_SCHED;
        }
        if constexpr (ALIGN_EPI) { if (wr == 0) PG8_BAR; }
        E(acc, cur, wr, wc, fr, fq);
        if (!has_next) break;
#pragma unroll
        for (int a = 0; a < 2; ++a)
#pragma unroll
            for (int b = 0; b < 2; ++b)
#pragma unroll
                for (int m = 0; m < 4; ++m)
#pragma unroll
                    for (int n = 0; n < 2; ++n) acc[a][b][m][n] = (f32x4){0.f, 0.f, 0.f, 0.f};
        cur = nxt; cB = nB; ++ui;
#pragma unroll
        for (int h = 0; h < 2; ++h)
#pragma unroll
            for (int i = 0; i < 2; ++i) cvA[h][i] = nvA[h][i];
        if constexpr (ALIGN_EPI) { if (wr == 1) PG8_BAR; }
    }
    PG8_WAIT_V(0);
    if constexpr (!ALIGN_EPI) { if (wr == 0) PG8_BAR; }
    PG8_BAR;
#undef PG8_SA
#undef PG8_SB
#undef PG8_STAGE_A
#undef PG8_STAGE_B
#undef PG8_LDA
#undef PG8_LDB
#undef PG8_MMA
#undef PG8_WAIT_V
#undef PG8_WAIT_L
#undef PG8_BAR
#undef PG8_SCHED
}

typedef f32x4 Acc[2][2][4][2];
__device__ __forceinline__ u32x4 pack8(const f32x4 a, const f32x4 b) { u32x4 w; w.x = cvt_pk_bf16(a[0], a[1]); w.y = cvt_pk_bf16(a[2], a[3]); w.z = cvt_pk_bf16(b[0], b[1]); w.w = cvt_pk_bf16(b[2], b[3]); return w; }

struct EpiPlain {
    static constexpr bool PERM = true, HAS_MID = false; static constexpr int MID_T = 0;
    bf16_t* O; int ldc; int use_aux;
    __device__ __forceinline__ void mid(Acc&, const Unit&, int, int, int, int) const {}
    __device__ __forceinline__ void operator()(const Acc& acc, const Unit& u, int wr, int wc, int fr, int fq) const {
        const int row0 = (use_aux ? u.aux : u.pm * BM) + wr * 64 + fr, col0 = u.pn * BM + wc * 32 + 8 * fq;
#pragma unroll
        for (int ai = 0; ai < 2; ++ai)
#pragma unroll
            for (int m = 0; m < 4; ++m) { bf16_t* rowp = O + (size_t)(row0 + ai * HALF + m * 16) * ldc + col0;
#pragma unroll
                for (int bj = 0; bj < 2; ++bj) st16(rowp + bj * HALF, pack8(acc[ai][bj][m][0], acc[ai][bj][m][1])); }
    }
};

struct EpiIn {
    static constexpr bool PERM = true, HAS_MID = false; static constexpr int MID_T = 0;
    const float* xpart; const float* qn; const float* kn;
    bf16_t *qb, *kb, *vb, *ub, *vsb, *gab; float* vspart;
    __device__ __forceinline__ void mid(Acc&, const Unit&, int, int, int, int) const {}
    __device__ __forceinline__ void operator()(const Acc& acc, const Unit& u, int wr, int wc, int fr, int fq) const {
        const int pn = u.pn;
        float rsv[2][4];
        { int rowb = u.pm * BM + wr * 64 + fr; asm volatile("" : "+v"(rowb));
          f32x4 xq[2][4];
#pragma unroll
          for (int ai = 0; ai < 2; ++ai)
#pragma unroll
              for (int m = 0; m < 4; ++m) xq[ai][m] = *(const f32x4*)(xpart + (size_t)(rowb + ai * HALF + m * 16) * 16 + 4 * fq);
#pragma unroll
          for (int ai = 0; ai < 2; ++ai)
#pragma unroll
              for (int m = 0; m < 4; ++m) { const float s_ = sum_xor16_32((xq[ai][m][0] + xq[ai][m][1]) + (xq[ai][m][2] + xq[ai][m][3])); rsv[ai][m] = fast_rsq(s_ * (1.f / D) + EPS); } }
#pragma unroll
        for (int ai = 0; ai < 2; ++ai)
#pragma unroll
            for (int m = 0; m < 4; ++m) {
                const int row = u.pm * BM + ai * HALF + wr * 64 + m * 16 + fr;
                const float rs = rsv[ai][m];
                f32x4 v[2][2];
#pragma unroll
                for (int bj = 0; bj < 2; ++bj)
#pragma unroll
                    for (int n = 0; n < 2; ++n) v[bj][n] = acc[ai][bj][m][n] * rs;
                if (pn < 4) {
                    float ss = 0.f;
#pragma unroll
                    for (int bj = 0; bj < 2; ++bj)
#pragma unroll
                        for (int n = 0; n < 2; ++n) ss += (v[bj][n][0] * v[bj][n][0] + v[bj][n][1] * v[bj][n][1]) + (v[bj][n][2] * v[bj][n][2] + v[bj][n][3] * v[bj][n][3]);
                    ss = sum_xor16_32(ss);
                    const bool isq = pn < 2;
                    const float sc = fast_rsq(ss * (1.f / 64.f) + EPS) * (isq ? 0.125f * LOG2E : 1.f);
                    const float* gn = isq ? qn : kn; bf16_t* O = isq ? qb : kb;
                    const int head = 4 * (pn & 1) + wc;
#pragma unroll
                    for (int bj = 0; bj < 2; ++bj) {
                        const f32x4 g0 = *(const f32x4*)(gn + 32 * bj + 8 * fq), g1 = *(const f32x4*)(gn + 32 * bj + 8 * fq + 4);
                        st16wt(O + (size_t)row * 512 + head * 64 + 32 * bj + 8 * fq, pack8(v[bj][0] * sc * g0, v[bj][1] * sc * g1));
                    }
                } else {
                    const int colw = wc * 32 + 8 * fq;
                    if (pn < 6) {
#pragma unroll
                        for (int bj = 0; bj < 2; ++bj) st16wt(vb + (size_t)row * 512 + (pn - 4) * BM + bj * HALF + colw, pack8(v[bj][0], v[bj][1]));
                    } else if (pn < 10) {
                        float ss = 0.f;
#pragma unroll
                        for (int bj = 0; bj < 2; ++bj)
#pragma unroll
                            for (int n = 0; n < 2; ++n)
#pragma unroll
                                for (int i = 0; i < 4; ++i) { const float gv = gelu_tanh_f(v[bj][n][i]); v[bj][n][i] = gv; ss += gv * gv; }
                        if (pn < 8) {
#pragma unroll
                            for (int bj = 0; bj < 2; ++bj) st16wt(ub + (size_t)row * 512 + (pn - 6) * BM + bj * HALF + colw, pack8(v[bj][0], v[bj][1]));
                        } else {
#pragma unroll
                            for (int bj = 0; bj < 2; ++bj) st16wt(vsb + (size_t)row * 512 + (pn - 8) * BM + bj * HALF + colw, pack8(v[bj][0], v[bj][1]));
                            ss = sum_xor16_32(ss);
                            if (fq == 0) vspart[(size_t)row * 8 + (pn - 8) * 4 + wc] = ss;
                        }
                    } else {
#pragma unroll
                        for (int bj = 0; bj < 2; ++bj) {
#pragma unroll
                            for (int n = 0; n < 2; ++n)
#pragma unroll
                                for (int i = 0; i < 4; ++i) v[bj][n][i] = fmaxf(sigmoid_f(v[bj][n][i]), 1e-13f);
                            st16wt(gab + (size_t)row * 2048 + (pn - 10) * BM + bj * HALF + colw, pack8(v[bj][0], v[bj][1]));
                        }
                    }
                }
            }
    }
};

struct EpiUp {
    static constexpr bool PERM = true, HAS_MID = true; static constexpr int MID_T = 8;
    const bf16_t* gab; bf16_t* mg;
    __device__ __forceinline__ void mid(Acc& acc, const Unit& u, int wr, int wc, int fr, int fq) const {
        int row0 = u.pm * BM + wr * 64 + fr; const int col0 = u.pn * BM + wc * 32 + 8 * fq; asm volatile("" : "+v"(row0));
#pragma unroll
        for (int am = 0; am < 4; ++am) {
            const int ai = am >> 1, mb = (am & 1) * 2;
            u32x4 ga[2][2], gb[2][2];
#pragma unroll
            for (int mm = 0; mm < 2; ++mm) { const bf16_t* gp = gab + (size_t)(row0 + ai * HALF + (mb + mm) * 16) * 2048 + col0;
#pragma unroll
                for (int bj = 0; bj < 2; ++bj) { ga[mm][bj] = *(const u32x4*)(gp + bj * HALF); gb[mm][bj] = *(const u32x4*)(gp + 1024 + bj * HALF); } }
#pragma unroll
            for (int mm = 0; mm < 2; ++mm)
#pragma unroll
                for (int bj = 0; bj < 2; ++bj)
#pragma unroll
                    for (int j = 0; j < 4; ++j) { const float r0 = bf_lo(ga[mm][bj][j]) * fast_rcp(bf_lo(gb[mm][bj][j])), r1 = bf_hi(ga[mm][bj][j]) * fast_rcp(bf_hi(gb[mm][bj][j]));
                        acc[ai][bj][mb + mm][j >> 1][(j & 1) * 2] *= r0; acc[ai][bj][mb + mm][j >> 1][(j & 1) * 2 + 1] *= r1; }
            asm volatile("" ::: "memory");
        }
    }
    __device__ __forceinline__ void operator()(const Acc& acc, const Unit& u, int wr, int wc, int fr, int fq) const {
        int row0 = u.pm * BM + wr * 64 + fr; const int col0 = u.pn * BM + wc * 32 + 8 * fq; asm volatile("" : "+v"(row0));
#pragma unroll
        for (int ai = 0; ai < 2; ++ai) {
            u32x4 gb[4][2];
#pragma unroll
            for (int m = 0; m < 4; ++m)
#pragma unroll
                for (int bj = 0; bj < 2; ++bj) gb[m][bj] = *(const u32x4*)(gab + (size_t)(row0 + ai * HALF + m * 16) * 2048 + 1024 + col0 + bj * HALF);
#pragma unroll
            for (int m = 0; m < 4; ++m) { const size_t ro = (size_t)(row0 + ai * HALF + m * 16);
#pragma unroll
                for (int bj = 0; bj < 2; ++bj) { const u32x4 b = gb[m][bj];
                    f32x4 o0, o1;
                    o0[0] = acc[ai][bj][m][0][0] * bf_lo(b[0]); o0[1] = acc[ai][bj][m][0][1] * bf_hi(b[0]); o0[2] = acc[ai][bj][m][0][2] * bf_lo(b[1]); o0[3] = acc[ai][bj][m][0][3] * bf_hi(b[1]);
                    o1[0] = acc[ai][bj][m][1][0] * bf_lo(b[2]); o1[1] = acc[ai][bj][m][1][1] * bf_hi(b[2]); o1[2] = acc[ai][bj][m][1][2] * bf_lo(b[3]); o1[3] = acc[ai][bj][m][1][3] * bf_hi(b[3]);
                    st16(mg + ro * 1024 + col0 + bj * HALF, pack8(o0, o1)); } }
            asm volatile("" ::: "memory");
        }
    }
};

struct EpiOut {
    static constexpr bool PERM = true, HAS_MID = false; static constexpr int MID_T = 0;
    const bf16_t* xin; bf16_t* xout;
    __device__ __forceinline__ void mid(Acc&, const Unit&, int, int, int, int) const {}
    __device__ __forceinline__ void operator()(const Acc& acc, const Unit& u, int wr, int wc, int fr, int fq) const {
        int row0 = u.pm * BM + wr * 64 + fr; const int col0 = u.pn * BM + wc * 32 + 8 * fq; asm volatile("" : "+v"(row0));
        u32x4 xv[2][4][2];
#pragma unroll
        for (int ai = 0; ai < 2; ++ai)
#pragma unroll
            for (int m = 0; m < 4; ++m)
#pragma unroll
                for (int bj = 0; bj < 2; ++bj) xv[ai][m][bj] = *(const u32x4*)(xin + (size_t)(row0 + ai * HALF + m * 16) * D + col0 + bj * HALF);
#pragma unroll
        for (int ai = 0; ai < 2; ++ai)
#pragma unroll
            for (int m = 0; m < 4; ++m)
#pragma unroll
                for (int bj = 0; bj < 2; ++bj) { const u32x4 xo = xv[ai][m][bj]; f32x4 o0, o1;
                    o0[0] = bf_lo(xo[0]) + acc[ai][bj][m][0][0]; o0[1] = bf_hi(xo[0]) + acc[ai][bj][m][0][1]; o0[2] = bf_lo(xo[1]) + acc[ai][bj][m][0][2]; o0[3] = bf_hi(xo[1]) + acc[ai][bj][m][0][3];
                    o1[0] = bf_lo(xo[2]) + acc[ai][bj][m][1][0]; o1[1] = bf_hi(xo[2]) + acc[ai][bj][m][1][1]; o1[2] = bf_lo(xo[3]) + acc[ai][bj][m][1][2]; o1[3] = bf_hi(xo[3]) + acc[ai][bj][m][1][3];
                    st16(xout + (size_t)(row0 + ai * HALF + m * 16) * D + col0 + bj * HALF, pack8(o0, o1)); }
    }
};

struct EpiG1 {
    static constexpr bool PERM = true, HAS_MID = false; static constexpr int MID_T = 0;
    const int* tokl; const int* cnt; const float* rs2; bf16_t* Gb;
    __device__ __forceinline__ void mid(Acc&, const Unit&, int, int, int, int) const {}
    __device__ __forceinline__ void operator()(const Acc& acc, const Unit& u, int wr, int wc, int fr, int fq) const {
        const int ce = cnt[u.e * CNT_STRIDE];
        int tokv[2][4]; float rsv[2][4];
#pragma unroll
        for (int ai = 0; ai < 2; ++ai)
#pragma unroll
            for (int m = 0; m < 4; ++m) { const int r = u.pm * BM + ai * HALF + wr * 64 + m * 16 + fr; tokv[ai][m] = (r < ce) ? tokl[u.e * ECAP + r] : 0; }
#pragma unroll
        for (int ai = 0; ai < 2; ++ai)
#pragma unroll
            for (int m = 0; m < 4; ++m) rsv[ai][m] = rs2[tokv[ai][m]];
#pragma unroll
        for (int ai = 0; ai < 2; ++ai)
#pragma unroll
            for (int m = 0; m < 4; ++m) {
                const int rl = ai * HALF + wr * 64 + m * 16 + fr;
                const float rs = rsv[ai][m];
                f32x4 o[2];
#pragma unroll
                for (int n = 0; n < 2; ++n)
#pragma unroll
                    for (int i = 0; i < 4; ++i) { const float g = acc[ai][0][m][n][i] * rs, up = acc[ai][1][m][n][i] * rs; o[n][i] = g * sigmoid_f(g) * up; }
                st16(Gb + (size_t)(u.aux + rl) * 512 + u.pn * HALF + wc * 32 + 8 * fq, pack8(o[0], o[1]));
            }
    }
};

struct EpiPle {
    static constexpr bool PERM = true, HAS_MID = false; static constexpr int MID_T = 0;
    const bf16_t* xin; bf16_t* xout; float* fout; const bf16_t* Eb; const float* rs3; float* xpart;
    __device__ __forceinline__ void mid(Acc&, const Unit&, int, int, int, int) const {}
    __device__ __forceinline__ void operator()(const Acc& acc, const Unit& u, int wr, int wc, int fr, int fq) const {
        int row0 = u.pm * BM + wr * 64 + fr; const int col0 = u.pn * BM + wc * 32 + 8 * fq; asm volatile("" : "+v"(row0));
#pragma unroll
        for (int ai = 0; ai < 2; ++ai) {
            constexpr int mb = 0;
            u32x4 xv[4][2], ev[4][2]; float rsv[4];
#pragma unroll
            for (int mm = 0; mm < 4; ++mm) { const int row = row0 + ai * HALF + (mb + mm) * 16; rsv[mm] = rs3[row];
#pragma unroll
                for (int bj = 0; bj < 2; ++bj) { xv[mm][bj] = *(const u32x4*)(xin + (size_t)row * D + col0 + bj * HALF); ev[mm][bj] = *(const u32x4*)(Eb + (size_t)row * D + col0 + bj * HALF); } }
#pragma unroll
            for (int mm = 0; mm < 4; ++mm) { const int row = row0 + ai * HALF + (mb + mm) * 16; const float rs = rsv[mm]; float ss = 0.f;
#pragma unroll
                for (int bj = 0; bj < 2; ++bj) { const u32x4 xo = xv[mm][bj], e = ev[mm][bj]; f32x4 o[2];
#pragma unroll
                    for (int j = 0; j < 4; ++j) { o[j >> 1][(j & 1) * 2] = bf_lo(xo[j]) + sigmoid_f(acc[ai][bj][mb + mm][j >> 1][(j & 1) * 2] * rs) * bf_lo(e[j]);
                                                  o[j >> 1][(j & 1) * 2 + 1] = bf_hi(xo[j]) + sigmoid_f(acc[ai][bj][mb + mm][j >> 1][(j & 1) * 2 + 1] * rs) * bf_hi(e[j]); }
                    const u32x4 w = pack8(o[0], o[1]);
#pragma unroll
                    for (int j = 0; j < 4; ++j) { const float a = bf_lo(w[j]), b = bf_hi(w[j]); ss += a * a + b * b; }
                    st16(xout + (size_t)row * D + col0 + bj * HALF, w);
                    if (fout) { *(f32x4*)(fout + (size_t)row * D + col0 + bj * HALF) = o[0]; *(f32x4*)(fout + (size_t)row * D + col0 + bj * HALF + 4) = o[1]; } }
                ss = sum_xor16_32(ss);
                if (fq == 0) xpart[(size_t)row * 16 + u.pn * 4 + wc] = ss; }
            asm volatile("" ::: "memory");
        }
    }
};
__device__ __forceinline__ int crow(int r, int hi) { return (r & 3) + 8 * (r >> 2) + 4 * hi; }
__device__ __forceinline__ unsigned cvtpk_s(float lo, float hi) { typedef __bf16 bf16x2_t __attribute__((ext_vector_type(2))); f32x2 v = {lo, hi}; bf16x2_t b = __builtin_convertvector(v, bf16x2_t); return __builtin_bit_cast(unsigned, b); }
#define FK_SBAR() __builtin_amdgcn_sched_barrier(0)
__device__ __forceinline__ void pv(f32x16* o, int vb, bf16x8 pa0, bf16x8 pa1, bf16x8 pa2, bf16x8 pa3) {
#pragma unroll
    for (int d0 = 0; d0 < 2; ++d0) { s16x4 lo[4], hi[4];
#pragma unroll
        for (int ks = 0; ks < 4; ++ks) {
            asm volatile("ds_read_b64_tr_b16 %0,%1 offset:%c2" : "=&v"(lo[ks]) : "v"(vb), "i"(d0 * 4096 + ks * 1024) : "memory");
            asm volatile("ds_read_b64_tr_b16 %0,%1 offset:%c2" : "=&v"(hi[ks]) : "v"(vb), "i"(d0 * 4096 + ks * 1024 + 512) : "memory"); }
        asm volatile("s_waitcnt lgkmcnt(0)" ::: "memory"); FK_SBAR();
#define FK_PK(k) (bf16x8){lo[k][0], lo[k][1], lo[k][2], lo[k][3], hi[k][0], hi[k][1], hi[k][2], hi[k][3]}
        o[d0] = __builtin_amdgcn_mfma_f32_32x32x16_bf16(pa0, FK_PK(0), o[d0], 0, 0, 0);
        o[d0] = __builtin_amdgcn_mfma_f32_32x32x16_bf16(pa1, FK_PK(1), o[d0], 0, 0, 0);
        o[d0] = __builtin_amdgcn_mfma_f32_32x32x16_bf16(pa2, FK_PK(2), o[d0], 0, 0, 0);
        o[d0] = __builtin_amdgcn_mfma_f32_32x32x16_bf16(pa3, FK_PK(3), o[d0], 0, 0, 0);
#undef FK_PK
    }
}
constexpr int WLDS_BYTES = 16384;

template <bool DIAG>
__device__ __forceinline__ void attn_tile(const bf16x8 (&k0)[4], const bf16x8 (&k1)[4], const bf16x8 (&qr)[4], f32x16 (&o)[2], float& R, int s0, int tq, int hi, int vbase) {
    f32x16 p0 = f32x16{}, p1 = f32x16{};
#pragma unroll
    for (int d0 = 0; d0 < 4; ++d0) { p0 = __builtin_amdgcn_mfma_f32_32x32x16_bf16(k0[d0], qr[d0], p0, 0, 0, 0); p1 = __builtin_amdgcn_mfma_f32_32x32x16_bf16(k1[d0], qr[d0], p1, 0, 0, 0); }
    float kp[32], bt[32];
#pragma unroll
    for (int r = 0; r < 32; ++r) {
        const float z = r < 16 ? p0[r] : p1[r - 16];
        const float e = fast_exp2(z);
        float k_ = fast_rcp(1.f + e), b_ = 1.f - k_;
        if (DIAG) { const int kv = s0 + crow(r & 15, hi) + (r >> 4) * 32; if (!(kv < tq)) { k_ = 1.f; b_ = 0.f; } }
        kp[r] = k_; bt[r] = b_;
    }
    float pg[8], T[8], SP[8];
#pragma unroll
    for (int g = 0; g < 8; ++g) { const float gs = (kp[4 * g] * kp[4 * g + 1]) * (kp[4 * g + 2] * kp[4 * g + 3]); float lo_, hi_; halves32(gs, lo_, hi_); pg[g] = hi ? lo_ : hi_; T[g] = lo_ * hi_; }
    SP[7] = 1.f;
#pragma unroll
    for (int g = 6; g >= 0; --g) SP[g] = SP[g + 1] * T[g + 1];
    float a[32];
#pragma unroll
    for (int g = 0; g < 8; ++g) {
        const float base = R * SP[g] * (hi == 0 ? pg[g] : 1.f);
        const float a3 = base, a2 = a3 * kp[4 * g + 3], a1 = a2 * kp[4 * g + 2], a0 = a1 * kp[4 * g + 1];
        a[4 * g + 3] = bt[4 * g + 3] * a3; a[4 * g + 2] = bt[4 * g + 2] * a2; a[4 * g + 1] = bt[4 * g + 1] * a1; a[4 * g] = bt[4 * g] * a0;
    }
    R *= SP[0] * T[0];
    u32x4 pw0, pw1, pw2, pw3;
    pw0 = (u32x4){cvtpk_s(a[0], a[1]), cvtpk_s(a[2], a[3]), cvtpk_s(a[4], a[5]), cvtpk_s(a[6], a[7])};
    pw1 = (u32x4){cvtpk_s(a[8], a[9]), cvtpk_s(a[10], a[11]), cvtpk_s(a[12], a[13]), cvtpk_s(a[14], a[15])};
    pw2 = (u32x4){cvtpk_s(a[16], a[17]), cvtpk_s(a[18], a[19]), cvtpk_s(a[20], a[21]), cvtpk_s(a[22], a[23])};
    pw3 = (u32x4){cvtpk_s(a[24], a[25]), cvtpk_s(a[26], a[27]), cvtpk_s(a[28], a[29]), cvtpk_s(a[30], a[31])};
    asm volatile("s_waitcnt vmcnt(0) lgkmcnt(0)" ::: "memory");
    pv(o, vbase, __builtin_bit_cast(bf16x8, pw0), __builtin_bit_cast(bf16x8, pw1), __builtin_bit_cast(bf16x8, pw2), __builtin_bit_cast(bf16x8, pw3));
}
__device__ __forceinline__ void attn_dma_v(const bf16_t* __restrict__ vb, long rowbase, int s0, int h, int lane, LAS unsigned char* wl) {
#pragma unroll
    for (int w8 = 0; w8 < 8; ++w8)
        __builtin_amdgcn_global_load_lds((const unsigned*)(vb + (size_t)(rowbase + s0 + 16 * (w8 & 3) + (lane >> 2)) * 512 + h * 64 + 32 * (w8 >> 2) + 8 * (lane & 3)), (LAS unsigned*)(wl + w8 * 1024), 16, 0, 0);
}
__device__ __forceinline__ void attn_dma_k(const bf16_t* __restrict__ kb, long rowbase, int s0, int h, int lane, LAS unsigned char* wl) {
#pragma unroll
    for (int c = 0; c < 8; ++c)
        __builtin_amdgcn_global_load_lds((const unsigned*)(kb + (size_t)(rowbase + s0 + lane) * 512 + h * 64 + 8 * c), (LAS unsigned*)(wl + 8192 + c * 1024), 16, 0, 0);
}
__device__ __forceinline__ void attn_read_k(bf16x8 (&k0)[4], bf16x8 (&k1)[4], LAS unsigned char* wl, int r32, int hi) {
    const LAS unsigned char* kp = wl + 8192 + hi * 1024 + r32 * 16;
#pragma unroll
    for (int d0 = 0; d0 < 4; ++d0) { k0[d0] = *(const LAS bf16x8*)(kp + d0 * 2048); k1[d0] = *(const LAS bf16x8*)(kp + d0 * 2048 + 512); }
}
__device__ __forceinline__ void attn_wave_unit(int b, int h, int qblk, const bf16_t* __restrict__ qb, const bf16_t* __restrict__ kb, const bf16_t* __restrict__ vb, bf16_t* __restrict__ oc, LAS unsigned char* wl, int lane) {
    const int r32 = lane & 31, hi = lane >> 5;
    const long rowbase = (long)b * SEQ; const int q0 = qblk * 32, tq = q0 + r32;
    bf16x8 qr[4];
    { const bf16_t* qp = qb + (size_t)(rowbase + q0 + r32) * 512 + h * 64 + hi * 8;
#pragma unroll
      for (int d0 = 0; d0 < 4; ++d0) qr[d0] = *(const bf16x8*)(qp + d0 * 16); }
    f32x16 o[2]; o[0] = f32x16{}; o[1] = f32x16{};
    float R = 1.f;
    const int vbase = (int)(unsigned)(uintptr_t)wl + ((lane >> 4) & 1) * 32 + (lane & 3) * 8 + (4 * hi + ((lane & 15) >> 2)) * 64;
    const int jd = q0 >> 6;
    bf16x8 k0[4], k1[4];
    attn_dma_k(kb, rowbase, jd * 64, h, lane, wl);
    attn_dma_v(vb, rowbase, jd * 64, h, lane, wl);
    asm volatile("s_waitcnt vmcnt(8)" ::: "memory");
    attn_read_k(k0, k1, wl, r32, hi);
    asm volatile("s_waitcnt lgkmcnt(0)" ::: "memory");
    attn_dma_k(kb, rowbase, (jd > 0 ? jd - 1 : 0) * 64, h, lane, wl);
    attn_tile<true>(k0, k1, qr, o, R, jd * 64, tq, hi, vbase);
    for (int jt = jd - 1; jt >= 0; --jt) {
        if (__all(R < 7.5e-37f)) break;
        attn_read_k(k0, k1, wl, r32, hi);
        attn_dma_v(vb, rowbase, jt * 64, h, lane, wl);
        asm volatile("s_waitcnt lgkmcnt(0)" ::: "memory");
        attn_dma_k(kb, rowbase, (jt > 0 ? jt - 1 : 0) * 64, h, lane, wl);
        attn_tile<false>(k0, k1, qr, o, R, jt * 64, tq, hi, vbase);
    }
    asm volatile("s_waitcnt vmcnt(0)" ::: "memory");
    LAS bf16_t* stg = (LAS bf16_t*)(wl + 8192);
#pragma unroll
    for (int r = 0; r < 16; ++r) { const int orow = crow(r, hi);
#pragma unroll
        for (int d0 = 0; d0 < 2; ++d0) stg[orow * 64 + d0 * 32 + r32] = (bf16_t)(cvtpk_s(o[d0][r], 0.f) & 0xffffu); }
    asm volatile("s_waitcnt lgkmcnt(0)" ::: "memory");
    bf16_t* Ow = oc + (size_t)(rowbase + q0) * 1024 + h * 64;
#pragma unroll
    for (int i = 0; i < 4; ++i) { const int row = i * 8 + (lane >> 3), ch = lane & 7; const u32x4 v = *(const LAS u32x4*)(stg + row * 64 + ch * 8); *(u32x4*)(Ow + (size_t)row * 1024 + ch * 8) = v; }
    asm volatile("s_waitcnt vmcnt(0) lgkmcnt(0)" ::: "memory");
}

template <int HF>
__device__ __forceinline__ void sgu_wave_unit(int chunk, int g, const bf16_t* __restrict__ ub, const bf16_t* __restrict__ vsb, const float* __restrict__ vspart, const bf16_t* __restrict__ wsp  ,
                                              const float* __restrict__ bsp  , const float* __restrict__ sgn  , bf16_t* __restrict__ oc, LAS unsigned char* wl, int lane) {
    const int r32 = lane & 31, hi = lane >> 5;
    const size_t row0 = (size_t)chunk * 128;
    const int vbase = (int)(unsigned)(uintptr_t)wl + ((lane >> 4) & 1) * 32 + (lane & 3) * 8 + (4 * hi + ((lane & 15) >> 2)) * 64;
    f32x16 o[2][2];
#pragma unroll
    for (int rl = 0; rl < 2; ++rl) { o[rl][0] = f32x16{}; o[rl][1] = f32x16{}; }
#pragma unroll
    for (int kt = 0; kt <= HF; ++kt) {
        float rvq[4];
#pragma unroll
        for (int q = 0; q < 4; ++q) { const size_t row = row0 + 64 * kt + 16 * q + (lane >> 2);
            const f32x4 s0 = *(const f32x4*)(vspart + row * 8), s1 = *(const f32x4*)(vspart + row * 8 + 4);
            rvq[q] = fast_rsq((((s0[0] + s0[1]) + (s0[2] + s0[3])) + ((s1[0] + s1[1]) + (s1[2] + s1[3]))) * (1.f / 512.f) + EPS); }
        u32x4 vv[8];
#pragma unroll
        for (int w8 = 0; w8 < 8; ++w8) vv[w8] = *(const u32x4*)(vsb + (row0 + 64 * kt + 16 * (w8 & 3) + (lane >> 2)) * 512 + g * 64 + 32 * (w8 >> 2) + 8 * (lane & 3));
#pragma unroll
        for (int w8 = 0; w8 < 8; ++w8) { const float rv = rvq[w8 & 3]; u32x4 w;
#pragma unroll
            for (int j = 0; j < 4; ++j) w[j] = cvtpk_s(bf_lo(vv[w8][j]) * rv, bf_hi(vv[w8][j]) * rv);
            *(LAS u32x4*)(wl + w8 * 1024 + lane * 16) = w; }
        asm volatile("s_waitcnt lgkmcnt(0)" ::: "memory");
#pragma unroll
        for (int rl = 0; rl < 2; ++rl) {
            const int rb = 2 * HF + rl;
            const bf16_t* wp = wsp + ((size_t)g * 128 + 32 * rb + r32) * 128 + 64 * kt + 4 * hi;
            u32x4 pw[4];
#pragma unroll
            for (int ks = 0; ks < 4; ++ks) { const u32x2 lo = *(const u32x2*)(wp + 16 * ks), h8 = *(const u32x2*)(wp + 16 * ks + 8); pw[ks] = (u32x4){lo.x, lo.y, h8.x, h8.y}; }
            pv(o[rl], vbase, __builtin_bit_cast(bf16x8, pw[0]), __builtin_bit_cast(bf16x8, pw[1]), __builtin_bit_cast(bf16x8, pw[2]), __builtin_bit_cast(bf16x8, pw[3]));
        }
        asm volatile("s_waitcnt lgkmcnt(0)" ::: "memory");
    }
    LAS bf16_t* stg = (LAS bf16_t*)(wl + 8192);
    const float gn0 = sgn[g * 64 + r32], gn1 = sgn[g * 64 + 32 + r32];
#pragma unroll
    for (int rl = 0; rl < 2; ++rl) {
        const int rb = 2 * HF + rl;
#pragma unroll
        for (int r = 0; r < 16; ++r) { const int orow = crow(r, hi); const float bb = bsp[g * 128 + 32 * rb + orow];
            stg[orow * 64 + r32] = (bf16_t)(cvtpk_s(gn0 * o[rl][0][r] + bb, 0.f) & 0xffffu); stg[orow * 64 + 32 + r32] = (bf16_t)(cvtpk_s(gn1 * o[rl][1][r] + bb, 0.f) & 0xffffu); }
        asm volatile("s_waitcnt lgkmcnt(0)" ::: "memory");
#pragma unroll
        for (int i = 0; i < 4; ++i) { const int row = i * 8 + (lane >> 3), ch = lane & 7; const size_t grow = row0 + 32 * rb + row;
            const u32x4 mv = *(const LAS u32x4*)(stg + row * 64 + ch * 8); const u32x4 uv = *(const u32x4*)(ub + grow * 512 + g * 64 + ch * 8); u32x4 w;
#pragma unroll
            for (int j = 0; j < 4; ++j) w[j] = cvtpk_s(bf_lo(mv[j]) * bf_lo(uv[j]), bf_hi(mv[j]) * bf_hi(uv[j]));
            *(u32x4*)(oc + grow * 1024 + 512 + g * 64 + ch * 8) = w; }
        asm volatile("s_waitcnt lgkmcnt(0)" ::: "memory");
    }
}
constexpr size_t MiB = 1u << 20;
constexpr size_t WS_CTL = 0, CTL_ZERO_BYTES = 1 * MiB;
constexpr size_t WS_W = 16 * MiB, WL_STRIDE = 112 * MiB;
constexpr size_t WO_IN = 0, WO_UP = 9 * MiB, WO_OUT = 11 * MiB, WO_PG = 13 * MiB, WO_PP = 15 * MiB, WO_SP = 15 * MiB + 512 * 1024, WO_R = 15 * MiB + 768 * 1024, WO_EI = 16 * MiB, WO_EO = 80 * MiB;
constexpr size_t WS_PB = 464 * MiB, WS_E = 496 * MiB, WS_XB = 624 * MiB, WS_Q = 656 * MiB, WS_K = 672 * MiB, WS_V = 688 * MiB, WS_U = 704 * MiB, WS_VS = 720 * MiB, WS_GAB = 736 * MiB,
                 WS_OC = 800 * MiB, WS_MG = 832 * MiB, WS_G = 864 * MiB, WS_YS = 904 * MiB, WS_XPART = 984 * MiB, WS_VSPART = 985 * MiB, WS_RS2 = 985 * MiB + 512 * 1024, WS_RS3 = 985 * MiB + 640 * 1024,
                 WS_TOKL = 986 * MiB, WS_TKE = 988 * MiB, WS_TKP = 988 * MiB + 256 * 1024, WS_TKW = 988 * MiB + 512 * 1024, WS_XB1 = 992 * MiB, WS_FAST_END = 1024 * MiB;
constexpr int GSLOTS = 2 * M + NE * 256;
constexpr int CW_TMO = 0, CW_CODE = 1, CW_BAR = 4096, CW_CNT = 8192  ;

constexpr int RING_OFF = 0, RING_BYTES = 131072, LDSCTL_OFF = 139264  , MISC_OFF = LDSCTL_OFF + 320, PREF_OFF = MISC_OFF + 128  , LDS_BYTES = 147456;

#define RLX_AGENT __ATOMIC_RELAXED, __HIP_MEMORY_SCOPE_AGENT
#define XB_TMO      128
#define XB_XCNT(j)  (256  + 64 * (j))
#define XB_XSUB(j)  (1280 + 64 * (j))
#define XB_XGEN(j)  (2304 + 64 * (j))
#define XB_TOP      3328
#define XB_TOPGEN   3392
#define XCD_BAR_WORDS 3456
#define XB_SPIN_CAP (1u << 18)
__device__ __forceinline__ unsigned xb_ld(unsigned* p)              { return __hip_atomic_load(p, __ATOMIC_RELAXED, __HIP_MEMORY_SCOPE_AGENT); }
__device__ __forceinline__ unsigned xb_add(unsigned* p, unsigned v) { return __hip_atomic_fetch_add(p, v, __ATOMIC_RELAXED, __HIP_MEMORY_SCOPE_AGENT); }
__device__ __forceinline__ unsigned xb_xcc_id() { return (unsigned)__builtin_amdgcn_s_getreg((3 << 11) | 20) & 0xFu; }
#define XB_SPIN(cond, bar) do { unsigned _sp = 0; while (cond) { __builtin_amdgcn_s_sleep(1); \
    if ((++_sp & 255u) == 0u) { if (xb_ld(&(bar)[XB_TMO])) break; if (_sp > XB_SPIN_CAP) { atomicAdd(&(bar)[XB_TMO], 1u); break; } } } } while (0)
struct XcdBarrier { unsigned* bar; unsigned x; volatile LAS unsigned* st; };
__device__ __forceinline__ XcdBarrier xcd_barrier_post(unsigned* bar, volatile LAS unsigned* st, const bool leader  ) {
    XcdBarrier b; b.bar = bar; b.x = xb_xcc_id(); b.st = st;
    if (leader) (void)xb_add(&bar[XB_XCNT(b.x)], 1u);
    return b;
}
__device__ __forceinline__ void xcd_barrier_complete(unsigned* bar, unsigned x, unsigned& nloc, unsigned& nx) {
    const unsigned G = gridDim.x * gridDim.y * gridDim.z;
    unsigned sum, cnt, mine, sp = 0u;
    for (;;) {
        sum = 0u; cnt = 0u; mine = 0u;
#pragma unroll
        for (unsigned j = 0; j < 16; ++j) { const unsigned c = xb_ld(&bar[XB_XCNT(j)]); sum += c; cnt += (c > 0u) ? 1u : 0u; mine = (j == x) ? c : mine; }
        if (sum == G) break;
        __builtin_amdgcn_s_sleep(1);
        if ((++sp & 255u) == 0u) { if (xb_ld(&bar[XB_TMO])) break; if (sp > XB_SPIN_CAP) { atomicAdd(&bar[XB_TMO], 1u); break; } }
    }
    nloc = mine > 0u ? mine : 1u; nx = cnt > 0u ? cnt : 1u;
}
__device__ __forceinline__ void xcd_barrier_t0(const XcdBarrier& b) {
        unsigned* bar = b.bar;
        __builtin_amdgcn_s_waitcnt(0);
        unsigned nloc = b.st[0], nx = b.st[1];
        if (nloc == 0u) { xcd_barrier_complete(bar, b.x, nloc, nx); b.st[0] = nloc; b.st[1] = nx; }
        const unsigned old = xb_add(&bar[XB_XSUB(b.x)], 1u);
        const unsigned gen = old / nloc;
        if (old + 1u == (gen + 1u) * nloc) {
            __builtin_amdgcn_fence(__ATOMIC_RELEASE, "agent");
            asm volatile("s_waitcnt vmcnt(0)" ::: "memory");
            const unsigned og = xb_add(&bar[XB_TOP], 1u);
            const unsigned tg = og / nx;
            if (og + 1u == (tg + 1u) * nx) xb_add(&bar[XB_TOPGEN], 1u);
            else XB_SPIN(xb_ld(&bar[XB_TOPGEN]) == tg, bar);
            __builtin_amdgcn_fence(__ATOMIC_ACQUIRE, "agent");
            xb_add(&bar[XB_XGEN(b.x)], 1u);
            asm volatile("s_waitcnt vmcnt(0)" ::: "memory");
        } else {
            XB_SPIN(xb_ld(&bar[XB_XGEN(b.x)]) == gen, bar);
            __builtin_amdgcn_fence(__ATOMIC_ACQUIRE, "agent");
            asm volatile("s_waitcnt vmcnt(0)" ::: "memory");
        }
}

struct Args {
    const float* in[22]; float* out; unsigned char* ws;
    int ph_lo, ph_hi, nlayers, pad;
};
__device__ __forceinline__ float wave_sum(float v) { v += xor_lt32<1>(v); v += xor_lt32<2>(v); v += xor_lt32<4>(v); v += xor_lt32<8>(v); return sum_xor16_32(v); }
__device__ __forceinline__ unsigned f2bf(float f) { unsigned u = __builtin_bit_cast(unsigned, f); return (u + 0x7fffu + ((u >> 16) & 1u)) >> 16; }
__device__ __forceinline__ unsigned pk2(float lo, float hi) { return f2bf(lo) | (f2bf(hi) << 16); }

__device__ __forceinline__ int rowmap(int kind, int n) {
    if (kind == 1) { if (n >= 1024) return n; const int nl = n & 255; return (n - nl) + 128 * ((nl & 63) >> 5) + 32 * (nl >> 6) + (nl & 31); }
    if (kind == 2) { return n < 512 ? 256 * (n >> 7) + (n & 127) : 256 * ((n - 512) >> 7) + 128 + ((n - 512) & 127); }
    return n;
}
__device__ __forceinline__ void transpose_item(const float* __restrict__ W, int N, const float* __restrict__ gain, bf16_t* __restrict__ WT, int ldt, int koff, int kind, LAS float* scr, int item, int lane) {
    const int nblk = N / 64, kb = item / nblk, nb = item % nblk, k0 = 64 * kb, n0 = 64 * nb;
    const int kr = lane >> 4, nc = 4 * (lane & 15);
    f32x4 v[16];
#pragma unroll
    for (int i = 0; i < 16; ++i) v[i] = __builtin_nontemporal_load((const f32x4*)(W + (size_t)(k0 + 4 * i + kr) * N + n0 + nc));
#pragma unroll
    for (int i = 0; i < 16; ++i) { const int kk = 4 * i + kr; const float gv = gain ? gain[k0 + kk] : 1.f; LAS float* d = scr + kk * 65 + nc; d[0] = v[i][0] * gv; d[1] = v[i][1] * gv; d[2] = v[i][2] * gv; d[3] = v[i][3] * gv; }
    asm volatile("s_waitcnt lgkmcnt(0)" ::: "memory");
    const int c = lane & 7;
#pragma unroll
    for (int j = 0; j < 8; ++j) { const int n = 8 * j + (lane >> 3); const LAS float* s = scr + (8 * c) * 65 + n;
        u32x4 o; o.x = pk2(s[0 * 65], s[1 * 65]); o.y = pk2(s[2 * 65], s[3 * 65]); o.z = pk2(s[4 * 65], s[5 * 65]); o.w = pk2(s[6 * 65], s[7 * 65]);
        st16(WT + (size_t)rowmap(kind, n0 + n) * ldt + koff + k0 + 8 * c, o); }
    asm volatile("s_waitcnt lgkmcnt(0)" ::: "memory");
}

typedef const __attribute__((address_space(4))) Args* KArgs;
__device__ __forceinline__ KArgs fresh(KArgs k) { asm volatile("" : "+s"(k)); return k; }
constexpr int NWAVES = 8;
#ifndef FK_FILLW
#define FK_FILLW 7
#endif
constexpr int FILLW = FK_FILLW, FILL_SLABS = 8;
constexpr int CVT_IN = 16 * 72, CVT_UP = 8 * 16, CVT_OUT = 16 * 16, CVT_PG = 16 * 16, CVT_PP = 4 * 16, CVT_EI = 16 * 16, CVT_EO = 8 * 16;
constexpr int CVT_PER_LAYER = CVT_IN + 2 * CVT_UP + CVT_OUT + CVT_PG + CVT_PP + NE * CVT_EI + NE * CVT_EO;
__device__ __forceinline__ void convert_item(KArgs ap, int L, int r, LAS float* scr, int lane) {
    unsigned char* wl = ap->ws + WS_W + (size_t)L * WL_STRIDE;
    const float* W; const float* gain = nullptr; bf16_t* WT; int N = D, ldt = D, koff = 0, kind = 0, item = r;
    if (r < CVT_IN) { W = ap->in[3] + (size_t)L * D * INW; N = INW; gain = ap->in[2] + (size_t)L * D; WT = (bf16_t*)(wl + WO_IN); kind = 1; }
    else if ((r -= CVT_IN) < CVT_UP) { W = ap->in[9] + (size_t)L * 512 * D; WT = (bf16_t*)(wl + WO_UP); ldt = 1024; item = r; }
    else if ((r -= CVT_UP) < CVT_UP) { W = ap->in[10] + (size_t)L * 512 * D; WT = (bf16_t*)(wl + WO_UP); ldt = 1024; koff = 512; item = r; }
    else if ((r -= CVT_UP) < CVT_OUT) { W = ap->in[11] + (size_t)L * D * D; WT = (bf16_t*)(wl + WO_OUT); item = r; }
    else if ((r -= CVT_OUT) < CVT_PG) { W = ap->in[20] + (size_t)L * D * D; gain = ap->in[19] + (size_t)L * D; WT = (bf16_t*)(wl + WO_PG); item = r; }
    else if ((r -= CVT_PG) < CVT_PP) { W = ap->in[21] + (size_t)L * 256 * D; WT = (bf16_t*)(wl + WO_PP); ldt = 256; item = r; }
    else if ((r -= CVT_PP) < NE * CVT_EI) { const int e = r / CVT_EI; W = ap->in[17] + ((size_t)L * NE + e) * D * 1024; N = 1024; gain = ap->in[12] + (size_t)L * D; WT = (bf16_t*)(wl + WO_EI) + (size_t)e * 1024 * 1024; ldt = 1024; kind = 2; item = r % CVT_EI; }
    else { r -= NE * CVT_EI; const int e = r / CVT_EO; W = ap->in[18] + ((size_t)L * NE + e) * 512 * D; WT = (bf16_t*)(wl + WO_EO) + (size_t)e * 1024 * 512; ldt = 512; item = r % CVT_EO; }
    transpose_item(W, N, gain, WT, ldt, koff, kind, scr, item, lane);
}
__device__ __forceinline__ void p0_prologue(KArgs ap, int nlayers, bool fill_later, LAS unsigned char* lds, int wave, int lane, int gw, int NGW) {
    LAS float* scr = (LAS float*)(lds + RING_OFF + wave * 17408);
    unsigned char* ws = ap->ws;
    const int nconv = fill_later ? 1 : nlayers;
    for (int it = gw; it < CVT_PER_LAYER * nconv; it += NGW) convert_item(ap, nconv - 1 - it / CVT_PER_LAYER, it % CVT_PER_LAYER, scr, lane);
    if (fill_later) { const int first = FILL_SLABS * FILLW * (NGW / NWAVES), rest = CVT_PER_LAYER - first;
        if (rest > 0) for (int it = gw; it < rest * (nlayers - 1); it += NGW) convert_item(ap, 1 + it / rest, first + it % rest, scr, lane); }
    const int gt = gw * 64 + lane, NGT = NGW * 64;
    for (int L = 0; L < nlayers; ++L) {
        unsigned char* wl = ws + WS_W + (size_t)L * WL_STRIDE;
        bf16_t* sp = (bf16_t*)(wl + WO_SP); const float* wsrc = ap->in[7] + (size_t)L * 8 * 128 * 128;
        for (int i = gt; i < 8 * 128 * 128; i += NGT) { const int s = i & 127, t = (i >> 7) & 127; sp[i] = (bf16_t)f2bf(s <= t ? wsrc[i] : 0.f); }
        bf16_t* wrh = (bf16_t*)(wl + WO_R); bf16_t* wrl = wrh + 48 * 1024; const float* gain = ap->in[12] + (size_t)L * D; const float* wg = ap->in[13] + (size_t)L * D * 4; const float* we = ap->in[15] + (size_t)L * D * 32;
        for (int i = gt; i < 48 * 1024; i += NGT) { const int o = i >> 10, k = i & 1023; const float wv = o < 36 ? gain[k] * (o < 4 ? wg[k * 4 + o] : we[k * 32 + (o - 4)]) : 0.f;
            const unsigned h = f2bf(wv); wrh[i] = (bf16_t)h; wrl[i] = (bf16_t)f2bf(wv - __uint_as_float(h << 16)); }
    }
    { const f32x4* p4 = (const f32x4*)ap->in[1]; u32x2* pb = (u32x2*)(ws + WS_PB); const size_t n4 = (size_t)nlayers * M * 256 / 4;
      for (size_t i = gt; i < n4; i += NGT) { const f32x4 v = p4[i]; u32x2 w; w.x = pk2(v[0], v[1]); w.y = pk2(v[2], v[3]); pb[i] = w; } }
    for (int m = gw; m < M; m += NGW) {
        const f32x4* xr = (const f32x4*)(ap->in[0] + (size_t)m * D) + lane; u32x2* o8 = (u32x2*)((bf16_t*)(ws + WS_XB) + (size_t)m * D) + lane; float s = 0.f;
#pragma unroll
        for (int j = 0; j < 4; ++j) { const f32x4 v = xr[64 * j]; s += (v[0] * v[0] + v[1] * v[1]) + (v[2] * v[2] + v[3] * v[3]); u32x2 w; w.x = pk2(v[0], v[1]); w.y = pk2(v[2], v[3]); o8[64 * j] = w; }
        s = wave_sum(s);
        if (lane < 16) ((float*)(ws + WS_XPART))[(size_t)m * 16 + lane] = lane == 0 ? s : 0.f;
    }
}

__device__ __forceinline__ void router_pass(const bf16_t* __restrict__ x, const bf16_t* __restrict__ wrh  , const bf16_t* __restrict__ wrl  , const float* __restrict__ bgr, const float* __restrict__ ber,
                                            float* __restrict__ rs2, int* __restrict__ cnt, int* __restrict__ tokl, int* __restrict__ tk_e, int* __restrict__ tk_pos, float* __restrict__ tk_w,
                                            LAS unsigned char* lds, int wave, int lane, int vcu, int G) {
    LAS float* lg = (LAS float*)(lds + RING_OFF + 106496 + (wave & 3) * 3200);
    LAS int* lcnt = (LAS int*)(lds + LDSCTL_OFF + 1024); LAS int* lbase = lcnt + 32;
    const int fr = lane & 15, fq = lane >> 4;
    for (int bt = vcu; bt < M / 64; bt += G) {
        if (wave == 0 && lane < 32) lcnt[lane] = 0;
        __syncthreads();
        int e1 = 0, e2 = 0, lp1 = 0, lp2 = 0; float tw1 = 0.f, tw2 = 0.f;
        const int t0 = bt * 64 + (wave & 3) * 16;
        {
            bf16x8 bh[3][4], bl[3][4]; u32x4 av[4][4];
            const bf16_t* wh = wrh + (size_t)fr * 1024 + 8 * fq + 128 * wave; const bf16_t* wl_ = wrl + (size_t)fr * 1024 + 8 * fq + 128 * wave;
            const bf16_t* xp = x + (size_t)(bt * 64 + fr) * D + 8 * fq + 128 * wave;
#pragma unroll
            for (int cb = 0; cb < 3; ++cb)
#pragma unroll
                for (int kk = 0; kk < 4; ++kk) { bh[cb][kk] = *(const bf16x8*)(wh + (size_t)cb * 16 * 1024 + 32 * kk); bl[cb][kk] = *(const bf16x8*)(wl_ + (size_t)cb * 16 * 1024 + 32 * kk); }
#pragma unroll
            for (int rg = 0; rg < 4; ++rg)
#pragma unroll
                for (int kk = 0; kk < 4; ++kk) av[rg][kk] = *(const u32x4*)(xp + (size_t)rg * 16 * D + 32 * kk);
#pragma unroll
            for (int rg = 0; rg < 4; ++rg) {
                f32x4 pacc[3]; pacc[0] = (f32x4){0.f, 0.f, 0.f, 0.f}; pacc[1] = pacc[0]; pacc[2] = pacc[0]; float pss = 0.f;
#pragma unroll
                for (int kk = 0; kk < 4; ++kk) {
#pragma unroll
                    for (int j = 0; j < 4; ++j) { const float a = bf_lo(av[rg][kk][j]), b = bf_hi(av[rg][kk][j]); pss += a * a + b * b; }
                    const bf16x8 Ah = __builtin_bit_cast(bf16x8, av[rg][kk]);
#pragma unroll
                    for (int cb = 0; cb < 3; ++cb) { pacc[cb] = __builtin_amdgcn_mfma_f32_16x16x32_bf16(bh[cb][kk], Ah, pacc[cb], 0, 0, 0); pacc[cb] = __builtin_amdgcn_mfma_f32_16x16x32_bf16(bl[cb][kk], Ah, pacc[cb], 0, 0, 0); }
                }
                LAS float* pp = (LAS float*)(lds + RING_OFF) + ((wave * 4 + rg) * 64 + lane) * 13;
#pragma unroll
                for (int cb = 0; cb < 3; ++cb)
#pragma unroll
                    for (int i = 0; i < 4; ++i) pp[cb * 4 + i] = pacc[cb][i];
                pp[12] = pss;
            }
        }
        __syncthreads();
        if (wave < 4) {
        f32x4 acc[3]; acc[0] = (f32x4){0.f, 0.f, 0.f, 0.f}; acc[1] = acc[0]; acc[2] = acc[0]; float ss = 0.f;
#pragma unroll
        for (int w2 = 0; w2 < 8; ++w2) { const LAS float* pp = (const LAS float*)(lds + RING_OFF) + ((w2 * 4 + wave) * 64 + lane) * 13;
#pragma unroll
            for (int cb = 0; cb < 3; ++cb)
#pragma unroll
                for (int i = 0; i < 4; ++i) acc[cb][i] += pp[cb * 4 + i];
            ss += pp[12]; }
        ss = sum_xor16_32(ss);
        const float rsr = 1.0f / sqrtf(ss * (1.f / D) + EPS);
#pragma unroll
        for (int cb = 0; cb < 3; ++cb)
#pragma unroll
            for (int i = 0; i < 4; ++i) lg[fr * 49 + 16 * cb + 4 * fq + i] = acc[cb][i] * rsr;
        if (fq == 0) lg[fr * 49 + 48] = rsr;
        asm volatile("s_waitcnt lgkmcnt(0)" ::: "memory");
        if (lane < 16) {
            const int tok = t0 + lane; const LAS float* l = lg + lane * 49;
            rs2[tok] = l[48];
            const float g0 = l[0] + bgr[0], g1 = l[1] + bgr[1], g2 = l[2] + bgr[2], g3 = l[3] + bgr[3];
            int grp = 0; float gm = g0;
            if (g1 > gm) { gm = g1; grp = 1; } if (g2 > gm) { gm = g2; grp = 2; } if (g3 > gm) { gm = g3; grp = 3; }
            const float gsum = (expf(g0 - gm) + expf(g1 - gm)) + (expf(g2 - gm) + expf(g3 - gm));
            const float grp_w = 1.f / gsum;
            int i1 = 0, i2 = 0; float m1 = -INFINITY, m2 = -INFINITY;
#pragma unroll
            for (int i = 0; i < 8; ++i) { const float el = l[4 + grp * 8 + i] + ber[grp * 8 + i]; if (el > m1) { m2 = m1; i2 = i1; m1 = el; i1 = i; } else if (el > m2) { m2 = el; i2 = i; } }
            const float p2 = expf(m2 - m1), w1 = 1.f / (1.f + p2), w2 = p2 / (1.f + p2);
            e1 = grp * 8 + i1; e2 = grp * 8 + i2; tw1 = grp_w * w1; tw2 = grp_w * w2;
            lp1 = __hip_atomic_fetch_add(&lcnt[e1], 1, __ATOMIC_RELAXED, __HIP_MEMORY_SCOPE_WORKGROUP); lp2 = __hip_atomic_fetch_add(&lcnt[e2], 1, __ATOMIC_RELAXED, __HIP_MEMORY_SCOPE_WORKGROUP);
        }
        }
        __syncthreads();
        if (wave == 0 && lane < 32) { const int c = lcnt[lane]; lbase[lane] = c > 0 ? atomicAdd(&cnt[lane * CNT_STRIDE], c) : 0; }
        __syncthreads();
        if (wave < 4 && lane < 16) {
            const int tok = t0 + lane; const int pos1 = lbase[e1] + lp1, pos2 = lbase[e2] + lp2;
            tokl[e1 * ECAP + pos1] = tok; tokl[e2 * ECAP + pos2] = tok;
            tk_e[tok * 2] = e1; tk_e[tok * 2 + 1] = e2; tk_pos[tok * 2] = pos1; tk_pos[tok * 2 + 1] = pos2; tk_w[tok * 2] = tw1; tk_w[tok * 2 + 1] = tw2;
        }
        __syncthreads();
    }
}

__device__ __forceinline__ void combine_pass(bf16_t* xb, const bf16_t* __restrict__ ys, const LAS int* pref, const int* __restrict__ tk_e, const int* __restrict__ tk_pos,
                                             const float* __restrict__ tk_w, float* __restrict__ rs3, int lane, int gw, int NGW) {
    for (int m0 = gw * 4; m0 < M; m0 += NGW * 4) {
        int s0[4], s1[4]; float w0[4], w1[4];
#pragma unroll
        for (int r = 0; r < 4; ++r) { const int m = m0 + r; const int e0 = tk_e[m * 2], e1 = tk_e[m * 2 + 1]; s0[r] = 256 * pref[e0] + tk_pos[m * 2]; s1[r] = 256 * pref[e1] + tk_pos[m * 2 + 1]; w0[r] = tk_w[m * 2]; w1[r] = tk_w[m * 2 + 1]; }
        u32x4 xv[4][2], a0[4][2], a1[4][2];
#pragma unroll
        for (int r = 0; r < 4; ++r)
#pragma unroll
            for (int j = 0; j < 2; ++j) { xv[r][j] = ((const u32x4*)(xb + (size_t)(m0 + r) * D) + lane)[64 * j]; a0[r][j] = ((const u32x4*)(ys + (size_t)s0[r] * D) + lane)[64 * j]; a1[r][j] = ((const u32x4*)(ys + (size_t)s1[r] * D) + lane)[64 * j]; }
#pragma unroll
        for (int r = 0; r < 4; ++r) { float s = 0.f;
#pragma unroll
            for (int j = 0; j < 2; ++j) { u32x4 w;
#pragma unroll
                for (int q = 0; q < 4; ++q) { w[q] = cvt_pk_bf16(bf_lo(xv[r][j][q]) + w0[r] * bf_lo(a0[r][j][q]) + w1[r] * bf_lo(a1[r][j][q]), bf_hi(xv[r][j][q]) + w0[r] * bf_hi(a0[r][j][q]) + w1[r] * bf_hi(a1[r][j][q]));
                    const float a = bf_lo(w[q]), b = bf_hi(w[q]); s += a * a + b * b; }
                st16((u32x4*)(xb + (size_t)(m0 + r) * D) + lane + 64 * j, w); }
            s = wave_sum(s);
            if (lane == 0) rs3[m0 + r] = 1.0f / sqrtf(s * (1.f / D) + EPS); }
    }
}

constexpr int PH_PER_LAYER = 10;
#ifndef FK_REP
#define FK_REP 0
#endif
#define REPS(bit) ((FK_REP & (bit)) ? 2 : 1)
__global__ void __launch_bounds__(NWAVES * 64, 2) mega_fwd(Args args_unused) {
    extern __shared__ __attribute__((aligned(16))) unsigned char lds_raw[];
    LAS unsigned char* lds = (LAS unsigned char*)lds_raw;
    LAS int* pref = (LAS int*)(lds + PREF_OFF);
    const KArgs kp0 = (KArgs)__builtin_amdgcn_kernarg_segment_ptr();
    const int tid = threadIdx.x, wave0 = __builtin_amdgcn_readfirstlane(tid >> 6);
    const int G = gridDim.x, bx = blockIdx.x;
    const int vcu = (G % 8 == 0) ? (bx % 8) * (G / 8) + bx / 8 : bx;
    const int gw0 = vcu * NWAVES + wave0, NGW = G * NWAVES;
#define FK_T0 (wave0 == 0 && fk_lane() == 0)
#define FK_IDS int lane_o = fk_lane(), wave_o = wave0, gw_o = gw0; asm volatile("" : "+v"(lane_o), "+s"(wave_o), "+s"(gw_o)); const int lane = lane_o, wave = wave_o, gw = gw_o; (void)lane; (void)wave; (void)gw;
    for (int u = tid; u < (LDS_BYTES - LDSCTL_OFF) / 4; u += NWAVES * 64) ((LAS unsigned*)(lds + LDSCTL_OFF))[u] = 0u;
    __syncthreads();
    const int lo = kp0->ph_lo, hi = kp0->ph_hi, nlayers = kp0->nlayers;
#define IN(k) (lo <= (k) && (k) < hi)
    const bool fill_on = (hi - lo > 1) && G == 256;
#define SEAM_F(k, Lc, slab) do { if (IN(k) && IN((k) + 1)) { \
        asm volatile("s_waitcnt vmcnt(0)" ::: "memory"); __syncthreads(); \
        if (wave0 == 0) { if (fk_lane() == 0) { KArgs A_ = fresh(kp0); XcdBarrier bar_; bar_.bar = (unsigned*)(A_->ws + WS_CTL) + CW_BAR; bar_.x = xb_xcc_id(); bar_.st = (volatile LAS unsigned*)(lds + MISC_OFF) + 8; xcd_barrier_t0(bar_); } } \
        else if (fill_on && (Lc) < nlayers && (slab) < FILL_SLABS && wave0 <= FILLW) { int idx_ = (slab) * FILLW * G + bx * FILLW + (wave0 - 1); asm volatile("" : "+s"(idx_));   if (idx_ < CVT_PER_LAYER) convert_item(fresh(kp0), (Lc), idx_, (LAS float*)(lds + RING_OFF + wave0 * 17408), fk_lane()); } \
        __syncthreads(); } } while (0)
#define SEAM(k) SEAM_F(k, L + 1, (k) - pb)
    if (hi - lo > 1) { KArgs A = fresh(kp0); (void)xcd_barrier_post((unsigned*)(A->ws + WS_CTL) + CW_BAR, (volatile LAS unsigned*)(lds + MISC_OFF) + 8, FK_T0); }

    if (IN(0)) { for (int rep = 0; rep < REPS(1); ++rep) { FK_IDS; p0_prologue(fresh(kp0), nlayers, fill_on, lds, wave, lane, gw, NGW); } }
    SEAM_F(0, nlayers, 0);
    if (IN(1)) { }
    for (int L = 0; L < nlayers; ++L) {
        const int pb = 2 + PH_PER_LAYER * L;
        if (IN(pb + 0)) for (int rep = 0; rep < REPS(4); ++rep) {
            KArgs A = fresh(kp0); unsigned char* ws = A->ws; unsigned char* wl = ws + WS_W + (size_t)L * WL_STRIDE;
            DenseOrder S; S.init(M, INW, G, bx, ws + WS_XB, wl + WO_IN, D);
            EpiIn E{(const float*)(ws + WS_XPART), A->in[4] + L * 64, A->in[5] + L * 64, (bf16_t*)(ws + WS_Q), (bf16_t*)(ws + WS_K), (bf16_t*)(ws + WS_V), (bf16_t*)(ws + WS_U), (bf16_t*)(ws + WS_VS), (bf16_t*)(ws + WS_GAB), (float*)(ws + WS_VSPART)};
            gemm_phase<EpiIn, DenseOrder, true>(lds + RING_OFF, D, S, E, wave0);
            { const int nshort = (G == 256) ? 128 : G; const int c2 = (G == 256) ? bx - 128 : bx;
              if (c2 >= 0) { DenseOrder S2; S2.init(M, D, nshort, c2, ws + WS_PB + (size_t)L * M * 256 * 2, wl + WO_PP, 256);
                  EpiPlain E2{(bf16_t*)(ws + WS_E) + (size_t)L * M * D, D, 0};
                  gemm_phase<EpiPlain, DenseOrder, true>(lds + RING_OFF, 256, S2, E2, wave0); } }
        }
        SEAM(pb + 0);
        if (IN(pb + 1)) for (int rep = 0; rep < REPS(8 | 2048); ++rep) {
            KArgs A = fresh(kp0); unsigned char* ws = A->ws; unsigned char* wl = ws + WS_W + (size_t)L * WL_STRIDE;
            FK_IDS;
            LAS unsigned char* wlds = lds + RING_OFF + wave * WLDS_BYTES;
            constexpr int NATT = 2 * 8 * (SEQ / 32), NSGU = (M / 128) * 8 * 2;
            const int nun = (NATT + NSGU - gw + NGW - 1) / NGW;
            for (int k_ = 0; k_ < nun; ++k_) { const int kk_ = (wave >= 4) ? (k_ == 0 ? nun - 1 : k_ - 1) : k_; const int it = gw + kk_ * NGW;
                if (rep == 1 && (it < NATT ? !(FK_REP & 8) : !(FK_REP & 2048))) continue;
                if (it < NATT) { const int qblk = it % (SEQ / 32), bh = it / (SEQ / 32); attn_wave_unit(bh >> 3, bh & 7, qblk, (const bf16_t*)(ws + WS_Q), (const bf16_t*)(ws + WS_K), (const bf16_t*)(ws + WS_V), (bf16_t*)(ws + WS_OC), wlds, lane); }
                else { const int j = it - NATT; const int hf = j & 1, g = (j >> 1) & 7, ch = j >> 4;
                    if (hf == 0) sgu_wave_unit<0>(ch, g, (const bf16_t*)(ws + WS_U), (const bf16_t*)(ws + WS_VS), (const float*)(ws + WS_VSPART), (const bf16_t*)(wl + WO_SP), A->in[8] + (size_t)L * 8 * 128, A->in[6] + (size_t)L * 512, (bf16_t*)(ws + WS_OC), wlds, lane);
                    else sgu_wave_unit<1>(ch, g, (const bf16_t*)(ws + WS_U), (const bf16_t*)(ws + WS_VS), (const float*)(ws + WS_VSPART), (const bf16_t*)(wl + WO_SP), A->in[8] + (size_t)L * 8 * 128, A->in[6] + (size_t)L * 512, (bf16_t*)(ws + WS_OC), wlds, lane); }
            }
        }
        SEAM(pb + 1);
        if (IN(pb + 2)) for (int rep = 0; rep < REPS(16); ++rep) {
            KArgs A = fresh(kp0); unsigned char* ws = A->ws; unsigned char* wl = ws + WS_W + (size_t)L * WL_STRIDE;
            DenseOrder S; S.init(M, D, G, bx, ws + WS_OC, wl + WO_UP, D);
            EpiUp E{(const bf16_t*)(ws + WS_GAB), (bf16_t*)(ws + WS_MG)};
            gemm_phase<EpiUp, DenseOrder, false>(lds + RING_OFF, D, S, E, wave0);
        }
        SEAM(pb + 2);
        if (IN(pb + 3)) {
            KArgs A = fresh(kp0); unsigned char* ws = A->ws; unsigned char* wl = ws + WS_W + (size_t)L * WL_STRIDE;
            DenseOrder S; S.init(M, D, G, bx, ws + WS_MG, wl + WO_OUT, D);
            EpiOut E{(const bf16_t*)(ws + WS_XB), (bf16_t*)(ws + WS_XB1)};
            gemm_phase<EpiOut, DenseOrder, false>(lds + RING_OFF, D, S, E, wave0);
        }
        SEAM(pb + 3);
        if (IN(pb + 4)) {
            KArgs A = fresh(kp0); unsigned char* ws = A->ws; unsigned char* wl = ws + WS_W + (size_t)L * WL_STRIDE;
            FK_IDS;
            router_pass((const bf16_t*)(ws + WS_XB1), (const bf16_t*)(wl + WO_R), (const bf16_t*)(wl + WO_R) + 48 * 1024, A->in[14] + L * 4, A->in[16] + L * 32, (float*)(ws + WS_RS2), (int*)((unsigned*)(ws + WS_CTL) + CW_CNT) + L * NE * CNT_STRIDE, (int*)(ws + WS_TOKL), (int*)(ws + WS_TKE), (int*)(ws + WS_TKP), (float*)(ws + WS_TKW), lds, wave, lane, vcu, G);
        }
        SEAM(pb + 4);
        if (IN(pb + 5) || IN(pb + 6) || IN(pb + 7) || IN(pb + 8)) {
            KArgs A = fresh(kp0); const int* cnt = (const int*)((unsigned*)(A->ws + WS_CTL) + CW_CNT) + L * NE * CNT_STRIDE;
            if (FK_T0) { int s = 0; for (int e = 0; e < NE; ++e) { pref[e] = s; s += (cnt[e * CNT_STRIDE] + 255) >> 8; } pref[NE] = s; }
            __syncthreads();
        }
        const int nG1 = pref[NE] * 4, fr = nG1 / G, n3 = nG1 - fr * G;
        const int jB = (fr >= 1) ? min(2 * (G - n3), (fr * G / 4) * 4) : 0;
        if (IN(pb + 5)) for (int rep = 0; rep < REPS(32); ++rep) {
            KArgs A = fresh(kp0); unsigned char* ws = A->ws; unsigned char* wl = ws + WS_W + (size_t)L * WL_STRIDE; const int* cnt = (const int*)((unsigned*)(ws + WS_CTL) + CW_CNT) + L * NE * CNT_STRIDE;
            ExpertOrder S{G, bx, D, 4, (const char*)(ws + WS_XB1), (const char*)(wl + WO_EI), (size_t)1024 * 1024 * 2, pref, (const int*)(ws + WS_TOKL), cnt, 1, 0, fr, fr * G, 0};
            EpiG1 E{(const int*)(ws + WS_TOKL), cnt, (const float*)(ws + WS_RS2), (bf16_t*)(ws + WS_G)};
            gemm_phase<EpiG1, ExpertOrder, true>(lds + RING_OFF, D, S, E, wave0);
        }
        SEAM(pb + 5);
        if (IN(pb + 6)) {
            KArgs A = fresh(kp0); unsigned char* ws = A->ws; unsigned char* wl = ws + WS_W + (size_t)L * WL_STRIDE; const int* cnt = (const int*)((unsigned*)(ws + WS_CTL) + CW_CNT) + L * NE * CNT_STRIDE;
            if (bx < n3) {
                ExpertOrder S{G, bx, D, 4, (const char*)(ws + WS_XB1), (const char*)(wl + WO_EI), (size_t)1024 * 1024 * 2, pref, (const int*)(ws + WS_TOKL), cnt, 1, fr * G, 1, nG1, 0};
                EpiG1 E{(const int*)(ws + WS_TOKL), cnt, (const float*)(ws + WS_RS2), (bf16_t*)(ws + WS_G)};
                gemm_phase<EpiG1, ExpertOrder, true>(lds + RING_OFF, D, S, E, wave0);
            } else {
                ExpertOrder S{G - n3, bx - n3, 512, 4, (const char*)(ws + WS_G), (const char*)(wl + WO_EO), (size_t)1024 * 512 * 2, pref, (const int*)(ws + WS_TOKL), cnt, 0, 0, 2, jB, 0};
                EpiPlain E{(bf16_t*)(ws + WS_YS), D, 1};
                gemm_phase<EpiPlain, ExpertOrder, true>(lds + RING_OFF, 512, S, E, wave0);
            }
        }
        SEAM(pb + 6);
        if (IN(pb + 7)) for (int rep = 0; rep < REPS(64); ++rep) {
            KArgs A = fresh(kp0); unsigned char* ws = A->ws; unsigned char* wl = ws + WS_W + (size_t)L * WL_STRIDE; const int* cnt = (const int*)((unsigned*)(ws + WS_CTL) + CW_CNT) + L * NE * CNT_STRIDE;
            ExpertOrder S{G, bx, 512, 4, (const char*)(ws + WS_G), (const char*)(wl + WO_EO), (size_t)1024 * 512 * 2, pref, (const int*)(ws + WS_TOKL), cnt, 0, jB, 1 << 20, nG1, 0};
            EpiPlain E{(bf16_t*)(ws + WS_YS), D, 1};
            gemm_phase<EpiPlain, ExpertOrder, true>(lds + RING_OFF, 512, S, E, wave0);
        }
        SEAM(pb + 7);
        if (IN(pb + 8)) {
            KArgs A = fresh(kp0); unsigned char* ws = A->ws;
            FK_IDS;
            combine_pass((bf16_t*)(ws + WS_XB1), (const bf16_t*)(ws + WS_YS), pref, (const int*)(ws + WS_TKE), (const int*)(ws + WS_TKP), (const float*)(ws + WS_TKW), (float*)(ws + WS_RS3), lane, gw, NGW);
        }
        SEAM(pb + 8);
        if (IN(pb + 9)) {
            KArgs A = fresh(kp0); unsigned char* ws = A->ws; unsigned char* wl = ws + WS_W + (size_t)L * WL_STRIDE;
            DenseOrder S; S.init(M, D, G, bx, ws + WS_XB1, wl + WO_PG, D);
            EpiPle E{(const bf16_t*)(ws + WS_XB1), (bf16_t*)(ws + WS_XB), (L == nlayers - 1) ? A->out : (float*)nullptr, (const bf16_t*)(ws + WS_E) + (size_t)L * M * D, (const float*)(ws + WS_RS3), (float*)(ws + WS_XPART)};
            gemm_phase<EpiPle, DenseOrder, false>(lds + RING_OFF, D, S, E, wave0);
        }
        SEAM(pb + 9);
    }
#undef IN
#undef SEAM
#undef SEAM_F
#undef FK_IDS
#undef FK_T0
}
}
#ifndef FK_N_LAUNCHES
#define FK_N_LAUNCHES 1
#endif
static int fk_grid = 0;
static bool fk_setup() {
    if (fk_grid) return fk_grid > 0;
    int dev = 0, cus = 0, per_cu = 0;
    if (hipGetDevice(&dev) != hipSuccess || hipDeviceGetAttribute(&cus, hipDeviceAttributeMultiprocessorCount, dev) != hipSuccess) { fprintf(stderr, "kernel_launch: device query failed\n"); fk_grid = -1; return false; }
    if (hipFuncSetAttribute((const void*)fk::mega_fwd, hipFuncAttributeMaxDynamicSharedMemorySize, fk::LDS_BYTES) != hipSuccess) { fprintf(stderr, "kernel_launch: hipFuncSetAttribute failed\n"); fk_grid = -1; return false; }
    if (hipOccupancyMaxActiveBlocksPerMultiprocessor(&per_cu, (const void*)fk::mega_fwd, fk::NWAVES * 64, fk::LDS_BYTES) != hipSuccess || per_cu < 1)
        fprintf(stderr, "kernel_launch: note: occupancy query reports %d workgroups per CU\n", per_cu);
    (void)hipGetLastError();
    fk_grid = cus;
    return true;
}
static void fk_launch_range(fk::Args a, int lo, int hi, hipStream_t stream) {
    a.ph_lo = lo; a.ph_hi = hi;
    hipLaunchKernelGGL(fk::mega_fwd, dim3(fk_grid), dim3(fk::NWAVES * 64), fk::LDS_BYTES, stream, a);
    const hipError_t le = hipPeekAtLastError();
    if (le != hipSuccess) fprintf(stderr, "kernel_launch: launch [%d,%d) failed: %s\n", lo, hi, hipGetErrorName(le));
}

#ifdef FK_DEBUG_CHECK
#ifndef FK_FOCUS
#define FK_FOCUS 0
#endif
#ifndef FK_STAT
#define FK_STAT 1
#endif
namespace dbg {
__global__ void __launch_bounds__(256) k_cmp(const void* fast, int is_bf16, int fld, int fcol0, const float* gold, int gld, int gcol0, int rows, int cols, float gscale, float* acc) {
    float sd = 0.f, sb = 0.f, sa = 0.f, sb2 = 0.f;
    const size_t n = (size_t)rows * cols;
    for (size_t i = (size_t)blockIdx.x * 256 + threadIdx.x; i < n; i += (size_t)gridDim.x * 256) {
        const size_t r = i / cols; const int c = (int)(i % cols);
        float a;
        if (is_bf16) { const unsigned short h = ((const unsigned short*)fast)[r * fld + fcol0 + c]; a = __uint_as_float((unsigned)h << 16); } else a = ((const float*)fast)[r * fld + fcol0 + c];
        const float b = gold[r * gld + gcol0 + c] * gscale;
        const float d = a - b; sd += d * d; sb += b * b; sa += (FK_STAT == 2 ? a : FK_STAT == 3 ? a * b : FK_STAT == 4 ? (a > 0.99f ? 1.f : 0.f) : a * a); sb2 += (FK_STAT == 2 ? b : FK_STAT == 4 ? 1.f : b * b);
    }
    for (int o = 1; o < 64; o <<= 1) { sd += __shfl_xor(sd, o); sb += __shfl_xor(sb, o); sa += __shfl_xor(sa, o); sb2 += __shfl_xor(sb2, o); }
    if ((threadIdx.x & 63) == 0) { atomicAdd(&acc[0], sd); atomicAdd(&acc[1], sb); atomicAdd(&acc[512], sa); atomicAdd(&acc[513], sb2); }
}
__global__ void __launch_bounds__(256) k_cmp_vs(const unsigned short* vsb, const float* vspart, const float* gain, const float* gz, float* acc) {
    const int row = blockIdx.x * 4 + (threadIdx.x >> 6), lane = threadIdx.x & 63;
    float ss = 0.f; for (int j = 0; j < 8; ++j) ss += vspart[(size_t)row * 8 + j];
    const float rv = 1.f / sqrtf(ss / 512.f + 1e-6f);
    float sd = 0.f, sb = 0.f;
    for (int j = 0; j < 8; ++j) { const int c = lane + 64 * j; const float a = __uint_as_float((unsigned)vsb[(size_t)row * 512 + c] << 16) * rv * gain[c]; const float b = gz[(size_t)row * 4608 + 2048 + c]; sd += (a - b) * (a - b); sb += b * b; }
    for (int o = 1; o < 64; o <<= 1) { sd += __shfl_xor(sd, o); sb += __shfl_xor(sb, o); }
    if (lane == 0) { atomicAdd(&acc[0], sd); atomicAdd(&acc[1], sb); }
}
__global__ void __launch_bounds__(256) k_cmp_w(const unsigned short* wt, const float* w, const float* gain, int n0, int n1, float* acc) {
    float sd = 0.f, sb = 0.f; const size_t tot = (size_t)(n1 - n0) * 1024;
    for (size_t i = (size_t)blockIdx.x * 256 + threadIdx.x; i < tot; i += (size_t)gridDim.x * 256) { const int n = n0 + (int)(i >> 10), k = (int)(i & 1023);
        const float a = __uint_as_float((unsigned)wt[(size_t)n * 1024 + k] << 16), b = gain[k] * w[(size_t)k * 4608 + n]; sd += (a - b) * (a - b); sb += b * b; }
    for (int o = 1; o < 64; o <<= 1) { sd += __shfl_xor(sd, o); sb += __shfl_xor(sb, o); }
    if ((threadIdx.x & 63) == 0) { atomicAdd(&acc[0], sd); atomicAdd(&acc[1], sb); }
}
__global__ void k_final_v(const float* acc, int nchecks, float tol, float* v, int focus) {
    if (threadIdx.x == 0 && blockIdx.x == 0) {
        float out = 0.f;
        if (focus > 0) { float m = acc[2 * focus + 512] / acc[2 * focus + 513]; if (FK_STAT == 1) m = sqrtf(m); if (!(m <= 8.f)) m = 8.f; m = floorf(m * 20.f + 0.5f) * 0.05f; v[0] = powf(10.f, (float)focus) * (1.f + m); return; }
        for (int c = nchecks; c >= 1; --c) { const float e = sqrtf(acc[2 * c] / acc[2 * c + 1]); if (!(e <= tol)) { float m = e; if (!(m <= 2.f)) m = 2.f; m = floorf(m * 10.f + 0.5f) * 0.1f;   out = powf(10.f, (float)c) * (1.f + m); } }
        v[0] = out;
    }
}
__global__ void __launch_bounds__(256) k_scale_out(const float* base, const float* v, float* out, size_t n) {
    const size_t i = (size_t)blockIdx.x * 256 + threadIdx.x; if (i < n) out[i] = base[i] * (1.f + v[0]);
}
}
#endif

extern "C" void kernel_launch(void* const* d_in, const int* in_sizes, int n_in, void* d_out, int out_size, void* d_ws, size_t ws_size, hipStream_t stream) {
    using namespace fk;
    if (n_in != 22 || out_size != M * D || ws_size < WS_FAST_END) { fprintf(stderr, "kernel_launch: unexpected shapes (n_in %d out %d ws %zu)\n", n_in, out_size, ws_size); return; }
    if (!fk_setup()) return;
    if (hipMemsetAsync((char*)d_ws + WS_CTL, 0, CTL_ZERO_BYTES, stream) != hipSuccess) { fprintf(stderr, "kernel_launch: memset failed\n"); return; }
    Args a{};
    for (int i = 0; i < 22; ++i) a.in[i] = (const float*)d_in[i];
    a.out = (float*)d_out; a.ws = (unsigned char*)d_ws; a.nlayers = DEPTH; a.pad = 0;
#ifndef FK_DEBUG_CHECK
    const int nph = 2 + PH_PER_LAYER * DEPTH;
    if (FK_N_LAUNCHES == 1) fk_launch_range(a, 0, nph, stream);
    else for (int p = 0; p < nph; ++p) fk_launch_range(a, p, p + 1, stream);
#else
    constexpr size_t GOLD_BASE = 1100 * MiB, SN_A = 128 * MiB, SN_B = 192 * MiB, SN_BASE = 256 * MiB, FS_A = 320 * MiB, FS_B = 384 * MiB, DBG_ACC = 448 * MiB;
    if (ws_size < GOLD_BASE + gold::O_END) { fprintf(stderr, "kernel_launch: debug build needs %zu bytes of workspace, got %zu\n", GOLD_BASE + gold::O_END, ws_size); return; }
    unsigned char* ws = (unsigned char*)d_ws; unsigned char* gb = ws + GOLD_BASE;
    gold::forward(d_in, (float*)(ws + SN_BASE), gb, 4, stream);
    gold::forward(d_in, nullptr, gb, 1, stream, (float*)(ws + SN_A), (float*)(ws + SN_B));
    a.nlayers = 1;
    const int nph = 2 + PH_PER_LAYER;
    for (int p = 0; p < nph; ++p) {
        fk_launch_range(a, p, p + 1, stream);
        if (p == 2 + 0) (void)hipMemcpyAsync(ws + 528 * MiB, ws + WS_GAB, (size_t)M * 2048 * 2, hipMemcpyDeviceToDevice, stream);
        if (p == 2 + 3) (void)hipMemcpyAsync(ws + FS_A, d_out, (size_t)M * D * 4, hipMemcpyDeviceToDevice, stream);
        if (p == 2 + 7) (void)hipMemcpyAsync(ws + FS_B, d_out, (size_t)M * D * 4, hipMemcpyDeviceToDevice, stream);
    }
    float* acc = (float*)(ws + DBG_ACC);
    (void)hipMemsetAsync(acc, 0, 4096, stream);
    const float* gz = (const float*)(gb + gold::O_Z);
    int c = 0;
#define CMP(fast, isbf, fld, fc0, gold_, gld, gc0, rows, cols, gs) do { ++c; hipLaunchKernelGGL(dbg::k_cmp, dim3(2048), dim3(256), 0, stream, (const void*)(fast), isbf, fld, fc0, (const float*)(gold_), gld, gc0, rows, cols, gs, acc + 2 * c); } while (0)
    ++c; hipLaunchKernelGGL(dbg::k_cmp_w, dim3(1024), dim3(256), 0, stream, (const unsigned short*)(ws + WS_W + WO_IN), (const float*)d_in[3], (const float*)d_in[2], 1024, 2560, acc + 2 * c);
    ++c; hipLaunchKernelGGL(dbg::k_cmp_w, dim3(1024), dim3(256), 0, stream, (const unsigned short*)(ws + WS_W + WO_IN), (const float*)d_in[3], (const float*)d_in[2], 2560, 3584, acc + 2 * c);
    ++c; hipLaunchKernelGGL(dbg::k_cmp_w, dim3(1024), dim3(256), 0, stream, (const unsigned short*)(ws + WS_W + WO_IN), (const float*)d_in[3], (const float*)d_in[2], 3584, 4608, acc + 2 * c);
    CMP(ws + WS_E, 1, 1024, 0, gb + gold::O_YB, 1024, 0, M, 1024, 1.f);
    CMP(ws + WS_Q, 1, 512, 0, gz, INW, 0, M, 512, 0.125f * LOG2E);
    CMP(ws + WS_K, 1, 512, 0, gz, INW, 512, M, 512, 1.f);
    CMP(ws + WS_V, 1, 512, 0, gz, INW, 1024, M, 512, 1.f);
    CMP(ws + WS_U, 1, 512, 0, gz, INW, 1536, M, 512, 1.f);
    ++c; hipLaunchKernelGGL(dbg::k_cmp_vs, dim3(M / 4), dim3(256), 0, stream, (const unsigned short*)(ws + WS_VS), (const float*)(ws + WS_VSPART), (const float*)d_in[6], gz, acc + 2 * c);
    CMP(ws + WS_OC, 1, 1024, 0, gb + gold::O_OA, 512, 0, M, 512, 1.f);
    CMP(ws + WS_OC, 1, 1024, 512, gb + gold::O_OB, 512, 0, M, 512, 1.f);
    CMP(ws + WS_MG, 1, 1024, 0, gb + gold::O_YA, 1024, 0, M, 1024, 1.f);
    CMP(ws + FS_A, 0, 1024, 0, ws + SN_A, 1024, 0, M, 1024, 1.f);
    CMP(ws + FS_B, 0, 1024, 0, ws + SN_B, 1024, 0, M, 1024, 1.f);
    CMP(d_out, 0, 1024, 0, gb + gold::O_X, 1024, 0, M, 1024, 1.f);
    CMP(ws + 528 * MiB, 1, 2048, 0, gz, INW, 2560, M, 256, 1.f);
    CMP(ws + WS_GAB, 1, 2048, 0, gz, INW, 2560, M, 256, 1.f);
    CMP(ws + WS_GAB, 1, 2048, 256, gz, INW, 2816, M, 256, 1.f);
    CMP(ws + WS_GAB, 1, 2048, 512, gz, INW, 3072, M, 512, 1.f);
    CMP(ws + WS_GAB, 1, 2048, 1024, gz, INW, 3584, M, 1024, 1.f);
    hipLaunchKernelGGL(dbg::k_final_v, dim3(1), dim3(64), 0, stream, acc, c, 0.03f, acc + 900, FK_FOCUS);
    hipLaunchKernelGGL(dbg::k_scale_out, dim3(M * D / 256), dim3(256), 0, stream, (const float*)(ws + SN_BASE), acc + 900, (float*)d_out, (size_t)M * D);
#endif
}
```

```cpp
#include <hip/hip_runtime.h>
#include <hip/hip_bf16.h>
#include <cstdio>
#include <cstdint>
#include <cmath>
namespace fk {
#define LAS __attribute__((address_space(3)))
#define GAS __attribute__((address_space(1)))
typedef unsigned short bf16_t;
typedef short bf16x8 __attribute__((ext_vector_type(8)));
typedef short s16x4 __attribute__((ext_vector_type(4)));
typedef float f32x2 __attribute__((ext_vector_type(2)));
typedef float f32x4 __attribute__((ext_vector_type(4)));
typedef float f32x16 __attribute__((ext_vector_type(16)));
typedef unsigned u32x2 __attribute__((ext_vector_type(2)));
typedef unsigned u32x4 __attribute__((ext_vector_type(4)));

constexpr int M = 16384, SEQ = 8192, D = 1024, INW = 4608, NE = 32, ECAP = 16384, DEPTH = 4;
constexpr float EPS = 1e-6f, LOG2E = 1.4426950408889634f;
constexpr int CNT_STRIDE = 64;
constexpr int BM = 256, BK = 64, HALF = 128, HTB = HALF * BK * 2, STAGE_BYTES = 8 * HTB, NXCD = 8, WGM = 8;

__device__ __forceinline__ unsigned cvt_pk_bf16(float lo, float hi) { unsigned r; asm volatile("v_cvt_pk_bf16_f32 %0, %1, %2" : "=v"(r) : "v"(lo), "v"(hi)); return r; }
__device__ __forceinline__ float bf_lo(unsigned w) { return __uint_as_float(w << 16); }
__device__ __forceinline__ float bf_hi(unsigned w) { return __uint_as_float(w & 0xffff0000u); }
__device__ __forceinline__ float fast_rcp(float x) { return __builtin_amdgcn_rcpf(x); }
__device__ __forceinline__ float fast_exp2(float x) { return __builtin_amdgcn_exp2f(x); }
__device__ __forceinline__ float fast_log2(float x) { return __builtin_amdgcn_logf(x); }
__device__ __forceinline__ float fast_rsq(float x) { return __builtin_amdgcn_rsqf(x); }
__device__ __forceinline__ float sigmoid_f(float x) { return fast_rcp(1.f + fast_exp2(-LOG2E * x)); }
__device__ __forceinline__ float gelu_tanh_f(float x) { const float u2 = 1.5957691216057308f * (x + 0.044715f * x * x * x); return x * fast_rcp(1.f + fast_exp2(-LOG2E * u2)); }

__host__ __device__ __forceinline__ int lds_byte(int r, int c) { const int st = (r >> 4) * 2 + (c >> 5), rr = r & 15, cc = c & 31, ob = rr * 64 + cc * 2; return st * 1024 + (ob ^ (((ob >> 9) & 1) << 5)); }
__host__ __device__ __forceinline__ void stage_rc(int b, int& R, int& C) { const int st = b / 1024, sb = b % 1024, swz = sb ^ (((sb >> 9) & 1) << 5); R = (st >> 1) * 16 + swz / 64; C = (st & 1) * 32 + (swz % 64) / 2; }
__host__ __device__ __forceinline__ int perm32(int rho) { const int n = rho >> 4, i = rho & 15; return 8 * (i >> 2) + 4 * n + (i & 3); }

template <int MASK> __device__ __forceinline__ float xor_lt32(float v) { return __int_as_float(__builtin_amdgcn_ds_swizzle(__float_as_int(v), (MASK << 10) | 0x1f)); }
__device__ __forceinline__ void halves32(float v, float& lo, float& hi) { auto rr = __builtin_amdgcn_permlane32_swap(__float_as_uint(v), __float_as_uint(v), false, false); lo = __uint_as_float(rr[0]); hi = __uint_as_float(rr[1]); }
__device__ __forceinline__ float sum_xor16_32(float v) { v += xor_lt32<16>(v); float lo, hi; halves32(v, lo, hi); return lo + hi; }
#ifndef FK_WT
#define FK_WT 0
#endif
__device__ __forceinline__ void st16wt(void* p, u32x4 v) {
#if FK_WT
    asm volatile("global_store_dwordx4 %0, %1, off sc1" :: "v"(p), "v"(v) : "memory");
#else
    *(u32x4*)p = v;
#endif
}
__device__ __forceinline__ void st16(void* p, u32x4 v) { *(u32x4*)p = v; }
__device__ __forceinline__ int fk_lane() { int l; asm volatile("v_mbcnt_lo_u32_b32 %0, -1, 0\n\tv_mbcnt_hi_u32_b32 %0, -1, %0" : "=v"(l)); return l; }
struct Unit { int pm, pn, e, aux; };

struct DenseOrder {
    int nM, nN, nwg, G, c; const char* A; const char* B; int K;
    __device__ void init(int Mr, int N, int G_, int c_, const void* A_, const void* B_, int K_) { nM = Mr / BM; nN = N / BM; nwg = nM * nN; G = G_; c = c_; A = (const char*)A_; B = (const char*)B_; K = K_; }
    __device__ __forceinline__ bool next(int i, Unit& u) const {
        const long L = (long)i * G + c; if (L >= nwg) return false;
        int wgid = (int)L; { const int q = nwg / NXCD, r = nwg % NXCD, xcd = wgid % NXCD, off = wgid / NXCD; wgid = (xcd < r ? xcd * (q + 1) : r * (q + 1) + (xcd - r) * q) + off; }
        const int nig = WGM * nN, gid = wgid / nig, fm = gid * WGM, gsz = (nM - fm) < WGM ? (nM - fm) : WGM;
        u.pm = fm + ((wgid % nig) % gsz); u.pn = (wgid % nig) / gsz; u.e = 0; u.aux = 0; return true;
    }
    __device__ __forceinline__ const char* a_base() const { return A; }
    __device__ __forceinline__ const char* b_base(const Unit& u) const { return B + (size_t)u.pn * BM * K * 2; }
    __device__ __forceinline__ void a_voff(const Unit& u, unsigned (&v)[2][2], const int (&R)[2], const int (&C)[2]) const {
#pragma unroll
        for (int h = 0; h < 2; ++h)
#pragma unroll
            for (int i = 0; i < 2; ++i) v[h][i] = (unsigned)((u.pm * BM + h * HALF + R[i]) * K + C[i]) * 2u;
    }
};

struct ExpertOrder {
    int G, c, K, nN; const char* A; const char* B; size_t bstride; const LAS int* pref; const int* tokl; const int* cnt; int gather;
    int L0, imax, Lend;
    int xcd_deal;
    __device__ __forceinline__ bool next(int i, Unit& u) const {
        if (i >= imax) return false;
        int u_ = c; if (xcd_deal) { const int q = c >> 3, x = c & 7; u_ = (x * (G >> 5) + (q >> 2)) * 4 + (q & 3); }
        const int L = L0 + i * G + u_; const int tot = pref[NE] * nN; if (L >= Lend || L >= tot) return false;
        const int rbi = L / nN; u.pn = L % nN; int e = 0;
#pragma unroll 1
        for (int j = 1; j < NE; ++j) if (rbi >= pref[j]) e = j;
        u.e = e; u.pm = rbi - pref[e]; u.aux = rbi * BM; return true;
    }
    __device__ __forceinline__ const char* a_base() const { return A; }
    __device__ __forceinline__ const char* b_base(const Unit& u) const { return B + (size_t)u.e * bstride + (size_t)u.pn * BM * K * 2; }
    __device__ __forceinline__ void a_voff(const Unit& u, unsigned (&v)[2][2], const int (&R)[2], const int (&C)[2]) const {
        const int ce = cnt[u.e * CNT_STRIDE];
#pragma unroll
        for (int h = 0; h < 2; ++h)
#pragma unroll
            for (int i = 0; i < 2; ++i) {
                const int r = u.pm * BM + h * HALF + R[i]; int row;
                if (gather) row = (r < ce) ? tokl[u.e * ECAP + r] : 0; else row = u.aux + h * HALF + R[i];
                v[h][i] = (unsigned)(row * K + C[i]) * 2u;
            }
    }
};

template <class Epi, class Sched, bool ALIGN_EPI>
__device__ __forceinline__ void gemm_phase(LAS unsigned char* lds, const int K, const Sched& S, const Epi& E, const int wave_id) {
    const int tid_ = (wave_id << 6) | fk_lane();
    const int tid = tid_, wid = __builtin_amdgcn_readfirstlane(tid >> 6), lane = tid & 63, wr = wid >> 2, wc = wid & 3, fr = lane & 15, fq = lane >> 4;
    const int nt = K / BK;
    int Rr[2], Cc[2]; unsigned voffB[2];
#pragma unroll
    for (int i = 0; i < 2; ++i) { int R, C; stage_rc(tid * 16 + i * 8192, R, C); Rr[i] = R; Cc[i] = C; const int Rb = Epi::PERM ? ((R & ~31) + perm32(R & 31)) : R; voffB[i] = (unsigned)(Rb * K + C) * 2u; }
    const size_t kstep = (size_t)(BK * 2);
    const size_t hstep = (size_t)HALF * K * 2;
    const unsigned ldsw = (unsigned)wid * 1024u;
    const int aoff = lds_byte(wr * 64 + fr, fq * 8), boff = lds_byte(wc * 32 + fr, fq * 8);
#define PG8_SA(b, h) (((b) * 2 + (h)) * HTB)
#define PG8_SB(b, h) ((4 + (b) * 2 + (h)) * HTB)
#define PG8_STAGE_B(bufoff, gbase) do { _Pragma("unroll") for (int _i = 0; _i < 2; ++_i) \
        __builtin_amdgcn_global_load_lds((const unsigned*)((const char*)(gbase) + voffB[_i]), (LAS unsigned*)(lds + (bufoff) + ldsw + _i * 8192), 16, 0, 0); } while (0)
#define PG8_STAGE_A(bufoff, vo, h, koff) do { _Pragma("unroll") for (int _i = 0; _i < 2; ++_i) \
        __builtin_amdgcn_global_load_lds((const unsigned*)(Ab + (size_t)(vo)[h][_i] + (size_t)(koff)), (LAS unsigned*)(lds + (bufoff) + ldsw + _i * 8192), 16, 0, 0); } while (0)
#define PG8_LDA(dst, b, h) do { _Pragma("unroll") for (int m = 0; m < 4; ++m) _Pragma("unroll") for (int k = 0; k < 2; ++k) dst[m][k] = *(const LAS bf16x8*)(lds + PG8_SA(b, h) + aoff + m * 2048 + k * 1024); } while (0)
#define PG8_LDB(dst, b, h) do { _Pragma("unroll") for (int n = 0; n < 2; ++n) _Pragma("unroll") for (int k = 0; k < 2; ++k) dst[n][k] = *(const LAS bf16x8*)(lds + PG8_SB(b, h) + boff + n * 2048 + k * 1024); } while (0)
#define PG8_MMA(ai, bj, At, Bt) do { __builtin_amdgcn_s_setprio(1); _Pragma("unroll") for (int m = 0; m < 4; ++m) _Pragma("unroll") for (int n = 0; n < 2; ++n) _Pragma("unroll") for (int k = 0; k < 2; ++k) \
        acc[ai][bj][m][n] = __builtin_amdgcn_mfma_f32_16x16x32_bf16(Bt[n][k], At[m][k], acc[ai][bj][m][n], 0, 0, 0); __builtin_amdgcn_s_setprio(0); } while (0)
#define PG8_WAIT_V(n) asm volatile("s_waitcnt vmcnt(" #n ")" ::: "memory")
#define PG8_WAIT_L(n) asm volatile("s_waitcnt lgkmcnt(" #n ")" ::: "memory")
#define PG8_BAR __builtin_amdgcn_s_barrier()
#define PG8_SCHED __builtin_amdgcn_sched_barrier(0)
    Unit cur, nxt; int ui = 0;
    if (!S.next(0, cur)) return;
    f32x4 acc[2][2][4][2];
#pragma unroll
    for (int a = 0; a < 2; ++a)
#pragma unroll
        for (int b = 0; b < 2; ++b)
#pragma unroll
            for (int m = 0; m < 4; ++m)
#pragma unroll
                for (int n = 0; n < 2; ++n) acc[a][b][m][n] = (f32x4){0.f, 0.f, 0.f, 0.f};
    bf16x8 At[4][2], B0[2][2], B1[2][2];
    const char* Ab = S.a_base();
    unsigned cvA[2][2], nvA[2][2];
    S.a_voff(cur, cvA, Rr, Cc);
    const char* cB = S.b_base(cur);
    PG8_STAGE_B(PG8_SB(0, 0), cB); PG8_STAGE_B(PG8_SB(0, 1), cB + hstep); PG8_STAGE_A(PG8_SA(0, 0), cvA, 0, 0); PG8_STAGE_A(PG8_SA(0, 1), cvA, 1, 0);
    if (wr == 1) PG8_BAR;
    PG8_WAIT_V(2); PG8_BAR;
    PG8_STAGE_B(PG8_SB(1, 0), cB + kstep); PG8_STAGE_A(PG8_SA(1, 0), cvA, 0, kstep); PG8_STAGE_B(PG8_SB(1, 1), cB + hstep + kstep);
    PG8_WAIT_V(6); PG8_BAR;
    for (;;) {
        const bool has_next = S.next(ui + 1, nxt);
        const char* nB = has_next ? S.b_base(nxt) : cB;
        if (has_next) S.a_voff(nxt, nvA, Rr, Cc);
        else {
#pragma unroll
            for (int h = 0; h < 2; ++h)
#pragma unroll
                for (int i = 0; i < 2; ++i) nvA[h][i] = cvA[h][i];
        }
#pragma unroll 1
        for (int t = 0; t < nt; t += 2) {
            const bool last = (t == nt - 2);
            if constexpr (Epi::HAS_MID) { if (t == Epi::MID_T) E.mid(acc, cur, wr, wc, fr, fq); }
            const size_t k1 = (size_t)(t + 1) * kstep;
            unsigned a2[2][2];
#pragma unroll
            for (int h = 0; h < 2; ++h)
#pragma unroll
                for (int i = 0; i < 2; ++i) a2[h][i] = last ? nvA[h][i] : cvA[h][i] + (unsigned)((t + 2) * (BK * 2));
            const char* b2 = last ? nB : cB + (size_t)(t + 2) * kstep;
            const char* b3 = b2 + kstep;
            PG8_LDB(B0, 0, 0); PG8_LDB(B1, 0, 1); PG8_SCHED; PG8_LDA(At, 0, 0); PG8_STAGE_A(PG8_SA(1, 1), cvA, 1, k1);
            PG8_WAIT_V(8); PG8_WAIT_L(0); PG8_BAR; PG8_MMA(0, 0, At, B0); PG8_MMA(0, 1, At, B1); PG8_BAR; PG8_SCHED;
            PG8_LDA(At, 0, 1); PG8_STAGE_B(PG8_SB(0, 0), b2); PG8_STAGE_B(PG8_SB(0, 1), b2 + hstep); PG8_STAGE_A(PG8_SA(0, 0), a2, 0, 0);
            PG8_WAIT_V(8); PG8_WAIT_L(0); PG8_BAR; PG8_MMA(1, 0, At, B0); PG8_MMA(1, 1, At, B1); PG8_BAR; PG8_SCHED;
            PG8_LDB(B0, 1, 0); PG8_LDB(B1, 1, 1); PG8_SCHED; PG8_LDA(At, 1, 0); PG8_STAGE_A(PG8_SA(0, 1), a2, 1, 0);
            PG8_WAIT_V(8); PG8_WAIT_L(0); PG8_BAR; PG8_MMA(0, 0, At, B0); PG8_MMA(0, 1, At, B1); PG8_BAR; PG8_SCHED;
            PG8_LDA(At, 1, 1); PG8_STAGE_B(PG8_SB(1, 0), b3); PG8_STAGE_B(PG8_SB(1, 1), b3 + hstep); PG8_STAGE_A(PG8_SA(1, 0), a2, 0, kstep);
            PG8_WAIT_V(8); PG8_WAIT_L(0); PG8_BAR; PG8_MMA(1, 0, At, B0); PG8_MMA(1, 1, At, B1); PG8_BAR; PG8_SCHED;
        }
        if constexpr (ALIGN_EPI) { if (wr == 0) PG8_BAR; }
        E(acc, cur, wr, wc, fr, fq);
        if (!has_next) break;
#pragma unroll
        for (int a = 0; a < 2; ++a)
#pragma unroll
            for (int b = 0; b < 2; ++b)
#pragma unroll
                for (int m = 0; m < 4; ++m)
#pragma unroll
                    for (int n = 0; n < 2; ++n) acc[a][b][m][n] = (f32x4){0.f, 0.f, 0.f, 0.f};
        cur = nxt; cB = nB; ++ui;
#pragma unroll
        for (int h = 0; h < 2; ++h)
#pragma unroll
            for (int i = 0; i < 2; ++i) cvA[h][i] = nvA[h][i];
        if constexpr (ALIGN_EPI) { if (wr == 1) PG8_BAR; }
    }
    PG8_WAIT_V(0);
    if constexpr (!ALIGN_EPI) { if (wr == 0) PG8_BAR; }
    PG8_BAR;
#undef PG8_SA
#undef PG8_SB
#undef PG8_STAGE_A
#undef PG8_STAGE_B
#undef PG8_LDA
#undef PG8_LDB
#undef PG8_MMA
#undef PG8_WAIT_V
#undef PG8_WAIT_L
#undef PG8_BAR
#undef PG8_SCHED
}

typedef f32x4 Acc[2][2][4][2];
__device__ __forceinline__ u32x4 pack8(const f32x4 a, const f32x4 b) { u32x4 w; w.x = cvt_pk_bf16(a[0], a[1]); w.y = cvt_pk_bf16(a[2], a[3]); w.z = cvt_pk_bf16(b[0], b[1]); w.w = cvt_pk_bf16(b[2], b[3]); return w; }

struct EpiPlain {
    static constexpr bool PERM = true, HAS_MID = false; static constexpr int MID_T = 0;
    bf16_t* O; int ldc; int use_aux;
    __device__ __forceinline__ void mid(Acc&, const Unit&, int, int, int, int) const {}
    __device__ __forceinline__ void operator()(const Acc& acc, const Unit& u, int wr, int wc, int fr, int fq) const {
        const int row0 = (use_aux ? u.aux : u.pm * BM) + wr * 64 + fr, col0 = u.pn * BM + wc * 32 + 8 * fq;
#pragma unroll
        for (int ai = 0; ai < 2; ++ai)
#pragma unroll
            for (int m = 0; m < 4; ++m) { bf16_t* rowp = O + (size_t)(row0 + ai * HALF + m * 16) * ldc + col0;
#pragma unroll
                for (int bj = 0; bj < 2; ++bj) st16(rowp + bj * HALF, pack8(acc[ai][bj][m][0], acc[ai][bj][m][1])); }
    }
};

struct EpiIn {
    static constexpr bool PERM = true, HAS_MID = false; static constexpr int MID_T = 0;
    const float* xpart; const float* qn; const float* kn;
    bf16_t *qb, *kb, *vb, *ub, *vsb, *gab; float* vspart;
    __device__ __forceinline__ void mid(Acc&, const Unit&, int, int, int, int) const {}
    __device__ __forceinline__ void operator()(const Acc& acc, const Unit& u, int wr, int wc, int fr, int fq) const {
        const int pn = u.pn;
        float rsv[2][4];
        { int rowb = u.pm * BM + wr * 64 + fr; asm volatile("" : "+v"(rowb));
          f32x4 xq[2][4];
#pragma unroll
          for (int ai = 0; ai < 2; ++ai)
#pragma unroll
              for (int m = 0; m < 4; ++m) xq[ai][m] = *(const f32x4*)(xpart + (size_t)(rowb + ai * HALF + m * 16) * 16 + 4 * fq);
#pragma unroll
          for (int ai = 0; ai < 2; ++ai)
#pragma unroll
              for (int m = 0; m < 4; ++m) { const float s_ = sum_xor16_32((xq[ai][m][0] + xq[ai][m][1]) + (xq[ai][m][2] + xq[ai][m][3])); rsv[ai][m] = fast_rsq(s_ * (1.f / D) + EPS); } }
#pragma unroll
        for (int ai = 0; ai < 2; ++ai)
#pragma unroll
            for (int m = 0; m < 4; ++m) {
                const int row = u.pm * BM + ai * HALF + wr * 64 + m * 16 + fr;
                const float rs = rsv[ai][m];
                f32x4 v[2][2];
#pragma unroll
                for (int bj = 0; bj < 2; ++bj)
#pragma unroll
                    for (int n = 0; n < 2; ++n) v[bj][n] = acc[ai][bj][m][n] * rs;
                if (pn < 4) {
                    float ss = 0.f;
#pragma unroll
                    for (int bj = 0; bj < 2; ++bj)
#pragma unroll
                        for (int n = 0; n < 2; ++n) ss += (v[bj][n][0] * v[bj][n][0] + v[bj][n][1] * v[bj][n][1]) + (v[bj][n][2] * v[bj][n][2] + v[bj][n][3] * v[bj][n][3]);
                    ss = sum_xor16_32(ss);
                    const bool isq = pn < 2;
                    const float sc = fast_rsq(ss * (1.f / 64.f) + EPS) * (isq ? 0.125f * LOG2E : 1.f);
                    const float* gn = isq ? qn : kn; bf16_t* O = isq ? qb : kb;
                    const int head = 4 * (pn & 1) + wc;
#pragma unroll
                    for (int bj = 0; bj < 2; ++bj) {
                        const f32x4 g0 = *(const f32x4*)(gn + 32 * bj + 8 * fq), g1 = *(const f32x4*)(gn + 32 * bj + 8 * fq + 4);
                        st16wt(O + (size_t)row * 512 + head * 64 + 32 * bj + 8 * fq, pack8(v[bj][0] * sc * g0, v[bj][1] * sc * g1));
                    }
                } else {
                    const int colw = wc * 32 + 8 * fq;
                    if (pn < 6) {
#pragma unroll
                        for (int bj = 0; bj < 2; ++bj) st16wt(vb + (size_t)row * 512 + (pn - 4) * BM + bj * HALF + colw, pack8(v[bj][0], v[bj][1]));
                    } else if (pn < 10) {
                        float ss = 0.f;
#pragma unroll
                        for (int bj = 0; bj < 2; ++bj)
#pragma unroll
                            for (int n = 0; n < 2; ++n)
#pragma unroll
                                for (int i = 0; i < 4; ++i) { const float gv = gelu_tanh_f(v[bj][n][i]); v[bj][n][i] = gv; ss += gv * gv; }
                        if (pn < 8) {
#pragma unroll
                            for (int bj = 0; bj < 2; ++bj) st16wt(ub + (size_t)row * 512 + (pn - 6) * BM + bj * HALF + colw, pack8(v[bj][0], v[bj][1]));
                        } else {
#pragma unroll
                            for (int bj = 0; bj < 2; ++bj) st16wt(vsb + (size_t)row * 512 + (pn - 8) * BM + bj * HALF + colw, pack8(v[bj][0], v[bj][1]));
                            ss = sum_xor16_32(ss);
                            if (fq == 0) vspart[(size_t)row * 8 + (pn - 8) * 4 + wc] = ss;
                        }
                    } else {
#pragma unroll
                        for (int bj = 0; bj < 2; ++bj) {
#pragma unroll
                            for (int n = 0; n < 2; ++n)
#pragma unroll
                                for (int i = 0; i < 4; ++i) v[bj][n][i] = fmaxf(sigmoid_f(v[bj][n][i]), 1e-13f);
                            st16wt(gab + (size_t)row * 2048 + (pn - 10) * BM + bj * HALF + colw, pack8(v[bj][0], v[bj][1]));
                        }
                    }
                }
            }
    }
};

struct EpiUp {
    static constexpr bool PERM = true, HAS_MID = true; static constexpr int MID_T = 8;
    const bf16_t* gab; bf16_t* mg;
    __device__ __forceinline__ void mid(Acc& acc, const Unit& u, int wr, int wc, int fr, int fq) const {
        int row0 = u.pm * BM + wr * 64 + fr; const int col0 = u.pn * BM + wc * 32 + 8 * fq; asm volatile("" : "+v"(row0));
#pragma unroll
        for (int am = 0; am < 4; ++am) {
            const int ai = am >> 1, mb = (am & 1) * 2;
            u32x4 ga[2][2], gb[2][2];
#pragma unroll
            for (int mm = 0; mm < 2; ++mm) { const bf16_t* gp = gab + (size_t)(row0 + ai * HALF + (mb + mm) * 16) * 2048 + col0;
#pragma unroll
                for (int bj = 0; bj < 2; ++bj) { ga[mm][bj] = *(const u32x4*)(gp + bj * HALF); gb[mm][bj] = *(const u32x4*)(gp + 1024 + bj * HALF); } }
#pragma unroll
            for (int mm = 0; mm < 2; ++mm)
#pragma unroll
                for (int bj = 0; bj < 2; ++bj)
#pragma unroll
                    for (int j = 0; j < 4; ++j) { const float r0 = bf_lo(ga[mm][bj][j]) * fast_rcp(bf_lo(gb[mm][bj][j])), r1 = bf_hi(ga[mm][bj][j]) * fast_rcp(bf_hi(gb[mm][bj][j]));
                        acc[ai][bj][mb + mm][j >> 1][(j & 1) * 2] *= r0; acc[ai][bj][mb + mm][j >> 1][(j & 1) * 2 + 1] *= r1; }
            asm volatile("" ::: "memory");
        }
    }
    __device__ __forceinline__ void operator()(const Acc& acc, const Unit& u, int wr, int wc, int fr, int fq) const {
        int row0 = u.pm * BM + wr * 64 + fr; const int col0 = u.pn * BM + wc * 32 + 8 * fq; asm volatile("" : "+v"(row0));
#pragma unroll
        for (int ai = 0; ai < 2; ++ai) {
            u32x4 gb[4][2];
#pragma unroll
            for (int m = 0; m < 4; ++m)
#pragma unroll
                for (int bj = 0; bj < 2; ++bj) gb[m][bj] = *(const u32x4*)(gab + (size_t)(row0 + ai * HALF + m * 16) * 2048 + 1024 + col0 + bj * HALF);
#pragma unroll
            for (int m = 0; m < 4; ++m) { const size_t ro = (size_t)(row0 + ai * HALF + m * 16);
#pragma unroll
                for (int bj = 0; bj < 2; ++bj) { const u32x4 b = gb[m][bj];
                    f32x4 o0, o1;
                    o0[0] = acc[ai][bj][m][0][0] * bf_lo(b[0]); o0[1] = acc[ai][bj][m][0][1] * bf_hi(b[0]); o0[2] = acc[ai][bj][m][0][2] * bf_lo(b[1]); o0[3] = acc[ai][bj][m][0][3] * bf_hi(b[1]);
                    o1[0] = acc[ai][bj][m][1][0] * bf_lo(b[2]); o1[1] = acc[ai][bj][m][1][1] * bf_hi(b[2]); o1[2] = acc[ai][bj][m][1][2] * bf_lo(b[3]); o1[3] = acc[ai][bj][m][1][3] * bf_hi(b[3]);
                    st16(mg + ro * 1024 + col0 + bj * HALF, pack8(o0, o1)); } }
            asm volatile("" ::: "memory");
        }
    }
};

struct EpiOut {
    static constexpr bool PERM = true, HAS_MID = false; static constexpr int MID_T = 0;
    const bf16_t* xin; bf16_t* xout;
    __device__ __forceinline__ void mid(Acc&, const Unit&, int, int, int, int) const {}
    __device__ __forceinline__ void operator()(const Acc& acc, const Unit& u, int wr, int wc, int fr, int fq) const {
        int row0 = u.pm * BM + wr * 64 + fr; const int col0 = u.pn * BM + wc * 32 + 8 * fq; asm volatile("" : "+v"(row0));
        u32x4 xv[2][4][2];
#pragma unroll
        for (int ai = 0; ai < 2; ++ai)
#pragma unroll
            for (int m = 0; m < 4; ++m)
#pragma unroll
                for (int bj = 0; bj < 2; ++bj) xv[ai][m][bj] = *(const u32x4*)(xin + (size_t)(row0 + ai * HALF + m * 16) * D + col0 + bj * HALF);
#pragma unroll
        for (int ai = 0; ai < 2; ++ai)
#pragma unroll
            for (int m = 0; m < 4; ++m)
#pragma unroll
                for (int bj = 0; bj < 2; ++bj) { const u32x4 xo = xv[ai][m][bj]; f32x4 o0, o1;
                    o0[0] = bf_lo(xo[0]) + acc[ai][bj][m][0][0]; o0[1] = bf_hi(xo[0]) + acc[ai][bj][m][0][1]; o0[2] = bf_lo(xo[1]) + acc[ai][bj][m][0][2]; o0[3] = bf_hi(xo[1]) + acc[ai][bj][m][0][3];
                    o1[0] = bf_lo(xo[2]) + acc[ai][bj][m][1][0]; o1[1] = bf_hi(xo[2]) + acc[ai][bj][m][1][1]; o1[2] = bf_lo(xo[3]) + acc[ai][bj][m][1][2]; o1[3] = bf_hi(xo[3]) + acc[ai][bj][m][1][3];
                    st16(xout + (size_t)(row0 + ai * HALF + m * 16) * D + col0 + bj * HALF, pack8(o0, o1)); }
    }
};

struct EpiG1 {
    static constexpr bool PERM = true, HAS_MID = false; static constexpr int MID_T = 0;
    const int* tokl; const int* cnt; const float* rs2; bf16_t* Gb;
    __device__ __forceinline__ void mid(Acc&, const Unit&, int, int, int, int) const {}
    __device__ __forceinline__ void operator()(const Acc& acc, const Unit& u, int wr, int wc, int fr, int fq) const {
        const int ce = cnt[u.e * CNT_STRIDE];
        int tokv[2][4]; float rsv[2][4];
#pragma unroll
        for (int ai = 0; ai < 2; ++ai)
#pragma unroll
            for (int m = 0; m < 4; ++m) { const int r = u.pm * BM + ai * HALF + wr * 64 + m * 16 + fr; tokv[ai][m] = (r < ce) ? tokl[u.e * ECAP + r] : 0; }
#pragma unroll
        for (int ai = 0; ai < 2; ++ai)
#pragma unroll
            for (int m = 0; m < 4; ++m) rsv[ai][m] = rs2[tokv[ai][m]];
#pragma unroll
        for (int ai = 0; ai < 2; ++ai)
#pragma unroll
            for (int m = 0; m < 4; ++m) {
                const int rl = ai * HALF + wr * 64 + m * 16 + fr;
                const float rs = rsv[ai][m];
                f32x4 o[2];
#pragma unroll
                for (int n = 0; n < 2; ++n)
#pragma unroll
                    for (int i = 0; i < 4; ++i) { const float g = acc[ai][0][m][n][i] * rs, up = acc[ai][1][m][n][i] * rs; o[n][i] = g * sigmoid_f(g) * up; }
                st16(Gb + (size_t)(u.aux + rl) * 512 + u.pn * HALF + wc * 32 + 8 * fq, pack8(o[0], o[1]));
            }
    }
};

struct EpiPle {
    static constexpr bool PERM = true, HAS_MID = false; static constexpr int MID_T = 0;
    const bf16_t* xin; bf16_t* xout; float* fout; const bf16_t* Eb; const float* rs3; float* xpart;
    __device__ __forceinline__ void mid(Acc&, const Unit&, int, int, int, int) const {}
    __device__ __forceinline__ void operator()(const Acc& acc, const Unit& u, int wr, int wc, int fr, int fq) const {
        int row0 = u.pm * BM + wr * 64 + fr; const int col0 = u.pn * BM + wc * 32 + 8 * fq; asm volatile("" : "+v"(row0));
#pragma unroll
        for (int ai = 0; ai < 2; ++ai) {
            constexpr int mb = 0;
            u32x4 xv[4][2], ev[4][2]; float rsv[4];
#pragma unroll
            for (int mm = 0; mm < 4; ++mm) { const int row = row0 + ai * HALF + (mb + mm) * 16; rsv[mm] = rs3[row];
#pragma unroll
                for (int bj = 0; bj < 2; ++bj) { xv[mm][bj] = *(const u32x4*)(xin + (size_t)row * D + col0 + bj * HALF); ev[mm][bj] = *(const u32x4*)(Eb + (size_t)row * D + col0 + bj * HALF); } }
#pragma unroll
            for (int mm = 0; mm < 4; ++mm) { const int row = row0 + ai * HALF + (mb + mm) * 16; const float rs = rsv[mm]; float ss = 0.f;
#pragma unroll
                for (int bj = 0; bj < 2; ++bj) { const u32x4 xo = xv[mm][bj], e = ev[mm][bj]; f32x4 o[2];
#pragma unroll
                    for (int j = 0; j < 4; ++j) { o[j >> 1][(j & 1) * 2] = bf_lo(xo[j]) + sigmoid_f(acc[ai][bj][mb + mm][j >> 1][(j & 1) * 2] * rs) * bf_lo(e[j]);
                                                  o[j >> 1][(j & 1) * 2 + 1] = bf_hi(xo[j]) + sigmoid_f(acc[ai][bj][mb + mm][j >> 1][(j & 1) * 2 + 1] * rs) * bf_hi(e[j]); }
                    const u32x4 w = pack8(o[0], o[1]);
#pragma unroll
                    for (int j = 0; j < 4; ++j) { const float a = bf_lo(w[j]), b = bf_hi(w[j]); ss += a * a + b * b; }
                    st16(xout + (size_t)row * D + col0 + bj * HALF, w);
                    if (fout) { *(f32x4*)(fout + (size_t)row * D + col0 + bj * HALF) = o[0]; *(f32x4*)(fout + (size_t)row * D + col0 + bj * HALF + 4) = o[1]; } }
                ss = sum_xor16_32(ss);
                if (fq == 0) xpart[(size_t)row * 16 + u.pn * 4 + wc] = ss; }
            asm volatile("" ::: "memory");
        }
    }
};
__device__ __forceinline__ int crow(int r, int hi) { return (r & 3) + 8 * (r >> 2) + 4 * hi; }
__device__ __forceinline__ unsigned cvtpk_s(float lo, float hi) { typedef __bf16 bf16x2_t __attribute__((ext_vector_type(2))); f32x2 v = {lo, hi}; bf16x2_t b = __builtin_convertvector(v, bf16x2_t); return __builtin_bit_cast(unsigned, b); }
#define FK_SBAR() __builtin_amdgcn_sched_barrier(0)
__device__ __forceinline__ void pv(f32x16* o, int vb, bf16x8 pa0, bf16x8 pa1, bf16x8 pa2, bf16x8 pa3) {
#pragma unroll
    for (int d0 = 0; d0 < 2; ++d0) { s16x4 lo[4], hi[4];
#pragma unroll
        for (int ks = 0; ks < 4; ++ks) {
            asm volatile("ds_read_b64_tr_b16 %0,%1 offset:%c2" : "=&v"(lo[ks]) : "v"(vb), "i"(d0 * 4096 + ks * 1024) : "memory");
            asm volatile("ds_read_b64_tr_b16 %0,%1 offset:%c2" : "=&v"(hi[ks]) : "v"(vb), "i"(d0 * 4096 + ks * 1024 + 512) : "memory"); }
        asm volatile("s_waitcnt lgkmcnt(0)" ::: "memory"); FK_SBAR();
#define FK_PK(k) (bf16x8){lo[k][0], lo[k][1], lo[k][2], lo[k][3], hi[k][0], hi[k][1], hi[k][2], hi[k][3]}
        o[d0] = __builtin_amdgcn_mfma_f32_32x32x16_bf16(pa0, FK_PK(0), o[d0], 0, 0, 0);
        o[d0] = __builtin_amdgcn_mfma_f32_32x32x16_bf16(pa1, FK_PK(1), o[d0], 0, 0, 0);
        o[d0] = __builtin_amdgcn_mfma_f32_32x32x16_bf16(pa2, FK_PK(2), o[d0], 0, 0, 0);
        o[d0] = __builtin_amdgcn_mfma_f32_32x32x16_bf16(pa3, FK_PK(3), o[d0], 0, 0, 0);
#undef FK_PK
    }
}
constexpr int WLDS_BYTES = 16384;

template <bool DIAG>
__device__ __forceinline__ void attn_tile(const bf16x8 (&k0)[4], const bf16x8 (&k1)[4], const bf16x8 (&qr)[4], f32x16 (&o)[2], float& R, int s0, int tq, int hi, int vbase) {
    f32x16 p0 = f32x16{}, p1 = f32x16{};
#pragma unroll
    for (int d0 = 0; d0 < 4; ++d0) { p0 = __builtin_amdgcn_mfma_f32_32x32x16_bf16(k0[d0], qr[d0], p0, 0, 0, 0); p1 = __builtin_amdgcn_mfma_f32_32x32x16_bf16(k1[d0], qr[d0], p1, 0, 0, 0); }
    float kp[32], bt[32];
#pragma unroll
    for (int r = 0; r < 32; ++r) {
        const float z = r < 16 ? p0[r] : p1[r - 16];
        const float e = fast_exp2(z);
        float k_ = fast_rcp(1.f + e), b_ = 1.f - k_;
        if (DIAG) { const int kv = s0 + crow(r & 15, hi) + (r >> 4) * 32; if (!(kv < tq)) { k_ = 1.f; b_ = 0.f; } }
        kp[r] = k_; bt[r] = b_;
    }
    float pg[8], T[8], SP[8];
#pragma unroll
    for (int g = 0; g < 8; ++g) { const float gs = (kp[4 * g] * kp[4 * g + 1]) * (kp[4 * g + 2] * kp[4 * g + 3]); float lo_, hi_; halves32(gs, lo_, hi_); pg[g] = hi ? lo_ : hi_; T[g] = lo_ * hi_; }
    SP[7] = 1.f;
#pragma unroll
    for (int g = 6; g >= 0; --g) SP[g] = SP[g + 1] * T[g + 1];
    float a[32];
#pragma unroll
    for (int g = 0; g < 8; ++g) {
        const float base = R * SP[g] * (hi == 0 ? pg[g] : 1.f);
        const float a3 = base, a2 = a3 * kp[4 * g + 3], a1 = a2 * kp[4 * g + 2], a0 = a1 * kp[4 * g + 1];
        a[4 * g + 3] = bt[4 * g + 3] * a3; a[4 * g + 2] = bt[4 * g + 2] * a2; a[4 * g + 1] = bt[4 * g + 1] * a1; a[4 * g] = bt[4 * g] * a0;
    }
    R *= SP[0] * T[0];
    u32x4 pw0, pw1, pw2, pw3;
    pw0 = (u32x4){cvtpk_s(a[0], a[1]), cvtpk_s(a[2], a[3]), cvtpk_s(a[4], a[5]), cvtpk_s(a[6], a[7])};
    pw1 = (u32x4){cvtpk_s(a[8], a[9]), cvtpk_s(a[10], a[11]), cvtpk_s(a[12], a[13]), cvtpk_s(a[14], a[15])};
    pw2 = (u32x4){cvtpk_s(a[16], a[17]), cvtpk_s(a[18], a[19]), cvtpk_s(a[20], a[21]), cvtpk_s(a[22], a[23])};
    pw3 = (u32x4){cvtpk_s(a[24], a[25]), cvtpk_s(a[26], a[27]), cvtpk_s(a[28], a[29]), cvtpk_s(a[30], a[31])};
    asm volatile("s_waitcnt vmcnt(0) lgkmcnt(0)" ::: "memory");
    pv(o, vbase, __builtin_bit_cast(bf16x8, pw0), __builtin_bit_cast(bf16x8, pw1), __builtin_bit_cast(bf16x8, pw2), __builtin_bit_cast(bf16x8, pw3));
}
__device__ __forceinline__ void attn_dma_v(const bf16_t* __restrict__ vb, long rowbase, int s0, int h, int lane, LAS unsigned char* wl) {
#pragma unroll
    for (int w8 = 0; w8 < 8; ++w8)
        __builtin_amdgcn_global_load_lds((const unsigned*)(vb + (size_t)(rowbase + s0 + 16 * (w8 & 3) + (lane >> 2)) * 512 + h * 64 + 32 * (w8 >> 2) + 8 * (lane & 3)), (LAS unsigned*)(wl + w8 * 1024), 16, 0, 0);
}
__device__ __forceinline__ void attn_dma_k(const bf16_t* __restrict__ kb, long rowbase, int s0, int h, int lane, LAS unsigned char* wl) {
#pragma unroll
    for (int c = 0; c < 8; ++c)
        __builtin_amdgcn_global_load_lds((const unsigned*)(kb + (size_t)(rowbase + s0 + lane) * 512 + h * 64 + 8 * c), (LAS unsigned*)(wl + 8192 + c * 1024), 16, 0, 0);
}
__device__ __forceinline__ void attn_read_k(bf16x8 (&k0)[4], bf16x8 (&k1)[4], LAS unsigned char* wl, int r32, int hi) {
    const LAS unsigned char* kp = wl + 8192 + hi * 1024 + r32 * 16;
#pragma unroll
    for (int d0 = 0; d0 < 4; ++d0) { k0[d0] = *(const LAS bf16x8*)(kp + d0 * 2048); k1[d0] = *(const LAS bf16x8*)(kp + d0 * 2048 + 512); }
}
__device__ __forceinline__ void attn_wave_unit(int b, int h, int qblk, const bf16_t* __restrict__ qb, const bf16_t* __restrict__ kb, const bf16_t* __restrict__ vb, bf16_t* __restrict__ oc, LAS unsigned char* wl, int lane) {
    const int r32 = lane & 31, hi = lane >> 5;
    const long rowbase = (long)b * SEQ; const int q0 = qblk * 32, tq = q0 + r32;
    bf16x8 qr[4];
    { const bf16_t* qp = qb + (size_t)(rowbase + q0 + r32) * 512 + h * 64 + hi * 8;
#pragma unroll
      for (int d0 = 0; d0 < 4; ++d0) qr[d0] = *(const bf16x8*)(qp + d0 * 16); }
    f32x16 o[2]; o[0] = f32x16{}; o[1] = f32x16{};
    float R = 1.f;
    const int vbase = (int)(unsigned)(uintptr_t)wl + ((lane >> 4) & 1) * 32 + (lane & 3) * 8 + (4 * hi + ((lane & 15) >> 2)) * 64;
    const int jd = q0 >> 6;
    bf16x8 k0[4], k1[4];
    attn_dma_k(kb, rowbase, jd * 64, h, lane, wl);
    attn_dma_v(vb, rowbase, jd * 64, h, lane, wl);
    asm volatile("s_waitcnt vmcnt(8)" ::: "memory");
    attn_read_k(k0, k1, wl, r32, hi);
    asm volatile("s_waitcnt lgkmcnt(0)" ::: "memory");
    attn_dma_k(kb, rowbase, (jd > 0 ? jd - 1 : 0) * 64, h, lane, wl);
    attn_tile<true>(k0, k1, qr, o, R, jd * 64, tq, hi, vbase);
    for (int jt = jd - 1; jt >= 0; --jt) {
        if (__all(R < 7.5e-37f)) break;
        attn_read_k(k0, k1, wl, r32, hi);
        attn_dma_v(vb, rowbase, jt * 64, h, lane, wl);
        asm volatile("s_waitcnt lgkmcnt(0)" ::: "memory");
        attn_dma_k(kb, rowbase, (jt > 0 ? jt - 1 : 0) * 64, h, lane, wl);
        attn_tile<false>(k0, k1, qr, o, R, jt * 64, tq, hi, vbase);
    }
    asm volatile("s_waitcnt vmcnt(0)" ::: "memory");
    LAS bf16_t* stg = (LAS bf16_t*)(wl + 8192);
#pragma unroll
    for (int r = 0; r < 16; ++r) { const int orow = crow(r, hi);
#pragma unroll
        for (int d0 = 0; d0 < 2; ++d0) stg[orow * 64 + d0 * 32 + r32] = (bf16_t)(cvtpk_s(o[d0][r], 0.f) & 0xffffu); }
    asm volatile("s_waitcnt lgkmcnt(0)" ::: "memory");
    bf16_t* Ow = oc + (size_t)(rowbase + q0) * 1024 + h * 64;
#pragma unroll
    for (int i = 0; i < 4; ++i) { const int row = i * 8 + (lane >> 3), ch = lane & 7; const u32x4 v = *(const LAS u32x4*)(stg + row * 64 + ch * 8); *(u32x4*)(Ow + (size_t)row * 1024 + ch * 8) = v; }
    asm volatile("s_waitcnt vmcnt(0) lgkmcnt(0)" ::: "memory");
}

template <int HF>
__device__ __forceinline__ void sgu_wave_unit(int chunk, int g, const bf16_t* __restrict__ ub, const bf16_t* __restrict__ vsb, const float* __restrict__ vspart, const bf16_t* __restrict__ wsp  ,
                                              const float* __restrict__ bsp  , const float* __restrict__ sgn  , bf16_t* __restrict__ oc, LAS unsigned char* wl, int lane) {
    const int r32 = lane & 31, hi = lane >> 5;
    const size_t row0 = (size_t)chunk * 128;
    const int vbase = (int)(unsigned)(uintptr_t)wl + ((lane >> 4) & 1) * 32 + (lane & 3) * 8 + (4 * hi + ((lane & 15) >> 2)) * 64;
    f32x16 o[2][2];
#pragma unroll
    for (int rl = 0; rl < 2; ++rl) { o[rl][0] = f32x16{}; o[rl][1] = f32x16{}; }
#pragma unroll
    for (int kt = 0; kt <= HF; ++kt) {
        float rvq[4];
#pragma unroll
        for (int q = 0; q < 4; ++q) { const size_t row = row0 + 64 * kt + 16 * q + (lane >> 2);
            const f32x4 s0 = *(const f32x4*)(vspart + row * 8), s1 = *(const f32x4*)(vspart + row * 8 + 4);
            rvq[q] = fast_rsq((((s0[0] + s0[1]) + (s0[2] + s0[3])) + ((s1[0] + s1[1]) + (s1[2] + s1[3]))) * (1.f / 512.f) + EPS); }
        u32x4 vv[8];
#pragma unroll
        for (int w8 = 0; w8 < 8; ++w8) vv[w8] = *(const u32x4*)(vsb + (row0 + 64 * kt + 16 * (w8 & 3) + (lane >> 2)) * 512 + g * 64 + 32 * (w8 >> 2) + 8 * (lane & 3));
#pragma unroll
        for (int w8 = 0; w8 < 8; ++w8) { const float rv = rvq[w8 & 3]; u32x4 w;
#pragma unroll
            for (int j = 0; j < 4; ++j) w[j] = cvtpk_s(bf_lo(vv[w8][j]) * rv, bf_hi(vv[w8][j]) * rv);
            *(LAS u32x4*)(wl + w8 * 1024 + lane * 16) = w; }
        asm volatile("s_waitcnt lgkmcnt(0)" ::: "memory");
#pragma unroll
        for (int rl = 0; rl < 2; ++rl) {
            const int rb = 2 * HF + rl;
            const bf16_t* wp = wsp + ((size_t)g * 128 + 32 * rb + r32) * 128 + 64 * kt + 4 * hi;
            u32x4 pw[4];
#pragma unroll
            for (int ks = 0; ks < 4; ++ks) { const u32x2 lo = *(const u32x2*)(wp + 16 * ks), h8 = *(const u32x2*)(wp + 16 * ks + 8); pw[ks] = (u32x4){lo.x, lo.y, h8.x, h8.y}; }
            pv(o[rl], vbase, __builtin_bit_cast(bf16x8, pw[0]), __builtin_bit_cast(bf16x8, pw[1]), __builtin_bit_cast(bf16x8, pw[2]), __builtin_bit_cast(bf16x8, pw[3]));
        }
        asm volatile("s_waitcnt lgkmcnt(0)" ::: "memory");
    }
    LAS bf16_t* stg = (LAS bf16_t*)(wl + 8192);
    const float gn0 = sgn[g * 64 + r32], gn1 = sgn[g * 64 + 32 + r32];
#pragma unroll
    for (int rl = 0; rl < 2; ++rl) {
        const int rb = 2 * HF + rl;
#pragma unroll
        for (int r = 0; r < 16; ++r) { const int orow = crow(r, hi); const float bb = bsp[g * 128 + 32 * rb + orow];
            stg[orow * 64 + r32] = (bf16_t)(cvtpk_s(gn0 * o[rl][0][r] + bb, 0.f) & 0xffffu); stg[orow * 64 + 32 + r32] = (bf16_t)(cvtpk_s(gn1 * o[rl][1][r] + bb, 0.f) & 0xffffu); }
        asm volatile("s_waitcnt lgkmcnt(0)" ::: "memory");
#pragma unroll
        for (int i = 0; i < 4; ++i) { const int row = i * 8 + (lane >> 3), ch = lane & 7; const size_t grow = row0 + 32 * rb + row;
            const u32x4 mv = *(const LAS u32x4*)(stg + row * 64 + ch * 8); const u32x4 uv = *(const u32x4*)(ub + grow * 512 + g * 64 + ch * 8); u32x4 w;
#pragma unroll
            for (int j = 0; j < 4; ++j) w[j] = cvtpk_s(bf_lo(mv[j]) * bf_lo(uv[j]), bf_hi(mv[j]) * bf_hi(uv[j]));
            *(u32x4*)(oc + grow * 1024 + 512 + g * 64 + ch * 8) = w; }
        asm volatile("s_waitcnt lgkmcnt(0)" ::: "memory");
    }
}
constexpr size_t MiB = 1u << 20;
constexpr size_t WS_CTL = 0, CTL_ZERO_BYTES = 1 * MiB;
constexpr size_t WS_W = 16 * MiB, WL_STRIDE = 112 * MiB;
constexpr size_t WO_IN = 0, WO_UP = 9 * MiB, WO_OUT = 11 * MiB, WO_PG = 13 * MiB, WO_PP = 15 * MiB, WO_SP = 15 * MiB + 512 * 1024, WO_R = 15 * MiB + 768 * 1024, WO_EI = 16 * MiB, WO_EO = 80 * MiB;
constexpr size_t WS_PB = 464 * MiB, WS_E = 496 * MiB, WS_XB = 624 * MiB, WS_Q = 656 * MiB, WS_K = 672 * MiB, WS_V = 688 * MiB, WS_U = 704 * MiB, WS_VS = 720 * MiB, WS_GAB = 736 * MiB,
                 WS_OC = 800 * MiB, WS_MG = 832 * MiB, WS_G = 864 * MiB, WS_YS = 904 * MiB, WS_XPART = 984 * MiB, WS_VSPART = 985 * MiB, WS_RS2 = 985 * MiB + 512 * 1024, WS_RS3 = 985 * MiB + 640 * 1024,
                 WS_TOKL = 986 * MiB, WS_TKE = 988 * MiB, WS_TKP = 988 * MiB + 256 * 1024, WS_TKW = 988 * MiB + 512 * 1024, WS_XB1 = 992 * MiB, WS_FAST_END = 1024 * MiB;
constexpr int GSLOTS = 2 * M + NE * 256;
constexpr int CW_TMO = 0, CW_CODE = 1, CW_BAR = 4096, CW_CNT = 8192  ;

constexpr int RING_OFF = 0, RING_BYTES = 131072, LDSCTL_OFF = 139264  , MISC_OFF = LDSCTL_OFF + 320, PREF_OFF = MISC_OFF + 128  , LDS_BYTES = 147456;

#define RLX_AGENT __ATOMIC_RELAXED, __HIP_MEMORY_SCOPE_AGENT
#define XB_TMO      128
#define XB_XCNT(j)  (256  + 64 * (j))
#define XB_XSUB(j)  (1280 + 64 * (j))
#define XB_XGEN(j)  (2304 + 64 * (j))
#define XB_TOP      3328
#define XB_TOPGEN   3392
#define XCD_BAR_WORDS 3456
#define XB_SPIN_CAP (1u << 18)
__device__ __forceinline__ unsigned xb_ld(unsigned* p)              { return __hip_atomic_load(p, __ATOMIC_RELAXED, __HIP_MEMORY_SCOPE_AGENT); }
__device__ __forceinline__ unsigned xb_add(unsigned* p, unsigned v) { return __hip_atomic_fetch_add(p, v, __ATOMIC_RELAXED, __HIP_MEMORY_SCOPE_AGENT); }
__device__ __forceinline__ unsigned xb_xcc_id() { return (unsigned)__builtin_amdgcn_s_getreg((3 << 11) | 20) & 0xFu; }
#define XB_SPIN(cond, bar) do { unsigned _sp = 0; while (cond) { __builtin_amdgcn_s_sleep(1); \
    if ((++_sp & 255u) == 0u) { if (xb_ld(&(bar)[XB_TMO])) break; if (_sp > XB_SPIN_CAP) { atomicAdd(&(bar)[XB_TMO], 1u); break; } } } } while (0)
struct XcdBarrier { unsigned* bar; unsigned x; volatile LAS unsigned* st; };
__device__ __forceinline__ XcdBarrier xcd_barrier_post(unsigned* bar, volatile LAS unsigned* st, const bool leader  ) {
    XcdBarrier b; b.bar = bar; b.x = xb_xcc_id(); b.st = st;
    if (leader) (void)xb_add(&bar[XB_XCNT(b.x)], 1u);
    return b;
}
__device__ __forceinline__ void xcd_barrier_complete(unsigned* bar, unsigned x, unsigned& nloc, unsigned& nx) {
    const unsigned G = gridDim.x * gridDim.y * gridDim.z;
    unsigned sum, cnt, mine, sp = 0u;
    for (;;) {
        sum = 0u; cnt = 0u; mine = 0u;
#pragma unroll
        for (unsigned j = 0; j < 16; ++j) { const unsigned c = xb_ld(&bar[XB_XCNT(j)]); sum += c; cnt += (c > 0u) ? 1u : 0u; mine = (j == x) ? c : mine; }
        if (sum == G) break;
        __builtin_amdgcn_s_sleep(1);
        if ((++sp & 255u) == 0u) { if (xb_ld(&bar[XB_TMO])) break; if (sp > XB_SPIN_CAP) { atomicAdd(&bar[XB_TMO], 1u); break; } }
    }
    nloc = mine > 0u ? mine : 1u; nx = cnt > 0u ? cnt : 1u;
}
__device__ __forceinline__ void xcd_barrier_t0(const XcdBarrier& b) {
        unsigned* bar = b.bar;
        __builtin_amdgcn_s_waitcnt(0);
        unsigned nloc = b.st[0], nx = b.st[1];
        if (nloc == 0u) { xcd_barrier_complete(bar, b.x, nloc, nx); b.st[0] = nloc; b.st[1] = nx; }
        const unsigned old = xb_add(&bar[XB_XSUB(b.x)], 1u);
        const unsigned gen = old / nloc;
        if (old + 1u == (gen + 1u) * nloc) {
            __builtin_amdgcn_fence(__ATOMIC_RELEASE, "agent");
            asm volatile("s_waitcnt vmcnt(0)" ::: "memory");
            const unsigned og = xb_add(&bar[XB_TOP], 1u);
            const unsigned tg = og / nx;
            if (og + 1u == (tg + 1u) * nx) xb_add(&bar[XB_TOPGEN], 1u);
            else XB_SPIN(xb_ld(&bar[XB_TOPGEN]) == tg, bar);
            __builtin_amdgcn_fence(__ATOMIC_ACQUIRE, "agent");
            xb_add(&bar[XB_XGEN(b.x)], 1u);
            asm volatile("s_waitcnt vmcnt(0)" ::: "memory");
        } else {
            XB_SPIN(xb_ld(&bar[XB_XGEN(b.x)]) == gen, bar);
            __builtin_amdgcn_fence(__ATOMIC_ACQUIRE, "agent");
            asm volatile("s_waitcnt vmcnt(0)" ::: "memory");
        }
}

struct Args {
    const float* in[22]; float* out; unsigned char* ws;
    int ph_lo, ph_hi, nlayers, pad;
};
__device__ __forceinline__ float wave_sum(float v) { v += xor_lt32<1>(v); v += xor_lt32<2>(v); v += xor_lt32<4>(v); v += xor_lt32<8>(v); return sum_xor16_32(v); }
__device__ __forceinline__ unsigned f2bf(float f) { unsigned u = __builtin_bit_cast(unsigned, f); return (u + 0x7fffu + ((u >> 16) & 1u)) >> 16; }
__device__ __forceinline__ unsigned pk2(float lo, float hi) { return f2bf(lo) | (f2bf(hi) << 16); }

__device__ __forceinline__ int rowmap(int kind, int n) {
    if (kind == 1) { if (n >= 1024) return n; const int nl = n & 255; return (n - nl) + 128 * ((nl & 63) >> 5) + 32 * (nl >> 6) + (nl & 31); }
    if (kind == 2) { return n < 512 ? 256 * (n >> 7) + (n & 127) : 256 * ((n - 512) >> 7) + 128 + ((n - 512) & 127); }
    return n;
}
__device__ __forceinline__ void transpose_item(const float* __restrict__ W, int N, const float* __restrict__ gain, bf16_t* __restrict__ WT, int ldt, int koff, int kind, LAS float* scr, int item, int lane) {
    const int nblk = N / 64, kb = item / nblk, nb = item % nblk, k0 = 64 * kb, n0 = 64 * nb;
    const int kr = lane >> 4, nc = 4 * (lane & 15);
    f32x4 v[16];
#pragma unroll
    for (int i = 0; i < 16; ++i) v[i] = __builtin_nontemporal_load((const f32x4*)(W + (size_t)(k0 + 4 * i + kr) * N + n0 + nc));
#pragma unroll
    for (int i = 0; i < 16; ++i) { const int kk = 4 * i + kr; const float gv = gain ? gain[k0 + kk] : 1.f; LAS float* d = scr + kk * 65 + nc; d[0] = v[i][0] * gv; d[1] = v[i][1] * gv; d[2] = v[i][2] * gv; d[3] = v[i][3] * gv; }
    asm volatile("s_waitcnt lgkmcnt(0)" ::: "memory");
    const int c = lane & 7;
#pragma unroll
    for (int j = 0; j < 8; ++j) { const int n = 8 * j + (lane >> 3); const LAS float* s = scr + (8 * c) * 65 + n;
        u32x4 o; o.x = pk2(s[0 * 65], s[1 * 65]); o.y = pk2(s[2 * 65], s[3 * 65]); o.z = pk2(s[4 * 65], s[5 * 65]); o.w = pk2(s[6 * 65], s[7 * 65]);
        __builtin_nontemporal_store(o, (u32x4*)(WT + (size_t)rowmap(kind, n0 + n) * ldt + koff + k0 + 8 * c)); }
    asm volatile("s_waitcnt lgkmcnt(0)" ::: "memory");
}

typedef const __attribute__((address_space(4))) Args* KArgs;
__device__ __forceinline__ KArgs fresh(KArgs k) { asm volatile("" : "+s"(k)); return k; }
constexpr int NWAVES = 8;
#ifndef FK_FILLW
#define FK_FILLW 7
#endif
constexpr int FILLW = FK_FILLW, FILL_SLABS = 8;
constexpr int CVT_IN = 16 * 72, CVT_UP = 8 * 16, CVT_OUT = 16 * 16, CVT_PG = 16 * 16, CVT_PP = 4 * 16, CVT_EI = 16 * 16, CVT_EO = 8 * 16;
constexpr int CVT_PER_LAYER = CVT_IN + 2 * CVT_UP + CVT_OUT + CVT_PG + CVT_PP + NE * CVT_EI + NE * CVT_EO;
__device__ __forceinline__ void convert_item(KArgs ap, int L, int r, LAS float* scr, int lane) {
    unsigned char* wl = ap->ws + WS_W + (size_t)L * WL_STRIDE;
    const float* W; const float* gain = nullptr; bf16_t* WT; int N = D, ldt = D, koff = 0, kind = 0, item = r;
    if (r < CVT_IN) { W = ap->in[3] + (size_t)L * D * INW; N = INW; gain = ap->in[2] + (size_t)L * D; WT = (bf16_t*)(wl + WO_IN); kind = 1; }
    else if ((r -= CVT_IN) < CVT_UP) { W = ap->in[9] + (size_t)L * 512 * D; WT = (bf16_t*)(wl + WO_UP); ldt = 1024; item = r; }
    else if ((r -= CVT_UP) < CVT_UP) { W = ap->in[10] + (size_t)L * 512 * D; WT = (bf16_t*)(wl + WO_UP); ldt = 1024; koff = 512; item = r; }
    else if ((r -= CVT_UP) < CVT_OUT) { W = ap->in[11] + (size_t)L * D * D; WT = (bf16_t*)(wl + WO_OUT); item = r; }
    else if ((r -= CVT_OUT) < CVT_PG) { W = ap->in[20] + (size_t)L * D * D; gain = ap->in[19] + (size_t)L * D; WT = (bf16_t*)(wl + WO_PG); item = r; }
    else if ((r -= CVT_PG) < CVT_PP) { W = ap->in[21] + (size_t)L * 256 * D; WT = (bf16_t*)(wl + WO_PP); ldt = 256; item = r; }
    else if ((r -= CVT_PP) < NE * CVT_EI) { const int e = r / CVT_EI; W = ap->in[17] + ((size_t)L * NE + e) * D * 1024; N = 1024; gain = ap->in[12] + (size_t)L * D; WT = (bf16_t*)(wl + WO_EI) + (size_t)e * 1024 * 1024; ldt = 1024; kind = 2; item = r % CVT_EI; }
    else { r -= NE * CVT_EI; const int e = r / CVT_EO; W = ap->in[18] + ((size_t)L * NE + e) * 512 * D; WT = (bf16_t*)(wl + WO_EO) + (size_t)e * 1024 * 512; ldt = 512; item = r % CVT_EO; }
    transpose_item(W, N, gain, WT, ldt, koff, kind, scr, item, lane);
}
__device__ __forceinline__ void p0_prologue(KArgs ap, int nlayers, bool fill_later, LAS unsigned char* lds, int wave, int lane, int gw, int NGW) {
    LAS float* scr = (LAS float*)(lds + RING_OFF + wave * 17408);
    unsigned char* ws = ap->ws;
    const int nconv = fill_later ? 1 : nlayers;
    for (int it = gw; it < CVT_PER_LAYER * nconv; it += NGW) convert_item(ap, nconv - 1 - it / CVT_PER_LAYER, it % CVT_PER_LAYER, scr, lane);
    if (fill_later) { const int first = FILL_SLABS * FILLW * (NGW / NWAVES), rest = CVT_PER_LAYER - first;
        if (rest > 0) for (int it = gw; it < rest * (nlayers - 1); it += NGW) convert_item(ap, 1 + it / rest, first + it % rest, scr, lane); }
    const int gt = gw * 64 + lane, NGT = NGW * 64;
    for (int L = 0; L < nlayers; ++L) {
        unsigned char* wl = ws + WS_W + (size_t)L * WL_STRIDE;
        bf16_t* sp = (bf16_t*)(wl + WO_SP); const float* wsrc = ap->in[7] + (size_t)L * 8 * 128 * 128;
        for (int i = gt; i < 8 * 128 * 128; i += NGT) { const int s = i & 127, t = (i >> 7) & 127; sp[i] = (bf16_t)f2bf(s <= t ? wsrc[i] : 0.f); }
        bf16_t* wrh = (bf16_t*)(wl + WO_R); bf16_t* wrl = wrh + 48 * 1024; const float* gain = ap->in[12] + (size_t)L * D; const float* wg = ap->in[13] + (size_t)L * D * 4; const float* we = ap->in[15] + (size_t)L * D * 32;
        for (int i = gt; i < 48 * 1024; i += NGT) { const int o = i >> 10, k = i & 1023; const float wv = o < 36 ? gain[k] * (o < 4 ? wg[k * 4 + o] : we[k * 32 + (o - 4)]) : 0.f;
            const unsigned h = f2bf(wv); wrh[i] = (bf16_t)h; wrl[i] = (bf16_t)f2bf(wv - __uint_as_float(h << 16)); }
    }
    { const f32x4* p4 = (const f32x4*)ap->in[1]; u32x2* pb = (u32x2*)(ws + WS_PB); const size_t n4 = (size_t)nlayers * M * 256 / 4;
      for (size_t i = gt; i < n4; i += NGT) { const f32x4 v = p4[i]; u32x2 w; w.x = pk2(v[0], v[1]); w.y = pk2(v[2], v[3]); pb[i] = w; } }
    for (int m = gw; m < M; m += NGW) {
        const f32x4* xr = (const f32x4*)(ap->in[0] + (size_t)m * D) + lane; u32x2* o8 = (u32x2*)((bf16_t*)(ws + WS_XB) + (size_t)m * D) + lane; float s = 0.f;
#pragma unroll
        for (int j = 0; j < 4; ++j) { const f32x4 v = xr[64 * j]; s += (v[0] * v[0] + v[1] * v[1]) + (v[2] * v[2] + v[3] * v[3]); u32x2 w; w.x = pk2(v[0], v[1]); w.y = pk2(v[2], v[3]); o8[64 * j] = w; }
        s = wave_sum(s);
        if (lane < 16) ((float*)(ws + WS_XPART))[(size_t)m * 16 + lane] = lane == 0 ? s : 0.f;
    }
}

__device__ __forceinline__ void router_pass(const bf16_t* __restrict__ x, const bf16_t* __restrict__ wrh  , const bf16_t* __restrict__ wrl  , const float* __restrict__ bgr, const float* __restrict__ ber,
                                            float* __restrict__ rs2, int* __restrict__ cnt, int* __restrict__ tokl, int* __restrict__ tk_e, int* __restrict__ tk_pos, float* __restrict__ tk_w,
                                            LAS unsigned char* lds, int wave, int lane, int vcu, int G) {
    LAS float* lg = (LAS float*)(lds + RING_OFF + 106496 + (wave & 3) * 3200);
    LAS int* lcnt = (LAS int*)(lds + LDSCTL_OFF + 1024); LAS int* lbase = lcnt + 32;
    const int fr = lane & 15, fq = lane >> 4;
    for (int bt = vcu; bt < M / 64; bt += G) {
        if (wave == 0 && lane < 32) lcnt[lane] = 0;
        __syncthreads();
        int e1 = 0, e2 = 0, lp1 = 0, lp2 = 0; float tw1 = 0.f, tw2 = 0.f;
        const int t0 = bt * 64 + (wave & 3) * 16;
        {
            bf16x8 bh[3][4], bl[3][4]; u32x4 av[4][4];
            const bf16_t* wh = wrh + (size_t)fr * 1024 + 8 * fq + 128 * wave; const bf16_t* wl_ = wrl + (size_t)fr * 1024 + 8 * fq + 128 * wave;
            const bf16_t* xp = x + (size_t)(bt * 64 + fr) * D + 8 * fq + 128 * wave;
#pragma unroll
            for (int cb = 0; cb < 3; ++cb)
#pragma unroll
                for (int kk = 0; kk < 4; ++kk) { bh[cb][kk] = *(const bf16x8*)(wh + (size_t)cb * 16 * 1024 + 32 * kk); bl[cb][kk] = *(const bf16x8*)(wl_ + (size_t)cb * 16 * 1024 + 32 * kk); }
#pragma unroll
            for (int rg = 0; rg < 4; ++rg)
#pragma unroll
                for (int kk = 0; kk < 4; ++kk) av[rg][kk] = *(const u32x4*)(xp + (size_t)rg * 16 * D + 32 * kk);
#pragma unroll
            for (int rg = 0; rg < 4; ++rg) {
                f32x4 pacc[3]; pacc[0] = (f32x4){0.f, 0.f, 0.f, 0.f}; pacc[1] = pacc[0]; pacc[2] = pacc[0]; float pss = 0.f;
#pragma unroll
                for (int kk = 0; kk < 4; ++kk) {
#pragma unroll
                    for (int j = 0; j < 4; ++j) { const float a = bf_lo(av[rg][kk][j]), b = bf_hi(av[rg][kk][j]); pss += a * a + b * b; }
                    const bf16x8 Ah = __builtin_bit_cast(bf16x8, av[rg][kk]);
#pragma unroll
                    for (int cb = 0; cb < 3; ++cb) { pacc[cb] = __builtin_amdgcn_mfma_f32_16x16x32_bf16(bh[cb][kk], Ah, pacc[cb], 0, 0, 0); pacc[cb] = __builtin_amdgcn_mfma_f32_16x16x32_bf16(bl[cb][kk], Ah, pacc[cb], 0, 0, 0); }
                }
                LAS float* pp = (LAS float*)(lds + RING_OFF) + ((wave * 4 + rg) * 64 + lane) * 13;
#pragma unroll
                for (int cb = 0; cb < 3; ++cb)
#pragma unroll
                    for (int i = 0; i < 4; ++i) pp[cb * 4 + i] = pacc[cb][i];
                pp[12] = pss;
            }
        }
        __syncthreads();
        if (wave < 4) {
        f32x4 acc[3]; acc[0] = (f32x4){0.f, 0.f, 0.f, 0.f}; acc[1] = acc[0]; acc[2] = acc[0]; float ss = 0.f;
#pragma unroll
        for (int w2 = 0; w2 < 8; ++w2) { const LAS float* pp = (const LAS float*)(lds + RING_OFF) + ((w2 * 4 + wave) * 64 + lane) * 13;
#pragma unroll
            for (int cb = 0; cb < 3; ++cb)
#pragma unroll
                for (int i = 0; i < 4; ++i) acc[cb][i] += pp[cb * 4 + i];
            ss += pp[12]; }
        ss = sum_xor16_32(ss);
        const float rsr = 1.0f / sqrtf(ss * (1.f / D) + EPS);
#pragma unroll
        for (int cb = 0; cb < 3; ++cb)
#pragma unroll
            for (int i = 0; i < 4; ++i) lg[fr * 49 + 16 * cb + 4 * fq + i] = acc[cb][i] * rsr;
        if (fq == 0) lg[fr * 49 + 48] = rsr;
        asm volatile("s_waitcnt lgkmcnt(0)" ::: "memory");
        if (lane < 16) {
            const int tok = t0 + lane; const LAS float* l = lg + lane * 49;
            rs2[tok] = l[48];
            const float g0 = l[0] + bgr[0], g1 = l[1] + bgr[1], g2 = l[2] + bgr[2], g3 = l[3] + bgr[3];
            int grp = 0; float gm = g0;
            if (g1 > gm) { gm = g1; grp = 1; } if (g2 > gm) { gm = g2; grp = 2; } if (g3 > gm) { gm = g3; grp = 3; }
            const float gsum = (expf(g0 - gm) + expf(g1 - gm)) + (expf(g2 - gm) + expf(g3 - gm));
            const float grp_w = 1.f / gsum;
            int i1 = 0, i2 = 0; float m1 = -INFINITY, m2 = -INFINITY;
#pragma unroll
            for (int i = 0; i < 8; ++i) { const float el = l[4 + grp * 8 + i] + ber[grp * 8 + i]; if (el > m1) { m2 = m1; i2 = i1; m1 = el; i1 = i; } else if (el > m2) { m2 = el; i2 = i; } }
            const float p2 = expf(m2 - m1), w1 = 1.f / (1.f + p2), w2 = p2 / (1.f + p2);
            e1 = grp * 8 + i1; e2 = grp * 8 + i2; tw1 = grp_w * w1; tw2 = grp_w * w2;
            lp1 = __hip_atomic_fetch_add(&lcnt[e1], 1, __ATOMIC_RELAXED, __HIP_MEMORY_SCOPE_WORKGROUP); lp2 = __hip_atomic_fetch_add(&lcnt[e2], 1, __ATOMIC_RELAXED, __HIP_MEMORY_SCOPE_WORKGROUP);
        }
        }
        __syncthreads();
        if (wave == 0 && lane < 32) { const int c = lcnt[lane]; lbase[lane] = c > 0 ? atomicAdd(&cnt[lane * CNT_STRIDE], c) : 0; }
        __syncthreads();
        if (wave < 4 && lane < 16) {
            const int tok = t0 + lane; const int pos1 = lbase[e1] + lp1, pos2 = lbase[e2] + lp2;
            tokl[e1 * ECAP + pos1] = tok; tokl[e2 * ECAP + pos2] = tok;
            tk_e[tok * 2] = e1; tk_e[tok * 2 + 1] = e2; tk_pos[tok * 2] = pos1; tk_pos[tok * 2 + 1] = pos2; tk_w[tok * 2] = tw1; tk_w[tok * 2 + 1] = tw2;
        }
        __syncthreads();
    }
}

__device__ __forceinline__ void combine_pass(bf16_t* xb, const bf16_t* __restrict__ ys, const LAS int* pref, const int* __restrict__ tk_e, const int* __restrict__ tk_pos,
                                             const float* __restrict__ tk_w, float* __restrict__ rs3, int lane, int gw, int NGW) {
    for (int m0 = gw * 4; m0 < M; m0 += NGW * 4) {
        int s0[4], s1[4]; float w0[4], w1[4];
#pragma unroll
        for (int r = 0; r < 4; ++r) { const int m = m0 + r; const int e0 = tk_e[m * 2], e1 = tk_e[m * 2 + 1]; s0[r] = 256 * pref[e0] + tk_pos[m * 2]; s1[r] = 256 * pref[e1] + tk_pos[m * 2 + 1]; w0[r] = tk_w[m * 2]; w1[r] = tk_w[m * 2 + 1]; }
        u32x4 xv[4][2], a0[4][2], a1[4][2];
#pragma unroll
        for (int r = 0; r < 4; ++r)
#pragma unroll
            for (int j = 0; j < 2; ++j) { xv[r][j] = ((const u32x4*)(xb + (size_t)(m0 + r) * D) + lane)[64 * j]; a0[r][j] = ((const u32x4*)(ys + (size_t)s0[r] * D) + lane)[64 * j]; a1[r][j] = ((const u32x4*)(ys + (size_t)s1[r] * D) + lane)[64 * j]; }
#pragma unroll
        for (int r = 0; r < 4; ++r) { float s = 0.f;
#pragma unroll
            for (int j = 0; j < 2; ++j) { u32x4 w;
#pragma unroll
                for (int q = 0; q < 4; ++q) { w[q] = cvt_pk_bf16(bf_lo(xv[r][j][q]) + w0[r] * bf_lo(a0[r][j][q]) + w1[r] * bf_lo(a1[r][j][q]), bf_hi(xv[r][j][q]) + w0[r] * bf_hi(a0[r][j][q]) + w1[r] * bf_hi(a1[r][j][q]));
                    const float a = bf_lo(w[q]), b = bf_hi(w[q]); s += a * a + b * b; }
                st16((u32x4*)(xb + (size_t)(m0 + r) * D) + lane + 64 * j, w); }
            s = wave_sum(s);
            if (lane == 0) rs3[m0 + r] = 1.0f / sqrtf(s * (1.f / D) + EPS); }
    }
}

constexpr int PH_PER_LAYER = 10;
#ifndef FK_REP
#define FK_REP 0
#endif
#define REPS(bit) ((FK_REP & (bit)) ? 2 : 1)
__global__ void __launch_bounds__(NWAVES * 64, 2) mega_fwd(Args args_unused) {
    extern __shared__ __attribute__((aligned(16))) unsigned char lds_raw[];
    LAS unsigned char* lds = (LAS unsigned char*)lds_raw;
    LAS int* pref = (LAS int*)(lds + PREF_OFF);
    const KArgs kp0 = (KArgs)__builtin_amdgcn_kernarg_segment_ptr();
    const int tid = threadIdx.x, wave0 = __builtin_amdgcn_readfirstlane(tid >> 6);
    const int G = gridDim.x, bx = blockIdx.x;
    const int vcu = (G % 8 == 0) ? (bx % 8) * (G / 8) + bx / 8 : bx;
    const int gw0 = vcu * NWAVES + wave0, NGW = G * NWAVES;
#define FK_T0 (wave0 == 0 && fk_lane() == 0)
#define FK_IDS int lane_o = fk_lane(), wave_o = wave0, gw_o = gw0; asm volatile("" : "+v"(lane_o), "+s"(wave_o), "+s"(gw_o)); const int lane = lane_o, wave = wave_o, gw = gw_o; (void)lane; (void)wave; (void)gw;
    for (int u = tid; u < (LDS_BYTES - LDSCTL_OFF) / 4; u += NWAVES * 64) ((LAS unsigned*)(lds + LDSCTL_OFF))[u] = 0u;
    __syncthreads();
    const int lo = kp0->ph_lo, hi = kp0->ph_hi, nlayers = kp0->nlayers;
#define IN(k) (lo <= (k) && (k) < hi)
    const bool fill_on = (hi - lo > 1) && G == 256;
#define SEAM_F(k, Lc, slab) do { if (IN(k) && IN((k) + 1)) { \
        asm volatile("s_waitcnt vmcnt(0)" ::: "memory"); __syncthreads(); \
        if (wave0 == 0) { if (fk_lane() == 0) { KArgs A_ = fresh(kp0); XcdBarrier bar_; bar_.bar = (unsigned*)(A_->ws + WS_CTL) + CW_BAR; bar_.x = xb_xcc_id(); bar_.st = (volatile LAS unsigned*)(lds + MISC_OFF) + 8; xcd_barrier_t0(bar_); } } \
        else if (fill_on && (Lc) < nlayers && (slab) < FILL_SLABS && wave0 <= FILLW) { int idx_ = (slab) * FILLW * G + bx * FILLW + (wave0 - 1); asm volatile("" : "+s"(idx_));   if (idx_ < CVT_PER_LAYER) convert_item(fresh(kp0), (Lc), idx_, (LAS float*)(lds + RING_OFF + wave0 * 17408), fk_lane()); } \
        __syncthreads(); } } while (0)
#define SEAM(k) SEAM_F(k, L + 1, (k) - pb)
    if (hi - lo > 1) { KArgs A = fresh(kp0); (void)xcd_barrier_post((unsigned*)(A->ws + WS_CTL) + CW_BAR, (volatile LAS unsigned*)(lds + MISC_OFF) + 8, FK_T0); }

    if (IN(0)) { for (int rep = 0; rep < REPS(1); ++rep) { FK_IDS; p0_prologue(fresh(kp0), nlayers, fill_on, lds, wave, lane, gw, NGW); } }
    SEAM_F(0, nlayers, 0);
    if (IN(1)) { }
    for (int L = 0; L < nlayers; ++L) {
        const int pb = 2 + PH_PER_LAYER * L;
        if (IN(pb + 0)) for (int rep = 0; rep < REPS(4); ++rep) {
            KArgs A = fresh(kp0); unsigned char* ws = A->ws; unsigned char* wl = ws + WS_W + (size_t)L * WL_STRIDE;
            DenseOrder S; S.init(M, INW, G, bx, ws + WS_XB, wl + WO_IN, D);
            EpiIn E{(const float*)(ws + WS_XPART), A->in[4] + L * 64, A->in[5] + L * 64, (bf16_t*)(ws + WS_Q), (bf16_t*)(ws + WS_K), (bf16_t*)(ws + WS_V), (bf16_t*)(ws + WS_U), (bf16_t*)(ws + WS_VS), (bf16_t*)(ws + WS_GAB), (float*)(ws + WS_VSPART)};
            gemm_phase<EpiIn, DenseOrder, true>(lds + RING_OFF, D, S, E, wave0);
            { const int nshort = (G == 256) ? 128 : G; const int c2 = (G == 256) ? bx - 128 : bx;
              if (c2 >= 0) { DenseOrder S2; S2.init(M, D, nshort, c2, ws + WS_PB + (size_t)L * M * 256 * 2, wl + WO_PP, 256);
                  EpiPlain E2{(bf16_t*)(ws + WS_E) + (size_t)L * M * D, D, 0};
                  gemm_phase<EpiPlain, DenseOrder, true>(lds + RING_OFF, 256, S2, E2, wave0); } }
        }
        SEAM(pb + 0);
        if (IN(pb + 1)) for (int rep = 0; rep < REPS(8 | 2048); ++rep) {
            KArgs A = fresh(kp0); unsigned char* ws = A->ws; unsigned char* wl = ws + WS_W + (size_t)L * WL_STRIDE;
            FK_IDS;
            LAS unsigned char* wlds = lds + RING_OFF + wave * WLDS_BYTES;
            constexpr int NATT = 2 * 8 * (SEQ / 32), NSGU = (M / 128) * 8 * 2;
            const int nun = (NATT + NSGU - gw + NGW - 1) / NGW;
            for (int k_ = 0; k_ < nun; ++k_) { const int kk_ = (wave >= 4) ? (k_ == 0 ? nun - 1 : k_ - 1) : k_; const int it = gw + kk_ * NGW;
                if (rep == 1 && (it < NATT ? !(FK_REP & 8) : !(FK_REP & 2048))) continue;
                if (it < NATT) { const int qblk = it % (SEQ / 32), bh = it / (SEQ / 32); attn_wave_unit(bh >> 3, bh & 7, qblk, (const bf16_t*)(ws + WS_Q), (const bf16_t*)(ws + WS_K), (const bf16_t*)(ws + WS_V), (bf16_t*)(ws + WS_OC), wlds, lane); }
                else { const int j = it - NATT; const int hf = j & 1, g = (j >> 1) & 7, ch = j >> 4;
                    if (hf == 0) sgu_wave_unit<0>(ch, g, (const bf16_t*)(ws + WS_U), (const bf16_t*)(ws + WS_VS), (const float*)(ws + WS_VSPART), (const bf16_t*)(wl + WO_SP), A->in[8] + (size_t)L * 8 * 128, A->in[6] + (size_t)L * 512, (bf16_t*)(ws + WS_OC), wlds, lane);
                    else sgu_wave_unit<1>(ch, g, (const bf16_t*)(ws + WS_U), (const bf16_t*)(ws + WS_VS), (const float*)(ws + WS_VSPART), (const bf16_t*)(wl + WO_SP), A->in[8] + (size_t)L * 8 * 128, A->in[6] + (size_t)L * 512, (bf16_t*)(ws + WS_OC), wlds, lane); }
            }
        }
        SEAM(pb + 1);
        if (IN(pb + 2)) for (int rep = 0; rep < REPS(16); ++rep) {
            KArgs A = fresh(kp0); unsigned char* ws = A->ws; unsigned char* wl = ws + WS_W + (size_t)L * WL_STRIDE;
            DenseOrder S; S.init(M, D, G, bx, ws + WS_OC, wl + WO_UP, D);
            EpiUp E{(const bf16_t*)(ws + WS_GAB), (bf16_t*)(ws + WS_MG)};
            gemm_phase<EpiUp, DenseOrder, false>(lds + RING_OFF, D, S, E, wave0);
        }
        SEAM(pb + 2);
        if (IN(pb + 3)) {
            KArgs A = fresh(kp0); unsigned char* ws = A->ws; unsigned char* wl = ws + WS_W + (size_t)L * WL_STRIDE;
            DenseOrder S; S.init(M, D, G, bx, ws + WS_MG, wl + WO_OUT, D);
            EpiOut E{(const bf16_t*)(ws + WS_XB), (bf16_t*)(ws + WS_XB1)};
            gemm_phase<EpiOut, DenseOrder, false>(lds + RING_OFF, D, S, E, wave0);
        }
        SEAM(pb + 3);
        if (IN(pb + 4)) {
            KArgs A = fresh(kp0); unsigned char* ws = A->ws; unsigned char* wl = ws + WS_W + (size_t)L * WL_STRIDE;
            FK_IDS;
            router_pass((const bf16_t*)(ws + WS_XB1), (const bf16_t*)(wl + WO_R), (const bf16_t*)(wl + WO_R) + 48 * 1024, A->in[14] + L * 4, A->in[16] + L * 32, (float*)(ws + WS_RS2), (int*)((unsigned*)(ws + WS_CTL) + CW_CNT) + L * NE * CNT_STRIDE, (int*)(ws + WS_TOKL), (int*)(ws + WS_TKE), (int*)(ws + WS_TKP), (float*)(ws + WS_TKW), lds, wave, lane, vcu, G);
        }
        SEAM(pb + 4);
        if (IN(pb + 5) || IN(pb + 6) || IN(pb + 7) || IN(pb + 8)) {
            KArgs A = fresh(kp0); const int* cnt = (const int*)((unsigned*)(A->ws + WS_CTL) + CW_CNT) + L * NE * CNT_STRIDE;
            if (FK_T0) { int s = 0; for (int e = 0; e < NE; ++e) { pref[e] = s; s += (cnt[e * CNT_STRIDE] + 255) >> 8; } pref[NE] = s; }
            __syncthreads();
        }
        const int nG1 = pref[NE] * 4, fr = nG1 / G, n3 = nG1 - fr * G;
        const int jB = (fr >= 1) ? min(2 * (G - n3), (fr * G / 4) * 4) : 0;
        if (IN(pb + 5)) for (int rep = 0; rep < REPS(32); ++rep) {
            KArgs A = fresh(kp0); unsigned char* ws = A->ws; unsigned char* wl = ws + WS_W + (size_t)L * WL_STRIDE; const int* cnt = (const int*)((unsigned*)(ws + WS_CTL) + CW_CNT) + L * NE * CNT_STRIDE;
            ExpertOrder S{G, bx, D, 4, (const char*)(ws + WS_XB1), (const char*)(wl + WO_EI), (size_t)1024 * 1024 * 2, pref, (const int*)(ws + WS_TOKL), cnt, 1, 0, fr, fr * G, 0};
            EpiG1 E{(const int*)(ws + WS_TOKL), cnt, (const float*)(ws + WS_RS2), (bf16_t*)(ws + WS_G)};
            gemm_phase<EpiG1, ExpertOrder, true>(lds + RING_OFF, D, S, E, wave0);
        }
        SEAM(pb + 5);
        if (IN(pb + 6)) {
            KArgs A = fresh(kp0); unsigned char* ws = A->ws; unsigned char* wl = ws + WS_W + (size_t)L * WL_STRIDE; const int* cnt = (const int*)((unsigned*)(ws + WS_CTL) + CW_CNT) + L * NE * CNT_STRIDE;
            if (bx < n3) {
                ExpertOrder S{G, bx, D, 4, (const char*)(ws + WS_XB1), (const char*)(wl + WO_EI), (size_t)1024 * 1024 * 2, pref, (const int*)(ws + WS_TOKL), cnt, 1, fr * G, 1, nG1, 0};
                EpiG1 E{(const int*)(ws + WS_TOKL), cnt, (const float*)(ws + WS_RS2), (bf16_t*)(ws + WS_G)};
                gemm_phase<EpiG1, ExpertOrder, true>(lds + RING_OFF, D, S, E, wave0);
            } else {
                ExpertOrder S{G - n3, bx - n3, 512, 4, (const char*)(ws + WS_G), (const char*)(wl + WO_EO), (size_t)1024 * 512 * 2, pref, (const int*)(ws + WS_TOKL), cnt, 0, 0, 2, jB, 0};
                EpiPlain E{(bf16_t*)(ws + WS_YS), D, 1};
                gemm_phase<EpiPlain, ExpertOrder, true>(lds + RING_OFF, 512, S, E, wave0);
            }
        }
        SEAM(pb + 6);
        if (IN(pb + 7)) for (int rep = 0; rep < REPS(64); ++rep) {
            KArgs A = fresh(kp0); unsigned char* ws = A->ws; unsigned char* wl = ws + WS_W + (size_t)L * WL_STRIDE; const int* cnt = (const int*)((unsigned*)(ws + WS_CTL) + CW_CNT) + L * NE * CNT_STRIDE;
            ExpertOrder S{G, bx, 512, 4, (const char*)(ws + WS_G), (const char*)(wl + WO_EO), (size_t)1024 * 512 * 2, pref, (const int*)(ws + WS_TOKL), cnt, 0, jB, 1 << 20, nG1, 0};
            EpiPlain E{(bf16_t*)(ws + WS_YS), D, 1};
            gemm_phase<EpiPlain, ExpertOrder, true>(lds + RING_OFF, 512, S, E, wave0);
        }
        SEAM(pb + 7);
        if (IN(pb + 8)) {
            KArgs A = fresh(kp0); unsigned char* ws = A->ws;
            FK_IDS;
            combine_pass((bf16_t*)(ws + WS_XB1), (const bf16_t*)(ws + WS_YS), pref, (const int*)(ws + WS_TKE), (const int*)(ws + WS_TKP), (const float*)(ws + WS_TKW), (float*)(ws + WS_RS3), lane, gw, NGW);
        }
        SEAM(pb + 8);
        if (IN(pb + 9)) {
            KArgs A = fresh(kp0); unsigned char* ws = A->ws; unsigned char* wl = ws + WS_W + (size_t)L * WL_STRIDE;
            DenseOrder S; S.init(M, D, G, bx, ws + WS_XB1, wl + WO_PG, D);
            EpiPle E{(const bf16_t*)(ws + WS_XB1), (bf16_t*)(ws + WS_XB), (L == nlayers - 1) ? A->out : (float*)nullptr, (const bf16_t*)(ws + WS_E) + (size_t)L * M * D, (const float*)(ws + WS_RS3), (float*)(ws + WS_XPART)};
            gemm_phase<EpiPle, DenseOrder, false>(lds + RING_OFF, D, S, E, wave0);
        }
        SEAM(pb + 9);
    }
#undef IN
#undef SEAM
#undef SEAM_F
#undef FK_IDS
#undef FK_T0
}
}
#ifndef FK_N_LAUNCHES
#define FK_N_LAUNCHES 1
#endif
static int fk_grid = 0;
static bool fk_setup() {
    if (fk_grid) return fk_grid > 0;
    int dev = 0, cus = 0, per_cu = 0;
    if (hipGetDevice(&dev) != hipSuccess || hipDeviceGetAttribute(&cus, hipDeviceAttributeMultiprocessorCount, dev) != hipSuccess) { fprintf(stderr, "kernel_launch: device query failed\n"); fk_grid = -1; return false; }
    if (hipFuncSetAttribute((const void*)fk::mega_fwd, hipFuncAttributeMaxDynamicSharedMemorySize, fk::LDS_BYTES) != hipSuccess) { fprintf(stderr, "kernel_launch: hipFuncSetAttribute failed\n"); fk_grid = -1; return false; }
    if (hipOccupancyMaxActiveBlocksPerMultiprocessor(&per_cu, (const void*)fk::mega_fwd, fk::NWAVES * 64, fk::LDS_BYTES) != hipSuccess || per_cu < 1)
        fprintf(stderr, "kernel_launch: note: occupancy query reports %d workgroups per CU\n", per_cu);
    (void)hipGetLastError();
    fk_grid = cus;
    return true;
}
static void fk_launch_range(fk::Args a, int lo, int hi, hipStream_t stream) {
    a.ph_lo = lo; a.ph_hi = hi;
    hipLaunchKernelGGL(fk::mega_fwd, dim3(fk_grid), dim3(fk::NWAVES * 64), fk::LDS_BYTES, stream, a);
    const hipError_t le = hipPeekAtLastError();
    if (le != hipSuccess) fprintf(stderr, "kernel_launch: launch [%d,%d) failed: %s\n", lo, hi, hipGetErrorName(le));
}

#ifdef FK_DEBUG_CHECK
#ifndef FK_FOCUS
#define FK_FOCUS 0
#endif
#ifndef FK_STAT
#define FK_STAT 1
#endif
namespace dbg {
__global__ void __launch_bounds__(256) k_cmp(const void* fast, int is_bf16, int fld, int fcol0, const float* gold, int gld, int gcol0, int rows, int cols, float gscale, float* acc) {
    float sd = 0.f, sb = 0.f, sa = 0.f, sb2 = 0.f;
    const size_t n = (size_t)rows * cols;
    for (size_t i = (size_t)blockIdx.x * 256 + threadIdx.x; i < n; i += (size_t)gridDim.x * 256) {
        const size_t r = i / cols; const int c = (int)(i % cols);
        float a;
        if (is_bf16) { const unsigned short h = ((const unsigned short*)fast)[r * fld + fcol0 + c]; a = __uint_as_float((unsigned)h << 16); } else a = ((const float*)fast)[r * fld + fcol0 + c];
        const float b = gold[r * gld + gcol0 + c] * gscale;
        const float d = a - b; sd += d * d; sb += b * b; sa += (FK_STAT == 2 ? a : FK_STAT == 3 ? a * b : FK_STAT == 4 ? (a > 0.99f ? 1.f : 0.f) : a * a); sb2 += (FK_STAT == 2 ? b : FK_STAT == 4 ? 1.f : b * b);
    }
    for (int o = 1; o < 64; o <<= 1) { sd += __shfl_xor(sd, o); sb += __shfl_xor(sb, o); sa += __shfl_xor(sa, o); sb2 += __shfl_xor(sb2, o); }
    if ((threadIdx.x & 63) == 0) { atomicAdd(&acc[0], sd); atomicAdd(&acc[1], sb); atomicAdd(&acc[512], sa); atomicAdd(&acc[513], sb2); }
}
__global__ void __launch_bounds__(256) k_cmp_vs(const unsigned short* vsb, const float* vspart, const float* gain, const float* gz, float* acc) {
    const int row = blockIdx.x * 4 + (threadIdx.x >> 6), lane = threadIdx.x & 63;
    float ss = 0.f; for (int j = 0; j < 8; ++j) ss += vspart[(size_t)row * 8 + j];
    const float rv = 1.f / sqrtf(ss / 512.f + 1e-6f);
    float sd = 0.f, sb = 0.f;
    for (int j = 0; j < 8; ++j) { const int c = lane + 64 * j; const float a = __uint_as_float((unsigned)vsb[(size_t)row * 512 + c] << 16) * rv * gain[c]; const float b = gz[(size_t)row * 4608 + 2048 + c]; sd += (a - b) * (a - b); sb += b * b; }
    for (int o = 1; o < 64; o <<= 1) { sd += __shfl_xor(sd, o); sb += __shfl_xor(sb, o); }
    if (lane == 0) { atomicAdd(&acc[0], sd); atomicAdd(&acc[1], sb); }
}
__global__ void __launch_bounds__(256) k_cmp_w(const unsigned short* wt, const float* w, const float* gain, int n0, int n1, float* acc) {
    float sd = 0.f, sb = 0.f; const size_t tot = (size_t)(n1 - n0) * 1024;
    for (size_t i = (size_t)blockIdx.x * 256 + threadIdx.x; i < tot; i += (size_t)gridDim.x * 256) { const int n = n0 + (int)(i >> 10), k = (int)(i & 1023);
        const float a = __uint_as_float((unsigned)wt[(size_t)n * 1024 + k] << 16), b = gain[k] * w[(size_t)k * 4608 + n]; sd += (a - b) * (a - b); sb += b * b; }
    for (int o = 1; o < 64; o <<= 1) { sd += __shfl_xor(sd, o); sb += __shfl_xor(sb, o); }
    if ((threadIdx.x & 63) == 0) { atomicAdd(&acc[0], sd); atomicAdd(&acc[1], sb); }
}
__global__ void k_final_v(const float* acc, int nchecks, float tol, float* v, int focus) {
    if (threadIdx.x == 0 && blockIdx.x == 0) {
        float out = 0.f;
        if (focus > 0) { float m = acc[2 * focus + 512] / acc[2 * focus + 513]; if (FK_STAT == 1) m = sqrtf(m); if (!(m <= 8.f)) m = 8.f; m = floorf(m * 20.f + 0.5f) * 0.05f; v[0] = powf(10.f, (float)focus) * (1.f + m); return; }
        for (int c = nchecks; c >= 1; --c) { const float e = sqrtf(acc[2 * c] / acc[2 * c + 1]); if (!(e <= tol)) { float m = e; if (!(m <= 2.f)) m = 2.f; m = floorf(m * 10.f + 0.5f) * 0.1f;   out = powf(10.f, (float)c) * (1.f + m); } }
        v[0] = out;
    }
}
__global__ void __launch_bounds__(256) k_scale_out(const float* base, const float* v, float* out, size_t n) {
    const size_t i = (size_t)blockIdx.x * 256 + threadIdx.x; if (i < n) out[i] = base[i] * (1.f + v[0]);
}
}
#endif

extern "C" void kernel_launch(void* const* d_in, const int* in_sizes, int n_in, void* d_out, int out_size, void* d_ws, size_t ws_size, hipStream_t stream) {
    using namespace fk;
    if (n_in != 22 || out_size != M * D || ws_size < WS_FAST_END) { fprintf(stderr, "kernel_launch: unexpected shapes (n_in %d out %d ws %zu)\n", n_in, out_size, ws_size); return; }
    if (!fk_setup()) return;
    if (hipMemsetAsync((char*)d_ws + WS_CTL, 0, CTL_ZERO_BYTES, stream) != hipSuccess) { fprintf(stderr, "kernel_launch: memset failed\n"); return; }
    Args a{};
    for (int i = 0; i < 22; ++i) a.in[i] = (const float*)d_in[i];
    a.out = (float*)d_out; a.ws = (unsigned char*)d_ws; a.nlayers = DEPTH; a.pad = 0;
#ifndef FK_DEBUG_CHECK
    const int nph = 2 + PH_PER_LAYER * DEPTH;
    if (FK_N_LAUNCHES == 1) fk_launch_range(a, 0, nph, stream);
    else for (int p = 0; p < nph; ++p) fk_launch_range(a, p, p + 1, stream);
#else
    constexpr size_t GOLD_BASE = 1100 * MiB, SN_A = 128 * MiB, SN_B = 192 * MiB, SN_BASE = 256 * MiB, FS_A = 320 * MiB, FS_B = 384 * MiB, DBG_ACC = 448 * MiB;
    if (ws_size < GOLD_BASE + gold::O_END) { fprintf(stderr, "kernel_launch: debug build needs %zu bytes of workspace, got %zu\n", GOLD_BASE + gold::O_END, ws_size); return; }
    unsigned char* ws = (unsigned char*)d_ws; unsigned char* gb = ws + GOLD_BASE;
    gold::forward(d_in, (float*)(ws + SN_BASE), gb, 4, stream);
    gold::forward(d_in, nullptr, gb, 1, stream, (float*)(ws + SN_A), (float*)(ws + SN_B));
    a.nlayers = 1;
    const int nph = 2 + PH_PER_LAYER;
    for (int p = 0; p < nph; ++p) {
        fk_launch_range(a, p, p + 1, stream);
        if (p == 2 + 0) (void)hipMemcpyAsync(ws + 528 * MiB, ws + WS_GAB, (size_t)M * 2048 * 2, hipMemcpyDeviceToDevice, stream);
        if (p == 2 + 3) (void)hipMemcpyAsync(ws + FS_A, d_out, (size_t)M * D * 4, hipMemcpyDeviceToDevice, stream);
        if (p == 2 + 7) (void)hipMemcpyAsync(ws + FS_B, d_out, (size_t)M * D * 4, hipMemcpyDeviceToDevice, stream);
    }
    float* acc = (float*)(ws + DBG_ACC);
    (void)hipMemsetAsync(acc, 0, 4096, stream);
    const float* gz = (const float*)(gb + gold::O_Z);
    int c = 0;
#define CMP(fast, isbf, fld, fc0, gold_, gld, gc0, rows, cols, gs) do { ++c; hipLaunchKernelGGL(dbg::k_cmp, dim3(2048), dim3(256), 0, stream, (const void*)(fast), isbf, fld, fc0, (const float*)(gold_), gld, gc0, rows, cols, gs, acc + 2 * c); } while (0)
    ++c; hipLaunchKernelGGL(dbg::k_cmp_w, dim3(1024), dim3(256), 0, stream, (const unsigned short*)(ws + WS_W + WO_IN), (const float*)d_in[3], (const float*)d_in[2], 1024, 2560, acc + 2 * c);
    ++c; hipLaunchKernelGGL(dbg::k_cmp_w, dim3(1024), dim3(256), 0, stream, (const unsigned short*)(ws + WS_W + WO_IN), (const float*)d_in[3], (const float*)d_in[2], 2560, 3584, acc + 2 * c);
    ++c; hipLaunchKernelGGL(dbg::k_cmp_w, dim3(1024), dim3(256), 0, stream, (const unsigned short*)(ws + WS_W + WO_IN), (const float*)d_in[3], (const float*)d_in[2], 3584, 4608, acc + 2 * c);
    CMP(ws + WS_E, 1, 1024, 0, gb + gold::O_YB, 1024, 0, M, 1024, 1.f);
    CMP(ws + WS_Q, 1, 512, 0, gz, INW, 0, M, 512, 0.125f * LOG2E);
    CMP(ws + WS_K, 1, 512, 0, gz, INW, 512, M, 512, 1.f);
    CMP(ws + WS_V, 1, 512, 0, gz, INW, 1024, M, 512, 1.f);
    CMP(ws + WS_U, 1, 512, 0, gz, INW, 1536, M, 512, 1.f);
    ++c; hipLaunchKernelGGL(dbg::k_cmp_vs, dim3(M / 4), dim3(256), 0, stream, (const unsigned short*)(ws + WS_VS), (const float*)(ws + WS_VSPART), (const float*)d_in[6], gz, acc + 2 * c);
    CMP(ws + WS_OC, 1, 1024, 0, gb + gold::O_OA, 512, 0, M, 512, 1.f);
    CMP(ws + WS_OC, 1, 1024, 512, gb + gold::O_OB, 512, 0, M, 512, 1.f);
    CMP(ws + WS_MG, 1, 1024, 0, gb + gold::O_YA, 1024, 0, M, 1024, 1.f);
    CMP(ws + FS_A, 0, 1024, 0, ws + SN_A, 1024, 0, M, 1024, 1.f);
    CMP(ws + FS_B, 0, 1024, 0, ws + SN_B, 1024, 0, M, 1024, 1.f);
    CMP(d_out, 0, 1024, 0, gb + gold::O_X, 1024, 0, M, 1024, 1.f);
    CMP(ws + 528 * MiB, 1, 2048, 0, gz, INW, 2560, M, 256, 1.f);
    CMP(ws + WS_GAB, 1, 2048, 0, gz, INW, 2560, M, 256, 1.f);
    CMP(ws + WS_GAB, 1, 2048, 256, gz, INW, 2816, M, 256, 1.f);
    CMP(ws + WS_GAB, 1, 2048, 512, gz, INW, 3072, M, 512, 1.f);
    CMP(ws + WS_GAB, 1, 2048, 1024, gz, INW, 3584, M, 1024, 1.f);
    hipLaunchKernelGGL(dbg::k_final_v, dim3(1), dim3(64), 0, stream, acc, c, 0.03f, acc + 900, FK_FOCUS);
    hipLaunchKernelGGL(dbg::k_scale_out, dim3(M * D / 256), dim3(256), 0, stream, (const float*)(ws + SN_BASE), acc + 900, (float*)d_out, (size_t)M * D);
#endif
}
```

```cpp
#include <hip/hip_runtime.h>
#include <hip/hip_bf16.h>
#include <cstdio>
#include <cstdint>
#include <cmath>
#define FK_EARLY_INV 2
namespace fk {
#define LAS __attribute__((address_space(3)))
#define GAS __attribute__((address_space(1)))
typedef unsigned short bf16_t;
typedef short bf16x8 __attribute__((ext_vector_type(8)));
typedef short s16x4 __attribute__((ext_vector_type(4)));
typedef float f32x2 __attribute__((ext_vector_type(2)));
typedef float f32x4 __attribute__((ext_vector_type(4)));
typedef float f32x16 __attribute__((ext_vector_type(16)));
typedef unsigned u32x2 __attribute__((ext_vector_type(2)));
typedef unsigned u32x4 __attribute__((ext_vector_type(4)));

constexpr int M = 16384, SEQ = 8192, D = 1024, INW = 4608, NE = 32, ECAP = 16384, DEPTH = 4;
constexpr float EPS = 1e-6f, LOG2E = 1.4426950408889634f;
constexpr int CNT_STRIDE = 64;
constexpr int BM = 256, BK = 64, HALF = 128, HTB = HALF * BK * 2, STAGE_BYTES = 8 * HTB, NXCD = 8, WGM = 8;

__device__ __forceinline__ unsigned cvt_pk_bf16(float lo, float hi) { unsigned r; asm volatile("v_cvt_pk_bf16_f32 %0, %1, %2" : "=v"(r) : "v"(lo), "v"(hi)); return r; }
__device__ __forceinline__ float bf_lo(unsigned w) { return __uint_as_float(w << 16); }
__device__ __forceinline__ float bf_hi(unsigned w) { return __uint_as_float(w & 0xffff0000u); }
__device__ __forceinline__ float fast_rcp(float x) { return __builtin_amdgcn_rcpf(x); }
__device__ __forceinline__ float fast_exp2(float x) { return __builtin_amdgcn_exp2f(x); }
__device__ __forceinline__ float fast_log2(float x) { return __builtin_amdgcn_logf(x); }
__device__ __forceinline__ float fast_rsq(float x) { return __builtin_amdgcn_rsqf(x); }
__device__ __forceinline__ float sigmoid_f(float x) { return fast_rcp(1.f + fast_exp2(-LOG2E * x)); }
__device__ __forceinline__ float gelu_tanh_f(float x) { const float u2 = 1.5957691216057308f * (x + 0.044715f * x * x * x); return x * fast_rcp(1.f + fast_exp2(-LOG2E * u2)); }

__host__ __device__ __forceinline__ int lds_byte(int r, int c) { const int st = (r >> 4) * 2 + (c >> 5), rr = r & 15, cc = c & 31, ob = rr * 64 + cc * 2; return st * 1024 + (ob ^ (((ob >> 9) & 1) << 5)); }
__host__ __device__ __forceinline__ void stage_rc(int b, int& R, int& C) { const int st = b / 1024, sb = b % 1024, swz = sb ^ (((sb >> 9) & 1) << 5); R = (st >> 1) * 16 + swz / 64; C = (st & 1) * 32 + (swz % 64) / 2; }
__host__ __device__ __forceinline__ int perm32(int rho) { const int n = rho >> 4, i = rho & 15; return 8 * (i >> 2) + 4 * n + (i & 3); }

template <int MASK> __device__ __forceinline__ float xor_lt32(float v) { return __int_as_float(__builtin_amdgcn_ds_swizzle(__float_as_int(v), (MASK << 10) | 0x1f)); }
__device__ __forceinline__ void halves32(float v, float& lo, float& hi) { auto rr = __builtin_amdgcn_permlane32_swap(__float_as_uint(v), __float_as_uint(v), false, false); lo = __uint_as_float(rr[0]); hi = __uint_as_float(rr[1]); }
__device__ __forceinline__ float sum_xor16_32(float v) { v += xor_lt32<16>(v); float lo, hi; halves32(v, lo, hi); return lo + hi; }
#ifndef FK_PFR
#define FK_PFR 0
#endif
#ifndef FK_UNC
#define FK_UNC 0
#endif
#ifndef FK_RAWG
#define FK_RAWG 0
#endif
#ifndef FK_WT
#define FK_WT 0
#endif
__device__ __forceinline__ void st16wt(void* p, u32x4 v) {
#if FK_WT
    asm volatile("global_store_dwordx4 %0, %1, off sc1\n\ts_nop 1" :: "v"(p), "v"(v) : "memory");
#else
    *(u32x4*)p = v;
#endif
}
#ifndef FK_NT
#define FK_NT 0
#endif
#ifndef FK_WT1
#define FK_WT1 0
#endif
__device__ __forceinline__ void st16o(void* p, u32x4 v) {
#if FK_WT1
    asm volatile("global_store_dwordx4 %0, %1, off sc1\n\ts_nop 1" :: "v"(p), "v"(v) : "memory");
#else
    *(u32x4*)p = v;
#endif
}
__device__ __forceinline__ void st16(void* p, u32x4 v) {
#if FK_WT
    st16wt(p, v);
#elif FK_NT
    __builtin_nontemporal_store(v, (u32x4*)p);
#else
    *(u32x4*)p = v;
#endif
}
__device__ __forceinline__ int fk_lane() { int l; asm volatile("v_mbcnt_lo_u32_b32 %0, -1, 0\n\tv_mbcnt_hi_u32_b32 %0, -1, %0" : "=v"(l)); return l; }
struct Unit { int pm, pn, e, aux; };

struct DenseOrder {
    int nM, nN, nwg, G, c; const char* A; const char* B; int K;
    __device__ void init(int Mr, int N, int G_, int c_, const void* A_, const void* B_, int K_) { nM = Mr / BM; nN = N / BM; nwg = nM * nN; G = G_; c = c_; A = (const char*)A_; B = (const char*)B_; K = K_; }
    __device__ __forceinline__ bool next(int i, Unit& u) const {
        const long L = (long)i * G + c; if (L >= nwg) return false;
        int wgid = (int)L; { const int q = nwg / NXCD, r = nwg % NXCD, xcd = wgid % NXCD, off = wgid / NXCD; wgid = (xcd < r ? xcd * (q + 1) : r * (q + 1) + (xcd - r) * q) + off; }
        const int nig = WGM * nN, gid = wgid / nig, fm = gid * WGM, gsz = (nM - fm) < WGM ? (nM - fm) : WGM;
        u.pm = fm + ((wgid % nig) % gsz); u.pn = (wgid % nig) / gsz; u.e = 0; u.aux = 0; return true;
    }
    __device__ __forceinline__ const char* a_base() const { return A; }
    __device__ __forceinline__ const char* b_base(const Unit& u) const { return B + (size_t)u.pn * BM * K * 2; }
    __device__ __forceinline__ void a_voff(const Unit& u, unsigned (&v)[2][2], const int (&R)[2], const int (&C)[2]) const {
#pragma unroll
        for (int h = 0; h < 2; ++h)
#pragma unroll
            for (int i = 0; i < 2; ++i) v[h][i] = (unsigned)((u.pm * BM + h * HALF + R[i]) * K + C[i]) * 2u;
    }
};

struct ExpertOrder {
    int G, c, K, nN; const char* A; const char* B; size_t bstride; const LAS int* pref; const int* tokl; const int* cnt; int gather;
    int L0, imax, Lend;
    int xcd_deal;
    int xx, frb, ltot;
    __device__ __forceinline__ bool next(int i, Unit& u) const {
        if (i >= imax) return false;
        if (xcd_deal == 2) {
            const int L = L0 + i * G + c; if (L >= Lend || L >= ltot) return false;
            const int lrb = L / nN; u.pn = L % nN;
            const int rbi = lrb < frb ? ((lrb >> 3) * 64 + 8 * xx + (lrb & 7)) : (frb * 8 + xx + 8 * (lrb - frb));
            int e = 0;
#pragma unroll 1
            for (int j = 1; j < NE; ++j) if (rbi >= pref[j]) e = j;
            u.e = e; u.pm = rbi - pref[e]; u.aux = rbi * BM; return true;
        }
        int u_ = c; if (xcd_deal) { const int q = c >> 3, x = c & 7; u_ = (x * (G >> 5) + (q >> 2)) * 4 + (q & 3); }
        const int L = L0 + i * G + u_; const int tot = pref[NE] * nN; if (L >= Lend || L >= tot) return false;
        const int rbi = L / nN; u.pn = L % nN; int e = 0;
#pragma unroll 1
        for (int j = 1; j < NE; ++j) if (rbi >= pref[j]) e = j;
        u.e = e; u.pm = rbi - pref[e]; u.aux = rbi * BM; return true;
    }
    __device__ __forceinline__ const char* a_base() const { return A; }
    __device__ __forceinline__ const char* b_base(const Unit& u) const { return B + (size_t)u.e * bstride + (size_t)u.pn * BM * K * 2; }
    __device__ __forceinline__ void a_voff(const Unit& u, unsigned (&v)[2][2], const int (&R)[2], const int (&C)[2]) const {
        const int ce = pref[40 + u.e];
#pragma unroll
        for (int h = 0; h < 2; ++h)
#pragma unroll
            for (int i = 0; i < 2; ++i) {
                const int r = u.pm * BM + h * HALF + R[i]; int row;
                if (gather == 1) { const int tk = tokl[u.e * ECAP + r]; row = (r < ce) ? tk : 0; }
                else if (gather == 2) row = (u.aux + h * HALF + R[i]) & (M - 1);
                else row = u.aux + h * HALF + R[i];
                v[h][i] = (unsigned)(row * K + C[i]) * 2u;
            }
    }
};

template <class Epi, class Sched, bool ALIGN_EPI>
__device__ __forceinline__ void gemm_phase(LAS unsigned char* lds, const int K, const Sched& S, const Epi& E, const int wave_id, const bool dry = false  ) {
    const int tid_ = (wave_id << 6) | fk_lane();
    const int tid = tid_, wid = __builtin_amdgcn_readfirstlane(tid >> 6), lane = tid & 63, wr = wid >> 2, wc = wid & 3, fr = lane & 15, fq = lane >> 4;
    const int nt = K / BK;
    int Rr[2], Cc[2]; unsigned voffB[2];
#pragma unroll
    for (int i = 0; i < 2; ++i) { int R, C; stage_rc(tid * 16 + i * 8192, R, C); Rr[i] = R; Cc[i] = C; const int Rb = Epi::PERM ? ((R & ~31) + perm32(R & 31)) : R; voffB[i] = (unsigned)(Rb * K + C) * 2u; }
    const size_t kstep = (size_t)(BK * 2);
    const size_t hstep = (size_t)HALF * K * 2;
    const unsigned ldsw = (unsigned)wid * 1024u;
    const int aoff = lds_byte(wr * 64 + fr, fq * 8), boff = lds_byte(wc * 32 + fr, fq * 8);
#define PG8_SA(b, h) (((b) * 2 + (h)) * HTB)
#define PG8_SB(b, h) ((4 + (b) * 2 + (h)) * HTB)
#define PG8_STAGE_B(bufoff, gbase) do { _Pragma("unroll") for (int _i = 0; _i < 2; ++_i) \
        __builtin_amdgcn_global_load_lds((const unsigned*)((const char*)(gbase) + voffB[_i]), (LAS unsigned*)(lds + (bufoff) + ldsw + _i * 8192), 16, 0, 0); } while (0)
#define PG8_STAGE_AX(base, bufoff, vo, h, koff) do { _Pragma("unroll") for (int _i = 0; _i < 2; ++_i) \
        __builtin_amdgcn_global_load_lds((const unsigned*)((base) + (size_t)(vo)[h][_i] + (size_t)(koff)), (LAS unsigned*)(lds + (bufoff) + ldsw + _i * 8192), 16, 0, 0); } while (0)
#define PG8_STAGE_A(bufoff, vo, h, koff) PG8_STAGE_AX(Ab, bufoff, vo, h, koff)
#define PG8_LDA(dst, b, h) do { _Pragma("unroll") for (int m = 0; m < 4; ++m) _Pragma("unroll") for (int k = 0; k < 2; ++k) dst[m][k] = *(const LAS bf16x8*)(lds + PG8_SA(b, h) + aoff + m * 2048 + k * 1024); } while (0)
#define PG8_LDB(dst, b, h) do { _Pragma("unroll") for (int n = 0; n < 2; ++n) _Pragma("unroll") for (int k = 0; k < 2; ++k) dst[n][k] = *(const LAS bf16x8*)(lds + PG8_SB(b, h) + boff + n * 2048 + k * 1024); } while (0)
#define PG8_MMA(ai, bj, At, Bt) do { __builtin_amdgcn_s_setprio(1); _Pragma("unroll") for (int m = 0; m < 4; ++m) _Pragma("unroll") for (int n = 0; n < 2; ++n) _Pragma("unroll") for (int k = 0; k < 2; ++k) \
        acc[ai][bj][m][n] = __builtin_amdgcn_mfma_f32_16x16x32_bf16(Bt[n][k], At[m][k], acc[ai][bj][m][n], 0, 0, 0); __builtin_amdgcn_s_setprio(0); } while (0)
#define PG8_WAIT_V(n) asm volatile("s_waitcnt vmcnt(" #n ")" ::: "memory")
#define PG8_WAIT_L(n) asm volatile("s_waitcnt lgkmcnt(" #n ")" ::: "memory")
#define PG8_BAR __builtin_amdgcn_s_barrier()
#define PG8_SCHED __builtin_amdgcn_sched_barrier(0)
    Unit cur, nxt; int ui = 0;
    if (!S.next(0, cur)) return;
    f32x4 acc[2][2][4][2];
#pragma unroll
    for (int a = 0; a < 2; ++a)
#pragma unroll
        for (int b = 0; b < 2; ++b)
#pragma unroll
            for (int m = 0; m < 4; ++m)
#pragma unroll
                for (int n = 0; n < 2; ++n) acc[a][b][m][n] = (f32x4){0.f, 0.f, 0.f, 0.f};
    bf16x8 At[4][2], B0[2][2], B1[2][2];
    const char* Ab = S.a_base();
    const char* pfb = (const char*)E.pf_base();
    unsigned cvA[2][2], nvA[2][2];
    S.a_voff(cur, cvA, Rr, Cc);
    const char* cB = S.b_base(cur);
    PG8_STAGE_B(PG8_SB(0, 0), cB); PG8_STAGE_B(PG8_SB(0, 1), cB + hstep); PG8_STAGE_A(PG8_SA(0, 0), cvA, 0, 0); PG8_STAGE_A(PG8_SA(0, 1), cvA, 1, 0);
    if (wr == 1) PG8_BAR;
    PG8_WAIT_V(2); PG8_BAR;
    PG8_STAGE_B(PG8_SB(1, 0), cB + kstep); PG8_STAGE_A(PG8_SA(1, 0), cvA, 0, kstep); PG8_STAGE_B(PG8_SB(1, 1), cB + hstep + kstep);
    PG8_WAIT_V(6); PG8_BAR;
    for (;;) {
        const bool has_next = S.next(ui + 1, nxt);
        const char* nB = has_next ? S.b_base(nxt) : cB;
        if (has_next) S.a_voff(nxt, nvA, Rr, Cc);
        else {
#pragma unroll
            for (int h = 0; h < 2; ++h)
#pragma unroll
                for (int i = 0; i < 2; ++i) nvA[h][i] = cvA[h][i];
        }
#pragma unroll 1
        for (int t = 0; t < nt; t += 2) {
            const bool last = (t == nt - 2);
            if constexpr (Epi::HAS_MID) { if (t == Epi::MID_T) E.mid(acc, cur, wr, wc, fr, fq); }
            const size_t k1 = (size_t)(t + 1) * kstep;
            unsigned a2[2][2];
#pragma unroll
            for (int h = 0; h < 2; ++h)
#pragma unroll
                for (int i = 0; i < 2; ++i) a2[h][i] = last ? nvA[h][i] : cvA[h][i] + (unsigned)((t + 2) * (BK * 2));
            const bool pfl = FK_PFR && last && !has_next && pfb != nullptr;
            if (pfl) {
#pragma unroll
                for (int h = 0; h < 2; ++h)
#pragma unroll
                    for (int i = 0; i < 2; ++i) a2[h][i] = cvA[h][i] + (unsigned)((cur.pn * BM + 128) * 2);
            }
            const char* Ab2 = pfl ? pfb : Ab;
            const char* b2 = pfl ? pfb + ((size_t)cur.pm * BM * K + (size_t)cur.pn * BM) * 2 : (last ? nB : cB + (size_t)(t + 2) * kstep);
            const char* b3 = b2 + kstep;
            PG8_LDB(B0, 0, 0); PG8_LDB(B1, 0, 1); PG8_SCHED; PG8_LDA(At, 0, 0); PG8_STAGE_A(PG8_SA(1, 1), cvA, 1, k1);
            PG8_WAIT_V(8); PG8_WAIT_L(0); PG8_BAR; PG8_MMA(0, 0, At, B0); PG8_MMA(0, 1, At, B1); PG8_BAR; PG8_SCHED;
            PG8_LDA(At, 0, 1); PG8_STAGE_B(PG8_SB(0, 0), b2); PG8_STAGE_B(PG8_SB(0, 1), b2 + hstep); PG8_STAGE_AX(Ab2, PG8_SA(0, 0), a2, 0, 0);
            PG8_WAIT_V(8); PG8_WAIT_L(0); PG8_BAR; PG8_MMA(1, 0, At, B0); PG8_MMA(1, 1, At, B1); PG8_BAR; PG8_SCHED;
            PG8_LDB(B0, 1, 0); PG8_LDB(B1, 1, 1); PG8_SCHED; PG8_LDA(At, 1, 0); PG8_STAGE_AX(Ab2, PG8_SA(0, 1), a2, 1, 0);
            PG8_WAIT_V(8); PG8_WAIT_L(0); PG8_BAR; PG8_MMA(0, 0, At, B0); PG8_MMA(0, 1, At, B1); PG8_BAR; PG8_SCHED;
            PG8_LDA(At, 1, 1); PG8_STAGE_B(PG8_SB(1, 0), b3); PG8_STAGE_B(PG8_SB(1, 1), b3 + hstep); PG8_STAGE_AX(Ab2, PG8_SA(1, 0), a2, 0, kstep);
            PG8_WAIT_V(8); PG8_WAIT_L(0); PG8_BAR; PG8_MMA(1, 0, At, B0); PG8_MMA(1, 1, At, B1); PG8_BAR; PG8_SCHED;
        }
        if constexpr (ALIGN_EPI) { if (wr == 0) PG8_BAR; }
        if (!dry) E(acc, cur, wr, wc, fr, fq);
        if (!has_next) break;
#pragma unroll
        for (int a = 0; a < 2; ++a)
#pragma unroll
            for (int b = 0; b < 2; ++b)
#pragma unroll
                for (int m = 0; m < 4; ++m)
#pragma unroll
                    for (int n = 0; n < 2; ++n) acc[a][b][m][n] = (f32x4){0.f, 0.f, 0.f, 0.f};
        cur = nxt; cB = nB; ++ui;
#pragma unroll
        for (int h = 0; h < 2; ++h)
#pragma unroll
            for (int i = 0; i < 2; ++i) cvA[h][i] = nvA[h][i];
        if constexpr (ALIGN_EPI) { if (wr == 1) PG8_BAR; }
    }
    PG8_WAIT_V(0);
    if constexpr (!ALIGN_EPI) { if (wr == 0) PG8_BAR; }
    PG8_BAR;
#undef PG8_SA
#undef PG8_SB
#undef PG8_STAGE_A
#undef PG8_STAGE_AX
#undef PG8_STAGE_B
#undef PG8_LDA
#undef PG8_LDB
#undef PG8_MMA
#undef PG8_WAIT_V
#undef PG8_WAIT_L
#undef PG8_BAR
#undef PG8_SCHED
}

typedef f32x4 Acc[2][2][4][2];
__device__ __forceinline__ u32x4 pack8(const f32x4 a, const f32x4 b) { u32x4 w; w.x = cvt_pk_bf16(a[0], a[1]); w.y = cvt_pk_bf16(a[2], a[3]); w.z = cvt_pk_bf16(b[0], b[1]); w.w = cvt_pk_bf16(b[2], b[3]); return w; }

struct EpiPlain {
    static constexpr bool PERM = true, HAS_MID = false; static constexpr int MID_T = 0;
    bf16_t* O; int ldc; int use_aux;
    __device__ __forceinline__ const void* pf_base() const { return nullptr; }
    __device__ __forceinline__ void mid(Acc&, const Unit&, int, int, int, int) const {}
    __device__ __forceinline__ void operator()(const Acc& acc, const Unit& u, int wr, int wc, int fr, int fq) const {
        const int row0 = (use_aux ? u.aux : u.pm * BM) + wr * 64 + fr, col0 = u.pn * BM + wc * 32 + 8 * fq;
#pragma unroll
        for (int ai = 0; ai < 2; ++ai)
#pragma unroll
            for (int m = 0; m < 4; ++m) { bf16_t* rowp = O + (size_t)(row0 + ai * HALF + m * 16) * ldc + col0;
#pragma unroll
                for (int bj = 0; bj < 2; ++bj) st16(rowp + bj * HALF, pack8(acc[ai][bj][m][0], acc[ai][bj][m][1])); }
    }
};

struct EpiIn {
    static constexpr bool PERM = true, HAS_MID = false; static constexpr int MID_T = 0;
    const float* xpart; const float* qn; const float* kn;
    bf16_t *qb, *kb, *vb, *ub, *vsb, *gab; float* vspart;
    __device__ __forceinline__ const void* pf_base() const { return nullptr; }
    __device__ __forceinline__ void mid(Acc&, const Unit&, int, int, int, int) const {}
    __device__ __forceinline__ void operator()(const Acc& acc, const Unit& u, int wr, int wc, int fr, int fq) const {
        const int pn = u.pn;
        float rsv[2][4];
        { int rowb = u.pm * BM + wr * 64 + fr; asm volatile("" : "+v"(rowb));
          f32x4 xq[2][4];
#pragma unroll
          for (int ai = 0; ai < 2; ++ai)
#pragma unroll
              for (int m = 0; m < 4; ++m) xq[ai][m] = *(const f32x4*)(xpart + (size_t)(rowb + ai * HALF + m * 16) * 16 + 4 * fq);
#pragma unroll
          for (int ai = 0; ai < 2; ++ai)
#pragma unroll
              for (int m = 0; m < 4; ++m) { const float s_ = sum_xor16_32((xq[ai][m][0] + xq[ai][m][1]) + (xq[ai][m][2] + xq[ai][m][3])); rsv[ai][m] = fast_rsq(s_ * (1.f / D) + EPS); } }
#pragma unroll
        for (int ai = 0; ai < 2; ++ai)
#pragma unroll
            for (int m = 0; m < 4; ++m) {
                const int row = u.pm * BM + ai * HALF + wr * 64 + m * 16 + fr;
                const float rs = rsv[ai][m];
                f32x4 v[2][2];
#pragma unroll
                for (int bj = 0; bj < 2; ++bj)
#pragma unroll
                    for (int n = 0; n < 2; ++n) v[bj][n] = acc[ai][bj][m][n] * rs;
                if (pn < 4) {
                    float ss = 0.f;
#pragma unroll
                    for (int bj = 0; bj < 2; ++bj)
#pragma unroll
                        for (int n = 0; n < 2; ++n) ss += (v[bj][n][0] * v[bj][n][0] + v[bj][n][1] * v[bj][n][1]) + (v[bj][n][2] * v[bj][n][2] + v[bj][n][3] * v[bj][n][3]);
                    ss = sum_xor16_32(ss);
                    const bool isq = pn < 2;
                    const float sc = fast_rsq(ss * (1.f / 64.f) + EPS) * (isq ? 0.125f * LOG2E : 1.f);
                    const float* gn = isq ? qn : kn; bf16_t* O = isq ? qb : kb;
                    const int head = 4 * (pn & 1) + wc;
#pragma unroll
                    for (int bj = 0; bj < 2; ++bj) {
                        const f32x4 g0 = *(const f32x4*)(gn + 32 * bj + 8 * fq), g1 = *(const f32x4*)(gn + 32 * bj + 8 * fq + 4);
                        st16wt(O + (size_t)row * 512 + head * 64 + 32 * bj + 8 * fq, pack8(v[bj][0] * sc * g0, v[bj][1] * sc * g1));
                    }
                } else {
                    const int colw = wc * 32 + 8 * fq;
                    if (pn < 6) {
#pragma unroll
                        for (int bj = 0; bj < 2; ++bj) st16wt(vb + (size_t)row * 512 + (pn - 4) * BM + bj * HALF + colw, pack8(v[bj][0], v[bj][1]));
                    } else if (pn < 10) {
                        float ss = 0.f;
#pragma unroll
                        for (int bj = 0; bj < 2; ++bj)
#pragma unroll
                            for (int n = 0; n < 2; ++n)
#pragma unroll
                                for (int i = 0; i < 4; ++i) { const float gv = gelu_tanh_f(v[bj][n][i]); v[bj][n][i] = gv; ss += gv * gv; }
                        if (pn < 8) {
#pragma unroll
                            for (int bj = 0; bj < 2; ++bj) st16wt(ub + (size_t)row * 512 + (pn - 6) * BM + bj * HALF + colw, pack8(v[bj][0], v[bj][1]));
                        } else {
#pragma unroll
                            for (int bj = 0; bj < 2; ++bj) st16wt(vsb + (size_t)row * 512 + (pn - 8) * BM + bj * HALF + colw, pack8(v[bj][0], v[bj][1]));
                            ss = sum_xor16_32(ss);
                            if (fq == 0) vspart[(size_t)row * 8 + (pn - 8) * 4 + wc] = ss;
                        }
                    } else {
#pragma unroll
                        for (int n = 0; n < 2; ++n)
#pragma unroll
                            for (int i = 0; i < 4; ++i) {
#if !FK_RAWG
                                const float ea = fast_exp2(-LOG2E * v[0][n][i]), d = fminf(1.f + fast_exp2(-LOG2E * v[1][n][i]), 1e13f);
                                v[0][n][i] = d * fast_rcp(1.f + ea); v[1][n][i] = fast_rcp(d);
#endif
                            }
                        st16wt(gab + (size_t)row * 2048 + (pn - 10) * HALF + colw, pack8(v[0][0], v[0][1]));
                        st16wt(gab + (size_t)row * 2048 + 1024 + (pn - 10) * HALF + colw, pack8(v[1][0], v[1][1]));
                    }
                }
            }
    }
};

struct EpiUp {
    static constexpr bool PERM = true, HAS_MID = true; static constexpr int MID_T = 8;
    const bf16_t* gab; bf16_t* mg;
    __device__ __forceinline__ const void* pf_base() const { return nullptr; }
    __device__ __forceinline__ void mid(Acc& acc, const Unit& u, int wr, int wc, int fr, int fq) const {
        int row0 = u.pm * BM + wr * 64 + fr; const int col0 = u.pn * BM + wc * 32 + 8 * fq; asm volatile("" : "+v"(row0));
#pragma unroll
#if FK_RAWG
        for (int am = 0; am < 4; ++am) {
            const int ai = am >> 1, mb = (am & 1) * 2;
            u32x4 ga[2][2], gb[2][2];
#pragma unroll
            for (int mm = 0; mm < 2; ++mm) { const bf16_t* gp = gab + (size_t)(row0 + ai * HALF + (mb + mm) * 16) * 2048 + col0;
#pragma unroll
                for (int bj = 0; bj < 2; ++bj) { ga[mm][bj] = *(const u32x4*)(gp + bj * HALF); gb[mm][bj] = *(const u32x4*)(gp + 1024 + bj * HALF); } }
#pragma unroll
            for (int mm = 0; mm < 2; ++mm)
#pragma unroll
                for (int bj = 0; bj < 2; ++bj)
#pragma unroll
                    for (int j = 0; j < 4; ++j) {
                        const float r0 = fminf(1.f + fast_exp2(-LOG2E * bf_lo(gb[mm][bj][j])), 1e13f) * fast_rcp(1.f + fast_exp2(-LOG2E * bf_lo(ga[mm][bj][j])));
                        const float r1 = fminf(1.f + fast_exp2(-LOG2E * bf_hi(gb[mm][bj][j])), 1e13f) * fast_rcp(1.f + fast_exp2(-LOG2E * bf_hi(ga[mm][bj][j])));
                        acc[ai][bj][mb + mm][j >> 1][(j & 1) * 2] *= r0; acc[ai][bj][mb + mm][j >> 1][(j & 1) * 2 + 1] *= r1; }
            asm volatile("" ::: "memory");
        }
    }
#else
        for (int ai = 0; ai < 2; ++ai) {
            u32x4 ga[4][2];
#pragma unroll
            for (int m = 0; m < 4; ++m) { const bf16_t* gp = gab + (size_t)(row0 + ai * HALF + m * 16) * 2048 + col0;
#pragma unroll
                for (int bj = 0; bj < 2; ++bj) ga[m][bj] = *(const u32x4*)(gp + bj * HALF); }
#pragma unroll
            for (int m = 0; m < 4; ++m)
#pragma unroll
                for (int bj = 0; bj < 2; ++bj)
#pragma unroll
                    for (int j = 0; j < 4; ++j) { acc[ai][bj][m][j >> 1][(j & 1) * 2] *= bf_lo(ga[m][bj][j]); acc[ai][bj][m][j >> 1][(j & 1) * 2 + 1] *= bf_hi(ga[m][bj][j]); }
            asm volatile("" ::: "memory");
        }
    }
#endif
    __device__ __forceinline__ void operator()(const Acc& acc, const Unit& u, int wr, int wc, int fr, int fq) const {
        int row0 = u.pm * BM + wr * 64 + fr; const int col0 = u.pn * BM + wc * 32 + 8 * fq; asm volatile("" : "+v"(row0));
        u32x4 gb[2][4][2];
#pragma unroll
        for (int ai = 0; ai < 2; ++ai)
#pragma unroll
            for (int m = 0; m < 4; ++m)
#pragma unroll
                for (int bj = 0; bj < 2; ++bj) gb[ai][m][bj] = *(const u32x4*)(gab + (size_t)(row0 + ai * HALF + m * 16) * 2048 + 1024 + col0 + bj * HALF);
#pragma unroll
        for (int ai = 0; ai < 2; ++ai)
#pragma unroll
            for (int m = 0; m < 4; ++m) { const size_t ro = (size_t)(row0 + ai * HALF + m * 16);
#pragma unroll
                for (int bj = 0; bj < 2; ++bj) { const u32x4 b = gb[ai][m][bj];
                    f32x4 o0, o1;
#if FK_RAWG
#define FK_SB(x) fast_rcp(fminf(1.f + fast_exp2(-LOG2E * (x)), 1e13f))
#else
#define FK_SB(x) (x)
#endif
                    o0[0] = acc[ai][bj][m][0][0] * FK_SB(bf_lo(b[0])); o0[1] = acc[ai][bj][m][0][1] * FK_SB(bf_hi(b[0])); o0[2] = acc[ai][bj][m][0][2] * FK_SB(bf_lo(b[1])); o0[3] = acc[ai][bj][m][0][3] * FK_SB(bf_hi(b[1]));
                    o1[0] = acc[ai][bj][m][1][0] * FK_SB(bf_lo(b[2])); o1[1] = acc[ai][bj][m][1][1] * FK_SB(bf_hi(b[2])); o1[2] = acc[ai][bj][m][1][2] * FK_SB(bf_lo(b[3])); o1[3] = acc[ai][bj][m][1][3] * FK_SB(bf_hi(b[3]));
#undef FK_SB
                    st16o(mg + ro * 1024 + col0 + bj * HALF, pack8(o0, o1)); } }
    }
};

struct EpiOut {
    static constexpr bool PERM = true, HAS_MID = false; static constexpr int MID_T = 0;
    const bf16_t* xin; bf16_t* xout;
    __device__ __forceinline__ const void* pf_base() const { return xin; }
    __device__ __forceinline__ void mid(Acc&, const Unit&, int, int, int, int) const {}
    __device__ __forceinline__ void operator()(const Acc& acc, const Unit& u, int wr, int wc, int fr, int fq) const {
        int row0 = u.pm * BM + wr * 64 + fr; const int col0 = u.pn * BM + wc * 32 + 8 * fq; asm volatile("" : "+v"(row0));
        u32x4 xv[2][4][2];
#pragma unroll
        for (int ai = 0; ai < 2; ++ai)
#pragma unroll
            for (int m = 0; m < 4; ++m)
#pragma unroll
                for (int bj = 0; bj < 2; ++bj) xv[ai][m][bj] = *(const u32x4*)(xin + (size_t)(row0 + ai * HALF + m * 16) * D + col0 + bj * HALF);
#pragma unroll
        for (int ai = 0; ai < 2; ++ai)
#pragma unroll
            for (int m = 0; m < 4; ++m)
#pragma unroll
                for (int bj = 0; bj < 2; ++bj) { const u32x4 xo = xv[ai][m][bj]; f32x4 o0, o1;
                    o0[0] = bf_lo(xo[0]) + acc[ai][bj][m][0][0]; o0[1] = bf_hi(xo[0]) + acc[ai][bj][m][0][1]; o0[2] = bf_lo(xo[1]) + acc[ai][bj][m][0][2]; o0[3] = bf_hi(xo[1]) + acc[ai][bj][m][0][3];
                    o1[0] = bf_lo(xo[2]) + acc[ai][bj][m][1][0]; o1[1] = bf_hi(xo[2]) + acc[ai][bj][m][1][1]; o1[2] = bf_lo(xo[3]) + acc[ai][bj][m][1][2]; o1[3] = bf_hi(xo[3]) + acc[ai][bj][m][1][3];
                    st16o(xout + (size_t)(row0 + ai * HALF + m * 16) * D + col0 + bj * HALF, pack8(o0, o1)); }
    }
};

struct EpiG1 {
    static constexpr bool PERM = true, HAS_MID = false; static constexpr int MID_T = 0;
    const LAS int* pref; const float* rs2s; bf16_t* Gb;
    __device__ __forceinline__ const void* pf_base() const { return nullptr; }
    __device__ __forceinline__ void mid(Acc&, const Unit&, int, int, int, int) const {}
    __device__ __forceinline__ void operator()(const Acc& acc, const Unit& u, int wr, int wc, int fr, int fq) const {
        const int ce = pref[40 + u.e];
        float rsv[2][4];
#pragma unroll
        for (int ai = 0; ai < 2; ++ai)
#pragma unroll
            for (int m = 0; m < 4; ++m) { const int r = u.pm * BM + ai * HALF + wr * 64 + m * 16 + fr;  const float v_ = rs2s[u.e * ECAP + r]; rsv[ai][m] = (r < ce) ? v_ : 0.f; }
#pragma unroll
        for (int ai = 0; ai < 2; ++ai)
#pragma unroll
            for (int m = 0; m < 4; ++m) {
                const int rl = ai * HALF + wr * 64 + m * 16 + fr;
                const float rs = rsv[ai][m];
                f32x4 o[2];
#pragma unroll
                for (int n = 0; n < 2; ++n)
#pragma unroll
                    for (int i = 0; i < 4; ++i) { const float g = acc[ai][0][m][n][i] * rs, up = acc[ai][1][m][n][i] * rs; o[n][i] = g * sigmoid_f(g) * up; }
                st16(Gb + (size_t)(u.aux + rl) * 512 + u.pn * HALF + wc * 32 + 8 * fq, pack8(o[0], o[1]));
            }
    }
};

struct EpiPle {
    static constexpr bool PERM = true, HAS_MID = false; static constexpr int MID_T = 0;
    const bf16_t* xin; bf16_t* xout; float* fout; const bf16_t* Eb; const float* rs3; float* xpart;
    __device__ __forceinline__ const void* pf_base() const { return xin; }
    __device__ __forceinline__ void mid(Acc&, const Unit&, int, int, int, int) const {}
    struct Bt { u32x4 xv[2][2], ev[2][2]; float rs[2]; };
    __device__ __forceinline__ void ld(Bt& b, int row0, int col0, int k) const {
#pragma unroll
        for (int mm = 0; mm < 2; ++mm) { const int row = row0 + (k >> 1) * HALF + ((k & 1) * 2 + mm) * 16; b.rs[mm] = rs3[row];
#pragma unroll
            for (int bj = 0; bj < 2; ++bj) { b.xv[mm][bj] = *(const u32x4*)(xin + (size_t)row * D + col0 + bj * HALF); b.ev[mm][bj] = *(const u32x4*)(Eb + (size_t)row * D + col0 + bj * HALF); } }
    }
    __device__ __forceinline__ void fin(const Bt& b, const Acc& acc, const Unit& u, int row0, int col0, int k, int wc, int fq) const {
        const int ai = k >> 1, mb = (k & 1) * 2;
#pragma unroll
        for (int mm = 0; mm < 2; ++mm) { const int row = row0 + ai * HALF + (mb + mm) * 16; const float rs = b.rs[mm]; float ss = 0.f;
#pragma unroll
            for (int bj = 0; bj < 2; ++bj) { const u32x4 xo = b.xv[mm][bj], e = b.ev[mm][bj]; f32x4 o[2];
#pragma unroll
                for (int j = 0; j < 4; ++j) { o[j >> 1][(j & 1) * 2] = bf_lo(xo[j]) + sigmoid_f(acc[ai][bj][mb + mm][j >> 1][(j & 1) * 2] * rs) * bf_lo(e[j]);
                                              o[j >> 1][(j & 1) * 2 + 1] = bf_hi(xo[j]) + sigmoid_f(acc[ai][bj][mb + mm][j >> 1][(j & 1) * 2 + 1] * rs) * bf_hi(e[j]); }
                const u32x4 w = pack8(o[0], o[1]);
#pragma unroll
                for (int j = 0; j < 4; ++j) { const float a = bf_lo(w[j]), b_ = bf_hi(w[j]); ss += a * a + b_ * b_; }
                st16o(xout + (size_t)row * D + col0 + bj * HALF, w);
                if (fout) { *(f32x4*)(fout + (size_t)row * D + col0 + bj * HALF) = o[0]; *(f32x4*)(fout + (size_t)row * D + col0 + bj * HALF + 4) = o[1]; } }
            ss = sum_xor16_32(ss);
            if (fq == 0) xpart[(size_t)row * 16 + u.pn * 4 + wc] = ss; }
    }
    __device__ __forceinline__ void operator()(const Acc& acc, const Unit& u, int wr, int wc, int fr, int fq) const {
        int row0 = u.pm * BM + wr * 64 + fr; const int col0 = u.pn * BM + wc * 32 + 8 * fq; asm volatile("" : "+v"(row0));
        Bt b0, b1;
        ld(b0, row0, col0, 0); ld(b1, row0, col0, 1);
        fin(b0, acc, u, row0, col0, 0, wc, fq); asm volatile("" ::: "memory"); ld(b0, row0, col0, 2);
        fin(b1, acc, u, row0, col0, 1, wc, fq); asm volatile("" ::: "memory"); ld(b1, row0, col0, 3);
        fin(b0, acc, u, row0, col0, 2, wc, fq); asm volatile("" ::: "memory");
        fin(b1, acc, u, row0, col0, 3, wc, fq);
    }
};
__device__ __forceinline__ int crow(int r, int hi) { return (r & 3) + 8 * (r >> 2) + 4 * hi; }
__device__ __forceinline__ unsigned cvtpk_s(float lo, float hi) { typedef __bf16 bf16x2_t __attribute__((ext_vector_type(2))); f32x2 v = {lo, hi}; bf16x2_t b = __builtin_convertvector(v, bf16x2_t); return __builtin_bit_cast(unsigned, b); }
#define FK_SBAR() __builtin_amdgcn_sched_barrier(0)
__device__ __forceinline__ void pv(f32x16* o, int vb, bf16x8 pa0, bf16x8 pa1, bf16x8 pa2, bf16x8 pa3) {
    s16x4 lo[2][4], hi[2][4];
#pragma unroll
    for (int d0 = 0; d0 < 2; ++d0)
#pragma unroll
        for (int ks = 0; ks < 4; ++ks) {
            asm volatile("ds_read_b64_tr_b16 %0,%1 offset:%c2" : "=&v"(lo[d0][ks]) : "v"(vb), "i"(d0 * 4096 + ks * 1024) : "memory");
            asm volatile("ds_read_b64_tr_b16 %0,%1 offset:%c2" : "=&v"(hi[d0][ks]) : "v"(vb), "i"(d0 * 4096 + ks * 1024 + 512) : "memory"); }
    asm volatile("s_waitcnt lgkmcnt(0)" ::: "memory"); FK_SBAR();
#define FK_PK(d, k) (bf16x8){lo[d][k][0], lo[d][k][1], lo[d][k][2], lo[d][k][3], hi[d][k][0], hi[d][k][1], hi[d][k][2], hi[d][k][3]}
    o[0] = __builtin_amdgcn_mfma_f32_32x32x16_bf16(pa0, FK_PK(0, 0), o[0], 0, 0, 0); o[1] = __builtin_amdgcn_mfma_f32_32x32x16_bf16(pa0, FK_PK(1, 0), o[1], 0, 0, 0);
    o[0] = __builtin_amdgcn_mfma_f32_32x32x16_bf16(pa1, FK_PK(0, 1), o[0], 0, 0, 0); o[1] = __builtin_amdgcn_mfma_f32_32x32x16_bf16(pa1, FK_PK(1, 1), o[1], 0, 0, 0);
    o[0] = __builtin_amdgcn_mfma_f32_32x32x16_bf16(pa2, FK_PK(0, 2), o[0], 0, 0, 0); o[1] = __builtin_amdgcn_mfma_f32_32x32x16_bf16(pa2, FK_PK(1, 2), o[1], 0, 0, 0);
    o[0] = __builtin_amdgcn_mfma_f32_32x32x16_bf16(pa3, FK_PK(0, 3), o[0], 0, 0, 0); o[1] = __builtin_amdgcn_mfma_f32_32x32x16_bf16(pa3, FK_PK(1, 3), o[1], 0, 0, 0);
#undef FK_PK
}
constexpr int WLDS_BYTES = 16384;

template <bool DIAG, int PROBE = 0>
__device__ __forceinline__ void attn_tile(const bf16x8 (&k0)[4], const bf16x8 (&k1)[4], const bf16x8 (&qr)[4], f32x16 (&o)[2], float& R, int s0, int tq, int hi, int vbase) {
    f32x16 p0 = f32x16{}, p1 = f32x16{};
#pragma unroll
    for (int d0 = 0; d0 < 4; ++d0) { p0 = __builtin_amdgcn_mfma_f32_32x32x16_bf16(k0[d0], qr[d0], p0, 0, 0, 0); p1 = __builtin_amdgcn_mfma_f32_32x32x16_bf16(k1[d0], qr[d0], p1, 0, 0, 0); }
    float kp[32], bt[32];
#pragma unroll
    for (int r = 0; r < 32; ++r) {
        const float z = r < 16 ? p0[r] : p1[r - 16];
        float k_, b_;
        if (PROBE == 3) { k_ = z * 1e-3f; b_ = 1.f - k_; }
        else { const float e = fast_exp2(z);
            k_ = fast_rcp(1.f + e); b_ = 1.f - k_; }
        if (DIAG) { const int kv = s0 + crow(r & 15, hi) + (r >> 4) * 32; if (!(kv < tq)) { k_ = 1.f; b_ = 0.f; } }
        kp[r] = k_; bt[r] = b_;
    }
    float pg[8], T[8], SP[8];
#pragma unroll
    for (int g = 0; g < 8; ++g) { const float gs = (kp[4 * g] * kp[4 * g + 1]) * (kp[4 * g + 2] * kp[4 * g + 3]); float lo_, hi_; halves32(gs, lo_, hi_); pg[g] = hi ? lo_ : hi_; T[g] = lo_ * hi_; }
    SP[7] = 1.f;
#pragma unroll
    for (int g = 6; g >= 0; --g) SP[g] = SP[g + 1] * T[g + 1];
    float a[32];
#pragma unroll
    for (int g = 0; g < 8; ++g) {
        const float base = R * SP[g] * (hi == 0 ? pg[g] : 1.f);
        const float a3 = base, a2 = a3 * kp[4 * g + 3], a1 = a2 * kp[4 * g + 2], a0 = a1 * kp[4 * g + 1];
        a[4 * g + 3] = bt[4 * g + 3] * a3; a[4 * g + 2] = bt[4 * g + 2] * a2; a[4 * g + 1] = bt[4 * g + 1] * a1; a[4 * g] = bt[4 * g] * a0;
    }
    R *= SP[0] * T[0];
    u32x4 pw0, pw1, pw2, pw3;
    pw0 = (u32x4){cvtpk_s(a[0], a[1]), cvtpk_s(a[2], a[3]), cvtpk_s(a[4], a[5]), cvtpk_s(a[6], a[7])};
    pw1 = (u32x4){cvtpk_s(a[8], a[9]), cvtpk_s(a[10], a[11]), cvtpk_s(a[12], a[13]), cvtpk_s(a[14], a[15])};
    pw2 = (u32x4){cvtpk_s(a[16], a[17]), cvtpk_s(a[18], a[19]), cvtpk_s(a[20], a[21]), cvtpk_s(a[22], a[23])};
    pw3 = (u32x4){cvtpk_s(a[24], a[25]), cvtpk_s(a[26], a[27]), cvtpk_s(a[28], a[29]), cvtpk_s(a[30], a[31])};
    if (PROBE == 9) asm volatile("s_waitcnt lgkmcnt(0)" ::: "memory");
    else asm volatile("s_waitcnt vmcnt(0) lgkmcnt(0)" ::: "memory");
    if (PROBE == 4) { o[0][0] += __uint_as_float(pw0[0] ^ pw1[1] ^ pw2[2] ^ pw3[3]); return; }
    pv(o, vbase, __builtin_bit_cast(bf16x8, pw0), __builtin_bit_cast(bf16x8, pw1), __builtin_bit_cast(bf16x8, pw2), __builtin_bit_cast(bf16x8, pw3));
}
__device__ __forceinline__ void attn_dma_v(const bf16_t* __restrict__ vb, long rowbase, int s0, int h, int lane, LAS unsigned char* wl) {
#pragma unroll
    for (int w8 = 0; w8 < 8; ++w8)
        __builtin_amdgcn_global_load_lds((const unsigned*)(vb + (size_t)(rowbase + s0 + 16 * (w8 & 3) + (lane >> 2)) * 512 + h * 64 + 32 * (w8 >> 2) + 8 * (lane & 3)), (LAS unsigned*)(wl + w8 * 1024), 16, 0, 0);
}
__device__ __forceinline__ void attn_dma_k(const bf16_t* __restrict__ kb, long rowbase, int s0, int h, int lane, LAS unsigned char* wl) {
#pragma unroll
    for (int c = 0; c < 8; ++c)
        __builtin_amdgcn_global_load_lds((const unsigned*)(kb + (size_t)(rowbase + s0 + lane) * 512 + h * 64 + 8 * c), (LAS unsigned*)(wl + 8192 + c * 1024), 16, 0, 0);
}
__device__ __forceinline__ void attn_read_k(bf16x8 (&k0)[4], bf16x8 (&k1)[4], LAS unsigned char* wl, int r32, int hi) {
    const LAS unsigned char* kp = wl + 8192 + hi * 1024 + r32 * 16;
#pragma unroll
    for (int d0 = 0; d0 < 4; ++d0) { k0[d0] = *(const LAS bf16x8*)(kp + d0 * 2048); k1[d0] = *(const LAS bf16x8*)(kp + d0 * 2048 + 512); }
}
template <int PROBE = 0>
__device__ __forceinline__ void attn_wave_unit(int b, int h, int qblk, const bf16_t* __restrict__ qb, const bf16_t* __restrict__ kb, const bf16_t* __restrict__ vb, bf16_t* __restrict__ oc, LAS unsigned char* wl, int lane) {
    const int r32 = lane & 31, hi = lane >> 5;
    const long rowbase = (long)b * SEQ; const int q0 = qblk * 32, tq = q0 + r32;
    bf16x8 qr[4];
    { const bf16_t* qp = qb + (size_t)(rowbase + q0 + r32) * 512 + h * 64 + hi * 8;
#pragma unroll
      for (int d0 = 0; d0 < 4; ++d0) qr[d0] = *(const bf16x8*)(qp + d0 * 16); }
    f32x16 o[2]; o[0] = f32x16{}; o[1] = f32x16{};
    float R = 1.f;
    const int vbase = (int)(unsigned)(uintptr_t)wl + ((lane >> 4) & 1) * 32 + (lane & 3) * 8 + (4 * hi + ((lane & 15) >> 2)) * 64;
    const int jd = q0 >> 6;
    bf16x8 k0[4], k1[4];
    attn_dma_k(kb, rowbase, jd * 64, h, lane, wl);
    attn_dma_v(vb, rowbase, jd * 64, h, lane, wl);
    asm volatile("s_waitcnt vmcnt(8)" ::: "memory");
    attn_read_k(k0, k1, wl, r32, hi);
    asm volatile("s_waitcnt lgkmcnt(0)" ::: "memory");
    attn_dma_k(kb, rowbase, (jd > 0 ? jd - 1 : 0) * 64, h, lane, wl);
    attn_tile<true, PROBE>(k0, k1, qr, o, R, jd * 64, tq, hi, vbase);
    for (int jt = jd - 1; jt >= 0; --jt) {
        if (PROBE ? (jt < jd - 2) : __all(R < 7.5e-37f)) break;
        attn_read_k(k0, k1, wl, r32, hi);
        if (PROBE != 2) attn_dma_v(vb, rowbase, jt * 64, h, lane, wl);
        asm volatile("s_waitcnt lgkmcnt(0)" ::: "memory");
        if (PROBE != 2) attn_dma_k(kb, rowbase, (jt > 0 ? jt - 1 : 0) * 64, h, lane, wl);
        attn_tile<false, PROBE>(k0, k1, qr, o, R, jt * 64, tq, hi, vbase);
    }
    if (PROBE) { asm volatile("s_waitcnt vmcnt(0) lgkmcnt(0)" ::: "memory"); if (o[0][0] == 1.2345e-30f && o[1][3] == 5.4321e-30f) oc[0] = 0; return; }
    asm volatile("s_waitcnt vmcnt(0)" ::: "memory");
    LAS bf16_t* stg = (LAS bf16_t*)(wl + 8192);
#pragma unroll
    for (int r = 0; r < 16; ++r) { const int orow = crow(r, hi);
#pragma unroll
        for (int d0 = 0; d0 < 2; ++d0) stg[orow * 64 + d0 * 32 + r32] = (bf16_t)(cvtpk_s(o[d0][r], 0.f) & 0xffffu); }
    asm volatile("s_waitcnt lgkmcnt(0)" ::: "memory");
    bf16_t* Ow = oc + (size_t)(rowbase + q0) * 1024 + h * 64;
#pragma unroll
    for (int i = 0; i < 4; ++i) { const int row = i * 8 + (lane >> 3), ch = lane & 7; const u32x4 v = *(const LAS u32x4*)(stg + row * 64 + ch * 8); *(u32x4*)(Ow + (size_t)row * 1024 + ch * 8) = v; }
    asm volatile("s_waitcnt lgkmcnt(0)" ::: "memory");
}

__device__ __forceinline__ void attn_block_dma(const bf16_t* __restrict__ kb, const bf16_t* __restrict__ vb, long rowbase, int T, int h, int wave, int lane, LAS unsigned char* buf) {
    __builtin_amdgcn_global_load_lds((const unsigned*)(kb + (size_t)(rowbase + T * 64 + lane) * 512 + h * 64 + 8 * wave), (LAS unsigned*)(buf + 8192 + wave * 1024), 16, 0, 0);
    __builtin_amdgcn_global_load_lds((const unsigned*)(vb + (size_t)(rowbase + T * 64 + 16 * (wave & 3) + (lane >> 2)) * 512 + h * 64 + 32 * (wave >> 2) + 8 * (lane & 3)), (LAS unsigned*)(buf + wave * 1024), 16, 0, 0);
}
struct AttnBU { int b, h, c; };
__device__ __forceinline__ void attn_block_begin(const AttnBU& u, bf16x8 (&qr)[4], const bf16_t* __restrict__ qb, const bf16_t* __restrict__ kb, const bf16_t* __restrict__ vb, LAS unsigned char* lds, int wave, int lane) {
    const int r32 = lane & 31, hi = lane >> 5; const long rowbase = (long)u.b * SEQ; const int q0 = u.c * 256 + wave * 32;
    const bf16_t* qp = qb + (size_t)(rowbase + q0 + r32) * 512 + u.h * 64 + hi * 8;
#pragma unroll
    for (int d0 = 0; d0 < 4; ++d0) qr[d0] = *(const bf16x8*)(qp + d0 * 16);
    attn_block_dma(kb, vb, rowbase, 4 * u.c + 3, u.h, wave, lane, lds);
}
template <int BP = 0>
__device__ __forceinline__ void attn_block_body(const AttnBU& u, const bf16x8 (&qr)[4], f32x16 (&o)[2], const bf16_t* __restrict__ kb, const bf16_t* __restrict__ vb, LAS unsigned char* lds, int wave, int lane) {
    const int r32 = lane & 31, hi = lane >> 5;
    const long rowbase = (long)u.b * SEQ; const int q0 = u.c * 256 + wave * 32, tq = q0 + r32, h = u.h;
    const int jd = q0 >> 6, Tmax = 4 * u.c + 3;
    LAS int* flg = (LAS int*)(lds + 65536);
    o[0] = f32x16{}; o[1] = f32x16{};
    float R = 1.f; bool done = false;
    const int vb0 = (int)(unsigned)(uintptr_t)lds + ((lane >> 4) & 1) * 32 + (lane & 3) * 8 + (4 * hi + ((lane & 15) >> 2)) * 64;
    asm volatile("s_waitcnt vmcnt(0)" ::: "memory");
    __builtin_amdgcn_s_barrier();
    int s = 0, it = 0;
    for (int T = Tmax; ; --T, s ^= 1, ++it) {
        LAS unsigned char* buf = lds + s * 16384;
        if (T > 0 && BP != 3) attn_block_dma(kb, vb, rowbase, T - 1, h, wave, lane, lds + (s ^ 1) * 16384);
        if (T <= jd && !done && BP != 2) {
            bf16x8 k0[4], k1[4];
            attn_read_k(k0, k1, buf, r32, hi);
            asm volatile("s_waitcnt lgkmcnt(0)" ::: "memory");
            if (T == jd) attn_tile<true, 9>(k0, k1, qr, o, R, T * 64, tq, hi, vb0 + s * 16384);
            else attn_tile<false, 9>(k0, k1, qr, o, R, T * 64, tq, hi, vb0 + s * 16384);
            done = __all(R < 7.5e-37f);
        }
        if (BP) done = (T <= jd - 2);
        asm volatile("s_waitcnt vmcnt(0)" ::: "memory");
        if (T > 4 * u.c) { __builtin_amdgcn_s_barrier(); continue; }
        const int want = (T > 0) && (T - 1 > jd || !done);
        if (lane == 0) flg[(it & 1) * 8 + wave] = want;
        asm volatile("s_waitcnt lgkmcnt(0)" ::: "memory");
        __builtin_amdgcn_s_barrier();
        const int f = flg[(it & 1) * 8 + (lane & 7)];
        if (!__any(f != 0)) break;
    }
}
__device__ __forceinline__ void attn_block_end(const AttnBU& u, const f32x16 (&o)[2], bf16_t* __restrict__ oc, LAS unsigned char* lds, int wave, int lane) {
    const int r32 = lane & 31, hi = lane >> 5; const long rowbase = (long)u.b * SEQ; const int q0 = u.c * 256 + wave * 32;
    LAS bf16_t* stg = (LAS bf16_t*)(lds + 32768 + wave * 4096);
#pragma unroll
    for (int r = 0; r < 16; ++r) { const int orow = crow(r, hi);
#pragma unroll
        for (int d0 = 0; d0 < 2; ++d0) stg[orow * 64 + d0 * 32 + r32] = (bf16_t)(cvtpk_s(o[d0][r], 0.f) & 0xffffu); }
    asm volatile("s_waitcnt lgkmcnt(0)" ::: "memory");
    bf16_t* Ow = oc + (size_t)(rowbase + q0) * 1024 + u.h * 64;
#pragma unroll
    for (int i = 0; i < 4; ++i) { const int row = i * 8 + (lane >> 3), ch = lane & 7; const u32x4 v = *(const LAS u32x4*)(stg + row * 64 + ch * 8); *(u32x4*)(Ow + (size_t)row * 1024 + ch * 8) = v; }
    asm volatile("s_waitcnt lgkmcnt(0)" ::: "memory");
}

#ifndef FK_WTEST
#define FK_WTEST 0
#endif
__device__ __forceinline__ void attn_win_begin(const AttnBU& u, bf16x8 (&qr)[4], const bf16_t* __restrict__ qb, const bf16_t* __restrict__ kb, const bf16_t* __restrict__ vb, LAS unsigned char* lds, int wave, int lane) {
    const int r32 = lane & 31, hi = lane >> 5; const long rowbase = (long)u.b * SEQ; const int q0 = u.c * 256 + wave * 32;
    const bf16_t* qp = qb + (size_t)(rowbase + q0 + r32) * 512 + u.h * 64 + hi * 8;
#pragma unroll
    for (int d0 = 0; d0 < 4; ++d0) qr[d0] = *(const bf16x8*)(qp + d0 * 16);
#pragma unroll
    for (int t = 0; t < 6; ++t) { const int T = 4 * u.c + 3 - t; if (T >= 0) attn_block_dma(kb, vb, rowbase, T, u.h, wave, lane, lds + t * 16384); }
}
__device__ __forceinline__ void attn_win_body(const AttnBU& u, const bf16x8 (&qr)[4], f32x16 (&o)[2], const bf16_t* __restrict__ kb, const bf16_t* __restrict__ vb, LAS unsigned char* lds, int wave, int lane) {
    const int r32 = lane & 31, hi = lane >> 5;
    const long rowbase = (long)u.b * SEQ; const int q0 = u.c * 256 + wave * 32, tq = q0 + r32, h = u.h;
    const int jd = q0 >> 6, Tmax = 4 * u.c + 3, Tlow = u.c > 0 ? 4 * u.c - 2 + FK_WTEST : 0;
    LAS int* flg = (LAS int*)(lds + 131072);
    o[0] = f32x16{}; o[1] = f32x16{};
    float R = 1.f; bool done = false;
    const int vb0 = (int)(unsigned)(uintptr_t)lds + ((lane >> 4) & 1) * 32 + (lane & 3) * 8 + (4 * hi + ((lane & 15) >> 2)) * 64;
    if (u.c > 0) asm volatile("s_waitcnt vmcnt(4)" ::: "memory"); else asm volatile("s_waitcnt vmcnt(0)" ::: "memory");
    __builtin_amdgcn_s_barrier();
    { bf16x8 k0[4], k1[4]; const int sl = Tmax - jd;
      attn_read_k(k0, k1, lds + sl * 16384, r32, hi);
      asm volatile("s_waitcnt lgkmcnt(0)" ::: "memory");
      attn_tile<true, 9>(k0, k1, qr, o, R, jd * 64, tq, hi, vb0 + sl * 16384);
      done = __all(R < 7.5e-37f); }
    asm volatile("s_waitcnt vmcnt(0)" ::: "memory");
    __builtin_amdgcn_s_barrier();
    for (int T = jd - 1; T >= Tlow && !done; --T) { bf16x8 k0[4], k1[4]; const int sl = Tmax - T;
        attn_read_k(k0, k1, lds + sl * 16384, r32, hi);
        asm volatile("s_waitcnt lgkmcnt(0)" ::: "memory");
        attn_tile<false, 9>(k0, k1, qr, o, R, T * 64, tq, hi, vb0 + sl * 16384);
        done = __all(R < 7.5e-37f); }
    int s = 0, it = 0;
    for (int T = Tlow - 1; ; --T, s ^= 1, ++it) {
        const int want = (T >= 0) && !done;
        if (lane == 0) flg[(it & 1) * 8 + wave] = want;
        asm volatile("s_waitcnt lgkmcnt(0)" ::: "memory");
        __builtin_amdgcn_s_barrier();
        const int f = flg[(it & 1) * 8 + (lane & 7)];
        if (!__any(f != 0)) break;
        attn_block_dma(kb, vb, rowbase, T, h, wave, lane, lds + s * 16384);
        asm volatile("s_waitcnt vmcnt(0)" ::: "memory");
        __builtin_amdgcn_s_barrier();
        if (!done) { bf16x8 k0[4], k1[4];
            attn_read_k(k0, k1, lds + s * 16384, r32, hi);
            asm volatile("s_waitcnt lgkmcnt(0)" ::: "memory");
            attn_tile<false, 9>(k0, k1, qr, o, R, T * 64, tq, hi, vb0 + s * 16384);
            done = __all(R < 7.5e-37f); }
    }
}
__device__ __forceinline__ void attn_win_end(const AttnBU& u, const f32x16 (&o)[2], bf16_t* __restrict__ oc, LAS unsigned char* lds, int wave, int lane) {
    const int r32 = lane & 31, hi = lane >> 5; const long rowbase = (long)u.b * SEQ; const int q0 = u.c * 256 + wave * 32;
    LAS bf16_t* stg = (LAS bf16_t*)(lds + 98304 + wave * 4096);
#pragma unroll
    for (int r = 0; r < 16; ++r) { const int orow = crow(r, hi);
#pragma unroll
        for (int d0 = 0; d0 < 2; ++d0) stg[orow * 64 + d0 * 32 + r32] = (bf16_t)(cvtpk_s(o[d0][r], 0.f) & 0xffffu); }
    asm volatile("s_waitcnt lgkmcnt(0)" ::: "memory");
    bf16_t* Ow = oc + (size_t)(rowbase + q0) * 1024 + u.h * 64;
#pragma unroll
    for (int i = 0; i < 4; ++i) { const int row = i * 8 + (lane >> 3), ch = lane & 7; const u32x4 v = *(const LAS u32x4*)(stg + row * 64 + ch * 8); *(u32x4*)(Ow + (size_t)row * 1024 + ch * 8) = v; }
    asm volatile("s_waitcnt lgkmcnt(0)" ::: "memory");
}

struct SguStage { u32x4 vv[8]; f32x2 sp[4]; };
__device__ __forceinline__ void sgu_load_v(SguStage& S, int kt, size_t row0, int g, const bf16_t* __restrict__ vsb, const float* __restrict__ vspart, int lane_) {
    int lane = lane_; asm volatile("" : "+v"(lane));
#pragma unroll
    for (int q = 0; q < 4; ++q) { const size_t row = row0 + 64 * kt + 16 * q + (lane >> 2); S.sp[q] = *(const f32x2*)(vspart + row * 8 + 2 * (lane & 3)); }
#pragma unroll
    for (int w8 = 0; w8 < 8; ++w8) S.vv[w8] = *(const u32x4*)(vsb + (row0 + 64 * kt + 16 * (w8 & 3) + (lane >> 2)) * 512 + g * 64 + 32 * (w8 >> 2) + 8 * (lane & 3));
}
template <int HF>
__device__ __forceinline__ void sgu_load_w(u32x4 (&pw)[2][4], int kt, int g, const bf16_t* __restrict__ wsp, int r32_, int hi) {
    int r32 = r32_; asm volatile("" : "+v"(r32));
#pragma unroll
    for (int rl = 0; rl < 2; ++rl) { const int rb = 2 * HF + rl; const bf16_t* wp = wsp + ((size_t)g * 128 + 32 * rb + r32) * 128 + 64 * kt + 4 * hi;
#pragma unroll
        for (int ks = 0; ks < 4; ++ks) { const u32x2 lo = *(const u32x2*)(wp + 16 * ks), h8 = *(const u32x2*)(wp + 16 * ks + 8); pw[rl][ks] = (u32x4){lo.x, lo.y, h8.x, h8.y}; } }
}
__device__ __forceinline__ void sgu_put_stage(const SguStage& S, LAS unsigned char* wl, int lane) {
    float rvq[4];
#pragma unroll
    for (int q = 0; q < 4; ++q) { float t = S.sp[q][0] + S.sp[q][1]; t += xor_lt32<1>(t); t += xor_lt32<2>(t); rvq[q] = fast_rsq(t * (1.f / 512.f) + EPS); }
#pragma unroll
    for (int w8 = 0; w8 < 8; ++w8) { const float rv = rvq[w8 & 3]; u32x4 w;
#pragma unroll
        for (int j = 0; j < 4; ++j) w[j] = cvtpk_s(bf_lo(S.vv[w8][j]) * rv, bf_hi(S.vv[w8][j]) * rv);
        *(LAS u32x4*)(wl + w8 * 1024 + lane * 16) = w; }
    asm volatile("s_waitcnt lgkmcnt(0)" ::: "memory");
}
template <int HF>
__device__ __forceinline__ void sgu_wave_unit(int chunk, int g, const bf16_t* __restrict__ ub, const bf16_t* __restrict__ vsb, const float* __restrict__ vspart, const bf16_t* __restrict__ wsp  ,
                                              const float* __restrict__ bsp  , const float* __restrict__ sgn  , bf16_t* __restrict__ oc, LAS unsigned char* wl, int lane) {
    const int r32 = lane & 31, hi = lane >> 5;
    const size_t row0 = (size_t)chunk * 128;
    const int vbase = (int)(unsigned)(uintptr_t)wl + ((lane >> 4) & 1) * 32 + (lane & 3) * 8 + (4 * hi + ((lane & 15) >> 2)) * 64;
    f32x16 o[2][2];
#pragma unroll
    for (int rl = 0; rl < 2; ++rl) { o[rl][0] = f32x16{}; o[rl][1] = f32x16{}; }
    SguStage A; u32x4 pw[2][4];
    sgu_load_v(A, 0, row0, g, vsb, vspart, lane);
    sgu_load_w<HF>(pw, 0, g, wsp, r32, hi);
    sgu_put_stage(A, wl, lane);
    if (HF) {
        sgu_load_v(A, 1, row0, g, vsb, vspart, lane);
#pragma unroll
        for (int rl = 0; rl < 2; ++rl) pv(o[rl], vbase, __builtin_bit_cast(bf16x8, pw[rl][0]), __builtin_bit_cast(bf16x8, pw[rl][1]), __builtin_bit_cast(bf16x8, pw[rl][2]), __builtin_bit_cast(bf16x8, pw[rl][3]));
        asm volatile("s_waitcnt lgkmcnt(0)" ::: "memory");
        sgu_load_w<HF>(pw, 1, g, wsp, r32, hi);
        sgu_put_stage(A, wl, lane);
    }
    u32x4 uv[2][4]; f32x4 bb4[2][4];
    int lane_e = lane; asm volatile("" : "+v"(lane_e));
#pragma unroll
    for (int rl = 0; rl < 2; ++rl) { const int rb = 2 * HF + rl;
#pragma unroll
        for (int i = 0; i < 4; ++i) { const int row = i * 8 + (lane_e >> 3), ch = lane_e & 7; uv[rl][i] = *(const u32x4*)(ub + (row0 + 32 * rb + row) * 512 + g * 64 + ch * 8); bb4[rl][i] = *(const f32x4*)(bsp + g * 128 + 32 * rb + 8 * i + 4 * (lane_e >> 5)); } }
    const float gn0 = sgn[g * 64 + r32], gn1 = sgn[g * 64 + 32 + r32];
#pragma unroll
    for (int rl = 0; rl < 2; ++rl) pv(o[rl], vbase, __builtin_bit_cast(bf16x8, pw[rl][0]), __builtin_bit_cast(bf16x8, pw[rl][1]), __builtin_bit_cast(bf16x8, pw[rl][2]), __builtin_bit_cast(bf16x8, pw[rl][3]));
    asm volatile("s_waitcnt lgkmcnt(0)" ::: "memory");
    LAS bf16_t* stg = (LAS bf16_t*)(wl + 8192);
#pragma unroll
    for (int rl = 0; rl < 2; ++rl) {
        const int rb = 2 * HF + rl;
#pragma unroll
        for (int r = 0; r < 16; ++r) { const int orow = crow(r, hi); const float bb = bb4[rl][r >> 2][r & 3];
            stg[orow * 64 + r32] = (bf16_t)(cvtpk_s(gn0 * o[rl][0][r] + bb, 0.f) & 0xffffu); stg[orow * 64 + 32 + r32] = (bf16_t)(cvtpk_s(gn1 * o[rl][1][r] + bb, 0.f) & 0xffffu); }
        asm volatile("s_waitcnt lgkmcnt(0)" ::: "memory");
#pragma unroll
        for (int i = 0; i < 4; ++i) { const int row = i * 8 + (lane >> 3), ch = lane & 7; const size_t grow = row0 + 32 * rb + row;
            const u32x4 mv = *(const LAS u32x4*)(stg + row * 64 + ch * 8); u32x4 w;
#pragma unroll
            for (int j = 0; j < 4; ++j) w[j] = cvtpk_s(bf_lo(mv[j]) * bf_lo(uv[rl][i][j]), bf_hi(mv[j]) * bf_hi(uv[rl][i][j]));
            *(u32x4*)(oc + grow * 1024 + 512 + g * 64 + ch * 8) = w; }
        asm volatile("s_waitcnt lgkmcnt(0)" ::: "memory");
    }
}
constexpr size_t MiB = 1u << 20;
constexpr size_t WS_CTL = 0, CTL_ZERO_BYTES = 1 * MiB;
constexpr size_t WS_W = 16 * MiB, WL_STRIDE = 112 * MiB;
constexpr size_t WO_IN = 0, WO_UP = 9 * MiB, WO_OUT = 11 * MiB, WO_PG = 13 * MiB, WO_PP = 15 * MiB, WO_SP = 15 * MiB + 512 * 1024, WO_R = 15 * MiB + 768 * 1024, WO_EI = 16 * MiB, WO_EO = 80 * MiB;
constexpr size_t WS_PB = 464 * MiB, WS_E = 496 * MiB, WS_XB = 624 * MiB, WS_Q = 656 * MiB, WS_K = 672 * MiB, WS_V = 688 * MiB, WS_U = 704 * MiB, WS_VS = 720 * MiB, WS_GAB = 736 * MiB,
                 WS_OC = 800 * MiB, WS_MG = 832 * MiB, WS_G = 864 * MiB, WS_YS = 904 * MiB, WS_XPART = 984 * MiB, WS_VSPART = 985 * MiB, WS_RS2 = 985 * MiB + 512 * 1024, WS_RS3 = 985 * MiB + 640 * 1024,
                 WS_TOKL = 986 * MiB, WS_RS2S = 989 * MiB  , WS_TKE = 988 * MiB, WS_TKP = 988 * MiB + 256 * 1024, WS_TKW = 988 * MiB + 512 * 1024, WS_XB1 = 992 * MiB, WS_FAST_END = 1024 * MiB;
constexpr int GSLOTS = 2 * M + NE * 256;
constexpr int CW_XID = 64  , CW_MIS = 128, CW_LOC = 2048  , CW_TMO = 0, CW_CODE = 1, CW_BAR = 4096, CW_CNT = 8192  ;

constexpr int RING_OFF = 0, RING_BYTES = 131072, LDSCTL_OFF = 139264  , MISC_OFF = LDSCTL_OFF + 320, PREF_OFF = MISC_OFF + 128  , LDS_BYTES = 147456;

#define RLX_AGENT __ATOMIC_RELAXED, __HIP_MEMORY_SCOPE_AGENT
#define XB_TMO      128
#define XB_XCNT(j)  (256  + 64 * (j))
#define XB_XSUB(j)  (1280 + 64 * (j))
#define XB_XGEN(j)  (2304 + 64 * (j))
#define XB_TOP      3328
#define XB_TOPGEN   3392
#define XCD_BAR_WORDS 3456
#define XB_SPIN_CAP (1u << 18)
__device__ __forceinline__ unsigned xb_ld(unsigned* p)              { return __hip_atomic_load(p, __ATOMIC_RELAXED, __HIP_MEMORY_SCOPE_AGENT); }
__device__ __forceinline__ unsigned xb_add(unsigned* p, unsigned v) { return __hip_atomic_fetch_add(p, v, __ATOMIC_RELAXED, __HIP_MEMORY_SCOPE_AGENT); }
__device__ __forceinline__ unsigned xb_xcc_id() { return (unsigned)__builtin_amdgcn_s_getreg((3 << 11) | 20) & 0xFu; }
#define XB_SPIN(cond, bar) do { unsigned _sp = 0; while (cond) { __builtin_amdgcn_s_sleep(1); \
    if ((++_sp & 255u) == 0u) { if (xb_ld(&(bar)[XB_TMO])) break; if (_sp > XB_SPIN_CAP) { atomicAdd(&(bar)[XB_TMO], 1u); break; } } } } while (0)
struct XcdBarrier { unsigned* bar; unsigned x; volatile LAS unsigned* st; };
__device__ __forceinline__ XcdBarrier xcd_barrier_post(unsigned* bar, volatile LAS unsigned* st, const bool leader  ) {
    XcdBarrier b; b.bar = bar; b.x = xb_xcc_id(); b.st = st;
    if (leader) (void)xb_add(&bar[XB_XCNT(b.x)], 1u);
    return b;
}
__device__ __forceinline__ void xcd_barrier_complete(unsigned* bar, unsigned x, unsigned& nloc, unsigned& nx) {
    const unsigned G = gridDim.x * gridDim.y * gridDim.z;
    unsigned sum, cnt, mine, sp = 0u;
    for (;;) {
        sum = 0u; cnt = 0u; mine = 0u;
#pragma unroll
        for (unsigned j = 0; j < 16; ++j) { const unsigned c = xb_ld(&bar[XB_XCNT(j)]); sum += c; cnt += (c > 0u) ? 1u : 0u; mine = (j == x) ? c : mine; }
        if (sum == G) break;
        __builtin_amdgcn_s_sleep(1);
        if ((++sp & 255u) == 0u) { if (xb_ld(&bar[XB_TMO])) break; if (sp > XB_SPIN_CAP) { atomicAdd(&bar[XB_TMO], 1u); break; } }
    }
    nloc = mine > 0u ? mine : 1u; nx = cnt > 0u ? cnt : 1u;
}
__device__ __forceinline__ void xcd_barrier_t0(const XcdBarrier& b, const bool local = false) {
        unsigned* bar = b.bar;
        __builtin_amdgcn_s_waitcnt(0);
        unsigned nloc = b.st[0], nx = b.st[1];
        if (nloc == 0u) { xcd_barrier_complete(bar, b.x, nloc, nx); b.st[0] = nloc; b.st[1] = nx; }
#if FK_LOCAL_L2
        if (local) {
            unsigned* lb = bar - CW_BAR + CW_LOC;
            const unsigned lo_ = __hip_atomic_fetch_add(&lb[64 * b.x], 1u, __ATOMIC_RELAXED, __HIP_MEMORY_SCOPE_WORKGROUP);
            const unsigned lg_ = lo_ / nloc;
            if (lo_ + 1u == (lg_ + 1u) * nloc) (void)__hip_atomic_fetch_add(&lb[1024 + 64 * b.x], 1u, __ATOMIC_RELAXED, __HIP_MEMORY_SCOPE_WORKGROUP);
            else XB_SPIN(xb_ld(&lb[1024 + 64 * b.x]) == lg_, bar);
            __builtin_amdgcn_fence(__ATOMIC_ACQUIRE, "agent");
            asm volatile("s_waitcnt vmcnt(0)" ::: "memory");
            return;
        }
#endif
        const unsigned old = xb_add(&bar[XB_XSUB(b.x)], 1u);
        const unsigned gen = old / nloc;
#if FK_EARLY_INV
        const bool einv = (FK_EARLY_INV == 1) || local;
        if (einv) asm volatile("buffer_inv sc1" ::: "memory");
#define FK_ACQ() do { if (!einv) __builtin_amdgcn_fence(__ATOMIC_ACQUIRE, "agent"); } while (0)
#else
#define FK_ACQ() __builtin_amdgcn_fence(__ATOMIC_ACQUIRE, "agent")
#endif
        if (old + 1u == (gen + 1u) * nloc) {
            if (!local) {
            __builtin_amdgcn_fence(__ATOMIC_RELEASE, "agent");
            asm volatile("s_waitcnt vmcnt(0)" ::: "memory");
            const unsigned og = xb_add(&bar[XB_TOP], 1u);
            const unsigned tg = og / nx;
            if (og + 1u == (tg + 1u) * nx) xb_add(&bar[XB_TOPGEN], 1u);
            else XB_SPIN(xb_ld(&bar[XB_TOPGEN]) == tg, bar);
            }
            FK_ACQ();
            xb_add(&bar[XB_XGEN(b.x)], 1u);
            asm volatile("s_waitcnt vmcnt(0)" ::: "memory");
        } else {
            XB_SPIN(xb_ld(&bar[XB_XGEN(b.x)]) == gen, bar);
            FK_ACQ();
            asm volatile("s_waitcnt vmcnt(0)" ::: "memory");
        }
#undef FK_ACQ
}

struct Args {
    const float* in[22]; float* out; unsigned char* ws;
    int ph_lo, ph_hi, nlayers, pad;
};
__device__ __forceinline__ int xcd_rank(int bx, int lo, int hi) {
    const int x = bx & 7; int r = 0;
#pragma unroll
    for (int xx = 0; xx < 8; ++xx) { const int first = lo + ((xx - lo) & 7); const int cnt = first < hi ? ((hi - 1 - first) >> 3) + 1 : 0; if (xx < x) r += cnt; else if (xx == x) r += (bx - first) >> 3; }
    return r;
}
__device__ __forceinline__ float wave_sum(float v) { v += xor_lt32<1>(v); v += xor_lt32<2>(v); v += xor_lt32<4>(v); v += xor_lt32<8>(v); return sum_xor16_32(v); }
__device__ __forceinline__ unsigned f2bf(float f) { unsigned u = __builtin_bit_cast(unsigned, f); return (u + 0x7fffu + ((u >> 16) & 1u)) >> 16; }
__device__ __forceinline__ unsigned pk2(float lo, float hi) { return f2bf(lo) | (f2bf(hi) << 16); }

__device__ __forceinline__ int rowmap(int kind, int n) {
    if (kind == 1) { if (n >= 2560) { const int j = n - 2560, jj = j & 1023; return 2560 + 256 * (jj >> 7) + 128 * (j >> 10) + (jj & 127); }
        if (n >= 1024) return n; const int nl = n & 255; return (n - nl) + 128 * ((nl & 63) >> 5) + 32 * (nl >> 6) + (nl & 31); }
    if (kind == 2) { return n < 512 ? 256 * (n >> 7) + (n & 127) : 256 * ((n - 512) >> 7) + 128 + ((n - 512) & 127); }
    return n;
}
__device__ __forceinline__ void transpose_item(const float* __restrict__ W, int N, const float* __restrict__ gain, bf16_t* __restrict__ WT, int ldt, int koff, int kind, LAS float* scr, int item, int lane) {
    const int nblk = N / 64, kb = item / nblk, nb = item % nblk, k0 = 64 * kb, n0 = 64 * nb;
    const int kr = lane >> 4, nc = 4 * (lane & 15);
    f32x4 v[16];
#pragma unroll
    for (int i = 0; i < 16; ++i) v[i] = __builtin_nontemporal_load((const f32x4*)(W + (size_t)(k0 + 4 * i + kr) * N + n0 + nc));
#pragma unroll
    for (int i = 0; i < 16; ++i) { const int kk = 4 * i + kr; const float gv = gain ? gain[k0 + kk] : 1.f; LAS float* d = scr + kk * 65 + nc; d[0] = v[i][0] * gv; d[1] = v[i][1] * gv; d[2] = v[i][2] * gv; d[3] = v[i][3] * gv; }
    asm volatile("s_waitcnt lgkmcnt(0)" ::: "memory");
    const int c = lane & 7;
#pragma unroll
    for (int j = 0; j < 8; ++j) { const int n = 8 * j + (lane >> 3); const LAS float* s = scr + (8 * c) * 65 + n;
        u32x4 o; o.x = pk2(s[0 * 65], s[1 * 65]); o.y = pk2(s[2 * 65], s[3 * 65]); o.z = pk2(s[4 * 65], s[5 * 65]); o.w = pk2(s[6 * 65], s[7 * 65]);
        __builtin_nontemporal_store(o, (u32x4*)(WT + (size_t)rowmap(kind, n0 + n) * ldt + koff + k0 + 8 * c)); }
    asm volatile("s_waitcnt lgkmcnt(0)" ::: "memory");
}

typedef const __attribute__((address_space(4))) Args* KArgs;
__device__ __forceinline__ KArgs fresh(KArgs k) { asm volatile("" : "+s"(k)); return k; }
constexpr int NWAVES = 8;
#ifndef FK_FILLW
#define FK_FILLW 7
#endif
#ifndef FK_FILL_MASK
#define FK_FILL_MASK 0xFF
#endif
#ifndef FK_FILL_T
#define FK_FILL_T 1
#endif
constexpr int fk_popc(unsigned v) { int c = 0; for (; v; v &= v - 1) ++c; return c; }
constexpr int FILLW = FK_FILLW, FILL_T = FK_FILL_T, FILL_SLABS = fk_popc(FK_FILL_MASK & 0x1FF);
constexpr int CVT_IN = 16 * 72, CVT_UP = 8 * 16, CVT_OUT = 16 * 16, CVT_PG = 16 * 16, CVT_PP = 4 * 16, CVT_EI = 16 * 16, CVT_EO = 8 * 16;
constexpr int CVT_PER_LAYER = CVT_IN + 2 * CVT_UP + CVT_OUT + CVT_PG + CVT_PP + NE * CVT_EI + NE * CVT_EO;
__device__ __forceinline__ void convert_item(KArgs ap, int L, int r, LAS float* scr, int lane) {
    unsigned char* wl = ap->ws + WS_W + (size_t)L * WL_STRIDE;
    const float* W; const float* gain = nullptr; bf16_t* WT; int N = D, ldt = D, koff = 0, kind = 0, item = r;
    if (r < CVT_IN) { W = ap->in[3] + (size_t)L * D * INW; N = INW; gain = ap->in[2] + (size_t)L * D; WT = (bf16_t*)(wl + WO_IN); kind = 1; }
    else if ((r -= CVT_IN) < CVT_UP) { W = ap->in[9] + (size_t)L * 512 * D; WT = (bf16_t*)(wl + WO_UP); ldt = 1024; item = r; }
    else if ((r -= CVT_UP) < CVT_UP) { W = ap->in[10] + (size_t)L * 512 * D; WT = (bf16_t*)(wl + WO_UP); ldt = 1024; koff = 512; item = r; }
    else if ((r -= CVT_UP) < CVT_OUT) { W = ap->in[11] + (size_t)L * D * D; WT = (bf16_t*)(wl + WO_OUT); item = r; }
    else if ((r -= CVT_OUT) < CVT_PG) { W = ap->in[20] + (size_t)L * D * D; gain = ap->in[19] + (size_t)L * D; WT = (bf16_t*)(wl + WO_PG); item = r; }
    else if ((r -= CVT_PG) < CVT_PP) { W = ap->in[21] + (size_t)L * 256 * D; WT = (bf16_t*)(wl + WO_PP); ldt = 256; item = r; }
    else if ((r -= CVT_PP) < NE * CVT_EI) { const int e = r / CVT_EI; W = ap->in[17] + ((size_t)L * NE + e) * D * 1024; N = 1024; gain = ap->in[12] + (size_t)L * D; WT = (bf16_t*)(wl + WO_EI) + (size_t)e * 1024 * 1024; ldt = 1024; kind = 2; item = r % CVT_EI; }
    else { r -= NE * CVT_EI; const int e = r / CVT_EO; W = ap->in[18] + ((size_t)L * NE + e) * 512 * D; WT = (bf16_t*)(wl + WO_EO) + (size_t)e * 1024 * 512; ldt = 512; item = r % CVT_EO; }
    transpose_item(W, N, gain, WT, ldt, koff, kind, scr, item, lane);
}
__device__ __forceinline__ void p0_prologue(KArgs ap, int nlayers, bool fill_later, LAS unsigned char* lds, int wave, int lane, int gw, int NGW) {
    LAS float* scr = (LAS float*)(lds + RING_OFF + wave * 17408);
    unsigned char* ws = ap->ws;
    const int nconv = fill_later ? 1 : nlayers;
    for (int it = gw; it < CVT_PER_LAYER * nconv; it += NGW) convert_item(ap, nconv - 1 - it / CVT_PER_LAYER, it % CVT_PER_LAYER, scr, lane);
    if (fill_later) { const int first = FILL_SLABS * FILL_T * FILLW * (NGW / NWAVES), rest = CVT_PER_LAYER - first;
        if (rest > 0) for (int it = gw; it < rest * (nlayers - 1); it += NGW) convert_item(ap, 1 + it / rest, first + it % rest, scr, lane); }
    const int gt = gw * 64 + lane, NGT = NGW * 64;
    for (int L = 0; L < nlayers; ++L) {
        unsigned char* wl = ws + WS_W + (size_t)L * WL_STRIDE;
        bf16_t* sp = (bf16_t*)(wl + WO_SP); const float* wsrc = ap->in[7] + (size_t)L * 8 * 128 * 128;
        for (int i = gt; i < 8 * 128 * 128; i += NGT) { const int s = i & 127, t = (i >> 7) & 127; sp[i] = (bf16_t)f2bf(s <= t ? wsrc[i] : 0.f); }
        bf16_t* wrh = (bf16_t*)(wl + WO_R); bf16_t* wrl = wrh + 48 * 1024; const float* gain = ap->in[12] + (size_t)L * D; const float* wg = ap->in[13] + (size_t)L * D * 4; const float* we = ap->in[15] + (size_t)L * D * 32;
        for (int i = gt; i < 48 * 1024; i += NGT) { const int o = i >> 10, k = i & 1023; const float wv = o < 36 ? gain[k] * (o < 4 ? wg[k * 4 + o] : we[k * 32 + (o - 4)]) : 0.f;
            const unsigned h = f2bf(wv); wrh[i] = (bf16_t)h; wrl[i] = (bf16_t)f2bf(wv - __uint_as_float(h << 16)); }
    }
    { const f32x4* p4 = (const f32x4*)ap->in[1]; u32x2* pb = (u32x2*)(ws + WS_PB); const size_t n4 = (size_t)nlayers * M * 256 / 4;
      for (size_t i = gt; i < n4; i += NGT) { const f32x4 v = p4[i]; u32x2 w; w.x = pk2(v[0], v[1]); w.y = pk2(v[2], v[3]); pb[i] = w; } }
    for (int m = gw; m < M; m += NGW) {
        const f32x4* xr = (const f32x4*)(ap->in[0] + (size_t)m * D) + lane; u32x2* o8 = (u32x2*)((bf16_t*)(ws + WS_XB) + (size_t)m * D) + lane; float s = 0.f;
#pragma unroll
        for (int j = 0; j < 4; ++j) { const f32x4 v = xr[64 * j]; s += (v[0] * v[0] + v[1] * v[1]) + (v[2] * v[2] + v[3] * v[3]); u32x2 w; w.x = pk2(v[0], v[1]); w.y = pk2(v[2], v[3]); o8[64 * j] = w; }
        s = wave_sum(s);
        if (lane < 16) ((float*)(ws + WS_XPART))[(size_t)m * 16 + lane] = lane == 0 ? s : 0.f;
    }
}

__device__ __forceinline__ void router_pass(const bf16_t* __restrict__ x, const bf16_t* __restrict__ wrh  , const bf16_t* __restrict__ wrl  , const float* __restrict__ bgr, const float* __restrict__ ber,
                                            float* __restrict__ rs2, float* __restrict__ rs2s, int* __restrict__ cnt, int* __restrict__ tokl, int* __restrict__ tk_e, int* __restrict__ tk_pos, float* __restrict__ tk_w,
                                            LAS unsigned char* lds, int wave, int lane, int vcu, int G) {
    LAS float* lg = (LAS float*)(lds + RING_OFF + 106496 + (wave & 3) * 3200);
    LAS int* lcnt = (LAS int*)(lds + LDSCTL_OFF + 1024); LAS int* lbase = lcnt + 32;
    const int fr = lane & 15, fq = lane >> 4;
    for (int bt = vcu; bt < M / 64; bt += G) {
        if (wave == 0 && lane < 32) lcnt[lane] = 0;
        __syncthreads();
        int e1 = 0, e2 = 0, lp1 = 0, lp2 = 0; float tw1 = 0.f, tw2 = 0.f, rst = 0.f;
        const int t0 = bt * 64 + (wave & 3) * 16;
        {
            bf16x8 bh[3][4], bl[3][4]; u32x4 av[4][4];
            const bf16_t* wh = wrh + (size_t)fr * 1024 + 8 * fq + 128 * wave; const bf16_t* wl_ = wrl + (size_t)fr * 1024 + 8 * fq + 128 * wave;
            const bf16_t* xp = x + (size_t)(bt * 64 + fr) * D + 8 * fq + 128 * wave;
#pragma unroll
            for (int cb = 0; cb < 3; ++cb)
#pragma unroll
                for (int kk = 0; kk < 4; ++kk) { bh[cb][kk] = *(const bf16x8*)(wh + (size_t)cb * 16 * 1024 + 32 * kk); bl[cb][kk] = *(const bf16x8*)(wl_ + (size_t)cb * 16 * 1024 + 32 * kk); }
#pragma unroll
            for (int rg = 0; rg < 4; ++rg)
#pragma unroll
                for (int kk = 0; kk < 4; ++kk) av[rg][kk] = *(const u32x4*)(xp + (size_t)rg * 16 * D + 32 * kk);
#pragma unroll
            for (int rg = 0; rg < 4; ++rg) {
                f32x4 pacc[3]; pacc[0] = (f32x4){0.f, 0.f, 0.f, 0.f}; pacc[1] = pacc[0]; pacc[2] = pacc[0]; float pss = 0.f;
#pragma unroll
                for (int kk = 0; kk < 4; ++kk) {
#pragma unroll
                    for (int j = 0; j < 4; ++j) { const float a = bf_lo(av[rg][kk][j]), b = bf_hi(av[rg][kk][j]); pss += a * a + b * b; }
                    const bf16x8 Ah = __builtin_bit_cast(bf16x8, av[rg][kk]);
#pragma unroll
                    for (int cb = 0; cb < 3; ++cb) { pacc[cb] = __builtin_amdgcn_mfma_f32_16x16x32_bf16(bh[cb][kk], Ah, pacc[cb], 0, 0, 0); pacc[cb] = __builtin_amdgcn_mfma_f32_16x16x32_bf16(bl[cb][kk], Ah, pacc[cb], 0, 0, 0); }
                }
                LAS float* pp = (LAS float*)(lds + RING_OFF) + ((wave * 4 + rg) * 64 + lane) * 13;
#pragma unroll
                for (int cb = 0; cb < 3; ++cb)
#pragma unroll
                    for (int i = 0; i < 4; ++i) pp[cb * 4 + i] = pacc[cb][i];
                pp[12] = pss;
            }
        }
        __syncthreads();
        if (wave < 4) {
        f32x4 acc[3]; acc[0] = (f32x4){0.f, 0.f, 0.f, 0.f}; acc[1] = acc[0]; acc[2] = acc[0]; float ss = 0.f;
#pragma unroll
        for (int w2 = 0; w2 < 8; ++w2) { const LAS float* pp = (const LAS float*)(lds + RING_OFF) + ((w2 * 4 + wave) * 64 + lane) * 13;
#pragma unroll
            for (int cb = 0; cb < 3; ++cb)
#pragma unroll
                for (int i = 0; i < 4; ++i) acc[cb][i] += pp[cb * 4 + i];
            ss += pp[12]; }
        ss = sum_xor16_32(ss);
        const float rsr = 1.0f / sqrtf(ss * (1.f / D) + EPS);
#pragma unroll
        for (int cb = 0; cb < 3; ++cb)
#pragma unroll
            for (int i = 0; i < 4; ++i) lg[fr * 49 + 16 * cb + 4 * fq + i] = acc[cb][i] * rsr;
        if (fq == 0) lg[fr * 49 + 48] = rsr;
        asm volatile("s_waitcnt lgkmcnt(0)" ::: "memory");
        if (lane < 16) {
            const int tok = t0 + lane; const LAS float* l = lg + lane * 49;
            rst = l[48]; rs2[tok] = rst;
            const float g0 = l[0] + bgr[0], g1 = l[1] + bgr[1], g2 = l[2] + bgr[2], g3 = l[3] + bgr[3];
            int grp = 0; float gm = g0;
            if (g1 > gm) { gm = g1; grp = 1; } if (g2 > gm) { gm = g2; grp = 2; } if (g3 > gm) { gm = g3; grp = 3; }
            const float gsum = (expf(g0 - gm) + expf(g1 - gm)) + (expf(g2 - gm) + expf(g3 - gm));
            const float grp_w = 1.f / gsum;
            int i1 = 0, i2 = 0; float m1 = -INFINITY, m2 = -INFINITY;
#pragma unroll
            for (int i = 0; i < 8; ++i) { const float el = l[4 + grp * 8 + i] + ber[grp * 8 + i]; if (el > m1) { m2 = m1; i2 = i1; m1 = el; i1 = i; } else if (el > m2) { m2 = el; i2 = i; } }
            const float p2 = expf(m2 - m1), w1 = 1.f / (1.f + p2), w2 = p2 / (1.f + p2);
            e1 = grp * 8 + i1; e2 = grp * 8 + i2; tw1 = grp_w * w1; tw2 = grp_w * w2;
            lp1 = __hip_atomic_fetch_add(&lcnt[e1], 1, __ATOMIC_RELAXED, __HIP_MEMORY_SCOPE_WORKGROUP); lp2 = __hip_atomic_fetch_add(&lcnt[e2], 1, __ATOMIC_RELAXED, __HIP_MEMORY_SCOPE_WORKGROUP);
        }
        }
        __syncthreads();
        if (wave == 0 && lane < 32) { const int c = lcnt[lane]; lbase[lane] = c > 0 ? atomicAdd(&cnt[lane * CNT_STRIDE], c) : 0; }
        __syncthreads();
        if (wave < 4 && lane < 16) {
            const int tok = t0 + lane; const int pos1 = lbase[e1] + lp1, pos2 = lbase[e2] + lp2;
            tokl[e1 * ECAP + pos1] = tok; tokl[e2 * ECAP + pos2] = tok; rs2s[e1 * ECAP + pos1] = rst; rs2s[e2 * ECAP + pos2] = rst;
            tk_e[tok * 2] = e1; tk_e[tok * 2 + 1] = e2; tk_pos[tok * 2] = pos1; tk_pos[tok * 2 + 1] = pos2; tk_w[tok * 2] = tw1; tk_w[tok * 2 + 1] = tw2;
        }
        __syncthreads();
    }
}

__device__ __forceinline__ void combine_pass(bf16_t* xb, const bf16_t* __restrict__ ys, const LAS int* pref, const int* __restrict__ tk_e, const int* __restrict__ tk_pos,
                                             const float* __restrict__ tk_w, float* __restrict__ rs3, int lane, int gw, int NGW) {
    int en[4][2], pn[4][2]; float wn[4][2];
    const bool contig = (M % (NGW * 4)) == 0; const int mstart = contig ? gw * (M / NGW) : gw * 4, mstep = contig ? 4 : NGW * 4, mend = contig ? mstart + M / NGW : M;
    { const int m0 = mstart;
#pragma unroll
      for (int r = 0; r < 4; ++r) { const int m = m0 + r; en[r][0] = tk_e[m * 2]; en[r][1] = tk_e[m * 2 + 1]; pn[r][0] = tk_pos[m * 2]; pn[r][1] = tk_pos[m * 2 + 1]; wn[r][0] = tk_w[m * 2]; wn[r][1] = tk_w[m * 2 + 1]; } }
    for (int m0 = mstart; m0 < mend; m0 += mstep) {
        int s0[4], s1[4]; float w0[4], w1[4];
#pragma unroll
        for (int r = 0; r < 4; ++r) { s0[r] = 256 * pref[en[r][0]] + pn[r][0]; s1[r] = 256 * pref[en[r][1]] + pn[r][1]; w0[r] = wn[r][0]; w1[r] = wn[r][1]; }
        u32x4 xv[4][2], a0[4][2], a1[4][2];
#pragma unroll
        for (int r = 0; r < 4; ++r)
#pragma unroll
            for (int j = 0; j < 2; ++j) { xv[r][j] = ((const u32x4*)(xb + (size_t)(m0 + r) * D) + lane)[64 * j]; a0[r][j] = ((const u32x4*)(ys + (size_t)s0[r] * D) + lane)[64 * j]; a1[r][j] = ((const u32x4*)(ys + (size_t)s1[r] * D) + lane)[64 * j]; }
        if (m0 + mstep < mend) { const int mn = m0 + mstep;
#pragma unroll
            for (int r = 0; r < 4; ++r) { const int m = mn + r; en[r][0] = tk_e[m * 2]; en[r][1] = tk_e[m * 2 + 1]; pn[r][0] = tk_pos[m * 2]; pn[r][1] = tk_pos[m * 2 + 1]; wn[r][0] = tk_w[m * 2]; wn[r][1] = tk_w[m * 2 + 1]; } }
#pragma unroll
        for (int r = 0; r < 4; ++r) { float s = 0.f;
#pragma unroll
            for (int j = 0; j < 2; ++j) { u32x4 w;
#pragma unroll
                for (int q = 0; q < 4; ++q) { w[q] = cvt_pk_bf16(bf_lo(xv[r][j][q]) + w0[r] * bf_lo(a0[r][j][q]) + w1[r] * bf_lo(a1[r][j][q]), bf_hi(xv[r][j][q]) + w0[r] * bf_hi(a0[r][j][q]) + w1[r] * bf_hi(a1[r][j][q]));
                    const float a = bf_lo(w[q]), b = bf_hi(w[q]); s += a * a + b * b; }
                st16((u32x4*)(xb + (size_t)(m0 + r) * D) + lane + 64 * j, w); }
            s = wave_sum(s);
            if (lane == 0) rs3[m0 + r] = 1.0f / sqrtf(s * (1.f / D) + EPS); }
    }
}

__device__ __forceinline__ AttnBU attn_unit_of(int i, int G) {
    if (G == 256) { const int vc = i & 255, k = i >> 8, x = vc >> 5, q = vc & 31, pm = 8 * x + (q & 7); return AttnBU{pm >> 5, k * 4 + (q >> 3), pm & 31}; }
    return AttnBU{(i / (SEQ / 256)) >> 3, (i / (SEQ / 256)) & 7, i % (SEQ / 256)};
}
constexpr int PH_PER_LAYER = 10;
#ifndef FK_XLOC
#define FK_XLOC 1
#endif
#ifndef FK_LOCAL_MASK
#if FK_XLOC
#define FK_LOCAL_MASK 0x36E
#else
#define FK_LOCAL_MASK 0x30E
#endif
#endif
#ifndef FK_BPROBE
#define FK_BPROBE 0
#endif
#ifndef FK_BATT
#define FK_BATT 2
#endif
#ifndef FK_APROBE
#define FK_APROBE 0
#endif
#ifndef FK_XD
#define FK_XD 1
#endif
#ifndef FK_PFW
#define FK_PFW 0
#endif
#ifndef FK_DRY
#define FK_DRY 0
#endif
#ifndef FK_REP
#define FK_REP 0
#endif
#define REPS(bit) ((FK_REP & (bit)) ? 2 : 1)
__global__ void __launch_bounds__(NWAVES * 64, 2) mega_fwd(Args args_unused) {
    extern __shared__ __attribute__((aligned(16))) unsigned char lds_raw[];
    LAS unsigned char* lds = (LAS unsigned char*)lds_raw;
    LAS int* pref = (LAS int*)(lds + PREF_OFF);
    const KArgs kp0 = (KArgs)__builtin_amdgcn_kernarg_segment_ptr();
    const int tid = threadIdx.x, wave0 = __builtin_amdgcn_readfirstlane(tid >> 6);
    const int G = gridDim.x, bx = blockIdx.x;
    const int vcu = (G % 8 == 0) ? (bx % 8) * (G / 8) + bx / 8 : bx;
    const int gw0 = vcu * NWAVES + wave0, NGW = G * NWAVES;
#define FK_T0 (wave0 == 0 && fk_lane() == 0)
#define FK_IDS int lane_o = fk_lane(), wave_o = wave0, gw_o = gw0; asm volatile("" : "+v"(lane_o), "+s"(wave_o), "+s"(gw_o)); const int lane = lane_o, wave = wave_o, gw = gw_o; (void)lane; (void)wave; (void)gw;
    for (int u = tid; u < (LDS_BYTES - LDSCTL_OFF) / 4; u += NWAVES * 64) ((LAS unsigned*)(lds + LDSCTL_OFF))[u] = 0u;
    __syncthreads();
    const int lo = kp0->ph_lo, hi = kp0->ph_hi, nlayers = kp0->nlayers;
#define IN(k) (lo <= (k) && (k) < hi)
    const bool fill_on = (hi - lo > 1) && G == 256;
#define SEAM_F(k, Lc, slab) do { if (IN(k) && IN((k) + 1)) { \
        asm volatile("s_waitcnt vmcnt(0)" ::: "memory"); __syncthreads(); \
        if (wave0 == 0) { if (fk_lane() == 0) { KArgs A_ = fresh(kp0); XcdBarrier bar_; bar_.bar = (unsigned*)(A_->ws + WS_CTL) + CW_BAR; bar_.x = xb_xcc_id(); bar_.st = (volatile LAS unsigned*)(lds + MISC_OFF) + 8; xcd_barrier_t0(bar_, FK_LOCAL_MASK && (slab) >= 0 && (slab) < 16 && ((FK_LOCAL_MASK >> ((slab) & 15)) & 1) && bar_.st[2] != 0u); } } \
        else if (fill_on && (Lc) < nlayers && (slab) >= 0 && (slab) <= 8 && ((FK_FILL_MASK >> (slab)) & 1) && wave0 <= FILLW) { \
            const int rank_ = fk_popc(FK_FILL_MASK & ((1u << (slab)) - 1u)); \
            _Pragma("unroll 1") for (int t_ = 0; t_ < FILL_T; ++t_) { int idx_ = (rank_ * FILL_T + t_) * FILLW * G + bx * FILLW + (wave0 - 1); asm volatile("" : "+s"(idx_));   \
                if (idx_ < CVT_PER_LAYER) convert_item(fresh(kp0), (Lc), idx_, (LAS float*)(lds + RING_OFF + wave0 * 17408), fk_lane()); } } \
        __syncthreads(); } } while (0)
#define SEAM(k) SEAM_F(k, L + 1, (k) - pb)
    if (hi - lo > 1) { KArgs A = fresh(kp0); (void)xcd_barrier_post((unsigned*)(A->ws + WS_CTL) + CW_BAR, (volatile LAS unsigned*)(lds + MISC_OFF) + 8, FK_T0);
        if (FK_LOCAL_MASK && FK_T0 && bx < 8) __hip_atomic_store((unsigned*)(A->ws + WS_CTL) + CW_XID + bx, xb_xcc_id() + 1u, __ATOMIC_RELAXED, __HIP_MEMORY_SCOPE_AGENT); }

    if (IN(0)) { for (int rep = 0; rep < REPS(1); ++rep) { FK_IDS; p0_prologue(fresh(kp0), nlayers, fill_on, lds, wave, lane, gw, NGW); } }
    SEAM_F(0, nlayers, -1);
    if (FK_LOCAL_MASK && IN(0) && IN(1) && FK_T0) { KArgs A = fresh(kp0); unsigned* ctl = (unsigned*)(A->ws + WS_CTL);
        if (G != 256 || xb_ld(ctl + CW_XID + (bx & 7)) != xb_xcc_id() + 1u) (void)xb_add(ctl + CW_MIS, 1u); }
    if (IN(1)) { }
    for (int L = 0; L < nlayers; ++L) {
        const int pb = 2 + PH_PER_LAYER * L;
        if (IN(pb + 0)) for (int rep = 0; rep < REPS(4); ++rep) {
            KArgs A = fresh(kp0); unsigned char* ws = A->ws; unsigned char* wl = ws + WS_W + (size_t)L * WL_STRIDE;
            DenseOrder S; S.init(M, INW, G, bx, ws + WS_XB, wl + WO_IN, D);
            EpiIn E{(const float*)(ws + WS_XPART), A->in[4] + L * 64, A->in[5] + L * 64, (bf16_t*)(ws + WS_Q), (bf16_t*)(ws + WS_K), (bf16_t*)(ws + WS_V), (bf16_t*)(ws + WS_U), (bf16_t*)(ws + WS_VS), (bf16_t*)(ws + WS_GAB), (float*)(ws + WS_VSPART)};
            gemm_phase<EpiIn, DenseOrder, true>(lds + RING_OFF, D, S, E, wave0, FK_DRY && rep + 1 < REPS(4));
            { const int nshort = (G == 256) ? 128 : G; const int c2 = (G == 256) ? bx - 128 : bx;
              if (c2 >= 0) { DenseOrder S2; S2.init(M, D, nshort, c2, ws + WS_PB + (size_t)L * M * 256 * 2, wl + WO_PP, 256);
                  EpiPlain E2{(bf16_t*)(ws + WS_E) + (size_t)L * M * D, D, 0};
                  gemm_phase<EpiPlain, DenseOrder, true>(lds + RING_OFF, 256, S2, E2, wave0); } }
        }
        SEAM(pb + 0);
        if (FK_LOCAL_MASK && L == 0 && IN(0) && IN(1) && IN(pb) && IN(pb + 1) && FK_T0) { KArgs A = fresh(kp0); ((volatile LAS unsigned*)(lds + MISC_OFF) + 8)[2] = (xb_ld((unsigned*)(A->ws + WS_CTL) + CW_MIS) == 0u) ? 1u : 0u; }
        if (IN(pb + 1)) for (int rep = 0; rep < REPS(8 | 2048); ++rep) {
            KArgs A = fresh(kp0); unsigned char* ws = A->ws; unsigned char* wl = ws + WS_W + (size_t)L * WL_STRIDE;
            FK_IDS;
            LAS unsigned char* wlds = lds + RING_OFF + wave * WLDS_BYTES;
            constexpr int NATT = 2 * 8 * (SEQ / 32), NSGU = (M / 128) * 8 * 2;
#if FK_BATT
            if (rep == 0 || (FK_REP & 8)) { constexpr int NBU = 2 * 8 * (SEQ / 256);
                const bf16_t* qb_ = (const bf16_t*)(ws + WS_Q); const bf16_t* kb_ = (const bf16_t*)(ws + WS_K); const bf16_t* vb_ = (const bf16_t*)(ws + WS_V);
                bf16x8 qr[4]; f32x16 o[2];
                int it2 = vcu;
#if FK_BATT == 2
#define FK_BU(i) attn_unit_of((i), G)
                if (it2 < NBU) { AttnBU u = FK_BU(it2); attn_win_begin(u, qr, qb_, kb_, vb_, lds + RING_OFF, wave, lane);
                    for (;;) { attn_win_body(u, qr, o, kb_, vb_, lds + RING_OFF, wave, lane);
                        const int itn = it2 + G; const bool more = itn < NBU; AttnBU un = FK_BU(more ? itn : it2);
                        if (more) attn_win_begin(un, qr, qb_, kb_, vb_, lds + RING_OFF, wave, lane);
                        attn_win_end(u, o, (bf16_t*)(ws + WS_OC), lds + RING_OFF, wave, lane);
                        if (!more) break; u = un; it2 = itn; } }
                __syncthreads(); }
            if (0) { bf16x8 qr[4]; f32x16 o[2]; int it2 = vcu; constexpr int NBU = 0; const bf16_t* qb_ = nullptr; const bf16_t* kb_ = nullptr; const bf16_t* vb_ = nullptr;
#endif
                if (it2 < NBU) { AttnBU u{(it2 / (SEQ / 256)) >> 3, (it2 / (SEQ / 256)) & 7, it2 % (SEQ / 256)}; attn_block_begin(u, qr, qb_, kb_, vb_, lds + RING_OFF, wave, lane);
                    for (;;) { if (FK_BPROBE && rep == 1) attn_block_body<FK_BPROBE>(u, qr, o, kb_, vb_, lds + RING_OFF, wave, lane); else attn_block_body(u, qr, o, kb_, vb_, lds + RING_OFF, wave, lane);
                        const int itn = it2 + G; const bool more = itn < NBU; AttnBU un{(itn / (SEQ / 256)) >> 3, (itn / (SEQ / 256)) & 7, itn % (SEQ / 256)};
                        if (more) attn_block_begin(un, qr, qb_, kb_, vb_, lds + RING_OFF, wave, lane);
                        if (FK_BPROBE && rep == 1) { if (o[0][0] == 1.2345e-30f && o[1][3] == 5.4321e-30f) ((bf16_t*)(ws + WS_OC))[0] = 0; } else
                        attn_block_end(u, o, (bf16_t*)(ws + WS_OC), lds + RING_OFF, wave, lane);
                        if (!more) break; u = un; it2 = itn; } }
                __syncthreads(); }
            if (rep == 0 || (FK_REP & 2048)) for (int j = gw; j < NSGU; j += NGW) { const int hf = j & 1, g = (j >> 1) & 7, ch = j >> 4;
                if (hf == 0) sgu_wave_unit<0>(ch, g, (const bf16_t*)(ws + WS_U), (const bf16_t*)(ws + WS_VS), (const float*)(ws + WS_VSPART), (const bf16_t*)(wl + WO_SP), A->in[8] + (size_t)L * 8 * 128, A->in[6] + (size_t)L * 512, (bf16_t*)(ws + WS_OC), wlds, lane);
                else sgu_wave_unit<1>(ch, g, (const bf16_t*)(ws + WS_U), (const bf16_t*)(ws + WS_VS), (const float*)(ws + WS_VSPART), (const bf16_t*)(wl + WO_SP), A->in[8] + (size_t)L * 8 * 128, A->in[6] + (size_t)L * 512, (bf16_t*)(ws + WS_OC), wlds, lane); }
            __syncthreads();
            continue;
#endif
            const int nun = (NATT + NSGU - gw + NGW - 1) / NGW;
            for (int k_ = 0; k_ < nun; ++k_) { const int kk_ = (wave >= 4) ? (k_ == 0 ? nun - 1 : k_ - 1) : k_; const int it = gw + kk_ * NGW;
                if (rep == 1 && (it < NATT ? !(FK_REP & 8) : !(FK_REP & 2048))) continue;
                if (FK_APROBE && rep == 1 && it < NATT) { const int qblk = it % (SEQ / 32), bh = it / (SEQ / 32); attn_wave_unit<FK_APROBE>(bh >> 3, bh & 7, qblk, (const bf16_t*)(ws + WS_Q), (const bf16_t*)(ws + WS_K), (const bf16_t*)(ws + WS_V), (bf16_t*)(ws + WS_OC), wlds, lane); continue; }
                if (it < NATT) { const int qblk = it % (SEQ / 32), bh = it / (SEQ / 32); attn_wave_unit(bh >> 3, bh & 7, qblk, (const bf16_t*)(ws + WS_Q), (const bf16_t*)(ws + WS_K), (const bf16_t*)(ws + WS_V), (bf16_t*)(ws + WS_OC), wlds, lane); }
                else { const int j = it - NATT; const int hf = j & 1, g = (j >> 1) & 7, ch = j >> 4;
                    if (hf == 0) sgu_wave_unit<0>(ch, g, (const bf16_t*)(ws + WS_U), (const bf16_t*)(ws + WS_VS), (const float*)(ws + WS_VSPART), (const bf16_t*)(wl + WO_SP), A->in[8] + (size_t)L * 8 * 128, A->in[6] + (size_t)L * 512, (bf16_t*)(ws + WS_OC), wlds, lane);
                    else sgu_wave_unit<1>(ch, g, (const bf16_t*)(ws + WS_U), (const bf16_t*)(ws + WS_VS), (const float*)(ws + WS_VSPART), (const bf16_t*)(wl + WO_SP), A->in[8] + (size_t)L * 8 * 128, A->in[6] + (size_t)L * 512, (bf16_t*)(ws + WS_OC), wlds, lane); }
            }
        }
        SEAM(pb + 1);
        if (IN(pb + 2)) for (int rep = 0; rep < REPS(16); ++rep) {
            KArgs A = fresh(kp0); unsigned char* ws = A->ws; unsigned char* wl = ws + WS_W + (size_t)L * WL_STRIDE;
            DenseOrder S; S.init(M, D, G, bx, ws + WS_OC, wl + WO_UP, D);
            EpiUp E{(const bf16_t*)(ws + WS_GAB), (bf16_t*)(ws + WS_MG)};
            gemm_phase<EpiUp, DenseOrder, false>(lds + RING_OFF, D, S, E, wave0);
        }
        SEAM(pb + 2);
        if (IN(pb + 3)) for (int rep = 0; rep < REPS(128); ++rep) {
            KArgs A = fresh(kp0); unsigned char* ws = A->ws; unsigned char* wl = ws + WS_W + (size_t)L * WL_STRIDE;
            DenseOrder S; S.init(M, D, G, bx, ws + WS_MG, wl + WO_OUT, D);
            EpiOut E{(const bf16_t*)(ws + WS_XB), (bf16_t*)(ws + WS_XB1)};
            gemm_phase<EpiOut, DenseOrder, false>(lds + RING_OFF, D, S, E, wave0, FK_DRY && rep + 1 < REPS(128));
        }
        SEAM(pb + 3);
        if (IN(pb + 4)) {
            KArgs A = fresh(kp0); unsigned char* ws = A->ws; unsigned char* wl = ws + WS_W + (size_t)L * WL_STRIDE;
            FK_IDS;
#if FK_PFW
            { const unsigned char* wsrc = wl + WO_EI; const unsigned ngr = (unsigned)((size_t)NE * 1024 * 1024 * 2 / 64);
#pragma unroll 1
              for (unsigned g_ = (unsigned)gw * 64u + (unsigned)lane; g_ < ngr; g_ += (unsigned)NGW * 64u)
                  __builtin_amdgcn_global_load_lds((const unsigned*)(wsrc + (size_t)g_ * 64), (LAS unsigned*)(lds + RING_OFF + 120832 + wave * 1024), 4, 0, 0); }
#endif
            router_pass((const bf16_t*)(ws + WS_XB1), (const bf16_t*)(wl + WO_R), (const bf16_t*)(wl + WO_R) + 48 * 1024, A->in[14] + L * 4, A->in[16] + L * 32, (float*)(ws + WS_RS2), (float*)(ws + WS_RS2S), (int*)((unsigned*)(ws + WS_CTL) + CW_CNT) + L * NE * CNT_STRIDE, (int*)(ws + WS_TOKL), (int*)(ws + WS_TKE), (int*)(ws + WS_TKP), (float*)(ws + WS_TKW), lds, wave, lane, vcu, G);
        }
        SEAM(pb + 4);
        if (IN(pb + 5) || IN(pb + 6) || IN(pb + 7) || IN(pb + 8)) {
            KArgs A = fresh(kp0); const int* cnt = (const int*)((unsigned*)(A->ws + WS_CTL) + CW_CNT) + L * NE * CNT_STRIDE;
            if (FK_T0) { int s = 0; for (int e = 0; e < NE; ++e) { const int ce = cnt[e * CNT_STRIDE]; pref[e] = s; pref[40 + e] = ce;   s += (ce + 255) >> 8; } pref[NE] = s; }
            __syncthreads();
        }
        const int nG1 = pref[NE] * 4, fr = nG1 / G, n3 = nG1 - fr * G;
        const int jB = (fr >= 1) ? min(2 * (G - n3), (fr * G / 4) * 4) : 0;
        const bool xl = FK_XLOC && G == 256;
        const int xq = bx >> 3, xx = bx & 7, frb = fr * 8, mx4 = xl ? 4 * ((pref[NE] - fr * 64 + 7 - xx) >> 3) : 0, ltot = 4 * frb + mx4, jBx = min(2 * (32 - mx4), 4 * frb);
        if (IN(pb + 5)) for (int rep = 0; rep < REPS(32); ++rep) {
            KArgs A = fresh(kp0); unsigned char* ws = A->ws; unsigned char* wl = ws + WS_W + (size_t)L * WL_STRIDE; const int* cnt = (const int*)((unsigned*)(ws + WS_CTL) + CW_CNT) + L * NE * CNT_STRIDE;
            ExpertOrder S = xl ? ExpertOrder{32, xq, D, 4, (const char*)(ws + WS_XB1), (const char*)(wl + WO_EI), (size_t)1024 * 1024 * 2, pref, (const int*)(ws + WS_TOKL), cnt, 1, 0, fr, 4 * frb, 2, xx, frb, ltot}
                               : ExpertOrder{G, FK_XD ? xcd_rank(bx, 0, G) : bx, D, 4, (const char*)(ws + WS_XB1), (const char*)(wl + WO_EI), (size_t)1024 * 1024 * 2, pref, (const int*)(ws + WS_TOKL), cnt, 1, 0, fr, fr * G, 0, 0, 0, 0};
            EpiG1 E{pref, (const float*)(ws + WS_RS2S), (bf16_t*)(ws + WS_G)};
            gemm_phase<EpiG1, ExpertOrder, true>(lds + RING_OFF, D, S, E, wave0);
        }
        SEAM(pb + 5);
        if (IN(pb + 6)) {
            KArgs A = fresh(kp0); unsigned char* ws = A->ws; unsigned char* wl = ws + WS_W + (size_t)L * WL_STRIDE; const int* cnt = (const int*)((unsigned*)(ws + WS_CTL) + CW_CNT) + L * NE * CNT_STRIDE;
            if (xl ? (xq < mx4) : (bx < n3)) {
                ExpertOrder S = xl ? ExpertOrder{32, xq, D, 4, (const char*)(ws + WS_XB1), (const char*)(wl + WO_EI), (size_t)1024 * 1024 * 2, pref, (const int*)(ws + WS_TOKL), cnt, 1, 4 * frb, 1, ltot, 2, xx, frb, ltot}
                                   : ExpertOrder{G, bx, D, 4, (const char*)(ws + WS_XB1), (const char*)(wl + WO_EI), (size_t)1024 * 1024 * 2, pref, (const int*)(ws + WS_TOKL), cnt, 1, fr * G, 1, nG1, 0, 0, 0, 0};
                EpiG1 E{pref, (const float*)(ws + WS_RS2S), (bf16_t*)(ws + WS_G)};
                gemm_phase<EpiG1, ExpertOrder, true>(lds + RING_OFF, D, S, E, wave0);
            } else {
                ExpertOrder S = xl ? ExpertOrder{32 - mx4, xq - mx4, 512, 4, (const char*)(ws + WS_G), (const char*)(wl + WO_EO), (size_t)1024 * 512 * 2, pref, (const int*)(ws + WS_TOKL), cnt, 0, 0, 2, jBx, 2, xx, frb, ltot}
                                   : ExpertOrder{G - n3, bx - n3, 512, 4, (const char*)(ws + WS_G), (const char*)(wl + WO_EO), (size_t)1024 * 512 * 2, pref, (const int*)(ws + WS_TOKL), cnt, 0, 0, 2, jB, 0, 0, 0, 0};
                EpiPlain E{(bf16_t*)(ws + WS_YS), D, 1};
                gemm_phase<EpiPlain, ExpertOrder, true>(lds + RING_OFF, 512, S, E, wave0);
            }
        }
        SEAM(pb + 6);
        if (IN(pb + 7)) for (int rep = 0; rep < REPS(64); ++rep) {
            KArgs A = fresh(kp0); unsigned char* ws = A->ws; unsigned char* wl = ws + WS_W + (size_t)L * WL_STRIDE; const int* cnt = (const int*)((unsigned*)(ws + WS_CTL) + CW_CNT) + L * NE * CNT_STRIDE;
            ExpertOrder S = xl ? ExpertOrder{32, xq, 512, 4, (const char*)(ws + WS_G), (const char*)(wl + WO_EO), (size_t)1024 * 512 * 2, pref, (const int*)(ws + WS_TOKL), cnt, 0, jBx, 1 << 20, ltot, 2, xx, frb, ltot}
                               : ExpertOrder{G, bx, 512, 4, (const char*)(ws + WS_G), (const char*)(wl + WO_EO), (size_t)1024 * 512 * 2, pref, (const int*)(ws + WS_TOKL), cnt, 0, jB, 1 << 20, nG1, 0, 0, 0, 0};
            EpiPlain E{(bf16_t*)(ws + WS_YS), D, 1};
            gemm_phase<EpiPlain, ExpertOrder, true>(lds + RING_OFF, 512, S, E, wave0);
        }
        SEAM(pb + 7);
        if (IN(pb + 8)) {
            KArgs A = fresh(kp0); unsigned char* ws = A->ws;
            FK_IDS;
            combine_pass((bf16_t*)(ws + WS_XB1), (const bf16_t*)(ws + WS_YS), pref, (const int*)(ws + WS_TKE), (const int*)(ws + WS_TKP), (const float*)(ws + WS_TKW), (float*)(ws + WS_RS3), lane, gw, NGW);
        }
        SEAM(pb + 8);
        if (IN(pb + 9)) {
            KArgs A = fresh(kp0); unsigned char* ws = A->ws; unsigned char* wl = ws + WS_W + (size_t)L * WL_STRIDE;
            DenseOrder S; S.init(M, D, G, bx, ws + WS_XB1, wl + WO_PG, D);
            EpiPle E{(const bf16_t*)(ws + WS_XB1), (bf16_t*)(ws + WS_XB), (L == nlayers - 1) ? A->out : (float*)nullptr, (const bf16_t*)(ws + WS_E) + (size_t)L * M * D, (const float*)(ws + WS_RS3), (float*)(ws + WS_XPART)};
            gemm_phase<EpiPle, DenseOrder, false>(lds + RING_OFF, D, S, E, wave0);
        }
        SEAM(pb + 9);
    }
#undef IN
#undef SEAM
#undef SEAM_F
#undef FK_IDS
#undef FK_T0
}
}
#ifndef FK_N_LAUNCHES
#define FK_N_LAUNCHES 1
#endif
static int fk_grid = 0;
static bool fk_setup() {
    if (fk_grid) return fk_grid > 0;
    int dev = 0, cus = 0, per_cu = 0;
    if (hipGetDevice(&dev) != hipSuccess || hipDeviceGetAttribute(&cus, hipDeviceAttributeMultiprocessorCount, dev) != hipSuccess) { fprintf(stderr, "kernel_launch: device query failed\n"); fk_grid = -1; return false; }
    if (hipFuncSetAttribute((const void*)fk::mega_fwd, hipFuncAttributeMaxDynamicSharedMemorySize, fk::LDS_BYTES) != hipSuccess) { fprintf(stderr, "kernel_launch: hipFuncSetAttribute failed\n"); fk_grid = -1; return false; }
    if (hipOccupancyMaxActiveBlocksPerMultiprocessor(&per_cu, (const void*)fk::mega_fwd, fk::NWAVES * 64, fk::LDS_BYTES) != hipSuccess || per_cu < 1)
        fprintf(stderr, "kernel_launch: note: occupancy query reports %d workgroups per CU\n", per_cu);
    (void)hipGetLastError();
    fk_grid = cus;
    return true;
}
static void fk_launch_range(fk::Args a, int lo, int hi, hipStream_t stream) {
    a.ph_lo = lo; a.ph_hi = hi;
    hipLaunchKernelGGL(fk::mega_fwd, dim3(fk_grid), dim3(fk::NWAVES * 64), fk::LDS_BYTES, stream, a);
    const hipError_t le = hipPeekAtLastError();
    if (le != hipSuccess) fprintf(stderr, "kernel_launch: launch [%d,%d) failed: %s\n", lo, hi, hipGetErrorName(le));
}

#ifdef FK_DEBUG_CHECK
#ifndef FK_FOCUS
#define FK_FOCUS 0
#endif
#ifndef FK_STAT
#define FK_STAT 1
#endif
namespace dbg {
__global__ void __launch_bounds__(256) k_cmp(const void* fast, int is_bf16, int fld, int fcol0, const float* gold, int gld, int gcol0, int rows, int cols, float gscale, float* acc) {
    float sd = 0.f, sb = 0.f, sa = 0.f, sb2 = 0.f;
    const size_t n = (size_t)rows * cols;
    for (size_t i = (size_t)blockIdx.x * 256 + threadIdx.x; i < n; i += (size_t)gridDim.x * 256) {
        const size_t r = i / cols; const int c = (int)(i % cols);
        float a;
        if (is_bf16) { const unsigned short h = ((const unsigned short*)fast)[r * fld + fcol0 + c]; a = __uint_as_float((unsigned)h << 16); } else a = ((const float*)fast)[r * fld + fcol0 + c];
        const float b = gold[r * gld + gcol0 + c] * gscale;
        const float d = a - b; sd += d * d; sb += b * b; sa += (FK_STAT == 2 ? a : FK_STAT == 3 ? a * b : FK_STAT == 4 ? (a > 0.99f ? 1.f : 0.f) : a * a); sb2 += (FK_STAT == 2 ? b : FK_STAT == 4 ? 1.f : b * b);
    }
    for (int o = 1; o < 64; o <<= 1) { sd += __shfl_xor(sd, o); sb += __shfl_xor(sb, o); sa += __shfl_xor(sa, o); sb2 += __shfl_xor(sb2, o); }
    if ((threadIdx.x & 63) == 0) { atomicAdd(&acc[0], sd); atomicAdd(&acc[1], sb); atomicAdd(&acc[512], sa); atomicAdd(&acc[513], sb2); }
}
__global__ void __launch_bounds__(256) k_cmp_vs(const unsigned short* vsb, const float* vspart, const float* gain, const float* gz, float* acc) {
    const int row = blockIdx.x * 4 + (threadIdx.x >> 6), lane = threadIdx.x & 63;
    float ss = 0.f; for (int j = 0; j < 8; ++j) ss += vspart[(size_t)row * 8 + j];
    const float rv = 1.f / sqrtf(ss / 512.f + 1e-6f);
    float sd = 0.f, sb = 0.f;
    for (int j = 0; j < 8; ++j) { const int c = lane + 64 * j; const float a = __uint_as_float((unsigned)vsb[(size_t)row * 512 + c] << 16) * rv * gain[c]; const float b = gz[(size_t)row * 4608 + 2048 + c]; sd += (a - b) * (a - b); sb += b * b; }
    for (int o = 1; o < 64; o <<= 1) { sd += __shfl_xor(sd, o); sb += __shfl_xor(sb, o); }
    if (lane == 0) { atomicAdd(&acc[0], sd); atomicAdd(&acc[1], sb); }
}
__global__ void __launch_bounds__(256) k_cmp_w(const unsigned short* wt, const float* w, const float* gain, int n0, int n1, float* acc) {
    float sd = 0.f, sb = 0.f; const size_t tot = (size_t)(n1 - n0) * 1024;
    for (size_t i = (size_t)blockIdx.x * 256 + threadIdx.x; i < tot; i += (size_t)gridDim.x * 256) { const int n = n0 + (int)(i >> 10), k = (int)(i & 1023);
        const float a = __uint_as_float((unsigned)wt[(size_t)n * 1024 + k] << 16), b = gain[k] * w[(size_t)k * 4608 + n]; sd += (a - b) * (a - b); sb += b * b; }
    for (int o = 1; o < 64; o <<= 1) { sd += __shfl_xor(sd, o); sb += __shfl_xor(sb, o); }
    if ((threadIdx.x & 63) == 0) { atomicAdd(&acc[0], sd); atomicAdd(&acc[1], sb); }
}
__global__ void k_final_v(const float* acc, int nchecks, float tol, float* v, int focus) {
    if (threadIdx.x == 0 && blockIdx.x == 0) {
        float out = 0.f;
        if (focus > 0) { float m = acc[2 * focus + 512] / acc[2 * focus + 513]; if (FK_STAT == 1) m = sqrtf(m); if (!(m <= 8.f)) m = 8.f; m = floorf(m * 20.f + 0.5f) * 0.05f; v[0] = powf(10.f, (float)focus) * (1.f + m); return; }
        for (int c = nchecks; c >= 1; --c) { const float e = sqrtf(acc[2 * c] / acc[2 * c + 1]); if (!(e <= tol)) { float m = e; if (!(m <= 2.f)) m = 2.f; m = floorf(m * 10.f + 0.5f) * 0.1f;   out = powf(10.f, (float)c) * (1.f + m); } }
        v[0] = out;
    }
}
__global__ void __launch_bounds__(256) k_scale_out(const float* base, const float* v, float* out, size_t n) {
    const size_t i = (size_t)blockIdx.x * 256 + threadIdx.x; if (i < n) out[i] = base[i] * (1.f + v[0]);
}
}
#endif

extern "C" void kernel_launch(void* const* d_in, const int* in_sizes, int n_in, void* d_out, int out_size, void* d_ws, size_t ws_size, hipStream_t stream) {
    using namespace fk;
    if (n_in != 22 || out_size != M * D || ws_size < WS_FAST_END) { fprintf(stderr, "kernel_launch: unexpected shapes (n_in %d out %d ws %zu)\n", n_in, out_size, ws_size); return; }
    if (!fk_setup()) return;
    if (hipMemsetAsync((char*)d_ws + WS_CTL, 0, CTL_ZERO_BYTES, stream) != hipSuccess) { fprintf(stderr, "kernel_launch: memset failed\n"); return; }
    Args a{};
    for (int i = 0; i < 22; ++i) a.in[i] = (const float*)d_in[i];
    a.out = (float*)d_out; a.ws = (unsigned char*)d_ws; a.nlayers = DEPTH; a.pad = 0;
#ifndef FK_DEBUG_CHECK
    const int nph = 2 + PH_PER_LAYER * DEPTH;
    if (FK_N_LAUNCHES == 1) fk_launch_range(a, 0, nph, stream);
    else for (int p = 0; p < nph; ++p) fk_launch_range(a, p, p + 1, stream);
#else
    constexpr size_t GOLD_BASE = 1100 * MiB, SN_A = 128 * MiB, SN_B = 192 * MiB, SN_BASE = 256 * MiB, FS_A = 320 * MiB, FS_B = 384 * MiB, DBG_ACC = 448 * MiB;
    if (ws_size < GOLD_BASE + gold::O_END) { fprintf(stderr, "kernel_launch: debug build needs %zu bytes of workspace, got %zu\n", GOLD_BASE + gold::O_END, ws_size); return; }
    unsigned char* ws = (unsigned char*)d_ws; unsigned char* gb = ws + GOLD_BASE;
    gold::forward(d_in, (float*)(ws + SN_BASE), gb, 4, stream);
    gold::forward(d_in, nullptr, gb, 1, stream, (float*)(ws + SN_A), (float*)(ws + SN_B));
    a.nlayers = 1;
    const int nph = 2 + PH_PER_LAYER;
    for (int p = 0; p < nph; ++p) {
        fk_launch_range(a, p, p + 1, stream);
        if (p == 2 + 0) (void)hipMemcpyAsync(ws + 528 * MiB, ws + WS_GAB, (size_t)M * 2048 * 2, hipMemcpyDeviceToDevice, stream);
        if (p == 2 + 3) (void)hipMemcpyAsync(ws + FS_A, d_out, (size_t)M * D * 4, hipMemcpyDeviceToDevice, stream);
        if (p == 2 + 7) (void)hipMemcpyAsync(ws + FS_B, d_out, (size_t)M * D * 4, hipMemcpyDeviceToDevice, stream);
    }
    float* acc = (float*)(ws + DBG_ACC);
    (void)hipMemsetAsync(acc, 0, 4096, stream);
    const float* gz = (const float*)(gb + gold::O_Z);
    int c = 0;
#define CMP(fast, isbf, fld, fc0, gold_, gld, gc0, rows, cols, gs) do { ++c; hipLaunchKernelGGL(dbg::k_cmp, dim3(2048), dim3(256), 0, stream, (const void*)(fast), isbf, fld, fc0, (const float*)(gold_), gld, gc0, rows, cols, gs, acc + 2 * c); } while (0)
    ++c; hipLaunchKernelGGL(dbg::k_cmp_w, dim3(1024), dim3(256), 0, stream, (const unsigned short*)(ws + WS_W + WO_IN), (const float*)d_in[3], (const float*)d_in[2], 1024, 2560, acc + 2 * c);
    ++c; hipLaunchKernelGGL(dbg::k_cmp_w, dim3(1024), dim3(256), 0, stream, (const unsigned short*)(ws + WS_W + WO_IN), (const float*)d_in[3], (const float*)d_in[2], 2560, 3584, acc + 2 * c);
    ++c; hipLaunchKernelGGL(dbg::k_cmp_w, dim3(1024), dim3(256), 0, stream, (const unsigned short*)(ws + WS_W + WO_IN), (const float*)d_in[3], (const float*)d_in[2], 3584, 4608, acc + 2 * c);
    CMP(ws + WS_E, 1, 1024, 0, gb + gold::O_YB, 1024, 0, M, 1024, 1.f);
    CMP(ws + WS_Q, 1, 512, 0, gz, INW, 0, M, 512, 0.125f * LOG2E);
    CMP(ws + WS_K, 1, 512, 0, gz, INW, 512, M, 512, 1.f);
    CMP(ws + WS_V, 1, 512, 0, gz, INW, 1024, M, 512, 1.f);
    CMP(ws + WS_U, 1, 512, 0, gz, INW, 1536, M, 512, 1.f);
    ++c; hipLaunchKernelGGL(dbg::k_cmp_vs, dim3(M / 4), dim3(256), 0, stream, (const unsigned short*)(ws + WS_VS), (const float*)(ws + WS_VSPART), (const float*)d_in[6], gz, acc + 2 * c);
    CMP(ws + WS_OC, 1, 1024, 0, gb + gold::O_OA, 512, 0, M, 512, 1.f);
    CMP(ws + WS_OC, 1, 1024, 512, gb + gold::O_OB, 512, 0, M, 512, 1.f);
    CMP(ws + WS_MG, 1, 1024, 0, gb + gold::O_YA, 1024, 0, M, 1024, 1.f);
    CMP(ws + FS_A, 0, 1024, 0, ws + SN_A, 1024, 0, M, 1024, 1.f);
    CMP(ws + FS_B, 0, 1024, 0, ws + SN_B, 1024, 0, M, 1024, 1.f);
    CMP(d_out, 0, 1024, 0, gb + gold::O_X, 1024, 0, M, 1024, 1.f);
    CMP(ws + 528 * MiB, 1, 2048, 0, gz, INW, 2560, M, 256, 1.f);
    CMP(ws + WS_GAB, 1, 2048, 0, gz, INW, 2560, M, 256, 1.f);
    CMP(ws + WS_GAB, 1, 2048, 256, gz, INW, 2816, M, 256, 1.f);
    CMP(ws + WS_GAB, 1, 2048, 512, gz, INW, 3072, M, 512, 1.f);
    CMP(ws + WS_GAB, 1, 2048, 1024, gz, INW, 3584, M, 1024, 1.f);
    hipLaunchKernelGGL(dbg::k_final_v, dim3(1), dim3(64), 0, stream, acc, c, 0.03f, acc + 900, FK_FOCUS);
    hipLaunchKernelGGL(dbg::k_scale_out, dim3(M * D / 256), dim3(256), 0, stream, (const float*)(ws + SN_BASE), acc + 900, (float*)d_out, (size_t)M * D);
#endif
}
```

```cpp
#include <hip/hip_runtime.h>
#include <hip/hip_bf16.h>
#include <cstdio>
#include <cstdint>
#include <cmath>
#define FK_SPIN_SLEEP 24
#define FK_NODUMMY 1
#define FK_TR2 1
#define FK_P0B 1
#define FK_LASTSKIP 1
#define FK_EARLY_INV 2
#define FK_TOPSLEEP 2
#define FK_CTLZ_KIB 256
#define FK_D1SLEEP 40
namespace fk {
#define LAS __attribute__((address_space(3)))
#define GAS __attribute__((address_space(1)))
typedef unsigned short bf16_t;
typedef short bf16x8 __attribute__((ext_vector_type(8)));
typedef short s16x4 __attribute__((ext_vector_type(4)));
typedef float f32x2 __attribute__((ext_vector_type(2)));
typedef float f32x4 __attribute__((ext_vector_type(4)));
typedef float f32x16 __attribute__((ext_vector_type(16)));
typedef unsigned u32x2 __attribute__((ext_vector_type(2)));
typedef unsigned u32x4 __attribute__((ext_vector_type(4)));

constexpr int M = 16384, SEQ = 8192, D = 1024, INW = 4608, NE = 32, ECAP = 16384, DEPTH = 4;
constexpr float EPS = 1e-6f, LOG2E = 1.4426950408889634f;
constexpr int CNT_STRIDE = 64;
constexpr int BM = 256, BK = 64, HALF = 128, HTB = HALF * BK * 2, STAGE_BYTES = 8 * HTB, NXCD = 8, WGM = 8;

__device__ __forceinline__ unsigned cvt_pk_bf16(float lo, float hi) { unsigned r; asm volatile("v_cvt_pk_bf16_f32 %0, %1, %2" : "=v"(r) : "v"(lo), "v"(hi)); return r; }
__device__ __forceinline__ float bf_lo(unsigned w) { return __uint_as_float(w << 16); }
__device__ __forceinline__ float bf_hi(unsigned w) { return __uint_as_float(w & 0xffff0000u); }
__device__ __forceinline__ float fast_rcp(float x) { return __builtin_amdgcn_rcpf(x); }
__device__ __forceinline__ float fast_exp2(float x) { return __builtin_amdgcn_exp2f(x); }
__device__ __forceinline__ float fast_log2(float x) { return __builtin_amdgcn_logf(x); }
__device__ __forceinline__ float fast_rsq(float x) { return __builtin_amdgcn_rsqf(x); }
__device__ __forceinline__ float sigmoid_f(float x) { return fast_rcp(1.f + fast_exp2(-LOG2E * x)); }
__device__ __forceinline__ float gelu_tanh_f(float x) { const float u2 = 1.5957691216057308f * (x + 0.044715f * x * x * x); return x * fast_rcp(1.f + fast_exp2(-LOG2E * u2)); }

__host__ __device__ __forceinline__ int lds_byte(int r, int c) { const int st = (r >> 4) * 2 + (c >> 5), rr = r & 15, cc = c & 31, ob = rr * 64 + cc * 2; return st * 1024 + (ob ^ (((ob >> 9) & 1) << 5)); }
__host__ __device__ __forceinline__ void stage_rc(int b, int& R, int& C) { const int st = b / 1024, sb = b % 1024, swz = sb ^ (((sb >> 9) & 1) << 5); R = (st >> 1) * 16 + swz / 64; C = (st & 1) * 32 + (swz % 64) / 2; }
__host__ __device__ __forceinline__ int perm32(int rho) { const int n = rho >> 4, i = rho & 15; return 8 * (i >> 2) + 4 * n + (i & 3); }

template <int MASK> __device__ __forceinline__ float xor_lt32(float v) { return __int_as_float(__builtin_amdgcn_ds_swizzle(__float_as_int(v), (MASK << 10) | 0x1f)); }
__device__ __forceinline__ void halves32(float v, float& lo, float& hi) { auto rr = __builtin_amdgcn_permlane32_swap(__float_as_uint(v), __float_as_uint(v), false, false); lo = __uint_as_float(rr[0]); hi = __uint_as_float(rr[1]); }
__device__ __forceinline__ float sum_xor16_32(float v) { v += xor_lt32<16>(v); float lo, hi; halves32(v, lo, hi); return lo + hi; }
#ifndef FK_PADSKIP
#define FK_PADSKIP 0
#endif
#ifndef FK_LASTSKIP
#define FK_LASTSKIP 0
#endif
#ifndef FK_GFOLD
#define FK_GFOLD 0
#endif
#ifndef FK_GQK
#define FK_GQK 0
#endif
#ifndef FK_MID16
#define FK_MID16 0
#endif
#ifndef FK_NODUMMY
#define FK_NODUMMY 0
#endif
#ifndef FK_PFR
#define FK_PFR 0
#endif
#ifndef FK_UNC
#define FK_UNC 0
#endif
#ifndef FK_RAWG
#define FK_RAWG 0
#endif
#ifndef FK_WT
#define FK_WT 0
#endif
__device__ __forceinline__ void st16wt(void* p, u32x4 v) {
#if FK_WT
    asm volatile("global_store_dwordx4 %0, %1, off sc1\n\ts_nop 1" :: "v"(p), "v"(v) : "memory");
#else
    *(u32x4*)p = v;
#endif
}
#ifndef FK_NT
#define FK_NT 0
#endif
#ifndef FK_WT1
#define FK_WT1 0
#endif
__device__ __forceinline__ void st16o(void* p, u32x4 v) {
#if FK_WT1
    asm volatile("global_store_dwordx4 %0, %1, off sc1\n\ts_nop 1" :: "v"(p), "v"(v) : "memory");
#else
    *(u32x4*)p = v;
#endif
}
__device__ __forceinline__ void st16(void* p, u32x4 v) {
#if FK_WT
    st16wt(p, v);
#elif FK_NT
    __builtin_nontemporal_store(v, (u32x4*)p);
#else
    *(u32x4*)p = v;
#endif
}
__device__ __forceinline__ int fk_lane() { int l; asm volatile("v_mbcnt_lo_u32_b32 %0, -1, 0\n\tv_mbcnt_hi_u32_b32 %0, -1, %0" : "=v"(l)); return l; }
struct Unit { int pm, pn, e, aux; };

struct DenseOrder {
    int nM, nN, nwg, G, c; const char* A; const char* B; int K;
    __device__ void init(int Mr, int N, int G_, int c_, const void* A_, const void* B_, int K_) { nM = Mr / BM; nN = N / BM; nwg = nM * nN; G = G_; c = c_; A = (const char*)A_; B = (const char*)B_; K = K_; }
    __device__ __forceinline__ bool next(int i, Unit& u) const {
        const long L = (long)i * G + c; if (L >= nwg) return false;
        int wgid = (int)L; { const int q = nwg / NXCD, r = nwg % NXCD, xcd = wgid % NXCD, off = wgid / NXCD; wgid = (xcd < r ? xcd * (q + 1) : r * (q + 1) + (xcd - r) * q) + off; }
        const int nig = WGM * nN, gid = wgid / nig, fm = gid * WGM, gsz = (nM - fm) < WGM ? (nM - fm) : WGM;
        u.pm = fm + ((wgid % nig) % gsz); u.pn = (wgid % nig) / gsz; u.e = 0; u.aux = 0; return true;
    }
    __device__ __forceinline__ const char* a_base() const { return A; }
    __device__ __forceinline__ const char* b_base(const Unit& u) const { return B + (size_t)u.pn * BM * K * 2; }
    __device__ __forceinline__ void a_voff(const Unit& u, unsigned (&v)[2][2], const int (&R)[2], const int (&C)[2]) const {
#pragma unroll
        for (int h = 0; h < 2; ++h)
#pragma unroll
            for (int i = 0; i < 2; ++i) v[h][i] = (unsigned)((u.pm * BM + h * HALF + R[i]) * K + C[i]) * 2u;
    }
};

struct ExpertOrder {
    int G, c, K, nN; const char* A; const char* B; size_t bstride; const LAS int* pref; const int* tokl; const int* cnt; int gather;
    int L0, imax, Lend;
    int xcd_deal;
    int xx, frb, ltot;
    __device__ __forceinline__ bool next(int i, Unit& u) const {
        if (i >= imax) return false;
        if (xcd_deal == 2) {
            const int L = L0 + i * G + c; if (L >= Lend || L >= ltot) return false;
            const int lrb = L / nN; u.pn = L % nN;
            const int rbi = lrb < frb ? ((lrb >> 3) * 64 + 8 * xx + (lrb & 7)) : (frb * 8 + xx + 8 * (lrb - frb));
            int e = 0;
#pragma unroll 1
            for (int j = 1; j < NE; ++j) if (rbi >= pref[j]) e = j;
            u.e = e; u.pm = rbi - pref[e]; u.aux = rbi * BM; return true;
        }
        int u_ = c; if (xcd_deal) { const int q = c >> 3, x = c & 7; u_ = (x * (G >> 5) + (q >> 2)) * 4 + (q & 3); }
        const int L = L0 + i * G + u_; const int tot = pref[NE] * nN; if (L >= Lend || L >= tot) return false;
        const int rbi = L / nN; u.pn = L % nN; int e = 0;
#pragma unroll 1
        for (int j = 1; j < NE; ++j) if (rbi >= pref[j]) e = j;
        u.e = e; u.pm = rbi - pref[e]; u.aux = rbi * BM; return true;
    }
    __device__ __forceinline__ const char* a_base() const { return A; }
    __device__ __forceinline__ const char* b_base(const Unit& u) const { return B + (size_t)u.e * bstride + (size_t)u.pn * BM * K * 2; }
    __device__ __forceinline__ void a_voff(const Unit& u, unsigned (&v)[2][2], const int (&R)[2], const int (&C)[2]) const {
        const int ce = pref[40 + u.e];
#pragma unroll
        for (int h = 0; h < 2; ++h)
#pragma unroll
            for (int i = 0; i < 2; ++i) {
                const int r = u.pm * BM + h * HALF + R[i]; int row;
                if (gather == 1) { const int tk = tokl[u.e * ECAP + r]; row = (r < ce) ? tk : 0; }
                else if (gather == 2) row = (u.aux + h * HALF + R[i]) & (M - 1);
                else row = u.aux + h * HALF + R[i];
                v[h][i] = (unsigned)(row * K + C[i]) * 2u;
            }
    }
};

template <class Epi, class Sched, bool ALIGN_EPI>
__device__ __forceinline__ void gemm_phase(LAS unsigned char* lds, const int K, const Sched& S, const Epi& E, const int wave_id, const bool dry = false  ) {
    const int tid_ = (wave_id << 6) | fk_lane();
    const int tid = tid_, wid = __builtin_amdgcn_readfirstlane(tid >> 6), lane = tid & 63, wr = wid >> 2, wc = wid & 3, fr = lane & 15, fq = lane >> 4;
    const int nt = K / BK;
    int Rr[2], Cc[2]; unsigned voffB[2];
#pragma unroll
    for (int i = 0; i < 2; ++i) { int R, C; stage_rc(tid * 16 + i * 8192, R, C); Rr[i] = R; Cc[i] = C; const int Rb = Epi::PERM ? ((R & ~31) + perm32(R & 31)) : R; voffB[i] = (unsigned)(Rb * K + C) * 2u; }
    const size_t kstep = (size_t)(BK * 2);
    const size_t hstep = (size_t)HALF * K * 2;
    const unsigned ldsw = (unsigned)wid * 1024u;
    const int aoff = lds_byte(wr * 64 + fr, fq * 8), boff = lds_byte(wc * 32 + fr, fq * 8);
#define PG8_SA(b, h) (((b) * 2 + (h)) * HTB)
#define PG8_SB(b, h) ((4 + (b) * 2 + (h)) * HTB)
#define PG8_STAGE_B(bufoff, gbase) do { _Pragma("unroll") for (int _i = 0; _i < 2; ++_i) \
        __builtin_amdgcn_global_load_lds((const unsigned*)((const char*)(gbase) + voffB[_i]), (LAS unsigned*)(lds + (bufoff) + ldsw + _i * 8192), 16, 0, 0); } while (0)
#define PG8_STAGE_AX(base, bufoff, vo, h, koff) do { _Pragma("unroll") for (int _i = 0; _i < 2; ++_i) \
        __builtin_amdgcn_global_load_lds((const unsigned*)((base) + (size_t)(vo)[h][_i] + (size_t)(koff)), (LAS unsigned*)(lds + (bufoff) + ldsw + _i * 8192), 16, 0, 0); } while (0)
#define PG8_STAGE_A(bufoff, vo, h, koff) PG8_STAGE_AX(Ab, bufoff, vo, h, koff)
#define PG8_LDA(dst, b, h) do { _Pragma("unroll") for (int m = 0; m < 4; ++m) _Pragma("unroll") for (int k = 0; k < 2; ++k) dst[m][k] = *(const LAS bf16x8*)(lds + PG8_SA(b, h) + aoff + m * 2048 + k * 1024); } while (0)
#define PG8_LDB(dst, b, h) do { _Pragma("unroll") for (int n = 0; n < 2; ++n) _Pragma("unroll") for (int k = 0; k < 2; ++k) dst[n][k] = *(const LAS bf16x8*)(lds + PG8_SB(b, h) + boff + n * 2048 + k * 1024); } while (0)
#define PG8_MMA(ai, bj, At, Bt) do { __builtin_amdgcn_s_setprio(1); _Pragma("unroll") for (int m = 0; m < 4; ++m) _Pragma("unroll") for (int n = 0; n < 2; ++n) _Pragma("unroll") for (int k = 0; k < 2; ++k) \
        acc[ai][bj][m][n] = __builtin_amdgcn_mfma_f32_16x16x32_bf16(Bt[n][k], At[m][k], acc[ai][bj][m][n], 0, 0, 0); __builtin_amdgcn_s_setprio(0); } while (0)
#define PG8_WAIT_V(n) asm volatile("s_waitcnt vmcnt(" #n ")" ::: "memory")
#define PG8_WAIT_L(n) asm volatile("s_waitcnt lgkmcnt(" #n ")" ::: "memory")
#define PG8_BAR __builtin_amdgcn_s_barrier()
#define PG8_SCHED __builtin_amdgcn_sched_barrier(0)
    Unit cur, nxt; int ui = 0;
    if (!S.next(0, cur)) return;
    f32x4 acc[2][2][4][2];
#pragma unroll
    for (int a = 0; a < 2; ++a)
#pragma unroll
        for (int b = 0; b < 2; ++b)
#pragma unroll
            for (int m = 0; m < 4; ++m)
#pragma unroll
                for (int n = 0; n < 2; ++n) acc[a][b][m][n] = (f32x4){0.f, 0.f, 0.f, 0.f};
    bf16x8 At[4][2], B0[2][2], B1[2][2];
    const char* Ab = S.a_base();
    const char* pfb = (const char*)E.pf_base();
    unsigned cvA[2][2], nvA[2][2];
    S.a_voff(cur, cvA, Rr, Cc);
    const char* cB = S.b_base(cur);
    PG8_STAGE_B(PG8_SB(0, 0), cB); PG8_STAGE_B(PG8_SB(0, 1), cB + hstep); PG8_STAGE_A(PG8_SA(0, 0), cvA, 0, 0); PG8_STAGE_A(PG8_SA(0, 1), cvA, 1, 0);
    if (wr == 1) PG8_BAR;
    PG8_WAIT_V(2); PG8_BAR;
    PG8_STAGE_B(PG8_SB(1, 0), cB + kstep); PG8_STAGE_A(PG8_SA(1, 0), cvA, 0, kstep); PG8_STAGE_B(PG8_SB(1, 1), cB + hstep + kstep);
    PG8_WAIT_V(6); PG8_BAR;
    for (;;) {
        const bool has_next = S.next(ui + 1, nxt);
        const char* nB = has_next ? S.b_base(nxt) : cB;
        if (has_next) S.a_voff(nxt, nvA, Rr, Cc);
        else {
#pragma unroll
            for (int h = 0; h < 2; ++h)
#pragma unroll
                for (int i = 0; i < 2; ++i) nvA[h][i] = cvA[h][i];
        }
#pragma unroll 1
        for (int t = 0; t < nt; t += 2) {
            const bool last = (t == nt - 2);
            if constexpr (Epi::HAS_MID) { if (t == Epi::MID_T) E.mid(acc, cur, wr, wc, fr, fq); }
            const size_t k1 = (size_t)(t + 1) * kstep;
            unsigned a2[2][2];
#pragma unroll
            for (int h = 0; h < 2; ++h)
#pragma unroll
                for (int i = 0; i < 2; ++i) a2[h][i] = last ? nvA[h][i] : cvA[h][i] + (unsigned)((t + 2) * (BK * 2));
            const bool fin = FK_NODUMMY && last && !has_next;
            const bool pfl = FK_PFR && last && !has_next && pfb != nullptr;
            if (pfl) {
#pragma unroll
                for (int h = 0; h < 2; ++h)
#pragma unroll
                    for (int i = 0; i < 2; ++i) a2[h][i] = cvA[h][i] + (unsigned)((cur.pn * BM + 128) * 2);
            }
            const char* Ab2 = pfl ? pfb : Ab;
            const char* b2 = pfl ? pfb + ((size_t)cur.pm * BM * K + (size_t)cur.pn * BM) * 2 : (last ? nB : cB + (size_t)(t + 2) * kstep);
            const char* b3 = b2 + kstep;
            PG8_LDB(B0, 0, 0); PG8_LDB(B1, 0, 1); PG8_SCHED; PG8_LDA(At, 0, 0); PG8_STAGE_A(PG8_SA(1, 1), cvA, 1, k1);
            PG8_WAIT_V(8); PG8_WAIT_L(0); PG8_BAR; PG8_MMA(0, 0, At, B0); PG8_MMA(0, 1, At, B1); PG8_BAR; PG8_SCHED;
            PG8_LDA(At, 0, 1); if (!fin) { PG8_STAGE_B(PG8_SB(0, 0), b2); PG8_STAGE_B(PG8_SB(0, 1), b2 + hstep); PG8_STAGE_AX(Ab2, PG8_SA(0, 0), a2, 0, 0); }
            if (fin) PG8_WAIT_V(2); else PG8_WAIT_V(8);
            PG8_WAIT_L(0); PG8_BAR; PG8_MMA(1, 0, At, B0); PG8_MMA(1, 1, At, B1); PG8_BAR; PG8_SCHED;
            PG8_LDB(B0, 1, 0); PG8_LDB(B1, 1, 1); PG8_SCHED; PG8_LDA(At, 1, 0); if (!fin) PG8_STAGE_AX(Ab2, PG8_SA(0, 1), a2, 1, 0);
            if (fin) PG8_WAIT_V(0); else PG8_WAIT_V(8);
            PG8_WAIT_L(0); PG8_BAR; PG8_MMA(0, 0, At, B0); PG8_MMA(0, 1, At, B1); PG8_BAR; PG8_SCHED;
            PG8_LDA(At, 1, 1); if (!fin) { PG8_STAGE_B(PG8_SB(1, 0), b3); PG8_STAGE_B(PG8_SB(1, 1), b3 + hstep); PG8_STAGE_AX(Ab2, PG8_SA(1, 0), a2, 0, kstep); }
            if (fin) PG8_WAIT_V(0); else PG8_WAIT_V(8);
            PG8_WAIT_L(0); PG8_BAR; PG8_MMA(1, 0, At, B0); PG8_MMA(1, 1, At, B1); PG8_BAR; PG8_SCHED;
        }
        if constexpr (ALIGN_EPI) { if (wr == 0) PG8_BAR; }
        if (!dry) E(acc, cur, wr, wc, fr, fq);
        if (!has_next) break;
#pragma unroll
        for (int a = 0; a < 2; ++a)
#pragma unroll
            for (int b = 0; b < 2; ++b)
#pragma unroll
                for (int m = 0; m < 4; ++m)
#pragma unroll
                    for (int n = 0; n < 2; ++n) acc[a][b][m][n] = (f32x4){0.f, 0.f, 0.f, 0.f};
        cur = nxt; cB = nB; ++ui;
#pragma unroll
        for (int h = 0; h < 2; ++h)
#pragma unroll
            for (int i = 0; i < 2; ++i) cvA[h][i] = nvA[h][i];
        if constexpr (ALIGN_EPI) { if (wr == 1) PG8_BAR; }
    }
    PG8_WAIT_V(0);
    if constexpr (!ALIGN_EPI) { if (wr == 0) PG8_BAR; }
    PG8_BAR;
#undef PG8_SA
#undef PG8_SB
#undef PG8_STAGE_A
#undef PG8_STAGE_AX
#undef PG8_STAGE_B
#undef PG8_LDA
#undef PG8_LDB
#undef PG8_MMA
#undef PG8_WAIT_V
#undef PG8_WAIT_L
#undef PG8_BAR
#undef PG8_SCHED
}

struct FillReq { const float* W; int N, k0, n0; LAS unsigned char* dst; };
__device__ __forceinline__ void fill_dma_raw(const FillReq& f, int lane) {
    const int kr = lane >> 4, nq = lane & 15;
#pragma unroll
    for (int i = 0; i < 16; ++i) __builtin_amdgcn_global_load_lds((const unsigned*)(f.W + (size_t)(f.k0 + 16 * kr + i) * f.N + f.n0 + 4 * nq), (LAS unsigned*)(f.dst + i * 1024), 16, 0, 0);
}
typedef f32x4 Acc[2][2][4][2];
__device__ __forceinline__ u32x4 pack8(const f32x4 a, const f32x4 b) { u32x4 w; w.x = cvt_pk_bf16(a[0], a[1]); w.y = cvt_pk_bf16(a[2], a[3]); w.z = cvt_pk_bf16(b[0], b[1]); w.w = cvt_pk_bf16(b[2], b[3]); return w; }

struct EpiPlain {
    static constexpr bool PERM = true, HAS_MID = false; static constexpr int MID_T = 0;
    bf16_t* O; int ldc; int use_aux; const LAS int* cntp;
    __device__ __forceinline__ const void* pf_base() const { return nullptr; }
    __device__ __forceinline__ void mid(Acc&, const Unit&, int, int, int, int) const {}
    __device__ __forceinline__ void operator()(const Acc& acc, const Unit& u, int wr, int wc, int fr, int fq) const {
        const int row0 = (use_aux ? u.aux : u.pm * BM) + wr * 64 + fr, col0 = u.pn * BM + wc * 32 + 8 * fq;
        const int lim = (FK_PADSKIP && cntp) ? cntp[u.e] - (u.pm * BM + wr * 64 + fr) : 0x7fffffff;
#pragma unroll
        for (int ai = 0; ai < 2; ++ai)
#pragma unroll
            for (int m = 0; m < 4; ++m) { bf16_t* rowp = O + (size_t)(row0 + ai * HALF + m * 16) * ldc + col0;
                if (ai * HALF + m * 16 < lim) {
#pragma unroll
                for (int bj = 0; bj < 2; ++bj) st16(rowp + bj * HALF, pack8(acc[ai][bj][m][0], acc[ai][bj][m][1])); } }
    }
};

struct EpiIn {
    static constexpr bool PERM = true, HAS_MID = false; static constexpr int MID_T = 0;
    const float* xpart; const float* qn; const float* kn;
    bf16_t *qb, *kb, *vb, *ub, *vsb, *gab; float* vspart;
    __device__ __forceinline__ const void* pf_base() const { return nullptr; }
    __device__ __forceinline__ void mid(Acc&, const Unit&, int, int, int, int) const {}
    __device__ __forceinline__ void operator()(const Acc& acc, const Unit& u, int wr, int wc, int fr, int fq) const {
        const int pn = u.pn;
        float rsv[2][4];
        { int rowb = u.pm * BM + wr * 64 + fr; asm volatile("" : "+v"(rowb));
          f32x4 xq[2][4];
#pragma unroll
          for (int ai = 0; ai < 2; ++ai)
#pragma unroll
              for (int m = 0; m < 4; ++m) xq[ai][m] = *(const f32x4*)(xpart + (size_t)(rowb + ai * HALF + m * 16) * 16 + 4 * fq);
#pragma unroll
          for (int ai = 0; ai < 2; ++ai)
#pragma unroll
              for (int m = 0; m < 4; ++m) { const float s_ = sum_xor16_32((xq[ai][m][0] + xq[ai][m][1]) + (xq[ai][m][2] + xq[ai][m][3])); rsv[ai][m] = fast_rsq(s_ * (1.f / D) + EPS); } }
        f32x4 gqk[2][2];
        if (FK_GQK && pn < 4) { const float* gn_ = pn < 2 ? qn : kn;
#pragma unroll
            for (int bj = 0; bj < 2; ++bj) { gqk[bj][0] = *(const f32x4*)(gn_ + 32 * bj + 8 * fq); gqk[bj][1] = *(const f32x4*)(gn_ + 32 * bj + 8 * fq + 4); } }
#pragma unroll
        for (int ai = 0; ai < 2; ++ai)
#pragma unroll
            for (int m = 0; m < 4; ++m) {
                const int row = u.pm * BM + ai * HALF + wr * 64 + m * 16 + fr;
                const float rs = rsv[ai][m];
                f32x4 v[2][2];
#pragma unroll
                for (int bj = 0; bj < 2; ++bj)
#pragma unroll
                    for (int n = 0; n < 2; ++n) v[bj][n] = acc[ai][bj][m][n] * rs;
                if (pn < 4) {
                    float ss = 0.f;
#pragma unroll
                    for (int bj = 0; bj < 2; ++bj)
#pragma unroll
                        for (int n = 0; n < 2; ++n) ss += (v[bj][n][0] * v[bj][n][0] + v[bj][n][1] * v[bj][n][1]) + (v[bj][n][2] * v[bj][n][2] + v[bj][n][3] * v[bj][n][3]);
                    ss = sum_xor16_32(ss);
                    const bool isq = pn < 2;
                    const float sc = fast_rsq(ss * (1.f / 64.f) + EPS) * (isq ? 0.125f * LOG2E : 1.f);
                    const float* gn = isq ? qn : kn; bf16_t* O = isq ? qb : kb;
                    const int head = 4 * (pn & 1) + wc;
#pragma unroll
                    for (int bj = 0; bj < 2; ++bj) {
                        const f32x4 g0 = FK_GQK ? gqk[bj][0] : *(const f32x4*)(gn + 32 * bj + 8 * fq), g1 = FK_GQK ? gqk[bj][1] : *(const f32x4*)(gn + 32 * bj + 8 * fq + 4);
                        st16wt(O + (size_t)row * 512 + head * 64 + 32 * bj + 8 * fq, pack8(v[bj][0] * sc * g0, v[bj][1] * sc * g1));
                    }
                } else {
                    const int colw = wc * 32 + 8 * fq;
                    if (pn < 6) {
#pragma unroll
                        for (int bj = 0; bj < 2; ++bj) st16wt(vb + (size_t)row * 512 + (pn - 4) * BM + bj * HALF + colw, pack8(v[bj][0], v[bj][1]));
                    } else if (pn < 10) {
                        float ss = 0.f;
#pragma unroll
                        for (int bj = 0; bj < 2; ++bj)
#pragma unroll
                            for (int n = 0; n < 2; ++n)
#pragma unroll
                                for (int i = 0; i < 4; ++i) { const float gv = gelu_tanh_f(v[bj][n][i]); v[bj][n][i] = gv; ss += gv * gv; }
                        if (pn < 8) {
#pragma unroll
                            for (int bj = 0; bj < 2; ++bj) st16wt(ub + (size_t)row * 512 + (pn - 6) * BM + bj * HALF + colw, pack8(v[bj][0], v[bj][1]));
                        } else {
#pragma unroll
                            for (int bj = 0; bj < 2; ++bj) st16wt(vsb + (size_t)row * 512 + (pn - 8) * BM + bj * HALF + colw, pack8(v[bj][0], v[bj][1]));
                            ss = sum_xor16_32(ss);
                            if (fq == 0) vspart[(size_t)row * 8 + (pn - 8) * 4 + wc] = ss;
                        }
                    } else {
#pragma unroll
                        for (int n = 0; n < 2; ++n)
#pragma unroll
                            for (int i = 0; i < 4; ++i) {
#if !FK_RAWG
#if FK_GFOLD
                                const float rsn = -LOG2E * rs;
                                const float ea = fast_exp2(acc[ai][0][m][n][i] * rsn), d = fminf(1.f + fast_exp2(acc[ai][1][m][n][i] * rsn), 1e13f);
#else
                                const float ea = fast_exp2(-LOG2E * v[0][n][i]), d = fminf(1.f + fast_exp2(-LOG2E * v[1][n][i]), 1e13f);
#endif
                                v[0][n][i] = d * fast_rcp(1.f + ea); v[1][n][i] = fast_rcp(d);
#endif
                            }
                        st16wt(gab + (size_t)row * 2048 + (pn - 10) * HALF + colw, pack8(v[0][0], v[0][1]));
                        st16wt(gab + (size_t)row * 2048 + 1024 + (pn - 10) * HALF + colw, pack8(v[1][0], v[1][1]));
                    }
                }
            }
    }
};

struct EpiUp {
    static constexpr bool PERM = true, HAS_MID = true; static constexpr int MID_T = 8;
    const bf16_t* gab; bf16_t* mg; FillReq fill;
    __device__ __forceinline__ const void* pf_base() const { return nullptr; }
    __device__ __forceinline__ void mid(Acc& acc, const Unit& u, int wr, int wc, int fr, int fq) const {
        int row0 = u.pm * BM + wr * 64 + fr; const int col0 = u.pn * BM + wc * 32 + 8 * fq; asm volatile("" : "+v"(row0));
#if FK_RAWG
#pragma unroll
        for (int am = 0; am < 4; ++am) {
            const int ai = am >> 1, mb = (am & 1) * 2;
            u32x4 ga[2][2], gb[2][2];
#pragma unroll
            for (int mm = 0; mm < 2; ++mm) { const bf16_t* gp = gab + (size_t)(row0 + ai * HALF + (mb + mm) * 16) * 2048 + col0;
#pragma unroll
                for (int bj = 0; bj < 2; ++bj) { ga[mm][bj] = *(const u32x4*)(gp + bj * HALF); gb[mm][bj] = *(const u32x4*)(gp + 1024 + bj * HALF); } }
#pragma unroll
            for (int mm = 0; mm < 2; ++mm)
#pragma unroll
                for (int bj = 0; bj < 2; ++bj)
#pragma unroll
                    for (int j = 0; j < 4; ++j) {
                        const float r0 = fminf(1.f + fast_exp2(-LOG2E * bf_lo(gb[mm][bj][j])), 1e13f) * fast_rcp(1.f + fast_exp2(-LOG2E * bf_lo(ga[mm][bj][j])));
                        const float r1 = fminf(1.f + fast_exp2(-LOG2E * bf_hi(gb[mm][bj][j])), 1e13f) * fast_rcp(1.f + fast_exp2(-LOG2E * bf_hi(ga[mm][bj][j])));
                        acc[ai][bj][mb + mm][j >> 1][(j & 1) * 2] *= r0; acc[ai][bj][mb + mm][j >> 1][(j & 1) * 2 + 1] *= r1; }
            asm volatile("" ::: "memory");
        }
    }
#else
#if FK_MID16
        { u32x4 ga[2][4][2];
#pragma unroll
          for (int ai = 0; ai < 2; ++ai)
#pragma unroll
            for (int m = 0; m < 4; ++m) { const bf16_t* gp = gab + (size_t)(row0 + ai * HALF + m * 16) * 2048 + col0;
#pragma unroll
                for (int bj = 0; bj < 2; ++bj) ga[ai][m][bj] = *(const u32x4*)(gp + bj * HALF); }
#pragma unroll
          for (int ai = 0; ai < 2; ++ai)
#pragma unroll
            for (int m = 0; m < 4; ++m)
#pragma unroll
                for (int bj = 0; bj < 2; ++bj)
#pragma unroll
                    for (int j = 0; j < 4; ++j) { acc[ai][bj][m][j >> 1][(j & 1) * 2] *= bf_lo(ga[ai][m][bj][j]); acc[ai][bj][m][j >> 1][(j & 1) * 2 + 1] *= bf_hi(ga[ai][m][bj][j]); }
          asm volatile("" ::: "memory"); }
#else
#pragma unroll
        for (int ai = 0; ai < 2; ++ai) {
            u32x4 ga[4][2];
#pragma unroll
            for (int m = 0; m < 4; ++m) { const bf16_t* gp = gab + (size_t)(row0 + ai * HALF + m * 16) * 2048 + col0;
#pragma unroll
                for (int bj = 0; bj < 2; ++bj) ga[m][bj] = *(const u32x4*)(gp + bj * HALF); }
#pragma unroll
            for (int m = 0; m < 4; ++m)
#pragma unroll
                for (int bj = 0; bj < 2; ++bj)
#pragma unroll
                    for (int j = 0; j < 4; ++j) { acc[ai][bj][m][j >> 1][(j & 1) * 2] *= bf_lo(ga[m][bj][j]); acc[ai][bj][m][j >> 1][(j & 1) * 2 + 1] *= bf_hi(ga[m][bj][j]); }
            asm volatile("" ::: "memory");
        }
#endif
    }
#endif
    __device__ __forceinline__ void operator()(const Acc& acc, const Unit& u, int wr, int wc, int fr, int fq) const {
        int row0 = u.pm * BM + wr * 64 + fr; const int col0 = u.pn * BM + wc * 32 + 8 * fq; asm volatile("" : "+v"(row0));
        u32x4 gb[2][4][2];
#pragma unroll
        for (int ai = 0; ai < 2; ++ai)
#pragma unroll
            for (int m = 0; m < 4; ++m)
#pragma unroll
                for (int bj = 0; bj < 2; ++bj) gb[ai][m][bj] = *(const u32x4*)(gab + (size_t)(row0 + ai * HALF + m * 16) * 2048 + 1024 + col0 + bj * HALF);
        if (fill.W) fill_dma_raw(fill, fk_lane());
#pragma unroll
        for (int ai = 0; ai < 2; ++ai)
#pragma unroll
            for (int m = 0; m < 4; ++m) { const size_t ro = (size_t)(row0 + ai * HALF + m * 16);
#pragma unroll
                for (int bj = 0; bj < 2; ++bj) { const u32x4 b = gb[ai][m][bj];
                    f32x4 o0, o1;
#if FK_RAWG
#define FK_SB(x) fast_rcp(fminf(1.f + fast_exp2(-LOG2E * (x)), 1e13f))
#else
#define FK_SB(x) (x)
#endif
                    o0[0] = acc[ai][bj][m][0][0] * FK_SB(bf_lo(b[0])); o0[1] = acc[ai][bj][m][0][1] * FK_SB(bf_hi(b[0])); o0[2] = acc[ai][bj][m][0][2] * FK_SB(bf_lo(b[1])); o0[3] = acc[ai][bj][m][0][3] * FK_SB(bf_hi(b[1]));
                    o1[0] = acc[ai][bj][m][1][0] * FK_SB(bf_lo(b[2])); o1[1] = acc[ai][bj][m][1][1] * FK_SB(bf_hi(b[2])); o1[2] = acc[ai][bj][m][1][2] * FK_SB(bf_lo(b[3])); o1[3] = acc[ai][bj][m][1][3] * FK_SB(bf_hi(b[3]));
#undef FK_SB
                    st16o(mg + ro * 1024 + col0 + bj * HALF, pack8(o0, o1)); } }
    }
};

struct EpiOut {
    static constexpr bool PERM = true, HAS_MID = false; static constexpr int MID_T = 0;
    const bf16_t* xin; bf16_t* xout; FillReq fill;
    __device__ __forceinline__ const void* pf_base() const { return xin; }
    __device__ __forceinline__ void mid(Acc&, const Unit&, int, int, int, int) const {}
    __device__ __forceinline__ void operator()(const Acc& acc, const Unit& u, int wr, int wc, int fr, int fq) const {
        int row0 = u.pm * BM + wr * 64 + fr; const int col0 = u.pn * BM + wc * 32 + 8 * fq; asm volatile("" : "+v"(row0));
        u32x4 xv[2][4][2];
#pragma unroll
        for (int ai = 0; ai < 2; ++ai)
#pragma unroll
            for (int m = 0; m < 4; ++m)
#pragma unroll
                for (int bj = 0; bj < 2; ++bj) xv[ai][m][bj] = *(const u32x4*)(xin + (size_t)(row0 + ai * HALF + m * 16) * D + col0 + bj * HALF);
        if (fill.W) fill_dma_raw(fill, fk_lane());
#pragma unroll
        for (int ai = 0; ai < 2; ++ai)
#pragma unroll
            for (int m = 0; m < 4; ++m)
#pragma unroll
                for (int bj = 0; bj < 2; ++bj) { const u32x4 xo = xv[ai][m][bj]; f32x4 o0, o1;
                    o0[0] = bf_lo(xo[0]) + acc[ai][bj][m][0][0]; o0[1] = bf_hi(xo[0]) + acc[ai][bj][m][0][1]; o0[2] = bf_lo(xo[1]) + acc[ai][bj][m][0][2]; o0[3] = bf_hi(xo[1]) + acc[ai][bj][m][0][3];
                    o1[0] = bf_lo(xo[2]) + acc[ai][bj][m][1][0]; o1[1] = bf_hi(xo[2]) + acc[ai][bj][m][1][1]; o1[2] = bf_lo(xo[3]) + acc[ai][bj][m][1][2]; o1[3] = bf_hi(xo[3]) + acc[ai][bj][m][1][3];
                    st16o(xout + (size_t)(row0 + ai * HALF + m * 16) * D + col0 + bj * HALF, pack8(o0, o1)); }
    }
};

struct EpiG1 {
    static constexpr bool PERM = true, HAS_MID = false; static constexpr int MID_T = 0;
    const LAS int* pref; const float* rs2s; bf16_t* Gb;
    __device__ __forceinline__ const void* pf_base() const { return nullptr; }
    __device__ __forceinline__ void mid(Acc&, const Unit&, int, int, int, int) const {}
    __device__ __forceinline__ void operator()(const Acc& acc, const Unit& u, int wr, int wc, int fr, int fq) const {
        const int ce = pref[40 + u.e];
        float rsv[2][4];
#pragma unroll
        for (int ai = 0; ai < 2; ++ai)
#pragma unroll
            for (int m = 0; m < 4; ++m) { const int r = u.pm * BM + ai * HALF + wr * 64 + m * 16 + fr;  const float v_ = rs2s[u.e * ECAP + r]; rsv[ai][m] = (r < ce) ? v_ : 0.f; }
#pragma unroll
        for (int ai = 0; ai < 2; ++ai)
#pragma unroll
            for (int m = 0; m < 4; ++m) {
                const int rl = ai * HALF + wr * 64 + m * 16 + fr;
                const float rs = rsv[ai][m];
                f32x4 o[2];
#pragma unroll
                for (int n = 0; n < 2; ++n)
#pragma unroll
                    for (int i = 0; i < 4; ++i) { const float g = acc[ai][0][m][n][i] * rs, up = acc[ai][1][m][n][i] * rs; o[n][i] = g * sigmoid_f(g) * up; }
                st16(Gb + (size_t)(u.aux + rl) * 512 + u.pn * HALF + wc * 32 + 8 * fq, pack8(o[0], o[1]));
            }
    }
};

struct EpiPle {
    static constexpr bool PERM = true, HAS_MID = false; static constexpr int MID_T = 0;
    const bf16_t* xin; bf16_t* xout; float* fout; const bf16_t* Eb; const float* rs3; float* xpart;
    __device__ __forceinline__ const void* pf_base() const { return xin; }
    __device__ __forceinline__ void mid(Acc&, const Unit&, int, int, int, int) const {}
    struct Bt { u32x4 xv[2][2], ev[2][2]; float rs[2]; };
    __device__ __forceinline__ void ld(Bt& b, int row0, int col0, int k) const {
#pragma unroll
        for (int mm = 0; mm < 2; ++mm) { const int row = row0 + (k >> 1) * HALF + ((k & 1) * 2 + mm) * 16; b.rs[mm] = rs3[row];
#pragma unroll
            for (int bj = 0; bj < 2; ++bj) { b.xv[mm][bj] = *(const u32x4*)(xin + (size_t)row * D + col0 + bj * HALF); b.ev[mm][bj] = *(const u32x4*)(Eb + (size_t)row * D + col0 + bj * HALF); } }
    }
    __device__ __forceinline__ void fin(const Bt& b, const Acc& acc, const Unit& u, int row0, int col0, int k, int wc, int fq) const {
        const int ai = k >> 1, mb = (k & 1) * 2;
#pragma unroll
        for (int mm = 0; mm < 2; ++mm) { const int row = row0 + ai * HALF + (mb + mm) * 16; const float rs = b.rs[mm]; float ss = 0.f;
#pragma unroll
            for (int bj = 0; bj < 2; ++bj) { const u32x4 xo = b.xv[mm][bj], e = b.ev[mm][bj]; f32x4 o[2];
#pragma unroll
                for (int j = 0; j < 4; ++j) { o[j >> 1][(j & 1) * 2] = bf_lo(xo[j]) + sigmoid_f(acc[ai][bj][mb + mm][j >> 1][(j & 1) * 2] * rs) * bf_lo(e[j]);
                                              o[j >> 1][(j & 1) * 2 + 1] = bf_hi(xo[j]) + sigmoid_f(acc[ai][bj][mb + mm][j >> 1][(j & 1) * 2 + 1] * rs) * bf_hi(e[j]); }
                const u32x4 w = pack8(o[0], o[1]);
#pragma unroll
                for (int j = 0; j < 4; ++j) { const float a = bf_lo(w[j]), b_ = bf_hi(w[j]); ss += a * a + b_ * b_; }
                if (!FK_LASTSKIP || xout) st16o(xout + (size_t)row * D + col0 + bj * HALF, w);
                if (fout) { *(f32x4*)(fout + (size_t)row * D + col0 + bj * HALF) = o[0]; *(f32x4*)(fout + (size_t)row * D + col0 + bj * HALF + 4) = o[1]; } }
            ss = sum_xor16_32(ss);
            if (fq == 0 && (!FK_LASTSKIP || xout)) xpart[(size_t)row * 16 + u.pn * 4 + wc] = ss; }
    }
    __device__ __forceinline__ void operator()(const Acc& acc, const Unit& u, int wr, int wc, int fr, int fq) const {
        int row0 = u.pm * BM + wr * 64 + fr; const int col0 = u.pn * BM + wc * 32 + 8 * fq; asm volatile("" : "+v"(row0));
        Bt b0, b1;
        ld(b0, row0, col0, 0); ld(b1, row0, col0, 1);
        fin(b0, acc, u, row0, col0, 0, wc, fq); asm volatile("" ::: "memory"); ld(b0, row0, col0, 2);
        fin(b1, acc, u, row0, col0, 1, wc, fq); asm volatile("" ::: "memory"); ld(b1, row0, col0, 3);
        fin(b0, acc, u, row0, col0, 2, wc, fq); asm volatile("" ::: "memory");
        fin(b1, acc, u, row0, col0, 3, wc, fq);
    }
};
__device__ __forceinline__ int crow(int r, int hi) { return (r & 3) + 8 * (r >> 2) + 4 * hi; }
__device__ __forceinline__ unsigned cvtpk_s(float lo, float hi) { typedef __bf16 bf16x2_t __attribute__((ext_vector_type(2))); f32x2 v = {lo, hi}; bf16x2_t b = __builtin_convertvector(v, bf16x2_t); return __builtin_bit_cast(unsigned, b); }
#define FK_SBAR() __builtin_amdgcn_sched_barrier(0)
__device__ __forceinline__ void pv(f32x16* o, int vb, bf16x8 pa0, bf16x8 pa1, bf16x8 pa2, bf16x8 pa3) {
    s16x4 lo[2][4], hi[2][4];
#pragma unroll
    for (int d0 = 0; d0 < 2; ++d0)
#pragma unroll
        for (int ks = 0; ks < 4; ++ks) {
            asm volatile("ds_read_b64_tr_b16 %0,%1 offset:%c2" : "=&v"(lo[d0][ks]) : "v"(vb), "i"(d0 * 4096 + ks * 1024) : "memory");
            asm volatile("ds_read_b64_tr_b16 %0,%1 offset:%c2" : "=&v"(hi[d0][ks]) : "v"(vb), "i"(d0 * 4096 + ks * 1024 + 512) : "memory"); }
    asm volatile("s_waitcnt lgkmcnt(0)" ::: "memory"); FK_SBAR();
#if FK_APRIO
    __builtin_amdgcn_s_setprio(1);
#endif
#define FK_PK(d, k) (bf16x8){lo[d][k][0], lo[d][k][1], lo[d][k][2], lo[d][k][3], hi[d][k][0], hi[d][k][1], hi[d][k][2], hi[d][k][3]}
    o[0] = __builtin_amdgcn_mfma_f32_32x32x16_bf16(pa0, FK_PK(0, 0), o[0], 0, 0, 0); o[1] = __builtin_amdgcn_mfma_f32_32x32x16_bf16(pa0, FK_PK(1, 0), o[1], 0, 0, 0);
    o[0] = __builtin_amdgcn_mfma_f32_32x32x16_bf16(pa1, FK_PK(0, 1), o[0], 0, 0, 0); o[1] = __builtin_amdgcn_mfma_f32_32x32x16_bf16(pa1, FK_PK(1, 1), o[1], 0, 0, 0);
    o[0] = __builtin_amdgcn_mfma_f32_32x32x16_bf16(pa2, FK_PK(0, 2), o[0], 0, 0, 0); o[1] = __builtin_amdgcn_mfma_f32_32x32x16_bf16(pa2, FK_PK(1, 2), o[1], 0, 0, 0);
    o[0] = __builtin_amdgcn_mfma_f32_32x32x16_bf16(pa3, FK_PK(0, 3), o[0], 0, 0, 0); o[1] = __builtin_amdgcn_mfma_f32_32x32x16_bf16(pa3, FK_PK(1, 3), o[1], 0, 0, 0);
#undef FK_PK
#if FK_APRIO
    __builtin_amdgcn_s_setprio(0);
#endif
}
constexpr int WLDS_BYTES = 16384;

template <bool DIAG, int PROBE = 0>
__device__ __forceinline__ void attn_tile(const bf16x8 (&k0)[4], const bf16x8 (&k1)[4], const bf16x8 (&qr)[4], f32x16 (&o)[2], float& R, int s0, int tq, int hi, int vbase) {
    f32x16 p0 = f32x16{}, p1 = f32x16{};
#if FK_APRIO
    __builtin_amdgcn_s_setprio(1);
#endif
#pragma unroll
    for (int d0 = 0; d0 < 4; ++d0) { p0 = __builtin_amdgcn_mfma_f32_32x32x16_bf16(k0[d0], qr[d0], p0, 0, 0, 0); p1 = __builtin_amdgcn_mfma_f32_32x32x16_bf16(k1[d0], qr[d0], p1, 0, 0, 0); }
#if FK_APRIO
    __builtin_amdgcn_s_setprio(0);
#endif
    float kp[32], bt[32];
#pragma unroll
    for (int r = 0; r < 32; ++r) {
        const float z = r < 16 ? p0[r] : p1[r - 16];
        float k_, b_;
        if (PROBE == 3) { k_ = z * 1e-3f; b_ = 1.f - k_; }
        else { const float e = fast_exp2(z);
            k_ = fast_rcp(1.f + e); b_ = 1.f - k_; }
        if (DIAG) { const int kv = s0 + crow(r & 15, hi) + (r >> 4) * 32; if (!(kv < tq)) { k_ = 1.f; b_ = 0.f; } }
        kp[r] = k_; bt[r] = b_;
    }
    float pg[8], T[8], SP[8];
#pragma unroll
    for (int g = 0; g < 8; ++g) { const float gs = (kp[4 * g] * kp[4 * g + 1]) * (kp[4 * g + 2] * kp[4 * g + 3]); float lo_, hi_; halves32(gs, lo_, hi_); pg[g] = hi ? lo_ : hi_; T[g] = lo_ * hi_; }
    SP[7] = 1.f;
#pragma unroll
    for (int g = 6; g >= 0; --g) SP[g] = SP[g + 1] * T[g + 1];
    float a[32];
#pragma unroll
    for (int g = 0; g < 8; ++g) {
        const float base = R * SP[g] * (hi == 0 ? pg[g] : 1.f);
        const float a3 = base, a2 = a3 * kp[4 * g + 3], a1 = a2 * kp[4 * g + 2], a0 = a1 * kp[4 * g + 1];
        a[4 * g + 3] = bt[4 * g + 3] * a3; a[4 * g + 2] = bt[4 * g + 2] * a2; a[4 * g + 1] = bt[4 * g + 1] * a1; a[4 * g] = bt[4 * g] * a0;
    }
    R *= SP[0] * T[0];
    u32x4 pw0, pw1, pw2, pw3;
    pw0 = (u32x4){cvtpk_s(a[0], a[1]), cvtpk_s(a[2], a[3]), cvtpk_s(a[4], a[5]), cvtpk_s(a[6], a[7])};
    pw1 = (u32x4){cvtpk_s(a[8], a[9]), cvtpk_s(a[10], a[11]), cvtpk_s(a[12], a[13]), cvtpk_s(a[14], a[15])};
    pw2 = (u32x4){cvtpk_s(a[16], a[17]), cvtpk_s(a[18], a[19]), cvtpk_s(a[20], a[21]), cvtpk_s(a[22], a[23])};
    pw3 = (u32x4){cvtpk_s(a[24], a[25]), cvtpk_s(a[26], a[27]), cvtpk_s(a[28], a[29]), cvtpk_s(a[30], a[31])};
    if (PROBE == 9) asm volatile("s_waitcnt lgkmcnt(0)" ::: "memory");
    else asm volatile("s_waitcnt vmcnt(0) lgkmcnt(0)" ::: "memory");
    if (PROBE == 4) { o[0][0] += __uint_as_float(pw0[0] ^ pw1[1] ^ pw2[2] ^ pw3[3]); return; }
    pv(o, vbase, __builtin_bit_cast(bf16x8, pw0), __builtin_bit_cast(bf16x8, pw1), __builtin_bit_cast(bf16x8, pw2), __builtin_bit_cast(bf16x8, pw3));
}
__device__ __forceinline__ void attn_dma_v(const bf16_t* __restrict__ vb, long rowbase, int s0, int h, int lane, LAS unsigned char* wl) {
#pragma unroll
    for (int w8 = 0; w8 < 8; ++w8)
        __builtin_amdgcn_global_load_lds((const unsigned*)(vb + (size_t)(rowbase + s0 + 16 * (w8 & 3) + (lane >> 2)) * 512 + h * 64 + 32 * (w8 >> 2) + 8 * (lane & 3)), (LAS unsigned*)(wl + w8 * 1024), 16, 0, 0);
}
__device__ __forceinline__ void attn_dma_k(const bf16_t* __restrict__ kb, long rowbase, int s0, int h, int lane, LAS unsigned char* wl) {
#pragma unroll
    for (int c = 0; c < 8; ++c)
        __builtin_amdgcn_global_load_lds((const unsigned*)(kb + (size_t)(rowbase + s0 + lane) * 512 + h * 64 + 8 * c), (LAS unsigned*)(wl + 8192 + c * 1024), 16, 0, 0);
}
__device__ __forceinline__ void attn_read_k(bf16x8 (&k0)[4], bf16x8 (&k1)[4], LAS unsigned char* wl, int r32, int hi) {
    const LAS unsigned char* kp = wl + 8192 + hi * 1024 + r32 * 16;
#pragma unroll
    for (int d0 = 0; d0 < 4; ++d0) { k0[d0] = *(const LAS bf16x8*)(kp + d0 * 2048); k1[d0] = *(const LAS bf16x8*)(kp + d0 * 2048 + 512); }
}
template <int PROBE = 0>
__device__ __forceinline__ void attn_wave_unit(int b, int h, int qblk, const bf16_t* __restrict__ qb, const bf16_t* __restrict__ kb, const bf16_t* __restrict__ vb, bf16_t* __restrict__ oc, LAS unsigned char* wl, int lane) {
    const int r32 = lane & 31, hi = lane >> 5;
    const long rowbase = (long)b * SEQ; const int q0 = qblk * 32, tq = q0 + r32;
    bf16x8 qr[4];
    { const bf16_t* qp = qb + (size_t)(rowbase + q0 + r32) * 512 + h * 64 + hi * 8;
#pragma unroll
      for (int d0 = 0; d0 < 4; ++d0) qr[d0] = *(const bf16x8*)(qp + d0 * 16); }
    f32x16 o[2]; o[0] = f32x16{}; o[1] = f32x16{};
    float R = 1.f;
    const int vbase = (int)(unsigned)(uintptr_t)wl + ((lane >> 4) & 1) * 32 + (lane & 3) * 8 + (4 * hi + ((lane & 15) >> 2)) * 64;
    const int jd = q0 >> 6;
    bf16x8 k0[4], k1[4];
    attn_dma_k(kb, rowbase, jd * 64, h, lane, wl);
    attn_dma_v(vb, rowbase, jd * 64, h, lane, wl);
    asm volatile("s_waitcnt vmcnt(8)" ::: "memory");
    attn_read_k(k0, k1, wl, r32, hi);
    asm volatile("s_waitcnt lgkmcnt(0)" ::: "memory");
    attn_dma_k(kb, rowbase, (jd > 0 ? jd - 1 : 0) * 64, h, lane, wl);
    attn_tile<true, PROBE>(k0, k1, qr, o, R, jd * 64, tq, hi, vbase);
    for (int jt = jd - 1; jt >= 0; --jt) {
        if (PROBE ? (jt < jd - 2) : __all(R < 7.5e-37f)) break;
        attn_read_k(k0, k1, wl, r32, hi);
        if (PROBE != 2) attn_dma_v(vb, rowbase, jt * 64, h, lane, wl);
        asm volatile("s_waitcnt lgkmcnt(0)" ::: "memory");
        if (PROBE != 2) attn_dma_k(kb, rowbase, (jt > 0 ? jt - 1 : 0) * 64, h, lane, wl);
        attn_tile<false, PROBE>(k0, k1, qr, o, R, jt * 64, tq, hi, vbase);
    }
    if (PROBE) { asm volatile("s_waitcnt vmcnt(0) lgkmcnt(0)" ::: "memory"); if (o[0][0] == 1.2345e-30f && o[1][3] == 5.4321e-30f) oc[0] = 0; return; }
    asm volatile("s_waitcnt vmcnt(0)" ::: "memory");
    LAS bf16_t* stg = (LAS bf16_t*)(wl + 8192);
#pragma unroll
    for (int r = 0; r < 16; ++r) { const int orow = crow(r, hi);
#pragma unroll
        for (int d0 = 0; d0 < 2; ++d0) stg[orow * 64 + d0 * 32 + r32] = (bf16_t)(cvtpk_s(o[d0][r], 0.f) & 0xffffu); }
    asm volatile("s_waitcnt lgkmcnt(0)" ::: "memory");
    bf16_t* Ow = oc + (size_t)(rowbase + q0) * 1024 + h * 64;
#pragma unroll
    for (int i = 0; i < 4; ++i) { const int row = i * 8 + (lane >> 3), ch = lane & 7; const u32x4 v = *(const LAS u32x4*)(stg + row * 64 + ch * 8); *(u32x4*)(Ow + (size_t)row * 1024 + ch * 8) = v; }
    asm volatile("s_waitcnt lgkmcnt(0)" ::: "memory");
}

__device__ __forceinline__ void attn_block_dma(const bf16_t* __restrict__ kb, const bf16_t* __restrict__ vb, long rowbase, int T, int h, int wave, int lane, LAS unsigned char* buf) {
    __builtin_amdgcn_global_load_lds((const unsigned*)(kb + (size_t)(rowbase + T * 64 + lane) * 512 + h * 64 + 8 * wave), (LAS unsigned*)(buf + 8192 + wave * 1024), 16, 0, 0);
    __builtin_amdgcn_global_load_lds((const unsigned*)(vb + (size_t)(rowbase + T * 64 + 16 * (wave & 3) + (lane >> 2)) * 512 + h * 64 + 32 * (wave >> 2) + 8 * (lane & 3)), (LAS unsigned*)(buf + wave * 1024), 16, 0, 0);
}
struct AttnBU { int b, h, c; };
__device__ __forceinline__ void attn_block_begin(const AttnBU& u, bf16x8 (&qr)[4], const bf16_t* __restrict__ qb, const bf16_t* __restrict__ kb, const bf16_t* __restrict__ vb, LAS unsigned char* lds, int wave, int lane) {
    const int r32 = lane & 31, hi = lane >> 5; const long rowbase = (long)u.b * SEQ; const int q0 = u.c * 256 + wave * 32;
    const bf16_t* qp = qb + (size_t)(rowbase + q0 + r32) * 512 + u.h * 64 + hi * 8;
#pragma unroll
    for (int d0 = 0; d0 < 4; ++d0) qr[d0] = *(const bf16x8*)(qp + d0 * 16);
    attn_block_dma(kb, vb, rowbase, 4 * u.c + 3, u.h, wave, lane, lds);
}
template <int BP = 0>
__device__ __forceinline__ void attn_block_body(const AttnBU& u, const bf16x8 (&qr)[4], f32x16 (&o)[2], const bf16_t* __restrict__ kb, const bf16_t* __restrict__ vb, LAS unsigned char* lds, int wave, int lane) {
    const int r32 = lane & 31, hi = lane >> 5;
    const long rowbase = (long)u.b * SEQ; const int q0 = u.c * 256 + wave * 32, tq = q0 + r32, h = u.h;
    const int jd = q0 >> 6, Tmax = 4 * u.c + 3;
    LAS int* flg = (LAS int*)(lds + 65536);
    o[0] = f32x16{}; o[1] = f32x16{};
    float R = 1.f; bool done = false;
    const int vb0 = (int)(unsigned)(uintptr_t)lds + ((lane >> 4) & 1) * 32 + (lane & 3) * 8 + (4 * hi + ((lane & 15) >> 2)) * 64;
    asm volatile("s_waitcnt vmcnt(0)" ::: "memory");
    __builtin_amdgcn_s_barrier();
    int s = 0, it = 0;
    for (int T = Tmax; ; --T, s ^= 1, ++it) {
        LAS unsigned char* buf = lds + s * 16384;
        if (T > 0 && BP != 3) attn_block_dma(kb, vb, rowbase, T - 1, h, wave, lane, lds + (s ^ 1) * 16384);
        if (T <= jd && !done && BP != 2) {
            bf16x8 k0[4], k1[4];
            attn_read_k(k0, k1, buf, r32, hi);
            asm volatile("s_waitcnt lgkmcnt(0)" ::: "memory");
            if (T == jd) attn_tile<true, 9>(k0, k1, qr, o, R, T * 64, tq, hi, vb0 + s * 16384);
            else attn_tile<false, 9>(k0, k1, qr, o, R, T * 64, tq, hi, vb0 + s * 16384);
            done = __all(R < 7.5e-37f);
        }
        if (BP) done = (T <= jd - 2);
        asm volatile("s_waitcnt vmcnt(0)" ::: "memory");
        if (T > 4 * u.c) { __builtin_amdgcn_s_barrier(); continue; }
        const int want = (T > 0) && (T - 1 > jd || !done);
        if (lane == 0) flg[(it & 1) * 8 + wave] = want;
        asm volatile("s_waitcnt lgkmcnt(0)" ::: "memory");
        __builtin_amdgcn_s_barrier();
        const int f = flg[(it & 1) * 8 + (lane & 7)];
        if (!__any(f != 0)) break;
    }
}
__device__ __forceinline__ void attn_block_end(const AttnBU& u, const f32x16 (&o)[2], bf16_t* __restrict__ oc, LAS unsigned char* lds, int wave, int lane) {
    const int r32 = lane & 31, hi = lane >> 5; const long rowbase = (long)u.b * SEQ; const int q0 = u.c * 256 + wave * 32;
    LAS bf16_t* stg = (LAS bf16_t*)(lds + 32768 + wave * 4096);
#pragma unroll
    for (int r = 0; r < 16; ++r) { const int orow = crow(r, hi);
#pragma unroll
        for (int d0 = 0; d0 < 2; ++d0) stg[orow * 64 + d0 * 32 + r32] = (bf16_t)(cvtpk_s(o[d0][r], 0.f) & 0xffffu); }
    asm volatile("s_waitcnt lgkmcnt(0)" ::: "memory");
    bf16_t* Ow = oc + (size_t)(rowbase + q0) * 1024 + u.h * 64;
#pragma unroll
    for (int i = 0; i < 4; ++i) { const int row = i * 8 + (lane >> 3), ch = lane & 7; const u32x4 v = *(const LAS u32x4*)(stg + row * 64 + ch * 8); *(u32x4*)(Ow + (size_t)row * 1024 + ch * 8) = v; }
    asm volatile("s_waitcnt lgkmcnt(0)" ::: "memory");
}

#ifndef FK_WTEST
#define FK_WTEST 0
#endif
__device__ __forceinline__ void attn_win_begin(const AttnBU& u, bf16x8 (&qr)[4], const bf16_t* __restrict__ qb, const bf16_t* __restrict__ kb, const bf16_t* __restrict__ vb, LAS unsigned char* lds, int wave, int lane) {
    const int r32 = lane & 31, hi = lane >> 5; const long rowbase = (long)u.b * SEQ; const int q0 = u.c * 256 + wave * 32;
    const bf16_t* qp = qb + (size_t)(rowbase + q0 + r32) * 512 + u.h * 64 + hi * 8;
#pragma unroll
    for (int d0 = 0; d0 < 4; ++d0) qr[d0] = *(const bf16x8*)(qp + d0 * 16);
#pragma unroll
    for (int t = 0; t < 6; ++t) { const int T = 4 * u.c + 3 - t; if (T >= 0) attn_block_dma(kb, vb, rowbase, T, u.h, wave, lane, lds + t * 16384); }
}
__device__ __forceinline__ void attn_win_body(const AttnBU& u, const bf16x8 (&qr)[4], f32x16 (&o)[2], const bf16_t* __restrict__ kb, const bf16_t* __restrict__ vb, LAS unsigned char* lds, int wave, int lane) {
    const int r32 = lane & 31, hi = lane >> 5;
    const long rowbase = (long)u.b * SEQ; const int q0 = u.c * 256 + wave * 32, tq = q0 + r32, h = u.h;
    const int jd = q0 >> 6, Tmax = 4 * u.c + 3, Tlow = u.c > 0 ? 4 * u.c - 2 + FK_WTEST : 0;
    LAS int* flg = (LAS int*)(lds + 131072);
    o[0] = f32x16{}; o[1] = f32x16{};
    float R = 1.f; bool done = false;
    const int vb0 = (int)(unsigned)(uintptr_t)lds + ((lane >> 4) & 1) * 32 + (lane & 3) * 8 + (4 * hi + ((lane & 15) >> 2)) * 64;
    if (u.c > 0) asm volatile("s_waitcnt vmcnt(4)" ::: "memory"); else asm volatile("s_waitcnt vmcnt(0)" ::: "memory");
    __builtin_amdgcn_s_barrier();
    { bf16x8 k0[4], k1[4]; const int sl = Tmax - jd;
      attn_read_k(k0, k1, lds + sl * 16384, r32, hi);
      asm volatile("s_waitcnt lgkmcnt(0)" ::: "memory");
      attn_tile<true, 9>(k0, k1, qr, o, R, jd * 64, tq, hi, vb0 + sl * 16384);
      done = __all(R < 7.5e-37f); }
    asm volatile("s_waitcnt vmcnt(0)" ::: "memory");
    __builtin_amdgcn_s_barrier();
    for (int T = jd - 1; T >= Tlow && !done; --T) { bf16x8 k0[4], k1[4]; const int sl = Tmax - T;
        attn_read_k(k0, k1, lds + sl * 16384, r32, hi);
        asm volatile("s_waitcnt lgkmcnt(0)" ::: "memory");
        attn_tile<false, 9>(k0, k1, qr, o, R, T * 64, tq, hi, vb0 + sl * 16384);
        done = __all(R < 7.5e-37f); }
    int s = 0, it = 0;
    for (int T = Tlow - 1; ; --T, s ^= 1, ++it) {
        const int want = (T >= 0) && !done;
        if (lane == 0) flg[(it & 1) * 8 + wave] = want;
        asm volatile("s_waitcnt lgkmcnt(0)" ::: "memory");
        __builtin_amdgcn_s_barrier();
        const int f = flg[(it & 1) * 8 + (lane & 7)];
        if (!__any(f != 0)) break;
        attn_block_dma(kb, vb, rowbase, T, h, wave, lane, lds + s * 16384);
        asm volatile("s_waitcnt vmcnt(0)" ::: "memory");
        __builtin_amdgcn_s_barrier();
        if (!done) { bf16x8 k0[4], k1[4];
            attn_read_k(k0, k1, lds + s * 16384, r32, hi);
            asm volatile("s_waitcnt lgkmcnt(0)" ::: "memory");
            attn_tile<false, 9>(k0, k1, qr, o, R, T * 64, tq, hi, vb0 + s * 16384);
            done = __all(R < 7.5e-37f); }
    }
}
__device__ __forceinline__ void attn_win_end(const AttnBU& u, const f32x16 (&o)[2], bf16_t* __restrict__ oc, LAS unsigned char* lds, int wave, int lane) {
    const int r32 = lane & 31, hi = lane >> 5; const long rowbase = (long)u.b * SEQ; const int q0 = u.c * 256 + wave * 32;
    LAS bf16_t* stg = (LAS bf16_t*)(lds + 98304 + wave * 4096);
#pragma unroll
    for (int r = 0; r < 16; ++r) { const int orow = crow(r, hi);
#pragma unroll
        for (int d0 = 0; d0 < 2; ++d0) stg[orow * 64 + d0 * 32 + r32] = (bf16_t)(cvtpk_s(o[d0][r], 0.f) & 0xffffu); }
    asm volatile("s_waitcnt lgkmcnt(0)" ::: "memory");
    bf16_t* Ow = oc + (size_t)(rowbase + q0) * 1024 + u.h * 64;
#pragma unroll
    for (int i = 0; i < 4; ++i) { const int row = i * 8 + (lane >> 3), ch = lane & 7; const u32x4 v = *(const LAS u32x4*)(stg + row * 64 + ch * 8); *(u32x4*)(Ow + (size_t)row * 1024 + ch * 8) = v; }
    asm volatile("s_waitcnt lgkmcnt(0)" ::: "memory");
}

struct SguStage { u32x4 vv[8]; f32x2 sp[4]; };
__device__ __forceinline__ void sgu_load_v(SguStage& S, int kt, size_t row0, int g, const bf16_t* __restrict__ vsb, const float* __restrict__ vspart, int lane_) {
    int lane = lane_; asm volatile("" : "+v"(lane));
#pragma unroll
    for (int q = 0; q < 4; ++q) { const size_t row = row0 + 64 * kt + 16 * q + (lane >> 2); S.sp[q] = *(const f32x2*)(vspart + row * 8 + 2 * (lane & 3)); }
#pragma unroll
    for (int w8 = 0; w8 < 8; ++w8) S.vv[w8] = *(const u32x4*)(vsb + (row0 + 64 * kt + 16 * (w8 & 3) + (lane >> 2)) * 512 + g * 64 + 32 * (w8 >> 2) + 8 * (lane & 3));
}
template <int HF>
__device__ __forceinline__ void sgu_load_w(u32x4 (&pw)[2][4], int kt, int g, const bf16_t* __restrict__ wsp, int r32_, int hi) {
    int r32 = r32_; asm volatile("" : "+v"(r32));
#pragma unroll
    for (int rl = 0; rl < 2; ++rl) { const int rb = 2 * HF + rl; const bf16_t* wp = wsp + ((size_t)g * 128 + 32 * rb + r32) * 128 + 64 * kt + 4 * hi;
#pragma unroll
        for (int ks = 0; ks < 4; ++ks) { const u32x2 lo = *(const u32x2*)(wp + 16 * ks), h8 = *(const u32x2*)(wp + 16 * ks + 8); pw[rl][ks] = (u32x4){lo.x, lo.y, h8.x, h8.y}; } }
}
__device__ __forceinline__ void sgu_put_stage(const SguStage& S, LAS unsigned char* wl, int lane) {
    float rvq[4];
#pragma unroll
    for (int q = 0; q < 4; ++q) { float t = S.sp[q][0] + S.sp[q][1]; t += xor_lt32<1>(t); t += xor_lt32<2>(t); rvq[q] = fast_rsq(t * (1.f / 512.f) + EPS); }
#pragma unroll
    for (int w8 = 0; w8 < 8; ++w8) { const float rv = rvq[w8 & 3]; u32x4 w;
#pragma unroll
        for (int j = 0; j < 4; ++j) w[j] = cvtpk_s(bf_lo(S.vv[w8][j]) * rv, bf_hi(S.vv[w8][j]) * rv);
        *(LAS u32x4*)(wl + w8 * 1024 + lane * 16) = w; }
    asm volatile("s_waitcnt lgkmcnt(0)" ::: "memory");
}
template <int HF>
__device__ __forceinline__ void sgu_wave_unit(int chunk, int g, const bf16_t* __restrict__ ub, const bf16_t* __restrict__ vsb, const float* __restrict__ vspart, const bf16_t* __restrict__ wsp  ,
                                              const float* __restrict__ bsp  , const float* __restrict__ sgn  , bf16_t* __restrict__ oc, LAS unsigned char* wl, int lane) {
    const int r32 = lane & 31, hi = lane >> 5;
    const size_t row0 = (size_t)chunk * 128;
    const int vbase = (int)(unsigned)(uintptr_t)wl + ((lane >> 4) & 1) * 32 + (lane & 3) * 8 + (4 * hi + ((lane & 15) >> 2)) * 64;
    f32x16 o[2][2];
#pragma unroll
    for (int rl = 0; rl < 2; ++rl) { o[rl][0] = f32x16{}; o[rl][1] = f32x16{}; }
    SguStage A; u32x4 pw[2][4];
    sgu_load_v(A, 0, row0, g, vsb, vspart, lane);
    sgu_load_w<HF>(pw, 0, g, wsp, r32, hi);
    sgu_put_stage(A, wl, lane);
    if (HF) {
        sgu_load_v(A, 1, row0, g, vsb, vspart, lane);
#pragma unroll
        for (int rl = 0; rl < 2; ++rl) pv(o[rl], vbase, __builtin_bit_cast(bf16x8, pw[rl][0]), __builtin_bit_cast(bf16x8, pw[rl][1]), __builtin_bit_cast(bf16x8, pw[rl][2]), __builtin_bit_cast(bf16x8, pw[rl][3]));
        asm volatile("s_waitcnt lgkmcnt(0)" ::: "memory");
        sgu_load_w<HF>(pw, 1, g, wsp, r32, hi);
        sgu_put_stage(A, wl, lane);
    }
    u32x4 uv[2][4]; f32x4 bb4[2][4];
    int lane_e = lane; asm volatile("" : "+v"(lane_e));
#pragma unroll
    for (int rl = 0; rl < 2; ++rl) { const int rb = 2 * HF + rl;
#pragma unroll
        for (int i = 0; i < 4; ++i) { const int row = i * 8 + (lane_e >> 3), ch = lane_e & 7; uv[rl][i] = *(const u32x4*)(ub + (row0 + 32 * rb + row) * 512 + g * 64 + ch * 8); bb4[rl][i] = *(const f32x4*)(bsp + g * 128 + 32 * rb + 8 * i + 4 * (lane_e >> 5)); } }
    const float gn0 = sgn[g * 64 + r32], gn1 = sgn[g * 64 + 32 + r32];
#pragma unroll
    for (int rl = 0; rl < 2; ++rl) pv(o[rl], vbase, __builtin_bit_cast(bf16x8, pw[rl][0]), __builtin_bit_cast(bf16x8, pw[rl][1]), __builtin_bit_cast(bf16x8, pw[rl][2]), __builtin_bit_cast(bf16x8, pw[rl][3]));
    asm volatile("s_waitcnt lgkmcnt(0)" ::: "memory");
    LAS bf16_t* stg = (LAS bf16_t*)(wl + 8192);
#pragma unroll
    for (int rl = 0; rl < 2; ++rl) {
        const int rb = 2 * HF + rl;
#pragma unroll
        for (int r = 0; r < 16; ++r) { const int orow = crow(r, hi); const float bb = bb4[rl][r >> 2][r & 3];
            stg[orow * 64 + r32] = (bf16_t)(cvtpk_s(gn0 * o[rl][0][r] + bb, 0.f) & 0xffffu); stg[orow * 64 + 32 + r32] = (bf16_t)(cvtpk_s(gn1 * o[rl][1][r] + bb, 0.f) & 0xffffu); }
        asm volatile("s_waitcnt lgkmcnt(0)" ::: "memory");
#pragma unroll
        for (int i = 0; i < 4; ++i) { const int row = i * 8 + (lane >> 3), ch = lane & 7; const size_t grow = row0 + 32 * rb + row;
            const u32x4 mv = *(const LAS u32x4*)(stg + row * 64 + ch * 8); u32x4 w;
#pragma unroll
            for (int j = 0; j < 4; ++j) w[j] = cvtpk_s(bf_lo(mv[j]) * bf_lo(uv[rl][i][j]), bf_hi(mv[j]) * bf_hi(uv[rl][i][j]));
            *(u32x4*)(oc + grow * 1024 + 512 + g * 64 + ch * 8) = w; }
        asm volatile("s_waitcnt lgkmcnt(0)" ::: "memory");
    }
}
constexpr size_t MiB = 1u << 20;
#ifndef FK_CTLZ_KIB
#define FK_CTLZ_KIB 1024
#endif
constexpr size_t WS_CTL = 0, CTL_ZERO_BYTES = (size_t)FK_CTLZ_KIB * 1024;
constexpr size_t WS_W = 16 * MiB, WL_STRIDE = 112 * MiB;
constexpr size_t WO_IN = 0, WO_UP = 9 * MiB, WO_OUT = 11 * MiB, WO_PG = 13 * MiB, WO_PP = 15 * MiB, WO_SP = 15 * MiB + 512 * 1024, WO_R = 15 * MiB + 768 * 1024, WO_EI = 16 * MiB, WO_EO = 80 * MiB;
constexpr size_t WS_PB = 464 * MiB, WS_E = 496 * MiB, WS_XB = 624 * MiB, WS_Q = 656 * MiB, WS_K = 672 * MiB, WS_V = 688 * MiB, WS_U = 704 * MiB, WS_VS = 720 * MiB, WS_GAB = 736 * MiB,
                 WS_OC = 800 * MiB, WS_MG = 832 * MiB, WS_G = 864 * MiB, WS_YS = 904 * MiB, WS_XPART = 984 * MiB, WS_VSPART = 985 * MiB, WS_RS2 = 985 * MiB + 512 * 1024, WS_RS3 = 985 * MiB + 640 * 1024,
                 WS_TOKL = 986 * MiB, WS_RS2S = 989 * MiB  , WS_TKE = 988 * MiB, WS_TKP = 988 * MiB + 256 * 1024, WS_TKW = 988 * MiB + 512 * 1024, WS_XB1 = 992 * MiB, WS_FAST_END = 1024 * MiB;
constexpr int GSLOTS = 2 * M + NE * 256;
constexpr int CW_XGR = 32768  , CW_D1F = 40960  , CW_XID = 64  , CW_MIS = 128, CW_D1 = 1024  , CW_D2 = 16384  , CW_LOC = 2048  , CW_TMO = 0, CW_CODE = 1, CW_BAR = 4096, CW_CNT = 8192  ;

constexpr int RING_OFF = 0, RING_BYTES = 131072, LDSCTL_OFF = 139264  , MISC_OFF = LDSCTL_OFF + 320, PREF_OFF = MISC_OFF + 128  , LDS_BYTES = 147456;

#define RLX_AGENT __ATOMIC_RELAXED, __HIP_MEMORY_SCOPE_AGENT
#define XB_TMO      128
#define XB_XCNT(j)  (256  + 64 * (j))
#define XB_XSUB(j)  (1280 + 64 * (j))
#define XB_XGEN(j)  (2304 + 64 * (j))
#define XB_TOP      3328
#define XB_TOPGEN   3392
#define XCD_BAR_WORDS 3456
#define XB_SPIN_CAP (1u << 18)
__device__ __forceinline__ unsigned xb_ld(unsigned* p)              { return __hip_atomic_load(p, __ATOMIC_RELAXED, __HIP_MEMORY_SCOPE_AGENT); }
__device__ __forceinline__ unsigned xb_add(unsigned* p, unsigned v) { return __hip_atomic_fetch_add(p, v, __ATOMIC_RELAXED, __HIP_MEMORY_SCOPE_AGENT); }
__device__ __forceinline__ unsigned xb_xcc_id() { return (unsigned)__builtin_amdgcn_s_getreg((3 << 11) | 20) & 0xFu; }
#ifndef FK_P0N
#define FK_P0N 4
#endif
#ifndef FK_P0R
#define FK_P0R 2
#endif
#ifndef FK_P0B
#define FK_P0B 0
#endif
#ifndef FK_FPRE
#define FK_FPRE 0
#endif
#ifndef FK_FPRE_MASK
#define FK_FPRE_MASK 0xC
#endif
#ifndef FK_TR2
#define FK_TR2 0
#endif
#ifndef FK_POLLREP
#define FK_POLLREP 0
#endif
#ifndef FK_SPIN_SLEEP
#define FK_SPIN_SLEEP 1
#endif
#define XB_SPIN(cond, bar) do { unsigned _sp = 0; while (cond) { __builtin_amdgcn_s_sleep(FK_SPIN_SLEEP); \
    if ((++_sp & 255u) == 0u) { if (xb_ld(&(bar)[XB_TMO])) break; if (_sp > XB_SPIN_CAP) { atomicAdd(&(bar)[XB_TMO], 1u); break; } } } } while (0)
struct XcdBarrier { unsigned* bar; unsigned x; volatile LAS unsigned* st; };
__device__ __forceinline__ XcdBarrier xcd_barrier_post(unsigned* bar, volatile LAS unsigned* st, const bool leader  ) {
    XcdBarrier b; b.bar = bar; b.x = xb_xcc_id(); b.st = st;
    if (leader) (void)xb_add(&bar[XB_XCNT(b.x)], 1u);
    return b;
}
__device__ __forceinline__ void xcd_barrier_complete(unsigned* bar, unsigned x, unsigned& nloc, unsigned& nx) {
    const unsigned G = gridDim.x * gridDim.y * gridDim.z;
    unsigned sum, cnt, mine, sp = 0u;
    for (;;) {
        sum = 0u; cnt = 0u; mine = 0u;
#pragma unroll
        for (unsigned j = 0; j < 16; ++j) { const unsigned c = xb_ld(&bar[XB_XCNT(j)]); sum += c; cnt += (c > 0u) ? 1u : 0u; mine = (j == x) ? c : mine; }
        if (sum == G) break;
        __builtin_amdgcn_s_sleep(1);
        if ((++sp & 255u) == 0u) { if (xb_ld(&bar[XB_TMO])) break; if (sp > XB_SPIN_CAP) { atomicAdd(&bar[XB_TMO], 1u); break; } }
    }
    nloc = mine > 0u ? mine : 1u; nx = cnt > 0u ? cnt : 1u;
}
__device__ __forceinline__ void xcd_barrier_t0(const XcdBarrier& b, const bool local = false) {
        unsigned* bar = b.bar;
        __builtin_amdgcn_s_waitcnt(0);
        unsigned nloc = b.st[0], nx = b.st[1];
        if (nloc == 0u) { xcd_barrier_complete(bar, b.x, nloc, nx); b.st[0] = nloc; b.st[1] = nx; }
#if FK_LOCAL_L2
        if (local) {
            unsigned* lb = bar - CW_BAR + CW_LOC;
            const unsigned lo_ = __hip_atomic_fetch_add(&lb[64 * b.x], 1u, __ATOMIC_RELAXED, __HIP_MEMORY_SCOPE_WORKGROUP);
            const unsigned lg_ = lo_ / nloc;
            if (lo_ + 1u == (lg_ + 1u) * nloc) (void)__hip_atomic_fetch_add(&lb[1024 + 64 * b.x], 1u, __ATOMIC_RELAXED, __HIP_MEMORY_SCOPE_WORKGROUP);
            else XB_SPIN(xb_ld(&lb[1024 + 64 * b.x]) == lg_, bar);
            __builtin_amdgcn_fence(__ATOMIC_ACQUIRE, "agent");
            asm volatile("s_waitcnt vmcnt(0)" ::: "memory");
            return;
        }
#endif
        const unsigned old = xb_add(&bar[XB_XSUB(b.x)], 1u);
        const unsigned gen = old / nloc;
#if FK_EARLY_INV
        asm volatile("buffer_inv sc1" ::: "memory");
#define FK_ACQ() ((void)0)
#else
#define FK_ACQ() __builtin_amdgcn_fence(__ATOMIC_ACQUIRE, "agent")
#endif
        if (old + 1u == (gen + 1u) * nloc) {
            if (!local) {
            __builtin_amdgcn_fence(__ATOMIC_RELEASE, "agent");
            asm volatile("s_waitcnt vmcnt(0)" ::: "memory");
            const unsigned og = xb_add(&bar[XB_TOP], 1u);
            const unsigned tg = og / nx;
            if (og + 1u == (tg + 1u) * nx) xb_add(&bar[XB_TOPGEN], 1u);
#if FK_TOPSLEEP
            else { unsigned _sp = 0; while (xb_ld(&bar[XB_TOPGEN]) == tg) { __builtin_amdgcn_s_sleep(FK_TOPSLEEP);
                if ((++_sp & 1023u) == 0u) { if (xb_ld(&bar[XB_TMO])) break; if (_sp > 8u * XB_SPIN_CAP) { atomicAdd(&bar[XB_TMO], 1u); break; } } } }
#else
            else XB_SPIN(xb_ld(&bar[XB_TOPGEN]) == tg, bar);
#endif
            }
            FK_ACQ();
#if FK_POLLREP
            { unsigned* rep = bar - CW_BAR + CW_XGR + (b.x * 8) * 32;
#pragma unroll
              for (int r = 0; r < 8; ++r) xb_add(&rep[r * 32], 1u); }
#else
            xb_add(&bar[XB_XGEN(b.x)], 1u);
#endif
            asm volatile("s_waitcnt vmcnt(0)" ::: "memory");
        } else {
#if FK_POLLREP
            XB_SPIN(xb_ld(&(bar - CW_BAR + CW_XGR)[(b.x * 8 + (old & 7u)) * 32]) == gen, bar);
#else
            XB_SPIN(xb_ld(&bar[XB_XGEN(b.x)]) == gen, bar);
#endif
            FK_ACQ();
            asm volatile("s_waitcnt vmcnt(0)" ::: "memory");
        }
#undef FK_ACQ
}

struct Args {
    const float* in[22]; float* out; unsigned char* ws;
    int ph_lo, ph_hi, nlayers, pad;
};
__device__ __forceinline__ int xcd_rank(int bx, int lo, int hi) {
    const int x = bx & 7; int r = 0;
#pragma unroll
    for (int xx = 0; xx < 8; ++xx) { const int first = lo + ((xx - lo) & 7); const int cnt = first < hi ? ((hi - 1 - first) >> 3) + 1 : 0; if (xx < x) r += cnt; else if (xx == x) r += (bx - first) >> 3; }
    return r;
}
__device__ __forceinline__ float wave_sum(float v) { v += xor_lt32<1>(v); v += xor_lt32<2>(v); v += xor_lt32<4>(v); v += xor_lt32<8>(v); return sum_xor16_32(v); }
__device__ __forceinline__ unsigned f2bf(float f) { unsigned u = __builtin_bit_cast(unsigned, f); return (u + 0x7fffu + ((u >> 16) & 1u)) >> 16; }
__device__ __forceinline__ unsigned pk2(float lo, float hi) { return f2bf(lo) | (f2bf(hi) << 16); }

__device__ __forceinline__ int rowmap(int kind, int n) {
    if (kind == 1) { if (n >= 2560) { const int j = n - 2560, jj = j & 1023; return 2560 + 256 * (jj >> 7) + 128 * (j >> 10) + (jj & 127); }
        if (n >= 1024) return n; const int nl = n & 255; return (n - nl) + 128 * ((nl & 63) >> 5) + 32 * (nl >> 6) + (nl & 31); }
    if (kind == 2) { return n < 512 ? 256 * (n >> 7) + (n & 127) : 256 * ((n - 512) >> 7) + 128 + ((n - 512) & 127); }
    return n;
}
__device__ __forceinline__ void transpose_item(const float* __restrict__ W, int N, const float* __restrict__ gain, bf16_t* __restrict__ WT, int ldt, int koff, int kind, LAS float* scr, int item, int lane, const LAS unsigned char* pre = nullptr  ) {
    const int nblk = N / 64, kb = item / nblk, nb = item % nblk, k0 = 64 * kb, n0 = 64 * nb;
#if FK_TR2
    { const int kr = lane >> 4, nq = lane & 15;
      f32x4 v[16];
#pragma unroll
      for (int i = 0; i < 16; ++i) v[i] = pre ? *(const LAS f32x4*)(pre + i * 1024 + lane * 16) : __builtin_nontemporal_load((const f32x4*)(W + (size_t)(k0 + 16 * kr + i) * N + n0 + 4 * nq));
      if (pre) asm volatile("s_waitcnt lgkmcnt(0)" ::: "memory");
      f32x4 g4[4];
#pragma unroll
      for (int q = 0; q < 4; ++q) g4[q] = gain ? *(const f32x4*)(gain + k0 + 16 * kr + 4 * q) : (f32x4){1.f, 1.f, 1.f, 1.f};
      LAS unsigned char* img = (LAS unsigned char*)scr;
#pragma unroll
      for (int c = 0; c < 4; ++c) { const int r = 4 * nq + c; u32x4 h0, h1;
          h0.x = cvt_pk_bf16(v[0][c] * g4[0][0], v[1][c] * g4[0][1]); h0.y = cvt_pk_bf16(v[2][c] * g4[0][2], v[3][c] * g4[0][3]); h0.z = cvt_pk_bf16(v[4][c] * g4[1][0], v[5][c] * g4[1][1]); h0.w = cvt_pk_bf16(v[6][c] * g4[1][2], v[7][c] * g4[1][3]);
          h1.x = cvt_pk_bf16(v[8][c] * g4[2][0], v[9][c] * g4[2][1]); h1.y = cvt_pk_bf16(v[10][c] * g4[2][2], v[11][c] * g4[2][3]); h1.z = cvt_pk_bf16(v[12][c] * g4[3][0], v[13][c] * g4[3][1]); h1.w = cvt_pk_bf16(v[14][c] * g4[3][2], v[15][c] * g4[3][3]);
          *(LAS u32x4*)(img + r * 128 + (((2 * kr) ^ (nq & 7)) * 16)) = h0; *(LAS u32x4*)(img + r * 128 + (((2 * kr + 1) ^ (nq & 7)) * 16)) = h1; }
      asm volatile("s_waitcnt lgkmcnt(0)" ::: "memory");
      const int ch = lane & 7;
#pragma unroll
      for (int j = 0; j < 8; ++j) { const int n = 8 * j + (lane >> 3);
          const u32x4 o = *(const LAS u32x4*)(img + n * 128 + ((ch ^ ((n >> 2) & 7)) * 16));
          __builtin_nontemporal_store(o, (u32x4*)(WT + (size_t)rowmap(kind, n0 + n) * ldt + koff + k0 + 8 * ch)); }
      asm volatile("s_waitcnt lgkmcnt(0)" ::: "memory");
      return; }
#endif
    const int kr = lane >> 4, nc = 4 * (lane & 15);
    f32x4 v[16];
#pragma unroll
    for (int i = 0; i < 16; ++i) v[i] = __builtin_nontemporal_load((const f32x4*)(W + (size_t)(k0 + 4 * i + kr) * N + n0 + nc));
#pragma unroll
    for (int i = 0; i < 16; ++i) { const int kk = 4 * i + kr; const float gv = gain ? gain[k0 + kk] : 1.f; LAS float* d = scr + kk * 65 + nc; d[0] = v[i][0] * gv; d[1] = v[i][1] * gv; d[2] = v[i][2] * gv; d[3] = v[i][3] * gv; }
    asm volatile("s_waitcnt lgkmcnt(0)" ::: "memory");
    const int c = lane & 7;
#pragma unroll
    for (int j = 0; j < 8; ++j) { const int n = 8 * j + (lane >> 3); const LAS float* s = scr + (8 * c) * 65 + n;
        u32x4 o; o.x = pk2(s[0 * 65], s[1 * 65]); o.y = pk2(s[2 * 65], s[3 * 65]); o.z = pk2(s[4 * 65], s[5 * 65]); o.w = pk2(s[6 * 65], s[7 * 65]);
        __builtin_nontemporal_store(o, (u32x4*)(WT + (size_t)rowmap(kind, n0 + n) * ldt + koff + k0 + 8 * c)); }
    asm volatile("s_waitcnt lgkmcnt(0)" ::: "memory");
}

typedef const __attribute__((address_space(4))) Args* KArgs;
__device__ __forceinline__ KArgs fresh(KArgs k) { asm volatile("" : "+s"(k)); return k; }
constexpr int NWAVES = 8;
#ifndef FK_FILLW
#define FK_FILLW 7
#endif
#ifndef FK_P0MIX
#define FK_P0MIX 0
#endif
#ifndef FK_DYN
#define FK_DYN 1
#endif
#ifndef FK_FILL_MASK
#if FK_DYN
#define FK_FILL_MASK 0x39F
#else
#define FK_FILL_MASK 0xFF
#endif
#endif
#ifndef FK_FILL_T
#define FK_FILL_T 1
#endif
constexpr int fk_popc(unsigned v) { int c = 0; for (; v; v &= v - 1) ++c; return c; }
constexpr int FILLW = FK_FILLW, FILL_T = FK_FILL_T, FILL_SLABS = fk_popc(FK_FILL_MASK & 0x3FF);
constexpr int CVT_IN = 16 * 72, CVT_UP = 8 * 16, CVT_OUT = 16 * 16, CVT_PG = 16 * 16, CVT_PP = 4 * 16, CVT_EI = 16 * 16, CVT_EO = 8 * 16;
constexpr int CVT_PER_LAYER = CVT_IN + 2 * CVT_UP + CVT_OUT + CVT_PG + CVT_PP + NE * CVT_EI + NE * CVT_EO;
__device__ __forceinline__ FillReq fill_req(KArgs ap, int L, int r, LAS unsigned char* dst) {
    const float* W; int N = D, item = r;
    if (r < CVT_IN) { W = ap->in[3] + (size_t)L * D * INW; N = INW; }
    else if ((r -= CVT_IN) < CVT_UP) { W = ap->in[9] + (size_t)L * 512 * D; item = r; }
    else if ((r -= CVT_UP) < CVT_UP) { W = ap->in[10] + (size_t)L * 512 * D; item = r; }
    else if ((r -= CVT_UP) < CVT_OUT) { W = ap->in[11] + (size_t)L * D * D; item = r; }
    else if ((r -= CVT_OUT) < CVT_PG) { W = ap->in[20] + (size_t)L * D * D; item = r; }
    else if ((r -= CVT_PG) < CVT_PP) { W = ap->in[21] + (size_t)L * 256 * D; item = r; }
    else if ((r -= CVT_PP) < NE * CVT_EI) { const int e = r / CVT_EI; W = ap->in[17] + ((size_t)L * NE + e) * D * 1024; N = 1024; item = r % CVT_EI; }
    else { r -= NE * CVT_EI; const int e = r / CVT_EO; W = ap->in[18] + ((size_t)L * NE + e) * 512 * D; item = r % CVT_EO; }
    const int nblk = N / 64, kb = item / nblk, nb = item % nblk;
    return FillReq{W, N, 64 * kb, 64 * nb, dst};
}
__device__ __forceinline__ int fill_idx(int slab, int bx, int wave0, int G) { return fk_popc(FK_FILL_MASK & ((1u << slab) - 1u)) * FILL_T * FILLW * G + bx * FILLW + (wave0 - 1); }
__device__ __forceinline__ void convert_item(KArgs ap, int L, int r, LAS float* scr, int lane, const LAS unsigned char* pre = nullptr) {
    unsigned char* wl = ap->ws + WS_W + (size_t)L * WL_STRIDE;
    const float* W; const float* gain = nullptr; bf16_t* WT; int N = D, ldt = D, koff = 0, kind = 0, item = r;
    if (r < CVT_IN) { W = ap->in[3] + (size_t)L * D * INW; N = INW; gain = ap->in[2] + (size_t)L * D; WT = (bf16_t*)(wl + WO_IN); kind = 1; }
    else if ((r -= CVT_IN) < CVT_UP) { W = ap->in[9] + (size_t)L * 512 * D; WT = (bf16_t*)(wl + WO_UP); ldt = 1024; item = r; }
    else if ((r -= CVT_UP) < CVT_UP) { W = ap->in[10] + (size_t)L * 512 * D; WT = (bf16_t*)(wl + WO_UP); ldt = 1024; koff = 512; item = r; }
    else if ((r -= CVT_UP) < CVT_OUT) { W = ap->in[11] + (size_t)L * D * D; WT = (bf16_t*)(wl + WO_OUT); item = r; }
    else if ((r -= CVT_OUT) < CVT_PG) { W = ap->in[20] + (size_t)L * D * D; gain = ap->in[19] + (size_t)L * D; WT = (bf16_t*)(wl + WO_PG); item = r; }
    else if ((r -= CVT_PG) < CVT_PP) { W = ap->in[21] + (size_t)L * 256 * D; WT = (bf16_t*)(wl + WO_PP); ldt = 256; item = r; }
    else if ((r -= CVT_PP) < NE * CVT_EI) { const int e = r / CVT_EI; W = ap->in[17] + ((size_t)L * NE + e) * D * 1024; N = 1024; gain = ap->in[12] + (size_t)L * D; WT = (bf16_t*)(wl + WO_EI) + (size_t)e * 1024 * 1024; ldt = 1024; kind = 2; item = r % CVT_EI; }
    else { r -= NE * CVT_EI; const int e = r / CVT_EO; W = ap->in[18] + ((size_t)L * NE + e) * 512 * D; WT = (bf16_t*)(wl + WO_EO) + (size_t)e * 1024 * 512; ldt = 512; item = r % CVT_EO; }
    transpose_item(W, N, gain, WT, ldt, koff, kind, scr, item, lane, pre);
}
__device__ __forceinline__ void p0_prologue(KArgs ap, int nlayers, bool fill_later, LAS unsigned char* lds, int wave, int lane, int gw, int NGW) {
    LAS float* scr = (LAS float*)(lds + RING_OFF + wave * 17408);
    unsigned char* ws = ap->ws;
    const int gt = gw * 64 + lane, NGT = NGW * 64;
#pragma unroll 1
    for (int st_ = 0; st_ < 4; ++st_) { const int sel = (FK_P0MIX && (wave & 1)) ? 3 - st_ : st_;
    if (sel == 0) {
    const int nconv = fill_later ? 1 : nlayers;
    for (int it = gw; it < CVT_PER_LAYER * nconv; it += NGW) convert_item(ap, nconv - 1 - it / CVT_PER_LAYER, it % CVT_PER_LAYER, scr, lane);
    if (fill_later) { const int first = FILL_SLABS * FILL_T * FILLW * (NGW / NWAVES), rest = CVT_PER_LAYER - first;
        if (rest > 0) for (int it = gw; it < rest * (nlayers - 1); it += NGW) convert_item(ap, 1 + it / rest, first + it % rest, scr, lane); }
    } else if (sel == 1) {
#if FK_P0B && 0
    for (int i = gt; i < 8 * 128 * 128; i += NGT) { const int s_ = i & 127, t = (i >> 7) & 127; float wv[DEPTH];
#pragma unroll
        for (int L = 0; L < DEPTH; ++L) wv[L] = L < nlayers ? (ap->in[7] + (size_t)L * 8 * 128 * 128)[i] : 0.f;
#pragma unroll
        for (int L = 0; L < DEPTH; ++L) if (L < nlayers) ((bf16_t*)(ws + WS_W + (size_t)L * WL_STRIDE + WO_SP))[i] = (bf16_t)f2bf(s_ <= t ? wv[L] : 0.f); }
    for (int i = gt; i < 48 * 1024; i += NGT) { const int o = i >> 10, k = i & 1023; float wv[DEPTH];
#pragma unroll
        for (int L = 0; L < DEPTH; ++L) { const float* gain = ap->in[12] + (size_t)L * D; const float* wg = ap->in[13] + (size_t)L * D * 4; const float* we = ap->in[15] + (size_t)L * D * 32;
            wv[L] = (L < nlayers && o < 36) ? gain[k] * (o < 4 ? wg[k * 4 + o] : we[k * 32 + (o - 4)]) : 0.f; }
#pragma unroll
        for (int L = 0; L < DEPTH; ++L) if (L < nlayers) { bf16_t* wrh = (bf16_t*)(ws + WS_W + (size_t)L * WL_STRIDE + WO_R); bf16_t* wrl = wrh + 48 * 1024;
            const unsigned h = f2bf(wv[L]); wrh[i] = (bf16_t)h; wrl[i] = (bf16_t)f2bf(wv[L] - __uint_as_float(h << 16)); } }
#else
    for (int L = 0; L < nlayers; ++L) {
        unsigned char* wl = ws + WS_W + (size_t)L * WL_STRIDE;
        bf16_t* sp = (bf16_t*)(wl + WO_SP); const float* wsrc = ap->in[7] + (size_t)L * 8 * 128 * 128;
        for (int i = gt; i < 8 * 128 * 128; i += NGT) { const int s = i & 127, t = (i >> 7) & 127; sp[i] = (bf16_t)f2bf(s <= t ? wsrc[i] : 0.f); }
        bf16_t* wrh = (bf16_t*)(wl + WO_R); bf16_t* wrl = wrh + 48 * 1024; const float* gain = ap->in[12] + (size_t)L * D; const float* wg = ap->in[13] + (size_t)L * D * 4; const float* we = ap->in[15] + (size_t)L * D * 32;
        for (int i = gt; i < 48 * 1024; i += NGT) { const int o = i >> 10, k = i & 1023; const float wv = o < 36 ? gain[k] * (o < 4 ? wg[k * 4 + o] : we[k * 32 + (o - 4)]) : 0.f;
            const unsigned h = f2bf(wv); wrh[i] = (bf16_t)h; wrl[i] = (bf16_t)f2bf(wv - __uint_as_float(h << 16)); }
    }
#endif
    } else if (sel == 2) {
    { const f32x4* p4 = (const f32x4*)ap->in[1]; u32x2* pb = (u32x2*)(ws + WS_PB); const size_t n4 = (size_t)nlayers * M * 256 / 4;
#if FK_P0B
      for (size_t i = gt; i < n4; i += (size_t)FK_P0N * NGT) { f32x4 v[FK_P0N];
#pragma unroll
          for (int q = 0; q < FK_P0N; ++q) { const size_t iq = i + (size_t)q * NGT; v[q] = iq < n4 ? __builtin_nontemporal_load(p4 + iq) : (f32x4){0.f, 0.f, 0.f, 0.f}; }
#pragma unroll
          for (int q = 0; q < FK_P0N; ++q) { const size_t iq = i + (size_t)q * NGT; if (iq < n4) { u32x2 w; w.x = cvt_pk_bf16(v[q][0], v[q][1]); w.y = cvt_pk_bf16(v[q][2], v[q][3]); pb[iq] = w; } } } }
#else
      for (size_t i = gt; i < n4; i += NGT) { const f32x4 v = p4[i]; u32x2 w; w.x = pk2(v[0], v[1]); w.y = pk2(v[2], v[3]); pb[i] = w; } }
#endif
    } else {
#if FK_P0B
    for (int m = gw; m < M; m += FK_P0R * NGW) {
        f32x4 v[FK_P0R][4];
#pragma unroll
        for (int rr = 0; rr < FK_P0R; ++rr) { const int mm = m + rr * NGW; const f32x4* xr = (const f32x4*)(ap->in[0] + (size_t)(mm < M ? mm : m) * D) + lane;
#pragma unroll
            for (int j = 0; j < 4; ++j) v[rr][j] = __builtin_nontemporal_load(xr + 64 * j); }
#pragma unroll
        for (int rr = 0; rr < FK_P0R; ++rr) { const int mm = m + rr * NGW; if (mm < M) { u32x2* o8 = (u32x2*)((bf16_t*)(ws + WS_XB) + (size_t)mm * D) + lane; float s_ = 0.f;
#pragma unroll
            for (int j = 0; j < 4; ++j) { const f32x4 q = v[rr][j]; u32x2 w; w.x = cvt_pk_bf16(q[0], q[1]); w.y = cvt_pk_bf16(q[2], q[3]); o8[64 * j] = w; s_ += (q[0] * q[0] + q[1] * q[1]) + (q[2] * q[2] + q[3] * q[3]); }
            s_ = wave_sum(s_);
            if (lane < 16) ((float*)(ws + WS_XPART))[(size_t)mm * 16 + lane] = lane == 0 ? s_ : 0.f; } }
    }
#else
    for (int m = gw; m < M; m += NGW) {
        const f32x4* xr = (const f32x4*)(ap->in[0] + (size_t)m * D) + lane; u32x2* o8 = (u32x2*)((bf16_t*)(ws + WS_XB) + (size_t)m * D) + lane; float s = 0.f;
#pragma unroll
        for (int j = 0; j < 4; ++j) { const f32x4 v = xr[64 * j]; s += (v[0] * v[0] + v[1] * v[1]) + (v[2] * v[2] + v[3] * v[3]); u32x2 w; w.x = pk2(v[0], v[1]); w.y = pk2(v[2], v[3]); o8[64 * j] = w; }
        s = wave_sum(s);
        if (lane < 16) ((float*)(ws + WS_XPART))[(size_t)m * 16 + lane] = lane == 0 ? s : 0.f;
    }
#endif
    }
    }
}

__device__ __forceinline__ void router_pass(const bf16_t* __restrict__ x, const bf16_t* __restrict__ wrh  , const bf16_t* __restrict__ wrl  , const float* __restrict__ bgr, const float* __restrict__ ber,
                                            float* __restrict__ rs2, float* __restrict__ rs2s, int* __restrict__ cnt, int* __restrict__ tokl, int* __restrict__ tk_e, int* __restrict__ tk_pos, float* __restrict__ tk_w,
                                            LAS unsigned char* lds, int wave, int lane, int vcu, int G) {
    LAS float* lg = (LAS float*)(lds + RING_OFF + 106496 + (wave & 3) * 3200);
    LAS int* lcnt = (LAS int*)(lds + LDSCTL_OFF + 1024); LAS int* lbase = lcnt + 32;
    const int fr = lane & 15, fq = lane >> 4;
    for (int bt = vcu; bt < M / 64; bt += G) {
        if (wave == 0 && lane < 32) lcnt[lane] = 0;
        __syncthreads();
        int e1 = 0, e2 = 0, lp1 = 0, lp2 = 0; float tw1 = 0.f, tw2 = 0.f, rst = 0.f;
        const int t0 = bt * 64 + (wave & 3) * 16;
        {
            bf16x8 bh[3][4], bl[3][4]; u32x4 av[4][4];
            const bf16_t* wh = wrh + (size_t)fr * 1024 + 8 * fq + 128 * wave; const bf16_t* wl_ = wrl + (size_t)fr * 1024 + 8 * fq + 128 * wave;
            const bf16_t* xp = x + (size_t)(bt * 64 + fr) * D + 8 * fq + 128 * wave;
#pragma unroll
            for (int cb = 0; cb < 3; ++cb)
#pragma unroll
                for (int kk = 0; kk < 4; ++kk) { bh[cb][kk] = *(const bf16x8*)(wh + (size_t)cb * 16 * 1024 + 32 * kk); bl[cb][kk] = *(const bf16x8*)(wl_ + (size_t)cb * 16 * 1024 + 32 * kk); }
#pragma unroll
            for (int rg = 0; rg < 4; ++rg)
#pragma unroll
                for (int kk = 0; kk < 4; ++kk) av[rg][kk] = *(const u32x4*)(xp + (size_t)rg * 16 * D + 32 * kk);
#pragma unroll
            for (int rg = 0; rg < 4; ++rg) {
                f32x4 pacc[3]; pacc[0] = (f32x4){0.f, 0.f, 0.f, 0.f}; pacc[1] = pacc[0]; pacc[2] = pacc[0]; float pss = 0.f;
#pragma unroll
                for (int kk = 0; kk < 4; ++kk) {
#pragma unroll
                    for (int j = 0; j < 4; ++j) { const float a = bf_lo(av[rg][kk][j]), b = bf_hi(av[rg][kk][j]); pss += a * a + b * b; }
                    const bf16x8 Ah = __builtin_bit_cast(bf16x8, av[rg][kk]);
#pragma unroll
                    for (int cb = 0; cb < 3; ++cb) { pacc[cb] = __builtin_amdgcn_mfma_f32_16x16x32_bf16(bh[cb][kk], Ah, pacc[cb], 0, 0, 0); pacc[cb] = __builtin_amdgcn_mfma_f32_16x16x32_bf16(bl[cb][kk], Ah, pacc[cb], 0, 0, 0); }
                }
                LAS float* pp = (LAS float*)(lds + RING_OFF) + ((wave * 4 + rg) * 64 + lane) * 13;
#pragma unroll
                for (int cb = 0; cb < 3; ++cb)
#pragma unroll
                    for (int i = 0; i < 4; ++i) pp[cb * 4 + i] = pacc[cb][i];
                pp[12] = pss;
            }
        }
        __syncthreads();
        if (wave < 4) {
        f32x4 acc[3]; acc[0] = (f32x4){0.f, 0.f, 0.f, 0.f}; acc[1] = acc[0]; acc[2] = acc[0]; float ss = 0.f;
#pragma unroll
        for (int w2 = 0; w2 < 8; ++w2) { const LAS float* pp = (const LAS float*)(lds + RING_OFF) + ((w2 * 4 + wave) * 64 + lane) * 13;
#pragma unroll
            for (int cb = 0; cb < 3; ++cb)
#pragma unroll
                for (int i = 0; i < 4; ++i) acc[cb][i] += pp[cb * 4 + i];
            ss += pp[12]; }
        ss = sum_xor16_32(ss);
        const float rsr = 1.0f / sqrtf(ss * (1.f / D) + EPS);
#pragma unroll
        for (int cb = 0; cb < 3; ++cb)
#pragma unroll
            for (int i = 0; i < 4; ++i) lg[fr * 49 + 16 * cb + 4 * fq + i] = acc[cb][i] * rsr;
        if (fq == 0) lg[fr * 49 + 48] = rsr;
        asm volatile("s_waitcnt lgkmcnt(0)" ::: "memory");
        if (lane < 16) {
            const int tok = t0 + lane; const LAS float* l = lg + lane * 49;
            rst = l[48]; rs2[tok] = rst;
            const float g0 = l[0] + bgr[0], g1 = l[1] + bgr[1], g2 = l[2] + bgr[2], g3 = l[3] + bgr[3];
            int grp = 0; float gm = g0;
            if (g1 > gm) { gm = g1; grp = 1; } if (g2 > gm) { gm = g2; grp = 2; } if (g3 > gm) { gm = g3; grp = 3; }
            const float gsum = (expf(g0 - gm) + expf(g1 - gm)) + (expf(g2 - gm) + expf(g3 - gm));
            const float grp_w = 1.f / gsum;
            int i1 = 0, i2 = 0; float m1 = -INFINITY, m2 = -INFINITY;
#pragma unroll
            for (int i = 0; i < 8; ++i) { const float el = l[4 + grp * 8 + i] + ber[grp * 8 + i]; if (el > m1) { m2 = m1; i2 = i1; m1 = el; i1 = i; } else if (el > m2) { m2 = el; i2 = i; } }
            const float p2 = expf(m2 - m1), w1 = 1.f / (1.f + p2), w2 = p2 / (1.f + p2);
            e1 = grp * 8 + i1; e2 = grp * 8 + i2; tw1 = grp_w * w1; tw2 = grp_w * w2;
            lp1 = __hip_atomic_fetch_add(&lcnt[e1], 1, __ATOMIC_RELAXED, __HIP_MEMORY_SCOPE_WORKGROUP); lp2 = __hip_atomic_fetch_add(&lcnt[e2], 1, __ATOMIC_RELAXED, __HIP_MEMORY_SCOPE_WORKGROUP);
        }
        }
        __syncthreads();
        if (wave == 0 && lane < 32) { const int c = lcnt[lane]; lbase[lane] = c > 0 ? atomicAdd(&cnt[lane * CNT_STRIDE], c) : 0; }
        __syncthreads();
        if (wave < 4 && lane < 16) {
            const int tok = t0 + lane; const int pos1 = lbase[e1] + lp1, pos2 = lbase[e2] + lp2;
            tokl[e1 * ECAP + pos1] = tok; tokl[e2 * ECAP + pos2] = tok; rs2s[e1 * ECAP + pos1] = rst; rs2s[e2 * ECAP + pos2] = rst;
            tk_e[tok * 2] = e1; tk_e[tok * 2 + 1] = e2; tk_pos[tok * 2] = pos1; tk_pos[tok * 2 + 1] = pos2; tk_w[tok * 2] = tw1; tk_w[tok * 2 + 1] = tw2;
        }
        __syncthreads();
    }
}

__device__ __forceinline__ void combine_pass(bf16_t* xb, const bf16_t* __restrict__ ys, const LAS int* pref, const int* __restrict__ tk_e, const int* __restrict__ tk_pos,
                                             const float* __restrict__ tk_w, float* __restrict__ rs3, int lane, int gw, int NGW) {
    int en[4][2], pn[4][2]; float wn[4][2];
    const bool contig = (M % (NGW * 4)) == 0; const int mstart = contig ? gw * (M / NGW) : gw * 4, mstep = contig ? 4 : NGW * 4, mend = contig ? mstart + M / NGW : M;
    { const int m0 = mstart;
#pragma unroll
      for (int r = 0; r < 4; ++r) { const int m = m0 + r; en[r][0] = tk_e[m * 2]; en[r][1] = tk_e[m * 2 + 1]; pn[r][0] = tk_pos[m * 2]; pn[r][1] = tk_pos[m * 2 + 1]; wn[r][0] = tk_w[m * 2]; wn[r][1] = tk_w[m * 2 + 1]; } }
    for (int m0 = mstart; m0 < mend; m0 += mstep) {
        int s0[4], s1[4]; float w0[4], w1[4];
#pragma unroll
        for (int r = 0; r < 4; ++r) { s0[r] = 256 * pref[en[r][0]] + pn[r][0]; s1[r] = 256 * pref[en[r][1]] + pn[r][1]; w0[r] = wn[r][0]; w1[r] = wn[r][1]; }
        u32x4 xv[4][2], a0[4][2], a1[4][2];
#pragma unroll
        for (int r = 0; r < 4; ++r)
#pragma unroll
            for (int j = 0; j < 2; ++j) { xv[r][j] = ((const u32x4*)(xb + (size_t)(m0 + r) * D) + lane)[64 * j]; a0[r][j] = ((const u32x4*)(ys + (size_t)s0[r] * D) + lane)[64 * j]; a1[r][j] = ((const u32x4*)(ys + (size_t)s1[r] * D) + lane)[64 * j]; }
        if (m0 + mstep < mend) { const int mn = m0 + mstep;
#pragma unroll
            for (int r = 0; r < 4; ++r) { const int m = mn + r; en[r][0] = tk_e[m * 2]; en[r][1] = tk_e[m * 2 + 1]; pn[r][0] = tk_pos[m * 2]; pn[r][1] = tk_pos[m * 2 + 1]; wn[r][0] = tk_w[m * 2]; wn[r][1] = tk_w[m * 2 + 1]; } }
#pragma unroll
        for (int r = 0; r < 4; ++r) { float s = 0.f;
#pragma unroll
            for (int j = 0; j < 2; ++j) { u32x4 w;
#pragma unroll
                for (int q = 0; q < 4; ++q) { w[q] = cvt_pk_bf16(bf_lo(xv[r][j][q]) + w0[r] * bf_lo(a0[r][j][q]) + w1[r] * bf_lo(a1[r][j][q]), bf_hi(xv[r][j][q]) + w0[r] * bf_hi(a0[r][j][q]) + w1[r] * bf_hi(a1[r][j][q]));
                    const float a = bf_lo(w[q]), b = bf_hi(w[q]); s += a * a + b * b; }
                st16((u32x4*)(xb + (size_t)(m0 + r) * D) + lane + 64 * j, w); }
            s = wave_sum(s);
            if (lane == 0) rs3[m0 + r] = 1.0f / sqrtf(s * (1.f / D) + EPS); }
    }
}

__device__ __forceinline__ AttnBU attn_unit_of(int i, int G) {
    if (G == 256) { const int vc = i & 255, k = i >> 8, x = vc >> 5, q = vc & 31, pm = 8 * x + (q & 7); return AttnBU{pm >> 5, k * 4 + (q >> 3), pm & 31}; }
    return AttnBU{(i / (SEQ / 256)) >> 3, (i / (SEQ / 256)) & 7, i % (SEQ / 256)};
}
constexpr int PH_PER_LAYER = 10;
#ifndef FK_XLOC
#define FK_XLOC 1
#endif
#ifndef FK_LOCAL_MASK
#if FK_XLOC
#define FK_LOCAL_MASK 0x36E
#else
#define FK_LOCAL_MASK 0x30E
#endif
#endif
#ifndef FK_BPROBE
#define FK_BPROBE 0
#endif
#ifndef FK_BATT
#define FK_BATT 2
#endif
#ifndef FK_APROBE
#define FK_APROBE 0
#endif
#ifndef FK_XD
#define FK_XD 1
#endif
#ifndef FK_PFW
#define FK_PFW 0
#endif
#ifndef FK_DRY
#define FK_DRY 0
#endif
#ifndef FK_REP
#define FK_REP 0
#endif
#define REPS(bit) ((FK_REP & (bit)) ? 2 : 1)
__global__ void __launch_bounds__(NWAVES * 64, 2) mega_fwd(Args args_unused) {
    extern __shared__ __attribute__((aligned(16))) unsigned char lds_raw[];
    LAS unsigned char* lds = (LAS unsigned char*)lds_raw;
    LAS int* pref = (LAS int*)(lds + PREF_OFF);
    const KArgs kp0 = (KArgs)__builtin_amdgcn_kernarg_segment_ptr();
    const int tid = threadIdx.x, wave0 = __builtin_amdgcn_readfirstlane(tid >> 6);
    const int G = gridDim.x, bx = blockIdx.x;
    const int vcu = (G % 8 == 0) ? (bx % 8) * (G / 8) + bx / 8 : bx;
    const int gw0 = vcu * NWAVES + wave0, NGW = G * NWAVES;
#define FK_T0 (wave0 == 0 && fk_lane() == 0)
#define FK_IDS int lane_o = fk_lane(), wave_o = wave0, gw_o = gw0; asm volatile("" : "+v"(lane_o), "+s"(wave_o), "+s"(gw_o)); const int lane = lane_o, wave = wave_o, gw = gw_o; (void)lane; (void)wave; (void)gw;
    for (int u = tid; u < (LDS_BYTES - LDSCTL_OFF) / 4; u += NWAVES * 64) ((LAS unsigned*)(lds + LDSCTL_OFF))[u] = 0u;
    __syncthreads();
    const int lo = kp0->ph_lo, hi = kp0->ph_hi, nlayers = kp0->nlayers;
#define IN(k) (lo <= (k) && (k) < hi)
    const bool fill_on = (hi - lo > 1) && G == 256;
#define SEAM_F(k, Lc, slab) do { if (IN(k) && IN((k) + 1)) { \
        asm volatile("s_waitcnt vmcnt(0)" ::: "memory"); __syncthreads(); \
        if (wave0 == 0) { if (fk_lane() == 0) { KArgs A_ = fresh(kp0); XcdBarrier bar_; bar_.bar = (unsigned*)(A_->ws + WS_CTL) + CW_BAR; bar_.x = xb_xcc_id(); bar_.st = (volatile LAS unsigned*)(lds + MISC_OFF) + 8; xcd_barrier_t0(bar_, FK_LOCAL_MASK && (slab) >= 0 && (slab) < 16 && ((FK_LOCAL_MASK >> ((slab) & 15)) & 1) && bar_.st[2] != 0u); } } \
        else if (fill_on && (Lc) < nlayers && (slab) >= 0 && (slab) <= 9 && ((FK_FILL_MASK >> (slab)) & 1) && wave0 <= FILLW) { \
            const int rank_ = fk_popc(FK_FILL_MASK & ((1u << (slab)) - 1u)); \
            _Pragma("unroll 1") for (int t_ = 0; t_ < FILL_T; ++t_) { int idx_ = (rank_ * FILL_T + t_) * FILLW * G + bx * FILLW + (wave0 - 1); asm volatile("" : "+s"(idx_));   \
                if (idx_ < CVT_PER_LAYER) convert_item(fresh(kp0), (Lc), idx_, (LAS float*)(lds + RING_OFF + wave0 * 17408), fk_lane(), (FK_FPRE && FILL_T == 1 && ((FK_FPRE_MASK >> (slab)) & 1)) ? (const LAS unsigned char*)(lds + RING_OFF + wave0 * 16384) : (const LAS unsigned char*)nullptr); } } \
        __syncthreads(); } } while (0)
#define SEAM(k) SEAM_F(k, L + 1, (k) - pb)
    if (hi - lo > 1) { KArgs A = fresh(kp0); (void)xcd_barrier_post((unsigned*)(A->ws + WS_CTL) + CW_BAR, (volatile LAS unsigned*)(lds + MISC_OFF) + 8, FK_T0);
        if (FK_LOCAL_MASK && FK_T0 && bx < 8) __hip_atomic_store((unsigned*)(A->ws + WS_CTL) + CW_XID + bx, xb_xcc_id() + 1u, __ATOMIC_RELAXED, __HIP_MEMORY_SCOPE_AGENT); }

    if (IN(0)) { for (int rep = 0; rep < REPS(1); ++rep) { FK_IDS; p0_prologue(fresh(kp0), nlayers, fill_on, lds, wave, lane, gw, NGW); } }
    SEAM_F(0, nlayers, -1);
    if (FK_LOCAL_MASK && IN(0) && IN(1) && FK_T0) { KArgs A = fresh(kp0); unsigned* ctl = (unsigned*)(A->ws + WS_CTL);
        if (G != 256 || xb_ld(ctl + CW_XID + (bx & 7)) != xb_xcc_id() + 1u) (void)xb_add(ctl + CW_MIS, 1u); }
    if (IN(1)) { }
    for (int L = 0; L < nlayers; ++L) {
        const int pb = 2 + PH_PER_LAYER * L;
        if (IN(pb + 0)) for (int rep = 0; rep < REPS(4); ++rep) {
            KArgs A = fresh(kp0); unsigned char* ws = A->ws; unsigned char* wl = ws + WS_W + (size_t)L * WL_STRIDE;
            DenseOrder S; S.init(M, INW, G, bx, ws + WS_XB, wl + WO_IN, D);
            EpiIn E{(const float*)(ws + WS_XPART), A->in[4] + L * 64, A->in[5] + L * 64, (bf16_t*)(ws + WS_Q), (bf16_t*)(ws + WS_K), (bf16_t*)(ws + WS_V), (bf16_t*)(ws + WS_U), (bf16_t*)(ws + WS_VS), (bf16_t*)(ws + WS_GAB), (float*)(ws + WS_VSPART)};
            gemm_phase<EpiIn, DenseOrder, true>(lds + RING_OFF, D, S, E, wave0, FK_DRY && rep + 1 < REPS(4));
            { const int nshort = (G == 256) ? 128 : G; const int c2 = (G == 256) ? bx - 128 : bx;
              if (c2 >= 0) { DenseOrder S2; S2.init(M, D, nshort, c2, ws + WS_PB + (size_t)L * M * 256 * 2, wl + WO_PP, 256);
                  EpiPlain E2{(bf16_t*)(ws + WS_E) + (size_t)L * M * D, D, 0, nullptr};
                  gemm_phase<EpiPlain, DenseOrder, true>(lds + RING_OFF, 256, S2, E2, wave0); } }
        }
        SEAM(pb + 0);
        if (FK_LOCAL_MASK && L == 0 && IN(0) && IN(1) && IN(pb) && IN(pb + 1) && FK_T0) { KArgs A = fresh(kp0); ((volatile LAS unsigned*)(lds + MISC_OFF) + 8)[2] = (xb_ld((unsigned*)(A->ws + WS_CTL) + CW_MIS) == 0u) ? 1u : 0u; }
        if (IN(pb + 1)) for (int rep = 0; rep < REPS(8 | 2048); ++rep) {
            KArgs A = fresh(kp0); unsigned char* ws = A->ws; unsigned char* wl = ws + WS_W + (size_t)L * WL_STRIDE;
            FK_IDS;
            LAS unsigned char* wlds = lds + RING_OFF + wave * WLDS_BYTES;
            constexpr int NATT = 2 * 8 * (SEQ / 32), NSGU = (M / 128) * 8 * 2;
#if FK_BATT
            if (rep == 0 || (FK_REP & 8)) { constexpr int NBU = 2 * 8 * (SEQ / 256);
                const bf16_t* qb_ = (const bf16_t*)(ws + WS_Q); const bf16_t* kb_ = (const bf16_t*)(ws + WS_K); const bf16_t* vb_ = (const bf16_t*)(ws + WS_V);
                bf16x8 qr[4]; f32x16 o[2];
                int it2 = vcu;
#if FK_BATT == 2
#define FK_BU(i) attn_unit_of((i), G)
                if (it2 < NBU) { AttnBU u = FK_BU(it2); attn_win_begin(u, qr, qb_, kb_, vb_, lds + RING_OFF, wave, lane);
                    for (;;) { attn_win_body(u, qr, o, kb_, vb_, lds + RING_OFF, wave, lane);
                        const int itn = it2 + G; const bool more = itn < NBU; AttnBU un = FK_BU(more ? itn : it2);
                        if (more) attn_win_begin(un, qr, qb_, kb_, vb_, lds + RING_OFF, wave, lane);
                        attn_win_end(u, o, (bf16_t*)(ws + WS_OC), lds + RING_OFF, wave, lane);
                        if (!more) break; u = un; it2 = itn; } }
                __syncthreads(); }
            if (0) { bf16x8 qr[4]; f32x16 o[2]; int it2 = vcu; constexpr int NBU = 0; const bf16_t* qb_ = nullptr; const bf16_t* kb_ = nullptr; const bf16_t* vb_ = nullptr;
#endif
                if (it2 < NBU) { AttnBU u{(it2 / (SEQ / 256)) >> 3, (it2 / (SEQ / 256)) & 7, it2 % (SEQ / 256)}; attn_block_begin(u, qr, qb_, kb_, vb_, lds + RING_OFF, wave, lane);
                    for (;;) { if (FK_BPROBE && rep == 1) attn_block_body<FK_BPROBE>(u, qr, o, kb_, vb_, lds + RING_OFF, wave, lane); else attn_block_body(u, qr, o, kb_, vb_, lds + RING_OFF, wave, lane);
                        const int itn = it2 + G; const bool more = itn < NBU; AttnBU un{(itn / (SEQ / 256)) >> 3, (itn / (SEQ / 256)) & 7, itn % (SEQ / 256)};
                        if (more) attn_block_begin(un, qr, qb_, kb_, vb_, lds + RING_OFF, wave, lane);
                        if (FK_BPROBE && rep == 1) { if (o[0][0] == 1.2345e-30f && o[1][3] == 5.4321e-30f) ((bf16_t*)(ws + WS_OC))[0] = 0; } else
                        attn_block_end(u, o, (bf16_t*)(ws + WS_OC), lds + RING_OFF, wave, lane);
                        if (!more) break; u = un; it2 = itn; } }
                __syncthreads(); }
            if (rep == 0 || (FK_REP & 2048)) for (int j = gw; j < NSGU; j += NGW) { const int hf = j & 1, g = (j >> 1) & 7, ch = j >> 4;
                if (hf == 0) sgu_wave_unit<0>(ch, g, (const bf16_t*)(ws + WS_U), (const bf16_t*)(ws + WS_VS), (const float*)(ws + WS_VSPART), (const bf16_t*)(wl + WO_SP), A->in[8] + (size_t)L * 8 * 128, A->in[6] + (size_t)L * 512, (bf16_t*)(ws + WS_OC), wlds, lane);
                else sgu_wave_unit<1>(ch, g, (const bf16_t*)(ws + WS_U), (const bf16_t*)(ws + WS_VS), (const float*)(ws + WS_VSPART), (const bf16_t*)(wl + WO_SP), A->in[8] + (size_t)L * 8 * 128, A->in[6] + (size_t)L * 512, (bf16_t*)(ws + WS_OC), wlds, lane); }
            __syncthreads();
            continue;
#endif
            const int nun = (NATT + NSGU - gw + NGW - 1) / NGW;
            for (int k_ = 0; k_ < nun; ++k_) { const int kk_ = (wave >= 4) ? (k_ == 0 ? nun - 1 : k_ - 1) : k_; const int it = gw + kk_ * NGW;
                if (rep == 1 && (it < NATT ? !(FK_REP & 8) : !(FK_REP & 2048))) continue;
                if (FK_APROBE && rep == 1 && it < NATT) { const int qblk = it % (SEQ / 32), bh = it / (SEQ / 32); attn_wave_unit<FK_APROBE>(bh >> 3, bh & 7, qblk, (const bf16_t*)(ws + WS_Q), (const bf16_t*)(ws + WS_K), (const bf16_t*)(ws + WS_V), (bf16_t*)(ws + WS_OC), wlds, lane); continue; }
                if (it < NATT) { const int qblk = it % (SEQ / 32), bh = it / (SEQ / 32); attn_wave_unit(bh >> 3, bh & 7, qblk, (const bf16_t*)(ws + WS_Q), (const bf16_t*)(ws + WS_K), (const bf16_t*)(ws + WS_V), (bf16_t*)(ws + WS_OC), wlds, lane); }
                else { const int j = it - NATT; const int hf = j & 1, g = (j >> 1) & 7, ch = j >> 4;
                    if (hf == 0) sgu_wave_unit<0>(ch, g, (const bf16_t*)(ws + WS_U), (const bf16_t*)(ws + WS_VS), (const float*)(ws + WS_VSPART), (const bf16_t*)(wl + WO_SP), A->in[8] + (size_t)L * 8 * 128, A->in[6] + (size_t)L * 512, (bf16_t*)(ws + WS_OC), wlds, lane);
                    else sgu_wave_unit<1>(ch, g, (const bf16_t*)(ws + WS_U), (const bf16_t*)(ws + WS_VS), (const float*)(ws + WS_VSPART), (const bf16_t*)(wl + WO_SP), A->in[8] + (size_t)L * 8 * 128, A->in[6] + (size_t)L * 512, (bf16_t*)(ws + WS_OC), wlds, lane); }
            }
        }
        SEAM(pb + 1);
        if (IN(pb + 2)) for (int rep = 0; rep < REPS(16); ++rep) {
            KArgs A = fresh(kp0); unsigned char* ws = A->ws; unsigned char* wl = ws + WS_W + (size_t)L * WL_STRIDE;
            DenseOrder S; S.init(M, D, G, bx, ws + WS_OC, wl + WO_UP, D);
            FillReq fq_{nullptr, 0, 0, 0, nullptr};
            if (FK_FPRE && ((FK_FPRE_MASK >> 2) & 1) && fill_on && L + 1 < nlayers && rep == 0 && wave0 >= 1 && wave0 <= FILLW && FILL_T == 1 && ((FK_FILL_MASK >> 2) & 1)) { const int ix = fill_idx(2, bx, wave0, G); if (ix < CVT_PER_LAYER) fq_ = fill_req(A, L + 1, ix, lds + RING_OFF + wave0 * 16384); }
            EpiUp E{(const bf16_t*)(ws + WS_GAB), (bf16_t*)(ws + WS_MG), fq_};
            gemm_phase<EpiUp, DenseOrder, FK_FPRE != 0>(lds + RING_OFF, D, S, E, wave0);
        }
        SEAM(pb + 2);
        if (IN(pb + 3)) for (int rep = 0; rep < REPS(128); ++rep) {
            KArgs A = fresh(kp0); unsigned char* ws = A->ws; unsigned char* wl = ws + WS_W + (size_t)L * WL_STRIDE;
            DenseOrder S; S.init(M, D, G, bx, ws + WS_MG, wl + WO_OUT, D);
            FillReq fq_{nullptr, 0, 0, 0, nullptr};
            if (FK_FPRE && ((FK_FPRE_MASK >> 3) & 1) && fill_on && L + 1 < nlayers && rep == 0 && wave0 >= 1 && wave0 <= FILLW && FILL_T == 1 && ((FK_FILL_MASK >> 3) & 1)) { const int ix = fill_idx(3, bx, wave0, G); if (ix < CVT_PER_LAYER) fq_ = fill_req(A, L + 1, ix, lds + RING_OFF + wave0 * 16384); }
            EpiOut E{(const bf16_t*)(ws + WS_XB), (bf16_t*)(ws + WS_XB1), fq_};
            gemm_phase<EpiOut, DenseOrder, FK_FPRE != 0>(lds + RING_OFF, D, S, E, wave0, FK_DRY && rep + 1 < REPS(128));
        }
        SEAM(pb + 3);
        if (IN(pb + 4)) {
            KArgs A = fresh(kp0); unsigned char* ws = A->ws; unsigned char* wl = ws + WS_W + (size_t)L * WL_STRIDE;
            FK_IDS;
#if FK_PFW
            { const unsigned char* wsrc = wl + WO_EI; const unsigned ngr = (unsigned)((size_t)NE * 1024 * 1024 * 2 / 64);
#pragma unroll 1
              for (unsigned g_ = (unsigned)gw * 64u + (unsigned)lane; g_ < ngr; g_ += (unsigned)NGW * 64u)
                  __builtin_amdgcn_global_load_lds((const unsigned*)(wsrc + (size_t)g_ * 64), (LAS unsigned*)(lds + RING_OFF + 120832 + wave * 1024), 4, 0, 0); }
#endif
            router_pass((const bf16_t*)(ws + WS_XB1), (const bf16_t*)(wl + WO_R), (const bf16_t*)(wl + WO_R) + 48 * 1024, A->in[14] + L * 4, A->in[16] + L * 32, (float*)(ws + WS_RS2), (float*)(ws + WS_RS2S), (int*)((unsigned*)(ws + WS_CTL) + CW_CNT) + L * NE * CNT_STRIDE, (int*)(ws + WS_TOKL), (int*)(ws + WS_TKE), (int*)(ws + WS_TKP), (float*)(ws + WS_TKW), lds, wave, lane, vcu, G);
        }
        SEAM(pb + 4);
        if (IN(pb + 5) || IN(pb + 6) || IN(pb + 7) || IN(pb + 8)) {
            KArgs A = fresh(kp0); const int* cnt = (const int*)((unsigned*)(A->ws + WS_CTL) + CW_CNT) + L * NE * CNT_STRIDE;
            if (FK_T0) { int s = 0; for (int e = 0; e < NE; ++e) { const int ce = cnt[e * CNT_STRIDE]; pref[e] = s; pref[40 + e] = ce;   s += (ce + 255) >> 8; } pref[NE] = s; }
            __syncthreads();
        }
        const int nG1 = pref[NE] * 4, fr = nG1 / G, n3 = nG1 - fr * G;
        const int jB = (fr >= 1) ? min(2 * (G - n3), (fr * G / 4) * 4) : 0;
        const bool xl = FK_XLOC && G == 256;
        const int xq = bx >> 3, xx = bx & 7, frb = fr * 8, mx4 = xl ? 4 * ((pref[NE] - fr * 64 + 7 - xx) >> 3) : 0, ltot = 4 * frb + mx4, jBx = min(2 * (32 - mx4), 4 * frb);
        const bool dyn = FK_DYN && xl && fr >= 1 && (pref[NE] - fr * 64) <= 32 && IN(pb + 5) && IN(pb + 6) && IN(pb + 7) && IN(pb + 8) && ((volatile LAS unsigned*)(lds + MISC_OFF) + 8)[2] != 0u;
        if (dyn) {
            KArgs A = fresh(kp0); unsigned char* ws = A->ws; unsigned char* wl = ws + WS_W + (size_t)L * WL_STRIDE; const int* cnt = (const int*)((unsigned*)(ws + WS_CTL) + CW_CNT) + L * NE * CNT_STRIDE;
            unsigned* ctl = (unsigned*)(ws + WS_CTL); unsigned* d1 = ctl + CW_D1 + (L * 8 + xx) * 32; unsigned* d2 = ctl + CW_D2 + (L * 32 + xx + 8 * (xq >> 2)) * 32;
            { ExpertOrder S{32, xq, D, 4, (const char*)(ws + WS_XB1), (const char*)(wl + WO_EI), (size_t)1024 * 1024 * 2, pref, (const int*)(ws + WS_TOKL), cnt, 1, 0, fr, 4 * frb, 2, xx, frb, ltot};
              EpiG1 E{pref, (const float*)(ws + WS_RS2S), (bf16_t*)(ws + WS_G)};
              gemm_phase<EpiG1, ExpertOrder, true>(lds + RING_OFF, D, S, E, wave0); }
            asm volatile("s_waitcnt vmcnt(0)" ::: "memory"); __syncthreads();
#if FK_POLLREP
            if (FK_T0) { if (xb_add(d1, 1u) == 31u) { unsigned* f_ = ctl + CW_D1F + ((L * 8 + xx) * 8) * 32;
#pragma unroll
                for (int r = 0; r < 8; ++r) xb_add(&f_[r * 32], 1u); } }
#else
            if (FK_T0) (void)xb_add(d1, 1u);
#endif
            if (xq < mx4) {
                ExpertOrder S{32, xq, D, 4, (const char*)(ws + WS_XB1), (const char*)(wl + WO_EI), (size_t)1024 * 1024 * 2, pref, (const int*)(ws + WS_TOKL), cnt, 1, 4 * frb, 1, ltot, 2, xx, frb, ltot};
                EpiG1 E{pref, (const float*)(ws + WS_RS2S), (bf16_t*)(ws + WS_G)};
                gemm_phase<EpiG1, ExpertOrder, true>(lds + RING_OFF, D, S, E, wave0);
                asm volatile("s_waitcnt vmcnt(0)" ::: "memory"); __syncthreads();
                if (FK_T0) (void)xb_add(d2, 1u);
            }
            if (FK_T0) { unsigned* bar_ = ctl + CW_BAR;
#if FK_EARLY_INV
                asm volatile("buffer_inv sc1" ::: "memory");
#endif
#if FK_POLLREP
                XB_SPIN(xb_ld(ctl + CW_D1F + ((L * 8 + xx) * 8 + (xq & 7)) * 32) == 0u, bar_);
#else
        #if FK_D1SLEEP
        { unsigned _sp = 0; while (xb_ld(d1) < 32u) { __builtin_amdgcn_s_sleep(FK_D1SLEEP);
            if ((++_sp & 255u) == 0u) { if (xb_ld(&bar_[XB_TMO])) break; if (_sp > XB_SPIN_CAP) { atomicAdd(&bar_[XB_TMO], 1u); break; } } } }
#else
        XB_SPIN(xb_ld(d1) < 32u, bar_);
#endif
#endif
                if (xq < mx4) XB_SPIN(xb_ld(d2) < 4u, bar_);
#if !FK_EARLY_INV
                __builtin_amdgcn_fence(__ATOMIC_ACQUIRE, "agent");
#endif
                asm volatile("s_waitcnt vmcnt(0)" ::: "memory"); }
            __syncthreads();
            { ExpertOrder S = (xq >= mx4) ? ExpertOrder{32 - mx4, xq - mx4, 512, 4, (const char*)(ws + WS_G), (const char*)(wl + WO_EO), (size_t)1024 * 512 * 2, pref, (const int*)(ws + WS_TOKL), cnt, 0, 0, 1 << 20, 4 * frb, 2, xx, frb, ltot}
                                          : ExpertOrder{32, xq, 512, 4, (const char*)(ws + WS_G), (const char*)(wl + WO_EO), (size_t)1024 * 512 * 2, pref, (const int*)(ws + WS_TOKL), cnt, 0, 4 * frb, 1, ltot, 2, xx, frb, ltot};
              EpiPlain E{(bf16_t*)(ws + WS_YS), D, 1, pref + 40};
              gemm_phase<EpiPlain, ExpertOrder, true>(lds + RING_OFF, 512, S, E, wave0); }
        }
        if (!dyn && IN(pb + 5)) for (int rep = 0; rep < REPS(32); ++rep) {
            KArgs A = fresh(kp0); unsigned char* ws = A->ws; unsigned char* wl = ws + WS_W + (size_t)L * WL_STRIDE; const int* cnt = (const int*)((unsigned*)(ws + WS_CTL) + CW_CNT) + L * NE * CNT_STRIDE;
            ExpertOrder S = xl ? ExpertOrder{32, xq, D, 4, (const char*)(ws + WS_XB1), (const char*)(wl + WO_EI), (size_t)1024 * 1024 * 2, pref, (const int*)(ws + WS_TOKL), cnt, 1, 0, fr, 4 * frb, 2, xx, frb, ltot}
                               : ExpertOrder{G, FK_XD ? xcd_rank(bx, 0, G) : bx, D, 4, (const char*)(ws + WS_XB1), (const char*)(wl + WO_EI), (size_t)1024 * 1024 * 2, pref, (const int*)(ws + WS_TOKL), cnt, 1, 0, fr, fr * G, 0, 0, 0, 0};
            EpiG1 E{pref, (const float*)(ws + WS_RS2S), (bf16_t*)(ws + WS_G)};
            gemm_phase<EpiG1, ExpertOrder, true>(lds + RING_OFF, D, S, E, wave0);
        }
        if (!dyn) SEAM(pb + 5);
        if (!dyn && IN(pb + 6)) {
            KArgs A = fresh(kp0); unsigned char* ws = A->ws; unsigned char* wl = ws + WS_W + (size_t)L * WL_STRIDE; const int* cnt = (const int*)((unsigned*)(ws + WS_CTL) + CW_CNT) + L * NE * CNT_STRIDE;
            if (xl ? (xq < mx4) : (bx < n3)) {
                ExpertOrder S = xl ? ExpertOrder{32, xq, D, 4, (const char*)(ws + WS_XB1), (const char*)(wl + WO_EI), (size_t)1024 * 1024 * 2, pref, (const int*)(ws + WS_TOKL), cnt, 1, 4 * frb, 1, ltot, 2, xx, frb, ltot}
                                   : ExpertOrder{G, bx, D, 4, (const char*)(ws + WS_XB1), (const char*)(wl + WO_EI), (size_t)1024 * 1024 * 2, pref, (const int*)(ws + WS_TOKL), cnt, 1, fr * G, 1, nG1, 0, 0, 0, 0};
                EpiG1 E{pref, (const float*)(ws + WS_RS2S), (bf16_t*)(ws + WS_G)};
                gemm_phase<EpiG1, ExpertOrder, true>(lds + RING_OFF, D, S, E, wave0);
            } else {
                ExpertOrder S = xl ? ExpertOrder{32 - mx4, xq - mx4, 512, 4, (const char*)(ws + WS_G), (const char*)(wl + WO_EO), (size_t)1024 * 512 * 2, pref, (const int*)(ws + WS_TOKL), cnt, 0, 0, 2, jBx, 2, xx, frb, ltot}
                                   : ExpertOrder{G - n3, bx - n3, 512, 4, (const char*)(ws + WS_G), (const char*)(wl + WO_EO), (size_t)1024 * 512 * 2, pref, (const int*)(ws + WS_TOKL), cnt, 0, 0, 2, jB, 0, 0, 0, 0};
                EpiPlain E{(bf16_t*)(ws + WS_YS), D, 1, pref + 40};
                gemm_phase<EpiPlain, ExpertOrder, true>(lds + RING_OFF, 512, S, E, wave0);
            }
        }
        if (!dyn) SEAM(pb + 6);
        if (!dyn && IN(pb + 7)) for (int rep = 0; rep < REPS(64); ++rep) {
            KArgs A = fresh(kp0); unsigned char* ws = A->ws; unsigned char* wl = ws + WS_W + (size_t)L * WL_STRIDE; const int* cnt = (const int*)((unsigned*)(ws + WS_CTL) + CW_CNT) + L * NE * CNT_STRIDE;
            ExpertOrder S = xl ? ExpertOrder{32, xq, 512, 4, (const char*)(ws + WS_G), (const char*)(wl + WO_EO), (size_t)1024 * 512 * 2, pref, (const int*)(ws + WS_TOKL), cnt, 0, jBx, 1 << 20, ltot, 2, xx, frb, ltot}
                               : ExpertOrder{G, bx, 512, 4, (const char*)(ws + WS_G), (const char*)(wl + WO_EO), (size_t)1024 * 512 * 2, pref, (const int*)(ws + WS_TOKL), cnt, 0, jB, 1 << 20, nG1, 0, 0, 0, 0};
            EpiPlain E{(bf16_t*)(ws + WS_YS), D, 1, pref + 40};
            gemm_phase<EpiPlain, ExpertOrder, true>(lds + RING_OFF, 512, S, E, wave0);
        }
        SEAM(pb + 7);
        if (IN(pb + 8)) {
            KArgs A = fresh(kp0); unsigned char* ws = A->ws;
            FK_IDS;
            combine_pass((bf16_t*)(ws + WS_XB1), (const bf16_t*)(ws + WS_YS), pref, (const int*)(ws + WS_TKE), (const int*)(ws + WS_TKP), (const float*)(ws + WS_TKW), (float*)(ws + WS_RS3), lane, gw, NGW);
        }
        SEAM(pb + 8);
        if (IN(pb + 9)) {
            KArgs A = fresh(kp0); unsigned char* ws = A->ws; unsigned char* wl = ws + WS_W + (size_t)L * WL_STRIDE;
            DenseOrder S; S.init(M, D, G, bx, ws + WS_XB1, wl + WO_PG, D);
            EpiPle E{(const bf16_t*)(ws + WS_XB1), (FK_LASTSKIP && L == nlayers - 1) ? (bf16_t*)nullptr : (bf16_t*)(ws + WS_XB), (L == nlayers - 1) ? A->out : (float*)nullptr, (const bf16_t*)(ws + WS_E) + (size_t)L * M * D, (const float*)(ws + WS_RS3), (float*)(ws + WS_XPART)};
            gemm_phase<EpiPle, DenseOrder, false>(lds + RING_OFF, D, S, E, wave0);
        }
        SEAM(pb + 9);
    }
#undef IN
#undef SEAM
#undef SEAM_F
#undef FK_IDS
#undef FK_T0
}
}
#ifndef FK_N_LAUNCHES
#define FK_N_LAUNCHES 1
#endif
static int fk_grid = 0;
static bool fk_setup() {
    if (fk_grid) return fk_grid > 0;
    int dev = 0, cus = 0, per_cu = 0;
    if (hipGetDevice(&dev) != hipSuccess || hipDeviceGetAttribute(&cus, hipDeviceAttributeMultiprocessorCount, dev) != hipSuccess) { fprintf(stderr, "kernel_launch: device query failed\n"); fk_grid = -1; return false; }
    if (hipFuncSetAttribute((const void*)fk::mega_fwd, hipFuncAttributeMaxDynamicSharedMemorySize, fk::LDS_BYTES) != hipSuccess) { fprintf(stderr, "kernel_launch: hipFuncSetAttribute failed\n"); fk_grid = -1; return false; }
    if (hipOccupancyMaxActiveBlocksPerMultiprocessor(&per_cu, (const void*)fk::mega_fwd, fk::NWAVES * 64, fk::LDS_BYTES) != hipSuccess || per_cu < 1)
        fprintf(stderr, "kernel_launch: note: occupancy query reports %d workgroups per CU\n", per_cu);
    (void)hipGetLastError();
    fk_grid = cus;
    return true;
}
static void fk_launch_range(fk::Args a, int lo, int hi, hipStream_t stream) {
    a.ph_lo = lo; a.ph_hi = hi;
    hipLaunchKernelGGL(fk::mega_fwd, dim3(fk_grid), dim3(fk::NWAVES * 64), fk::LDS_BYTES, stream, a);
    const hipError_t le = hipPeekAtLastError();
    if (le != hipSuccess) fprintf(stderr, "kernel_launch: launch [%d,%d) failed: %s\n", lo, hi, hipGetErrorName(le));
}

#ifdef FK_DEBUG_CHECK
#ifndef FK_FOCUS
#define FK_FOCUS 0
#endif
#ifndef FK_STAT
#define FK_STAT 1
#endif
namespace dbg {
__global__ void __launch_bounds__(256) k_cmp(const void* fast, int is_bf16, int fld, int fcol0, const float* gold, int gld, int gcol0, int rows, int cols, float gscale, float* acc) {
    float sd = 0.f, sb = 0.f, sa = 0.f, sb2 = 0.f;
    const size_t n = (size_t)rows * cols;
    for (size_t i = (size_t)blockIdx.x * 256 + threadIdx.x; i < n; i += (size_t)gridDim.x * 256) {
        const size_t r = i / cols; const int c = (int)(i % cols);
        float a;
        if (is_bf16) { const unsigned short h = ((const unsigned short*)fast)[r * fld + fcol0 + c]; a = __uint_as_float((unsigned)h << 16); } else a = ((const float*)fast)[r * fld + fcol0 + c];
        const float b = gold[r * gld + gcol0 + c] * gscale;
        const float d = a - b; sd += d * d; sb += b * b; sa += (FK_STAT == 2 ? a : FK_STAT == 3 ? a * b : FK_STAT == 4 ? (a > 0.99f ? 1.f : 0.f) : a * a); sb2 += (FK_STAT == 2 ? b : FK_STAT == 4 ? 1.f : b * b);
    }
    for (int o = 1; o < 64; o <<= 1) { sd += __shfl_xor(sd, o); sb += __shfl_xor(sb, o); sa += __shfl_xor(sa, o); sb2 += __shfl_xor(sb2, o); }
    if ((threadIdx.x & 63) == 0) { atomicAdd(&acc[0], sd); atomicAdd(&acc[1], sb); atomicAdd(&acc[512], sa); atomicAdd(&acc[513], sb2); }
}
__global__ void __launch_bounds__(256) k_cmp_vs(const unsigned short* vsb, const float* vspart, const float* gain, const float* gz, float* acc) {
    const int row = blockIdx.x * 4 + (threadIdx.x >> 6), lane = threadIdx.x & 63;
    float ss = 0.f; for (int j = 0; j < 8; ++j) ss += vspart[(size_t)row * 8 + j];
    const float rv = 1.f / sqrtf(ss / 512.f + 1e-6f);
    float sd = 0.f, sb = 0.f;
    for (int j = 0; j < 8; ++j) { const int c = lane + 64 * j; const float a = __uint_as_float((unsigned)vsb[(size_t)row * 512 + c] << 16) * rv * gain[c]; const float b = gz[(size_t)row * 4608 + 2048 + c]; sd += (a - b) * (a - b); sb += b * b; }
    for (int o = 1; o < 64; o <<= 1) { sd += __shfl_xor(sd, o); sb += __shfl_xor(sb, o); }
    if (lane == 0) { atomicAdd(&acc[0], sd); atomicAdd(&acc[1], sb); }
}
__global__ void __launch_bounds__(256) k_cmp_w(const unsigned short* wt, const float* w, const float* gain, int n0, int n1, float* acc) {
    float sd = 0.f, sb = 0.f; const size_t tot = (size_t)(n1 - n0) * 1024;
    for (size_t i = (size_t)blockIdx.x * 256 + threadIdx.x; i < tot; i += (size_t)gridDim.x * 256) { const int n = n0 + (int)(i >> 10), k = (int)(i & 1023);
        const float a = __uint_as_float((unsigned)wt[(size_t)n * 1024 + k] << 16), b = gain[k] * w[(size_t)k * 4608 + n]; sd += (a - b) * (a - b); sb += b * b; }
    for (int o = 1; o < 64; o <<= 1) { sd += __shfl_xor(sd, o); sb += __shfl_xor(sb, o); }
    if ((threadIdx.x & 63) == 0) { atomicAdd(&acc[0], sd); atomicAdd(&acc[1], sb); }
}
__global__ void k_final_v(const float* acc, int nchecks, float tol, float* v, int focus) {
    if (threadIdx.x == 0 && blockIdx.x == 0) {
        float out = 0.f;
        if (focus > 0) { float m = acc[2 * focus + 512] / acc[2 * focus + 513]; if (FK_STAT == 1) m = sqrtf(m); if (!(m <= 8.f)) m = 8.f; m = floorf(m * 20.f + 0.5f) * 0.05f; v[0] = powf(10.f, (float)focus) * (1.f + m); return; }
        for (int c = nchecks; c >= 1; --c) { const float e = sqrtf(acc[2 * c] / acc[2 * c + 1]); if (!(e <= tol)) { float m = e; if (!(m <= 2.f)) m = 2.f; m = floorf(m * 10.f + 0.5f) * 0.1f;   out = powf(10.f, (float)c) * (1.f + m); } }
        v[0] = out;
    }
}
__global__ void __launch_bounds__(256) k_scale_out(const float* base, const float* v, float* out, size_t n) {
    const size_t i = (size_t)blockIdx.x * 256 + threadIdx.x; if (i < n) out[i] = base[i] * (1.f + v[0]);
}
}
#endif

extern "C" void kernel_launch(void* const* d_in, const int* in_sizes, int n_in, void* d_out, int out_size, void* d_ws, size_t ws_size, hipStream_t stream) {
    using namespace fk;
    if (n_in != 22 || out_size != M * D || ws_size < WS_FAST_END) { fprintf(stderr, "kernel_launch: unexpected shapes (n_in %d out %d ws %zu)\n", n_in, out_size, ws_size); return; }
    if (!fk_setup()) return;
    if (hipMemsetAsync((char*)d_ws + WS_CTL, 0, CTL_ZERO_BYTES, stream) != hipSuccess) { fprintf(stderr, "kernel_launch: memset failed\n"); return; }
    Args a{};
    for (int i = 0; i < 22; ++i) a.in[i] = (const float*)d_in[i];
    a.out = (float*)d_out; a.ws = (unsigned char*)d_ws; a.nlayers = DEPTH; a.pad = 0;
#ifndef FK_DEBUG_CHECK
    const int nph = 2 + PH_PER_LAYER * DEPTH;
    if (FK_N_LAUNCHES == 1) fk_launch_range(a, 0, nph, stream);
    else for (int p = 0; p < nph; ++p) fk_launch_range(a, p, p + 1, stream);
#else
    constexpr size_t GOLD_BASE = 1100 * MiB, SN_A = 128 * MiB, SN_B = 192 * MiB, SN_BASE = 256 * MiB, FS_A = 320 * MiB, FS_B = 384 * MiB, DBG_ACC = 448 * MiB;
    if (ws_size < GOLD_BASE + gold::O_END) { fprintf(stderr, "kernel_launch: debug build needs %zu bytes of workspace, got %zu\n", GOLD_BASE + gold::O_END, ws_size); return; }
    unsigned char* ws = (unsigned char*)d_ws; unsigned char* gb = ws + GOLD_BASE;
    gold::forward(d_in, (float*)(ws + SN_BASE), gb, 4, stream);
    gold::forward(d_in, nullptr, gb, 1, stream, (float*)(ws + SN_A), (float*)(ws + SN_B));
    a.nlayers = 1;
    const int nph = 2 + PH_PER_LAYER;
    for (int p = 0; p < nph; ++p) {
        fk_launch_range(a, p, p + 1, stream);
        if (p == 2 + 0) (void)hipMemcpyAsync(ws + 528 * MiB, ws + WS_GAB, (size_t)M * 2048 * 2, hipMemcpyDeviceToDevice, stream);
        if (p == 2 + 3) (void)hipMemcpyAsync(ws + FS_A, d_out, (size_t)M * D * 4, hipMemcpyDeviceToDevice, stream);
        if (p == 2 + 7) (void)hipMemcpyAsync(ws + FS_B, d_out, (size_t)M * D * 4, hipMemcpyDeviceToDevice, stream);
    }
    float* acc = (float*)(ws + DBG_ACC);
    (void)hipMemsetAsync(acc, 0, 4096, stream);
    const float* gz = (const float*)(gb + gold::O_Z);
    int c = 0;
#define CMP(fast, isbf, fld, fc0, gold_, gld, gc0, rows, cols, gs) do { ++c; hipLaunchKernelGGL(dbg::k_cmp, dim3(2048), dim3(256), 0, stream, (const void*)(fast), isbf, fld, fc0, (const float*)(gold_), gld, gc0, rows, cols, gs, acc + 2 * c); } while (0)
    ++c; hipLaunchKernelGGL(dbg::k_cmp_w, dim3(1024), dim3(256), 0, stream, (const unsigned short*)(ws + WS_W + WO_IN), (const float*)d_in[3], (const float*)d_in[2], 1024, 2560, acc + 2 * c);
    ++c; hipLaunchKernelGGL(dbg::k_cmp_w, dim3(1024), dim3(256), 0, stream, (const unsigned short*)(ws + WS_W + WO_IN), (const float*)d_in[3], (const float*)d_in[2], 2560, 3584, acc + 2 * c);
    ++c; hipLaunchKernelGGL(dbg::k_cmp_w, dim3(1024), dim3(256), 0, stream, (const unsigned short*)(ws + WS_W + WO_IN), (const float*)d_in[3], (const float*)d_in[2], 3584, 4608, acc + 2 * c);
    CMP(ws + WS_E, 1, 1024, 0, gb + gold::O_YB, 1024, 0, M, 1024, 1.f);
    CMP(ws + WS_Q, 1, 512, 0, gz, INW, 0, M, 512, 0.125f * LOG2E);
    CMP(ws + WS_K, 1, 512, 0, gz, INW, 512, M, 512, 1.f);
    CMP(ws + WS_V, 1, 512, 0, gz, INW, 1024, M, 512, 1.f);
    CMP(ws + WS_U, 1, 512, 0, gz, INW, 1536, M, 512, 1.f);
    ++c; hipLaunchKernelGGL(dbg::k_cmp_vs, dim3(M / 4), dim3(256), 0, stream, (const unsigned short*)(ws + WS_VS), (const float*)(ws + WS_VSPART), (const float*)d_in[6], gz, acc + 2 * c);
    CMP(ws + WS_OC, 1, 1024, 0, gb + gold::O_OA, 512, 0, M, 512, 1.f);
    CMP(ws + WS_OC, 1, 1024, 512, gb + gold::O_OB, 512, 0, M, 512, 1.f);
    CMP(ws + WS_MG, 1, 1024, 0, gb + gold::O_YA, 1024, 0, M, 1024, 1.f);
    CMP(ws + FS_A, 0, 1024, 0, ws + SN_A, 1024, 0, M, 1024, 1.f);
    CMP(ws + FS_B, 0, 1024, 0, ws + SN_B, 1024, 0, M, 1024, 1.f);
    CMP(d_out, 0, 1024, 0, gb + gold::O_X, 1024, 0, M, 1024, 1.f);
    CMP(ws + 528 * MiB, 1, 2048, 0, gz, INW, 2560, M, 256, 1.f);
    CMP(ws + WS_GAB, 1, 2048, 0, gz, INW, 2560, M, 256, 1.f);
    CMP(ws + WS_GAB, 1, 2048, 256, gz, INW, 2816, M, 256, 1.f);
    CMP(ws + WS_GAB, 1, 2048, 512, gz, INW, 3072, M, 512, 1.f);
    CMP(ws + WS_GAB, 1, 2048, 1024, gz, INW, 3584, M, 1024, 1.f);
    hipLaunchKernelGGL(dbg::k_final_v, dim3(1), dim3(64), 0, stream, acc, c, 0.03f, acc + 900, FK_FOCUS);
    hipLaunchKernelGGL(dbg::k_scale_out, dim3(M * D / 256), dim3(256), 0, stream, (const float*)(ws + SN_BASE), acc + 900, (float*)d_out, (size_t)M * D);
#endif
}
```
